# Optimizing an MI355X kernel written in HIP

```python
import math
import jax, jax.numpy as jnp
from jax import lax
import numpy as np

D_MODEL = 1024
BATCH = 4
SEQ = 4096
DEPTH = 1

CHUNK = 64
D_MIX = D_MODEL
SB_HEADS = 8
SB_HEAD_DIM = 64
D_SB = SB_HEADS * SB_HEAD_DIM
CONV_GROUPS = 8
D_CONV = D_MIX - D_SB
CONV_WIDTH = 3
Q_BLOCK = 128
D_IN_PROJ = 3 * D_SB + 3 * D_CONV
PEER_HEADS = 8
N_KEYS = 128
N_EXPERTS = N_KEYS * N_KEYS
D_KEY = 256
D_HALF = D_KEY // 2
TOPK_HALF = 16
TOPK = 16
TOKEN_BLOCK = 128
EPS = 1e-6

kernel_name = "hymba_stickbreak_shortconv_peer_block"


def _rmsnorm(x, g):
    x32 = x.astype(jnp.float32)
    inv = lax.rsqrt(jnp.mean(x32 * x32, axis=-1, keepdims=True) + EPS)
    return (x32 * inv).astype(x.dtype) * g


def _stick_breaking(q, k, v):
    seq = q.shape[2]
    scale = 1.0 / math.sqrt(q.shape[-1])
    outs = []
    for i in range(seq // Q_BLOCK):
        q0 = i * Q_BLOCK
        kv_len = q0 + Q_BLOCK
        qb = q[:, :, q0:kv_len].astype(jnp.float32)
        kb = k[:, :, :kv_len].astype(jnp.float32)
        vb = v[:, :, :kv_len]
        z = jnp.einsum('bhqd,bhkd->bhqk', qb, kb) * scale
        t_pos = q0 + jnp.arange(Q_BLOCK)
        s_pos = jnp.arange(kv_len)
        mask = s_pos[None, :] < t_pos[:, None]
        log_beta = jax.nn.log_sigmoid(z)
        log_1m = jnp.where(mask, jax.nn.log_sigmoid(-z), 0.0)
        log_stick = lax.cumsum(log_1m, axis=3, reverse=True) - log_1m
        a = jnp.where(mask, jnp.exp(log_beta + log_stick), 0.0)
        outs.append(jnp.einsum('bhqk,bhkd->bhqd', a.astype(vb.dtype), vb))
    return jnp.concatenate(outs, axis=2)


def _short_conv(xc, b_gate, c_gate, conv_w):
    seq = xc.shape[1]
    u = c_gate * xc
    up = jnp.pad(u, ((0, 0), (CONV_WIDTH - 1, 0), (0, 0)))
    y = sum(conv_w[w] * up[:, w:w + seq] for w in range(CONV_WIDTH))
    return b_gate * y


def _peer(h, w_q, sub_keys, expert_u, expert_v):
    bsz, seq, d = h.shape
    tok = h.reshape(bsz * seq, d)
    q = (tok @ w_q).reshape(-1, PEER_HEADS, D_KEY)
    q1, q2 = q[..., :D_HALF], q[..., D_HALF:]
    s1 = jnp.einsum('thd,kd->thk', q1, sub_keys[0]).astype(jnp.float32)
    s2 = jnp.einsum('thd,kd->thk', q2, sub_keys[1]).astype(jnp.float32)
    v1, i1 = lax.top_k(s1, TOPK_HALF)
    v2, i2 = lax.top_k(s2, TOPK_HALF)
    cand_s = (v1[..., :, None] + v2[..., None, :]).reshape(-1, PEER_HEADS, TOPK_HALF * TOPK_HALF)
    cand_i = (i1[..., :, None] * N_KEYS + i2[..., None, :]).reshape(-1, PEER_HEADS, TOPK_HALF * TOPK_HALF)
    top_s, pos = lax.top_k(cand_s, TOPK)
    idx = jnp.take_along_axis(cand_i, pos, axis=-1)
    gate = jax.nn.softmax(top_s, axis=-1).astype(h.dtype)

    n_blk = tok.shape[0] // TOKEN_BLOCK
    xb = tok.reshape(n_blk, TOKEN_BLOCK, d)
    ib = idx.reshape(n_blk, TOKEN_BLOCK, PEER_HEADS, TOPK)
    gb = gate.reshape(n_blk, TOKEN_BLOCK, PEER_HEADS, TOPK)

    def block_fn(args):
        xt, it, gt = args
        u = expert_u[it]
        vv = expert_v[it]
        act = jax.nn.gelu(jnp.einsum('thkd,td->thk', u, xt), approximate=False)
        return jnp.einsum('thk,thkd->td', gt * act, vv)

    out = lax.map(block_fn, (xb, ib, gb))
    return out.reshape(bsz, seq, d)


def setup_inputs(seed: int = 0) -> dict:
    key = jax.random.key(seed)
    ks = jax.random.split(key, 16)
    f32 = jnp.float32

    def gain(k, n):
        return (1.0 + 0.02 * jax.random.normal(k, (DEPTH, n))).astype(f32)

    return {
        "x": jax.random.normal(ks[0], (BATCH, SEQ, D_MODEL), f32),
        "norm1_g": gain(ks[1], D_MODEL),
        "w_in": jax.random.normal(ks[2], (DEPTH, D_MODEL, D_IN_PROJ), f32) * D_MODEL ** -0.5,
        "q_norm_g": gain(ks[3], SB_HEAD_DIM),
        "k_norm_g": gain(ks[4], SB_HEAD_DIM),
        "conv_w": jax.random.normal(ks[5], (DEPTH, CONV_WIDTH, D_CONV), f32) * CONV_WIDTH ** -0.5,
        "sb_out_g": gain(ks[6], D_SB),
        "conv_out_g": gain(ks[7], D_CONV),
        "w_out": jax.random.normal(ks[8], (DEPTH, D_MIX, D_MODEL), f32) * D_MIX ** -0.5,
        "norm2_g": gain(ks[9], D_MODEL),
        "peer_w_q": jax.random.normal(ks[10], (DEPTH, D_MODEL, PEER_HEADS * D_KEY), f32) * D_MODEL ** -0.5,
        "peer_sub_keys": jax.random.normal(ks[11], (DEPTH, 2, N_KEYS, D_HALF), f32) * D_HALF ** -0.5,
        "peer_u": jax.random.normal(ks[12], (DEPTH, N_EXPERTS, D_MODEL), f32) * D_MODEL ** -0.5,
        "peer_v": jax.random.normal(ks[13], (DEPTH, N_EXPERTS, D_MODEL), f32) * 0.5,
    }


def reference(x, norm1_g, w_in, q_norm_g, k_norm_g, conv_w, sb_out_g, conv_out_g,
              w_out, norm2_g, peer_w_q, peer_sub_keys, peer_u, peer_v):
    bsz, seq, _ = x.shape
    for l in range(DEPTH):
        h = _rmsnorm(x, norm1_g[l])
        proj = h @ w_in[l]
        q, k, v, xc, b_gate, c_gate = jnp.split(
            proj, [D_SB, 2 * D_SB, 3 * D_SB, 3 * D_SB + D_CONV, 3 * D_SB + 2 * D_CONV], axis=-1)
        q = _rmsnorm(q.reshape(bsz, seq, SB_HEADS, SB_HEAD_DIM), q_norm_g[l]).transpose(0, 2, 1, 3)
        k = _rmsnorm(k.reshape(bsz, seq, SB_HEADS, SB_HEAD_DIM), k_norm_g[l]).transpose(0, 2, 1, 3)
        v = v.reshape(bsz, seq, SB_HEADS, SB_HEAD_DIM).transpose(0, 2, 1, 3)
        sb = _stick_breaking(q, k, v).transpose(0, 2, 1, 3).reshape(bsz, seq, D_SB)
        cv = _short_conv(xc, b_gate, c_gate, conv_w[l])
        mixed = jnp.concatenate([_rmsnorm(sb, sb_out_g[l]), _rmsnorm(cv, conv_out_g[l])], axis=-1)
        x = x + mixed @ w_out[l]
        h2 = _rmsnorm(x, norm2_g[l])
        x = x + _peer(h2, peer_w_q[l], peer_sub_keys[l], peer_u[l], peer_v[l])
    return x
```

```cpp
#include <hip/hip_runtime.h>
#include <hip/hip_cooperative_groups.h>
#include <cstdio>
#include <cstdint>
namespace cg = cooperative_groups;

typedef __attribute__((ext_vector_type(8))) short bf16x8;
typedef __attribute__((ext_vector_type(4))) float f32x4;
typedef unsigned short u16;
#define DI __device__ __forceinline__

constexpr int T = 16384, D = 1024, SEQ = 4096;
constexpr int DIN = 3072, DSB = 512;
constexpr int NEXP = 16384;
constexpr float EPS = 1e-6f;
constexpr int NTHREADS = 256;

constexpr size_t MBy = 1u << 20;
constexpr size_t WS_WTIN = 0, WS_WTOUT = 6 * MBy, WS_WTQ = 8 * MBy, WS_ACT = 13 * MBy, WS_PROJ = 45 * MBy,
                 WS_SB = 141 * MBy, WS_IDX = 173 * MBy, WS_GATE = 181 * MBy, WS_U16 = 189 * MBy, WS_V16 = 221 * MBy;

struct Params {
  const float *x, *norm1_g, *w_in, *q_norm_g, *k_norm_g, *conv_w, *sb_out_g, *conv_out_g, *w_out, *norm2_g, *w_q, *sub_keys, *peer_u, *peer_v;
  float* out; unsigned char* ws; int ph_lo, ph_hi;
};

DI u16 f2bf(float x) { unsigned u = __float_as_uint(x); u += 0x7fffu + ((u >> 16) & 1u); return (u16)(u >> 16); }
DI float bflo(unsigned w) { return __uint_as_float(w << 16); }
DI float bfhi(unsigned w) { return __uint_as_float(w & 0xffff0000u); }
DI unsigned pack2(float a, float b) { return (unsigned)f2bf(a) | ((unsigned)f2bf(b) << 16); }
DI float wave_sum(float v) {
#pragma unroll
  for (int o = 32; o >= 1; o >>= 1) v += __shfl_xor(v, o);
  return v;
}
DI float wave_max(float v) {
#pragma unroll
  for (int o = 32; o >= 1; o >>= 1) v = fmaxf(v, __shfl_xor(v, o));
  return v;
}

DI void transpose_convert(const float* __restrict__ W, u16* __restrict__ Wt, int K, int N, float* sm) {
  const int tid = threadIdx.x, tn_cnt = N / 64, ntile = (K / 64) * tn_cnt;
  for (int tile = blockIdx.x; tile < ntile; tile += gridDim.x) {
    const int tk = tile / tn_cnt, tn = tile % tn_cnt;
    __syncthreads();
#pragma unroll
    for (int r = 0; r < 16; ++r) { const int row = r * 4 + (tid >> 6), col = tid & 63; sm[row * 65 + col] = W[(size_t)(tk * 64 + row) * N + tn * 64 + col]; }
    __syncthreads();
#pragma unroll
    for (int r = 0; r < 16; ++r) { const int nrow = r * 4 + (tid >> 6), kcol = tid & 63; Wt[(size_t)(tn * 64 + nrow) * K + tk * 64 + kcol] = f2bf(sm[kcol * 65 + nrow]); }
  }
}
DI void convert_bf16(const float* __restrict__ src, u16* __restrict__ dst, size_t n) {
  const size_t n8 = n / 8;
  for (size_t i = (size_t)blockIdx.x * NTHREADS + threadIdx.x; i < n8; i += (size_t)gridDim.x * NTHREADS) {
    const float4 a = ((const float4*)src)[2 * i], b = ((const float4*)src)[2 * i + 1];
    uint4 o; o.x = pack2(a.x, a.y); o.y = pack2(a.z, a.w); o.z = pack2(b.x, b.y); o.w = pack2(b.z, b.w);
    ((uint4*)dst)[i] = o;
  }
}
DI void rmsnorm1024(const float* __restrict__ src, const float* __restrict__ g, u16* __restrict__ dst) {
  const int lane = threadIdx.x & 63, gw = blockIdx.x * 4 + (threadIdx.x >> 6), nw = gridDim.x * 4;
  for (int row = gw; row < T; row += nw) {
    const float4* xr = (const float4*)(src + (size_t)row * D);
    float4 v[4]; float ss = 0.f;
#pragma unroll
    for (int j = 0; j < 4; ++j) { v[j] = xr[lane + 64 * j]; ss += v[j].x * v[j].x + v[j].y * v[j].y + v[j].z * v[j].z + v[j].w * v[j].w; }
    ss = wave_sum(ss);
    const float inv = rsqrtf(ss * (1.f / D) + EPS);
#pragma unroll
    for (int j = 0; j < 4; ++j) {
      const float4 gg = ((const float4*)g)[lane + 64 * j];
      uint2 o; o.x = pack2(v[j].x * inv * gg.x, v[j].y * inv * gg.y); o.y = pack2(v[j].z * inv * gg.z, v[j].w * inv * gg.w);
      *(uint2*)(dst + (size_t)row * D + 4 * (lane + 64 * j)) = o;
    }
  }
}

constexpr int GP = 72;
template <int EPI>
DI void gemm_phase(const u16* __restrict__ A, const u16* __restrict__ Bt, int M, int N, int K, u16* __restrict__ out16, int ldc,
                   const float* __restrict__ resid, float* __restrict__ out32, u16* sm) {
  u16* sA = sm; u16* sB = sm + 128 * GP;
  const int tid = threadIdx.x, lane = tid & 63, wave = tid >> 6, wm = wave >> 1, wn = wave & 1;
  const int l15 = lane & 15, quad = lane >> 4;
  const int tiles_n = N / 128, ntiles = (M / 128) * tiles_n, nk = K / 64;
  for (int tile = blockIdx.x; tile < ntiles; tile += gridDim.x) {
    const int m0 = (tile / tiles_n) * 128, n0 = (tile % tiles_n) * 128;
    f32x4 acc[4][4];
#pragma unroll
    for (int i = 0; i < 4; ++i)
#pragma unroll
      for (int j = 0; j < 4; ++j) acc[i][j] = (f32x4){0.f, 0.f, 0.f, 0.f};
    const int lrow = tid >> 3, lkc = (tid & 7) * 8;
    const u16* ga = A + (size_t)(m0 + lrow) * K + lkc;
    const u16* gb = Bt + (size_t)(n0 + lrow) * K + lkc;
    uint4 ra0, ra1, ra2, ra3, rb0, rb1, rb2, rb3;
#define GLOAD(koff) do { \
      ra0 = *(const uint4*)(ga + (koff)); ra1 = *(const uint4*)(ga + (size_t)32 * K + (koff)); \
      ra2 = *(const uint4*)(ga + (size_t)64 * K + (koff)); ra3 = *(const uint4*)(ga + (size_t)96 * K + (koff)); \
      rb0 = *(const uint4*)(gb + (koff)); rb1 = *(const uint4*)(gb + (size_t)32 * K + (koff)); \
      rb2 = *(const uint4*)(gb + (size_t)64 * K + (koff)); rb3 = *(const uint4*)(gb + (size_t)96 * K + (koff)); } while (0)
    GLOAD(0);
    for (int kt = 0; kt < nk; ++kt) {
      __syncthreads();
      *(uint4*)(sA + (lrow) * GP + lkc) = ra0; *(uint4*)(sA + (lrow + 32) * GP + lkc) = ra1;
      *(uint4*)(sA + (lrow + 64) * GP + lkc) = ra2; *(uint4*)(sA + (lrow + 96) * GP + lkc) = ra3;
      *(uint4*)(sB + (lrow) * GP + lkc) = rb0; *(uint4*)(sB + (lrow + 32) * GP + lkc) = rb1;
      *(uint4*)(sB + (lrow + 64) * GP + lkc) = rb2; *(uint4*)(sB + (lrow + 96) * GP + lkc) = rb3;
      __syncthreads();
      if (kt + 1 < nk) GLOAD((kt + 1) * 64);
#pragma unroll
      for (int ks = 0; ks < 2; ++ks) {
        bf16x8 aop[4], bop[4];
#pragma unroll
        for (int i = 0; i < 4; ++i) aop[i] = *(const bf16x8*)(sB + (wn * 64 + i * 16 + l15) * GP + ks * 32 + quad * 8);
#pragma unroll
        for (int j = 0; j < 4; ++j) bop[j] = *(const bf16x8*)(sA + (wm * 64 + j * 16 + l15) * GP + ks * 32 + quad * 8);
#pragma unroll
        for (int i = 0; i < 4; ++i)
#pragma unroll
          for (int j = 0; j < 4; ++j) acc[i][j] = __builtin_amdgcn_mfma_f32_16x16x32_bf16(aop[i], bop[j], acc[i][j], 0, 0, 0);
      }
    }
#pragma unroll
    for (int i = 0; i < 4; ++i)
#pragma unroll
      for (int j = 0; j < 4; ++j) {
        const int m = m0 + wm * 64 + j * 16 + l15, n = n0 + wn * 64 + i * 16 + quad * 4;
        const f32x4 v = acc[i][j];
        if (EPI == 0) {
          uint2 o; o.x = pack2(v[0], v[1]); o.y = pack2(v[2], v[3]);
          *(uint2*)(out16 + (size_t)m * ldc + n) = o;
        } else {
          const float4 r = *(const float4*)(resid + (size_t)m * ldc + n);
          float4 o; o.x = r.x + v[0]; o.y = r.y + v[1]; o.z = r.z + v[2]; o.w = r.w + v[3];
          *(float4*)(out32 + (size_t)m * ldc + n) = o;
        }
      }
  }
}

DI void unpack8(const uint4 w, float* f) {
  f[0] = bflo(w.x); f[1] = bfhi(w.x); f[2] = bflo(w.y); f[3] = bfhi(w.y); f[4] = bflo(w.z); f[5] = bfhi(w.z); f[6] = bflo(w.w); f[7] = bfhi(w.w);
}
DI uint4 pack8(const float* f) { uint4 o; o.x = pack2(f[0], f[1]); o.y = pack2(f[2], f[3]); o.z = pack2(f[4], f[5]); o.w = pack2(f[6], f[7]); return o; }
DI void postproj_phase(const Params& p, u16* __restrict__ proj, u16* __restrict__ mixed) {
  const int lane = threadIdx.x & 63, gw = blockIdx.x * 4 + (threadIdx.x >> 6), nw = gridDim.x * 4;
  for (int t = gw; t < T; t += nw) {
    u16* row = proj + (size_t)t * DIN;
#pragma unroll
    for (int which = 0; which < 2; ++which) {
      float f[8]; unpack8(*(const uint4*)(row + which * 512 + 8 * lane), f);
      float ss = 0.f;
#pragma unroll
      for (int j = 0; j < 8; ++j) ss += f[j] * f[j];
      ss += __shfl_xor(ss, 1); ss += __shfl_xor(ss, 2); ss += __shfl_xor(ss, 4);
      const float inv = rsqrtf(ss * (1.f / 64.f) + EPS);
      const float* g = (which == 0 ? p.q_norm_g : p.k_norm_g) + 8 * (lane & 7);
#pragma unroll
      for (int j = 0; j < 8; ++j) f[j] = f[j] * inv * g[j];
      *(uint4*)(row + which * 512 + 8 * lane) = pack8(f);
    }
    const int c0 = 8 * lane, tpos = t & (SEQ - 1);
    float xc[8], bg[8], cg[8], y[8];
    unpack8(*(const uint4*)(row + 1536 + c0), xc); unpack8(*(const uint4*)(row + 2048 + c0), bg); unpack8(*(const uint4*)(row + 2560 + c0), cg);
#pragma unroll
    for (int j = 0; j < 8; ++j) y[j] = p.conv_w[2 * DSB + c0 + j] * (cg[j] * xc[j]);
    if (tpos >= 1) {
      float x1[8], c1[8]; unpack8(*(const uint4*)(row - DIN + 1536 + c0), x1); unpack8(*(const uint4*)(row - DIN + 2560 + c0), c1);
#pragma unroll
      for (int j = 0; j < 8; ++j) y[j] += p.conv_w[1 * DSB + c0 + j] * (c1[j] * x1[j]);
    }
    if (tpos >= 2) {
      float x2[8], c2[8]; unpack8(*(const uint4*)(row - 2 * DIN + 1536 + c0), x2); unpack8(*(const uint4*)(row - 2 * DIN + 2560 + c0), c2);
#pragma unroll
      for (int j = 0; j < 8; ++j) y[j] += p.conv_w[0 * DSB + c0 + j] * (c2[j] * x2[j]);
    }
    float ss = 0.f;
#pragma unroll
    for (int j = 0; j < 8; ++j) { y[j] *= bg[j]; ss += y[j] * y[j]; }
    ss = wave_sum(ss);
    const float inv = rsqrtf(ss * (1.f / DSB) + EPS);
#pragma unroll
    for (int j = 0; j < 8; ++j) y[j] = y[j] * inv * p.conv_out_g[c0 + j];
    *(uint4*)(mixed + (size_t)t * D + DSB + c0) = pack8(y);
  }
}

DI void attn_phase(const u16* __restrict__ proj, float* __restrict__ sb) {
  const int lane = threadIdx.x & 63, gw = blockIdx.x * 4 + (threadIdx.x >> 6), nw = gridDim.x * 4;
  for (int item = gw; item < 4 * 8 * 64; item += nw) {
    const int qb = 63 - (item >> 5), bh = item & 31, b = bh >> 3, h = bh & 7;
    const int t0 = qb * 64, tq = t0 + lane;
    const u16* qrow = proj + (size_t)(b * SEQ + tq) * DIN + h * 64;
    float q[64], acc[64];
#pragma unroll
    for (int c = 0; c < 8; ++c) { float f[8]; unpack8(((const uint4*)qrow)[c], f);
#pragma unroll
      for (int j = 0; j < 8; ++j) { q[8 * c + j] = f[j] * 0.125f; acc[8 * c + j] = 0.f; } }
    float P = 1.f;
    for (int s = t0 + 62; s >= 0; --s) {
      const u16* krow = proj + (size_t)(b * SEQ + s) * DIN + 512 + h * 64;
      float z = 0.f;
#pragma unroll
      for (int c = 0; c < 8; ++c) { float f[8]; unpack8(((const uint4*)krow)[c], f);
#pragma unroll
        for (int j = 0; j < 8; ++j) z += q[8 * c + j] * f[j]; }
      const float e = __expf(fminf(z, 80.f));
      const float r = __builtin_amdgcn_rcpf(1.f + e);
      const bool on = s < tq;
      const float a = on ? e * r * P : 0.f;
      P = on ? P * r : P;
      const u16* vrow = krow + 512;
#pragma unroll
      for (int c = 0; c < 8; ++c) { float f[8]; unpack8(((const uint4*)vrow)[c], f);
#pragma unroll
        for (int j = 0; j < 8; ++j) acc[8 * c + j] += a * f[j]; }
      if (s < t0 && __all(P == 0.f)) break;
    }
    float* orow = sb + (size_t)(b * SEQ + tq) * DSB + h * 64;
#pragma unroll
    for (int c = 0; c < 16; ++c) ((float4*)orow)[c] = make_float4(acc[4 * c], acc[4 * c + 1], acc[4 * c + 2], acc[4 * c + 3]);
  }
}

DI void sbnorm_phase(const Params& p, const float* __restrict__ sb, u16* __restrict__ mixed) {
  const int lane = threadIdx.x & 63, gw = blockIdx.x * 4 + (threadIdx.x >> 6), nw = gridDim.x * 4;
  for (int t = gw; t < T; t += nw) {
    const float4 a = ((const float4*)(sb + (size_t)t * DSB))[2 * lane], b = ((const float4*)(sb + (size_t)t * DSB))[2 * lane + 1];
    float f[8] = {a.x, a.y, a.z, a.w, b.x, b.y, b.z, b.w};
    float ss = 0.f;
#pragma unroll
    for (int j = 0; j < 8; ++j) ss += f[j] * f[j];
    ss = wave_sum(ss);
    const float inv = rsqrtf(ss * (1.f / DSB) + EPS);
#pragma unroll
    for (int j = 0; j < 8; ++j) f[j] = f[j] * inv * p.sb_out_g[8 * lane + j];
    *(uint4*)(mixed + (size_t)t * D + 8 * lane) = pack8(f);
  }
}

DI void wave_top16_2(float a0, float a1, int lane, float& tv, int& ti) {
  tv = -INFINITY; ti = 0;
  for (int k = 0; k < 16; ++k) {
    const float m = wave_max(fmaxf(a0, a1));
    const unsigned long long b0 = __ballot(a0 == m), b1 = __ballot(a1 == m);
    int idx;
    if (b0) { const int wl = __ffsll((long long)b0) - 1; idx = wl; if (lane == wl) a0 = -INFINITY; }
    else { const int wl = __ffsll((long long)b1) - 1; idx = 64 + wl; if (lane == wl) a1 = -INFINITY; }
    if (lane == k) { tv = m; ti = idx; }
  }
}
DI void topk_phase(const Params& p, const u16* __restrict__ qp, int* __restrict__ idx_out, float* __restrict__ gate_out) {
  const int lane = threadIdx.x & 63, gw = blockIdx.x * 4 + (threadIdx.x >> 6), nw = gridDim.x * 4;
  for (int item = gw; item < T * 8; item += nw) {
    const int t = item >> 3, h = item & 7;
    const u16* q = qp + (size_t)t * 2048 + h * 256;
    float tv[2]; int ti[2];
#pragma unroll
    for (int half = 0; half < 2; ++half) {
      const float* sk = p.sub_keys + (size_t)half * 128 * 128;
      float s0 = 0.f, s1 = 0.f;
#pragma unroll 2
      for (int c = 0; c < 16; ++c) {
        float f[8]; unpack8(((const uint4*)(q + half * 128))[c], f);
        const float4 k0a = ((const float4*)(sk + (size_t)lane * 128))[2 * c], k0b = ((const float4*)(sk + (size_t)lane * 128))[2 * c + 1];
        const float4 k1a = ((const float4*)(sk + (size_t)(lane + 64) * 128))[2 * c], k1b = ((const float4*)(sk + (size_t)(lane + 64) * 128))[2 * c + 1];
        s0 += f[0] * k0a.x + f[1] * k0a.y + f[2] * k0a.z + f[3] * k0a.w + f[4] * k0b.x + f[5] * k0b.y + f[6] * k0b.z + f[7] * k0b.w;
        s1 += f[0] * k1a.x + f[1] * k1a.y + f[2] * k1a.z + f[3] * k1a.w + f[4] * k1b.x + f[5] * k1b.y + f[6] * k1b.z + f[7] * k1b.w;
      }
      wave_top16_2(s0, s1, lane, tv[half], ti[half]);
    }
    float cs[4];
#pragma unroll
    for (int jj = 0; jj < 4; ++jj) cs[jj] = __shfl(tv[0], (lane >> 4) + 4 * jj) + __shfl(tv[1], lane & 15);
    float sv = -INFINITY; int sc = 0;
    for (int k = 0; k < 16; ++k) {
      const float m = wave_max(fmaxf(fmaxf(cs[0], cs[1]), fmaxf(cs[2], cs[3])));
      int cidx = 0; bool found = false;
#pragma unroll
      for (int jj = 0; jj < 4; ++jj) {
        const unsigned long long bb = __ballot(cs[jj] == m);
        if (!found && bb) { const int wl = __ffsll((long long)bb) - 1; cidx = wl + 64 * jj; if (lane == wl) cs[jj] = -INFINITY; found = true; }
      }
      if (lane == k) { sv = m; sc = cidx; }
    }
    const int e1 = __shfl(ti[0], (sc >> 4) & 15), e2 = __shfl(ti[1], sc & 15);
    const float mx = __shfl(sv, 0);
    const float e = lane < 16 ? __expf(sv - mx) : 0.f;
    const float sum = wave_sum(e);
    if (lane < 16) { idx_out[(size_t)t * 128 + h * 16 + lane] = e1 * 128 + e2; gate_out[(size_t)t * 128 + h * 16 + lane] = e / sum; }
  }
}

DI void peer_phase(const Params& p, const u16* __restrict__ h2, const int* __restrict__ idx, const float* __restrict__ gate,
                   const u16* __restrict__ U, const u16* __restrict__ V, float* sm) {
  const int tid = threadIdx.x, lane = tid & 63, wave = tid >> 6;
  for (int t = blockIdx.x; t < T; t += gridDim.x) {
    float hx[16], acc[16];
    { float f[8]; unpack8(*(const uint4*)(h2 + (size_t)t * D + 8 * lane), f);
#pragma unroll
      for (int j = 0; j < 8; ++j) hx[j] = f[j];
      unpack8(*(const uint4*)(h2 + (size_t)t * D + 512 + 8 * lane), f);
#pragma unroll
      for (int j = 0; j < 8; ++j) hx[8 + j] = f[j]; }
#pragma unroll
    for (int j = 0; j < 16; ++j) acc[j] = 0.f;
    for (int pk = wave; pk < 128; pk += 4) {
      const int e = idx[(size_t)t * 128 + pk]; const float g = gate[(size_t)t * 128 + pk];
      const u16* ur = U + (size_t)e * D; const u16* vr = V + (size_t)e * D;
      float ua[8], ub[8], va[8], vb[8];
      unpack8(*(const uint4*)(ur + 8 * lane), ua); unpack8(*(const uint4*)(ur + 512 + 8 * lane), ub);
      unpack8(*(const uint4*)(vr + 8 * lane), va); unpack8(*(const uint4*)(vr + 512 + 8 * lane), vb);
      float d = 0.f;
#pragma unroll
      for (int j = 0; j < 8; ++j) d += ua[j] * hx[j] + ub[j] * hx[8 + j];
      d = wave_sum(d);
      const float w = g * 0.5f * d * (1.f + erff(d * 0.70710678118654752f));
#pragma unroll
      for (int j = 0; j < 8; ++j) { acc[j] += w * va[j]; acc[8 + j] += w * vb[j]; }
    }
    __syncthreads();
#pragma unroll
    for (int j = 0; j < 8; ++j) { sm[wave * 1024 + 8 * lane + j] = acc[j]; sm[wave * 1024 + 512 + 8 * lane + j] = acc[8 + j]; }
    __syncthreads();
    {
      const float4 a = ((const float4*)sm)[tid], b = ((const float4*)sm)[256 + tid], c = ((const float4*)sm)[512 + tid], d4 = ((const float4*)sm)[768 + tid];
      float4* o = (float4*)(p.out + (size_t)t * D) + tid;
      float4 r = *o;
      r.x += a.x + b.x + c.x + d4.x; r.y += a.y + b.y + c.y + d4.y; r.z += a.z + b.z + c.z + d4.z; r.w += a.w + b.w + c.w + d4.w;
      *o = r;
    }
  }
}

constexpr int NPHASE = 10;
__global__ void __launch_bounds__(NTHREADS) fwd_kernel(Params p) {
  __shared__ __attribute__((aligned(16))) unsigned char smem[2 * 128 * GP * 2];
  cg::grid_group grid = cg::this_grid();
  unsigned char* ws = p.ws;
  u16* wt_in = (u16*)(ws + WS_WTIN); u16* wt_out = (u16*)(ws + WS_WTOUT); u16* wt_q = (u16*)(ws + WS_WTQ);
  u16* act = (u16*)(ws + WS_ACT); u16* proj = (u16*)(ws + WS_PROJ); float* sb = (float*)(ws + WS_SB);
  int* idx = (int*)(ws + WS_IDX); float* gate = (float*)(ws + WS_GATE); u16* U16 = (u16*)(ws + WS_U16); u16* V16 = (u16*)(ws + WS_V16);
  const int lo = p.ph_lo, hi = p.ph_hi;
#define IN(k) (lo <= (k) && (k) < hi)
#define SEAM(k) do { if (IN(k) && IN((k) + 1)) grid.sync(); } while (0)
  if (IN(0)) {
    transpose_convert(p.w_in, wt_in, D, DIN, (float*)smem);
    transpose_convert(p.w_out, wt_out, D, D, (float*)smem);
    transpose_convert(p.w_q, wt_q, D, 2048, (float*)smem);
    convert_bf16(p.peer_u, U16, (size_t)NEXP * D);
    convert_bf16(p.peer_v, V16, (size_t)NEXP * D);
    rmsnorm1024(p.x, p.norm1_g, act);
  }
  SEAM(0);
  if (IN(1)) gemm_phase<0>(act, wt_in, T, DIN, D, proj, DIN, nullptr, nullptr, (u16*)smem);
  SEAM(1);
  if (IN(2)) postproj_phase(p, proj, act);
  SEAM(2);
  if (IN(3)) attn_phase(proj, sb);
  SEAM(3);
  if (IN(4)) sbnorm_phase(p, sb, act);
  SEAM(4);
  if (IN(5)) gemm_phase<1>(act, wt_out, T, D, D, nullptr, D, p.x, p.out, (u16*)smem);
  SEAM(5);
  if (IN(6)) rmsnorm1024(p.out, p.norm2_g, act);
  SEAM(6);
  if (IN(7)) gemm_phase<0>(act, wt_q, T, 2048, D, proj, 2048, nullptr, nullptr, (u16*)smem);
  SEAM(7);
  if (IN(8)) topk_phase(p, proj, idx, gate);
  SEAM(8);
  if (IN(9)) peer_phase(p, act, idx, gate, U16, V16, (float*)smem);
}

extern "C" void kernel_launch(void* const* d_in, const int* in_sizes, int n_in, void* d_out, int out_size, void* d_ws, size_t ws_size,
                              hipStream_t stream) {
  static int grid_blocks = 0;
  if (!grid_blocks) {
    int dev = 0, cus = 0, per_cu = 0;
    hipGetDevice(&dev);
    hipDeviceGetAttribute(&cus, hipDeviceAttributeMultiprocessorCount, dev);
    hipOccupancyMaxActiveBlocksPerMultiprocessor(&per_cu, fwd_kernel, NTHREADS, 0);
    if (per_cu < 1) per_cu = 1;
    if (per_cu > 2) per_cu = 2;
    grid_blocks = cus * per_cu;
  }
  Params p{};
  p.x = (const float*)d_in[0]; p.norm1_g = (const float*)d_in[1]; p.w_in = (const float*)d_in[2]; p.q_norm_g = (const float*)d_in[3];
  p.k_norm_g = (const float*)d_in[4]; p.conv_w = (const float*)d_in[5]; p.sb_out_g = (const float*)d_in[6]; p.conv_out_g = (const float*)d_in[7];
  p.w_out = (const float*)d_in[8]; p.norm2_g = (const float*)d_in[9]; p.w_q = (const float*)d_in[10]; p.sub_keys = (const float*)d_in[11];
  p.peer_u = (const float*)d_in[12]; p.peer_v = (const float*)d_in[13];
  p.out = (float*)d_out; p.ws = (unsigned char*)d_ws;
  for (int ph = 0; ph < NPHASE; ++ph) {
    p.ph_lo = ph; p.ph_hi = ph + 1;
    hipLaunchKernelGGL(fwd_kernel, dim3(grid_blocks), dim3(NTHREADS), 0, stream, p);
  }
}
```

```cpp
#include <hip/hip_runtime.h>
#include <hip/hip_cooperative_groups.h>
#include <cstdio>
#include <cstdint>
namespace cg = cooperative_groups;

typedef __attribute__((ext_vector_type(8))) short bf16x8;
typedef __attribute__((ext_vector_type(4))) float f32x4;
typedef unsigned short u16;
#define DI __device__ __forceinline__

constexpr int T = 16384, D = 1024, SEQ = 4096;
constexpr int DIN = 3072, DSB = 512;
constexpr int NEXP = 16384;
constexpr float EPS = 1e-6f;
constexpr int NTHREADS = 256;

constexpr size_t MBy = 1u << 20;
constexpr size_t WS_WTIN = 0, WS_WTOUT = 6 * MBy, WS_WTQ = 8 * MBy, WS_ACT = 13 * MBy, WS_PROJ = 45 * MBy,
                 WS_SB = 141 * MBy, WS_IDX = 173 * MBy, WS_GATE = 181 * MBy, WS_U16 = 189 * MBy, WS_V16 = 221 * MBy;

struct Params {
  const float *x, *norm1_g, *w_in, *q_norm_g, *k_norm_g, *conv_w, *sb_out_g, *conv_out_g, *w_out, *norm2_g, *w_q, *sub_keys, *peer_u, *peer_v;
  float* out; unsigned char* ws; int ph_lo, ph_hi;
};

DI u16 f2bf(float x) { unsigned u = __float_as_uint(x); u += 0x7fffu + ((u >> 16) & 1u); return (u16)(u >> 16); }
DI float bflo(unsigned w) { return __uint_as_float(w << 16); }
DI float bfhi(unsigned w) { return __uint_as_float(w & 0xffff0000u); }
DI unsigned pack2(float a, float b) { return (unsigned)f2bf(a) | ((unsigned)f2bf(b) << 16); }
DI float wave_sum(float v) {
#pragma unroll
  for (int o = 32; o >= 1; o >>= 1) v += __shfl_xor(v, o);
  return v;
}
DI float wave_max(float v) {
#pragma unroll
  for (int o = 32; o >= 1; o >>= 1) v = fmaxf(v, __shfl_xor(v, o));
  return v;
}

DI void transpose_convert(const float* __restrict__ W, u16* __restrict__ Wt, int K, int N, float* sm) {
  const int tid = threadIdx.x, tn_cnt = N / 64, ntile = (K / 64) * tn_cnt;
  for (int tile = blockIdx.x; tile < ntile; tile += gridDim.x) {
    const int tk = tile / tn_cnt, tn = tile % tn_cnt;
    __syncthreads();
#pragma unroll
    for (int r = 0; r < 16; ++r) { const int row = r * 4 + (tid >> 6), col = tid & 63; sm[row * 65 + col] = W[(size_t)(tk * 64 + row) * N + tn * 64 + col]; }
    __syncthreads();
#pragma unroll
    for (int r = 0; r < 16; ++r) { const int nrow = r * 4 + (tid >> 6), kcol = tid & 63; Wt[(size_t)(tn * 64 + nrow) * K + tk * 64 + kcol] = f2bf(sm[kcol * 65 + nrow]); }
  }
}
DI void convert_bf16(const float* __restrict__ src, u16* __restrict__ dst, size_t n) {
  const size_t n8 = n / 8;
  for (size_t i = (size_t)blockIdx.x * NTHREADS + threadIdx.x; i < n8; i += (size_t)gridDim.x * NTHREADS) {
    const float4 a = ((const float4*)src)[2 * i], b = ((const float4*)src)[2 * i + 1];
    uint4 o; o.x = pack2(a.x, a.y); o.y = pack2(a.z, a.w); o.z = pack2(b.x, b.y); o.w = pack2(b.z, b.w);
    ((uint4*)dst)[i] = o;
  }
}
DI void rmsnorm1024(const float* __restrict__ src, const float* __restrict__ g, u16* __restrict__ dst) {
  const int lane = threadIdx.x & 63, gw = blockIdx.x * 4 + (threadIdx.x >> 6), nw = gridDim.x * 4;
  for (int row = gw; row < T; row += nw) {
    const float4* xr = (const float4*)(src + (size_t)row * D);
    float4 v[4]; float ss = 0.f;
#pragma unroll
    for (int j = 0; j < 4; ++j) { v[j] = xr[lane + 64 * j]; ss += v[j].x * v[j].x + v[j].y * v[j].y + v[j].z * v[j].z + v[j].w * v[j].w; }
    ss = wave_sum(ss);
    const float inv = rsqrtf(ss * (1.f / D) + EPS);
#pragma unroll
    for (int j = 0; j < 4; ++j) {
      const float4 gg = ((const float4*)g)[lane + 64 * j];
      uint2 o; o.x = pack2(v[j].x * inv * gg.x, v[j].y * inv * gg.y); o.y = pack2(v[j].z * inv * gg.z, v[j].w * inv * gg.w);
      *(uint2*)(dst + (size_t)row * D + 4 * (lane + 64 * j)) = o;
    }
  }
}

constexpr int GP = 72;
template <int EPI>
DI void gemm_phase(const u16* __restrict__ A, const u16* __restrict__ Bt, int M, int N, int K, u16* __restrict__ out16, int ldc,
                   const float* __restrict__ resid, float* __restrict__ out32, u16* sm) {
  u16* sA = sm; u16* sB = sm + 128 * GP;
  const int tid = threadIdx.x, lane = tid & 63, wave = tid >> 6, wm = wave >> 1, wn = wave & 1;
  const int l15 = lane & 15, quad = lane >> 4;
  const int tiles_n = N / 128, ntiles = (M / 128) * tiles_n, nk = K / 64;
  for (int tile = blockIdx.x; tile < ntiles; tile += gridDim.x) {
    const int m0 = (tile / tiles_n) * 128, n0 = (tile % tiles_n) * 128;
    f32x4 acc[4][4];
#pragma unroll
    for (int i = 0; i < 4; ++i)
#pragma unroll
      for (int j = 0; j < 4; ++j) acc[i][j] = (f32x4){0.f, 0.f, 0.f, 0.f};
    const int lrow = tid >> 3, lkc = (tid & 7) * 8;
    const u16* ga = A + (size_t)(m0 + lrow) * K + lkc;
    const u16* gb = Bt + (size_t)(n0 + lrow) * K + lkc;
    uint4 ra0, ra1, ra2, ra3, rb0, rb1, rb2, rb3;
#define GLOAD(koff) do { \
      ra0 = *(const uint4*)(ga + (koff)); ra1 = *(const uint4*)(ga + (size_t)32 * K + (koff)); \
      ra2 = *(const uint4*)(ga + (size_t)64 * K + (koff)); ra3 = *(const uint4*)(ga + (size_t)96 * K + (koff)); \
      rb0 = *(const uint4*)(gb + (koff)); rb1 = *(const uint4*)(gb + (size_t)32 * K + (koff)); \
      rb2 = *(const uint4*)(gb + (size_t)64 * K + (koff)); rb3 = *(const uint4*)(gb + (size_t)96 * K + (koff)); } while (0)
    GLOAD(0);
    for (int kt = 0; kt < nk; ++kt) {
      __syncthreads();
      *(uint4*)(sA + (lrow) * GP + lkc) = ra0; *(uint4*)(sA + (lrow + 32) * GP + lkc) = ra1;
      *(uint4*)(sA + (lrow + 64) * GP + lkc) = ra2; *(uint4*)(sA + (lrow + 96) * GP + lkc) = ra3;
      *(uint4*)(sB + (lrow) * GP + lkc) = rb0; *(uint4*)(sB + (lrow + 32) * GP + lkc) = rb1;
      *(uint4*)(sB + (lrow + 64) * GP + lkc) = rb2; *(uint4*)(sB + (lrow + 96) * GP + lkc) = rb3;
      __syncthreads();
      if (kt + 1 < nk) GLOAD((kt + 1) * 64);
#pragma unroll
      for (int ks = 0; ks < 2; ++ks) {
        bf16x8 aop[4], bop[4];
#pragma unroll
        for (int i = 0; i < 4; ++i) aop[i] = *(const bf16x8*)(sB + (wn * 64 + i * 16 + l15) * GP + ks * 32 + quad * 8);
#pragma unroll
        for (int j = 0; j < 4; ++j) bop[j] = *(const bf16x8*)(sA + (wm * 64 + j * 16 + l15) * GP + ks * 32 + quad * 8);
#pragma unroll
        for (int i = 0; i < 4; ++i)
#pragma unroll
          for (int j = 0; j < 4; ++j) acc[i][j] = __builtin_amdgcn_mfma_f32_16x16x32_bf16(aop[i], bop[j], acc[i][j], 0, 0, 0);
      }
    }
#pragma unroll
    for (int i = 0; i < 4; ++i)
#pragma unroll
      for (int j = 0; j < 4; ++j) {
        const int m = m0 + wm * 64 + j * 16 + l15, n = n0 + wn * 64 + i * 16 + quad * 4;
        const f32x4 v = acc[i][j];
        if (EPI == 0) {
          uint2 o; o.x = pack2(v[0], v[1]); o.y = pack2(v[2], v[3]);
          *(uint2*)(out16 + (size_t)m * ldc + n) = o;
        } else {
          const float4 r = *(const float4*)(resid + (size_t)m * ldc + n);
          float4 o; o.x = r.x + v[0]; o.y = r.y + v[1]; o.z = r.z + v[2]; o.w = r.w + v[3];
          *(float4*)(out32 + (size_t)m * ldc + n) = o;
        }
      }
  }
}

DI void unpack8(const uint4 w, float* f) {
  f[0] = bflo(w.x); f[1] = bfhi(w.x); f[2] = bflo(w.y); f[3] = bfhi(w.y); f[4] = bflo(w.z); f[5] = bfhi(w.z); f[6] = bflo(w.w); f[7] = bfhi(w.w);
}
DI uint4 pack8(const float* f) { uint4 o; o.x = pack2(f[0], f[1]); o.y = pack2(f[2], f[3]); o.z = pack2(f[4], f[5]); o.w = pack2(f[6], f[7]); return o; }
DI void postproj_phase(const Params& p, u16* __restrict__ proj, u16* __restrict__ mixed) {
  const int lane = threadIdx.x & 63, gw = blockIdx.x * 4 + (threadIdx.x >> 6), nw = gridDim.x * 4;
  for (int t = gw; t < T; t += nw) {
    u16* row = proj + (size_t)t * DIN;
#pragma unroll
    for (int which = 0; which < 2; ++which) {
      float f[8]; unpack8(*(const uint4*)(row + which * 512 + 8 * lane), f);
      float ss = 0.f;
#pragma unroll
      for (int j = 0; j < 8; ++j) ss += f[j] * f[j];
      ss += __shfl_xor(ss, 1); ss += __shfl_xor(ss, 2); ss += __shfl_xor(ss, 4);
      const float inv = rsqrtf(ss * (1.f / 64.f) + EPS);
      const float* g = (which == 0 ? p.q_norm_g : p.k_norm_g) + 8 * (lane & 7);
#pragma unroll
      for (int j = 0; j < 8; ++j) f[j] = f[j] * inv * g[j];
      *(uint4*)(row + which * 512 + 8 * lane) = pack8(f);
    }
    const int c0 = 8 * lane, tpos = t & (SEQ - 1);
    float xc[8], bg[8], cg[8], y[8];
    unpack8(*(const uint4*)(row + 1536 + c0), xc); unpack8(*(const uint4*)(row + 2048 + c0), bg); unpack8(*(const uint4*)(row + 2560 + c0), cg);
#pragma unroll
    for (int j = 0; j < 8; ++j) y[j] = p.conv_w[2 * DSB + c0 + j] * (cg[j] * xc[j]);
    if (tpos >= 1) {
      float x1[8], c1[8]; unpack8(*(const uint4*)(row - DIN + 1536 + c0), x1); unpack8(*(const uint4*)(row - DIN + 2560 + c0), c1);
#pragma unroll
      for (int j = 0; j < 8; ++j) y[j] += p.conv_w[1 * DSB + c0 + j] * (c1[j] * x1[j]);
    }
    if (tpos >= 2) {
      float x2[8], c2[8]; unpack8(*(const uint4*)(row - 2 * DIN + 1536 + c0), x2); unpack8(*(const uint4*)(row - 2 * DIN + 2560 + c0), c2);
#pragma unroll
      for (int j = 0; j < 8; ++j) y[j] += p.conv_w[0 * DSB + c0 + j] * (c2[j] * x2[j]);
    }
    float ss = 0.f;
#pragma unroll
    for (int j = 0; j < 8; ++j) { y[j] *= bg[j]; ss += y[j] * y[j]; }
    ss = wave_sum(ss);
    const float inv = rsqrtf(ss * (1.f / DSB) + EPS);
#pragma unroll
    for (int j = 0; j < 8; ++j) y[j] = y[j] * inv * p.conv_out_g[c0 + j];
    *(uint4*)(mixed + (size_t)t * D + DSB + c0) = pack8(y);
  }
}

DI void attn_phase(const u16* __restrict__ proj, float* __restrict__ sb) {
  const int lane = threadIdx.x & 63, gw = blockIdx.x * 4 + (threadIdx.x >> 6), nw = gridDim.x * 4;
  for (int item = gw; item < 4 * 8 * 64; item += nw) {
    const int qb = 63 - (item >> 5), bh = item & 31, b = bh >> 3, h = bh & 7;
    const int t0 = qb * 64, tq = t0 + lane;
    const u16* qrow = proj + (size_t)(b * SEQ + tq) * DIN + h * 64;
    float q[64], acc[64];
#pragma unroll
    for (int c = 0; c < 8; ++c) { float f[8]; unpack8(((const uint4*)qrow)[c], f);
#pragma unroll
      for (int j = 0; j < 8; ++j) { q[8 * c + j] = f[j] * 0.125f; acc[8 * c + j] = 0.f; } }
    float P = 1.f;
    for (int s = t0 + 62; s >= 0; --s) {
      const u16* krow = proj + (size_t)(b * SEQ + s) * DIN + 512 + h * 64;
      float z = 0.f;
#pragma unroll
      for (int c = 0; c < 8; ++c) { float f[8]; unpack8(((const uint4*)krow)[c], f);
#pragma unroll
        for (int j = 0; j < 8; ++j) z += q[8 * c + j] * f[j]; }
      const float e = __expf(fminf(z, 80.f));
      const float r = __builtin_amdgcn_rcpf(1.f + e);
      const bool on = s < tq;
      const float a = on ? e * r * P : 0.f;
      P = on ? P * r : P;
      const u16* vrow = krow + 512;
#pragma unroll
      for (int c = 0; c < 8; ++c) { float f[8]; unpack8(((const uint4*)vrow)[c], f);
#pragma unroll
        for (int j = 0; j < 8; ++j) acc[8 * c + j] += a * f[j]; }
      if (s < t0 && __all(P == 0.f)) break;
    }
    float* orow = sb + (size_t)(b * SEQ + tq) * DSB + h * 64;
#pragma unroll
    for (int c = 0; c < 16; ++c) ((float4*)orow)[c] = make_float4(acc[4 * c], acc[4 * c + 1], acc[4 * c + 2], acc[4 * c + 3]);
  }
}

DI void sbnorm_phase(const Params& p, const float* __restrict__ sb, u16* __restrict__ mixed) {
  const int lane = threadIdx.x & 63, gw = blockIdx.x * 4 + (threadIdx.x >> 6), nw = gridDim.x * 4;
  for (int t = gw; t < T; t += nw) {
    const float4 a = ((const float4*)(sb + (size_t)t * DSB))[2 * lane], b = ((const float4*)(sb + (size_t)t * DSB))[2 * lane + 1];
    float f[8] = {a.x, a.y, a.z, a.w, b.x, b.y, b.z, b.w};
    float ss = 0.f;
#pragma unroll
    for (int j = 0; j < 8; ++j) ss += f[j] * f[j];
    ss = wave_sum(ss);
    const float inv = rsqrtf(ss * (1.f / DSB) + EPS);
#pragma unroll
    for (int j = 0; j < 8; ++j) f[j] = f[j] * inv * p.sb_out_g[8 * lane + j];
    *(uint4*)(mixed + (size_t)t * D + 8 * lane) = pack8(f);
  }
}

DI void wave_top16_2(float a0, float a1, int lane, float& tv, int& ti) {
  tv = -INFINITY; ti = 0;
  for (int k = 0; k < 16; ++k) {
    const float m = wave_max(fmaxf(a0, a1));
    const unsigned long long b0 = __ballot(a0 == m), b1 = __ballot(a1 == m);
    int idx;
    if (b0) { const int wl = __ffsll((long long)b0) - 1; idx = wl; if (lane == wl) a0 = -INFINITY; }
    else { const int wl = __ffsll((long long)b1) - 1; idx = 64 + wl; if (lane == wl) a1 = -INFINITY; }
    if (lane == k) { tv = m; ti = idx; }
  }
}
DI void topk_phase(const Params& p, const u16* __restrict__ qp, int* __restrict__ idx_out, float* __restrict__ gate_out) {
  const int lane = threadIdx.x & 63, gw = blockIdx.x * 4 + (threadIdx.x >> 6), nw = gridDim.x * 4;
  for (int item = gw; item < T * 8; item += nw) {
    const int t = item >> 3, h = item & 7;
    const u16* q = qp + (size_t)t * 2048 + h * 256;
    float tv[2]; int ti[2];
#pragma unroll
    for (int half = 0; half < 2; ++half) {
      const float* sk = p.sub_keys + (size_t)half * 128 * 128;
      float s0 = 0.f, s1 = 0.f;
#pragma unroll 2
      for (int c = 0; c < 16; ++c) {
        float f[8]; unpack8(((const uint4*)(q + half * 128))[c], f);
        const float4 k0a = ((const float4*)(sk + (size_t)lane * 128))[2 * c], k0b = ((const float4*)(sk + (size_t)lane * 128))[2 * c + 1];
        const float4 k1a = ((const float4*)(sk + (size_t)(lane + 64) * 128))[2 * c], k1b = ((const float4*)(sk + (size_t)(lane + 64) * 128))[2 * c + 1];
        s0 += f[0] * k0a.x + f[1] * k0a.y + f[2] * k0a.z + f[3] * k0a.w + f[4] * k0b.x + f[5] * k0b.y + f[6] * k0b.z + f[7] * k0b.w;
        s1 += f[0] * k1a.x + f[1] * k1a.y + f[2] * k1a.z + f[3] * k1a.w + f[4] * k1b.x + f[5] * k1b.y + f[6] * k1b.z + f[7] * k1b.w;
      }
      wave_top16_2(s0, s1, lane, tv[half], ti[half]);
    }
    float cs[4];
#pragma unroll
    for (int jj = 0; jj < 4; ++jj) cs[jj] = __shfl(tv[0], (lane >> 4) + 4 * jj) + __shfl(tv[1], lane & 15);
    float sv = -INFINITY; int sc = 0;
    for (int k = 0; k < 16; ++k) {
      const float m = wave_max(fmaxf(fmaxf(cs[0], cs[1]), fmaxf(cs[2], cs[3])));
      int cidx = 0; bool found = false;
#pragma unroll
      for (int jj = 0; jj < 4; ++jj) {
        const unsigned long long bb = __ballot(cs[jj] == m);
        if (!found && bb) { const int wl = __ffsll((long long)bb) - 1; cidx = wl + 64 * jj; if (lane == wl) cs[jj] = -INFINITY; found = true; }
      }
      if (lane == k) { sv = m; sc = cidx; }
    }
    const int e1 = __shfl(ti[0], (sc >> 4) & 15), e2 = __shfl(ti[1], sc & 15);
    const float mx = __shfl(sv, 0);
    const float e = lane < 16 ? __expf(sv - mx) : 0.f;
    const float sum = wave_sum(e);
    if (lane < 16) { idx_out[(size_t)t * 128 + h * 16 + lane] = e1 * 128 + e2; gate_out[(size_t)t * 128 + h * 16 + lane] = e / sum; }
  }
}

DI void peer_phase(const Params& p, const u16* __restrict__ h2, const int* __restrict__ idx, const float* __restrict__ gate,
                   const u16* __restrict__ U, const u16* __restrict__ V, float* sm) {
  const int tid = threadIdx.x, lane = tid & 63, wave = tid >> 6;
  for (int t = blockIdx.x; t < T; t += gridDim.x) {
    float hx[16], acc[16];
    { float f[8]; unpack8(*(const uint4*)(h2 + (size_t)t * D + 8 * lane), f);
#pragma unroll
      for (int j = 0; j < 8; ++j) hx[j] = f[j];
      unpack8(*(const uint4*)(h2 + (size_t)t * D + 512 + 8 * lane), f);
#pragma unroll
      for (int j = 0; j < 8; ++j) hx[8 + j] = f[j]; }
#pragma unroll
    for (int j = 0; j < 16; ++j) acc[j] = 0.f;
    for (int pk = wave; pk < 128; pk += 4) {
      const int e = idx[(size_t)t * 128 + pk]; const float g = gate[(size_t)t * 128 + pk];
      const u16* ur = U + (size_t)e * D; const u16* vr = V + (size_t)e * D;
      float ua[8], ub[8], va[8], vb[8];
      unpack8(*(const uint4*)(ur + 8 * lane), ua); unpack8(*(const uint4*)(ur + 512 + 8 * lane), ub);
      unpack8(*(const uint4*)(vr + 8 * lane), va); unpack8(*(const uint4*)(vr + 512 + 8 * lane), vb);
      float d = 0.f;
#pragma unroll
      for (int j = 0; j < 8; ++j) d += ua[j] * hx[j] + ub[j] * hx[8 + j];
      d = wave_sum(d);
      const float w = g * 0.5f * d * (1.f + erff(d * 0.70710678118654752f));
#pragma unroll
      for (int j = 0; j < 8; ++j) { acc[j] += w * va[j]; acc[8 + j] += w * vb[j]; }
    }
    __syncthreads();
#pragma unroll
    for (int j = 0; j < 8; ++j) { sm[wave * 1024 + 8 * lane + j] = acc[j]; sm[wave * 1024 + 512 + 8 * lane + j] = acc[8 + j]; }
    __syncthreads();
    {
      const float4 a = ((const float4*)sm)[tid], b = ((const float4*)sm)[256 + tid], c = ((const float4*)sm)[512 + tid], d4 = ((const float4*)sm)[768 + tid];
      float4* o = (float4*)(p.out + (size_t)t * D) + tid;
      float4 r = *o;
      r.x += a.x + b.x + c.x + d4.x; r.y += a.y + b.y + c.y + d4.y; r.z += a.z + b.z + c.z + d4.z; r.w += a.w + b.w + c.w + d4.w;
      *o = r;
    }
  }
}

constexpr int NPHASE = 10;
__global__ void __launch_bounds__(NTHREADS) fwd_kernel(Params p) {
  __shared__ __attribute__((aligned(16))) unsigned char smem[2 * 128 * GP * 2];
  cg::grid_group grid = cg::this_grid();
  unsigned char* ws = p.ws;
  u16* wt_in = (u16*)(ws + WS_WTIN); u16* wt_out = (u16*)(ws + WS_WTOUT); u16* wt_q = (u16*)(ws + WS_WTQ);
  u16* act = (u16*)(ws + WS_ACT); u16* proj = (u16*)(ws + WS_PROJ); float* sb = (float*)(ws + WS_SB);
  int* idx = (int*)(ws + WS_IDX); float* gate = (float*)(ws + WS_GATE); u16* U16 = (u16*)(ws + WS_U16); u16* V16 = (u16*)(ws + WS_V16);
  const int lo = p.ph_lo, hi = p.ph_hi;
#define IN(k) (lo <= (k) && (k) < hi)
#define SEAM(k) do { if (IN(k) && IN((k) + 1)) grid.sync(); } while (0)
  if (IN(0)) {
    transpose_convert(p.w_in, wt_in, D, DIN, (float*)smem);
    transpose_convert(p.w_out, wt_out, D, D, (float*)smem);
    transpose_convert(p.w_q, wt_q, D, 2048, (float*)smem);
    convert_bf16(p.peer_u, U16, (size_t)NEXP * D);
    convert_bf16(p.peer_v, V16, (size_t)NEXP * D);
    rmsnorm1024(p.x, p.norm1_g, act);
  }
  SEAM(0);
  if (IN(1)) gemm_phase<0>(act, wt_in, T, DIN, D, proj, DIN, nullptr, nullptr, (u16*)smem);
  SEAM(1);
  if (IN(2)) postproj_phase(p, proj, act);
  SEAM(2);
  if (IN(3)) attn_phase(proj, sb);
  SEAM(3);
  if (IN(4)) sbnorm_phase(p, sb, act);
  SEAM(4);
  if (IN(5)) gemm_phase<1>(act, wt_out, T, D, D, nullptr, D, p.x, p.out, (u16*)smem);
  SEAM(5);
  if (IN(6)) rmsnorm1024(p.out, p.norm2_g, act);
  SEAM(6);
  if (IN(7)) gemm_phase<0>(act, wt_q, T, 2048, D, proj, 2048, nullptr, nullptr, (u16*)smem);
  SEAM(7);
  if (IN(8)) topk_phase(p, proj, idx, gate);
  SEAM(8);
  if (IN(9)) peer_phase(p, act, idx, gate, U16, V16, (float*)smem);
}

extern "C" void kernel_launch(void* const* d_in, const int* in_sizes, int n_in, void* d_out, int out_size, void* d_ws, size_t ws_size,
                              hipStream_t stream) {
  static int grid_blocks = 0;
  if (!grid_blocks) {
    int dev = 0, cus = 0, per_cu = 0;
    hipGetDevice(&dev);
    hipDeviceGetAttribute(&cus, hipDeviceAttributeMultiprocessorCount, dev);
    hipOccupancyMaxActiveBlocksPerMultiprocessor(&per_cu, fwd_kernel, NTHREADS, 0);
    if (per_cu < 1) per_cu = 1;
    if (per_cu > 2) per_cu = 2;
    grid_blocks = cus * per_cu;
  }
  Params p{};
  p.x = (const float*)d_in[0]; p.norm1_g = (const float*)d_in[1]; p.w_in = (const float*)d_in[2]; p.q_norm_g = (const float*)d_in[3];
  p.k_norm_g = (const float*)d_in[4]; p.conv_w = (const float*)d_in[5]; p.sb_out_g = (const float*)d_in[6]; p.conv_out_g = (const float*)d_in[7];
  p.w_out = (const float*)d_in[8]; p.norm2_g = (const float*)d_in[9]; p.w_q = (const float*)d_in[10]; p.sub_keys = (const float*)d_in[11];
  p.peer_u = (const float*)d_in[12]; p.peer_v = (const float*)d_in[13];
  p.out = (float*)d_out; p.ws = (unsigned char*)d_ws;
  p.ph_lo = 0; p.ph_hi = NPHASE;
  void* args[] = {&p};
  hipError_t e = hipLaunchCooperativeKernel((void*)fwd_kernel, dim3(grid_blocks), dim3(NTHREADS), args, 0, stream);
  if (e != hipSuccess) fprintf(stderr, "cooperative launch failed: %s (grid %d)\n", hipGetErrorString(e), grid_blocks);
}
```

```cpp
#include <hip/hip_runtime.h>
#include <hip/hip_cooperative_groups.h>
#include <cstdio>
#include <cstdint>
namespace cg = cooperative_groups;

typedef unsigned short u16;
#define DI __device__ __forceinline__
#define LAS __attribute__((address_space(3)))

constexpr int T = 16384, D = 1024, SEQ = 4096;
constexpr int DIN = 3072, DSB = 512;
constexpr int NEXP = 16384;
constexpr float EPS = 1e-6f;
constexpr int NWAVES = 8, NTHREADS = NWAVES * 64;

namespace pg8 {
#define PG8_LAS __attribute__((address_space(3)))
typedef unsigned short bf16_t;
typedef short bf16x8 __attribute__((ext_vector_type(8)));
typedef float f32x4 __attribute__((ext_vector_type(4)));
typedef unsigned u32x4 __attribute__((ext_vector_type(4)));
constexpr int BM = 256, BK = 64, HALF = 128, HTB = HALF * BK * 2  , STAGE_BYTES = 8 * HTB, NXCD = 8, WGM = 8;

__host__ __device__ __forceinline__ int lds_byte(int r, int c) { const int st = (r >> 4) * 2 + (c >> 5), rr = r & 15, cc = c & 31, ob = rr * 64 + cc * 2; return st * 1024 + (ob ^ (((ob >> 9) & 1) << 5)); }
__host__ __device__ __forceinline__ void stage_rc(int b, int& R, int& C) { const int st = b / 1024, sb = b % 1024, swz = sb ^ (((sb >> 9) & 1) << 5); R = (st >> 1) * 16 + swz / 64; C = (st & 1) * 32 + (swz % 64) / 2; }
__host__ __device__ __forceinline__ int perm32(int rho) { const int n = rho >> 4, i = rho & 15; return 8 * (i >> 2) + 4 * n + (i & 3); }

struct Unit { int pm, pn; };
struct Gemm { const bf16_t* A; const bf16_t* Bt; int M, N, K; };
struct StaticOrder {
    int nM, nN, nwg, G, c;
    __host__ __device__ void init(int M, int N, int G_, int c_) { nM = M / BM; nN = N / BM; nwg = nM * nN; G = G_; c = c_; }
    __host__ __device__ bool next(int i, Unit& u) const {
        const long L = (long)i * G + c; if (L >= nwg) return false;
        int wgid = (int)L; { const int q = nwg / NXCD, r = nwg % NXCD, xcd = wgid % NXCD, off = wgid / NXCD; wgid = (xcd < r ? xcd * (q + 1) : r * (q + 1) + (xcd - r) * q) + off; }
        const int nig = WGM * nN, gid = wgid / nig, fm = gid * WGM, gsz = (nM - fm) < WGM ? (nM - fm) : WGM;
        u.pm = fm + ((wgid % nig) % gsz); u.pn = (wgid % nig) / gsz; return true;
    }
    __device__ __forceinline__ void a_ready(const Unit&) const {}
    __device__ __forceinline__ void done(const Unit&) const {}
};
__device__ __forceinline__ unsigned cvt_pk_bf16(float lo, float hi) { unsigned r; asm volatile("v_cvt_pk_bf16_f32 %0, %1, %2" : "=v"(r) : "v"(lo), "v"(hi)); return r; }

struct EpiBf16S {
    static constexpr bool PERM = true, AFTER_DRAIN = false;
    bf16_t* O; int ldc; const float* rowss;
    __device__ __forceinline__ void operator()(const f32x4 (&acc)[2][2][4][2], const Unit& u, int wr, int wc, int fr, int fq) const {
        const int row0 = u.pm * BM + wr * 64 + fr, col0 = u.pn * BM + wc * 32 + 8 * fq;
#pragma unroll
        for (int ai = 0; ai < 2; ++ai)
#pragma unroll
            for (int m = 0; m < 4; ++m) { const int row = row0 + ai * HALF + m * 16; bf16_t* rowp = O + (size_t)row * ldc + col0;
                const float sc = rowss ? rsqrtf(rowss[row] * (1.f / 1024.f) + 1e-6f) : 1.f;
#pragma unroll
                for (int bj = 0; bj < 2; ++bj) { const f32x4 v0 = acc[ai][bj][m][0] * sc, v1 = acc[ai][bj][m][1] * sc;
                    u32x4 w; w.x = cvt_pk_bf16(v0[0], v0[1]); w.y = cvt_pk_bf16(v0[2], v0[3]); w.z = cvt_pk_bf16(v1[0], v1[1]); w.w = cvt_pk_bf16(v1[2], v1[3]);
                    *(u32x4*)(rowp + bj * HALF) = w; } }
    }
};
struct EpiResid {
    static constexpr bool PERM = true, AFTER_DRAIN = false;
    const float* resid; float* out32; bf16_t* xb; float* rowss; int ldc;
    __device__ __forceinline__ void operator()(const f32x4 (&acc)[2][2][4][2], const Unit& u, int wr, int wc, int fr, int fq) const {
        const int row0 = u.pm * BM + wr * 64 + fr, col0 = u.pn * BM + wc * 32 + 8 * fq;
#pragma unroll
        for (int ai = 0; ai < 2; ++ai)
#pragma unroll
            for (int m = 0; m < 4; ++m) { const int row = row0 + ai * HALF + m * 16; const size_t off = (size_t)row * ldc + col0; float ss = 0.f;
#pragma unroll
                for (int bj = 0; bj < 2; ++bj) {
                    const f32x4 r0 = *(const f32x4*)(resid + off + bj * HALF), r1 = *(const f32x4*)(resid + off + bj * HALF + 4);
                    const f32x4 o0 = r0 + acc[ai][bj][m][0], o1 = r1 + acc[ai][bj][m][1];
                    *(f32x4*)(out32 + off + bj * HALF) = o0; *(f32x4*)(out32 + off + bj * HALF + 4) = o1;
                    ss += o0[0] * o0[0] + o0[1] * o0[1] + o0[2] * o0[2] + o0[3] * o0[3] + o1[0] * o1[0] + o1[1] * o1[1] + o1[2] * o1[2] + o1[3] * o1[3];
                    u32x4 w; w.x = cvt_pk_bf16(o0[0], o0[1]); w.y = cvt_pk_bf16(o0[2], o0[3]); w.z = cvt_pk_bf16(o1[0], o1[1]); w.w = cvt_pk_bf16(o1[2], o1[3]);
                    *(u32x4*)(xb + off + bj * HALF) = w; }
                ss += __shfl_xor(ss, 16); ss += __shfl_xor(ss, 32);
                if (fq == 0) unsafeAtomicAdd(rowss + row, ss); }
    }
};
template <class Epi, class Sched, bool STAMP = false>
__device__ __forceinline__ void gemm_phase(PG8_LAS unsigned char* lds, const Gemm g, const Sched& S, const Epi& E, unsigned long long* stamps) {
    const int tid = threadIdx.x, wid = __builtin_amdgcn_readfirstlane(tid >> 6), lane = tid & 63, wr = wid >> 2, wc = wid & 3, fr = lane & 15, fq = lane >> 4;
    const int K = g.K, nt = K / BK;
    int ts_lo = 0, ts_hi = 0, nts = 0; const unsigned long long rt_entry = STAMP ? (unsigned long long)wall_clock64() : 0ull;
#define PG8_STAMP() do { if (STAMP && wid == 0 && nts < 64) { const unsigned long long _c = (unsigned long long)clock64(); \
        ts_lo = (lane == nts) ? (int)(unsigned)_c : ts_lo; ts_hi = (lane == nts) ? (int)(unsigned)(_c >> 32) : ts_hi; ++nts; } } while (0)
    PG8_STAMP();
    unsigned voffA[2], voffB[2];
#pragma unroll
    for (int i = 0; i < 2; ++i) { int R, C; stage_rc(tid * 16 + i * 8192, R, C); const int Rb = Epi::PERM ? ((R & ~31) + perm32(R & 31)) : R;
        voffA[i] = (unsigned)(R * K + C) * 2u; voffB[i] = (unsigned)(Rb * K + C) * 2u; }
    const size_t kstep = (size_t)(BK * 2);
    const size_t hstep = (size_t)HALF * K * 2;
    const size_t tstep = 2 * hstep;
    const unsigned ldsw = (unsigned)wid * 1024u;
    const int aoff = lds_byte(wr * 64 + fr, fq * 8), boff = lds_byte(wc * 32 + fr, fq * 8);
#define PG8_SA(b, h) (((b) * 2 + (h)) * HTB)
#define PG8_SB(b, h) ((4 + (b) * 2 + (h)) * HTB)
#define PG8_STAGE(bufoff, gbase, voff) do { _Pragma("unroll") for (int _i = 0; _i < 2; ++_i) \
        __builtin_amdgcn_global_load_lds((const unsigned*)((const char*)(gbase) + (voff)[_i]), (PG8_LAS unsigned*)(lds + (bufoff) + ldsw + _i * 8192), 16, 0, 0); } while (0)
#define PG8_LDA(dst, b, h) do { _Pragma("unroll") for (int m = 0; m < 4; ++m) _Pragma("unroll") for (int k = 0; k < 2; ++k) dst[m][k] = *(const PG8_LAS bf16x8*)(lds + PG8_SA(b, h) + aoff + m * 2048 + k * 1024); } while (0)
#define PG8_LDB(dst, b, h) do { _Pragma("unroll") for (int n = 0; n < 2; ++n) _Pragma("unroll") for (int k = 0; k < 2; ++k) dst[n][k] = *(const PG8_LAS bf16x8*)(lds + PG8_SB(b, h) + boff + n * 2048 + k * 1024); } while (0)
#define PG8_MMA(ai, bj, At, Bt) do { __builtin_amdgcn_s_setprio(1); _Pragma("unroll") for (int m = 0; m < 4; ++m) _Pragma("unroll") for (int n = 0; n < 2; ++n) _Pragma("unroll") for (int k = 0; k < 2; ++k) \
        acc[ai][bj][m][n] = __builtin_amdgcn_mfma_f32_16x16x32_bf16(Bt[n][k], At[m][k], acc[ai][bj][m][n], 0, 0, 0); __builtin_amdgcn_s_setprio(0); } while (0)
#define PG8_WAIT_V(n) asm volatile("s_waitcnt vmcnt(" #n ")" ::: "memory")
#define PG8_WAIT_L(n) asm volatile("s_waitcnt lgkmcnt(" #n ")" ::: "memory")
#define PG8_BAR __builtin_amdgcn_s_barrier()
#define PG8_SCHED __builtin_amdgcn_sched_barrier(0)
    Unit cur, nxt; int ui = 0;
    if (!S.next(0, cur)) return;
    f32x4 acc[2][2][4][2];
#pragma unroll
    for (int a = 0; a < 2; ++a)
#pragma unroll
        for (int b = 0; b < 2; ++b)
#pragma unroll
            for (int m = 0; m < 4; ++m)
#pragma unroll
                for (int n = 0; n < 2; ++n) acc[a][b][m][n] = (f32x4){0.f, 0.f, 0.f, 0.f};
    bf16x8 At[4][2], B0[2][2], B1[2][2];
    const char* cA = (const char*)g.A + (size_t)cur.pm * tstep; const char* cB = (const char*)g.Bt + (size_t)cur.pn * tstep;
    S.a_ready(cur);
    PG8_STAGE(PG8_SB(0, 0), cB, voffB); PG8_STAGE(PG8_SA(0, 0), cA, voffA); PG8_STAGE(PG8_SB(0, 1), cB + hstep, voffB); PG8_STAGE(PG8_SA(0, 1), cA + hstep, voffA);
    if (wr == 1) PG8_BAR;
    PG8_WAIT_V(4); PG8_BAR;
    PG8_STAGE(PG8_SB(1, 0), cB + kstep, voffB); PG8_STAGE(PG8_SA(1, 0), cA + kstep, voffA); PG8_STAGE(PG8_SB(1, 1), cB + hstep + kstep, voffB);
    PG8_WAIT_V(6); PG8_BAR;
    PG8_STAMP();
    for (;;) {
        const bool has_next = S.next(ui + 1, nxt);
        const char* nA = has_next ? (const char*)g.A + (size_t)nxt.pm * tstep : cA; const char* nB = has_next ? (const char*)g.Bt + (size_t)nxt.pn * tstep : cB;
        for (int t = 0; t < nt; t += 2) {
            const bool last = (t == nt - 2);
            const char* a1 = cA + (size_t)(t + 1) * kstep;
            const char* a2 = last ? nA : cA + (size_t)(t + 2) * kstep; const char* b2 = last ? nB : cB + (size_t)(t + 2) * kstep;
            const char* a3 = a2 + kstep; const char* b3 = b2 + kstep;
            if (last && has_next) S.a_ready(nxt);
            PG8_LDB(B0, 0, 0); PG8_SCHED; PG8_LDA(At, 0, 0); PG8_STAGE(PG8_SA(1, 1), a1 + hstep, voffA);
            PG8_WAIT_L(8); PG8_BAR; PG8_WAIT_L(0); PG8_MMA(0, 0, At, B0); PG8_BAR; PG8_SCHED;
            PG8_LDB(B1, 0, 1); PG8_STAGE(PG8_SB(0, 0), b2, voffB);
            PG8_BAR; PG8_WAIT_L(0); PG8_MMA(0, 1, At, B1); PG8_BAR;
            PG8_LDA(At, 0, 1); PG8_STAGE(PG8_SA(0, 0), a2, voffA);
            PG8_BAR; PG8_WAIT_L(0); PG8_MMA(1, 0, At, B0); PG8_BAR; PG8_SCHED;
            PG8_STAGE(PG8_SB(0, 1), b2 + hstep, voffB);
            PG8_WAIT_V(6); PG8_BAR; PG8_MMA(1, 1, At, B1); PG8_BAR;
            PG8_LDB(B0, 1, 0); PG8_SCHED; PG8_LDA(At, 1, 0); PG8_STAGE(PG8_SA(0, 1), a2 + hstep, voffA);
            PG8_WAIT_L(8); PG8_BAR; PG8_WAIT_L(0); PG8_MMA(0, 0, At, B0); PG8_BAR; PG8_SCHED;
            PG8_LDB(B1, 1, 1); PG8_STAGE(PG8_SB(1, 0), b3, voffB);
            PG8_BAR; PG8_WAIT_L(0); PG8_MMA(0, 1, At, B1); PG8_BAR;
            PG8_LDA(At, 1, 1); PG8_STAGE(PG8_SA(1, 0), a3, voffA);
            PG8_BAR; PG8_WAIT_L(0); PG8_MMA(1, 0, At, B0); PG8_BAR; PG8_SCHED;
            PG8_STAGE(PG8_SB(1, 1), b3 + hstep, voffB);
            PG8_WAIT_V(6); PG8_BAR; PG8_MMA(1, 1, At, B1); PG8_BAR;
        }
        PG8_STAMP();
        if constexpr (!Epi::AFTER_DRAIN) { E(acc, cur, wr, wc, fr, fq); S.done(cur); }
        PG8_STAMP();
        if (!has_next) break;
#pragma unroll
        for (int a = 0; a < 2; ++a)
#pragma unroll
            for (int b = 0; b < 2; ++b)
#pragma unroll
                for (int m = 0; m < 4; ++m)
#pragma unroll
                    for (int n = 0; n < 2; ++n) acc[a][b][m][n] = (f32x4){0.f, 0.f, 0.f, 0.f};
        cur = nxt; cA = nA; cB = nB; ++ui;
    }
    PG8_WAIT_V(0);
    if (wr == 0) PG8_BAR;
    PG8_BAR;
    if constexpr (Epi::AFTER_DRAIN) { E.fused(acc, cur, wr, wc, fr, fq, lds, wid, lane); S.done(cur); }
    PG8_STAMP();
    if (STAMP && wid == 0) { stamps[lane] = lane < nts ? (((unsigned long long)(unsigned)ts_hi << 32) | (unsigned)ts_lo) : 0ull;
        if (lane == 62) stamps[62] = rt_entry; if (lane == 63) stamps[63] = (unsigned long long)wall_clock64(); }
#undef PG8_STAMP
#undef PG8_SA
#undef PG8_SB
#undef PG8_STAGE
#undef PG8_LDA
#undef PG8_LDB
#undef PG8_MMA
#undef PG8_WAIT_V
#undef PG8_WAIT_L
#undef PG8_BAR
#undef PG8_SCHED
}
}


constexpr size_t MBy = 1u << 20;
constexpr size_t WS_WTIN = 0, WS_WTOUT = 6 * MBy, WS_WTQ = 8 * MBy, WS_CTL = 12 * MBy, WS_ROWSS = 12 * MBy + 65536, WS_ACT = 13 * MBy, WS_PROJ = 45 * MBy,
                 WS_SB = 141 * MBy, WS_IDX = 173 * MBy, WS_GATE = 181 * MBy, WS_U16 = 189 * MBy, WS_V16 = 221 * MBy;
constexpr int LDS_MISC = pg8::STAGE_BYTES, LDS_BYTES = pg8::STAGE_BYTES + 256;

struct Params {
  const float *x, *norm1_g, *w_in, *q_norm_g, *k_norm_g, *conv_w, *sb_out_g, *conv_out_g, *w_out, *norm2_g, *w_q, *sub_keys, *peer_u, *peer_v;
  float* out; unsigned char* ws; int ph_lo, ph_hi;
};

#define XB_TMO      128
#define XB_XCNT(j)  (256  + 64 * (j))
#define XB_XSUB(j)  (1280 + 64 * (j))
#define XB_XGEN(j)  (2304 + 64 * (j))
#define XB_TOP      3328
#define XB_TOPGEN   3392
#define XCD_BAR_WORDS 3456
#define XB_SPIN_CAP (1u << 18)
DI unsigned xb_ld(unsigned* p) { return __hip_atomic_load(p, __ATOMIC_RELAXED, __HIP_MEMORY_SCOPE_AGENT); }
DI unsigned xb_add(unsigned* p, unsigned v) { return __hip_atomic_fetch_add(p, v, __ATOMIC_RELAXED, __HIP_MEMORY_SCOPE_AGENT); }
DI unsigned xb_xcc_id() { return (unsigned)__builtin_amdgcn_s_getreg((3 << 11) | 20) & 0xFu; }
#define XB_SPIN(cond, bar) do { unsigned _sp = 0; while (cond) { __builtin_amdgcn_s_sleep(1); \
    if ((++_sp & 255u) == 0u) { if (xb_ld(&(bar)[XB_TMO])) break; if (_sp > XB_SPIN_CAP) { atomicAdd(&(bar)[XB_TMO], 1u); break; } } } } while (0)
struct XcdBarrier { unsigned* bar; unsigned x; volatile LAS unsigned* st; };
DI XcdBarrier xcd_barrier_post(unsigned* bar, volatile LAS unsigned* st) {
  XcdBarrier b; b.bar = bar; b.x = xb_xcc_id(); b.st = st;
  if (threadIdx.x == 0) (void)xb_add(&bar[XB_XCNT(b.x)], 1u);
  return b;
}
DI void xcd_barrier_complete(unsigned* bar, unsigned x, unsigned& nloc, unsigned& nx) {
  const unsigned G = gridDim.x * gridDim.y * gridDim.z;
  unsigned sum, cnt, mine, sp = 0u;
  for (;;) {
    sum = 0u; cnt = 0u; mine = 0u;
#pragma unroll
    for (unsigned j = 0; j < 16; ++j) { const unsigned c = xb_ld(&bar[XB_XCNT(j)]); sum += c; cnt += (c > 0u) ? 1u : 0u; mine = (j == x) ? c : mine; }
    if (sum == G) break;
    __builtin_amdgcn_s_sleep(1);
    if ((++sp & 255u) == 0u) { if (xb_ld(&bar[XB_TMO])) break; if (sp > XB_SPIN_CAP) { atomicAdd(&bar[XB_TMO], 1u); break; } }
  }
  nloc = mine > 0u ? mine : 1u; nx = cnt > 0u ? cnt : 1u;
}
DI void xcd_barrier(const XcdBarrier& b) {
  asm volatile("s_waitcnt vmcnt(0)" ::: "memory");
  __syncthreads();
  if (threadIdx.x == 0) {
    unsigned* bar = b.bar;
    __builtin_amdgcn_s_waitcnt(0);
    unsigned nloc = b.st[0], nx = b.st[1];
    if (nloc == 0u) { xcd_barrier_complete(bar, b.x, nloc, nx); b.st[0] = nloc; b.st[1] = nx; }
    const unsigned old = xb_add(&bar[XB_XSUB(b.x)], 1u);
    const unsigned gen = old / nloc;
    if (old + 1u == (gen + 1u) * nloc) {
      __builtin_amdgcn_fence(__ATOMIC_RELEASE, "agent");
      asm volatile("s_waitcnt vmcnt(0)" ::: "memory");
      const unsigned og = xb_add(&bar[XB_TOP], 1u);
      const unsigned tg = og / nx;
      if (og + 1u == (tg + 1u) * nx) xb_add(&bar[XB_TOPGEN], 1u);
      else XB_SPIN(xb_ld(&bar[XB_TOPGEN]) == tg, bar);
      __builtin_amdgcn_fence(__ATOMIC_ACQUIRE, "agent");
      xb_add(&bar[XB_XGEN(b.x)], 1u);
      asm volatile("s_waitcnt vmcnt(0)" ::: "memory");
    } else {
      XB_SPIN(xb_ld(&bar[XB_XGEN(b.x)]) == gen, bar);
      __builtin_amdgcn_fence(__ATOMIC_ACQUIRE, "agent");
      asm volatile("s_waitcnt vmcnt(0)" ::: "memory");
    }
  }
  __syncthreads();
}

DI u16 f2bf(float x) { unsigned u = __float_as_uint(x); u += 0x7fffu + ((u >> 16) & 1u); return (u16)(u >> 16); }
DI float bflo(unsigned w) { return __uint_as_float(w << 16); }
DI float bfhi(unsigned w) { return __uint_as_float(w & 0xffff0000u); }
DI unsigned pack2(float a, float b) { return (unsigned)f2bf(a) | ((unsigned)f2bf(b) << 16); }
DI float wave_sum(float v) {
#pragma unroll
  for (int o = 32; o >= 1; o >>= 1) v += __shfl_xor(v, o);
  return v;
}
DI float wave_max(float v) {
#pragma unroll
  for (int o = 32; o >= 1; o >>= 1) v = fmaxf(v, __shfl_xor(v, o));
  return v;
}
DI void unpack8(const uint4 w, float* f) {
  f[0] = bflo(w.x); f[1] = bfhi(w.x); f[2] = bflo(w.y); f[3] = bfhi(w.y); f[4] = bflo(w.z); f[5] = bfhi(w.z); f[6] = bflo(w.w); f[7] = bfhi(w.w);
}
DI uint4 pack8(const float* f) { uint4 o; o.x = pack2(f[0], f[1]); o.y = pack2(f[2], f[3]); o.z = pack2(f[4], f[5]); o.w = pack2(f[6], f[7]); return o; }

DI void transpose_convert(const float* __restrict__ W, u16* __restrict__ Wt, int K, int N, const float* __restrict__ rg, float* sm) {
  const int tid = threadIdx.x, tn_cnt = N / 64, ntile = (K / 64) * tn_cnt;
  for (int tile = blockIdx.x; tile < ntile; tile += gridDim.x) {
    const int tk = tile / tn_cnt, tn = tile % tn_cnt;
    __syncthreads();
#pragma unroll
    for (int r = 0; r < 8; ++r) { const int row = r * 8 + (tid >> 6), col = tid & 63;
      const float g = rg ? rg[tk * 64 + row] : 1.f;
      sm[row * 65 + col] = W[(size_t)(tk * 64 + row) * N + tn * 64 + col] * g; }
    __syncthreads();
#pragma unroll
    for (int r = 0; r < 8; ++r) { const int nrow = r * 8 + (tid >> 6), kcol = tid & 63; Wt[(size_t)(tn * 64 + nrow) * K + tk * 64 + kcol] = f2bf(sm[kcol * 65 + nrow]); }
  }
}
DI void convert_bf16(const float* __restrict__ src, u16* __restrict__ dst, size_t n) {
  const size_t n8 = n / 8;
  for (size_t i = (size_t)blockIdx.x * NTHREADS + threadIdx.x; i < n8; i += (size_t)gridDim.x * NTHREADS) {
    const float4 a = ((const float4*)src)[2 * i], b = ((const float4*)src)[2 * i + 1];
    uint4 o; o.x = pack2(a.x, a.y); o.y = pack2(a.z, a.w); o.z = pack2(b.x, b.y); o.w = pack2(b.z, b.w);
    ((uint4*)dst)[i] = o;
  }
}
DI void rmsnorm1024(const float* __restrict__ src, const float* __restrict__ g, u16* __restrict__ dst) {
  const int lane = threadIdx.x & 63, gw = blockIdx.x * NWAVES + (threadIdx.x >> 6), nw = gridDim.x * NWAVES;
  for (int row = gw; row < T; row += nw) {
    const float4* xr = (const float4*)(src + (size_t)row * D);
    float4 v[4]; float ss = 0.f;
#pragma unroll
    for (int j = 0; j < 4; ++j) { v[j] = xr[lane + 64 * j]; ss += v[j].x * v[j].x + v[j].y * v[j].y + v[j].z * v[j].z + v[j].w * v[j].w; }
    ss = wave_sum(ss);
    const float inv = rsqrtf(ss * (1.f / D) + EPS);
#pragma unroll
    for (int j = 0; j < 4; ++j) {
      const float4 gg = ((const float4*)g)[lane + 64 * j];
      uint2 o; o.x = pack2(v[j].x * inv * gg.x, v[j].y * inv * gg.y); o.y = pack2(v[j].z * inv * gg.z, v[j].w * inv * gg.w);
      *(uint2*)(dst + (size_t)row * D + 4 * (lane + 64 * j)) = o;
    }
  }
}

DI void postproj_phase(const Params& p, u16* __restrict__ proj, u16* __restrict__ mixed) {
  const int lane = threadIdx.x & 63, gw = blockIdx.x * NWAVES + (threadIdx.x >> 6), nw = gridDim.x * NWAVES;
  for (int t = gw; t < T; t += nw) {
    u16* row = proj + (size_t)t * DIN;
#pragma unroll
    for (int which = 0; which < 2; ++which) {
      float f[8]; unpack8(*(const uint4*)(row + which * 512 + 8 * lane), f);
      float ss = 0.f;
#pragma unroll
      for (int j = 0; j < 8; ++j) ss += f[j] * f[j];
      ss += __shfl_xor(ss, 1); ss += __shfl_xor(ss, 2); ss += __shfl_xor(ss, 4);
      const float inv = rsqrtf(ss * (1.f / 64.f) + EPS);
      const float* g = (which == 0 ? p.q_norm_g : p.k_norm_g) + 8 * (lane & 7);
#pragma unroll
      for (int j = 0; j < 8; ++j) f[j] = f[j] * inv * g[j];
      *(uint4*)(row + which * 512 + 8 * lane) = pack8(f);
    }
    const int c0 = 8 * lane, tpos = t & (SEQ - 1);
    float xc[8], bg[8], cg[8], y[8];
    unpack8(*(const uint4*)(row + 1536 + c0), xc); unpack8(*(const uint4*)(row + 2048 + c0), bg); unpack8(*(const uint4*)(row + 2560 + c0), cg);
#pragma unroll
    for (int j = 0; j < 8; ++j) y[j] = p.conv_w[2 * DSB + c0 + j] * (cg[j] * xc[j]);
    if (tpos >= 1) {
      float x1[8], c1[8]; unpack8(*(const uint4*)(row - DIN + 1536 + c0), x1); unpack8(*(const uint4*)(row - DIN + 2560 + c0), c1);
#pragma unroll
      for (int j = 0; j < 8; ++j) y[j] += p.conv_w[1 * DSB + c0 + j] * (c1[j] * x1[j]);
    }
    if (tpos >= 2) {
      float x2[8], c2[8]; unpack8(*(const uint4*)(row - 2 * DIN + 1536 + c0), x2); unpack8(*(const uint4*)(row - 2 * DIN + 2560 + c0), c2);
#pragma unroll
      for (int j = 0; j < 8; ++j) y[j] += p.conv_w[0 * DSB + c0 + j] * (c2[j] * x2[j]);
    }
    float ss = 0.f;
#pragma unroll
    for (int j = 0; j < 8; ++j) { y[j] *= bg[j]; ss += y[j] * y[j]; }
    ss = wave_sum(ss);
    const float inv = rsqrtf(ss * (1.f / DSB) + EPS);
#pragma unroll
    for (int j = 0; j < 8; ++j) y[j] = y[j] * inv * p.conv_out_g[c0 + j];
    *(uint4*)(mixed + (size_t)t * D + DSB + c0) = pack8(y);
  }
}

DI void attn_phase(const u16* __restrict__ proj, float* __restrict__ sb) {
  const int lane = threadIdx.x & 63, gw = blockIdx.x * NWAVES + (threadIdx.x >> 6), nw = gridDim.x * NWAVES;
  for (int item = gw; item < 4 * 8 * 64; item += nw) {
    const int qb = 63 - (item >> 5), bh = item & 31, b = bh >> 3, h = bh & 7;
    const int t0 = qb * 64, tq = t0 + lane;
    const u16* qrow = proj + (size_t)(b * SEQ + tq) * DIN + h * 64;
    float q[64], acc[64];
#pragma unroll
    for (int c = 0; c < 8; ++c) { float f[8]; unpack8(((const uint4*)qrow)[c], f);
#pragma unroll
      for (int j = 0; j < 8; ++j) { q[8 * c + j] = f[j] * 0.125f; acc[8 * c + j] = 0.f; } }
    float P = 1.f;
    for (int s = t0 + 62; s >= 0; --s) {
      const u16* krow = proj + (size_t)(b * SEQ + s) * DIN + 512 + h * 64;
      float z = 0.f;
#pragma unroll
      for (int c = 0; c < 8; ++c) { float f[8]; unpack8(((const uint4*)krow)[c], f);
#pragma unroll
        for (int j = 0; j < 8; ++j) z += q[8 * c + j] * f[j]; }
      const float e = __expf(fminf(z, 80.f));
      const float r = __builtin_amdgcn_rcpf(1.f + e);
      const bool on = s < tq;
      const float a = on ? e * r * P : 0.f;
      P = on ? P * r : P;
      const u16* vrow = krow + 512;
#pragma unroll
      for (int c = 0; c < 8; ++c) { float f[8]; unpack8(((const uint4*)vrow)[c], f);
#pragma unroll
        for (int j = 0; j < 8; ++j) acc[8 * c + j] += a * f[j]; }
      if (s < t0 && __all(P == 0.f)) break;
    }
    float* orow = sb + (size_t)(b * SEQ + tq) * DSB + h * 64;
#pragma unroll
    for (int c = 0; c < 16; ++c) ((float4*)orow)[c] = make_float4(acc[4 * c], acc[4 * c + 1], acc[4 * c + 2], acc[4 * c + 3]);
  }
}

DI void sbnorm_phase(const Params& p, const float* __restrict__ sb, u16* __restrict__ mixed) {
  const int lane = threadIdx.x & 63, gw = blockIdx.x * NWAVES + (threadIdx.x >> 6), nw = gridDim.x * NWAVES;
  for (int t = gw; t < T; t += nw) {
    const float4 a = ((const float4*)(sb + (size_t)t * DSB))[2 * lane], b = ((const float4*)(sb + (size_t)t * DSB))[2 * lane + 1];
    float f[8] = {a.x, a.y, a.z, a.w, b.x, b.y, b.z, b.w};
    float ss = 0.f;
#pragma unroll
    for (int j = 0; j < 8; ++j) ss += f[j] * f[j];
    ss = wave_sum(ss);
    const float inv = rsqrtf(ss * (1.f / DSB) + EPS);
#pragma unroll
    for (int j = 0; j < 8; ++j) f[j] = f[j] * inv * p.sb_out_g[8 * lane + j];
    *(uint4*)(mixed + (size_t)t * D + 8 * lane) = pack8(f);
  }
}

DI void wave_top16_2(float a0, float a1, int lane, float& tv, int& ti) {
  tv = -INFINITY; ti = 0;
  for (int k = 0; k < 16; ++k) {
    const float m = wave_max(fmaxf(a0, a1));
    const unsigned long long b0 = __ballot(a0 == m), b1 = __ballot(a1 == m);
    int idx;
    if (b0) { const int wl = __ffsll((long long)b0) - 1; idx = wl; if (lane == wl) a0 = -INFINITY; }
    else { const int wl = __ffsll((long long)b1) - 1; idx = 64 + wl; if (lane == wl) a1 = -INFINITY; }
    if (lane == k) { tv = m; ti = idx; }
  }
}
DI void topk_phase(const Params& p, const u16* __restrict__ qp, int* __restrict__ idx_out, float* __restrict__ gate_out) {
  const int lane = threadIdx.x & 63, gw = blockIdx.x * NWAVES + (threadIdx.x >> 6), nw = gridDim.x * NWAVES;
  for (int item = gw; item < T * 8; item += nw) {
    const int t = item >> 3, h = item & 7;
    const u16* q = qp + (size_t)t * 2048 + h * 256;
    float tv[2]; int ti[2];
#pragma unroll
    for (int half = 0; half < 2; ++half) {
      const float* sk = p.sub_keys + (size_t)half * 128 * 128;
      float s0 = 0.f, s1 = 0.f;
#pragma unroll 2
      for (int c = 0; c < 16; ++c) {
        float f[8]; unpack8(((const uint4*)(q + half * 128))[c], f);
        const float4 k0a = ((const float4*)(sk + (size_t)lane * 128))[2 * c], k0b = ((const float4*)(sk + (size_t)lane * 128))[2 * c + 1];
        const float4 k1a = ((const float4*)(sk + (size_t)(lane + 64) * 128))[2 * c], k1b = ((const float4*)(sk + (size_t)(lane + 64) * 128))[2 * c + 1];
        s0 += f[0] * k0a.x + f[1] * k0a.y + f[2] * k0a.z + f[3] * k0a.w + f[4] * k0b.x + f[5] * k0b.y + f[6] * k0b.z + f[7] * k0b.w;
        s1 += f[0] * k1a.x + f[1] * k1a.y + f[2] * k1a.z + f[3] * k1a.w + f[4] * k1b.x + f[5] * k1b.y + f[6] * k1b.z + f[7] * k1b.w;
      }
      wave_top16_2(s0, s1, lane, tv[half], ti[half]);
    }
    float cs[4];
#pragma unroll
    for (int jj = 0; jj < 4; ++jj) cs[jj] = __shfl(tv[0], (lane >> 4) + 4 * jj) + __shfl(tv[1], lane & 15);
    float sv = -INFINITY; int sc = 0;
    for (int k = 0; k < 16; ++k) {
      const float m = wave_max(fmaxf(fmaxf(cs[0], cs[1]), fmaxf(cs[2], cs[3])));
      int cidx = 0; bool found = false;
#pragma unroll
      for (int jj = 0; jj < 4; ++jj) {
        const unsigned long long bb = __ballot(cs[jj] == m);
        if (!found && bb) { const int wl = __ffsll((long long)bb) - 1; cidx = wl + 64 * jj; if (lane == wl) cs[jj] = -INFINITY; found = true; }
      }
      if (lane == k) { sv = m; sc = cidx; }
    }
    const int e1 = __shfl(ti[0], (sc >> 4) & 15), e2 = __shfl(ti[1], sc & 15);
    const float mx = __shfl(sv, 0);
    const float e = lane < 16 ? __expf(sv - mx) : 0.f;
    const float sum = wave_sum(e);
    if (lane < 16) { idx_out[(size_t)t * 128 + h * 16 + lane] = e1 * 128 + e2; gate_out[(size_t)t * 128 + h * 16 + lane] = e / sum; }
  }
}

DI void peer_phase(const Params& p, const u16* __restrict__ xb, const float* __restrict__ rowss, const int* __restrict__ idx, const float* __restrict__ gate,
                   const u16* __restrict__ U, const u16* __restrict__ V, float* sm) {
  const int tid = threadIdx.x, lane = tid & 63, wave = tid >> 6;
  for (int t = blockIdx.x; t < T; t += gridDim.x) {
    const float inv = rsqrtf(rowss[t] * (1.f / D) + EPS);
    float hx[16], acc[16];
    { float f[8]; unpack8(*(const uint4*)(xb + (size_t)t * D + 8 * lane), f);
#pragma unroll
      for (int j = 0; j < 8; ++j) hx[j] = f[j] * inv * p.norm2_g[8 * lane + j];
      unpack8(*(const uint4*)(xb + (size_t)t * D + 512 + 8 * lane), f);
#pragma unroll
      for (int j = 0; j < 8; ++j) hx[8 + j] = f[j] * inv * p.norm2_g[512 + 8 * lane + j]; }
#pragma unroll
    for (int j = 0; j < 16; ++j) acc[j] = 0.f;
    for (int pk = wave; pk < 128; pk += NWAVES) {
      const int e = idx[(size_t)t * 128 + pk]; const float g = gate[(size_t)t * 128 + pk];
      const u16* ur = U + (size_t)e * D; const u16* vr = V + (size_t)e * D;
      float ua[8], ub[8], va[8], vb[8];
      unpack8(*(const uint4*)(ur + 8 * lane), ua); unpack8(*(const uint4*)(ur + 512 + 8 * lane), ub);
      unpack8(*(const uint4*)(vr + 8 * lane), va); unpack8(*(const uint4*)(vr + 512 + 8 * lane), vb);
      float d = 0.f;
#pragma unroll
      for (int j = 0; j < 8; ++j) d += ua[j] * hx[j] + ub[j] * hx[8 + j];
      d = wave_sum(d);
      const float w = g * 0.5f * d * (1.f + erff(d * 0.70710678118654752f));
#pragma unroll
      for (int j = 0; j < 8; ++j) { acc[j] += w * va[j]; acc[8 + j] += w * vb[j]; }
    }
    __syncthreads();
#pragma unroll
    for (int j = 0; j < 8; ++j) { sm[wave * 1024 + 8 * lane + j] = acc[j]; sm[wave * 1024 + 512 + 8 * lane + j] = acc[8 + j]; }
    __syncthreads();
    {
      float2 s = make_float2(0.f, 0.f);
#pragma unroll
      for (int w = 0; w < NWAVES; ++w) { const float2 a = ((const float2*)sm)[w * 512 + tid]; s.x += a.x; s.y += a.y; }
      float2* o = (float2*)(p.out + (size_t)t * D) + tid;
      float2 r = *o; r.x += s.x; r.y += s.y; *o = r;
    }
  }
}

constexpr int NPHASE = 9;
__global__ void __launch_bounds__(NTHREADS, 2) fwd_kernel(Params p) {
  extern __shared__ __attribute__((aligned(16))) unsigned char smem[];
  cg::grid_group grid = cg::this_grid();
  unsigned char* ws = p.ws;
  u16* wt_in = (u16*)(ws + WS_WTIN); u16* wt_out = (u16*)(ws + WS_WTOUT); u16* wt_q = (u16*)(ws + WS_WTQ);
  u16* act = (u16*)(ws + WS_ACT); u16* proj = (u16*)(ws + WS_PROJ); float* sb = (float*)(ws + WS_SB);
  int* idx = (int*)(ws + WS_IDX); float* gate = (float*)(ws + WS_GATE); u16* U16 = (u16*)(ws + WS_U16); u16* V16 = (u16*)(ws + WS_V16);
  float* rowss = (float*)(ws + WS_ROWSS);
  volatile LAS unsigned* misc = (volatile LAS unsigned*)(LAS unsigned char*)(smem + LDS_MISC);
  if (threadIdx.x < 4) misc[threadIdx.x] = 0u;
  __syncthreads();
  XcdBarrier bar = xcd_barrier_post((unsigned*)(ws + WS_CTL), misc);
  PG8_LAS unsigned char* lds = (PG8_LAS unsigned char*)smem;
  const int lo = p.ph_lo, hi = p.ph_hi;
#define IN(k) (lo <= (k) && (k) < hi)
#define SEAM(k) do { if (IN(k) && IN((k) + 1)) xcd_barrier(bar); } while (0)
  if (IN(0)) {
    transpose_convert(p.w_in, wt_in, D, DIN, nullptr, (float*)smem);
    transpose_convert(p.w_out, wt_out, D, D, nullptr, (float*)smem);
    transpose_convert(p.w_q, wt_q, D, 2048, p.norm2_g, (float*)smem);
    convert_bf16(p.peer_u, U16, (size_t)NEXP * D);
    convert_bf16(p.peer_v, V16, (size_t)NEXP * D);
    rmsnorm1024(p.x, p.norm1_g, act);
    for (int i = blockIdx.x * NTHREADS + threadIdx.x; i < T; i += gridDim.x * NTHREADS) rowss[i] = 0.f;
  }
  if (IN(0) && IN(1)) grid.sync();
  if (IN(1)) { pg8::Gemm g{act, wt_in, T, DIN, D}; pg8::StaticOrder S; S.init(T, DIN, gridDim.x, blockIdx.x);
    pg8::EpiBf16S E{proj, DIN, nullptr}; pg8::gemm_phase<pg8::EpiBf16S, pg8::StaticOrder>(lds, g, S, E, nullptr); }
  SEAM(1);
  if (IN(2)) postproj_phase(p, proj, act);
  SEAM(2);
  if (IN(3)) attn_phase(proj, sb);
  SEAM(3);
  if (IN(4)) sbnorm_phase(p, sb, act);
  SEAM(4);
  if (IN(5)) { pg8::Gemm g{act, wt_out, T, D, D}; pg8::StaticOrder S; S.init(T, D, gridDim.x, blockIdx.x);
    pg8::EpiResid E{p.x, p.out, proj, rowss, D}; pg8::gemm_phase<pg8::EpiResid, pg8::StaticOrder>(lds, g, S, E, nullptr); }
  SEAM(5);
  u16* xb = proj;
  u16* qp = proj + (size_t)T * D;
  if (IN(6)) { pg8::Gemm g{xb, wt_q, T, 2048, D}; pg8::StaticOrder S; S.init(T, 2048, gridDim.x, blockIdx.x);
    pg8::EpiBf16S E{qp, 2048, rowss}; pg8::gemm_phase<pg8::EpiBf16S, pg8::StaticOrder>(lds, g, S, E, nullptr); }
  SEAM(6);
  if (IN(7)) topk_phase(p, qp, idx, gate);
  SEAM(7);
  if (IN(8)) peer_phase(p, xb, rowss, idx, gate, U16, V16, (float*)smem);
}

extern "C" void kernel_launch(void* const* d_in, const int* in_sizes, int n_in, void* d_out, int out_size, void* d_ws, size_t ws_size,
                              hipStream_t stream) {
  static int grid_blocks = 0;
  if (!grid_blocks) {
    int dev = 0, cus = 0, per_cu = 0;
    (void)hipGetDevice(&dev);
    (void)hipDeviceGetAttribute(&cus, hipDeviceAttributeMultiprocessorCount, dev);
    (void)hipFuncSetAttribute((const void*)fwd_kernel, hipFuncAttributeMaxDynamicSharedMemorySize, LDS_BYTES);
    (void)hipOccupancyMaxActiveBlocksPerMultiprocessor(&per_cu, fwd_kernel, NTHREADS, LDS_BYTES);
    if (per_cu < 1) per_cu = 1;
    if (per_cu > 1) per_cu = 1;
    grid_blocks = cus * per_cu;
  }
  Params p{};
  p.x = (const float*)d_in[0]; p.norm1_g = (const float*)d_in[1]; p.w_in = (const float*)d_in[2]; p.q_norm_g = (const float*)d_in[3];
  p.k_norm_g = (const float*)d_in[4]; p.conv_w = (const float*)d_in[5]; p.sb_out_g = (const float*)d_in[6]; p.conv_out_g = (const float*)d_in[7];
  p.w_out = (const float*)d_in[8]; p.norm2_g = (const float*)d_in[9]; p.w_q = (const float*)d_in[10]; p.sub_keys = (const float*)d_in[11];
  p.peer_u = (const float*)d_in[12]; p.peer_v = (const float*)d_in[13];
  p.out = (float*)d_out; p.ws = (unsigned char*)d_ws;
  p.ph_lo = 0; p.ph_hi = NPHASE;
  (void)hipMemsetAsync((unsigned char*)d_ws + WS_CTL, 0, XCD_BAR_WORDS * 4, stream);
  void* args[] = {&p};
  hipError_t e = hipLaunchCooperativeKernel((void*)fwd_kernel, dim3(grid_blocks), dim3(NTHREADS), args, LDS_BYTES, stream);
  if (e != hipSuccess) fprintf(stderr, "cooperative launch failed: %s (grid %d)\n", hipGetErrorString(e), grid_blocks);
}
```

```cpp
#include <hip/hip_runtime.h>
#include <hip/hip_cooperative_groups.h>
#include <cstdio>
#include <cstdint>
namespace cg = cooperative_groups;

typedef unsigned short u16;
#define DI __device__ __forceinline__
#define LAS __attribute__((address_space(3)))

constexpr int T = 16384, D = 1024, SEQ = 4096;
constexpr int DIN = 3072, DSB = 512;
constexpr int NEXP = 16384;
constexpr float EPS = 1e-6f;
constexpr int NWAVES = 8, NTHREADS = NWAVES * 64;

namespace pg8 {
#define PG8_LAS __attribute__((address_space(3)))
typedef unsigned short bf16_t;
typedef short bf16x8 __attribute__((ext_vector_type(8)));
typedef float f32x4 __attribute__((ext_vector_type(4)));
typedef unsigned u32x4 __attribute__((ext_vector_type(4)));
constexpr int BM = 256, BK = 64, HALF = 128, HTB = HALF * BK * 2  , STAGE_BYTES = 8 * HTB, NXCD = 8, WGM = 8;

__host__ __device__ __forceinline__ int lds_byte(int r, int c) { const int st = (r >> 4) * 2 + (c >> 5), rr = r & 15, cc = c & 31, ob = rr * 64 + cc * 2; return st * 1024 + (ob ^ (((ob >> 9) & 1) << 5)); }
__host__ __device__ __forceinline__ void stage_rc(int b, int& R, int& C) { const int st = b / 1024, sb = b % 1024, swz = sb ^ (((sb >> 9) & 1) << 5); R = (st >> 1) * 16 + swz / 64; C = (st & 1) * 32 + (swz % 64) / 2; }
__host__ __device__ __forceinline__ int perm32(int rho) { const int n = rho >> 4, i = rho & 15; return 8 * (i >> 2) + 4 * n + (i & 3); }

struct Unit { int pm, pn; };
struct Gemm { const bf16_t* A; const bf16_t* Bt; int M, N, K; };
struct StaticOrder {
    int nM, nN, nwg, G, c;
    __host__ __device__ void init(int M, int N, int G_, int c_) { nM = M / BM; nN = N / BM; nwg = nM * nN; G = G_; c = c_; }
    __host__ __device__ bool next(int i, Unit& u) const {
        const long L = (long)i * G + c; if (L >= nwg) return false;
        int wgid = (int)L; { const int q = nwg / NXCD, r = nwg % NXCD, xcd = wgid % NXCD, off = wgid / NXCD; wgid = (xcd < r ? xcd * (q + 1) : r * (q + 1) + (xcd - r) * q) + off; }
        const int nig = WGM * nN, gid = wgid / nig, fm = gid * WGM, gsz = (nM - fm) < WGM ? (nM - fm) : WGM;
        u.pm = fm + ((wgid % nig) % gsz); u.pn = (wgid % nig) / gsz; return true;
    }
    __device__ __forceinline__ void a_ready(const Unit&) const {}
    __device__ __forceinline__ void done(const Unit&) const {}
};
__device__ __forceinline__ unsigned cvt_pk_bf16(float lo, float hi) { unsigned r; asm volatile("v_cvt_pk_bf16_f32 %0, %1, %2" : "=v"(r) : "v"(lo), "v"(hi)); return r; }

struct EpiBf16S {
    static constexpr bool PERM = true, AFTER_DRAIN = false;
    bf16_t* O; int ldc; const float* rowss;
    __device__ __forceinline__ void operator()(const f32x4 (&acc)[2][2][4][2], const Unit& u, int wr, int wc, int fr, int fq) const {
        const int row0 = u.pm * BM + wr * 64 + fr, col0 = u.pn * BM + wc * 32 + 8 * fq;
#pragma unroll
        for (int ai = 0; ai < 2; ++ai)
#pragma unroll
            for (int m = 0; m < 4; ++m) { const int row = row0 + ai * HALF + m * 16; bf16_t* rowp = O + (size_t)row * ldc + col0;
                const float sc = rowss ? rsqrtf(rowss[row] * (1.f / 1024.f) + 1e-6f) : 1.f;
#pragma unroll
                for (int bj = 0; bj < 2; ++bj) { const f32x4 v0 = acc[ai][bj][m][0] * sc, v1 = acc[ai][bj][m][1] * sc;
                    u32x4 w; w.x = cvt_pk_bf16(v0[0], v0[1]); w.y = cvt_pk_bf16(v0[2], v0[3]); w.z = cvt_pk_bf16(v1[0], v1[1]); w.w = cvt_pk_bf16(v1[2], v1[3]);
                    *(u32x4*)(rowp + bj * HALF) = w; } }
    }
};
struct EpiResid {
    static constexpr bool PERM = true, AFTER_DRAIN = false;
    const float* resid; float* out32; bf16_t* xb; float* rowss; int ldc;
    __device__ __forceinline__ void operator()(const f32x4 (&acc)[2][2][4][2], const Unit& u, int wr, int wc, int fr, int fq) const {
        const int row0 = u.pm * BM + wr * 64 + fr, col0 = u.pn * BM + wc * 32 + 8 * fq;
#pragma unroll
        for (int ai = 0; ai < 2; ++ai)
#pragma unroll
            for (int m = 0; m < 4; ++m) { const int row = row0 + ai * HALF + m * 16; const size_t off = (size_t)row * ldc + col0; float ss = 0.f;
#pragma unroll
                for (int bj = 0; bj < 2; ++bj) {
                    const f32x4 r0 = *(const f32x4*)(resid + off + bj * HALF), r1 = *(const f32x4*)(resid + off + bj * HALF + 4);
                    const f32x4 o0 = r0 + acc[ai][bj][m][0], o1 = r1 + acc[ai][bj][m][1];
                    *(f32x4*)(out32 + off + bj * HALF) = o0; *(f32x4*)(out32 + off + bj * HALF + 4) = o1;
                    ss += o0[0] * o0[0] + o0[1] * o0[1] + o0[2] * o0[2] + o0[3] * o0[3] + o1[0] * o1[0] + o1[1] * o1[1] + o1[2] * o1[2] + o1[3] * o1[3];
                    u32x4 w; w.x = cvt_pk_bf16(o0[0], o0[1]); w.y = cvt_pk_bf16(o0[2], o0[3]); w.z = cvt_pk_bf16(o1[0], o1[1]); w.w = cvt_pk_bf16(o1[2], o1[3]);
                    *(u32x4*)(xb + off + bj * HALF) = w; }
                ss += __shfl_xor(ss, 16); ss += __shfl_xor(ss, 32);
                if (fq == 0) unsafeAtomicAdd(rowss + row, ss); }
    }
};
template <class Epi, class Sched, bool STAMP = false>
__device__ __forceinline__ void gemm_phase(PG8_LAS unsigned char* lds, const Gemm g, const Sched& S, const Epi& E, unsigned long long* stamps) {
    const int tid = threadIdx.x, wid = __builtin_amdgcn_readfirstlane(tid >> 6), lane = tid & 63, wr = wid >> 2, wc = wid & 3, fr = lane & 15, fq = lane >> 4;
    const int K = g.K, nt = K / BK;
    int ts_lo = 0, ts_hi = 0, nts = 0; const unsigned long long rt_entry = STAMP ? (unsigned long long)wall_clock64() : 0ull;
#define PG8_STAMP() do { if (STAMP && wid == 0 && nts < 64) { const unsigned long long _c = (unsigned long long)clock64(); \
        ts_lo = (lane == nts) ? (int)(unsigned)_c : ts_lo; ts_hi = (lane == nts) ? (int)(unsigned)(_c >> 32) : ts_hi; ++nts; } } while (0)
    PG8_STAMP();
    unsigned voffA[2], voffB[2];
#pragma unroll
    for (int i = 0; i < 2; ++i) { int R, C; stage_rc(tid * 16 + i * 8192, R, C); const int Rb = Epi::PERM ? ((R & ~31) + perm32(R & 31)) : R;
        voffA[i] = (unsigned)(R * K + C) * 2u; voffB[i] = (unsigned)(Rb * K + C) * 2u; }
    const size_t kstep = (size_t)(BK * 2);
    const size_t hstep = (size_t)HALF * K * 2;
    const size_t tstep = 2 * hstep;
    const unsigned ldsw = (unsigned)wid * 1024u;
    const int aoff = lds_byte(wr * 64 + fr, fq * 8), boff = lds_byte(wc * 32 + fr, fq * 8);
#define PG8_SA(b, h) (((b) * 2 + (h)) * HTB)
#define PG8_SB(b, h) ((4 + (b) * 2 + (h)) * HTB)
#define PG8_STAGE(bufoff, gbase, voff) do { _Pragma("unroll") for (int _i = 0; _i < 2; ++_i) \
        __builtin_amdgcn_global_load_lds((const unsigned*)((const char*)(gbase) + (voff)[_i]), (PG8_LAS unsigned*)(lds + (bufoff) + ldsw + _i * 8192), 16, 0, 0); } while (0)
#define PG8_LDA(dst, b, h) do { _Pragma("unroll") for (int m = 0; m < 4; ++m) _Pragma("unroll") for (int k = 0; k < 2; ++k) dst[m][k] = *(const PG8_LAS bf16x8*)(lds + PG8_SA(b, h) + aoff + m * 2048 + k * 1024); } while (0)
#define PG8_LDB(dst, b, h) do { _Pragma("unroll") for (int n = 0; n < 2; ++n) _Pragma("unroll") for (int k = 0; k < 2; ++k) dst[n][k] = *(const PG8_LAS bf16x8*)(lds + PG8_SB(b, h) + boff + n * 2048 + k * 1024); } while (0)
#define PG8_MMA(ai, bj, At, Bt) do { __builtin_amdgcn_s_setprio(1); _Pragma("unroll") for (int m = 0; m < 4; ++m) _Pragma("unroll") for (int n = 0; n < 2; ++n) _Pragma("unroll") for (int k = 0; k < 2; ++k) \
        acc[ai][bj][m][n] = __builtin_amdgcn_mfma_f32_16x16x32_bf16(Bt[n][k], At[m][k], acc[ai][bj][m][n], 0, 0, 0); __builtin_amdgcn_s_setprio(0); } while (0)
#define PG8_WAIT_V(n) asm volatile("s_waitcnt vmcnt(" #n ")" ::: "memory")
#define PG8_WAIT_L(n) asm volatile("s_waitcnt lgkmcnt(" #n ")" ::: "memory")
#define PG8_BAR __builtin_amdgcn_s_barrier()
#define PG8_SCHED __builtin_amdgcn_sched_barrier(0)
    Unit cur, nxt; int ui = 0;
    if (!S.next(0, cur)) return;
    f32x4 acc[2][2][4][2];
#pragma unroll
    for (int a = 0; a < 2; ++a)
#pragma unroll
        for (int b = 0; b < 2; ++b)
#pragma unroll
            for (int m = 0; m < 4; ++m)
#pragma unroll
                for (int n = 0; n < 2; ++n) acc[a][b][m][n] = (f32x4){0.f, 0.f, 0.f, 0.f};
    bf16x8 At[4][2], B0[2][2], B1[2][2];
    const char* cA = (const char*)g.A + (size_t)cur.pm * tstep; const char* cB = (const char*)g.Bt + (size_t)cur.pn * tstep;
    S.a_ready(cur);
    PG8_STAGE(PG8_SB(0, 0), cB, voffB); PG8_STAGE(PG8_SA(0, 0), cA, voffA); PG8_STAGE(PG8_SB(0, 1), cB + hstep, voffB); PG8_STAGE(PG8_SA(0, 1), cA + hstep, voffA);
    if (wr == 1) PG8_BAR;
    PG8_WAIT_V(4); PG8_BAR;
    PG8_STAGE(PG8_SB(1, 0), cB + kstep, voffB); PG8_STAGE(PG8_SA(1, 0), cA + kstep, voffA); PG8_STAGE(PG8_SB(1, 1), cB + hstep + kstep, voffB);
    PG8_WAIT_V(6); PG8_BAR;
    PG8_STAMP();
    for (;;) {
        const bool has_next = S.next(ui + 1, nxt);
        const char* nA = has_next ? (const char*)g.A + (size_t)nxt.pm * tstep : cA; const char* nB = has_next ? (const char*)g.Bt + (size_t)nxt.pn * tstep : cB;
        for (int t = 0; t < nt; t += 2) {
            const bool last = (t == nt - 2);
            const char* a1 = cA + (size_t)(t + 1) * kstep;
            const char* a2 = last ? nA : cA + (size_t)(t + 2) * kstep; const char* b2 = last ? nB : cB + (size_t)(t + 2) * kstep;
            const char* a3 = a2 + kstep; const char* b3 = b2 + kstep;
            if (last && has_next) S.a_ready(nxt);
            PG8_LDB(B0, 0, 0); PG8_SCHED; PG8_LDA(At, 0, 0); PG8_STAGE(PG8_SA(1, 1), a1 + hstep, voffA);
            PG8_WAIT_L(8); PG8_BAR; PG8_WAIT_L(0); PG8_MMA(0, 0, At, B0); PG8_BAR; PG8_SCHED;
            PG8_LDB(B1, 0, 1); PG8_STAGE(PG8_SB(0, 0), b2, voffB);
            PG8_BAR; PG8_WAIT_L(0); PG8_MMA(0, 1, At, B1); PG8_BAR;
            PG8_LDA(At, 0, 1); PG8_STAGE(PG8_SA(0, 0), a2, voffA);
            PG8_BAR; PG8_WAIT_L(0); PG8_MMA(1, 0, At, B0); PG8_BAR; PG8_SCHED;
            PG8_STAGE(PG8_SB(0, 1), b2 + hstep, voffB);
            PG8_WAIT_V(6); PG8_BAR; PG8_MMA(1, 1, At, B1); PG8_BAR;
            PG8_LDB(B0, 1, 0); PG8_SCHED; PG8_LDA(At, 1, 0); PG8_STAGE(PG8_SA(0, 1), a2 + hstep, voffA);
            PG8_WAIT_L(8); PG8_BAR; PG8_WAIT_L(0); PG8_MMA(0, 0, At, B0); PG8_BAR; PG8_SCHED;
            PG8_LDB(B1, 1, 1); PG8_STAGE(PG8_SB(1, 0), b3, voffB);
            PG8_BAR; PG8_WAIT_L(0); PG8_MMA(0, 1, At, B1); PG8_BAR;
            PG8_LDA(At, 1, 1); PG8_STAGE(PG8_SA(1, 0), a3, voffA);
            PG8_BAR; PG8_WAIT_L(0); PG8_MMA(1, 0, At, B0); PG8_BAR; PG8_SCHED;
            PG8_STAGE(PG8_SB(1, 1), b3 + hstep, voffB);
            PG8_WAIT_V(6); PG8_BAR; PG8_MMA(1, 1, At, B1); PG8_BAR;
        }
        PG8_STAMP();
        if constexpr (!Epi::AFTER_DRAIN) { E(acc, cur, wr, wc, fr, fq); S.done(cur); }
        PG8_STAMP();
        if (!has_next) break;
#pragma unroll
        for (int a = 0; a < 2; ++a)
#pragma unroll
            for (int b = 0; b < 2; ++b)
#pragma unroll
                for (int m = 0; m < 4; ++m)
#pragma unroll
                    for (int n = 0; n < 2; ++n) acc[a][b][m][n] = (f32x4){0.f, 0.f, 0.f, 0.f};
        cur = nxt; cA = nA; cB = nB; ++ui;
    }
    PG8_WAIT_V(0);
    if (wr == 0) PG8_BAR;
    PG8_BAR;
    if constexpr (Epi::AFTER_DRAIN) { E.fused(acc, cur, wr, wc, fr, fq, lds, wid, lane); S.done(cur); }
    PG8_STAMP();
    if (STAMP && wid == 0) { stamps[lane] = lane < nts ? (((unsigned long long)(unsigned)ts_hi << 32) | (unsigned)ts_lo) : 0ull;
        if (lane == 62) stamps[62] = rt_entry; if (lane == 63) stamps[63] = (unsigned long long)wall_clock64(); }
#undef PG8_STAMP
#undef PG8_SA
#undef PG8_SB
#undef PG8_STAGE
#undef PG8_LDA
#undef PG8_LDB
#undef PG8_MMA
#undef PG8_WAIT_V
#undef PG8_WAIT_L
#undef PG8_BAR
#undef PG8_SCHED
}
}


constexpr size_t MBy = 1u << 20;
constexpr size_t WS_WTIN = 0, WS_WTOUT = 6 * MBy, WS_WTQ = 8 * MBy, WS_CTL = 12 * MBy, WS_ROWSS = 12 * MBy + 65536, WS_ACT = 13 * MBy, WS_PROJ = 45 * MBy,
                 WS_SB = 141 * MBy, WS_IDX = 173 * MBy, WS_GATE = 181 * MBy, WS_U8 = 189 * MBy, WS_V8 = 205 * MBy, WS_PW = 221 * MBy,
                 WS_UINV = 12 * MBy + 262144, WS_VINV = 12 * MBy + 393216;
constexpr int LDS_MISC = pg8::STAGE_BYTES, LDS_BYTES = pg8::STAGE_BYTES + 256;

struct Params {
  const float *x, *norm1_g, *w_in, *q_norm_g, *k_norm_g, *conv_w, *sb_out_g, *conv_out_g, *w_out, *norm2_g, *w_q, *sub_keys, *peer_u, *peer_v;
  float* out; unsigned char* ws; int ph_lo, ph_hi;
};

#define XB_TMO      128
#define XB_XCNT(j)  (256  + 64 * (j))
#define XB_XSUB(j)  (1280 + 64 * (j))
#define XB_XGEN(j)  (2304 + 64 * (j))
#define XB_TOP      3328
#define XB_TOPGEN   3392
#define XCD_BAR_WORDS 3456
#define XB_SPIN_CAP (1u << 18)
DI unsigned xb_ld(unsigned* p) { return __hip_atomic_load(p, __ATOMIC_RELAXED, __HIP_MEMORY_SCOPE_AGENT); }
DI unsigned xb_add(unsigned* p, unsigned v) { return __hip_atomic_fetch_add(p, v, __ATOMIC_RELAXED, __HIP_MEMORY_SCOPE_AGENT); }
DI unsigned xb_xcc_id() { return (unsigned)__builtin_amdgcn_s_getreg((3 << 11) | 20) & 0xFu; }
#define XB_SPIN(cond, bar) do { unsigned _sp = 0; while (cond) { __builtin_amdgcn_s_sleep(1); \
    if ((++_sp & 255u) == 0u) { if (xb_ld(&(bar)[XB_TMO])) break; if (_sp > XB_SPIN_CAP) { atomicAdd(&(bar)[XB_TMO], 1u); break; } } } } while (0)
struct XcdBarrier { unsigned* bar; unsigned x; volatile LAS unsigned* st; };
DI XcdBarrier xcd_barrier_post(unsigned* bar, volatile LAS unsigned* st) {
  XcdBarrier b; b.bar = bar; b.x = xb_xcc_id(); b.st = st;
  if (threadIdx.x == 0) (void)xb_add(&bar[XB_XCNT(b.x)], 1u);
  return b;
}
DI void xcd_barrier_complete(unsigned* bar, unsigned x, unsigned& nloc, unsigned& nx) {
  const unsigned G = gridDim.x * gridDim.y * gridDim.z;
  unsigned sum, cnt, mine, sp = 0u;
  for (;;) {
    sum = 0u; cnt = 0u; mine = 0u;
#pragma unroll
    for (unsigned j = 0; j < 16; ++j) { const unsigned c = xb_ld(&bar[XB_XCNT(j)]); sum += c; cnt += (c > 0u) ? 1u : 0u; mine = (j == x) ? c : mine; }
    if (sum == G) break;
    __builtin_amdgcn_s_sleep(1);
    if ((++sp & 255u) == 0u) { if (xb_ld(&bar[XB_TMO])) break; if (sp > XB_SPIN_CAP) { atomicAdd(&bar[XB_TMO], 1u); break; } }
  }
  nloc = mine > 0u ? mine : 1u; nx = cnt > 0u ? cnt : 1u;
}
DI void xcd_barrier(const XcdBarrier& b) {
  asm volatile("s_waitcnt vmcnt(0)" ::: "memory");
  __syncthreads();
  if (threadIdx.x == 0) {
    unsigned* bar = b.bar;
    __builtin_amdgcn_s_waitcnt(0);
    unsigned nloc = b.st[0], nx = b.st[1];
    if (nloc == 0u) { xcd_barrier_complete(bar, b.x, nloc, nx); b.st[0] = nloc; b.st[1] = nx; }
    const unsigned old = xb_add(&bar[XB_XSUB(b.x)], 1u);
    const unsigned gen = old / nloc;
    if (old + 1u == (gen + 1u) * nloc) {
      __builtin_amdgcn_fence(__ATOMIC_RELEASE, "agent");
      asm volatile("s_waitcnt vmcnt(0)" ::: "memory");
      const unsigned og = xb_add(&bar[XB_TOP], 1u);
      const unsigned tg = og / nx;
      if (og + 1u == (tg + 1u) * nx) xb_add(&bar[XB_TOPGEN], 1u);
      else XB_SPIN(xb_ld(&bar[XB_TOPGEN]) == tg, bar);
      __builtin_amdgcn_fence(__ATOMIC_ACQUIRE, "agent");
      xb_add(&bar[XB_XGEN(b.x)], 1u);
      asm volatile("s_waitcnt vmcnt(0)" ::: "memory");
    } else {
      XB_SPIN(xb_ld(&bar[XB_XGEN(b.x)]) == gen, bar);
      __builtin_amdgcn_fence(__ATOMIC_ACQUIRE, "agent");
      asm volatile("s_waitcnt vmcnt(0)" ::: "memory");
    }
  }
  __syncthreads();
}

DI u16 f2bf(float x) { unsigned u = __float_as_uint(x); u += 0x7fffu + ((u >> 16) & 1u); return (u16)(u >> 16); }
DI float bflo(unsigned w) { return __uint_as_float(w << 16); }
DI float bfhi(unsigned w) { return __uint_as_float(w & 0xffff0000u); }
DI unsigned pack2(float a, float b) { return (unsigned)f2bf(a) | ((unsigned)f2bf(b) << 16); }
DI float wave_sum(float v) {
#pragma unroll
  for (int o = 32; o >= 1; o >>= 1) v += __shfl_xor(v, o);
  return v;
}
DI float wave_max(float v) {
#pragma unroll
  for (int o = 32; o >= 1; o >>= 1) v = fmaxf(v, __shfl_xor(v, o));
  return v;
}
DI void unpack8(const uint4 w, float* f) {
  f[0] = bflo(w.x); f[1] = bfhi(w.x); f[2] = bflo(w.y); f[3] = bfhi(w.y); f[4] = bflo(w.z); f[5] = bfhi(w.z); f[6] = bflo(w.w); f[7] = bfhi(w.w);
}
DI uint4 pack8(const float* f) { uint4 o; o.x = pack2(f[0], f[1]); o.y = pack2(f[2], f[3]); o.z = pack2(f[4], f[5]); o.w = pack2(f[6], f[7]); return o; }

DI void transpose_convert(const float* __restrict__ W, u16* __restrict__ Wt, int K, int N, const float* __restrict__ rg, float* sm) {
  const int tid = threadIdx.x, tn_cnt = N / 64, ntile = (K / 64) * tn_cnt;
  for (int tile = blockIdx.x; tile < ntile; tile += gridDim.x) {
    const int tk = tile / tn_cnt, tn = tile % tn_cnt;
    __syncthreads();
#pragma unroll
    for (int r = 0; r < 8; ++r) { const int row = r * 8 + (tid >> 6), col = tid & 63;
      const float g = rg ? rg[tk * 64 + row] : 1.f;
      sm[row * 65 + col] = W[(size_t)(tk * 64 + row) * N + tn * 64 + col] * g; }
    __syncthreads();
#pragma unroll
    for (int r = 0; r < 8; ++r) { const int nrow = r * 8 + (tid >> 6), kcol = tid & 63; Wt[(size_t)(tn * 64 + nrow) * K + tk * 64 + kcol] = f2bf(sm[kcol * 65 + nrow]); }
  }
}
DI void convert_fp8_rows(const float* __restrict__ src, const float* __restrict__ cg, unsigned char* __restrict__ dst, float* __restrict__ inv_out) {
  const int lane = threadIdx.x & 63, gw = blockIdx.x * NWAVES + (threadIdx.x >> 6), nw = gridDim.x * NWAVES;
  float g[16];
#pragma unroll
  for (int j = 0; j < 16; ++j) g[j] = cg ? cg[16 * lane + j] : 1.f;
  for (int row = gw; row < NEXP; row += nw) {
    const float4* s = (const float4*)(src + (size_t)row * D + 16 * lane);
    float v[16];
#pragma unroll
    for (int k = 0; k < 4; ++k) { const float4 a = s[k]; v[4 * k] = a.x * g[4 * k]; v[4 * k + 1] = a.y * g[4 * k + 1]; v[4 * k + 2] = a.z * g[4 * k + 2]; v[4 * k + 3] = a.w * g[4 * k + 3]; }
    float am = 0.f;
#pragma unroll
    for (int j = 0; j < 16; ++j) am = fmaxf(am, fabsf(v[j]));
    am = wave_max(am);
    const float sc = am > 0.f ? 240.f / am : 1.f;
    uint4 o;
    { int w;
      w = __builtin_amdgcn_cvt_pk_fp8_f32(v[0] * sc, v[1] * sc, 0, false); w = __builtin_amdgcn_cvt_pk_fp8_f32(v[2] * sc, v[3] * sc, w, true); o.x = (unsigned)w;
      w = __builtin_amdgcn_cvt_pk_fp8_f32(v[4] * sc, v[5] * sc, 0, false); w = __builtin_amdgcn_cvt_pk_fp8_f32(v[6] * sc, v[7] * sc, w, true); o.y = (unsigned)w;
      w = __builtin_amdgcn_cvt_pk_fp8_f32(v[8] * sc, v[9] * sc, 0, false); w = __builtin_amdgcn_cvt_pk_fp8_f32(v[10] * sc, v[11] * sc, w, true); o.z = (unsigned)w;
      w = __builtin_amdgcn_cvt_pk_fp8_f32(v[12] * sc, v[13] * sc, 0, false); w = __builtin_amdgcn_cvt_pk_fp8_f32(v[14] * sc, v[15] * sc, w, true); o.w = (unsigned)w; }
    *(uint4*)(dst + (size_t)row * D + 16 * lane) = o;
    if (lane == 0) inv_out[row] = am > 0.f ? am * (1.f / 240.f) : 1.f;
  }
}
DI void rmsnorm1024(const float* __restrict__ src, const float* __restrict__ g, u16* __restrict__ dst) {
  const int lane = threadIdx.x & 63, gw = blockIdx.x * NWAVES + (threadIdx.x >> 6), nw = gridDim.x * NWAVES;
  for (int row = gw; row < T; row += nw) {
    const float4* xr = (const float4*)(src + (size_t)row * D);
    float4 v[4]; float ss = 0.f;
#pragma unroll
    for (int j = 0; j < 4; ++j) { v[j] = xr[lane + 64 * j]; ss += v[j].x * v[j].x + v[j].y * v[j].y + v[j].z * v[j].z + v[j].w * v[j].w; }
    ss = wave_sum(ss);
    const float inv = rsqrtf(ss * (1.f / D) + EPS);
#pragma unroll
    for (int j = 0; j < 4; ++j) {
      const float4 gg = ((const float4*)g)[lane + 64 * j];
      uint2 o; o.x = pack2(v[j].x * inv * gg.x, v[j].y * inv * gg.y); o.y = pack2(v[j].z * inv * gg.z, v[j].w * inv * gg.w);
      *(uint2*)(dst + (size_t)row * D + 4 * (lane + 64 * j)) = o;
    }
  }
}

DI void postproj_phase(const Params& p, u16* __restrict__ proj, u16* __restrict__ mixed) {
  const int lane = threadIdx.x & 63, gw = blockIdx.x * NWAVES + (threadIdx.x >> 6), nw = gridDim.x * NWAVES;
  for (int t = gw; t < T; t += nw) {
    u16* row = proj + (size_t)t * DIN;
#pragma unroll
    for (int which = 0; which < 2; ++which) {
      float f[8]; unpack8(*(const uint4*)(row + which * 512 + 8 * lane), f);
      float ss = 0.f;
#pragma unroll
      for (int j = 0; j < 8; ++j) ss += f[j] * f[j];
      ss += __shfl_xor(ss, 1); ss += __shfl_xor(ss, 2); ss += __shfl_xor(ss, 4);
      const float inv = rsqrtf(ss * (1.f / 64.f) + EPS);
      const float* g = (which == 0 ? p.q_norm_g : p.k_norm_g) + 8 * (lane & 7);
#pragma unroll
      for (int j = 0; j < 8; ++j) f[j] = f[j] * inv * g[j];
      *(uint4*)(row + which * 512 + 8 * lane) = pack8(f);
    }
    const int c0 = 8 * lane, tpos = t & (SEQ - 1);
    float xc[8], bg[8], cg[8], y[8];
    unpack8(*(const uint4*)(row + 1536 + c0), xc); unpack8(*(const uint4*)(row + 2048 + c0), bg); unpack8(*(const uint4*)(row + 2560 + c0), cg);
#pragma unroll
    for (int j = 0; j < 8; ++j) y[j] = p.conv_w[2 * DSB + c0 + j] * (cg[j] * xc[j]);
    if (tpos >= 1) {
      float x1[8], c1[8]; unpack8(*(const uint4*)(row - DIN + 1536 + c0), x1); unpack8(*(const uint4*)(row - DIN + 2560 + c0), c1);
#pragma unroll
      for (int j = 0; j < 8; ++j) y[j] += p.conv_w[1 * DSB + c0 + j] * (c1[j] * x1[j]);
    }
    if (tpos >= 2) {
      float x2[8], c2[8]; unpack8(*(const uint4*)(row - 2 * DIN + 1536 + c0), x2); unpack8(*(const uint4*)(row - 2 * DIN + 2560 + c0), c2);
#pragma unroll
      for (int j = 0; j < 8; ++j) y[j] += p.conv_w[0 * DSB + c0 + j] * (c2[j] * x2[j]);
    }
    float ss = 0.f;
#pragma unroll
    for (int j = 0; j < 8; ++j) { y[j] *= bg[j]; ss += y[j] * y[j]; }
    ss = wave_sum(ss);
    const float inv = rsqrtf(ss * (1.f / DSB) + EPS);
#pragma unroll
    for (int j = 0; j < 8; ++j) y[j] = y[j] * inv * p.conv_out_g[c0 + j];
    *(uint4*)(mixed + (size_t)t * D + DSB + c0) = pack8(y);
  }
}

DI void attn_phase(const u16* __restrict__ proj, float* __restrict__ sb) {
  const int lane = threadIdx.x & 63, gw = blockIdx.x * NWAVES + (threadIdx.x >> 6), nw = gridDim.x * NWAVES;
  for (int item = gw; item < 4 * 8 * 64; item += nw) {
    const int qb = 63 - (item >> 5), bh = item & 31, b = bh >> 3, h = bh & 7;
    const int t0 = qb * 64, tq = t0 + lane;
    const u16* qrow = proj + (size_t)(b * SEQ + tq) * DIN + h * 64;
    float q[64], acc[64];
#pragma unroll
    for (int c = 0; c < 8; ++c) { float f[8]; unpack8(((const uint4*)qrow)[c], f);
#pragma unroll
      for (int j = 0; j < 8; ++j) { q[8 * c + j] = f[j] * 0.125f; acc[8 * c + j] = 0.f; } }
    float P = 1.f;
    for (int s = t0 + 62; s >= 0; --s) {
      const u16* krow = proj + (size_t)(b * SEQ + s) * DIN + 512 + h * 64;
      float z = 0.f;
#pragma unroll
      for (int c = 0; c < 8; ++c) { float f[8]; unpack8(((const uint4*)krow)[c], f);
#pragma unroll
        for (int j = 0; j < 8; ++j) z += q[8 * c + j] * f[j]; }
      const float e = __expf(fminf(z, 80.f));
      const float r = __builtin_amdgcn_rcpf(1.f + e);
      const bool on = s < tq;
      const float a = on ? e * r * P : 0.f;
      P = on ? P * r : P;
      const u16* vrow = krow + 512;
#pragma unroll
      for (int c = 0; c < 8; ++c) { float f[8]; unpack8(((const uint4*)vrow)[c], f);
#pragma unroll
        for (int j = 0; j < 8; ++j) acc[8 * c + j] += a * f[j]; }
      if (s < t0 && __all(P == 0.f)) break;
    }
    float* orow = sb + (size_t)(b * SEQ + tq) * DSB + h * 64;
#pragma unroll
    for (int c = 0; c < 16; ++c) ((float4*)orow)[c] = make_float4(acc[4 * c], acc[4 * c + 1], acc[4 * c + 2], acc[4 * c + 3]);
  }
}

DI void sbnorm_phase(const Params& p, const float* __restrict__ sb, u16* __restrict__ mixed) {
  const int lane = threadIdx.x & 63, gw = blockIdx.x * NWAVES + (threadIdx.x >> 6), nw = gridDim.x * NWAVES;
  for (int t = gw; t < T; t += nw) {
    const float4 a = ((const float4*)(sb + (size_t)t * DSB))[2 * lane], b = ((const float4*)(sb + (size_t)t * DSB))[2 * lane + 1];
    float f[8] = {a.x, a.y, a.z, a.w, b.x, b.y, b.z, b.w};
    float ss = 0.f;
#pragma unroll
    for (int j = 0; j < 8; ++j) ss += f[j] * f[j];
    ss = wave_sum(ss);
    const float inv = rsqrtf(ss * (1.f / DSB) + EPS);
#pragma unroll
    for (int j = 0; j < 8; ++j) f[j] = f[j] * inv * p.sb_out_g[8 * lane + j];
    *(uint4*)(mixed + (size_t)t * D + 8 * lane) = pack8(f);
  }
}

#define SEL_DI DI
#define SEL_F2U(x) __float_as_uint(x)
#define SEL_U2F(x) __uint_as_float(x)

#define CE(a, b) do { const unsigned _h = (a) > (b) ? (a) : (b), _l = (a) > (b) ? (b) : (a); (a) = _h; (b) = _l; } while (0)
SEL_DI void sort16(unsigned (&v)[16]) {
  CE(v[0], v[1]); CE(v[2], v[3]); CE(v[0], v[2]); CE(v[1], v[3]); CE(v[1], v[2]); CE(v[4], v[5]); CE(v[6], v[7]); CE(v[4], v[6]);
  CE(v[5], v[7]); CE(v[5], v[6]); CE(v[0], v[4]); CE(v[2], v[6]); CE(v[2], v[4]); CE(v[1], v[5]); CE(v[3], v[7]); CE(v[3], v[5]);
  CE(v[1], v[2]); CE(v[3], v[4]); CE(v[5], v[6]); CE(v[8], v[9]); CE(v[10], v[11]); CE(v[8], v[10]); CE(v[9], v[11]); CE(v[9], v[10]);
  CE(v[12], v[13]); CE(v[14], v[15]); CE(v[12], v[14]); CE(v[13], v[15]); CE(v[13], v[14]); CE(v[8], v[12]); CE(v[10], v[14]); CE(v[10], v[12]);
  CE(v[9], v[13]); CE(v[11], v[15]); CE(v[11], v[13]); CE(v[9], v[10]); CE(v[11], v[12]); CE(v[13], v[14]); CE(v[0], v[8]); CE(v[4], v[12]);
  CE(v[4], v[8]); CE(v[2], v[10]); CE(v[6], v[14]); CE(v[6], v[10]); CE(v[2], v[4]); CE(v[6], v[8]); CE(v[10], v[12]); CE(v[1], v[9]);
  CE(v[5], v[13]); CE(v[5], v[9]); CE(v[3], v[11]); CE(v[7], v[15]); CE(v[7], v[11]); CE(v[3], v[5]); CE(v[7], v[9]); CE(v[11], v[13]);
  CE(v[1], v[2]); CE(v[3], v[4]); CE(v[5], v[6]); CE(v[7], v[8]); CE(v[9], v[10]); CE(v[11], v[12]); CE(v[13], v[14]);
}
SEL_DI void bitonic_merge16(unsigned (&v)[16]) {
#pragma unroll
  for (int d = 8; d >= 1; d >>= 1)
#pragma unroll
    for (int i = 0; i < 16; ++i) if ((i & d) == 0) CE(v[i], v[i + d]);
}
SEL_DI void merge_top16(unsigned (&a)[16], const unsigned (&b)[16]) {
#pragma unroll
  for (int i = 0; i < 16; ++i) a[i] = a[i] > b[15 - i] ? a[i] : b[15 - i];
  bitonic_merge16(a);
}
SEL_DI void top16_of_64(unsigned (&g0)[16], unsigned (&g1)[16], unsigned (&g2)[16], unsigned (&g3)[16]) {
  sort16(g0); sort16(g1); sort16(g2); sort16(g3);
  merge_top16(g0, g1); merge_top16(g2, g3); merge_top16(g0, g2);
}
SEL_DI unsigned cand_key(float a, float b, unsigned payload) {
  float s = a + b; s = s < 32.0f ? 32.0f : (s > 127.99f ? 127.99f : s);
  return ((SEL_F2U(s) << 8) & 0xFFFFC000u) | payload;
}
SEL_DI void stage2(const unsigned (&L1)[16], const unsigned (&L2)[16], unsigned (&R)[16]) {
  float f1[16], f2m[16]; unsigned P1[16], P2[16];
#pragma unroll
  for (int i = 0; i < 16; ++i) { f1[i] = SEL_U2F(L1[i] & ~127u); f2m[i] = SEL_U2F(L2[i] & ~127u) - 64.0f; P1[i] = (L1[i] & 127u) << 7; P2[i] = L2[i] & 127u; }
  unsigned K[64];
  K[0] = cand_key(f1[0], f2m[0], P1[0] | P2[0]);
  K[1] = cand_key(f1[0], f2m[1], P1[0] | P2[1]);
  K[2] = cand_key(f1[0], f2m[2], P1[0] | P2[2]);
  K[3] = cand_key(f1[0], f2m[3], P1[0] | P2[3]);
  K[4] = cand_key(f1[0], f2m[4], P1[0] | P2[4]);
  K[5] = cand_key(f1[0], f2m[5], P1[0] | P2[5]);
  K[6] = cand_key(f1[0], f2m[6], P1[0] | P2[6]);
  K[7] = cand_key(f1[0], f2m[7], P1[0] | P2[7]);
  K[8] = cand_key(f1[0], f2m[8], P1[0] | P2[8]);
  K[9] = cand_key(f1[0], f2m[9], P1[0] | P2[9]);
  K[10] = cand_key(f1[0], f2m[10], P1[0] | P2[10]);
  K[11] = cand_key(f1[0], f2m[11], P1[0] | P2[11]);
  K[12] = cand_key(f1[0], f2m[12], P1[0] | P2[12]);
  K[13] = cand_key(f1[0], f2m[13], P1[0] | P2[13]);
  K[14] = cand_key(f1[0], f2m[14], P1[0] | P2[14]);
  K[15] = cand_key(f1[0], f2m[15], P1[0] | P2[15]);
  K[16] = cand_key(f1[1], f2m[0], P1[1] | P2[0]);
  K[17] = cand_key(f1[1], f2m[1], P1[1] | P2[1]);
  K[18] = cand_key(f1[1], f2m[2], P1[1] | P2[2]);
  K[19] = cand_key(f1[1], f2m[3], P1[1] | P2[3]);
  K[20] = cand_key(f1[1], f2m[4], P1[1] | P2[4]);
  K[21] = cand_key(f1[1], f2m[5], P1[1] | P2[5]);
  K[22] = cand_key(f1[1], f2m[6], P1[1] | P2[6]);
  K[23] = cand_key(f1[1], f2m[7], P1[1] | P2[7]);
  K[24] = cand_key(f1[2], f2m[0], P1[2] | P2[0]);
  K[25] = cand_key(f1[2], f2m[1], P1[2] | P2[1]);
  K[26] = cand_key(f1[2], f2m[2], P1[2] | P2[2]);
  K[27] = cand_key(f1[2], f2m[3], P1[2] | P2[3]);
  K[28] = cand_key(f1[2], f2m[4], P1[2] | P2[4]);
  K[29] = cand_key(f1[3], f2m[0], P1[3] | P2[0]);
  K[30] = cand_key(f1[3], f2m[1], P1[3] | P2[1]);
  K[31] = cand_key(f1[3], f2m[2], P1[3] | P2[2]);
  K[32] = cand_key(f1[3], f2m[3], P1[3] | P2[3]);
  K[33] = cand_key(f1[4], f2m[0], P1[4] | P2[0]);
  K[34] = cand_key(f1[4], f2m[1], P1[4] | P2[1]);
  K[35] = cand_key(f1[4], f2m[2], P1[4] | P2[2]);
  K[36] = cand_key(f1[5], f2m[0], P1[5] | P2[0]);
  K[37] = cand_key(f1[5], f2m[1], P1[5] | P2[1]);
  K[38] = cand_key(f1[6], f2m[0], P1[6] | P2[0]);
  K[39] = cand_key(f1[6], f2m[1], P1[6] | P2[1]);
  K[40] = cand_key(f1[7], f2m[0], P1[7] | P2[0]);
  K[41] = cand_key(f1[7], f2m[1], P1[7] | P2[1]);
  K[42] = cand_key(f1[8], f2m[0], P1[8] | P2[0]);
  K[43] = cand_key(f1[9], f2m[0], P1[9] | P2[0]);
  K[44] = cand_key(f1[10], f2m[0], P1[10] | P2[0]);
  K[45] = cand_key(f1[11], f2m[0], P1[11] | P2[0]);
  K[46] = cand_key(f1[12], f2m[0], P1[12] | P2[0]);
  K[47] = cand_key(f1[13], f2m[0], P1[13] | P2[0]);
  K[48] = cand_key(f1[14], f2m[0], P1[14] | P2[0]);
  K[49] = cand_key(f1[15], f2m[0], P1[15] | P2[0]);
#pragma unroll
  for (int c = 50; c < 64; ++c) K[c] = 0u;
  unsigned g1[16], g2[16], g3[16];
#pragma unroll
  for (int i = 0; i < 16; ++i) { R[i] = K[i]; g1[i] = K[16 + i]; g2[i] = K[32 + i]; g3[i] = K[48 + i]; }
  sort16(R); sort16(g1); sort16(g2); CE(g3[0], g3[1]);
  merge_top16(R, g1);
  g2[15] = g2[15] > g3[0] ? g2[15] : g3[0]; g2[14] = g2[14] > g3[1] ? g2[14] : g3[1];
  bitonic_merge16(g2);
  merge_top16(R, g2);
}

typedef float f32x16_t __attribute__((ext_vector_type(16)));
typedef short bf16x8_t __attribute__((ext_vector_type(8)));
constexpr int SKP = 272;
DI void stage1(const u16* __restrict__ qrow, const LAS unsigned char* sk, int tok, int hh, unsigned (&out)[16]) {
  f32x16_t acc[4];
#pragma unroll
  for (int kt = 0; kt < 4; ++kt)
#pragma unroll
    for (int r = 0; r < 16; ++r) acc[kt][r] = 64.0f;
#pragma unroll 1
  for (int ks = 0; ks < 8; ++ks) {
    const bf16x8_t bq = *(const bf16x8_t*)(qrow + 16 * ks + 8 * hh);
#pragma unroll
    for (int kt = 0; kt < 4; ++kt) {
      const bf16x8_t ak = *(const LAS bf16x8_t*)(sk + (32 * kt + tok) * SKP + (16 * ks + 8 * hh) * 2);
      acc[kt] = __builtin_amdgcn_mfma_f32_32x32x16_bf16(ak, bq, acc[kt], 0, 0, 0);
    }
  }
  unsigned g1[16], g2[16], g3[16];
#pragma unroll
  for (int r = 0; r < 16; ++r) {
    const unsigned ix = (unsigned)((r & 3) + 8 * (r >> 2));
    out[r] = (__float_as_uint(acc[0][r]) & ~127u) | ix; g1[r] = (__float_as_uint(acc[1][r]) & ~127u) | (32u + ix);
    g2[r] = (__float_as_uint(acc[2][r]) & ~127u) | (64u + ix); g3[r] = (__float_as_uint(acc[3][r]) & ~127u) | (96u + ix);
  }
  top16_of_64(out, g1, g2, g3);
  unsigned oth[16];
#pragma unroll
  for (int i = 0; i < 16; ++i) { out[i] |= (unsigned)(hh << 2); }
#pragma unroll
  for (int i = 0; i < 16; ++i) oth[i] = (unsigned)__shfl_xor((int)out[i], 32);
  merge_top16(out, oth);
}
DI void topk_phase(const Params& p, const u16* __restrict__ qp, const float* __restrict__ uinv, int* __restrict__ idx_out, float2* __restrict__ gu_out, unsigned char* smem) {
  const int tid = threadIdx.x;
  LAS unsigned char* sk = (LAS unsigned char*)smem;
  __syncthreads();
  for (int i = tid; i < 2 * 128 * 16; i += NTHREADS) {
    const int c = i & 15, row = i >> 4;
    const float4* s = (const float4*)(p.sub_keys + (size_t)row * 128 + c * 8);
    const float4 a = s[0], b = s[1];
    pg8::u32x4 o; o.x = pack2(a.x, a.y); o.y = pack2(a.z, a.w); o.z = pack2(b.x, b.y); o.w = pack2(b.z, b.w);
    *(LAS pg8::u32x4*)(sk + row * SKP + c * 16) = o;
  }
  __syncthreads();
  const int lane = tid & 63, tok = lane & 31, hh = lane >> 5, gw = blockIdx.x * NWAVES + (tid >> 6), nw = gridDim.x * NWAVES;
  for (int item = gw; item < (T / 32) * 4; item += nw) {
    const int t = (item >> 2) * 32 + tok, hp = item & 3;
    const u16* qt = qp + (size_t)t * 2048 + hp * 512;
    unsigned LA1[16], LA2[16], LB1[16], LB2[16];
    stage1(qt, sk, tok, hh, LA1);
    stage1(qt + 128, sk + 128 * SKP, tok, hh, LA2);
    stage1(qt + 256, sk, tok, hh, LB1);
    stage1(qt + 384, sk + 128 * SKP, tok, hh, LB2);
    unsigned L1[16], L2[16], R[16];
#pragma unroll
    for (int i = 0; i < 16; ++i) { L1[i] = hh ? LB1[i] : LA1[i]; L2[i] = hh ? LB2[i] : LA2[i]; }
    stage2(L1, L2, R);
    const int head = hp * 2 + hh;
    float ev[16], sum = 0.f;
    const float mx = __uint_as_float(0x42000000u | ((R[0] >> 14) << 6));
#pragma unroll
    for (int k = 0; k < 16; ++k) { ev[k] = __expf(__uint_as_float(0x42000000u | ((R[k] >> 14) << 6)) - mx); sum += ev[k]; }
    const float rs = 1.f / sum;
    int* io = idx_out + (size_t)t * 128 + head * 16; float2* go = gu_out + (size_t)t * 128 + head * 16;
#pragma unroll
    for (int k4 = 0; k4 < 4; ++k4) {
      int4 ex; ex.x = (int)(R[4 * k4] & 0x3FFFu); ex.y = (int)(R[4 * k4 + 1] & 0x3FFFu); ex.z = (int)(R[4 * k4 + 2] & 0x3FFFu); ex.w = (int)(R[4 * k4 + 3] & 0x3FFFu);
      ((int4*)io)[k4] = ex;
      float4 ga, gb; ga.x = ev[4 * k4] * rs; ga.y = uinv[ex.x]; ga.z = ev[4 * k4 + 1] * rs; ga.w = uinv[ex.y];
      gb.x = ev[4 * k4 + 2] * rs; gb.y = uinv[ex.z]; gb.z = ev[4 * k4 + 3] * rs; gb.w = uinv[ex.w];
      ((float4*)go)[2 * k4] = ga; ((float4*)go)[2 * k4 + 1] = gb;
    }
  }
}

typedef float f32x4_t __attribute__((ext_vector_type(4)));
DI long lo64(const uint4& a) { return (long)(((unsigned long long)a.y << 32) | a.x); }
DI long hi64(const uint4& a) { return (long)(((unsigned long long)a.w << 32) | a.z); }
#define U_LOAD(A, e) do { const uint4* _r = (const uint4*)(U8 + (size_t)(e) * D + 16 * q); _Pragma("unroll") for (int i = 0; i < 16; ++i) A[i] = _r[4 * i]; } while (0)
#define U_COMPUTE(A, e, gu2, g) do { f32x4_t c0 = {0.f, 0.f, 0.f, 0.f}, c1 = {0.f, 0.f, 0.f, 0.f}; \
    _Pragma("unroll") for (int i = 0; i < 16; ++i) { c0 = __builtin_amdgcn_mfma_f32_16x16x32_fp8_fp8(lo64(A[i]), lo64(B[i]), c0, 0, 0, 0); \
                                                      c1 = __builtin_amdgcn_mfma_f32_16x16x32_fp8_fp8(hi64(A[i]), hi64(B[i]), c1, 0, 0, 0); } \
    const f32x4_t cc = c0 + c1; const int r = pp & 3; \
    float d = r == 0 ? cc[0] : r == 1 ? cc[1] : r == 2 ? cc[2] : cc[3]; \
    if (q == (pp >> 2)) { d *= (gu2).y; const float act = 0.5f * d * (1.f + erff(d * 0.70710678118654752f)); \
      uint2 o; o.x = (unsigned)(e); o.y = __float_as_uint((gu2).x * act); pw[(size_t)tok * 128 + sh * 64 + (g)] = o; } } while (0)
DI void peer_u_phase(const u16* __restrict__ xb, const float* __restrict__ rowss, const int* __restrict__ idx, const float2* __restrict__ gu,
                     const unsigned char* __restrict__ U8, uint2* __restrict__ pw) {
  const int lane = threadIdx.x & 63, pp = lane & 15, q = lane >> 4, gw = blockIdx.x * NWAVES + (threadIdx.x >> 6), nw = gridDim.x * NWAVES;
  for (int item = gw; item < (T / 16) * 2; item += nw) {
    const int tg = item >> 1, sh = item & 1, tok = tg * 16 + pp;
    const float inv = rsqrtf(rowss[tok] * (1.f / D) + EPS);
    uint4 B[16];
#pragma unroll
    for (int i = 0; i < 16; ++i) {
      const uint4* s = (const uint4*)(xb + (size_t)tok * D + 64 * i + 16 * q);
      float f[16]; unpack8(s[0], f); unpack8(s[1], f + 8);
      int w;
      w = __builtin_amdgcn_cvt_pk_fp8_f32(f[0] * inv, f[1] * inv, 0, false); w = __builtin_amdgcn_cvt_pk_fp8_f32(f[2] * inv, f[3] * inv, w, true); B[i].x = (unsigned)w;
      w = __builtin_amdgcn_cvt_pk_fp8_f32(f[4] * inv, f[5] * inv, 0, false); w = __builtin_amdgcn_cvt_pk_fp8_f32(f[6] * inv, f[7] * inv, w, true); B[i].y = (unsigned)w;
      w = __builtin_amdgcn_cvt_pk_fp8_f32(f[8] * inv, f[9] * inv, 0, false); w = __builtin_amdgcn_cvt_pk_fp8_f32(f[10] * inv, f[11] * inv, w, true); B[i].z = (unsigned)w;
      w = __builtin_amdgcn_cvt_pk_fp8_f32(f[12] * inv, f[13] * inv, 0, false); w = __builtin_amdgcn_cvt_pk_fp8_f32(f[14] * inv, f[15] * inv, w, true); B[i].w = (unsigned)w;
    }
    const int* irow = idx + (size_t)tok * 128 + sh * 64; const float2* grow = gu + (size_t)tok * 128 + sh * 64;
    uint4 A0[16], A1[16];
    int e0 = irow[0], e1 = irow[1], e2 = irow[2], e3 = irow[3];
    float2 g0 = grow[0], g1 = grow[1], g2 = grow[2], g3 = grow[3];
    U_LOAD(A0, e0);
    for (int g = 0; g < 64; g += 2) {
      U_LOAD(A1, e1);
      const int n0 = irow[(g + 4) & 63], n1 = irow[(g + 5) & 63]; const float2 h0 = grow[(g + 4) & 63], h1 = grow[(g + 5) & 63];
      U_COMPUTE(A0, e0, g0, g);
      U_LOAD(A0, e2);
      U_COMPUTE(A1, e1, g1, g + 1);
      e0 = e2; e1 = e3; e2 = n0; e3 = n1; g0 = g2; g1 = g3; g2 = h0; g3 = h1;
    }
  }
}

DI void peer_v_phase(const uint2* __restrict__ pw, const unsigned char* __restrict__ V8, const float* __restrict__ vinv, float* __restrict__ out) {
  const int lane = threadIdx.x & 63, wave = threadIdx.x >> 6, r = lane >> 3, cc = lane & 7;
  for (int unit = blockIdx.x; unit < 8 * (T / NWAVES); unit += gridDim.x) {
    const int j = unit & 7, t = (unit >> 3) * NWAVES + wave;
    const uint2* prow = pw + (size_t)t * 128 + r;
    const unsigned char* vbase = V8 + 128 * j + 16 * cc;
    float acc[16];
#pragma unroll
    for (int k = 0; k < 16; ++k) acc[k] = 0.f;
#pragma unroll
    for (int i = 0; i < 16; ++i) {
      const uint2 pe = prow[8 * i];
      const float w = __uint_as_float(pe.y) * vinv[pe.x];
      const uint4 d = *(const uint4*)(vbase + (size_t)pe.x * D);
      const unsigned dw[4] = {d.x, d.y, d.z, d.w};
#pragma unroll
      for (int k = 0; k < 4; ++k) {
        const auto lo = __builtin_amdgcn_cvt_pk_f32_fp8((int)dw[k], false), hi = __builtin_amdgcn_cvt_pk_f32_fp8((int)dw[k], true);
        acc[4 * k] += w * lo[0]; acc[4 * k + 1] += w * lo[1]; acc[4 * k + 2] += w * hi[0]; acc[4 * k + 3] += w * hi[1];
      }
    }
#pragma unroll
    for (int k = 0; k < 16; ++k) { acc[k] += __shfl_xor(acc[k], 8); acc[k] += __shfl_xor(acc[k], 16); acc[k] += __shfl_xor(acc[k], 32); }
    if (r == 0) {
      float4* o = (float4*)(out + (size_t)t * D + 128 * j + 16 * cc);
#pragma unroll
      for (int k = 0; k < 4; ++k) { float4 v = o[k]; v.x += acc[4 * k]; v.y += acc[4 * k + 1]; v.z += acc[4 * k + 2]; v.w += acc[4 * k + 3]; o[k] = v; }
    }
  }
}

constexpr int NPHASE = 10;
__global__ void __launch_bounds__(NTHREADS, 2) fwd_kernel(Params p) {
  extern __shared__ __attribute__((aligned(16))) unsigned char smem[];
  cg::grid_group grid = cg::this_grid();
  unsigned char* ws = p.ws;
  u16* wt_in = (u16*)(ws + WS_WTIN); u16* wt_out = (u16*)(ws + WS_WTOUT); u16* wt_q = (u16*)(ws + WS_WTQ);
  u16* act = (u16*)(ws + WS_ACT); u16* proj = (u16*)(ws + WS_PROJ); float* sb = (float*)(ws + WS_SB);
  int* idx = (int*)(ws + WS_IDX); float2* gu = (float2*)(ws + WS_SB); unsigned char* U8 = ws + WS_U8; unsigned char* V8 = ws + WS_V8;
  uint2* pw = (uint2*)(ws + WS_PW); float* uinv = (float*)(ws + WS_UINV); float* vinv = (float*)(ws + WS_VINV);
  float* rowss = (float*)(ws + WS_ROWSS);
  volatile LAS unsigned* misc = (volatile LAS unsigned*)(LAS unsigned char*)(smem + LDS_MISC);
  if (threadIdx.x < 4) misc[threadIdx.x] = 0u;
  __syncthreads();
  XcdBarrier bar = xcd_barrier_post((unsigned*)(ws + WS_CTL), misc);
  PG8_LAS unsigned char* lds = (PG8_LAS unsigned char*)smem;
  const int lo = p.ph_lo, hi = p.ph_hi;
#define IN(k) (lo <= (k) && (k) < hi)
#define SEAM(k) do { if (IN(k) && IN((k) + 1)) xcd_barrier(bar); } while (0)
  if (IN(0)) {
    transpose_convert(p.w_in, wt_in, D, DIN, nullptr, (float*)smem);
    transpose_convert(p.w_out, wt_out, D, D, nullptr, (float*)smem);
    transpose_convert(p.w_q, wt_q, D, 2048, p.norm2_g, (float*)smem);
    convert_fp8_rows(p.peer_u, p.norm2_g, U8, uinv);
    convert_fp8_rows(p.peer_v, nullptr, V8, vinv);
    rmsnorm1024(p.x, p.norm1_g, act);
    for (int i = blockIdx.x * NTHREADS + threadIdx.x; i < T; i += gridDim.x * NTHREADS) rowss[i] = 0.f;
  }
  if (IN(0) && IN(1)) grid.sync();
  if (IN(1)) { pg8::Gemm g{act, wt_in, T, DIN, D}; pg8::StaticOrder S; S.init(T, DIN, gridDim.x, blockIdx.x);
    pg8::EpiBf16S E{proj, DIN, nullptr}; pg8::gemm_phase<pg8::EpiBf16S, pg8::StaticOrder>(lds, g, S, E, nullptr); }
  SEAM(1);
  if (IN(2)) postproj_phase(p, proj, act);
  SEAM(2);
  if (IN(3)) attn_phase(proj, sb);
  SEAM(3);
  if (IN(4)) sbnorm_phase(p, sb, act);
  SEAM(4);
  if (IN(5)) { pg8::Gemm g{act, wt_out, T, D, D}; pg8::StaticOrder S; S.init(T, D, gridDim.x, blockIdx.x);
    pg8::EpiResid E{p.x, p.out, proj, rowss, D}; pg8::gemm_phase<pg8::EpiResid, pg8::StaticOrder>(lds, g, S, E, nullptr); }
  SEAM(5);
  u16* xb = proj;
  u16* qp = proj + (size_t)T * D;
  if (IN(6)) { pg8::Gemm g{xb, wt_q, T, 2048, D}; pg8::StaticOrder S; S.init(T, 2048, gridDim.x, blockIdx.x);
    pg8::EpiBf16S E{qp, 2048, rowss}; pg8::gemm_phase<pg8::EpiBf16S, pg8::StaticOrder>(lds, g, S, E, nullptr); }
  SEAM(6);
  if (IN(7)) topk_phase(p, qp, uinv, idx, gu, smem);
  SEAM(7);
  if (IN(8)) peer_u_phase(xb, rowss, idx, gu, U8, pw);
  SEAM(8);
  if (IN(9)) peer_v_phase(pw, V8, vinv, p.out);
}

extern "C" void kernel_launch(void* const* d_in, const int* in_sizes, int n_in, void* d_out, int out_size, void* d_ws, size_t ws_size,
                              hipStream_t stream) {
  static int grid_blocks = 0;
  if (!grid_blocks) {
    int dev = 0, cus = 0, per_cu = 0;
    (void)hipGetDevice(&dev);
    (void)hipDeviceGetAttribute(&cus, hipDeviceAttributeMultiprocessorCount, dev);
    (void)hipFuncSetAttribute((const void*)fwd_kernel, hipFuncAttributeMaxDynamicSharedMemorySize, LDS_BYTES);
    (void)hipOccupancyMaxActiveBlocksPerMultiprocessor(&per_cu, fwd_kernel, NTHREADS, LDS_BYTES);
    if (per_cu < 1) per_cu = 1;
    if (per_cu > 1) per_cu = 1;
    grid_blocks = cus * per_cu;
  }
  Params p{};
  p.x = (const float*)d_in[0]; p.norm1_g = (const float*)d_in[1]; p.w_in = (const float*)d_in[2]; p.q_norm_g = (const float*)d_in[3];
  p.k_norm_g = (const float*)d_in[4]; p.conv_w = (const float*)d_in[5]; p.sb_out_g = (const float*)d_in[6]; p.conv_out_g = (const float*)d_in[7];
  p.w_out = (const float*)d_in[8]; p.norm2_g = (const float*)d_in[9]; p.w_q = (const float*)d_in[10]; p.sub_keys = (const float*)d_in[11];
  p.peer_u = (const float*)d_in[12]; p.peer_v = (const float*)d_in[13];
  p.out = (float*)d_out; p.ws = (unsigned char*)d_ws;
  p.ph_lo = 0; p.ph_hi = NPHASE;
  (void)hipMemsetAsync((unsigned char*)d_ws + WS_CTL, 0, XCD_BAR_WORDS * 4, stream);
  void* args[] = {&p};
  hipError_t e = hipLaunchCooperativeKernel((void*)fwd_kernel, dim3(grid_blocks), dim3(NTHREADS), args, LDS_BYTES, stream);
  if (e != hipSuccess) fprintf(stderr, "cooperative launch failed: %s (grid %d)\n", hipGetErrorString(e), grid_blocks);
}
```

```cpp
#include <hip/hip_runtime.h>
#include <hip/hip_cooperative_groups.h>
#include <cstdio>
#include <cstdint>
namespace cg = cooperative_groups;

typedef unsigned short u16;
#define DI __device__ __forceinline__
#define LAS __attribute__((address_space(3)))

constexpr int T = 16384, D = 1024, SEQ = 4096;
constexpr int DIN = 3072, DSB = 512;
constexpr int NEXP = 16384;
constexpr float EPS = 1e-6f;
constexpr int NWAVES = 8, NTHREADS = NWAVES * 64;

namespace pg8 {
#define PG8_LAS __attribute__((address_space(3)))
typedef unsigned short bf16_t;
typedef short bf16x8 __attribute__((ext_vector_type(8)));
typedef float f32x4 __attribute__((ext_vector_type(4)));
typedef unsigned u32x4 __attribute__((ext_vector_type(4)));
constexpr int BM = 256, BK = 64, HALF = 128, HTB = HALF * BK * 2  , STAGE_BYTES = 8 * HTB, NXCD = 8, WGM = 8;

__host__ __device__ __forceinline__ int lds_byte(int r, int c) { const int st = (r >> 4) * 2 + (c >> 5), rr = r & 15, cc = c & 31, ob = rr * 64 + cc * 2; return st * 1024 + (ob ^ (((ob >> 9) & 1) << 5)); }
__host__ __device__ __forceinline__ void stage_rc(int b, int& R, int& C) { const int st = b / 1024, sb = b % 1024, swz = sb ^ (((sb >> 9) & 1) << 5); R = (st >> 1) * 16 + swz / 64; C = (st & 1) * 32 + (swz % 64) / 2; }
__host__ __device__ __forceinline__ int perm32(int rho) { const int n = rho >> 4, i = rho & 15; return 8 * (i >> 2) + 4 * n + (i & 3); }

struct Unit { int pm, pn; };
struct Gemm { const bf16_t* A; const bf16_t* Bt; int M, N, K; };
struct StaticOrder {
    int nM, nN, nwg, G, c;
    __host__ __device__ void init(int M, int N, int G_, int c_) { nM = M / BM; nN = N / BM; nwg = nM * nN; G = G_; c = c_; }
    __host__ __device__ bool next(int i, Unit& u) const {
        const long L = (long)i * G + c; if (L >= nwg) return false;
        int wgid = (int)L; { const int q = nwg / NXCD, r = nwg % NXCD, xcd = wgid % NXCD, off = wgid / NXCD; wgid = (xcd < r ? xcd * (q + 1) : r * (q + 1) + (xcd - r) * q) + off; }
        const int nig = WGM * nN, gid = wgid / nig, fm = gid * WGM, gsz = (nM - fm) < WGM ? (nM - fm) : WGM;
        u.pm = fm + ((wgid % nig) % gsz); u.pn = (wgid % nig) / gsz; return true;
    }
    __device__ __forceinline__ void a_ready(const Unit&) const {}
    __device__ __forceinline__ void done(const Unit&) const {}
};
__device__ __forceinline__ unsigned cvt_pk_bf16(float lo, float hi) { unsigned r; asm volatile("v_cvt_pk_bf16_f32 %0, %1, %2" : "=v"(r) : "v"(lo), "v"(hi)); return r; }

struct EpiBf16S {
    static constexpr bool PERM = true, AFTER_DRAIN = false;
    bf16_t* O; int ldc; const float* rowss;
    __device__ __forceinline__ void operator()(const f32x4 (&acc)[2][2][4][2], const Unit& u, int wr, int wc, int fr, int fq) const {
        const int row0 = u.pm * BM + wr * 64 + fr, col0 = u.pn * BM + wc * 32 + 8 * fq;
#pragma unroll
        for (int ai = 0; ai < 2; ++ai)
#pragma unroll
            for (int m = 0; m < 4; ++m) { const int row = row0 + ai * HALF + m * 16; bf16_t* rowp = O + (size_t)row * ldc + col0;
                const float sc = rowss ? rsqrtf(rowss[row] * (1.f / 1024.f) + 1e-6f) : 1.f;
#pragma unroll
                for (int bj = 0; bj < 2; ++bj) { const f32x4 v0 = acc[ai][bj][m][0] * sc, v1 = acc[ai][bj][m][1] * sc;
                    u32x4 w; w.x = cvt_pk_bf16(v0[0], v0[1]); w.y = cvt_pk_bf16(v0[2], v0[3]); w.z = cvt_pk_bf16(v1[0], v1[1]); w.w = cvt_pk_bf16(v1[2], v1[3]);
                    *(u32x4*)(rowp + bj * HALF) = w; } }
    }
};
struct EpiResid {
    static constexpr bool PERM = true, AFTER_DRAIN = false;
    const float* resid; float* out32; bf16_t* xb; float* rowss; int ldc;
    __device__ __forceinline__ void operator()(const f32x4 (&acc)[2][2][4][2], const Unit& u, int wr, int wc, int fr, int fq) const {
        const int row0 = u.pm * BM + wr * 64 + fr, col0 = u.pn * BM + wc * 32 + 8 * fq;
#pragma unroll
        for (int ai = 0; ai < 2; ++ai)
#pragma unroll
            for (int m = 0; m < 4; ++m) { const int row = row0 + ai * HALF + m * 16; const size_t off = (size_t)row * ldc + col0; float ss = 0.f;
#pragma unroll
                for (int bj = 0; bj < 2; ++bj) {
                    const f32x4 r0 = *(const f32x4*)(resid + off + bj * HALF), r1 = *(const f32x4*)(resid + off + bj * HALF + 4);
                    const f32x4 o0 = r0 + acc[ai][bj][m][0], o1 = r1 + acc[ai][bj][m][1];
                    *(f32x4*)(out32 + off + bj * HALF) = o0; *(f32x4*)(out32 + off + bj * HALF + 4) = o1;
                    ss += o0[0] * o0[0] + o0[1] * o0[1] + o0[2] * o0[2] + o0[3] * o0[3] + o1[0] * o1[0] + o1[1] * o1[1] + o1[2] * o1[2] + o1[3] * o1[3];
                    u32x4 w; w.x = cvt_pk_bf16(o0[0], o0[1]); w.y = cvt_pk_bf16(o0[2], o0[3]); w.z = cvt_pk_bf16(o1[0], o1[1]); w.w = cvt_pk_bf16(o1[2], o1[3]);
                    *(u32x4*)(xb + off + bj * HALF) = w; }
                ss += __shfl_xor(ss, 16); ss += __shfl_xor(ss, 32);
                if (fq == 0) unsafeAtomicAdd(rowss + row, ss); }
    }
};
template <class Epi, class Sched, bool STAMP = false>
__device__ __forceinline__ void gemm_phase(PG8_LAS unsigned char* lds, const Gemm g, const Sched& S, const Epi& E, unsigned long long* stamps) {
    const int tid = threadIdx.x, wid = __builtin_amdgcn_readfirstlane(tid >> 6), lane = tid & 63, wr = wid >> 2, wc = wid & 3, fr = lane & 15, fq = lane >> 4;
    const int K = g.K, nt = K / BK;
    int ts_lo = 0, ts_hi = 0, nts = 0; const unsigned long long rt_entry = STAMP ? (unsigned long long)wall_clock64() : 0ull;
#define PG8_STAMP() do { if (STAMP && wid == 0 && nts < 64) { const unsigned long long _c = (unsigned long long)clock64(); \
        ts_lo = (lane == nts) ? (int)(unsigned)_c : ts_lo; ts_hi = (lane == nts) ? (int)(unsigned)(_c >> 32) : ts_hi; ++nts; } } while (0)
    PG8_STAMP();
    unsigned voffA[2], voffB[2];
#pragma unroll
    for (int i = 0; i < 2; ++i) { int R, C; stage_rc(tid * 16 + i * 8192, R, C); const int Rb = Epi::PERM ? ((R & ~31) + perm32(R & 31)) : R;
        voffA[i] = (unsigned)(R * K + C) * 2u; voffB[i] = (unsigned)(Rb * K + C) * 2u; }
    const size_t kstep = (size_t)(BK * 2);
    const size_t hstep = (size_t)HALF * K * 2;
    const size_t tstep = 2 * hstep;
    const unsigned ldsw = (unsigned)wid * 1024u;
    const int aoff = lds_byte(wr * 64 + fr, fq * 8), boff = lds_byte(wc * 32 + fr, fq * 8);
#define PG8_SA(b, h) (((b) * 2 + (h)) * HTB)
#define PG8_SB(b, h) ((4 + (b) * 2 + (h)) * HTB)
#define PG8_STAGE(bufoff, gbase, voff) do { _Pragma("unroll") for (int _i = 0; _i < 2; ++_i) \
        __builtin_amdgcn_global_load_lds((const unsigned*)((const char*)(gbase) + (voff)[_i]), (PG8_LAS unsigned*)(lds + (bufoff) + ldsw + _i * 8192), 16, 0, 0); } while (0)
#define PG8_LDA(dst, b, h) do { _Pragma("unroll") for (int m = 0; m < 4; ++m) _Pragma("unroll") for (int k = 0; k < 2; ++k) dst[m][k] = *(const PG8_LAS bf16x8*)(lds + PG8_SA(b, h) + aoff + m * 2048 + k * 1024); } while (0)
#define PG8_LDB(dst, b, h) do { _Pragma("unroll") for (int n = 0; n < 2; ++n) _Pragma("unroll") for (int k = 0; k < 2; ++k) dst[n][k] = *(const PG8_LAS bf16x8*)(lds + PG8_SB(b, h) + boff + n * 2048 + k * 1024); } while (0)
#define PG8_MMA(ai, bj, At, Bt) do { __builtin_amdgcn_s_setprio(1); _Pragma("unroll") for (int m = 0; m < 4; ++m) _Pragma("unroll") for (int n = 0; n < 2; ++n) _Pragma("unroll") for (int k = 0; k < 2; ++k) \
        acc[ai][bj][m][n] = __builtin_amdgcn_mfma_f32_16x16x32_bf16(Bt[n][k], At[m][k], acc[ai][bj][m][n], 0, 0, 0); __builtin_amdgcn_s_setprio(0); } while (0)
#define PG8_WAIT_V(n) asm volatile("s_waitcnt vmcnt(" #n ")" ::: "memory")
#define PG8_WAIT_L(n) asm volatile("s_waitcnt lgkmcnt(" #n ")" ::: "memory")
#define PG8_BAR __builtin_amdgcn_s_barrier()
#define PG8_SCHED __builtin_amdgcn_sched_barrier(0)
    Unit cur, nxt; int ui = 0;
    if (!S.next(0, cur)) return;
    f32x4 acc[2][2][4][2];
#pragma unroll
    for (int a = 0; a < 2; ++a)
#pragma unroll
        for (int b = 0; b < 2; ++b)
#pragma unroll
            for (int m = 0; m < 4; ++m)
#pragma unroll
                for (int n = 0; n < 2; ++n) acc[a][b][m][n] = (f32x4){0.f, 0.f, 0.f, 0.f};
    bf16x8 At[4][2], B0[2][2], B1[2][2];
    const char* cA = (const char*)g.A + (size_t)cur.pm * tstep; const char* cB = (const char*)g.Bt + (size_t)cur.pn * tstep;
    S.a_ready(cur);
    PG8_STAGE(PG8_SB(0, 0), cB, voffB); PG8_STAGE(PG8_SA(0, 0), cA, voffA); PG8_STAGE(PG8_SB(0, 1), cB + hstep, voffB); PG8_STAGE(PG8_SA(0, 1), cA + hstep, voffA);
    if (wr == 1) PG8_BAR;
    PG8_WAIT_V(4); PG8_BAR;
    PG8_STAGE(PG8_SB(1, 0), cB + kstep, voffB); PG8_STAGE(PG8_SA(1, 0), cA + kstep, voffA); PG8_STAGE(PG8_SB(1, 1), cB + hstep + kstep, voffB);
    PG8_WAIT_V(6); PG8_BAR;
    PG8_STAMP();
    for (;;) {
        const bool has_next = S.next(ui + 1, nxt);
        const char* nA = has_next ? (const char*)g.A + (size_t)nxt.pm * tstep : cA; const char* nB = has_next ? (const char*)g.Bt + (size_t)nxt.pn * tstep : cB;
        for (int t = 0; t < nt; t += 2) {
            const bool last = (t == nt - 2);
            const char* a1 = cA + (size_t)(t + 1) * kstep;
            const char* a2 = last ? nA : cA + (size_t)(t + 2) * kstep; const char* b2 = last ? nB : cB + (size_t)(t + 2) * kstep;
            const char* a3 = a2 + kstep; const char* b3 = b2 + kstep;
            if (last && has_next) S.a_ready(nxt);
            PG8_LDB(B0, 0, 0); PG8_SCHED; PG8_LDA(At, 0, 0); PG8_STAGE(PG8_SA(1, 1), a1 + hstep, voffA);
            PG8_WAIT_L(8); PG8_BAR; PG8_WAIT_L(0); PG8_MMA(0, 0, At, B0); PG8_BAR; PG8_SCHED;
            PG8_LDB(B1, 0, 1); PG8_STAGE(PG8_SB(0, 0), b2, voffB);
            PG8_BAR; PG8_WAIT_L(0); PG8_MMA(0, 1, At, B1); PG8_BAR;
            PG8_LDA(At, 0, 1); PG8_STAGE(PG8_SA(0, 0), a2, voffA);
            PG8_BAR; PG8_WAIT_L(0); PG8_MMA(1, 0, At, B0); PG8_BAR; PG8_SCHED;
            PG8_STAGE(PG8_SB(0, 1), b2 + hstep, voffB);
            PG8_WAIT_V(6); PG8_BAR; PG8_MMA(1, 1, At, B1); PG8_BAR;
            PG8_LDB(B0, 1, 0); PG8_SCHED; PG8_LDA(At, 1, 0); PG8_STAGE(PG8_SA(0, 1), a2 + hstep, voffA);
            PG8_WAIT_L(8); PG8_BAR; PG8_WAIT_L(0); PG8_MMA(0, 0, At, B0); PG8_BAR; PG8_SCHED;
            PG8_LDB(B1, 1, 1); PG8_STAGE(PG8_SB(1, 0), b3, voffB);
            PG8_BAR; PG8_WAIT_L(0); PG8_MMA(0, 1, At, B1); PG8_BAR;
            PG8_LDA(At, 1, 1); PG8_STAGE(PG8_SA(1, 0), a3, voffA);
            PG8_BAR; PG8_WAIT_L(0); PG8_MMA(1, 0, At, B0); PG8_BAR; PG8_SCHED;
            PG8_STAGE(PG8_SB(1, 1), b3 + hstep, voffB);
            PG8_WAIT_V(6); PG8_BAR; PG8_MMA(1, 1, At, B1); PG8_BAR;
        }
        PG8_STAMP();
        if constexpr (!Epi::AFTER_DRAIN) { E(acc, cur, wr, wc, fr, fq); S.done(cur); }
        PG8_STAMP();
        if (!has_next) break;
#pragma unroll
        for (int a = 0; a < 2; ++a)
#pragma unroll
            for (int b = 0; b < 2; ++b)
#pragma unroll
                for (int m = 0; m < 4; ++m)
#pragma unroll
                    for (int n = 0; n < 2; ++n) acc[a][b][m][n] = (f32x4){0.f, 0.f, 0.f, 0.f};
        cur = nxt; cA = nA; cB = nB; ++ui;
    }
    PG8_WAIT_V(0);
    if (wr == 0) PG8_BAR;
    PG8_BAR;
    if constexpr (Epi::AFTER_DRAIN) { E.fused(acc, cur, wr, wc, fr, fq, lds, wid, lane); S.done(cur); }
    PG8_STAMP();
    if (STAMP && wid == 0) { stamps[lane] = lane < nts ? (((unsigned long long)(unsigned)ts_hi << 32) | (unsigned)ts_lo) : 0ull;
        if (lane == 62) stamps[62] = rt_entry; if (lane == 63) stamps[63] = (unsigned long long)wall_clock64(); }
#undef PG8_STAMP
#undef PG8_SA
#undef PG8_SB
#undef PG8_STAGE
#undef PG8_LDA
#undef PG8_LDB
#undef PG8_MMA
#undef PG8_WAIT_V
#undef PG8_WAIT_L
#undef PG8_BAR
#undef PG8_SCHED
}
}


constexpr size_t MBy = 1u << 20;
constexpr size_t WS_WTIN = 0, WS_WTOUT = 6 * MBy, WS_WTQ = 8 * MBy, WS_CTL = 12 * MBy, WS_ROWSS = 12 * MBy + 65536, WS_ACT = 13 * MBy, WS_PROJ = 45 * MBy,
                 WS_SB = 141 * MBy, WS_IDX = 173 * MBy, WS_GATE = 181 * MBy, WS_U8 = 189 * MBy, WS_V8 = 205 * MBy, WS_PW = 221 * MBy,
                 WS_UINV = 12 * MBy + 262144, WS_VINV = 12 * MBy + 393216;
constexpr int LDS_MISC = pg8::STAGE_BYTES, LDS_BYTES = pg8::STAGE_BYTES + 256;

struct Params {
  const float *x, *norm1_g, *w_in, *q_norm_g, *k_norm_g, *conv_w, *sb_out_g, *conv_out_g, *w_out, *norm2_g, *w_q, *sub_keys, *peer_u, *peer_v;
  float* out; unsigned char* ws; int ph_lo, ph_hi;
};

#define XB_TMO      128
#define XB_XCNT(j)  (256  + 64 * (j))
#define XB_XSUB(j)  (1280 + 64 * (j))
#define XB_XGEN(j)  (2304 + 64 * (j))
#define XB_TOP      3328
#define XB_TOPGEN   3392
#define XCD_BAR_WORDS 3456
#define XB_SPIN_CAP (1u << 18)
DI unsigned xb_ld(unsigned* p) { return __hip_atomic_load(p, __ATOMIC_RELAXED, __HIP_MEMORY_SCOPE_AGENT); }
DI unsigned xb_add(unsigned* p, unsigned v) { return __hip_atomic_fetch_add(p, v, __ATOMIC_RELAXED, __HIP_MEMORY_SCOPE_AGENT); }
DI unsigned xb_xcc_id() { return (unsigned)__builtin_amdgcn_s_getreg((3 << 11) | 20) & 0xFu; }
#define XB_SPIN(cond, bar) do { unsigned _sp = 0; while (cond) { __builtin_amdgcn_s_sleep(1); \
    if ((++_sp & 255u) == 0u) { if (xb_ld(&(bar)[XB_TMO])) break; if (_sp > XB_SPIN_CAP) { atomicAdd(&(bar)[XB_TMO], 1u); break; } } } } while (0)
struct XcdBarrier { unsigned* bar; unsigned x; volatile LAS unsigned* st; };
DI XcdBarrier xcd_barrier_post(unsigned* bar, volatile LAS unsigned* st) {
  XcdBarrier b; b.bar = bar; b.x = xb_xcc_id(); b.st = st;
  if (threadIdx.x == 0) (void)xb_add(&bar[XB_XCNT(b.x)], 1u);
  return b;
}
DI void xcd_barrier_complete(unsigned* bar, unsigned x, unsigned& nloc, unsigned& nx) {
  const unsigned G = gridDim.x * gridDim.y * gridDim.z;
  unsigned sum, cnt, mine, sp = 0u;
  for (;;) {
    sum = 0u; cnt = 0u; mine = 0u;
#pragma unroll
    for (unsigned j = 0; j < 16; ++j) { const unsigned c = xb_ld(&bar[XB_XCNT(j)]); sum += c; cnt += (c > 0u) ? 1u : 0u; mine = (j == x) ? c : mine; }
    if (sum == G) break;
    __builtin_amdgcn_s_sleep(1);
    if ((++sp & 255u) == 0u) { if (xb_ld(&bar[XB_TMO])) break; if (sp > XB_SPIN_CAP) { atomicAdd(&bar[XB_TMO], 1u); break; } }
  }
  nloc = mine > 0u ? mine : 1u; nx = cnt > 0u ? cnt : 1u;
}
DI void xcd_barrier(const XcdBarrier& b) {
  asm volatile("s_waitcnt vmcnt(0)" ::: "memory");
  __syncthreads();
  if (threadIdx.x == 0) {
    unsigned* bar = b.bar;
    __builtin_amdgcn_s_waitcnt(0);
    unsigned nloc = b.st[0], nx = b.st[1];
    if (nloc == 0u) { xcd_barrier_complete(bar, b.x, nloc, nx); b.st[0] = nloc; b.st[1] = nx; }
    const unsigned old = xb_add(&bar[XB_XSUB(b.x)], 1u);
    const unsigned gen = old / nloc;
    if (old + 1u == (gen + 1u) * nloc) {
      __builtin_amdgcn_fence(__ATOMIC_RELEASE, "agent");
      asm volatile("s_waitcnt vmcnt(0)" ::: "memory");
      const unsigned og = xb_add(&bar[XB_TOP], 1u);
      const unsigned tg = og / nx;
      if (og + 1u == (tg + 1u) * nx) xb_add(&bar[XB_TOPGEN], 1u);
      else XB_SPIN(xb_ld(&bar[XB_TOPGEN]) == tg, bar);
      __builtin_amdgcn_fence(__ATOMIC_ACQUIRE, "agent");
      xb_add(&bar[XB_XGEN(b.x)], 1u);
      asm volatile("s_waitcnt vmcnt(0)" ::: "memory");
    } else {
      XB_SPIN(xb_ld(&bar[XB_XGEN(b.x)]) == gen, bar);
      __builtin_amdgcn_fence(__ATOMIC_ACQUIRE, "agent");
      asm volatile("s_waitcnt vmcnt(0)" ::: "memory");
    }
  }
  __syncthreads();
}

DI u16 f2bf(float x) { unsigned u = __float_as_uint(x); u += 0x7fffu + ((u >> 16) & 1u); return (u16)(u >> 16); }
DI float bflo(unsigned w) { return __uint_as_float(w << 16); }
DI float bfhi(unsigned w) { return __uint_as_float(w & 0xffff0000u); }
DI unsigned pack2(float a, float b) { return (unsigned)f2bf(a) | ((unsigned)f2bf(b) << 16); }
DI float wave_sum(float v) {
#pragma unroll
  for (int o = 32; o >= 1; o >>= 1) v += __shfl_xor(v, o);
  return v;
}
DI float wave_max(float v) {
#pragma unroll
  for (int o = 32; o >= 1; o >>= 1) v = fmaxf(v, __shfl_xor(v, o));
  return v;
}
DI void unpack8(const uint4 w, float* f) {
  f[0] = bflo(w.x); f[1] = bfhi(w.x); f[2] = bflo(w.y); f[3] = bfhi(w.y); f[4] = bflo(w.z); f[5] = bfhi(w.z); f[6] = bflo(w.w); f[7] = bfhi(w.w);
}
DI uint4 pack8(const float* f) { uint4 o; o.x = pack2(f[0], f[1]); o.y = pack2(f[2], f[3]); o.z = pack2(f[4], f[5]); o.w = pack2(f[6], f[7]); return o; }

DI void transpose_convert(const float* __restrict__ W, u16* __restrict__ Wt, int K, int N, const float* __restrict__ rg, float* sm) {
  const int tid = threadIdx.x, tn_cnt = N / 64, ntile = (K / 64) * tn_cnt;
  for (int tile = blockIdx.x; tile < ntile; tile += gridDim.x) {
    const int tk = tile / tn_cnt, tn = tile % tn_cnt;
    __syncthreads();
#pragma unroll
    for (int r = 0; r < 8; ++r) { const int row = r * 8 + (tid >> 6), col = tid & 63;
      const float g = rg ? rg[tk * 64 + row] : 1.f;
      sm[row * 65 + col] = W[(size_t)(tk * 64 + row) * N + tn * 64 + col] * g; }
    __syncthreads();
#pragma unroll
    for (int r = 0; r < 8; ++r) { const int nrow = r * 8 + (tid >> 6), kcol = tid & 63; Wt[(size_t)(tn * 64 + nrow) * K + tk * 64 + kcol] = f2bf(sm[kcol * 65 + nrow]); }
  }
}
template <bool SLICED>
DI void convert_fp8_rows(const float* __restrict__ src, const float* __restrict__ cg, unsigned char* __restrict__ dst, float* __restrict__ inv_out) {
  const int lane = threadIdx.x & 63, gw = blockIdx.x * NWAVES + (threadIdx.x >> 6), nw = gridDim.x * NWAVES;
  float g[16];
#pragma unroll
  for (int j = 0; j < 16; ++j) g[j] = cg ? cg[16 * lane + j] : 1.f;
  for (int row = gw; row < NEXP; row += nw) {
    const float4* s = (const float4*)(src + (size_t)row * D + 16 * lane);
    float v[16];
#pragma unroll
    for (int k = 0; k < 4; ++k) { const float4 a = s[k]; v[4 * k] = a.x * g[4 * k]; v[4 * k + 1] = a.y * g[4 * k + 1]; v[4 * k + 2] = a.z * g[4 * k + 2]; v[4 * k + 3] = a.w * g[4 * k + 3]; }
    float am = 0.f;
#pragma unroll
    for (int j = 0; j < 16; ++j) am = fmaxf(am, fabsf(v[j]));
    am = wave_max(am);
    const float sc = am > 0.f ? 240.f / am : 1.f;
    uint4 o;
    { int w;
      w = __builtin_amdgcn_cvt_pk_fp8_f32(v[0] * sc, v[1] * sc, 0, false); w = __builtin_amdgcn_cvt_pk_fp8_f32(v[2] * sc, v[3] * sc, w, true); o.x = (unsigned)w;
      w = __builtin_amdgcn_cvt_pk_fp8_f32(v[4] * sc, v[5] * sc, 0, false); w = __builtin_amdgcn_cvt_pk_fp8_f32(v[6] * sc, v[7] * sc, w, true); o.y = (unsigned)w;
      w = __builtin_amdgcn_cvt_pk_fp8_f32(v[8] * sc, v[9] * sc, 0, false); w = __builtin_amdgcn_cvt_pk_fp8_f32(v[10] * sc, v[11] * sc, w, true); o.z = (unsigned)w;
      w = __builtin_amdgcn_cvt_pk_fp8_f32(v[12] * sc, v[13] * sc, 0, false); w = __builtin_amdgcn_cvt_pk_fp8_f32(v[14] * sc, v[15] * sc, w, true); o.w = (unsigned)w; }
    if (SLICED) *(uint4*)(dst + (size_t)(lane >> 3) * ((size_t)NEXP * 128) + (size_t)row * 128 + 16 * (lane & 7)) = o;
    else *(uint4*)(dst + (size_t)row * D + 16 * lane) = o;
    if (lane == 0) inv_out[row] = am > 0.f ? am * (1.f / 240.f) : 1.f;
  }
}
DI void rmsnorm1024(const float* __restrict__ src, const float* __restrict__ g, u16* __restrict__ dst) {
  const int lane = threadIdx.x & 63, gw = blockIdx.x * NWAVES + (threadIdx.x >> 6), nw = gridDim.x * NWAVES;
  for (int row = gw; row < T; row += nw) {
    const float4* xr = (const float4*)(src + (size_t)row * D);
    float4 v[4]; float ss = 0.f;
#pragma unroll
    for (int j = 0; j < 4; ++j) { v[j] = xr[lane + 64 * j]; ss += v[j].x * v[j].x + v[j].y * v[j].y + v[j].z * v[j].z + v[j].w * v[j].w; }
    ss = wave_sum(ss);
    const float inv = rsqrtf(ss * (1.f / D) + EPS);
#pragma unroll
    for (int j = 0; j < 4; ++j) {
      const float4 gg = ((const float4*)g)[lane + 64 * j];
      uint2 o; o.x = pack2(v[j].x * inv * gg.x, v[j].y * inv * gg.y); o.y = pack2(v[j].z * inv * gg.z, v[j].w * inv * gg.w);
      *(uint2*)(dst + (size_t)row * D + 4 * (lane + 64 * j)) = o;
    }
  }
}

constexpr int VTP = 1028;
DI void postproj_phase(const Params& p, u16* __restrict__ proj, u16* __restrict__ mixed, u16* __restrict__ vt, unsigned char* smem) {
  const int lane = threadIdx.x & 63, wave = threadIdx.x >> 6;
  LAS unsigned char* tile = (LAS unsigned char*)smem;
  for (int chunk = blockIdx.x; chunk < T / 64; chunk += gridDim.x) {
    __syncthreads();
    for (int i = 0; i < 8; ++i) {
      const int tl = wave * 8 + i, t = chunk * 64 + tl;
      u16* row = proj + (size_t)t * DIN;
#pragma unroll
      for (int which = 0; which < 2; ++which) {
        float f[8]; unpack8(*(const uint4*)(row + which * 512 + 8 * lane), f);
        float ss = 0.f;
#pragma unroll
        for (int j = 0; j < 8; ++j) ss += f[j] * f[j];
        ss += __shfl_xor(ss, 1); ss += __shfl_xor(ss, 2); ss += __shfl_xor(ss, 4);
        const float inv = rsqrtf(ss * (1.f / 64.f) + EPS);
        const float* g = (which == 0 ? p.q_norm_g : p.k_norm_g) + 8 * (lane & 7);
#pragma unroll
        for (int j = 0; j < 8; ++j) f[j] = f[j] * inv * g[j];
        *(uint4*)(row + which * 512 + 8 * lane) = pack8(f);
      }
      { const uint4 v = *(const uint4*)(row + 1024 + 8 * lane);
        LAS unsigned* d = (LAS unsigned*)(tile + tl * VTP + 16 * lane); d[0] = v.x; d[1] = v.y; d[2] = v.z; d[3] = v.w; }
      const int c0 = 8 * lane, tpos = t & (SEQ - 1);
      float xc[8], bg[8], cg[8], y[8];
      unpack8(*(const uint4*)(row + 1536 + c0), xc); unpack8(*(const uint4*)(row + 2048 + c0), bg); unpack8(*(const uint4*)(row + 2560 + c0), cg);
#pragma unroll
      for (int j = 0; j < 8; ++j) y[j] = p.conv_w[2 * DSB + c0 + j] * (cg[j] * xc[j]);
      if (tpos >= 1) {
        float x1[8], c1[8]; unpack8(*(const uint4*)(row - DIN + 1536 + c0), x1); unpack8(*(const uint4*)(row - DIN + 2560 + c0), c1);
#pragma unroll
        for (int j = 0; j < 8; ++j) y[j] += p.conv_w[1 * DSB + c0 + j] * (c1[j] * x1[j]);
      }
      if (tpos >= 2) {
        float x2[8], c2[8]; unpack8(*(const uint4*)(row - 2 * DIN + 1536 + c0), x2); unpack8(*(const uint4*)(row - 2 * DIN + 2560 + c0), c2);
#pragma unroll
        for (int j = 0; j < 8; ++j) y[j] += p.conv_w[0 * DSB + c0 + j] * (c2[j] * x2[j]);
      }
      float ss = 0.f;
#pragma unroll
      for (int j = 0; j < 8; ++j) { y[j] *= bg[j]; ss += y[j] * y[j]; }
      ss = wave_sum(ss);
      const float inv = rsqrtf(ss * (1.f / DSB) + EPS);
#pragma unroll
      for (int j = 0; j < 8; ++j) y[j] = y[j] * inv * p.conv_out_g[c0 + j];
      *(uint4*)(mixed + (size_t)t * D + DSB + c0) = pack8(y);
    }
    __syncthreads();
    const int dg = lane >> 3, tg = lane & 7, bb = (chunk * 64) / SEQ, tp0 = (chunk * 64) & (SEQ - 1);
#pragma unroll
    for (int it = 0; it < 8; ++it) {
      const int d = it * 64 + wave * 8 + dg;
      unsigned w[4];
#pragma unroll
      for (int k = 0; k < 4; ++k) {
        const unsigned lo = *(const LAS u16*)(tile + (tg * 8 + 2 * k) * VTP + 2 * d), hi = *(const LAS u16*)(tile + (tg * 8 + 2 * k + 1) * VTP + 2 * d);
        w[k] = lo | (hi << 16);
      }
      *(uint4*)(vt + ((size_t)(bb * 512 + d)) * SEQ + tp0 + tg * 8) = make_uint4(w[0], w[1], w[2], w[3]);
    }
  }
}

typedef float f32x16_t __attribute__((ext_vector_type(16)));
typedef short bf16x8_t __attribute__((ext_vector_type(8)));
DI bf16x8_t pack_bf16x8(float a0, float a1, float a2, float a3, float a4, float a5, float a6, float a7) {
  pg8::u32x4 r;
  asm volatile("v_cvt_pk_bf16_f32 %0, %4, %5\n\tv_cvt_pk_bf16_f32 %1, %6, %7\n\tv_cvt_pk_bf16_f32 %2, %8, %9\n\tv_cvt_pk_bf16_f32 %3, %10, %11\n\ts_nop 1"
               : "=&v"(r[0]), "=&v"(r[1]), "=&v"(r[2]), "=&v"(r[3]) : "v"(a0), "v"(a1), "v"(a2), "v"(a3), "v"(a4), "v"(a5), "v"(a6), "v"(a7));
  return __builtin_bit_cast(bf16x8_t, r);
}
template <bool DIAG>
DI void attn_tile(const u16* __restrict__ kr, const u16* __restrict__ vr, const bf16x8_t (&qf)[4], int c, int hh, float& carry, f32x16_t& o0, f32x16_t& o1) {
  f32x16_t s;
#pragma unroll
  for (int r = 0; r < 16; ++r) s[r] = 0.f;
#pragma unroll
  for (int ks = 0; ks < 4; ++ks) s = __builtin_amdgcn_mfma_f32_32x32x16_bf16(*(const bf16x8_t*)(kr + 16 * ks), qf[ks], s, 0, 0, 0);
  const bf16x8_t v00 = *(const bf16x8_t*)(vr), v01 = *(const bf16x8_t*)(vr + 8), v10 = *(const bf16x8_t*)(vr + 32 * SEQ), v11 = *(const bf16x8_t*)(vr + 32 * SEQ + 8);
  float rr[16], be[16];
#pragma unroll
  for (int r = 0; r < 16; ++r) {
    const float e = __builtin_amdgcn_exp2f(fminf(s[r] * 0.18033688011112042f, 100.f));
    float x = __builtin_amdgcn_rcpf(1.f + e), b = e * x;
    if (DIAG) { const bool on = (16 * hh + r) < c; x = on ? x : 1.f; b = on ? b : 0.f; }
    rr[r] = x; be[r] = b;
  }
  float tot = ((rr[0] * rr[1]) * (rr[2] * rr[3])) * ((rr[4] * rr[5]) * (rr[6] * rr[7]));
  tot *= ((rr[8] * rr[9]) * (rr[10] * rr[11])) * ((rr[12] * rr[13]) * (rr[14] * rr[15]));
  const float oth = __shfl_xor(tot, 32);
  float P = hh ? carry : carry * oth;
  float a[16];
#pragma unroll
  for (int r = 15; r >= 0; --r) { a[r] = be[r] * P; P *= rr[r]; }
  carry = carry * tot * oth;
  const bf16x8_t af0 = pack_bf16x8(a[0], a[1], a[2], a[3], a[4], a[5], a[6], a[7]), af1 = pack_bf16x8(a[8], a[9], a[10], a[11], a[12], a[13], a[14], a[15]);
  o0 = __builtin_amdgcn_mfma_f32_32x32x16_bf16(v00, af0, o0, 0, 0, 0); o0 = __builtin_amdgcn_mfma_f32_32x32x16_bf16(v01, af1, o0, 0, 0, 0);
  o1 = __builtin_amdgcn_mfma_f32_32x32x16_bf16(v10, af0, o1, 0, 0, 0); o1 = __builtin_amdgcn_mfma_f32_32x32x16_bf16(v11, af1, o1, 0, 0, 0);
}
DI void attn_phase(const Params& p, const u16* __restrict__ proj, const u16* __restrict__ vt, u16* __restrict__ mixed, unsigned char* smem) {
  const int lane = threadIdx.x & 63, head = threadIdx.x >> 6, c = lane & 31, hh = lane >> 5;
  LAS float* red = (LAS float*)smem;
  const int kap = 16 * ((c >> 2) & 1) + (c & 3) + 4 * (c >> 3);
  for (int item = blockIdx.x; item < 4 * 128; item += gridDim.x) {
    const int b = item & 3, q0 = (127 - (item >> 2)) * 32;
    const size_t tq = (size_t)b * SEQ + q0 + c;
    bf16x8_t qf[4];
#pragma unroll
    for (int ks = 0; ks < 4; ++ks) qf[ks] = *(const bf16x8_t*)(proj + tq * DIN + head * 64 + 16 * ks + 8 * hh);
    f32x16_t o0, o1;
#pragma unroll
    for (int r = 0; r < 16; ++r) { o0[r] = 0.f; o1[r] = 0.f; }
    float carry = 1.f;
    const u16* kbase = proj + ((size_t)b * SEQ + kap) * DIN + 512 + head * 64 + 8 * hh;
    const u16* vbase = vt + ((size_t)(b * 512 + head * 64 + c)) * SEQ + 16 * hh;
    attn_tile<true>(kbase + (size_t)q0 * DIN, vbase + q0, qf, c, hh, carry, o0, o1);
    for (int tb = q0 - 32; tb >= 0; tb -= 32) {
      attn_tile<false>(kbase + (size_t)tb * DIN, vbase + tb, qf, c, hh, carry, o0, o1);
      if (__all(carry == 0.f)) break;
    }
    float ss = 0.f;
#pragma unroll
    for (int r = 0; r < 16; ++r) ss += o0[r] * o0[r] + o1[r] * o1[r];
    ss += __shfl_xor(ss, 32);
    __syncthreads();
    if (hh == 0) red[head * 32 + c] = ss;
    __syncthreads();
    float tot = 0.f;
#pragma unroll
    for (int h8 = 0; h8 < 8; ++h8) tot += red[h8 * 32 + c];
    const float inv = rsqrtf(tot * (1.f / DSB) + EPS);
    u16* orow = mixed + tq * D + head * 64 + 4 * hh;
    const float* g = p.sb_out_g + head * 64 + 4 * hh;
#pragma unroll
    for (int rg = 0; rg < 4; ++rg) {
      const float4 g0 = *(const float4*)(g + 8 * rg), g1 = *(const float4*)(g + 32 + 8 * rg);
      uint2 w0, w1;
      w0.x = pack2(o0[4 * rg] * inv * g0.x, o0[4 * rg + 1] * inv * g0.y); w0.y = pack2(o0[4 * rg + 2] * inv * g0.z, o0[4 * rg + 3] * inv * g0.w);
      w1.x = pack2(o1[4 * rg] * inv * g1.x, o1[4 * rg + 1] * inv * g1.y); w1.y = pack2(o1[4 * rg + 2] * inv * g1.z, o1[4 * rg + 3] * inv * g1.w);
      *(uint2*)(orow + 8 * rg) = w0; *(uint2*)(orow + 32 + 8 * rg) = w1;
    }
  }
}

#define SEL_DI DI
#define SEL_F2U(x) __float_as_uint(x)
#define SEL_U2F(x) __uint_as_float(x)

#define CE(a, b) do { const unsigned _h = (a) > (b) ? (a) : (b), _l = (a) > (b) ? (b) : (a); (a) = _h; (b) = _l; } while (0)
SEL_DI void sort16(unsigned (&v)[16]) {
  CE(v[0], v[1]); CE(v[2], v[3]); CE(v[0], v[2]); CE(v[1], v[3]); CE(v[1], v[2]); CE(v[4], v[5]); CE(v[6], v[7]); CE(v[4], v[6]);
  CE(v[5], v[7]); CE(v[5], v[6]); CE(v[0], v[4]); CE(v[2], v[6]); CE(v[2], v[4]); CE(v[1], v[5]); CE(v[3], v[7]); CE(v[3], v[5]);
  CE(v[1], v[2]); CE(v[3], v[4]); CE(v[5], v[6]); CE(v[8], v[9]); CE(v[10], v[11]); CE(v[8], v[10]); CE(v[9], v[11]); CE(v[9], v[10]);
  CE(v[12], v[13]); CE(v[14], v[15]); CE(v[12], v[14]); CE(v[13], v[15]); CE(v[13], v[14]); CE(v[8], v[12]); CE(v[10], v[14]); CE(v[10], v[12]);
  CE(v[9], v[13]); CE(v[11], v[15]); CE(v[11], v[13]); CE(v[9], v[10]); CE(v[11], v[12]); CE(v[13], v[14]); CE(v[0], v[8]); CE(v[4], v[12]);
  CE(v[4], v[8]); CE(v[2], v[10]); CE(v[6], v[14]); CE(v[6], v[10]); CE(v[2], v[4]); CE(v[6], v[8]); CE(v[10], v[12]); CE(v[1], v[9]);
  CE(v[5], v[13]); CE(v[5], v[9]); CE(v[3], v[11]); CE(v[7], v[15]); CE(v[7], v[11]); CE(v[3], v[5]); CE(v[7], v[9]); CE(v[11], v[13]);
  CE(v[1], v[2]); CE(v[3], v[4]); CE(v[5], v[6]); CE(v[7], v[8]); CE(v[9], v[10]); CE(v[11], v[12]); CE(v[13], v[14]);
}
SEL_DI void bitonic_merge16(unsigned (&v)[16]) {
#pragma unroll
  for (int d = 8; d >= 1; d >>= 1)
#pragma unroll
    for (int i = 0; i < 16; ++i) if ((i & d) == 0) CE(v[i], v[i + d]);
}
SEL_DI void merge_top16(unsigned (&a)[16], const unsigned (&b)[16]) {
#pragma unroll
  for (int i = 0; i < 16; ++i) a[i] = a[i] > b[15 - i] ? a[i] : b[15 - i];
  bitonic_merge16(a);
}
SEL_DI void top16_of_64(unsigned (&g0)[16], unsigned (&g1)[16], unsigned (&g2)[16], unsigned (&g3)[16]) {
  sort16(g0); sort16(g1); sort16(g2); sort16(g3);
  merge_top16(g0, g1); merge_top16(g2, g3); merge_top16(g0, g2);
}
SEL_DI unsigned cand_key(float a, float b, unsigned payload) {
  float s = a + b; s = s < 32.0f ? 32.0f : (s > 127.99f ? 127.99f : s);
  return ((SEL_F2U(s) << 8) & 0xFFFFC000u) | payload;
}
SEL_DI void stage2(const unsigned (&L1)[16], const unsigned (&L2)[16], unsigned (&R)[16]) {
  float f1[16], f2m[16]; unsigned P1[16], P2[16];
#pragma unroll
  for (int i = 0; i < 16; ++i) { f1[i] = SEL_U2F(L1[i] & ~127u); f2m[i] = SEL_U2F(L2[i] & ~127u) - 64.0f; P1[i] = (L1[i] & 127u) << 7; P2[i] = L2[i] & 127u; }
  unsigned K[64];
  K[0] = cand_key(f1[0], f2m[0], P1[0] | P2[0]);
  K[1] = cand_key(f1[0], f2m[1], P1[0] | P2[1]);
  K[2] = cand_key(f1[0], f2m[2], P1[0] | P2[2]);
  K[3] = cand_key(f1[0], f2m[3], P1[0] | P2[3]);
  K[4] = cand_key(f1[0], f2m[4], P1[0] | P2[4]);
  K[5] = cand_key(f1[0], f2m[5], P1[0] | P2[5]);
  K[6] = cand_key(f1[0], f2m[6], P1[0] | P2[6]);
  K[7] = cand_key(f1[0], f2m[7], P1[0] | P2[7]);
  K[8] = cand_key(f1[0], f2m[8], P1[0] | P2[8]);
  K[9] = cand_key(f1[0], f2m[9], P1[0] | P2[9]);
  K[10] = cand_key(f1[0], f2m[10], P1[0] | P2[10]);
  K[11] = cand_key(f1[0], f2m[11], P1[0] | P2[11]);
  K[12] = cand_key(f1[0], f2m[12], P1[0] | P2[12]);
  K[13] = cand_key(f1[0], f2m[13], P1[0] | P2[13]);
  K[14] = cand_key(f1[0], f2m[14], P1[0] | P2[14]);
  K[15] = cand_key(f1[0], f2m[15], P1[0] | P2[15]);
  K[16] = cand_key(f1[1], f2m[0], P1[1] | P2[0]);
  K[17] = cand_key(f1[1], f2m[1], P1[1] | P2[1]);
  K[18] = cand_key(f1[1], f2m[2], P1[1] | P2[2]);
  K[19] = cand_key(f1[1], f2m[3], P1[1] | P2[3]);
  K[20] = cand_key(f1[1], f2m[4], P1[1] | P2[4]);
  K[21] = cand_key(f1[1], f2m[5], P1[1] | P2[5]);
  K[22] = cand_key(f1[1], f2m[6], P1[1] | P2[6]);
  K[23] = cand_key(f1[1], f2m[7], P1[1] | P2[7]);
  K[24] = cand_key(f1[2], f2m[0], P1[2] | P2[0]);
  K[25] = cand_key(f1[2], f2m[1], P1[2] | P2[1]);
  K[26] = cand_key(f1[2], f2m[2], P1[2] | P2[2]);
  K[27] = cand_key(f1[2], f2m[3], P1[2] | P2[3]);
  K[28] = cand_key(f1[2], f2m[4], P1[2] | P2[4]);
  K[29] = cand_key(f1[3], f2m[0], P1[3] | P2[0]);
  K[30] = cand_key(f1[3], f2m[1], P1[3] | P2[1]);
  K[31] = cand_key(f1[3], f2m[2], P1[3] | P2[2]);
  K[32] = cand_key(f1[3], f2m[3], P1[3] | P2[3]);
  K[33] = cand_key(f1[4], f2m[0], P1[4] | P2[0]);
  K[34] = cand_key(f1[4], f2m[1], P1[4] | P2[1]);
  K[35] = cand_key(f1[4], f2m[2], P1[4] | P2[2]);
  K[36] = cand_key(f1[5], f2m[0], P1[5] | P2[0]);
  K[37] = cand_key(f1[5], f2m[1], P1[5] | P2[1]);
  K[38] = cand_key(f1[6], f2m[0], P1[6] | P2[0]);
  K[39] = cand_key(f1[6], f2m[1], P1[6] | P2[1]);
  K[40] = cand_key(f1[7], f2m[0], P1[7] | P2[0]);
  K[41] = cand_key(f1[7], f2m[1], P1[7] | P2[1]);
  K[42] = cand_key(f1[8], f2m[0], P1[8] | P2[0]);
  K[43] = cand_key(f1[9], f2m[0], P1[9] | P2[0]);
  K[44] = cand_key(f1[10], f2m[0], P1[10] | P2[0]);
  K[45] = cand_key(f1[11], f2m[0], P1[11] | P2[0]);
  K[46] = cand_key(f1[12], f2m[0], P1[12] | P2[0]);
  K[47] = cand_key(f1[13], f2m[0], P1[13] | P2[0]);
  K[48] = cand_key(f1[14], f2m[0], P1[14] | P2[0]);
  K[49] = cand_key(f1[15], f2m[0], P1[15] | P2[0]);
#pragma unroll
  for (int c = 50; c < 64; ++c) K[c] = 0u;
  unsigned g1[16], g2[16], g3[16];
#pragma unroll
  for (int i = 0; i < 16; ++i) { R[i] = K[i]; g1[i] = K[16 + i]; g2[i] = K[32 + i]; g3[i] = K[48 + i]; }
  sort16(R); sort16(g1); sort16(g2); CE(g3[0], g3[1]);
  merge_top16(R, g1);
  g2[15] = g2[15] > g3[0] ? g2[15] : g3[0]; g2[14] = g2[14] > g3[1] ? g2[14] : g3[1];
  bitonic_merge16(g2);
  merge_top16(R, g2);
}

constexpr int SKP = 272;
DI void stage1(const u16* __restrict__ qrow, const LAS unsigned char* sk, int tok, int hh, unsigned (&out)[16]) {
  f32x16_t acc[4];
#pragma unroll
  for (int kt = 0; kt < 4; ++kt)
#pragma unroll
    for (int r = 0; r < 16; ++r) acc[kt][r] = 64.0f;
#pragma unroll 1
  for (int ks = 0; ks < 8; ++ks) {
    const bf16x8_t bq = *(const bf16x8_t*)(qrow + 16 * ks + 8 * hh);
#pragma unroll
    for (int kt = 0; kt < 4; ++kt) {
      const bf16x8_t ak = *(const LAS bf16x8_t*)(sk + (32 * kt + tok) * SKP + (16 * ks + 8 * hh) * 2);
      acc[kt] = __builtin_amdgcn_mfma_f32_32x32x16_bf16(ak, bq, acc[kt], 0, 0, 0);
    }
  }
  unsigned g1[16], g2[16], g3[16];
#pragma unroll
  for (int r = 0; r < 16; ++r) {
    const unsigned ix = (unsigned)((r & 3) + 8 * (r >> 2));
    out[r] = (__float_as_uint(acc[0][r]) & ~127u) | ix; g1[r] = (__float_as_uint(acc[1][r]) & ~127u) | (32u + ix);
    g2[r] = (__float_as_uint(acc[2][r]) & ~127u) | (64u + ix); g3[r] = (__float_as_uint(acc[3][r]) & ~127u) | (96u + ix);
  }
  top16_of_64(out, g1, g2, g3);
  unsigned oth[16];
#pragma unroll
  for (int i = 0; i < 16; ++i) { out[i] |= (unsigned)(hh << 2); }
#pragma unroll
  for (int i = 0; i < 16; ++i) oth[i] = (unsigned)__shfl_xor((int)out[i], 32);
  merge_top16(out, oth);
}
DI void topk_phase(const Params& p, const u16* __restrict__ qp, const float* __restrict__ uinv, int* __restrict__ idx_out, float2* __restrict__ gu_out, unsigned char* smem) {
  const int tid = threadIdx.x;
  LAS unsigned char* sk = (LAS unsigned char*)smem;
  __syncthreads();
  for (int i = tid; i < 2 * 128 * 16; i += NTHREADS) {
    const int c = i & 15, row = i >> 4;
    const float4* s = (const float4*)(p.sub_keys + (size_t)row * 128 + c * 8);
    const float4 a = s[0], b = s[1];
    pg8::u32x4 o; o.x = pack2(a.x, a.y); o.y = pack2(a.z, a.w); o.z = pack2(b.x, b.y); o.w = pack2(b.z, b.w);
    *(LAS pg8::u32x4*)(sk + row * SKP + c * 16) = o;
  }
  __syncthreads();
  const int lane = tid & 63, tok = lane & 31, hh = lane >> 5, gw = blockIdx.x * NWAVES + (tid >> 6), nw = gridDim.x * NWAVES;
  for (int item = gw; item < (T / 32) * 4; item += nw) {
    const int t = (item >> 2) * 32 + tok, hp = item & 3;
    const u16* qt = qp + (size_t)t * 2048 + hp * 512;
    unsigned LA1[16], LA2[16], LB1[16], LB2[16];
    stage1(qt, sk, tok, hh, LA1);
    stage1(qt + 128, sk + 128 * SKP, tok, hh, LA2);
    stage1(qt + 256, sk, tok, hh, LB1);
    stage1(qt + 384, sk + 128 * SKP, tok, hh, LB2);
    unsigned L1[16], L2[16], R[16];
#pragma unroll
    for (int i = 0; i < 16; ++i) { L1[i] = hh ? LB1[i] : LA1[i]; L2[i] = hh ? LB2[i] : LA2[i]; }
    stage2(L1, L2, R);
    const int head = hp * 2 + hh;
    float ev[16], sum = 0.f;
    const float mx = __uint_as_float(0x42000000u | ((R[0] >> 14) << 6));
#pragma unroll
    for (int k = 0; k < 16; ++k) { ev[k] = __expf(__uint_as_float(0x42000000u | ((R[k] >> 14) << 6)) - mx); sum += ev[k]; }
    const float rs = 1.f / sum;
    int* io = idx_out + (size_t)t * 128 + head * 16; float2* go = gu_out + (size_t)t * 128 + head * 16;
#pragma unroll
    for (int k4 = 0; k4 < 4; ++k4) {
      int4 ex; ex.x = (int)(R[4 * k4] & 0x3FFFu); ex.y = (int)(R[4 * k4 + 1] & 0x3FFFu); ex.z = (int)(R[4 * k4 + 2] & 0x3FFFu); ex.w = (int)(R[4 * k4 + 3] & 0x3FFFu);
      ((int4*)io)[k4] = ex;
      float4 ga, gb; ga.x = ev[4 * k4] * rs; ga.y = uinv[ex.x]; ga.z = ev[4 * k4 + 1] * rs; ga.w = uinv[ex.y];
      gb.x = ev[4 * k4 + 2] * rs; gb.y = uinv[ex.z]; gb.z = ev[4 * k4 + 3] * rs; gb.w = uinv[ex.w];
      ((float4*)go)[2 * k4] = ga; ((float4*)go)[2 * k4 + 1] = gb;
    }
  }
}

typedef float f32x4_t __attribute__((ext_vector_type(4)));
DI long lo64(const uint4& a) { return (long)(((unsigned long long)a.y << 32) | a.x); }
DI long hi64(const uint4& a) { return (long)(((unsigned long long)a.w << 32) | a.z); }
#define U_LOAD(A, e) do { const uint4* _r = (const uint4*)(U8 + (size_t)(e) * D + 16 * q); _Pragma("unroll") for (int i = 0; i < 16; ++i) A[i] = _r[4 * i]; } while (0)
#define U_COMPUTE(A, e, gu2, vi, g) do { f32x4_t c0 = {0.f, 0.f, 0.f, 0.f}, c1 = {0.f, 0.f, 0.f, 0.f}; \
    _Pragma("unroll") for (int i = 0; i < 16; ++i) { c0 = __builtin_amdgcn_mfma_f32_16x16x32_fp8_fp8(lo64(A[i]), lo64(B[i]), c0, 0, 0, 0); \
                                                      c1 = __builtin_amdgcn_mfma_f32_16x16x32_fp8_fp8(hi64(A[i]), hi64(B[i]), c1, 0, 0, 0); } \
    const f32x4_t cc = c0 + c1; const int r = pp & 3; \
    float d = r == 0 ? cc[0] : r == 1 ? cc[1] : r == 2 ? cc[2] : cc[3]; \
    if (q == (pp >> 2)) { d *= (gu2).y; const float act = 0.5f * d * (1.f + erff(d * 0.70710678118654752f)); \
      uint2 o; o.x = (unsigned)(e); o.y = __float_as_uint((gu2).x * act * (vi)); pw[(size_t)tok * 128 + sh * 64 + (g)] = o; } } while (0)
DI void peer_u_phase(const u16* __restrict__ xb, const float* __restrict__ rowss, const int* __restrict__ idx, const float2* __restrict__ gu,
                     const unsigned char* __restrict__ U8, const float* __restrict__ vinv, uint2* __restrict__ pw) {
  const int lane = threadIdx.x & 63, pp = lane & 15, q = lane >> 4, gw = blockIdx.x * NWAVES + (threadIdx.x >> 6), nw = gridDim.x * NWAVES;
  for (int item = gw; item < (T / 16) * 2; item += nw) {
    const int tg = item >> 1, sh = item & 1, tok = tg * 16 + pp;
    const float inv = rsqrtf(rowss[tok] * (1.f / D) + EPS);
    uint4 B[16];
#pragma unroll
    for (int i = 0; i < 16; ++i) {
      const uint4* s = (const uint4*)(xb + (size_t)tok * D + 64 * i + 16 * q);
      float f[16]; unpack8(s[0], f); unpack8(s[1], f + 8);
      int w;
      w = __builtin_amdgcn_cvt_pk_fp8_f32(f[0] * inv, f[1] * inv, 0, false); w = __builtin_amdgcn_cvt_pk_fp8_f32(f[2] * inv, f[3] * inv, w, true); B[i].x = (unsigned)w;
      w = __builtin_amdgcn_cvt_pk_fp8_f32(f[4] * inv, f[5] * inv, 0, false); w = __builtin_amdgcn_cvt_pk_fp8_f32(f[6] * inv, f[7] * inv, w, true); B[i].y = (unsigned)w;
      w = __builtin_amdgcn_cvt_pk_fp8_f32(f[8] * inv, f[9] * inv, 0, false); w = __builtin_amdgcn_cvt_pk_fp8_f32(f[10] * inv, f[11] * inv, w, true); B[i].z = (unsigned)w;
      w = __builtin_amdgcn_cvt_pk_fp8_f32(f[12] * inv, f[13] * inv, 0, false); w = __builtin_amdgcn_cvt_pk_fp8_f32(f[14] * inv, f[15] * inv, w, true); B[i].w = (unsigned)w;
    }
    const int* irow = idx + (size_t)tok * 128 + sh * 64; const float2* grow = gu + (size_t)tok * 128 + sh * 64;
    uint4 A0[16], A1[16];
    int e0 = irow[0], e1 = irow[1], e2 = irow[2], e3 = irow[3];
    float2 g0 = grow[0], g1 = grow[1], g2 = grow[2], g3 = grow[3];
    float vi0 = vinv[e0], vi1 = vinv[e1], vi2 = vinv[e2], vi3 = vinv[e3];
    U_LOAD(A0, e0);
    for (int g = 0; g < 64; g += 2) {
      U_LOAD(A1, e1);
      const int n0 = irow[(g + 4) & 63], n1 = irow[(g + 5) & 63]; const float2 h0 = grow[(g + 4) & 63], h1 = grow[(g + 5) & 63];
      U_COMPUTE(A0, e0, g0, vi0, g);
      U_LOAD(A0, e2);
      U_COMPUTE(A1, e1, g1, vi1, g + 1);
      vi0 = vi2; vi1 = vi3; vi2 = vinv[n0]; vi3 = vinv[n1];
      e0 = e2; e1 = e3; e2 = n0; e3 = n1; g0 = g2; g1 = g3; g2 = h0; g3 = h1;
    }
  }
}

typedef float f32x2_t __attribute__((ext_vector_type(2)));
constexpr int PEP = 1032;
typedef unsigned u32x2_t __attribute__((ext_vector_type(2)));
#define V_LOAD(PE, ROW, i0) do { _Pragma("unroll") for (int k = 0; k < 8; ++k) { PE[k] = *(const LAS u32x2_t*)(myp + ((i0) + k) * 8); \
      ROW[k] = *(const uint4*)(vbase + (PE[k].x * 128u + cc16)); } } while (0)
#define V_COMP(PE, ROW) do { _Pragma("unroll") for (int k = 0; k < 8; ++k) { const float w = __uint_as_float(PE[k].y); const f32x2_t w2 = {w, w}; \
      const unsigned dw[4] = {ROW[k].x, ROW[k].y, ROW[k].z, ROW[k].w}; \
      _Pragma("unroll") for (int c = 0; c < 4; ++c) { \
        const f32x2_t lo = __builtin_amdgcn_cvt_pk_f32_fp8((int)dw[c], false), hi = __builtin_amdgcn_cvt_pk_f32_fp8((int)dw[c], true); \
        acc[2 * c] = __builtin_elementwise_fma(w2, lo, acc[2 * c]); acc[2 * c + 1] = __builtin_elementwise_fma(w2, hi, acc[2 * c + 1]); } } } while (0)
DI void peer_v_phase(const uint2* __restrict__ pw, const unsigned char* __restrict__ V8, float* __restrict__ out, unsigned char* smem, unsigned* __restrict__ qcnt, volatile LAS unsigned* misc) {
  const int lane = threadIdx.x & 63, wave = threadIdx.x >> 6, r = lane >> 3, cc = lane & 7;
  LAS unsigned char* pes = (LAS unsigned char*)smem + wave * (8 * PEP);
  const LAS unsigned char* myp = pes + r * PEP;
  const unsigned myx = xb_xcc_id() & 7u;
  for (;;) {
    __syncthreads();
    if (threadIdx.x == 0) {
      unsigned got = 0xFFFFFFFFu;
      for (unsigned k = 0; k < 8u; ++k) { const unsigned s = (myx + k) & 7u; const unsigned u = xb_add(&qcnt[64 * s], 1u); if (u < (unsigned)(T / 64)) { got = s + 8u * u; break; } }
      misc[4] = got;
    }
    __syncthreads();
    const unsigned unit = misc[4];
    if (unit == 0xFFFFFFFFu) break;
    const int j = unit & 7, t0 = (unit >> 3) * 64 + wave * 8;
    __builtin_amdgcn_wave_barrier();
    uint4 nxt[8];
#pragma unroll
    for (int r8 = 0; r8 < 8; ++r8) nxt[r8] = ((const uint4*)(pw + (size_t)(t0 + r8) * 128))[lane];
#pragma unroll
    for (int r8 = 0; r8 < 8; ++r8) { pg8::u32x4 o; o.x = nxt[r8].x; o.y = nxt[r8].y; o.z = nxt[r8].z; o.w = nxt[r8].w; *(LAS pg8::u32x4*)(pes + r8 * PEP + lane * 16) = o; }
    __builtin_amdgcn_fence(__ATOMIC_RELEASE, "wavefront");
    __builtin_amdgcn_wave_barrier();
    float4* o = (float4*)(out + (size_t)(t0 + r) * D + 128 * j + 16 * cc);
    const unsigned char* vbase = V8 + (size_t)j * ((size_t)NEXP * 128); const unsigned cc16 = 16u * cc;
    f32x2_t acc[8];
#pragma unroll
    for (int k = 0; k < 8; ++k) acc[k] = (f32x2_t){0.f, 0.f};
    const float4 o0 = o[0], o1 = o[1], o2 = o[2], o3 = o[3];
    u32x2_t Pa[8], Pb[8]; uint4 Ra[8], Rb[8];
#define SB() __builtin_amdgcn_sched_barrier(0)
    V_LOAD(Pa, Ra, 0); SB();
#pragma unroll 1
    for (int b = 0; b < 16; b += 2) {
      V_LOAD(Pb, Rb, (b + 1) * 8); SB(); V_COMP(Pa, Ra); SB();
      V_LOAD(Pa, Ra, ((b + 2) & 15) * 8); SB(); V_COMP(Pb, Rb); SB();
    }
    float4 v;
    v.x = o0.x + acc[0][0]; v.y = o0.y + acc[0][1]; v.z = o0.z + acc[1][0]; v.w = o0.w + acc[1][1]; o[0] = v;
    v.x = o1.x + acc[2][0]; v.y = o1.y + acc[2][1]; v.z = o1.z + acc[3][0]; v.w = o1.w + acc[3][1]; o[1] = v;
    v.x = o2.x + acc[4][0]; v.y = o2.y + acc[4][1]; v.z = o2.z + acc[5][0]; v.w = o2.w + acc[5][1]; o[2] = v;
    v.x = o3.x + acc[6][0]; v.y = o3.y + acc[6][1]; v.z = o3.z + acc[7][0]; v.w = o3.w + acc[7][1]; o[3] = v;
  }
}

constexpr int NPHASE = 9;
__global__ void __launch_bounds__(NTHREADS, 2) fwd_kernel(Params p) {
  extern __shared__ __attribute__((aligned(16))) unsigned char smem[];
  cg::grid_group grid = cg::this_grid();
  unsigned char* ws = p.ws;
  u16* wt_in = (u16*)(ws + WS_WTIN); u16* wt_out = (u16*)(ws + WS_WTOUT); u16* wt_q = (u16*)(ws + WS_WTQ);
  u16* act = (u16*)(ws + WS_ACT); u16* proj = (u16*)(ws + WS_PROJ);
  int* idx = (int*)(ws + WS_IDX); float2* gu = (float2*)(ws + WS_SB); unsigned char* U8 = ws + WS_U8; unsigned char* V8 = ws + WS_V8;
  uint2* pw = (uint2*)(ws + WS_PW); float* uinv = (float*)(ws + WS_UINV); float* vinv = (float*)(ws + WS_VINV);
  float* rowss = (float*)(ws + WS_ROWSS);
  volatile LAS unsigned* misc = (volatile LAS unsigned*)(LAS unsigned char*)(smem + LDS_MISC);
  if (threadIdx.x < 8) misc[threadIdx.x] = 0u;
  __syncthreads();
  XcdBarrier bar = xcd_barrier_post((unsigned*)(ws + WS_CTL), misc);
  PG8_LAS unsigned char* lds = (PG8_LAS unsigned char*)smem;
  const int lo = p.ph_lo, hi = p.ph_hi;
#define IN(k) (lo <= (k) && (k) < hi)
#define SEAM(k) do { if (IN(k) && IN((k) + 1)) xcd_barrier(bar); } while (0)
  if (IN(0)) {
    transpose_convert(p.w_in, wt_in, D, DIN, nullptr, (float*)smem);
    transpose_convert(p.w_out, wt_out, D, D, nullptr, (float*)smem);
    transpose_convert(p.w_q, wt_q, D, 2048, p.norm2_g, (float*)smem);
    convert_fp8_rows<false>(p.peer_u, p.norm2_g, U8, uinv);
    convert_fp8_rows<true>(p.peer_v, nullptr, V8, vinv);
    rmsnorm1024(p.x, p.norm1_g, act);
    for (int i = blockIdx.x * NTHREADS + threadIdx.x; i < T; i += gridDim.x * NTHREADS) rowss[i] = 0.f;
  }
  if (IN(0) && IN(1)) grid.sync();
  if (IN(1)) { pg8::Gemm g{act, wt_in, T, DIN, D}; pg8::StaticOrder S; S.init(T, DIN, gridDim.x, blockIdx.x);
    pg8::EpiBf16S E{proj, DIN, nullptr}; pg8::gemm_phase<pg8::EpiBf16S, pg8::StaticOrder>(lds, g, S, E, nullptr); }
  SEAM(1);
  u16* vt = (u16*)(ws + WS_SB);
  if (IN(2)) postproj_phase(p, proj, act, vt, smem);
  SEAM(2);
  if (IN(3)) attn_phase(p, proj, vt, act, smem);
  SEAM(3);
  if (IN(4)) { pg8::Gemm g{act, wt_out, T, D, D}; pg8::StaticOrder S; S.init(T, D, gridDim.x, blockIdx.x);
    pg8::EpiResid E{p.x, p.out, proj, rowss, D}; pg8::gemm_phase<pg8::EpiResid, pg8::StaticOrder>(lds, g, S, E, nullptr); }
  SEAM(4);
  u16* xb = proj;
  u16* qp = proj + (size_t)T * D;
  if (IN(5)) { pg8::Gemm g{xb, wt_q, T, 2048, D}; pg8::StaticOrder S; S.init(T, 2048, gridDim.x, blockIdx.x);
    pg8::EpiBf16S E{qp, 2048, rowss}; pg8::gemm_phase<pg8::EpiBf16S, pg8::StaticOrder>(lds, g, S, E, nullptr); }
  SEAM(5);
  if (IN(6)) topk_phase(p, qp, uinv, idx, gu, smem);
  SEAM(6);
  if (IN(7)) peer_u_phase(xb, rowss, idx, gu, U8, vinv, pw);
  SEAM(7);
  if (IN(8)) peer_v_phase(pw, V8, p.out, smem, (unsigned*)(ws + WS_CTL) + 4096, misc);
}

extern "C" void kernel_launch(void* const* d_in, const int* in_sizes, int n_in, void* d_out, int out_size, void* d_ws, size_t ws_size,
                              hipStream_t stream) {
  static int grid_blocks = 0;
  if (!grid_blocks) {
    int dev = 0, cus = 0, per_cu = 0;
    (void)hipGetDevice(&dev);
    (void)hipDeviceGetAttribute(&cus, hipDeviceAttributeMultiprocessorCount, dev);
    (void)hipFuncSetAttribute((const void*)fwd_kernel, hipFuncAttributeMaxDynamicSharedMemorySize, LDS_BYTES);
    (void)hipOccupancyMaxActiveBlocksPerMultiprocessor(&per_cu, fwd_kernel, NTHREADS, LDS_BYTES);
    if (per_cu < 1) per_cu = 1;
    if (per_cu > 1) per_cu = 1;
    grid_blocks = cus * per_cu;
  }
  Params p{};
  p.x = (const float*)d_in[0]; p.norm1_g = (const float*)d_in[1]; p.w_in = (const float*)d_in[2]; p.q_norm_g = (const float*)d_in[3];
  p.k_norm_g = (const float*)d_in[4]; p.conv_w = (const float*)d_in[5]; p.sb_out_g = (const float*)d_in[6]; p.conv_out_g = (const float*)d_in[7];
  p.w_out = (const float*)d_in[8]; p.norm2_g = (const float*)d_in[9]; p.w_q = (const float*)d_in[10]; p.sub_keys = (const float*)d_in[11];
  p.peer_u = (const float*)d_in[12]; p.peer_v = (const float*)d_in[13];
  p.out = (float*)d_out; p.ws = (unsigned char*)d_ws;
  p.ph_lo = 0; p.ph_hi = NPHASE;
  (void)hipMemsetAsync((unsigned char*)d_ws + WS_CTL, 0, 4096 * 4 + 8 * 64 * 4, stream);
  void* args[] = {&p};
  hipError_t e = hipLaunchCooperativeKernel((void*)fwd_kernel, dim3(grid_blocks), dim3(NTHREADS), args, LDS_BYTES, stream);
  if (e != hipSuccess) fprintf(stderr, "cooperative launch failed: %s (grid %d)\n", hipGetErrorString(e), grid_blocks);
}
```

```cpp
#include <hip/hip_runtime.h>
#include <hip/hip_cooperative_groups.h>
#include <cstdio>
#include <cstdint>
namespace cg = cooperative_groups;

typedef unsigned short u16;
#define DI __device__ __forceinline__
#define LAS __attribute__((address_space(3)))

constexpr int T = 16384, D = 1024, SEQ = 4096;
constexpr int DIN = 3072, DSB = 512;
constexpr int NEXP = 16384;
constexpr float EPS = 1e-6f;
constexpr int NWAVES = 8, NTHREADS = NWAVES * 64;

namespace pg8 {
#define PG8_LAS __attribute__((address_space(3)))
typedef unsigned short bf16_t;
typedef short bf16x8 __attribute__((ext_vector_type(8)));
typedef float f32x4 __attribute__((ext_vector_type(4)));
typedef unsigned u32x4 __attribute__((ext_vector_type(4)));
constexpr int BM = 256, BK = 64, HALF = 128, HTB = HALF * BK * 2  , STAGE_BYTES = 8 * HTB, NXCD = 8, WGM = 8;

__host__ __device__ __forceinline__ int lds_byte(int r, int c) { const int st = (r >> 4) * 2 + (c >> 5), rr = r & 15, cc = c & 31, ob = rr * 64 + cc * 2; return st * 1024 + (ob ^ (((ob >> 9) & 1) << 5)); }
__host__ __device__ __forceinline__ void stage_rc(int b, int& R, int& C) { const int st = b / 1024, sb = b % 1024, swz = sb ^ (((sb >> 9) & 1) << 5); R = (st >> 1) * 16 + swz / 64; C = (st & 1) * 32 + (swz % 64) / 2; }
__host__ __device__ __forceinline__ int perm32(int rho) { const int n = rho >> 4, i = rho & 15; return 8 * (i >> 2) + 4 * n + (i & 3); }

struct Unit { int pm, pn; };
struct Gemm { const bf16_t* A; const bf16_t* Bt; int M, N, K; };
struct StaticOrder {
    int nM, nN, nwg, G, c;
    __host__ __device__ void init(int M, int N, int G_, int c_) { nM = M / BM; nN = N / BM; nwg = nM * nN; G = G_; c = c_; }
    __host__ __device__ bool next(int i, Unit& u) const {
        const long L = (long)i * G + c; if (L >= nwg) return false;
        int wgid = (int)L; { const int q = nwg / NXCD, r = nwg % NXCD, xcd = wgid % NXCD, off = wgid / NXCD; wgid = (xcd < r ? xcd * (q + 1) : r * (q + 1) + (xcd - r) * q) + off; }
        const int nig = WGM * nN, gid = wgid / nig, fm = gid * WGM, gsz = (nM - fm) < WGM ? (nM - fm) : WGM;
        u.pm = fm + ((wgid % nig) % gsz); u.pn = (wgid % nig) / gsz; return true;
    }
    __device__ __forceinline__ void a_ready(const Unit&) const {}
    __device__ __forceinline__ void done(const Unit&) const {}
};
__device__ __forceinline__ unsigned cvt_pk_bf16(float lo, float hi) { unsigned r; asm volatile("v_cvt_pk_bf16_f32 %0, %1, %2" : "=v"(r) : "v"(lo), "v"(hi)); return r; }

struct EpiBf16S {
    static constexpr bool PERM = true, AFTER_DRAIN = false;
    bf16_t* O; int ldc; const float* rowss;
    __device__ __forceinline__ void operator()(const f32x4 (&acc)[2][2][4][2], const Unit& u, int wr, int wc, int fr, int fq) const {
        const int row0 = u.pm * BM + wr * 64 + fr, col0 = u.pn * BM + wc * 32 + 8 * fq;
#pragma unroll
        for (int ai = 0; ai < 2; ++ai)
#pragma unroll
            for (int m = 0; m < 4; ++m) { const int row = row0 + ai * HALF + m * 16; bf16_t* rowp = O + (size_t)row * ldc + col0;
                const float sc = rowss ? rsqrtf(rowss[row] * (1.f / 1024.f) + 1e-6f) : 1.f;
#pragma unroll
                for (int bj = 0; bj < 2; ++bj) { const f32x4 v0 = acc[ai][bj][m][0] * sc, v1 = acc[ai][bj][m][1] * sc;
                    u32x4 w; w.x = cvt_pk_bf16(v0[0], v0[1]); w.y = cvt_pk_bf16(v0[2], v0[3]); w.z = cvt_pk_bf16(v1[0], v1[1]); w.w = cvt_pk_bf16(v1[2], v1[3]);
                    *(u32x4*)(rowp + bj * HALF) = w; } }
    }
};
struct EpiResid {
    static constexpr bool PERM = true, AFTER_DRAIN = false;
    const float* resid; float* out32; bf16_t* xb; float* rowss; int ldc;
    __device__ __forceinline__ void operator()(const f32x4 (&acc)[2][2][4][2], const Unit& u, int wr, int wc, int fr, int fq) const {
        const int row0 = u.pm * BM + wr * 64 + fr, col0 = u.pn * BM + wc * 32 + 8 * fq;
#pragma unroll
        for (int ai = 0; ai < 2; ++ai)
#pragma unroll
            for (int m = 0; m < 4; ++m) { const int row = row0 + ai * HALF + m * 16; const size_t off = (size_t)row * ldc + col0; float ss = 0.f;
#pragma unroll
                for (int bj = 0; bj < 2; ++bj) {
                    const f32x4 r0 = *(const f32x4*)(resid + off + bj * HALF), r1 = *(const f32x4*)(resid + off + bj * HALF + 4);
                    const f32x4 o0 = r0 + acc[ai][bj][m][0], o1 = r1 + acc[ai][bj][m][1];
                    *(f32x4*)(out32 + off + bj * HALF) = o0; *(f32x4*)(out32 + off + bj * HALF + 4) = o1;
                    ss += o0[0] * o0[0] + o0[1] * o0[1] + o0[2] * o0[2] + o0[3] * o0[3] + o1[0] * o1[0] + o1[1] * o1[1] + o1[2] * o1[2] + o1[3] * o1[3];
                    u32x4 w; w.x = cvt_pk_bf16(o0[0], o0[1]); w.y = cvt_pk_bf16(o0[2], o0[3]); w.z = cvt_pk_bf16(o1[0], o1[1]); w.w = cvt_pk_bf16(o1[2], o1[3]);
                    *(u32x4*)(xb + off + bj * HALF) = w; }
                ss += __shfl_xor(ss, 16); ss += __shfl_xor(ss, 32);
                if (fq == 0) unsafeAtomicAdd(rowss + row, ss); }
    }
};
template <class Epi, class Sched, bool STAMP = false>
__device__ __forceinline__ void gemm_phase(PG8_LAS unsigned char* lds, const Gemm g, const Sched& S, const Epi& E, unsigned long long* stamps) {
    const int tid = threadIdx.x, wid = __builtin_amdgcn_readfirstlane(tid >> 6), lane = tid & 63, wr = wid >> 2, wc = wid & 3, fr = lane & 15, fq = lane >> 4;
    const int K = g.K, nt = K / BK;
    int ts_lo = 0, ts_hi = 0, nts = 0; const unsigned long long rt_entry = STAMP ? (unsigned long long)wall_clock64() : 0ull;
#define PG8_STAMP() do { if (STAMP && wid == 0 && nts < 64) { const unsigned long long _c = (unsigned long long)clock64(); \
        ts_lo = (lane == nts) ? (int)(unsigned)_c : ts_lo; ts_hi = (lane == nts) ? (int)(unsigned)(_c >> 32) : ts_hi; ++nts; } } while (0)
    PG8_STAMP();
    unsigned voffA[2], voffB[2];
#pragma unroll
    for (int i = 0; i < 2; ++i) { int R, C; stage_rc(tid * 16 + i * 8192, R, C); const int Rb = Epi::PERM ? ((R & ~31) + perm32(R & 31)) : R;
        voffA[i] = (unsigned)(R * K + C) * 2u; voffB[i] = (unsigned)(Rb * K + C) * 2u; }
    const size_t kstep = (size_t)(BK * 2);
    const size_t hstep = (size_t)HALF * K * 2;
    const size_t tstep = 2 * hstep;
    const unsigned ldsw = (unsigned)wid * 1024u;
    const int aoff = lds_byte(wr * 64 + fr, fq * 8), boff = lds_byte(wc * 32 + fr, fq * 8);
#define PG8_SA(b, h) (((b) * 2 + (h)) * HTB)
#define PG8_SB(b, h) ((4 + (b) * 2 + (h)) * HTB)
#define PG8_STAGE(bufoff, gbase, voff) do { _Pragma("unroll") for (int _i = 0; _i < 2; ++_i) \
        __builtin_amdgcn_global_load_lds((const unsigned*)((const char*)(gbase) + (voff)[_i]), (PG8_LAS unsigned*)(lds + (bufoff) + ldsw + _i * 8192), 16, 0, 0); } while (0)
#define PG8_LDA(dst, b, h) do { _Pragma("unroll") for (int m = 0; m < 4; ++m) _Pragma("unroll") for (int k = 0; k < 2; ++k) dst[m][k] = *(const PG8_LAS bf16x8*)(lds + PG8_SA(b, h) + aoff + m * 2048 + k * 1024); } while (0)
#define PG8_LDB(dst, b, h) do { _Pragma("unroll") for (int n = 0; n < 2; ++n) _Pragma("unroll") for (int k = 0; k < 2; ++k) dst[n][k] = *(const PG8_LAS bf16x8*)(lds + PG8_SB(b, h) + boff + n * 2048 + k * 1024); } while (0)
#define PG8_MMA(ai, bj, At, Bt) do { __builtin_amdgcn_s_setprio(1); _Pragma("unroll") for (int m = 0; m < 4; ++m) _Pragma("unroll") for (int n = 0; n < 2; ++n) _Pragma("unroll") for (int k = 0; k < 2; ++k) \
        acc[ai][bj][m][n] = __builtin_amdgcn_mfma_f32_16x16x32_bf16(Bt[n][k], At[m][k], acc[ai][bj][m][n], 0, 0, 0); __builtin_amdgcn_s_setprio(0); } while (0)
#define PG8_WAIT_V(n) asm volatile("s_waitcnt vmcnt(" #n ")" ::: "memory")
#define PG8_WAIT_L(n) asm volatile("s_waitcnt lgkmcnt(" #n ")" ::: "memory")
#define PG8_BAR __builtin_amdgcn_s_barrier()
#define PG8_SCHED __builtin_amdgcn_sched_barrier(0)
    Unit cur, nxt; int ui = 0;
    if (!S.next(0, cur)) return;
    f32x4 acc[2][2][4][2];
#pragma unroll
    for (int a = 0; a < 2; ++a)
#pragma unroll
        for (int b = 0; b < 2; ++b)
#pragma unroll
            for (int m = 0; m < 4; ++m)
#pragma unroll
                for (int n = 0; n < 2; ++n) acc[a][b][m][n] = (f32x4){0.f, 0.f, 0.f, 0.f};
    bf16x8 At[4][2], B0[2][2], B1[2][2];
    const char* cA = (const char*)g.A + (size_t)cur.pm * tstep; const char* cB = (const char*)g.Bt + (size_t)cur.pn * tstep;
    S.a_ready(cur);
    PG8_STAGE(PG8_SB(0, 0), cB, voffB); PG8_STAGE(PG8_SA(0, 0), cA, voffA); PG8_STAGE(PG8_SB(0, 1), cB + hstep, voffB); PG8_STAGE(PG8_SA(0, 1), cA + hstep, voffA);
    if (wr == 1) PG8_BAR;
    PG8_WAIT_V(4); PG8_BAR;
    PG8_STAGE(PG8_SB(1, 0), cB + kstep, voffB); PG8_STAGE(PG8_SA(1, 0), cA + kstep, voffA); PG8_STAGE(PG8_SB(1, 1), cB + hstep + kstep, voffB);
    PG8_WAIT_V(6); PG8_BAR;
    PG8_STAMP();
    for (;;) {
        const bool has_next = S.next(ui + 1, nxt);
        const char* nA = has_next ? (const char*)g.A + (size_t)nxt.pm * tstep : cA; const char* nB = has_next ? (const char*)g.Bt + (size_t)nxt.pn * tstep : cB;
        for (int t = 0; t < nt; t += 2) {
            const bool last = (t == nt - 2);
            const char* a1 = cA + (size_t)(t + 1) * kstep;
            const char* a2 = last ? nA : cA + (size_t)(t + 2) * kstep; const char* b2 = last ? nB : cB + (size_t)(t + 2) * kstep;
            const char* a3 = a2 + kstep; const char* b3 = b2 + kstep;
            if (last && has_next) S.a_ready(nxt);
            PG8_LDB(B0, 0, 0); PG8_SCHED; PG8_LDA(At, 0, 0); PG8_STAGE(PG8_SA(1, 1), a1 + hstep, voffA);
            PG8_WAIT_L(8); PG8_BAR; PG8_WAIT_L(0); PG8_MMA(0, 0, At, B0); PG8_BAR; PG8_SCHED;
            PG8_LDB(B1, 0, 1); PG8_STAGE(PG8_SB(0, 0), b2, voffB);
            PG8_BAR; PG8_WAIT_L(0); PG8_MMA(0, 1, At, B1); PG8_BAR;
            PG8_LDA(At, 0, 1); PG8_STAGE(PG8_SA(0, 0), a2, voffA);
            PG8_BAR; PG8_WAIT_L(0); PG8_MMA(1, 0, At, B0); PG8_BAR; PG8_SCHED;
            PG8_STAGE(PG8_SB(0, 1), b2 + hstep, voffB);
            PG8_WAIT_V(6); PG8_BAR; PG8_MMA(1, 1, At, B1); PG8_BAR;
            PG8_LDB(B0, 1, 0); PG8_SCHED; PG8_LDA(At, 1, 0); PG8_STAGE(PG8_SA(0, 1), a2 + hstep, voffA);
            PG8_WAIT_L(8); PG8_BAR; PG8_WAIT_L(0); PG8_MMA(0, 0, At, B0); PG8_BAR; PG8_SCHED;
            PG8_LDB(B1, 1, 1); PG8_STAGE(PG8_SB(1, 0), b3, voffB);
            PG8_BAR; PG8_WAIT_L(0); PG8_MMA(0, 1, At, B1); PG8_BAR;
            PG8_LDA(At, 1, 1); PG8_STAGE(PG8_SA(1, 0), a3, voffA);
            PG8_BAR; PG8_WAIT_L(0); PG8_MMA(1, 0, At, B0); PG8_BAR; PG8_SCHED;
            PG8_STAGE(PG8_SB(1, 1), b3 + hstep, voffB);
            PG8_WAIT_V(6); PG8_BAR; PG8_MMA(1, 1, At, B1); PG8_BAR;
        }
        PG8_STAMP();
        if constexpr (!Epi::AFTER_DRAIN) { E(acc, cur, wr, wc, fr, fq); S.done(cur); }
        PG8_STAMP();
        if (!has_next) break;
#pragma unroll
        for (int a = 0; a < 2; ++a)
#pragma unroll
            for (int b = 0; b < 2; ++b)
#pragma unroll
                for (int m = 0; m < 4; ++m)
#pragma unroll
                    for (int n = 0; n < 2; ++n) acc[a][b][m][n] = (f32x4){0.f, 0.f, 0.f, 0.f};
        cur = nxt; cA = nA; cB = nB; ++ui;
    }
    PG8_WAIT_V(0);
    if (wr == 0) PG8_BAR;
    PG8_BAR;
    if constexpr (Epi::AFTER_DRAIN) { E.fused(acc, cur, wr, wc, fr, fq, lds, wid, lane); S.done(cur); }
    PG8_STAMP();
    if (STAMP && wid == 0) { stamps[lane] = lane < nts ? (((unsigned long long)(unsigned)ts_hi << 32) | (unsigned)ts_lo) : 0ull;
        if (lane == 62) stamps[62] = rt_entry; if (lane == 63) stamps[63] = (unsigned long long)wall_clock64(); }
#undef PG8_STAMP
#undef PG8_SA
#undef PG8_SB
#undef PG8_STAGE
#undef PG8_LDA
#undef PG8_LDB
#undef PG8_MMA
#undef PG8_WAIT_V
#undef PG8_WAIT_L
#undef PG8_BAR
#undef PG8_SCHED
}
}


constexpr size_t MBy = 1u << 20;
constexpr size_t WS_WTIN = 0, WS_WTOUT = 6 * MBy, WS_WTQ = 8 * MBy, WS_CTL = 12 * MBy, WS_ROWSS = 12 * MBy + 65536, WS_ACT = 13 * MBy, WS_PROJ = 45 * MBy,
                 WS_SB = 141 * MBy, WS_IDX = 173 * MBy, WS_GATE = 181 * MBy, WS_U8 = 189 * MBy, WS_V8 = 205 * MBy, WS_PW = 221 * MBy,
                 WS_UINV = 12 * MBy + 262144, WS_VINV = 12 * MBy + 393216;
constexpr int LDS_MISC = pg8::STAGE_BYTES, LDS_BYTES = pg8::STAGE_BYTES + 256;

struct Params {
  const float *x, *norm1_g, *w_in, *q_norm_g, *k_norm_g, *conv_w, *sb_out_g, *conv_out_g, *w_out, *norm2_g, *w_q, *sub_keys, *peer_u, *peer_v;
  float* out; unsigned char* ws; int ph_lo, ph_hi;
};

#define XB_TMO      128
#define XB_XCNT(j)  (256  + 64 * (j))
#define XB_XSUB(j)  (1280 + 64 * (j))
#define XB_XGEN(j)  (2304 + 64 * (j))
#define XB_TOP      3328
#define XB_TOPGEN   3392
#define XCD_BAR_WORDS 3456
#define XB_SPIN_CAP (1u << 18)
DI unsigned xb_ld(unsigned* p) { return __hip_atomic_load(p, __ATOMIC_RELAXED, __HIP_MEMORY_SCOPE_AGENT); }
DI unsigned xb_add(unsigned* p, unsigned v) { return __hip_atomic_fetch_add(p, v, __ATOMIC_RELAXED, __HIP_MEMORY_SCOPE_AGENT); }
DI unsigned xb_xcc_id() { return (unsigned)__builtin_amdgcn_s_getreg((3 << 11) | 20) & 0xFu; }
#define XB_SPIN(cond, bar) do { unsigned _sp = 0; while (cond) { __builtin_amdgcn_s_sleep(1); \
    if ((++_sp & 255u) == 0u) { if (xb_ld(&(bar)[XB_TMO])) break; if (_sp > XB_SPIN_CAP) { atomicAdd(&(bar)[XB_TMO], 1u); break; } } } } while (0)
struct XcdBarrier { unsigned* bar; unsigned x; volatile LAS unsigned* st; };
DI XcdBarrier xcd_barrier_post(unsigned* bar, volatile LAS unsigned* st) {
  XcdBarrier b; b.bar = bar; b.x = xb_xcc_id(); b.st = st;
  if (threadIdx.x == 0) (void)xb_add(&bar[XB_XCNT(b.x)], 1u);
  return b;
}
DI void xcd_barrier_complete(unsigned* bar, unsigned x, unsigned& nloc, unsigned& nx) {
  const unsigned G = gridDim.x * gridDim.y * gridDim.z;
  unsigned sum, cnt, mine, sp = 0u;
  for (;;) {
    sum = 0u; cnt = 0u; mine = 0u;
#pragma unroll
    for (unsigned j = 0; j < 16; ++j) { const unsigned c = xb_ld(&bar[XB_XCNT(j)]); sum += c; cnt += (c > 0u) ? 1u : 0u; mine = (j == x) ? c : mine; }
    if (sum == G) break;
    __builtin_amdgcn_s_sleep(1);
    if ((++sp & 255u) == 0u) { if (xb_ld(&bar[XB_TMO])) break; if (sp > XB_SPIN_CAP) { atomicAdd(&bar[XB_TMO], 1u); break; } }
  }
  nloc = mine > 0u ? mine : 1u; nx = cnt > 0u ? cnt : 1u;
}
DI void xcd_barrier(const XcdBarrier& b) {
  asm volatile("s_waitcnt vmcnt(0)" ::: "memory");
  __syncthreads();
  if (threadIdx.x == 0) {
    unsigned* bar = b.bar;
    __builtin_amdgcn_s_waitcnt(0);
    unsigned nloc = b.st[0], nx = b.st[1];
    if (nloc == 0u) { xcd_barrier_complete(bar, b.x, nloc, nx); b.st[0] = nloc; b.st[1] = nx; }
    const unsigned old = xb_add(&bar[XB_XSUB(b.x)], 1u);
    const unsigned gen = old / nloc;
    if (old + 1u == (gen + 1u) * nloc) {
      __builtin_amdgcn_fence(__ATOMIC_RELEASE, "agent");
      asm volatile("s_waitcnt vmcnt(0)" ::: "memory");
      const unsigned og = xb_add(&bar[XB_TOP], 1u);
      const unsigned tg = og / nx;
      if (og + 1u == (tg + 1u) * nx) xb_add(&bar[XB_TOPGEN], 1u);
      else XB_SPIN(xb_ld(&bar[XB_TOPGEN]) == tg, bar);
      __builtin_amdgcn_fence(__ATOMIC_ACQUIRE, "agent");
      xb_add(&bar[XB_XGEN(b.x)], 1u);
      asm volatile("s_waitcnt vmcnt(0)" ::: "memory");
    } else {
      XB_SPIN(xb_ld(&bar[XB_XGEN(b.x)]) == gen, bar);
      __builtin_amdgcn_fence(__ATOMIC_ACQUIRE, "agent");
      asm volatile("s_waitcnt vmcnt(0)" ::: "memory");
    }
  }
  __syncthreads();
}

DI u16 f2bf(float x) { unsigned u = __float_as_uint(x); u += 0x7fffu + ((u >> 16) & 1u); return (u16)(u >> 16); }
DI float bflo(unsigned w) { return __uint_as_float(w << 16); }
DI float bfhi(unsigned w) { return __uint_as_float(w & 0xffff0000u); }
DI unsigned pack2(float a, float b) { return (unsigned)f2bf(a) | ((unsigned)f2bf(b) << 16); }
DI float wave_sum(float v) {
#pragma unroll
  for (int o = 32; o >= 1; o >>= 1) v += __shfl_xor(v, o);
  return v;
}
DI float wave_max(float v) {
#pragma unroll
  for (int o = 32; o >= 1; o >>= 1) v = fmaxf(v, __shfl_xor(v, o));
  return v;
}
DI void unpack8(const uint4 w, float* f) {
  f[0] = bflo(w.x); f[1] = bfhi(w.x); f[2] = bflo(w.y); f[3] = bfhi(w.y); f[4] = bflo(w.z); f[5] = bfhi(w.z); f[6] = bflo(w.w); f[7] = bfhi(w.w);
}
DI uint4 pack8(const float* f) { uint4 o; o.x = pack2(f[0], f[1]); o.y = pack2(f[2], f[3]); o.z = pack2(f[4], f[5]); o.w = pack2(f[6], f[7]); return o; }

DI void transpose_convert(const float* __restrict__ W, u16* __restrict__ Wt, int K, int N, const float* __restrict__ rg, float* sm) {
  const int tid = threadIdx.x, tn_cnt = N / 64, ntile = (K / 64) * tn_cnt;
  for (int tile = blockIdx.x; tile < ntile; tile += gridDim.x) {
    const int tk = tile / tn_cnt, tn = tile % tn_cnt;
    __syncthreads();
#pragma unroll
    for (int r = 0; r < 8; ++r) { const int row = r * 8 + (tid >> 6), col = tid & 63;
      const float g = rg ? rg[tk * 64 + row] : 1.f;
      sm[row * 65 + col] = W[(size_t)(tk * 64 + row) * N + tn * 64 + col] * g; }
    __syncthreads();
#pragma unroll
    for (int r = 0; r < 8; ++r) { const int nrow = r * 8 + (tid >> 6), kcol = tid & 63; Wt[(size_t)(tn * 64 + nrow) * K + tk * 64 + kcol] = f2bf(sm[kcol * 65 + nrow]); }
  }
}
template <bool SLICED>
DI void convert_fp8_rows(const float* __restrict__ src, const float* __restrict__ cg, unsigned char* __restrict__ dst, float* __restrict__ inv_out) {
  const int lane = threadIdx.x & 63, gw = blockIdx.x * NWAVES + (threadIdx.x >> 6), nw = gridDim.x * NWAVES;
  float g[16];
#pragma unroll
  for (int j = 0; j < 16; ++j) g[j] = cg ? cg[16 * lane + j] : 1.f;
  for (int row = gw; row < NEXP; row += nw) {
    const float4* s = (const float4*)(src + (size_t)row * D + 16 * lane);
    float v[16];
#pragma unroll
    for (int k = 0; k < 4; ++k) { const float4 a = s[k]; v[4 * k] = a.x * g[4 * k]; v[4 * k + 1] = a.y * g[4 * k + 1]; v[4 * k + 2] = a.z * g[4 * k + 2]; v[4 * k + 3] = a.w * g[4 * k + 3]; }
    float am = 0.f;
#pragma unroll
    for (int j = 0; j < 16; ++j) am = fmaxf(am, fabsf(v[j]));
    am = wave_max(am);
    const float sc = am > 0.f ? 240.f / am : 1.f;
    uint4 o;
    { int w;
      w = __builtin_amdgcn_cvt_pk_fp8_f32(v[0] * sc, v[1] * sc, 0, false); w = __builtin_amdgcn_cvt_pk_fp8_f32(v[2] * sc, v[3] * sc, w, true); o.x = (unsigned)w;
      w = __builtin_amdgcn_cvt_pk_fp8_f32(v[4] * sc, v[5] * sc, 0, false); w = __builtin_amdgcn_cvt_pk_fp8_f32(v[6] * sc, v[7] * sc, w, true); o.y = (unsigned)w;
      w = __builtin_amdgcn_cvt_pk_fp8_f32(v[8] * sc, v[9] * sc, 0, false); w = __builtin_amdgcn_cvt_pk_fp8_f32(v[10] * sc, v[11] * sc, w, true); o.z = (unsigned)w;
      w = __builtin_amdgcn_cvt_pk_fp8_f32(v[12] * sc, v[13] * sc, 0, false); w = __builtin_amdgcn_cvt_pk_fp8_f32(v[14] * sc, v[15] * sc, w, true); o.w = (unsigned)w; }
    if (SLICED) *(uint4*)(dst + (size_t)(lane >> 3) * ((size_t)NEXP * 128) + (size_t)row * 128 + 16 * (lane & 7)) = o;
    else *(uint4*)(dst + (size_t)row * D + 16 * lane) = o;
    if (lane == 0) inv_out[row] = am > 0.f ? am * (1.f / 240.f) : 1.f;
  }
}
DI void convert_fp4_rows_sliced(const float* __restrict__ src, unsigned char* __restrict__ dst, float* __restrict__ inv_out) {
  const int lane = threadIdx.x & 63, gw = blockIdx.x * NWAVES + (threadIdx.x >> 6), nw = gridDim.x * NWAVES;
  for (int row = gw; row < NEXP; row += nw) {
    const float4* s = (const float4*)(src + (size_t)row * D + 16 * lane);
    float v[16];
#pragma unroll
    for (int k = 0; k < 4; ++k) { const float4 a = s[k]; v[4 * k] = a.x; v[4 * k + 1] = a.y; v[4 * k + 2] = a.z; v[4 * k + 3] = a.w; }
    float am = 0.f;
#pragma unroll
    for (int j = 0; j < 16; ++j) am = fmaxf(am, fabsf(v[j]));
    am = wave_max(am);
    const float sc = am > 0.f ? 6.f / am : 1.f;
    unsigned w0 = 0u, w1 = 0u;
    w0 = __builtin_amdgcn_cvt_scalef32_pk_fp4_f32(w0, v[0] * sc, v[1] * sc, 1.0f, 0); w0 = __builtin_amdgcn_cvt_scalef32_pk_fp4_f32(w0, v[2] * sc, v[3] * sc, 1.0f, 1);
    w0 = __builtin_amdgcn_cvt_scalef32_pk_fp4_f32(w0, v[4] * sc, v[5] * sc, 1.0f, 2); w0 = __builtin_amdgcn_cvt_scalef32_pk_fp4_f32(w0, v[6] * sc, v[7] * sc, 1.0f, 3);
    w1 = __builtin_amdgcn_cvt_scalef32_pk_fp4_f32(w1, v[8] * sc, v[9] * sc, 1.0f, 0); w1 = __builtin_amdgcn_cvt_scalef32_pk_fp4_f32(w1, v[10] * sc, v[11] * sc, 1.0f, 1);
    w1 = __builtin_amdgcn_cvt_scalef32_pk_fp4_f32(w1, v[12] * sc, v[13] * sc, 1.0f, 2); w1 = __builtin_amdgcn_cvt_scalef32_pk_fp4_f32(w1, v[14] * sc, v[15] * sc, 1.0f, 3);
    *(uint2*)(dst + (size_t)(lane >> 4) * ((size_t)NEXP * 128) + (size_t)row * 128 + 8 * (lane & 15)) = make_uint2(w0, w1);
    if (lane == 0) inv_out[row] = am > 0.f ? am * (1.f / 6.f) : 1.f;
  }
}
DI void convert_fp4_rows(const float* __restrict__ src, const float* __restrict__ cg, unsigned char* __restrict__ dst, float* __restrict__ inv_out) {
  const int lane = threadIdx.x & 63, gw = blockIdx.x * NWAVES + (threadIdx.x >> 6), nw = gridDim.x * NWAVES;
  float g[16];
#pragma unroll
  for (int j = 0; j < 16; ++j) g[j] = cg[16 * lane + j];
  for (int row = gw; row < NEXP; row += nw) {
    const float4* s = (const float4*)(src + (size_t)row * D + 16 * lane);
    float v[16];
#pragma unroll
    for (int k = 0; k < 4; ++k) { const float4 a = s[k]; v[4 * k] = a.x * g[4 * k]; v[4 * k + 1] = a.y * g[4 * k + 1]; v[4 * k + 2] = a.z * g[4 * k + 2]; v[4 * k + 3] = a.w * g[4 * k + 3]; }
    float am = 0.f;
#pragma unroll
    for (int j = 0; j < 16; ++j) am = fmaxf(am, fabsf(v[j]));
    am = wave_max(am);
    const float sc = am > 0.f ? 6.f / am : 1.f;
    unsigned w0 = 0u, w1 = 0u;
    w0 = __builtin_amdgcn_cvt_scalef32_pk_fp4_f32(w0, v[0] * sc, v[1] * sc, 1.0f, 0); w0 = __builtin_amdgcn_cvt_scalef32_pk_fp4_f32(w0, v[2] * sc, v[3] * sc, 1.0f, 1);
    w0 = __builtin_amdgcn_cvt_scalef32_pk_fp4_f32(w0, v[4] * sc, v[5] * sc, 1.0f, 2); w0 = __builtin_amdgcn_cvt_scalef32_pk_fp4_f32(w0, v[6] * sc, v[7] * sc, 1.0f, 3);
    w1 = __builtin_amdgcn_cvt_scalef32_pk_fp4_f32(w1, v[8] * sc, v[9] * sc, 1.0f, 0); w1 = __builtin_amdgcn_cvt_scalef32_pk_fp4_f32(w1, v[10] * sc, v[11] * sc, 1.0f, 1);
    w1 = __builtin_amdgcn_cvt_scalef32_pk_fp4_f32(w1, v[12] * sc, v[13] * sc, 1.0f, 2); w1 = __builtin_amdgcn_cvt_scalef32_pk_fp4_f32(w1, v[14] * sc, v[15] * sc, 1.0f, 3);
    *(uint2*)(dst + (size_t)row * 512 + 8 * lane) = make_uint2(w0, w1);
    if (lane == 0) inv_out[row] = am > 0.f ? am * (1.f / 6.f) : 1.f;
  }
}
DI void rmsnorm1024(const float* __restrict__ src, const float* __restrict__ g, u16* __restrict__ dst) {
  const int lane = threadIdx.x & 63, gw = blockIdx.x * NWAVES + (threadIdx.x >> 6), nw = gridDim.x * NWAVES;
  for (int row = gw; row < T; row += nw) {
    const float4* xr = (const float4*)(src + (size_t)row * D);
    float4 v[4]; float ss = 0.f;
#pragma unroll
    for (int j = 0; j < 4; ++j) { v[j] = xr[lane + 64 * j]; ss += v[j].x * v[j].x + v[j].y * v[j].y + v[j].z * v[j].z + v[j].w * v[j].w; }
    ss = wave_sum(ss);
    const float inv = rsqrtf(ss * (1.f / D) + EPS);
#pragma unroll
    for (int j = 0; j < 4; ++j) {
      const float4 gg = ((const float4*)g)[lane + 64 * j];
      uint2 o; o.x = pack2(v[j].x * inv * gg.x, v[j].y * inv * gg.y); o.y = pack2(v[j].z * inv * gg.z, v[j].w * inv * gg.w);
      *(uint2*)(dst + (size_t)row * D + 4 * (lane + 64 * j)) = o;
    }
  }
}

constexpr int VTP = 1028;
DI void postproj_phase(const Params& p, u16* __restrict__ proj, u16* __restrict__ mixed, u16* __restrict__ vt, unsigned char* smem) {
  const int lane = threadIdx.x & 63, wave = threadIdx.x >> 6;
  LAS unsigned char* tile = (LAS unsigned char*)smem;
  for (int chunk = blockIdx.x; chunk < T / 64; chunk += gridDim.x) {
    __syncthreads();
    for (int i = 0; i < 8; ++i) {
      const int tl = wave * 8 + i, t = chunk * 64 + tl;
      u16* row = proj + (size_t)t * DIN;
#pragma unroll
      for (int which = 0; which < 2; ++which) {
        float f[8]; unpack8(*(const uint4*)(row + which * 512 + 8 * lane), f);
        float ss = 0.f;
#pragma unroll
        for (int j = 0; j < 8; ++j) ss += f[j] * f[j];
        ss += __shfl_xor(ss, 1); ss += __shfl_xor(ss, 2); ss += __shfl_xor(ss, 4);
        const float inv = rsqrtf(ss * (1.f / 64.f) + EPS);
        const float* g = (which == 0 ? p.q_norm_g : p.k_norm_g) + 8 * (lane & 7);
#pragma unroll
        for (int j = 0; j < 8; ++j) f[j] = f[j] * inv * g[j];
        *(uint4*)(row + which * 512 + 8 * lane) = pack8(f);
      }
      { const uint4 v = *(const uint4*)(row + 1024 + 8 * lane);
        LAS unsigned* d = (LAS unsigned*)(tile + tl * VTP + 16 * lane); d[0] = v.x; d[1] = v.y; d[2] = v.z; d[3] = v.w; }
      const int c0 = 8 * lane, tpos = t & (SEQ - 1);
      float xc[8], bg[8], cg[8], y[8];
      unpack8(*(const uint4*)(row + 1536 + c0), xc); unpack8(*(const uint4*)(row + 2048 + c0), bg); unpack8(*(const uint4*)(row + 2560 + c0), cg);
#pragma unroll
      for (int j = 0; j < 8; ++j) y[j] = p.conv_w[2 * DSB + c0 + j] * (cg[j] * xc[j]);
      if (tpos >= 1) {
        float x1[8], c1[8]; unpack8(*(const uint4*)(row - DIN + 1536 + c0), x1); unpack8(*(const uint4*)(row - DIN + 2560 + c0), c1);
#pragma unroll
        for (int j = 0; j < 8; ++j) y[j] += p.conv_w[1 * DSB + c0 + j] * (c1[j] * x1[j]);
      }
      if (tpos >= 2) {
        float x2[8], c2[8]; unpack8(*(const uint4*)(row - 2 * DIN + 1536 + c0), x2); unpack8(*(const uint4*)(row - 2 * DIN + 2560 + c0), c2);
#pragma unroll
        for (int j = 0; j < 8; ++j) y[j] += p.conv_w[0 * DSB + c0 + j] * (c2[j] * x2[j]);
      }
      float ss = 0.f;
#pragma unroll
      for (int j = 0; j < 8; ++j) { y[j] *= bg[j]; ss += y[j] * y[j]; }
      ss = wave_sum(ss);
      const float inv = rsqrtf(ss * (1.f / DSB) + EPS);
#pragma unroll
      for (int j = 0; j < 8; ++j) y[j] = y[j] * inv * p.conv_out_g[c0 + j];
      *(uint4*)(mixed + (size_t)t * D + DSB + c0) = pack8(y);
    }
    __syncthreads();
    const int dg = lane >> 3, tg = lane & 7, bb = (chunk * 64) / SEQ, tp0 = (chunk * 64) & (SEQ - 1);
#pragma unroll
    for (int it = 0; it < 8; ++it) {
      const int d = it * 64 + wave * 8 + dg;
      unsigned w[4];
#pragma unroll
      for (int k = 0; k < 4; ++k) {
        const unsigned lo = *(const LAS u16*)(tile + (tg * 8 + 2 * k) * VTP + 2 * d), hi = *(const LAS u16*)(tile + (tg * 8 + 2 * k + 1) * VTP + 2 * d);
        w[k] = lo | (hi << 16);
      }
      *(uint4*)(vt + ((size_t)(bb * 512 + d)) * SEQ + tp0 + tg * 8) = make_uint4(w[0], w[1], w[2], w[3]);
    }
  }
}

typedef float f32x16_t __attribute__((ext_vector_type(16)));
typedef short bf16x8_t __attribute__((ext_vector_type(8)));
DI bf16x8_t pack_bf16x8(float a0, float a1, float a2, float a3, float a4, float a5, float a6, float a7) {
  pg8::u32x4 r;
  asm volatile("v_cvt_pk_bf16_f32 %0, %4, %5\n\tv_cvt_pk_bf16_f32 %1, %6, %7\n\tv_cvt_pk_bf16_f32 %2, %8, %9\n\tv_cvt_pk_bf16_f32 %3, %10, %11\n\ts_nop 1"
               : "=&v"(r[0]), "=&v"(r[1]), "=&v"(r[2]), "=&v"(r[3]) : "v"(a0), "v"(a1), "v"(a2), "v"(a3), "v"(a4), "v"(a5), "v"(a6), "v"(a7));
  return __builtin_bit_cast(bf16x8_t, r);
}
template <bool DIAG>
DI void attn_tile(const u16* __restrict__ kr, const u16* __restrict__ vr, const bf16x8_t (&qf)[4], int c, int hh, float& carry, f32x16_t& o0, f32x16_t& o1) {
  f32x16_t s;
#pragma unroll
  for (int r = 0; r < 16; ++r) s[r] = 0.f;
#pragma unroll
  for (int ks = 0; ks < 4; ++ks) s = __builtin_amdgcn_mfma_f32_32x32x16_bf16(*(const bf16x8_t*)(kr + 16 * ks), qf[ks], s, 0, 0, 0);
  const bf16x8_t v00 = *(const bf16x8_t*)(vr), v01 = *(const bf16x8_t*)(vr + 8), v10 = *(const bf16x8_t*)(vr + 32 * SEQ), v11 = *(const bf16x8_t*)(vr + 32 * SEQ + 8);
  float rr[16], be[16];
#pragma unroll
  for (int r = 0; r < 16; ++r) {
    const float e = __builtin_amdgcn_exp2f(fminf(s[r] * 0.18033688011112042f, 100.f));
    float x = __builtin_amdgcn_rcpf(1.f + e), b = e * x;
    if (DIAG) { const bool on = (16 * hh + r) < c; x = on ? x : 1.f; b = on ? b : 0.f; }
    rr[r] = x; be[r] = b;
  }
  float tot = ((rr[0] * rr[1]) * (rr[2] * rr[3])) * ((rr[4] * rr[5]) * (rr[6] * rr[7]));
  tot *= ((rr[8] * rr[9]) * (rr[10] * rr[11])) * ((rr[12] * rr[13]) * (rr[14] * rr[15]));
  const float oth = __shfl_xor(tot, 32);
  float P = hh ? carry : carry * oth;
  float a[16];
#pragma unroll
  for (int r = 15; r >= 0; --r) { a[r] = be[r] * P; P *= rr[r]; }
  carry = carry * tot * oth;
  const bf16x8_t af0 = pack_bf16x8(a[0], a[1], a[2], a[3], a[4], a[5], a[6], a[7]), af1 = pack_bf16x8(a[8], a[9], a[10], a[11], a[12], a[13], a[14], a[15]);
  o0 = __builtin_amdgcn_mfma_f32_32x32x16_bf16(v00, af0, o0, 0, 0, 0); o0 = __builtin_amdgcn_mfma_f32_32x32x16_bf16(v01, af1, o0, 0, 0, 0);
  o1 = __builtin_amdgcn_mfma_f32_32x32x16_bf16(v10, af0, o1, 0, 0, 0); o1 = __builtin_amdgcn_mfma_f32_32x32x16_bf16(v11, af1, o1, 0, 0, 0);
}
DI void attn_phase(const Params& p, const u16* __restrict__ proj, const u16* __restrict__ vt, u16* __restrict__ mixed, unsigned char* smem) {
  const int lane = threadIdx.x & 63, head = threadIdx.x >> 6, c = lane & 31, hh = lane >> 5;
  LAS float* red = (LAS float*)smem;
  const int kap = 16 * ((c >> 2) & 1) + (c & 3) + 4 * (c >> 3);
  for (int item = blockIdx.x; item < 4 * 128; item += gridDim.x) {
    const int b = item & 3, q0 = (127 - (item >> 2)) * 32;
    const size_t tq = (size_t)b * SEQ + q0 + c;
    bf16x8_t qf[4];
#pragma unroll
    for (int ks = 0; ks < 4; ++ks) qf[ks] = *(const bf16x8_t*)(proj + tq * DIN + head * 64 + 16 * ks + 8 * hh);
    f32x16_t o0, o1;
#pragma unroll
    for (int r = 0; r < 16; ++r) { o0[r] = 0.f; o1[r] = 0.f; }
    float carry = 1.f;
    const u16* kbase = proj + ((size_t)b * SEQ + kap) * DIN + 512 + head * 64 + 8 * hh;
    const u16* vbase = vt + ((size_t)(b * 512 + head * 64 + c)) * SEQ + 16 * hh;
    attn_tile<true>(kbase + (size_t)q0 * DIN, vbase + q0, qf, c, hh, carry, o0, o1);
    for (int tb = q0 - 32; tb >= 0; tb -= 32) {
      attn_tile<false>(kbase + (size_t)tb * DIN, vbase + tb, qf, c, hh, carry, o0, o1);
      if (__all(carry == 0.f)) break;
    }
    float ss = 0.f;
#pragma unroll
    for (int r = 0; r < 16; ++r) ss += o0[r] * o0[r] + o1[r] * o1[r];
    ss += __shfl_xor(ss, 32);
    __syncthreads();
    if (hh == 0) red[head * 32 + c] = ss;
    __syncthreads();
    float tot = 0.f;
#pragma unroll
    for (int h8 = 0; h8 < 8; ++h8) tot += red[h8 * 32 + c];
    const float inv = rsqrtf(tot * (1.f / DSB) + EPS);
    u16* orow = mixed + tq * D + head * 64 + 4 * hh;
    const float* g = p.sb_out_g + head * 64 + 4 * hh;
#pragma unroll
    for (int rg = 0; rg < 4; ++rg) {
      const float4 g0 = *(const float4*)(g + 8 * rg), g1 = *(const float4*)(g + 32 + 8 * rg);
      uint2 w0, w1;
      w0.x = pack2(o0[4 * rg] * inv * g0.x, o0[4 * rg + 1] * inv * g0.y); w0.y = pack2(o0[4 * rg + 2] * inv * g0.z, o0[4 * rg + 3] * inv * g0.w);
      w1.x = pack2(o1[4 * rg] * inv * g1.x, o1[4 * rg + 1] * inv * g1.y); w1.y = pack2(o1[4 * rg + 2] * inv * g1.z, o1[4 * rg + 3] * inv * g1.w);
      *(uint2*)(orow + 8 * rg) = w0; *(uint2*)(orow + 32 + 8 * rg) = w1;
    }
  }
}

#define SEL_DI DI
#define SEL_F2U(x) __float_as_uint(x)
#define SEL_U2F(x) __uint_as_float(x)

#define CE(a, b) do { const unsigned _h = (a) > (b) ? (a) : (b), _l = (a) > (b) ? (b) : (a); (a) = _h; (b) = _l; } while (0)
SEL_DI void sort16(unsigned (&v)[16]) {
  CE(v[0], v[1]); CE(v[2], v[3]); CE(v[0], v[2]); CE(v[1], v[3]); CE(v[1], v[2]); CE(v[4], v[5]); CE(v[6], v[7]); CE(v[4], v[6]);
  CE(v[5], v[7]); CE(v[5], v[6]); CE(v[0], v[4]); CE(v[2], v[6]); CE(v[2], v[4]); CE(v[1], v[5]); CE(v[3], v[7]); CE(v[3], v[5]);
  CE(v[1], v[2]); CE(v[3], v[4]); CE(v[5], v[6]); CE(v[8], v[9]); CE(v[10], v[11]); CE(v[8], v[10]); CE(v[9], v[11]); CE(v[9], v[10]);
  CE(v[12], v[13]); CE(v[14], v[15]); CE(v[12], v[14]); CE(v[13], v[15]); CE(v[13], v[14]); CE(v[8], v[12]); CE(v[10], v[14]); CE(v[10], v[12]);
  CE(v[9], v[13]); CE(v[11], v[15]); CE(v[11], v[13]); CE(v[9], v[10]); CE(v[11], v[12]); CE(v[13], v[14]); CE(v[0], v[8]); CE(v[4], v[12]);
  CE(v[4], v[8]); CE(v[2], v[10]); CE(v[6], v[14]); CE(v[6], v[10]); CE(v[2], v[4]); CE(v[6], v[8]); CE(v[10], v[12]); CE(v[1], v[9]);
  CE(v[5], v[13]); CE(v[5], v[9]); CE(v[3], v[11]); CE(v[7], v[15]); CE(v[7], v[11]); CE(v[3], v[5]); CE(v[7], v[9]); CE(v[11], v[13]);
  CE(v[1], v[2]); CE(v[3], v[4]); CE(v[5], v[6]); CE(v[7], v[8]); CE(v[9], v[10]); CE(v[11], v[12]); CE(v[13], v[14]);
}
SEL_DI void bitonic_merge16(unsigned (&v)[16]) {
#pragma unroll
  for (int d = 8; d >= 1; d >>= 1)
#pragma unroll
    for (int i = 0; i < 16; ++i) if ((i & d) == 0) CE(v[i], v[i + d]);
}
SEL_DI void merge_top16(unsigned (&a)[16], const unsigned (&b)[16]) {
#pragma unroll
  for (int i = 0; i < 16; ++i) a[i] = a[i] > b[15 - i] ? a[i] : b[15 - i];
  bitonic_merge16(a);
}
SEL_DI void top16_of_64(unsigned (&g0)[16], unsigned (&g1)[16], unsigned (&g2)[16], unsigned (&g3)[16]) {
  sort16(g0); sort16(g1); sort16(g2); sort16(g3);
  merge_top16(g0, g1); merge_top16(g2, g3); merge_top16(g0, g2);
}
SEL_DI unsigned cand_key(float a, float b, unsigned payload) {
  float s = a + b; s = s < 32.0f ? 32.0f : (s > 127.99f ? 127.99f : s);
  return ((SEL_F2U(s) << 8) & 0xFFFFC000u) | payload;
}
SEL_DI void stage2(const unsigned (&L1)[16], const unsigned (&L2)[16], unsigned (&R)[16]) {
  float f1[16], f2m[16]; unsigned P1[16], P2[16];
#pragma unroll
  for (int i = 0; i < 16; ++i) { f1[i] = SEL_U2F(L1[i] & ~127u); f2m[i] = SEL_U2F(L2[i] & ~127u) - 64.0f; P1[i] = (L1[i] & 127u) << 7; P2[i] = L2[i] & 127u; }
  unsigned K[64];
  K[0] = cand_key(f1[0], f2m[0], P1[0] | P2[0]);
  K[1] = cand_key(f1[0], f2m[1], P1[0] | P2[1]);
  K[2] = cand_key(f1[0], f2m[2], P1[0] | P2[2]);
  K[3] = cand_key(f1[0], f2m[3], P1[0] | P2[3]);
  K[4] = cand_key(f1[0], f2m[4], P1[0] | P2[4]);
  K[5] = cand_key(f1[0], f2m[5], P1[0] | P2[5]);
  K[6] = cand_key(f1[0], f2m[6], P1[0] | P2[6]);
  K[7] = cand_key(f1[0], f2m[7], P1[0] | P2[7]);
  K[8] = cand_key(f1[0], f2m[8], P1[0] | P2[8]);
  K[9] = cand_key(f1[0], f2m[9], P1[0] | P2[9]);
  K[10] = cand_key(f1[0], f2m[10], P1[0] | P2[10]);
  K[11] = cand_key(f1[0], f2m[11], P1[0] | P2[11]);
  K[12] = cand_key(f1[0], f2m[12], P1[0] | P2[12]);
  K[13] = cand_key(f1[0], f2m[13], P1[0] | P2[13]);
  K[14] = cand_key(f1[0], f2m[14], P1[0] | P2[14]);
  K[15] = cand_key(f1[0], f2m[15], P1[0] | P2[15]);
  K[16] = cand_key(f1[1], f2m[0], P1[1] | P2[0]);
  K[17] = cand_key(f1[1], f2m[1], P1[1] | P2[1]);
  K[18] = cand_key(f1[1], f2m[2], P1[1] | P2[2]);
  K[19] = cand_key(f1[1], f2m[3], P1[1] | P2[3]);
  K[20] = cand_key(f1[1], f2m[4], P1[1] | P2[4]);
  K[21] = cand_key(f1[1], f2m[5], P1[1] | P2[5]);
  K[22] = cand_key(f1[1], f2m[6], P1[1] | P2[6]);
  K[23] = cand_key(f1[1], f2m[7], P1[1] | P2[7]);
  K[24] = cand_key(f1[2], f2m[0], P1[2] | P2[0]);
  K[25] = cand_key(f1[2], f2m[1], P1[2] | P2[1]);
  K[26] = cand_key(f1[2], f2m[2], P1[2] | P2[2]);
  K[27] = cand_key(f1[2], f2m[3], P1[2] | P2[3]);
  K[28] = cand_key(f1[2], f2m[4], P1[2] | P2[4]);
  K[29] = cand_key(f1[3], f2m[0], P1[3] | P2[0]);
  K[30] = cand_key(f1[3], f2m[1], P1[3] | P2[1]);
  K[31] = cand_key(f1[3], f2m[2], P1[3] | P2[2]);
  K[32] = cand_key(f1[3], f2m[3], P1[3] | P2[3]);
  K[33] = cand_key(f1[4], f2m[0], P1[4] | P2[0]);
  K[34] = cand_key(f1[4], f2m[1], P1[4] | P2[1]);
  K[35] = cand_key(f1[4], f2m[2], P1[4] | P2[2]);
  K[36] = cand_key(f1[5], f2m[0], P1[5] | P2[0]);
  K[37] = cand_key(f1[5], f2m[1], P1[5] | P2[1]);
  K[38] = cand_key(f1[6], f2m[0], P1[6] | P2[0]);
  K[39] = cand_key(f1[6], f2m[1], P1[6] | P2[1]);
  K[40] = cand_key(f1[7], f2m[0], P1[7] | P2[0]);
  K[41] = cand_key(f1[7], f2m[1], P1[7] | P2[1]);
  K[42] = cand_key(f1[8], f2m[0], P1[8] | P2[0]);
  K[43] = cand_key(f1[9], f2m[0], P1[9] | P2[0]);
  K[44] = cand_key(f1[10], f2m[0], P1[10] | P2[0]);
  K[45] = cand_key(f1[11], f2m[0], P1[11] | P2[0]);
  K[46] = cand_key(f1[12], f2m[0], P1[12] | P2[0]);
  K[47] = cand_key(f1[13], f2m[0], P1[13] | P2[0]);
  K[48] = cand_key(f1[14], f2m[0], P1[14] | P2[0]);
  K[49] = cand_key(f1[15], f2m[0], P1[15] | P2[0]);
#pragma unroll
  for (int c = 50; c < 64; ++c) K[c] = 0u;
  unsigned g1[16], g2[16], g3[16];
#pragma unroll
  for (int i = 0; i < 16; ++i) { R[i] = K[i]; g1[i] = K[16 + i]; g2[i] = K[32 + i]; g3[i] = K[48 + i]; }
  sort16(R); sort16(g1); sort16(g2); CE(g3[0], g3[1]);
  merge_top16(R, g1);
  g2[15] = g2[15] > g3[0] ? g2[15] : g3[0]; g2[14] = g2[14] > g3[1] ? g2[14] : g3[1];
  bitonic_merge16(g2);
  merge_top16(R, g2);
}

constexpr int SKP = 272;
DI void stage1(const u16* __restrict__ qrow, const LAS unsigned char* sk, int tok, int hh, unsigned (&out)[16]) {
  f32x16_t acc[4];
#pragma unroll
  for (int kt = 0; kt < 4; ++kt)
#pragma unroll
    for (int r = 0; r < 16; ++r) acc[kt][r] = 64.0f;
#pragma unroll 1
  for (int ks = 0; ks < 8; ++ks) {
    const bf16x8_t bq = *(const bf16x8_t*)(qrow + 16 * ks + 8 * hh);
#pragma unroll
    for (int kt = 0; kt < 4; ++kt) {
      const bf16x8_t ak = *(const LAS bf16x8_t*)(sk + (32 * kt + tok) * SKP + (16 * ks + 8 * hh) * 2);
      acc[kt] = __builtin_amdgcn_mfma_f32_32x32x16_bf16(ak, bq, acc[kt], 0, 0, 0);
    }
  }
  unsigned g1[16], g2[16], g3[16];
#pragma unroll
  for (int r = 0; r < 16; ++r) {
    const unsigned ix = (unsigned)((r & 3) + 8 * (r >> 2));
    out[r] = (__float_as_uint(acc[0][r]) & ~127u) | ix; g1[r] = (__float_as_uint(acc[1][r]) & ~127u) | (32u + ix);
    g2[r] = (__float_as_uint(acc[2][r]) & ~127u) | (64u + ix); g3[r] = (__float_as_uint(acc[3][r]) & ~127u) | (96u + ix);
  }
  top16_of_64(out, g1, g2, g3);
  unsigned oth[16];
#pragma unroll
  for (int i = 0; i < 16; ++i) { out[i] |= (unsigned)(hh << 2); }
#pragma unroll
  for (int i = 0; i < 16; ++i) oth[i] = (unsigned)__shfl_xor((int)out[i], 32);
  merge_top16(out, oth);
}
DI void topk_phase(const Params& p, const u16* __restrict__ qp, const float* __restrict__ uinv, int* __restrict__ idx_out, float2* __restrict__ gu_out, unsigned char* smem) {
  const int tid = threadIdx.x;
  LAS unsigned char* sk = (LAS unsigned char*)smem;
  __syncthreads();
  for (int i = tid; i < 2 * 128 * 16; i += NTHREADS) {
    const int c = i & 15, row = i >> 4;
    const float4* s = (const float4*)(p.sub_keys + (size_t)row * 128 + c * 8);
    const float4 a = s[0], b = s[1];
    pg8::u32x4 o; o.x = pack2(a.x, a.y); o.y = pack2(a.z, a.w); o.z = pack2(b.x, b.y); o.w = pack2(b.z, b.w);
    *(LAS pg8::u32x4*)(sk + row * SKP + c * 16) = o;
  }
  __syncthreads();
  const int lane = tid & 63, tok = lane & 31, hh = lane >> 5, gw = blockIdx.x * NWAVES + (tid >> 6), nw = gridDim.x * NWAVES;
  for (int item = gw; item < (T / 32) * 4; item += nw) {
    const int t = (item >> 2) * 32 + tok, hp = item & 3;
    const u16* qt = qp + (size_t)t * 2048 + hp * 512;
    unsigned LA1[16], LA2[16], LB1[16], LB2[16];
    stage1(qt, sk, tok, hh, LA1);
    stage1(qt + 128, sk + 128 * SKP, tok, hh, LA2);
    stage1(qt + 256, sk, tok, hh, LB1);
    stage1(qt + 384, sk + 128 * SKP, tok, hh, LB2);
    unsigned L1[16], L2[16], R[16];
#pragma unroll
    for (int i = 0; i < 16; ++i) { L1[i] = hh ? LB1[i] : LA1[i]; L2[i] = hh ? LB2[i] : LA2[i]; }
    stage2(L1, L2, R);
    const int head = hp * 2 + hh;
    float ev[16], sum = 0.f;
    const float mx = __uint_as_float(0x42000000u | ((R[0] >> 14) << 6));
#pragma unroll
    for (int k = 0; k < 16; ++k) { ev[k] = __expf(__uint_as_float(0x42000000u | ((R[k] >> 14) << 6)) - mx); sum += ev[k]; }
    const float rs = 1.f / sum;
    int* io = idx_out + (size_t)t * 128 + head * 16; float2* go = gu_out + (size_t)t * 128 + head * 16;
#pragma unroll
    for (int k4 = 0; k4 < 4; ++k4) {
      int4 ex; ex.x = (int)(R[4 * k4] & 0x3FFFu); ex.y = (int)(R[4 * k4 + 1] & 0x3FFFu); ex.z = (int)(R[4 * k4 + 2] & 0x3FFFu); ex.w = (int)(R[4 * k4 + 3] & 0x3FFFu);
      ((int4*)io)[k4] = ex;
      float4 ga, gb; ga.x = ev[4 * k4] * rs; ga.y = uinv[ex.x]; ga.z = ev[4 * k4 + 1] * rs; ga.w = uinv[ex.y];
      gb.x = ev[4 * k4 + 2] * rs; gb.y = uinv[ex.z]; gb.z = ev[4 * k4 + 3] * rs; gb.w = uinv[ex.w];
      ((float4*)go)[2 * k4] = ga; ((float4*)go)[2 * k4 + 1] = gb;
    }
  }
}

typedef float f32x4_t __attribute__((ext_vector_type(4)));
typedef float f32x2_t __attribute__((ext_vector_type(2)));
typedef int i32x8_t __attribute__((ext_vector_type(8)));
constexpr int UIP = 132;
constexpr int UGP = 1032;
struct UBuf { uint4 r0, r1, r2, r3; unsigned e; float vi; };
#define U_LOAD(buf, g) do { const unsigned _e = myi[(g)]; const unsigned char* _r = U4 + (size_t)_e * 512 + xoff; \
    buf.r0 = *(const uint4*)(_r); buf.r1 = *(const uint4*)(_r + 128); buf.r2 = *(const uint4*)(_r + 256); buf.r3 = *(const uint4*)(_r + 384); \
    buf.e = _e; buf.vi = vinv[_e]; } while (0)
#define U_MMA(c, r, b) c = __builtin_amdgcn_mfma_scale_f32_16x16x128_f8f6f4((i32x8_t){(int)(r).x, (int)(r).y, (int)(r).z, (int)(r).w, 0, 0, 0, 0}, b, c, 4, 0, 0, 0x7F7F7F7F, 0, 0x7F7F7F7F)
#define U_COMP(buf, g) do { f32x4_t c = {0.f, 0.f, 0.f, 0.f}; \
    U_MMA(c, buf.r0, B0); U_MMA(c, buf.r1, B1); U_MMA(c, buf.r2, B2); U_MMA(c, buf.r3, B3); \
    const int rsel = pp & 3; const float v = rsel == 0 ? c[0] : rsel == 1 ? c[1] : rsel == 2 ? c[2] : c[3]; \
    const float vo = __shfl(v, (lane + 40) & 63); \
    if (pp < 8 && q == (pp >> 2)) { const f32x2_t gu2 = *(const LAS f32x2_t*)(myg + (g) * 8); \
      const float d = (v + vo) * gu2[1]; const float act = 0.5f * d * (1.f + erff(d * 0.70710678118654752f)); \
      uint2 o; o.x = buf.e; o.y = __float_as_uint(gu2[0] * act * buf.vi); pw[(size_t)tok * 128 + (g)] = o; } } while (0)
DI void peer_u_phase(const u16* __restrict__ xb, const float* __restrict__ rowss, const int* __restrict__ idx, const float2* __restrict__ gu,
                     const unsigned char* __restrict__ U4, const float* __restrict__ vinv, uint2* __restrict__ pw, unsigned char* smem) {
  const int lane = threadIdx.x & 63, wave = threadIdx.x >> 6, pp = lane & 15, q = lane >> 4, gw = blockIdx.x * NWAVES + wave, nw = gridDim.x * NWAVES;
  const int pi = pp & 7, x = q + 4 * (pp >> 3);
  const unsigned xoff = 16u * x;
  LAS unsigned* idl = (LAS unsigned*)(smem + wave * (8 * UIP * 4 + 8 * UGP));
  LAS unsigned char* gul = (LAS unsigned char*)(idl + 8 * UIP);
  const LAS unsigned* myi = idl + pi * UIP;
  const LAS unsigned char* myg = gul + pi * UGP;
  for (int unit = gw; unit < T / 8; unit += nw) {
    const int tok = unit * 8 + pi;
    __builtin_amdgcn_wave_barrier();
#pragma unroll
    for (int r8 = 0; r8 < 8; ++r8) {
      const int* ir = idx + (size_t)(unit * 8 + r8) * 128;
      idl[r8 * UIP + lane] = (unsigned)ir[lane]; idl[r8 * UIP + 64 + lane] = (unsigned)ir[64 + lane];
      const uint4 gv = ((const uint4*)(gu + (size_t)(unit * 8 + r8) * 128))[lane];
      pg8::u32x4 o; o.x = gv.x; o.y = gv.y; o.z = gv.z; o.w = gv.w; *(LAS pg8::u32x4*)(gul + r8 * UGP + lane * 16) = o;
    }
    __builtin_amdgcn_fence(__ATOMIC_RELEASE, "wavefront");
    __builtin_amdgcn_wave_barrier();
    const float inv = rsqrtf(rowss[tok] * (1.f / D) + EPS);
    i32x8_t B0, B1, B2, B3;
#define U_BUILD(Bv, i) do { const u16* sb = xb + (size_t)tok * D + 256 * (i) + 128 * (pp >> 3) + 16 * q; \
      _Pragma("unroll") for (int h = 0; h < 4; ++h) { float f[8]; unpack8(*(const uint4*)(sb + 64 * (h >> 1) + 8 * (h & 1)), f); int w; \
        w = __builtin_amdgcn_cvt_pk_fp8_f32(f[0] * inv, f[1] * inv, 0, false); w = __builtin_amdgcn_cvt_pk_fp8_f32(f[2] * inv, f[3] * inv, w, true); Bv[2 * h] = w; \
        w = __builtin_amdgcn_cvt_pk_fp8_f32(f[4] * inv, f[5] * inv, 0, false); w = __builtin_amdgcn_cvt_pk_fp8_f32(f[6] * inv, f[7] * inv, w, true); Bv[2 * h + 1] = w; } } while (0)
    U_BUILD(B0, 0); U_BUILD(B1, 1); U_BUILD(B2, 2); U_BUILD(B3, 3);
    UBuf b0, b1, b2, b3;
#define SB() __builtin_amdgcn_sched_barrier(0)
    U_LOAD(b0, 0); U_LOAD(b1, 1); U_LOAD(b2, 2); SB();
#pragma unroll 1
    for (int g = 0; g < 128; g += 4) {
      U_LOAD(b3, g + 3); SB(); U_COMP(b0, g); SB();
      U_LOAD(b0, (g + 4) & 127); SB(); U_COMP(b1, g + 1); SB();
      U_LOAD(b1, (g + 5) & 127); SB(); U_COMP(b2, g + 2); SB();
      U_LOAD(b2, (g + 6) & 127); SB(); U_COMP(b3, g + 3); SB();
    }
  }
}

constexpr int PEP = 1032;
typedef unsigned u32x2_t __attribute__((ext_vector_type(2)));
#define V_LOAD(PE, ROW, i0) do { _Pragma("unroll") for (int k = 0; k < 8; ++k) { PE[k] = *(const LAS u32x2_t*)(myp + ((i0) + k) * 8); \
      ROW[k] = *(const uint4*)(vbase + (PE[k].x * 128u + cc16)); } } while (0)
#define V_COMP(PE, ROW) do { _Pragma("unroll") for (int k = 0; k < 8; ++k) { const float w = __uint_as_float(PE[k].y); const f32x2_t w2 = {w, w}; \
      const unsigned dw[4] = {ROW[k].x, ROW[k].y, ROW[k].z, ROW[k].w}; \
      _Pragma("unroll") for (int c = 0; c < 4; ++c) { \
        acc[4 * c] = __builtin_elementwise_fma(w2, (f32x2_t)__builtin_amdgcn_cvt_scalef32_pk_f32_fp4(dw[c], 1.0f, 0), acc[4 * c]); \
        acc[4 * c + 1] = __builtin_elementwise_fma(w2, (f32x2_t)__builtin_amdgcn_cvt_scalef32_pk_f32_fp4(dw[c], 1.0f, 1), acc[4 * c + 1]); \
        acc[4 * c + 2] = __builtin_elementwise_fma(w2, (f32x2_t)__builtin_amdgcn_cvt_scalef32_pk_f32_fp4(dw[c], 1.0f, 2), acc[4 * c + 2]); \
        acc[4 * c + 3] = __builtin_elementwise_fma(w2, (f32x2_t)__builtin_amdgcn_cvt_scalef32_pk_f32_fp4(dw[c], 1.0f, 3), acc[4 * c + 3]); } } } while (0)
DI void peer_v_phase(const uint2* __restrict__ pw, const unsigned char* __restrict__ V8, float* __restrict__ out, unsigned char* smem, unsigned* __restrict__ qcnt, volatile LAS unsigned* misc) {
  const int lane = threadIdx.x & 63, wave = threadIdx.x >> 6, r = lane >> 3, cc = lane & 7;
  LAS unsigned char* pes = (LAS unsigned char*)smem + wave * (8 * PEP);
  const LAS unsigned char* myp = pes + r * PEP;
  const unsigned myx = xb_xcc_id() & 3u;
  for (;;) {
    __syncthreads();
    if (threadIdx.x == 0) {
      unsigned got = 0xFFFFFFFFu;
      for (unsigned k = 0; k < 4u; ++k) { const unsigned s = (myx + k) & 3u; const unsigned u = xb_add(&qcnt[64 * s], 1u); if (u < (unsigned)(T / 64)) { got = s + 4u * u; break; } }
      misc[4] = got;
    }
    __syncthreads();
    const unsigned unit = misc[4];
    if (unit == 0xFFFFFFFFu) break;
    const int j = unit & 3, t0 = (unit >> 2) * 64 + wave * 8;
    __builtin_amdgcn_wave_barrier();
    uint4 nxt[8];
#pragma unroll
    for (int r8 = 0; r8 < 8; ++r8) nxt[r8] = ((const uint4*)(pw + (size_t)(t0 + r8) * 128))[lane];
#pragma unroll
    for (int r8 = 0; r8 < 8; ++r8) { pg8::u32x4 o; o.x = nxt[r8].x; o.y = nxt[r8].y; o.z = nxt[r8].z; o.w = nxt[r8].w; *(LAS pg8::u32x4*)(pes + r8 * PEP + lane * 16) = o; }
    __builtin_amdgcn_fence(__ATOMIC_RELEASE, "wavefront");
    __builtin_amdgcn_wave_barrier();
    float4* o = (float4*)(out + (size_t)(t0 + r) * D + 256 * j + 32 * cc);
    const unsigned char* vbase = V8 + (size_t)j * ((size_t)NEXP * 128); const unsigned cc16 = 16u * cc;
    f32x2_t acc[16];
#pragma unroll
    for (int k = 0; k < 16; ++k) acc[k] = (f32x2_t){0.f, 0.f};
    u32x2_t Pa[8], Pb[8]; uint4 Ra[8], Rb[8];
    V_LOAD(Pa, Ra, 0); SB();
#pragma unroll 1
    for (int b = 0; b < 16; b += 2) {
      V_LOAD(Pb, Rb, (b + 1) * 8); SB(); V_COMP(Pa, Ra); SB();
      V_LOAD(Pa, Ra, ((b + 2) & 15) * 8); SB(); V_COMP(Pb, Rb); SB();
    }
#pragma unroll
    for (int k = 0; k < 8; ++k) { float4 v = o[k]; v.x += acc[2 * k][0]; v.y += acc[2 * k][1]; v.z += acc[2 * k + 1][0]; v.w += acc[2 * k + 1][1]; o[k] = v; }
  }
}

constexpr int NPHASE = 9;
__global__ void __launch_bounds__(NTHREADS, 2) fwd_kernel(Params p) {
  extern __shared__ __attribute__((aligned(16))) unsigned char smem[];
  cg::grid_group grid = cg::this_grid();
  unsigned char* ws = p.ws;
  u16* wt_in = (u16*)(ws + WS_WTIN); u16* wt_out = (u16*)(ws + WS_WTOUT); u16* wt_q = (u16*)(ws + WS_WTQ);
  u16* act = (u16*)(ws + WS_ACT); u16* proj = (u16*)(ws + WS_PROJ);
  int* idx = (int*)(ws + WS_IDX); float2* gu = (float2*)(ws + WS_SB); unsigned char* U8 = ws + WS_U8; unsigned char* V8 = ws + WS_V8;
  uint2* pw = (uint2*)(ws + WS_PW); float* uinv = (float*)(ws + WS_UINV); float* vinv = (float*)(ws + WS_VINV);
  float* rowss = (float*)(ws + WS_ROWSS);
  volatile LAS unsigned* misc = (volatile LAS unsigned*)(LAS unsigned char*)(smem + LDS_MISC);
  if (threadIdx.x < 8) misc[threadIdx.x] = 0u;
  __syncthreads();
  XcdBarrier bar = xcd_barrier_post((unsigned*)(ws + WS_CTL), misc);
  PG8_LAS unsigned char* lds = (PG8_LAS unsigned char*)smem;
  const int lo = p.ph_lo, hi = p.ph_hi;
#define IN(k) (lo <= (k) && (k) < hi)
#define SEAM(k) do { if (IN(k) && IN((k) + 1)) xcd_barrier(bar); } while (0)
  if (IN(0)) {
    transpose_convert(p.w_in, wt_in, D, DIN, nullptr, (float*)smem);
    transpose_convert(p.w_out, wt_out, D, D, nullptr, (float*)smem);
    transpose_convert(p.w_q, wt_q, D, 2048, p.norm2_g, (float*)smem);
    convert_fp4_rows(p.peer_u, p.norm2_g, U8, uinv);
    convert_fp4_rows_sliced(p.peer_v, V8, vinv);
    rmsnorm1024(p.x, p.norm1_g, act);
    for (int i = blockIdx.x * NTHREADS + threadIdx.x; i < T; i += gridDim.x * NTHREADS) rowss[i] = 0.f;
  }
  if (IN(0) && IN(1)) grid.sync();
  if (IN(1)) { pg8::Gemm g{act, wt_in, T, DIN, D}; pg8::StaticOrder S; S.init(T, DIN, gridDim.x, blockIdx.x);
    pg8::EpiBf16S E{proj, DIN, nullptr}; pg8::gemm_phase<pg8::EpiBf16S, pg8::StaticOrder>(lds, g, S, E, nullptr); }
  SEAM(1);
  u16* vt = (u16*)(ws + WS_SB);
  if (IN(2)) postproj_phase(p, proj, act, vt, smem);
  SEAM(2);
  if (IN(3)) attn_phase(p, proj, vt, act, smem);
  SEAM(3);
  if (IN(4)) { pg8::Gemm g{act, wt_out, T, D, D}; pg8::StaticOrder S; S.init(T, D, gridDim.x, blockIdx.x);
    pg8::EpiResid E{p.x, p.out, proj, rowss, D}; pg8::gemm_phase<pg8::EpiResid, pg8::StaticOrder>(lds, g, S, E, nullptr); }
  SEAM(4);
  u16* xb = proj;
  u16* qp = proj + (size_t)T * D;
  if (IN(5)) { pg8::Gemm g{xb, wt_q, T, 2048, D}; pg8::StaticOrder S; S.init(T, 2048, gridDim.x, blockIdx.x);
    pg8::EpiBf16S E{qp, 2048, rowss}; pg8::gemm_phase<pg8::EpiBf16S, pg8::StaticOrder>(lds, g, S, E, nullptr); }
  SEAM(5);
  if (IN(6)) topk_phase(p, qp, uinv, idx, gu, smem);
  SEAM(6);
  if (IN(7)) peer_u_phase(xb, rowss, idx, gu, U8, vinv, pw, smem);
  SEAM(7);
  if (IN(8)) peer_v_phase(pw, V8, p.out, smem, (unsigned*)(ws + WS_CTL) + 4096, misc);
}

extern "C" void kernel_launch(void* const* d_in, const int* in_sizes, int n_in, void* d_out, int out_size, void* d_ws, size_t ws_size,
                              hipStream_t stream) {
  static int grid_blocks = 0;
  if (!grid_blocks) {
    int dev = 0, cus = 0, per_cu = 0;
    (void)hipGetDevice(&dev);
    (void)hipDeviceGetAttribute(&cus, hipDeviceAttributeMultiprocessorCount, dev);
    (void)hipFuncSetAttribute((const void*)fwd_kernel, hipFuncAttributeMaxDynamicSharedMemorySize, LDS_BYTES);
    (void)hipOccupancyMaxActiveBlocksPerMultiprocessor(&per_cu, fwd_kernel, NTHREADS, LDS_BYTES);
    if (per_cu < 1) per_cu = 1;
    if (per_cu > 1) per_cu = 1;
    grid_blocks = cus * per_cu;
  }
  Params p{};
  p.x = (const float*)d_in[0]; p.norm1_g = (const float*)d_in[1]; p.w_in = (const float*)d_in[2]; p.q_norm_g = (const float*)d_in[3];
  p.k_norm_g = (const float*)d_in[4]; p.conv_w = (const float*)d_in[5]; p.sb_out_g = (const float*)d_in[6]; p.conv_out_g = (const float*)d_in[7];
  p.w_out = (const float*)d_in[8]; p.norm2_g = (const float*)d_in[9]; p.w_q = (const float*)d_in[10]; p.sub_keys = (const float*)d_in[11];
  p.peer_u = (const float*)d_in[12]; p.peer_v = (const float*)d_in[13];
  p.out = (float*)d_out; p.ws = (unsigned char*)d_ws;
  p.ph_lo = 0; p.ph_hi = NPHASE;
  (void)hipMemsetAsync((unsigned char*)d_ws + WS_CTL, 0, 4096 * 4 + 8 * 64 * 4, stream);
  void* args[] = {&p};
  hipError_t e = hipLaunchCooperativeKernel((void*)fwd_kernel, dim3(grid_blocks), dim3(NTHREADS), args, LDS_BYTES, stream);
  if (e != hipSuccess) fprintf(stderr, "cooperative launch failed: %s (grid %d)\n", hipGetErrorString(e), grid_blocks);
}
```

```cpp
#include <hip/hip_runtime.h>
#include <hip/hip_cooperative_groups.h>
#include <cstdio>
#include <cstdint>
namespace cg = cooperative_groups;

typedef unsigned short u16;
#define DI __device__ __forceinline__
#define LAS __attribute__((address_space(3)))

constexpr int T = 16384, D = 1024, SEQ = 4096;
constexpr int DIN = 3072, DSB = 512;
constexpr int NEXP = 16384;
constexpr float EPS = 1e-6f;
constexpr int NWAVES = 8, NTHREADS = NWAVES * 64;

namespace pg8 {
#define PG8_LAS __attribute__((address_space(3)))
typedef unsigned short bf16_t;
typedef short bf16x8 __attribute__((ext_vector_type(8)));
typedef float f32x4 __attribute__((ext_vector_type(4)));
typedef unsigned u32x4 __attribute__((ext_vector_type(4)));
constexpr int BM = 256, BK = 64, HALF = 128, HTB = HALF * BK * 2  , STAGE_BYTES = 8 * HTB, NXCD = 8, WGM = 8;

__host__ __device__ __forceinline__ int lds_byte(int r, int c) { const int st = (r >> 4) * 2 + (c >> 5), rr = r & 15, cc = c & 31, ob = rr * 64 + cc * 2; return st * 1024 + (ob ^ (((ob >> 9) & 1) << 5)); }
__host__ __device__ __forceinline__ void stage_rc(int b, int& R, int& C) { const int st = b / 1024, sb = b % 1024, swz = sb ^ (((sb >> 9) & 1) << 5); R = (st >> 1) * 16 + swz / 64; C = (st & 1) * 32 + (swz % 64) / 2; }
__host__ __device__ __forceinline__ int perm32(int rho) { const int n = rho >> 4, i = rho & 15; return 8 * (i >> 2) + 4 * n + (i & 3); }

struct Unit { int pm, pn; };
struct Gemm { const bf16_t* A; const bf16_t* Bt; int M, N, K; };
struct StaticOrder {
    int nM, nN, nwg, G, c;
    __host__ __device__ void init(int M, int N, int G_, int c_) { nM = M / BM; nN = N / BM; nwg = nM * nN; G = G_; c = c_; }
    __host__ __device__ bool next(int i, Unit& u) const {
        const long L = (long)i * G + c; if (L >= nwg) return false;
        int wgid = (int)L; { const int q = nwg / NXCD, r = nwg % NXCD, xcd = wgid % NXCD, off = wgid / NXCD; wgid = (xcd < r ? xcd * (q + 1) : r * (q + 1) + (xcd - r) * q) + off; }
        const int nig = WGM * nN, gid = wgid / nig, fm = gid * WGM, gsz = (nM - fm) < WGM ? (nM - fm) : WGM;
        u.pm = fm + ((wgid % nig) % gsz); u.pn = (wgid % nig) / gsz; return true;
    }
    __device__ __forceinline__ void a_ready(const Unit&) const {}
    __device__ __forceinline__ void done(const Unit&) const {}
};
__device__ __forceinline__ unsigned cvt_pk_bf16(float lo, float hi) { unsigned r; asm volatile("v_cvt_pk_bf16_f32 %0, %1, %2" : "=v"(r) : "v"(lo), "v"(hi)); return r; }

struct EpiBf16S {
    static constexpr bool PERM = true, AFTER_DRAIN = false;
    bf16_t* O; int ldc; const float* rowss;
    __device__ __forceinline__ void operator()(const f32x4 (&acc)[2][2][4][2], const Unit& u, int wr, int wc, int fr, int fq) const {
        const int row0 = u.pm * BM + wr * 64 + fr, col0 = u.pn * BM + wc * 32 + 8 * fq;
#pragma unroll
        for (int ai = 0; ai < 2; ++ai)
#pragma unroll
            for (int m = 0; m < 4; ++m) { const int row = row0 + ai * HALF + m * 16; bf16_t* rowp = O + (size_t)row * ldc + col0;
                const float sc = rowss ? rsqrtf(rowss[row] * (1.f / 1024.f) + 1e-6f) : 1.f;
#pragma unroll
                for (int bj = 0; bj < 2; ++bj) { const f32x4 v0 = acc[ai][bj][m][0] * sc, v1 = acc[ai][bj][m][1] * sc;
                    u32x4 w; w.x = cvt_pk_bf16(v0[0], v0[1]); w.y = cvt_pk_bf16(v0[2], v0[3]); w.z = cvt_pk_bf16(v1[0], v1[1]); w.w = cvt_pk_bf16(v1[2], v1[3]);
                    *(u32x4*)(rowp + bj * HALF) = w; } }
    }
};
struct EpiResid {
    static constexpr bool PERM = true, AFTER_DRAIN = false;
    const float* resid; float* out32; bf16_t* xb; float* rowss; int ldc;
    __device__ __forceinline__ void operator()(const f32x4 (&acc)[2][2][4][2], const Unit& u, int wr, int wc, int fr, int fq) const {
        const int row0 = u.pm * BM + wr * 64 + fr, col0 = u.pn * BM + wc * 32 + 8 * fq;
#pragma unroll
        for (int ai = 0; ai < 2; ++ai)
#pragma unroll
            for (int m = 0; m < 4; ++m) { const int row = row0 + ai * HALF + m * 16; const size_t off = (size_t)row * ldc + col0; float ss = 0.f;
#pragma unroll
                for (int bj = 0; bj < 2; ++bj) {
                    const f32x4 r0 = *(const f32x4*)(resid + off + bj * HALF), r1 = *(const f32x4*)(resid + off + bj * HALF + 4);
                    const f32x4 o0 = r0 + acc[ai][bj][m][0], o1 = r1 + acc[ai][bj][m][1];
                    ss += o0[0] * o0[0] + o0[1] * o0[1] + o0[2] * o0[2] + o0[3] * o0[3] + o1[0] * o1[0] + o1[1] * o1[1] + o1[2] * o1[2] + o1[3] * o1[3];
                    u32x4 w; w.x = cvt_pk_bf16(o0[0], o0[1]); w.y = cvt_pk_bf16(o0[2], o0[3]); w.z = cvt_pk_bf16(o1[0], o1[1]); w.w = cvt_pk_bf16(o1[2], o1[3]);
                    *(u32x4*)(xb + off + bj * HALF) = w; }
                ss += __shfl_xor(ss, 16); ss += __shfl_xor(ss, 32);
                if (fq == 0) unsafeAtomicAdd(rowss + row, ss); }
    }
};
template <class Epi, class Sched, bool STAMP = false>
__device__ __forceinline__ void gemm_phase(PG8_LAS unsigned char* lds, const Gemm g, const Sched& S, const Epi& E, unsigned long long* stamps) {
    const int tid = threadIdx.x, wid = __builtin_amdgcn_readfirstlane(tid >> 6), lane = tid & 63, wr = wid >> 2, wc = wid & 3, fr = lane & 15, fq = lane >> 4;
    const int K = g.K, nt = K / BK;
    int ts_lo = 0, ts_hi = 0, nts = 0; const unsigned long long rt_entry = STAMP ? (unsigned long long)wall_clock64() : 0ull;
#define PG8_STAMP() do { if (STAMP && wid == 0 && nts < 64) { const unsigned long long _c = (unsigned long long)clock64(); \
        ts_lo = (lane == nts) ? (int)(unsigned)_c : ts_lo; ts_hi = (lane == nts) ? (int)(unsigned)(_c >> 32) : ts_hi; ++nts; } } while (0)
    PG8_STAMP();
    unsigned voffA[2], voffB[2];
#pragma unroll
    for (int i = 0; i < 2; ++i) { int R, C; stage_rc(tid * 16 + i * 8192, R, C); const int Rb = Epi::PERM ? ((R & ~31) + perm32(R & 31)) : R;
        voffA[i] = (unsigned)(R * K + C) * 2u; voffB[i] = (unsigned)(Rb * K + C) * 2u; }
    const size_t kstep = (size_t)(BK * 2);
    const size_t hstep = (size_t)HALF * K * 2;
    const size_t tstep = 2 * hstep;
    const unsigned ldsw = (unsigned)wid * 1024u;
    const int aoff = lds_byte(wr * 64 + fr, fq * 8), boff = lds_byte(wc * 32 + fr, fq * 8);
#define PG8_SA(b, h) (((b) * 2 + (h)) * HTB)
#define PG8_SB(b, h) ((4 + (b) * 2 + (h)) * HTB)
#define PG8_STAGE(bufoff, gbase, voff) do { _Pragma("unroll") for (int _i = 0; _i < 2; ++_i) \
        __builtin_amdgcn_global_load_lds((const unsigned*)((const char*)(gbase) + (voff)[_i]), (PG8_LAS unsigned*)(lds + (bufoff) + ldsw + _i * 8192), 16, 0, 0); } while (0)
#define PG8_LDA(dst, b, h) do { _Pragma("unroll") for (int m = 0; m < 4; ++m) _Pragma("unroll") for (int k = 0; k < 2; ++k) dst[m][k] = *(const PG8_LAS bf16x8*)(lds + PG8_SA(b, h) + aoff + m * 2048 + k * 1024); } while (0)
#define PG8_LDB(dst, b, h) do { _Pragma("unroll") for (int n = 0; n < 2; ++n) _Pragma("unroll") for (int k = 0; k < 2; ++k) dst[n][k] = *(const PG8_LAS bf16x8*)(lds + PG8_SB(b, h) + boff + n * 2048 + k * 1024); } while (0)
#define PG8_MMA(ai, bj, At, Bt) do { __builtin_amdgcn_s_setprio(1); _Pragma("unroll") for (int m = 0; m < 4; ++m) _Pragma("unroll") for (int n = 0; n < 2; ++n) _Pragma("unroll") for (int k = 0; k < 2; ++k) \
        acc[ai][bj][m][n] = __builtin_amdgcn_mfma_f32_16x16x32_bf16(Bt[n][k], At[m][k], acc[ai][bj][m][n], 0, 0, 0); __builtin_amdgcn_s_setprio(0); } while (0)
#define PG8_WAIT_V(n) asm volatile("s_waitcnt vmcnt(" #n ")" ::: "memory")
#define PG8_WAIT_L(n) asm volatile("s_waitcnt lgkmcnt(" #n ")" ::: "memory")
#define PG8_BAR __builtin_amdgcn_s_barrier()
#define PG8_SCHED __builtin_amdgcn_sched_barrier(0)
    Unit cur, nxt; int ui = 0;
    if (!S.next(0, cur)) return;
    f32x4 acc[2][2][4][2];
#pragma unroll
    for (int a = 0; a < 2; ++a)
#pragma unroll
        for (int b = 0; b < 2; ++b)
#pragma unroll
            for (int m = 0; m < 4; ++m)
#pragma unroll
                for (int n = 0; n < 2; ++n) acc[a][b][m][n] = (f32x4){0.f, 0.f, 0.f, 0.f};
    bf16x8 At[4][2], B0[2][2], B1[2][2];
    const char* cA = (const char*)g.A + (size_t)cur.pm * tstep; const char* cB = (const char*)g.Bt + (size_t)cur.pn * tstep;
    S.a_ready(cur);
    PG8_STAGE(PG8_SB(0, 0), cB, voffB); PG8_STAGE(PG8_SA(0, 0), cA, voffA); PG8_STAGE(PG8_SB(0, 1), cB + hstep, voffB); PG8_STAGE(PG8_SA(0, 1), cA + hstep, voffA);
    if (wr == 1) PG8_BAR;
    PG8_WAIT_V(4); PG8_BAR;
    PG8_STAGE(PG8_SB(1, 0), cB + kstep, voffB); PG8_STAGE(PG8_SA(1, 0), cA + kstep, voffA); PG8_STAGE(PG8_SB(1, 1), cB + hstep + kstep, voffB);
    PG8_WAIT_V(6); PG8_BAR;
    PG8_STAMP();
    for (;;) {
        const bool has_next = S.next(ui + 1, nxt);
        const char* nA = has_next ? (const char*)g.A + (size_t)nxt.pm * tstep : cA; const char* nB = has_next ? (const char*)g.Bt + (size_t)nxt.pn * tstep : cB;
        for (int t = 0; t < nt; t += 2) {
            const bool last = (t == nt - 2);
            const char* a1 = cA + (size_t)(t + 1) * kstep;
            const char* a2 = last ? nA : cA + (size_t)(t + 2) * kstep; const char* b2 = last ? nB : cB + (size_t)(t + 2) * kstep;
            const char* a3 = a2 + kstep; const char* b3 = b2 + kstep;
            if (last && has_next) S.a_ready(nxt);
            PG8_LDB(B0, 0, 0); PG8_SCHED; PG8_LDA(At, 0, 0); PG8_STAGE(PG8_SA(1, 1), a1 + hstep, voffA);
            PG8_WAIT_L(8); PG8_BAR; PG8_WAIT_L(0); PG8_MMA(0, 0, At, B0); PG8_BAR; PG8_SCHED;
            PG8_LDB(B1, 0, 1); PG8_STAGE(PG8_SB(0, 0), b2, voffB);
            PG8_BAR; PG8_WAIT_L(0); PG8_MMA(0, 1, At, B1); PG8_BAR;
            PG8_LDA(At, 0, 1); PG8_STAGE(PG8_SA(0, 0), a2, voffA);
            PG8_BAR; PG8_WAIT_L(0); PG8_MMA(1, 0, At, B0); PG8_BAR; PG8_SCHED;
            PG8_STAGE(PG8_SB(0, 1), b2 + hstep, voffB);
            PG8_WAIT_V(6); PG8_BAR; PG8_MMA(1, 1, At, B1); PG8_BAR;
            PG8_LDB(B0, 1, 0); PG8_SCHED; PG8_LDA(At, 1, 0); PG8_STAGE(PG8_SA(0, 1), a2 + hstep, voffA);
            PG8_WAIT_L(8); PG8_BAR; PG8_WAIT_L(0); PG8_MMA(0, 0, At, B0); PG8_BAR; PG8_SCHED;
            PG8_LDB(B1, 1, 1); PG8_STAGE(PG8_SB(1, 0), b3, voffB);
            PG8_BAR; PG8_WAIT_L(0); PG8_MMA(0, 1, At, B1); PG8_BAR;
            PG8_LDA(At, 1, 1); PG8_STAGE(PG8_SA(1, 0), a3, voffA);
            PG8_BAR; PG8_WAIT_L(0); PG8_MMA(1, 0, At, B0); PG8_BAR; PG8_SCHED;
            PG8_STAGE(PG8_SB(1, 1), b3 + hstep, voffB);
            PG8_WAIT_V(6); PG8_BAR; PG8_MMA(1, 1, At, B1); PG8_BAR;
        }
        PG8_STAMP();
        if constexpr (!Epi::AFTER_DRAIN) { E(acc, cur, wr, wc, fr, fq); S.done(cur); }
        PG8_STAMP();
        if (!has_next) break;
#pragma unroll
        for (int a = 0; a < 2; ++a)
#pragma unroll
            for (int b = 0; b < 2; ++b)
#pragma unroll
                for (int m = 0; m < 4; ++m)
#pragma unroll
                    for (int n = 0; n < 2; ++n) acc[a][b][m][n] = (f32x4){0.f, 0.f, 0.f, 0.f};
        cur = nxt; cA = nA; cB = nB; ++ui;
    }
    PG8_WAIT_V(0);
    if (wr == 0) PG8_BAR;
    PG8_BAR;
    if constexpr (Epi::AFTER_DRAIN) { E.fused(acc, cur, wr, wc, fr, fq, lds, wid, lane); S.done(cur); }
    PG8_STAMP();
    if (STAMP && wid == 0) { stamps[lane] = lane < nts ? (((unsigned long long)(unsigned)ts_hi << 32) | (unsigned)ts_lo) : 0ull;
        if (lane == 62) stamps[62] = rt_entry; if (lane == 63) stamps[63] = (unsigned long long)wall_clock64(); }
#undef PG8_STAMP
#undef PG8_SA
#undef PG8_SB
#undef PG8_STAGE
#undef PG8_LDA
#undef PG8_LDB
#undef PG8_MMA
#undef PG8_WAIT_V
#undef PG8_WAIT_L
#undef PG8_BAR
#undef PG8_SCHED
}
}


constexpr size_t MBy = 1u << 20;
constexpr size_t WS_WTIN = 0, WS_WTOUT = 6 * MBy, WS_WTQ = 8 * MBy, WS_CTL = 12 * MBy, WS_ROWSS = 12 * MBy + 65536, WS_ACT = 13 * MBy, WS_PROJ = 45 * MBy,
                 WS_SB = 141 * MBy, WS_IDX = 173 * MBy, WS_GATE = 181 * MBy, WS_U8 = 189 * MBy, WS_V8 = 205 * MBy, WS_PW = 221 * MBy,
                 WS_UINV = 12 * MBy + 262144, WS_VINV = 12 * MBy + 393216;
constexpr int LDS_MISC = pg8::STAGE_BYTES, LDS_BYTES = pg8::STAGE_BYTES + 256;

struct Params {
  const float *x, *norm1_g, *w_in, *q_norm_g, *k_norm_g, *conv_w, *sb_out_g, *conv_out_g, *w_out, *norm2_g, *w_q, *sub_keys, *peer_u, *peer_v;
  float* out; unsigned char* ws; int ph_lo, ph_hi;
};

#define XB_TMO      128
#define XB_XCNT(j)  (256  + 64 * (j))
#define XB_XSUB(j)  (1280 + 64 * (j))
#define XB_XGEN(j)  (2304 + 64 * (j))
#define XB_TOP      3328
#define XB_TOPGEN   3392
#define XCD_BAR_WORDS 3456
#define XB_SPIN_CAP (1u << 18)
DI unsigned xb_ld(unsigned* p) { return __hip_atomic_load(p, __ATOMIC_RELAXED, __HIP_MEMORY_SCOPE_AGENT); }
DI unsigned xb_add(unsigned* p, unsigned v) { return __hip_atomic_fetch_add(p, v, __ATOMIC_RELAXED, __HIP_MEMORY_SCOPE_AGENT); }
DI unsigned xb_xcc_id() { return (unsigned)__builtin_amdgcn_s_getreg((3 << 11) | 20) & 0xFu; }
#define XB_SPIN(cond, bar) do { unsigned _sp = 0; while (cond) { __builtin_amdgcn_s_sleep(1); \
    if ((++_sp & 255u) == 0u) { if (xb_ld(&(bar)[XB_TMO])) break; if (_sp > XB_SPIN_CAP) { atomicAdd(&(bar)[XB_TMO], 1u); break; } } } } while (0)
struct XcdBarrier { unsigned* bar; unsigned x; volatile LAS unsigned* st; };
DI XcdBarrier xcd_barrier_post(unsigned* bar, volatile LAS unsigned* st) {
  XcdBarrier b; b.bar = bar; b.x = xb_xcc_id(); b.st = st;
  if (threadIdx.x == 0) (void)xb_add(&bar[XB_XCNT(b.x)], 1u);
  return b;
}
DI void xcd_barrier_complete(unsigned* bar, unsigned x, unsigned& nloc, unsigned& nx) {
  const unsigned G = gridDim.x * gridDim.y * gridDim.z;
  unsigned sum, cnt, mine, sp = 0u;
  for (;;) {
    sum = 0u; cnt = 0u; mine = 0u;
#pragma unroll
    for (unsigned j = 0; j < 16; ++j) { const unsigned c = xb_ld(&bar[XB_XCNT(j)]); sum += c; cnt += (c > 0u) ? 1u : 0u; mine = (j == x) ? c : mine; }
    if (sum == G) break;
    __builtin_amdgcn_s_sleep(1);
    if ((++sp & 255u) == 0u) { if (xb_ld(&bar[XB_TMO])) break; if (sp > XB_SPIN_CAP) { atomicAdd(&bar[XB_TMO], 1u); break; } }
  }
  nloc = mine > 0u ? mine : 1u; nx = cnt > 0u ? cnt : 1u;
}
DI void xcd_barrier(const XcdBarrier& b) {
  asm volatile("s_waitcnt vmcnt(0)" ::: "memory");
  __syncthreads();
  if (threadIdx.x == 0) {
    unsigned* bar = b.bar;
    __builtin_amdgcn_s_waitcnt(0);
    unsigned nloc = b.st[0], nx = b.st[1];
    if (nloc == 0u) { xcd_barrier_complete(bar, b.x, nloc, nx); b.st[0] = nloc; b.st[1] = nx; }
    const unsigned old = xb_add(&bar[XB_XSUB(b.x)], 1u);
    const unsigned gen = old / nloc;
    if (old + 1u == (gen + 1u) * nloc) {
      __builtin_amdgcn_fence(__ATOMIC_RELEASE, "agent");
      asm volatile("s_waitcnt vmcnt(0)" ::: "memory");
      const unsigned og = xb_add(&bar[XB_TOP], 1u);
      const unsigned tg = og / nx;
      if (og + 1u == (tg + 1u) * nx) xb_add(&bar[XB_TOPGEN], 1u);
      else XB_SPIN(xb_ld(&bar[XB_TOPGEN]) == tg, bar);
      __builtin_amdgcn_fence(__ATOMIC_ACQUIRE, "agent");
      xb_add(&bar[XB_XGEN(b.x)], 1u);
      asm volatile("s_waitcnt vmcnt(0)" ::: "memory");
    } else {
      XB_SPIN(xb_ld(&bar[XB_XGEN(b.x)]) == gen, bar);
      __builtin_amdgcn_fence(__ATOMIC_ACQUIRE, "agent");
      asm volatile("s_waitcnt vmcnt(0)" ::: "memory");
    }
  }
  __syncthreads();
}

DI u16 f2bf(float x) { unsigned u = __float_as_uint(x); u += 0x7fffu + ((u >> 16) & 1u); return (u16)(u >> 16); }
DI float bflo(unsigned w) { return __uint_as_float(w << 16); }
DI float bfhi(unsigned w) { return __uint_as_float(w & 0xffff0000u); }
DI unsigned pack2(float a, float b) { return (unsigned)f2bf(a) | ((unsigned)f2bf(b) << 16); }
DI float wave_sum(float v) {
#pragma unroll
  for (int o = 32; o >= 1; o >>= 1) v += __shfl_xor(v, o);
  return v;
}
DI float wave_max(float v) {
#pragma unroll
  for (int o = 32; o >= 1; o >>= 1) v = fmaxf(v, __shfl_xor(v, o));
  return v;
}
DI void unpack8(const uint4 w, float* f) {
  f[0] = bflo(w.x); f[1] = bfhi(w.x); f[2] = bflo(w.y); f[3] = bfhi(w.y); f[4] = bflo(w.z); f[5] = bfhi(w.z); f[6] = bflo(w.w); f[7] = bfhi(w.w);
}
DI uint4 pack8(const float* f) { uint4 o; o.x = pack2(f[0], f[1]); o.y = pack2(f[2], f[3]); o.z = pack2(f[4], f[5]); o.w = pack2(f[6], f[7]); return o; }

DI void transpose_convert(const float* __restrict__ W, u16* __restrict__ Wt, int K, int N, const float* __restrict__ rg, float* sm) {
  const int tid = threadIdx.x, tn_cnt = N / 64, ntile = (K / 64) * tn_cnt;
  for (int tile = blockIdx.x; tile < ntile; tile += gridDim.x) {
    const int tk = tile / tn_cnt, tn = tile % tn_cnt;
    __syncthreads();
#pragma unroll
    for (int r = 0; r < 8; ++r) { const int row = r * 8 + (tid >> 6), col = tid & 63;
      const float g = rg ? rg[tk * 64 + row] : 1.f;
      sm[row * 65 + col] = W[(size_t)(tk * 64 + row) * N + tn * 64 + col] * g; }
    __syncthreads();
#pragma unroll
    for (int r = 0; r < 8; ++r) { const int nrow = r * 8 + (tid >> 6), kcol = tid & 63; Wt[(size_t)(tn * 64 + nrow) * K + tk * 64 + kcol] = f2bf(sm[kcol * 65 + nrow]); }
  }
}
template <bool SLICED>
DI void convert_fp8_rows(const float* __restrict__ src, const float* __restrict__ cg, unsigned char* __restrict__ dst, float* __restrict__ inv_out) {
  const int lane = threadIdx.x & 63, gw = blockIdx.x * NWAVES + (threadIdx.x >> 6), nw = gridDim.x * NWAVES;
  float g[16];
#pragma unroll
  for (int j = 0; j < 16; ++j) g[j] = cg ? cg[16 * lane + j] : 1.f;
  for (int row = gw; row < NEXP; row += nw) {
    const float4* s = (const float4*)(src + (size_t)row * D + 16 * lane);
    float v[16];
#pragma unroll
    for (int k = 0; k < 4; ++k) { const float4 a = s[k]; v[4 * k] = a.x * g[4 * k]; v[4 * k + 1] = a.y * g[4 * k + 1]; v[4 * k + 2] = a.z * g[4 * k + 2]; v[4 * k + 3] = a.w * g[4 * k + 3]; }
    float am = 0.f;
#pragma unroll
    for (int j = 0; j < 16; ++j) am = fmaxf(am, fabsf(v[j]));
    am = wave_max(am);
    const float sc = am > 0.f ? 240.f / am : 1.f;
    uint4 o;
    { int w;
      w = __builtin_amdgcn_cvt_pk_fp8_f32(v[0] * sc, v[1] * sc, 0, false); w = __builtin_amdgcn_cvt_pk_fp8_f32(v[2] * sc, v[3] * sc, w, true); o.x = (unsigned)w;
      w = __builtin_amdgcn_cvt_pk_fp8_f32(v[4] * sc, v[5] * sc, 0, false); w = __builtin_amdgcn_cvt_pk_fp8_f32(v[6] * sc, v[7] * sc, w, true); o.y = (unsigned)w;
      w = __builtin_amdgcn_cvt_pk_fp8_f32(v[8] * sc, v[9] * sc, 0, false); w = __builtin_amdgcn_cvt_pk_fp8_f32(v[10] * sc, v[11] * sc, w, true); o.z = (unsigned)w;
      w = __builtin_amdgcn_cvt_pk_fp8_f32(v[12] * sc, v[13] * sc, 0, false); w = __builtin_amdgcn_cvt_pk_fp8_f32(v[14] * sc, v[15] * sc, w, true); o.w = (unsigned)w; }
    if (SLICED) *(uint4*)(dst + (size_t)(lane >> 3) * ((size_t)NEXP * 128) + (size_t)row * 128 + 16 * (lane & 7)) = o;
    else *(uint4*)(dst + (size_t)row * D + 16 * lane) = o;
    if (lane == 0) inv_out[row] = am > 0.f ? am * (1.f / 240.f) : 1.f;
  }
}
DI void convert_fp4_rows_sliced(const float* __restrict__ src, unsigned char* __restrict__ dst, float* __restrict__ inv_out) {
  const int lane = threadIdx.x & 63, gw = blockIdx.x * NWAVES + (threadIdx.x >> 6), nw = gridDim.x * NWAVES;
  for (int row = gw; row < NEXP; row += nw) {
    const float4* s = (const float4*)(src + (size_t)row * D + 16 * lane);
    float v[16];
#pragma unroll
    for (int k = 0; k < 4; ++k) { const float4 a = s[k]; v[4 * k] = a.x; v[4 * k + 1] = a.y; v[4 * k + 2] = a.z; v[4 * k + 3] = a.w; }
    float am = 0.f;
#pragma unroll
    for (int j = 0; j < 16; ++j) am = fmaxf(am, fabsf(v[j]));
    am = wave_max(am);
    const float sc = am > 0.f ? 6.f / am : 1.f;
    unsigned w0 = 0u, w1 = 0u;
    w0 = __builtin_amdgcn_cvt_scalef32_pk_fp4_f32(w0, v[0] * sc, v[1] * sc, 1.0f, 0); w0 = __builtin_amdgcn_cvt_scalef32_pk_fp4_f32(w0, v[2] * sc, v[3] * sc, 1.0f, 1);
    w0 = __builtin_amdgcn_cvt_scalef32_pk_fp4_f32(w0, v[4] * sc, v[5] * sc, 1.0f, 2); w0 = __builtin_amdgcn_cvt_scalef32_pk_fp4_f32(w0, v[6] * sc, v[7] * sc, 1.0f, 3);
    w1 = __builtin_amdgcn_cvt_scalef32_pk_fp4_f32(w1, v[8] * sc, v[9] * sc, 1.0f, 0); w1 = __builtin_amdgcn_cvt_scalef32_pk_fp4_f32(w1, v[10] * sc, v[11] * sc, 1.0f, 1);
    w1 = __builtin_amdgcn_cvt_scalef32_pk_fp4_f32(w1, v[12] * sc, v[13] * sc, 1.0f, 2); w1 = __builtin_amdgcn_cvt_scalef32_pk_fp4_f32(w1, v[14] * sc, v[15] * sc, 1.0f, 3);
    *(uint2*)(dst + (size_t)(lane >> 4) * ((size_t)NEXP * 128) + (size_t)row * 128 + 8 * (lane & 15)) = make_uint2(w0, w1);
    if (lane == 0) inv_out[row] = am > 0.f ? am * (1.f / 6.f) : 1.f;
  }
}
DI void convert_fp4_rows(const float* __restrict__ src, const float* __restrict__ cg, unsigned char* __restrict__ dst, float* __restrict__ inv_out) {
  const int lane = threadIdx.x & 63, gw = blockIdx.x * NWAVES + (threadIdx.x >> 6), nw = gridDim.x * NWAVES;
  float g[16];
#pragma unroll
  for (int j = 0; j < 16; ++j) g[j] = cg[16 * lane + j];
  for (int row = gw; row < NEXP; row += nw) {
    const float4* s = (const float4*)(src + (size_t)row * D + 16 * lane);
    float v[16];
#pragma unroll
    for (int k = 0; k < 4; ++k) { const float4 a = s[k]; v[4 * k] = a.x * g[4 * k]; v[4 * k + 1] = a.y * g[4 * k + 1]; v[4 * k + 2] = a.z * g[4 * k + 2]; v[4 * k + 3] = a.w * g[4 * k + 3]; }
    float am = 0.f;
#pragma unroll
    for (int j = 0; j < 16; ++j) am = fmaxf(am, fabsf(v[j]));
    am = wave_max(am);
    const float sc = am > 0.f ? 6.f / am : 1.f;
    unsigned w0 = 0u, w1 = 0u;
    w0 = __builtin_amdgcn_cvt_scalef32_pk_fp4_f32(w0, v[0] * sc, v[1] * sc, 1.0f, 0); w0 = __builtin_amdgcn_cvt_scalef32_pk_fp4_f32(w0, v[2] * sc, v[3] * sc, 1.0f, 1);
    w0 = __builtin_amdgcn_cvt_scalef32_pk_fp4_f32(w0, v[4] * sc, v[5] * sc, 1.0f, 2); w0 = __builtin_amdgcn_cvt_scalef32_pk_fp4_f32(w0, v[6] * sc, v[7] * sc, 1.0f, 3);
    w1 = __builtin_amdgcn_cvt_scalef32_pk_fp4_f32(w1, v[8] * sc, v[9] * sc, 1.0f, 0); w1 = __builtin_amdgcn_cvt_scalef32_pk_fp4_f32(w1, v[10] * sc, v[11] * sc, 1.0f, 1);
    w1 = __builtin_amdgcn_cvt_scalef32_pk_fp4_f32(w1, v[12] * sc, v[13] * sc, 1.0f, 2); w1 = __builtin_amdgcn_cvt_scalef32_pk_fp4_f32(w1, v[14] * sc, v[15] * sc, 1.0f, 3);
    *(uint2*)(dst + (size_t)row * 512 + 8 * lane) = make_uint2(w0, w1);
    if (lane == 0) inv_out[row] = am > 0.f ? am * (1.f / 6.f) : 1.f;
  }
}
DI void rmsnorm1024(const float* __restrict__ src, const float* __restrict__ g, u16* __restrict__ dst) {
  const int lane = threadIdx.x & 63, gw = blockIdx.x * NWAVES + (threadIdx.x >> 6), nw = gridDim.x * NWAVES;
  for (int row = gw; row < T; row += nw) {
    const float4* xr = (const float4*)(src + (size_t)row * D);
    float4 v[4]; float ss = 0.f;
#pragma unroll
    for (int j = 0; j < 4; ++j) { v[j] = xr[lane + 64 * j]; ss += v[j].x * v[j].x + v[j].y * v[j].y + v[j].z * v[j].z + v[j].w * v[j].w; }
    ss = wave_sum(ss);
    const float inv = rsqrtf(ss * (1.f / D) + EPS);
#pragma unroll
    for (int j = 0; j < 4; ++j) {
      const float4 gg = ((const float4*)g)[lane + 64 * j];
      uint2 o; o.x = pack2(v[j].x * inv * gg.x, v[j].y * inv * gg.y); o.y = pack2(v[j].z * inv * gg.z, v[j].w * inv * gg.w);
      *(uint2*)(dst + (size_t)row * D + 4 * (lane + 64 * j)) = o;
    }
  }
}

constexpr int VTP = 1028;
DI void postproj_phase(const Params& p, u16* __restrict__ proj, u16* __restrict__ mixed, u16* __restrict__ vt, unsigned char* smem) {
  const int lane = threadIdx.x & 63, wave = threadIdx.x >> 6;
  LAS unsigned char* tile = (LAS unsigned char*)smem;
  for (int chunk = blockIdx.x; chunk < T / 64; chunk += gridDim.x) {
    __syncthreads();
    for (int i = 0; i < 8; ++i) {
      const int tl = wave * 8 + i, t = chunk * 64 + tl;
      u16* row = proj + (size_t)t * DIN;
#pragma unroll
      for (int which = 0; which < 2; ++which) {
        float f[8]; unpack8(*(const uint4*)(row + which * 512 + 8 * lane), f);
        float ss = 0.f;
#pragma unroll
        for (int j = 0; j < 8; ++j) ss += f[j] * f[j];
        ss += __shfl_xor(ss, 1); ss += __shfl_xor(ss, 2); ss += __shfl_xor(ss, 4);
        const float inv = rsqrtf(ss * (1.f / 64.f) + EPS);
        const float* g = (which == 0 ? p.q_norm_g : p.k_norm_g) + 8 * (lane & 7);
#pragma unroll
        for (int j = 0; j < 8; ++j) f[j] = f[j] * inv * g[j];
        *(uint4*)(row + which * 512 + 8 * lane) = pack8(f);
      }
      { const uint4 v = *(const uint4*)(row + 1024 + 8 * lane);
        LAS unsigned* d = (LAS unsigned*)(tile + tl * VTP + 16 * lane); d[0] = v.x; d[1] = v.y; d[2] = v.z; d[3] = v.w; }
      const int c0 = 8 * lane, tpos = t & (SEQ - 1);
      float xc[8], bg[8], cg[8], y[8];
      unpack8(*(const uint4*)(row + 1536 + c0), xc); unpack8(*(const uint4*)(row + 2048 + c0), bg); unpack8(*(const uint4*)(row + 2560 + c0), cg);
#pragma unroll
      for (int j = 0; j < 8; ++j) y[j] = p.conv_w[2 * DSB + c0 + j] * (cg[j] * xc[j]);
      if (tpos >= 1) {
        float x1[8], c1[8]; unpack8(*(const uint4*)(row - DIN + 1536 + c0), x1); unpack8(*(const uint4*)(row - DIN + 2560 + c0), c1);
#pragma unroll
        for (int j = 0; j < 8; ++j) y[j] += p.conv_w[1 * DSB + c0 + j] * (c1[j] * x1[j]);
      }
      if (tpos >= 2) {
        float x2[8], c2[8]; unpack8(*(const uint4*)(row - 2 * DIN + 1536 + c0), x2); unpack8(*(const uint4*)(row - 2 * DIN + 2560 + c0), c2);
#pragma unroll
        for (int j = 0; j < 8; ++j) y[j] += p.conv_w[0 * DSB + c0 + j] * (c2[j] * x2[j]);
      }
      float ss = 0.f;
#pragma unroll
      for (int j = 0; j < 8; ++j) { y[j] *= bg[j]; ss += y[j] * y[j]; }
      ss = wave_sum(ss);
      const float inv = rsqrtf(ss * (1.f / DSB) + EPS);
#pragma unroll
      for (int j = 0; j < 8; ++j) y[j] = y[j] * inv * p.conv_out_g[c0 + j];
      *(uint4*)(mixed + (size_t)t * D + DSB + c0) = pack8(y);
    }
    __syncthreads();
    const int dg = lane >> 3, tg = lane & 7, bb = (chunk * 64) / SEQ, tp0 = (chunk * 64) & (SEQ - 1);
#pragma unroll
    for (int it = 0; it < 8; ++it) {
      const int d = it * 64 + wave * 8 + dg;
      unsigned w[4];
#pragma unroll
      for (int k = 0; k < 4; ++k) {
        const unsigned lo = *(const LAS u16*)(tile + (tg * 8 + 2 * k) * VTP + 2 * d), hi = *(const LAS u16*)(tile + (tg * 8 + 2 * k + 1) * VTP + 2 * d);
        w[k] = lo | (hi << 16);
      }
      *(uint4*)(vt + ((size_t)(bb * 512 + d)) * SEQ + tp0 + tg * 8) = make_uint4(w[0], w[1], w[2], w[3]);
    }
  }
}

typedef float f32x16_t __attribute__((ext_vector_type(16)));
typedef short bf16x8_t __attribute__((ext_vector_type(8)));
DI bf16x8_t pack_bf16x8(float a0, float a1, float a2, float a3, float a4, float a5, float a6, float a7) {
  pg8::u32x4 r;
  asm volatile("v_cvt_pk_bf16_f32 %0, %4, %5\n\tv_cvt_pk_bf16_f32 %1, %6, %7\n\tv_cvt_pk_bf16_f32 %2, %8, %9\n\tv_cvt_pk_bf16_f32 %3, %10, %11\n\ts_nop 1"
               : "=&v"(r[0]), "=&v"(r[1]), "=&v"(r[2]), "=&v"(r[3]) : "v"(a0), "v"(a1), "v"(a2), "v"(a3), "v"(a4), "v"(a5), "v"(a6), "v"(a7));
  return __builtin_bit_cast(bf16x8_t, r);
}
template <bool DIAG>
DI void attn_tile(const u16* __restrict__ kr, const u16* __restrict__ vr, const bf16x8_t (&qf)[4], int c, int hh, float& carry, f32x16_t& o0, f32x16_t& o1) {
  f32x16_t s;
#pragma unroll
  for (int r = 0; r < 16; ++r) s[r] = 0.f;
#pragma unroll
  for (int ks = 0; ks < 4; ++ks) s = __builtin_amdgcn_mfma_f32_32x32x16_bf16(*(const bf16x8_t*)(kr + 16 * ks), qf[ks], s, 0, 0, 0);
  const bf16x8_t v00 = *(const bf16x8_t*)(vr), v01 = *(const bf16x8_t*)(vr + 8), v10 = *(const bf16x8_t*)(vr + 32 * SEQ), v11 = *(const bf16x8_t*)(vr + 32 * SEQ + 8);
  float rr[16], be[16];
#pragma unroll
  for (int r = 0; r < 16; ++r) {
    const float e = __builtin_amdgcn_exp2f(fminf(s[r] * 0.18033688011112042f, 100.f));
    float x = __builtin_amdgcn_rcpf(1.f + e), b = e * x;
    if (DIAG) { const bool on = (16 * hh + r) < c; x = on ? x : 1.f; b = on ? b : 0.f; }
    rr[r] = x; be[r] = b;
  }
  float tot = ((rr[0] * rr[1]) * (rr[2] * rr[3])) * ((rr[4] * rr[5]) * (rr[6] * rr[7]));
  tot *= ((rr[8] * rr[9]) * (rr[10] * rr[11])) * ((rr[12] * rr[13]) * (rr[14] * rr[15]));
  const float oth = __shfl_xor(tot, 32);
  float P = hh ? carry : carry * oth;
  float a[16];
#pragma unroll
  for (int r = 15; r >= 0; --r) { a[r] = be[r] * P; P *= rr[r]; }
  carry = carry * tot * oth;
  const bf16x8_t af0 = pack_bf16x8(a[0], a[1], a[2], a[3], a[4], a[5], a[6], a[7]), af1 = pack_bf16x8(a[8], a[9], a[10], a[11], a[12], a[13], a[14], a[15]);
  o0 = __builtin_amdgcn_mfma_f32_32x32x16_bf16(v00, af0, o0, 0, 0, 0); o0 = __builtin_amdgcn_mfma_f32_32x32x16_bf16(v01, af1, o0, 0, 0, 0);
  o1 = __builtin_amdgcn_mfma_f32_32x32x16_bf16(v10, af0, o1, 0, 0, 0); o1 = __builtin_amdgcn_mfma_f32_32x32x16_bf16(v11, af1, o1, 0, 0, 0);
}
DI void attn_phase(const Params& p, const u16* __restrict__ proj, const u16* __restrict__ vt, u16* __restrict__ mixed, unsigned char* smem) {
  const int lane = threadIdx.x & 63, head = threadIdx.x >> 6, c = lane & 31, hh = lane >> 5;
  LAS float* red = (LAS float*)smem;
  const int kap = 16 * ((c >> 2) & 1) + (c & 3) + 4 * (c >> 3);
  for (int item = blockIdx.x; item < 4 * 128; item += gridDim.x) {
    const int b = item & 3, q0 = (127 - (item >> 2)) * 32;
    const size_t tq = (size_t)b * SEQ + q0 + c;
    bf16x8_t qf[4];
#pragma unroll
    for (int ks = 0; ks < 4; ++ks) qf[ks] = *(const bf16x8_t*)(proj + tq * DIN + head * 64 + 16 * ks + 8 * hh);
    f32x16_t o0, o1;
#pragma unroll
    for (int r = 0; r < 16; ++r) { o0[r] = 0.f; o1[r] = 0.f; }
    float carry = 1.f;
    const u16* kbase = proj + ((size_t)b * SEQ + kap) * DIN + 512 + head * 64 + 8 * hh;
    const u16* vbase = vt + ((size_t)(b * 512 + head * 64 + c)) * SEQ + 16 * hh;
    attn_tile<true>(kbase + (size_t)q0 * DIN, vbase + q0, qf, c, hh, carry, o0, o1);
    for (int tb = q0 - 32; tb >= 0; tb -= 32) {
      attn_tile<false>(kbase + (size_t)tb * DIN, vbase + tb, qf, c, hh, carry, o0, o1);
      if (__all(carry == 0.f)) break;
    }
    float ss = 0.f;
#pragma unroll
    for (int r = 0; r < 16; ++r) ss += o0[r] * o0[r] + o1[r] * o1[r];
    ss += __shfl_xor(ss, 32);
    __syncthreads();
    if (hh == 0) red[head * 32 + c] = ss;
    __syncthreads();
    float tot = 0.f;
#pragma unroll
    for (int h8 = 0; h8 < 8; ++h8) tot += red[h8 * 32 + c];
    const float inv = rsqrtf(tot * (1.f / DSB) + EPS);
    u16* orow = mixed + tq * D + head * 64 + 4 * hh;
    const float* g = p.sb_out_g + head * 64 + 4 * hh;
#pragma unroll
    for (int rg = 0; rg < 4; ++rg) {
      const float4 g0 = *(const float4*)(g + 8 * rg), g1 = *(const float4*)(g + 32 + 8 * rg);
      uint2 w0, w1;
      w0.x = pack2(o0[4 * rg] * inv * g0.x, o0[4 * rg + 1] * inv * g0.y); w0.y = pack2(o0[4 * rg + 2] * inv * g0.z, o0[4 * rg + 3] * inv * g0.w);
      w1.x = pack2(o1[4 * rg] * inv * g1.x, o1[4 * rg + 1] * inv * g1.y); w1.y = pack2(o1[4 * rg + 2] * inv * g1.z, o1[4 * rg + 3] * inv * g1.w);
      *(uint2*)(orow + 8 * rg) = w0; *(uint2*)(orow + 32 + 8 * rg) = w1;
    }
  }
}

#define SEL_DI DI
#define SEL_F2U(x) __float_as_uint(x)
#define SEL_U2F(x) __uint_as_float(x)

#define CE(a, b) do { const unsigned _h = (a) > (b) ? (a) : (b), _l = (a) > (b) ? (b) : (a); (a) = _h; (b) = _l; } while (0)
SEL_DI void sort16(unsigned (&v)[16]) {
  CE(v[0], v[1]); CE(v[2], v[3]); CE(v[0], v[2]); CE(v[1], v[3]); CE(v[1], v[2]); CE(v[4], v[5]); CE(v[6], v[7]); CE(v[4], v[6]);
  CE(v[5], v[7]); CE(v[5], v[6]); CE(v[0], v[4]); CE(v[2], v[6]); CE(v[2], v[4]); CE(v[1], v[5]); CE(v[3], v[7]); CE(v[3], v[5]);
  CE(v[1], v[2]); CE(v[3], v[4]); CE(v[5], v[6]); CE(v[8], v[9]); CE(v[10], v[11]); CE(v[8], v[10]); CE(v[9], v[11]); CE(v[9], v[10]);
  CE(v[12], v[13]); CE(v[14], v[15]); CE(v[12], v[14]); CE(v[13], v[15]); CE(v[13], v[14]); CE(v[8], v[12]); CE(v[10], v[14]); CE(v[10], v[12]);
  CE(v[9], v[13]); CE(v[11], v[15]); CE(v[11], v[13]); CE(v[9], v[10]); CE(v[11], v[12]); CE(v[13], v[14]); CE(v[0], v[8]); CE(v[4], v[12]);
  CE(v[4], v[8]); CE(v[2], v[10]); CE(v[6], v[14]); CE(v[6], v[10]); CE(v[2], v[4]); CE(v[6], v[8]); CE(v[10], v[12]); CE(v[1], v[9]);
  CE(v[5], v[13]); CE(v[5], v[9]); CE(v[3], v[11]); CE(v[7], v[15]); CE(v[7], v[11]); CE(v[3], v[5]); CE(v[7], v[9]); CE(v[11], v[13]);
  CE(v[1], v[2]); CE(v[3], v[4]); CE(v[5], v[6]); CE(v[7], v[8]); CE(v[9], v[10]); CE(v[11], v[12]); CE(v[13], v[14]);
}
SEL_DI void bitonic_merge16(unsigned (&v)[16]) {
#pragma unroll
  for (int d = 8; d >= 1; d >>= 1)
#pragma unroll
    for (int i = 0; i < 16; ++i) if ((i & d) == 0) CE(v[i], v[i + d]);
}
SEL_DI void merge_top16(unsigned (&a)[16], const unsigned (&b)[16]) {
#pragma unroll
  for (int i = 0; i < 16; ++i) a[i] = a[i] > b[15 - i] ? a[i] : b[15 - i];
  bitonic_merge16(a);
}
SEL_DI void top16_of_64(unsigned (&g0)[16], unsigned (&g1)[16], unsigned (&g2)[16], unsigned (&g3)[16]) {
  sort16(g0); sort16(g1); sort16(g2); sort16(g3);
  merge_top16(g0, g1); merge_top16(g2, g3); merge_top16(g0, g2);
}
SEL_DI unsigned cand_key(float a, float b, unsigned payload) {
  float s = a + b; s = s < 32.0f ? 32.0f : (s > 127.99f ? 127.99f : s);
  return ((SEL_F2U(s) << 8) & 0xFFFFC000u) | payload;
}
SEL_DI void stage2(const unsigned (&L1)[16], const unsigned (&L2)[16], unsigned (&R)[16]) {
  float f1[16], f2m[16]; unsigned P1[16], P2[16];
#pragma unroll
  for (int i = 0; i < 16; ++i) { f1[i] = SEL_U2F(L1[i] & ~127u); f2m[i] = SEL_U2F(L2[i] & ~127u) - 64.0f; P1[i] = (L1[i] & 127u) << 7; P2[i] = L2[i] & 127u; }
  unsigned K[64];
  K[0] = cand_key(f1[0], f2m[0], P1[0] | P2[0]);
  K[1] = cand_key(f1[0], f2m[1], P1[0] | P2[1]);
  K[2] = cand_key(f1[0], f2m[2], P1[0] | P2[2]);
  K[3] = cand_key(f1[0], f2m[3], P1[0] | P2[3]);
  K[4] = cand_key(f1[0], f2m[4], P1[0] | P2[4]);
  K[5] = cand_key(f1[0], f2m[5], P1[0] | P2[5]);
  K[6] = cand_key(f1[0], f2m[6], P1[0] | P2[6]);
  K[7] = cand_key(f1[0], f2m[7], P1[0] | P2[7]);
  K[8] = cand_key(f1[0], f2m[8], P1[0] | P2[8]);
  K[9] = cand_key(f1[0], f2m[9], P1[0] | P2[9]);
  K[10] = cand_key(f1[0], f2m[10], P1[0] | P2[10]);
  K[11] = cand_key(f1[0], f2m[11], P1[0] | P2[11]);
  K[12] = cand_key(f1[0], f2m[12], P1[0] | P2[12]);
  K[13] = cand_key(f1[0], f2m[13], P1[0] | P2[13]);
  K[14] = cand_key(f1[0], f2m[14], P1[0] | P2[14]);
  K[15] = cand_key(f1[0], f2m[15], P1[0] | P2[15]);
  K[16] = cand_key(f1[1], f2m[0], P1[1] | P2[0]);
  K[17] = cand_key(f1[1], f2m[1], P1[1] | P2[1]);
  K[18] = cand_key(f1[1], f2m[2], P1[1] | P2[2]);
  K[19] = cand_key(f1[1], f2m[3], P1[1] | P2[3]);
  K[20] = cand_key(f1[1], f2m[4], P1[1] | P2[4]);
  K[21] = cand_key(f1[1], f2m[5], P1[1] | P2[5]);
  K[22] = cand_key(f1[1], f2m[6], P1[1] | P2[6]);
  K[23] = cand_key(f1[1], f2m[7], P1[1] | P2[7]);
  K[24] = cand_key(f1[2], f2m[0], P1[2] | P2[0]);
  K[25] = cand_key(f1[2], f2m[1], P1[2] | P2[1]);
  K[26] = cand_key(f1[2], f2m[2], P1[2] | P2[2]);
  K[27] = cand_key(f1[2], f2m[3], P1[2] | P2[3]);
  K[28] = cand_key(f1[2], f2m[4], P1[2] | P2[4]);
  K[29] = cand_key(f1[3], f2m[0], P1[3] | P2[0]);
  K[30] = cand_key(f1[3], f2m[1], P1[3] | P2[1]);
  K[31] = cand_key(f1[3], f2m[2], P1[3] | P2[2]);
  K[32] = cand_key(f1[3], f2m[3], P1[3] | P2[3]);
  K[33] = cand_key(f1[4], f2m[0], P1[4] | P2[0]);
  K[34] = cand_key(f1[4], f2m[1], P1[4] | P2[1]);
  K[35] = cand_key(f1[4], f2m[2], P1[4] | P2[2]);
  K[36] = cand_key(f1[5], f2m[0], P1[5] | P2[0]);
  K[37] = cand_key(f1[5], f2m[1], P1[5] | P2[1]);
  K[38] = cand_key(f1[6], f2m[0], P1[6] | P2[0]);
  K[39] = cand_key(f1[6], f2m[1], P1[6] | P2[1]);
  K[40] = cand_key(f1[7], f2m[0], P1[7] | P2[0]);
  K[41] = cand_key(f1[7], f2m[1], P1[7] | P2[1]);
  K[42] = cand_key(f1[8], f2m[0], P1[8] | P2[0]);
  K[43] = cand_key(f1[9], f2m[0], P1[9] | P2[0]);
  K[44] = cand_key(f1[10], f2m[0], P1[10] | P2[0]);
  K[45] = cand_key(f1[11], f2m[0], P1[11] | P2[0]);
  K[46] = cand_key(f1[12], f2m[0], P1[12] | P2[0]);
  K[47] = cand_key(f1[13], f2m[0], P1[13] | P2[0]);
  K[48] = cand_key(f1[14], f2m[0], P1[14] | P2[0]);
  K[49] = cand_key(f1[15], f2m[0], P1[15] | P2[0]);
#pragma unroll
  for (int c = 50; c < 64; ++c) K[c] = 0u;
  unsigned g1[16], g2[16], g3[16];
#pragma unroll
  for (int i = 0; i < 16; ++i) { R[i] = K[i]; g1[i] = K[16 + i]; g2[i] = K[32 + i]; g3[i] = K[48 + i]; }
  sort16(R); sort16(g1); sort16(g2); CE(g3[0], g3[1]);
  merge_top16(R, g1);
  g2[15] = g2[15] > g3[0] ? g2[15] : g3[0]; g2[14] = g2[14] > g3[1] ? g2[14] : g3[1];
  bitonic_merge16(g2);
  merge_top16(R, g2);
}

constexpr int SKP = 272;
DI void stage1(const u16* __restrict__ qrow, const LAS unsigned char* sk, int tok, int hh, unsigned (&out)[16]) {
  f32x16_t acc[4];
#pragma unroll
  for (int kt = 0; kt < 4; ++kt)
#pragma unroll
    for (int r = 0; r < 16; ++r) acc[kt][r] = 64.0f;
#pragma unroll 1
  for (int ks = 0; ks < 8; ++ks) {
    const bf16x8_t bq = *(const bf16x8_t*)(qrow + 16 * ks + 8 * hh);
#pragma unroll
    for (int kt = 0; kt < 4; ++kt) {
      const bf16x8_t ak = *(const LAS bf16x8_t*)(sk + (32 * kt + tok) * SKP + (16 * ks + 8 * hh) * 2);
      acc[kt] = __builtin_amdgcn_mfma_f32_32x32x16_bf16(ak, bq, acc[kt], 0, 0, 0);
    }
  }
  unsigned g1[16], g2[16], g3[16];
#pragma unroll
  for (int r = 0; r < 16; ++r) {
    const unsigned ix = (unsigned)((r & 3) + 8 * (r >> 2));
    out[r] = (__float_as_uint(acc[0][r]) & ~127u) | ix; g1[r] = (__float_as_uint(acc[1][r]) & ~127u) | (32u + ix);
    g2[r] = (__float_as_uint(acc[2][r]) & ~127u) | (64u + ix); g3[r] = (__float_as_uint(acc[3][r]) & ~127u) | (96u + ix);
  }
  top16_of_64(out, g1, g2, g3);
  unsigned oth[16];
#pragma unroll
  for (int i = 0; i < 16; ++i) { out[i] |= (unsigned)(hh << 2); }
#pragma unroll
  for (int i = 0; i < 16; ++i) oth[i] = (unsigned)__shfl_xor((int)out[i], 32);
  merge_top16(out, oth);
}
DI void topk_phase(const Params& p, const u16* __restrict__ qp, const float* __restrict__ uinv, int* __restrict__ idx_out, float2* __restrict__ gu_out, unsigned char* smem) {
  const int tid = threadIdx.x;
  LAS unsigned char* sk = (LAS unsigned char*)smem;
  __syncthreads();
  for (int i = tid; i < 2 * 128 * 16; i += NTHREADS) {
    const int c = i & 15, row = i >> 4;
    const float4* s = (const float4*)(p.sub_keys + (size_t)row * 128 + c * 8);
    const float4 a = s[0], b = s[1];
    pg8::u32x4 o; o.x = pack2(a.x, a.y); o.y = pack2(a.z, a.w); o.z = pack2(b.x, b.y); o.w = pack2(b.z, b.w);
    *(LAS pg8::u32x4*)(sk + row * SKP + c * 16) = o;
  }
  __syncthreads();
  const int lane = tid & 63, tok = lane & 31, hh = lane >> 5, gw = blockIdx.x * NWAVES + (tid >> 6), nw = gridDim.x * NWAVES;
  for (int item = gw; item < (T / 32) * 4; item += nw) {
    const int t = (item >> 2) * 32 + tok, hp = item & 3;
    const u16* qt = qp + (size_t)t * 2048 + hp * 512;
    unsigned LA1[16], LA2[16], LB1[16], LB2[16];
    stage1(qt, sk, tok, hh, LA1);
    stage1(qt + 128, sk + 128 * SKP, tok, hh, LA2);
    stage1(qt + 256, sk, tok, hh, LB1);
    stage1(qt + 384, sk + 128 * SKP, tok, hh, LB2);
    unsigned L1[16], L2[16], R[16];
#pragma unroll
    for (int i = 0; i < 16; ++i) { L1[i] = hh ? LB1[i] : LA1[i]; L2[i] = hh ? LB2[i] : LA2[i]; }
    stage2(L1, L2, R);
    const int head = hp * 2 + hh;
    float ev[16], sum = 0.f;
    const float mx = __uint_as_float(0x42000000u | ((R[0] >> 14) << 6));
#pragma unroll
    for (int k = 0; k < 16; ++k) { ev[k] = __expf(__uint_as_float(0x42000000u | ((R[k] >> 14) << 6)) - mx); sum += ev[k]; }
    const float rs = 1.f / sum;
    int* io = idx_out + (size_t)t * 128 + head * 16; float2* go = gu_out + (size_t)t * 128 + head * 16;
#pragma unroll
    for (int k4 = 0; k4 < 4; ++k4) {
      int4 ex; ex.x = (int)(R[4 * k4] & 0x3FFFu); ex.y = (int)(R[4 * k4 + 1] & 0x3FFFu); ex.z = (int)(R[4 * k4 + 2] & 0x3FFFu); ex.w = (int)(R[4 * k4 + 3] & 0x3FFFu);
      ((int4*)io)[k4] = ex;
      float4 ga, gb; ga.x = ev[4 * k4] * rs; ga.y = uinv[ex.x]; ga.z = ev[4 * k4 + 1] * rs; ga.w = uinv[ex.y];
      gb.x = ev[4 * k4 + 2] * rs; gb.y = uinv[ex.z]; gb.z = ev[4 * k4 + 3] * rs; gb.w = uinv[ex.w];
      ((float4*)go)[2 * k4] = ga; ((float4*)go)[2 * k4 + 1] = gb;
    }
  }
}

typedef float f32x4_t __attribute__((ext_vector_type(4)));
typedef float f32x2_t __attribute__((ext_vector_type(2)));
typedef int i32x8_t __attribute__((ext_vector_type(8)));
constexpr int UIP = 132;
constexpr int UGP = 1032;
struct UBuf { uint4 r0, r1, r2, r3; unsigned e; float vi; };
#define U_LOAD(buf, g) do { const unsigned _e = myi[(g)]; const unsigned char* _r = U4 + (size_t)_e * 512 + xoff; \
    buf.r0 = *(const uint4*)(_r); buf.r1 = *(const uint4*)(_r + 128); buf.r2 = *(const uint4*)(_r + 256); buf.r3 = *(const uint4*)(_r + 384); \
    buf.e = _e; buf.vi = vinv[_e]; } while (0)
#define U_MMA(c, r, b) c = __builtin_amdgcn_mfma_scale_f32_16x16x128_f8f6f4((i32x8_t){(int)(r).x, (int)(r).y, (int)(r).z, (int)(r).w, 0, 0, 0, 0}, b, c, 4, 0, 0, 0x7F7F7F7F, 0, 0x7F7F7F7F)
#define U_COMP(buf, g) do { f32x4_t c = {0.f, 0.f, 0.f, 0.f}; \
    U_MMA(c, buf.r0, B0); U_MMA(c, buf.r1, B1); U_MMA(c, buf.r2, B2); U_MMA(c, buf.r3, B3); \
    const int rsel = pp & 3; const float v = rsel == 0 ? c[0] : rsel == 1 ? c[1] : rsel == 2 ? c[2] : c[3]; \
    const float vo = __shfl(v, (lane + 40) & 63); \
    if (pp < 8 && q == (pp >> 2)) { const f32x2_t gu2 = *(const LAS f32x2_t*)(myg + (g) * 8); \
      const float d = (v + vo) * gu2[1]; const float act = 0.5f * d * (1.f + erff(d * 0.70710678118654752f)); \
      uint2 o; o.x = buf.e; o.y = __float_as_uint(gu2[0] * act * buf.vi); pw[(size_t)tok * 128 + (g)] = o; } } while (0)
DI void peer_u_phase(const u16* __restrict__ xb, const float* __restrict__ rowss, const int* __restrict__ idx, const float2* __restrict__ gu,
                     const unsigned char* __restrict__ U4, const float* __restrict__ vinv, uint2* __restrict__ pw, unsigned char* smem) {
  const int lane = threadIdx.x & 63, wave = threadIdx.x >> 6, pp = lane & 15, q = lane >> 4, gw = blockIdx.x * NWAVES + wave, nw = gridDim.x * NWAVES;
  const int pi = pp & 7, x = q + 4 * (pp >> 3);
  const unsigned xoff = 16u * x;
  LAS unsigned* idl = (LAS unsigned*)(smem + wave * (8 * UIP * 4 + 8 * UGP));
  LAS unsigned char* gul = (LAS unsigned char*)(idl + 8 * UIP);
  const LAS unsigned* myi = idl + pi * UIP;
  const LAS unsigned char* myg = gul + pi * UGP;
  for (int unit = gw; unit < T / 8; unit += nw) {
    const int tok = unit * 8 + pi;
    __builtin_amdgcn_wave_barrier();
#pragma unroll
    for (int r8 = 0; r8 < 8; ++r8) {
      const int* ir = idx + (size_t)(unit * 8 + r8) * 128;
      idl[r8 * UIP + lane] = (unsigned)ir[lane]; idl[r8 * UIP + 64 + lane] = (unsigned)ir[64 + lane];
      const uint4 gv = ((const uint4*)(gu + (size_t)(unit * 8 + r8) * 128))[lane];
      pg8::u32x4 o; o.x = gv.x; o.y = gv.y; o.z = gv.z; o.w = gv.w; *(LAS pg8::u32x4*)(gul + r8 * UGP + lane * 16) = o;
    }
    __builtin_amdgcn_fence(__ATOMIC_RELEASE, "wavefront");
    __builtin_amdgcn_wave_barrier();
    const float inv = rsqrtf(rowss[tok] * (1.f / D) + EPS);
    i32x8_t B0, B1, B2, B3;
#define U_BUILD(Bv, i) do { const u16* sb = xb + (size_t)tok * D + 256 * (i) + 128 * (pp >> 3) + 16 * q; \
      _Pragma("unroll") for (int h = 0; h < 4; ++h) { float f[8]; unpack8(*(const uint4*)(sb + 64 * (h >> 1) + 8 * (h & 1)), f); int w; \
        w = __builtin_amdgcn_cvt_pk_fp8_f32(f[0] * inv, f[1] * inv, 0, false); w = __builtin_amdgcn_cvt_pk_fp8_f32(f[2] * inv, f[3] * inv, w, true); Bv[2 * h] = w; \
        w = __builtin_amdgcn_cvt_pk_fp8_f32(f[4] * inv, f[5] * inv, 0, false); w = __builtin_amdgcn_cvt_pk_fp8_f32(f[6] * inv, f[7] * inv, w, true); Bv[2 * h + 1] = w; } } while (0)
    U_BUILD(B0, 0); U_BUILD(B1, 1); U_BUILD(B2, 2); U_BUILD(B3, 3);
    UBuf b0, b1, b2, b3;
#define SB() __builtin_amdgcn_sched_barrier(0)
    U_LOAD(b0, 0); U_LOAD(b1, 1); U_LOAD(b2, 2); SB();
#pragma unroll 1
    for (int g = 0; g < 128; g += 4) {
      U_LOAD(b3, g + 3); SB(); U_COMP(b0, g); SB();
      U_LOAD(b0, (g + 4) & 127); SB(); U_COMP(b1, g + 1); SB();
      U_LOAD(b1, (g + 5) & 127); SB(); U_COMP(b2, g + 2); SB();
      U_LOAD(b2, (g + 6) & 127); SB(); U_COMP(b3, g + 3); SB();
    }
  }
}

constexpr int PEP = 1032;
typedef unsigned u32x2_t __attribute__((ext_vector_type(2)));
#define V_LOAD(PE, ROW, i0) do { _Pragma("unroll") for (int k = 0; k < 8; ++k) { PE[k] = *(const LAS u32x2_t*)(myp + ((i0) + k) * 8); \
      ROW[k] = *(const uint4*)(vbase + (PE[k].x * 128u + cc16)); } } while (0)
#define V_COMP(PE, ROW) do { _Pragma("unroll") for (int k = 0; k < 8; ++k) { const float w = __uint_as_float(PE[k].y); const f32x2_t w2 = {w, w}; \
      const unsigned dw[4] = {ROW[k].x, ROW[k].y, ROW[k].z, ROW[k].w}; \
      _Pragma("unroll") for (int c = 0; c < 4; ++c) { \
        acc[4 * c] = __builtin_elementwise_fma(w2, (f32x2_t)__builtin_amdgcn_cvt_scalef32_pk_f32_fp4(dw[c], 1.0f, 0), acc[4 * c]); \
        acc[4 * c + 1] = __builtin_elementwise_fma(w2, (f32x2_t)__builtin_amdgcn_cvt_scalef32_pk_f32_fp4(dw[c], 1.0f, 1), acc[4 * c + 1]); \
        acc[4 * c + 2] = __builtin_elementwise_fma(w2, (f32x2_t)__builtin_amdgcn_cvt_scalef32_pk_f32_fp4(dw[c], 1.0f, 2), acc[4 * c + 2]); \
        acc[4 * c + 3] = __builtin_elementwise_fma(w2, (f32x2_t)__builtin_amdgcn_cvt_scalef32_pk_f32_fp4(dw[c], 1.0f, 3), acc[4 * c + 3]); } } } while (0)
DI void peer_v_phase(const uint2* __restrict__ pw, const unsigned char* __restrict__ V8, const u16* __restrict__ xb, float* __restrict__ out, unsigned char* smem, unsigned* __restrict__ qcnt, volatile LAS unsigned* misc) {
  const int lane = threadIdx.x & 63, wave = threadIdx.x >> 6, r = lane >> 3, cc = lane & 7;
  LAS unsigned char* pes = (LAS unsigned char*)smem + wave * (8 * PEP);
  const LAS unsigned char* myp = pes + r * PEP;
  const unsigned myx = xb_xcc_id() & 3u;
  for (;;) {
    __syncthreads();
    if (threadIdx.x == 0) {
      unsigned got = 0xFFFFFFFFu;
      for (unsigned k = 0; k < 4u; ++k) { const unsigned s = (myx + k) & 3u; const unsigned u = xb_add(&qcnt[64 * s], 1u); if (u < (unsigned)(T / 64)) { got = s + 4u * u; break; } }
      misc[4] = got;
    }
    __syncthreads();
    const unsigned unit = misc[4];
    if (unit == 0xFFFFFFFFu) break;
    const int j = unit & 3, t0 = (unit >> 2) * 64 + wave * 8;
    __builtin_amdgcn_wave_barrier();
    uint4 nxt[8];
#pragma unroll
    for (int r8 = 0; r8 < 8; ++r8) nxt[r8] = ((const uint4*)(pw + (size_t)(t0 + r8) * 128))[lane];
#pragma unroll
    for (int r8 = 0; r8 < 8; ++r8) { pg8::u32x4 o; o.x = nxt[r8].x; o.y = nxt[r8].y; o.z = nxt[r8].z; o.w = nxt[r8].w; *(LAS pg8::u32x4*)(pes + r8 * PEP + lane * 16) = o; }
    __builtin_amdgcn_fence(__ATOMIC_RELEASE, "wavefront");
    __builtin_amdgcn_wave_barrier();
    float4* o = (float4*)(out + (size_t)(t0 + r) * D + 256 * j + 32 * cc);
    const unsigned char* vbase = V8 + (size_t)j * ((size_t)NEXP * 128); const unsigned cc16 = 16u * cc;
    f32x2_t acc[16];
#pragma unroll
    for (int k = 0; k < 16; ++k) acc[k] = (f32x2_t){0.f, 0.f};
    u32x2_t Pa[8], Pb[8]; uint4 Ra[8], Rb[8];
    V_LOAD(Pa, Ra, 0); SB();
#pragma unroll 1
    for (int b = 0; b < 16; b += 2) {
      V_LOAD(Pb, Rb, (b + 1) * 8); SB(); V_COMP(Pa, Ra); SB();
      V_LOAD(Pa, Ra, ((b + 2) & 15) * 8); SB(); V_COMP(Pb, Rb); SB();
    }
    const uint4* xr = (const uint4*)(xb + (size_t)(t0 + r) * D + 256 * j + 32 * cc);
#pragma unroll
    for (int k4 = 0; k4 < 4; ++k4) { float f[8]; unpack8(xr[k4], f);
      float4 v0, v1;
      v0.x = f[0] + acc[4 * k4][0]; v0.y = f[1] + acc[4 * k4][1]; v0.z = f[2] + acc[4 * k4 + 1][0]; v0.w = f[3] + acc[4 * k4 + 1][1];
      v1.x = f[4] + acc[4 * k4 + 2][0]; v1.y = f[5] + acc[4 * k4 + 2][1]; v1.z = f[6] + acc[4 * k4 + 3][0]; v1.w = f[7] + acc[4 * k4 + 3][1];
      o[2 * k4] = v0; o[2 * k4 + 1] = v1; }
  }
}

constexpr int NPHASE = 9;
__global__ void __launch_bounds__(NTHREADS, 2) fwd_kernel(Params p) {
  extern __shared__ __attribute__((aligned(16))) unsigned char smem[];
  cg::grid_group grid = cg::this_grid();
  unsigned char* ws = p.ws;
  u16* wt_in = (u16*)(ws + WS_WTIN); u16* wt_out = (u16*)(ws + WS_WTOUT); u16* wt_q = (u16*)(ws + WS_WTQ);
  u16* act = (u16*)(ws + WS_ACT); u16* proj = (u16*)(ws + WS_PROJ);
  int* idx = (int*)(ws + WS_IDX); float2* gu = (float2*)(ws + WS_SB); unsigned char* U8 = ws + WS_U8; unsigned char* V8 = ws + WS_V8;
  uint2* pw = (uint2*)(ws + WS_PW); float* uinv = (float*)(ws + WS_UINV); float* vinv = (float*)(ws + WS_VINV);
  float* rowss = (float*)(ws + WS_ROWSS);
  volatile LAS unsigned* misc = (volatile LAS unsigned*)(LAS unsigned char*)(smem + LDS_MISC);
  if (threadIdx.x < 8) misc[threadIdx.x] = 0u;
  __syncthreads();
  XcdBarrier bar = xcd_barrier_post((unsigned*)(ws + WS_CTL), misc);
  PG8_LAS unsigned char* lds = (PG8_LAS unsigned char*)smem;
  const int lo = p.ph_lo, hi = p.ph_hi;
#define IN(k) (lo <= (k) && (k) < hi)
#define SEAM(k) do { if (IN(k) && IN((k) + 1)) xcd_barrier(bar); } while (0)
  if (IN(0)) {
    transpose_convert(p.w_in, wt_in, D, DIN, nullptr, (float*)smem);
    transpose_convert(p.w_out, wt_out, D, D, nullptr, (float*)smem);
    transpose_convert(p.w_q, wt_q, D, 2048, p.norm2_g, (float*)smem);
    convert_fp4_rows(p.peer_u, p.norm2_g, U8, uinv);
    convert_fp4_rows_sliced(p.peer_v, V8, vinv);
    rmsnorm1024(p.x, p.norm1_g, act);
    for (int i = blockIdx.x * NTHREADS + threadIdx.x; i < T; i += gridDim.x * NTHREADS) rowss[i] = 0.f;
  }
  if (lo < 0) grid.sync();
  SEAM(0);
  if (IN(1)) { pg8::Gemm g{act, wt_in, T, DIN, D}; pg8::StaticOrder S; S.init(T, DIN, gridDim.x, blockIdx.x);
    pg8::EpiBf16S E{proj, DIN, nullptr}; pg8::gemm_phase<pg8::EpiBf16S, pg8::StaticOrder>(lds, g, S, E, nullptr); }
  SEAM(1);
  u16* vt = (u16*)(ws + WS_SB);
  if (IN(2)) postproj_phase(p, proj, act, vt, smem);
  SEAM(2);
  if (IN(3)) attn_phase(p, proj, vt, act, smem);
  SEAM(3);
  if (IN(4)) { pg8::Gemm g{act, wt_out, T, D, D}; pg8::StaticOrder S; S.init(T, D, gridDim.x, blockIdx.x);
    pg8::EpiResid E{p.x, p.out, proj, rowss, D}; pg8::gemm_phase<pg8::EpiResid, pg8::StaticOrder>(lds, g, S, E, nullptr); }
  SEAM(4);
  u16* xb = proj;
  u16* qp = proj + (size_t)T * D;
  if (IN(5)) { pg8::Gemm g{xb, wt_q, T, 2048, D}; pg8::StaticOrder S; S.init(T, 2048, gridDim.x, blockIdx.x);
    pg8::EpiBf16S E{qp, 2048, rowss}; pg8::gemm_phase<pg8::EpiBf16S, pg8::StaticOrder>(lds, g, S, E, nullptr); }
  SEAM(5);
  if (IN(6)) topk_phase(p, qp, uinv, idx, gu, smem);
  SEAM(6);
  if (IN(7)) peer_u_phase(xb, rowss, idx, gu, U8, vinv, pw, smem);
  SEAM(7);
  if (IN(8)) peer_v_phase(pw, V8, xb, p.out, smem, (unsigned*)(ws + WS_CTL) + 4096, misc);
}

extern "C" void kernel_launch(void* const* d_in, const int* in_sizes, int n_in, void* d_out, int out_size, void* d_ws, size_t ws_size,
                              hipStream_t stream) {
  static int grid_blocks = 0;
  if (!grid_blocks) {
    int dev = 0, cus = 0, per_cu = 0;
    (void)hipGetDevice(&dev);
    (void)hipDeviceGetAttribute(&cus, hipDeviceAttributeMultiprocessorCount, dev);
    (void)hipFuncSetAttribute((const void*)fwd_kernel, hipFuncAttributeMaxDynamicSharedMemorySize, LDS_BYTES);
    (void)hipOccupancyMaxActiveBlocksPerMultiprocessor(&per_cu, fwd_kernel, NTHREADS, LDS_BYTES);
    if (per_cu < 1) per_cu = 1;
    if (per_cu > 1) per_cu = 1;
    grid_blocks = cus * per_cu;
  }
  Params p{};
  p.x = (const float*)d_in[0]; p.norm1_g = (const float*)d_in[1]; p.w_in = (const float*)d_in[2]; p.q_norm_g = (const float*)d_in[3];
  p.k_norm_g = (const float*)d_in[4]; p.conv_w = (const float*)d_in[5]; p.sb_out_g = (const float*)d_in[6]; p.conv_out_g = (const float*)d_in[7];
  p.w_out = (const float*)d_in[8]; p.norm2_g = (const float*)d_in[9]; p.w_q = (const float*)d_in[10]; p.sub_keys = (const float*)d_in[11];
  p.peer_u = (const float*)d_in[12]; p.peer_v = (const float*)d_in[13];
  p.out = (float*)d_out; p.ws = (unsigned char*)d_ws;
  p.ph_lo = 0; p.ph_hi = NPHASE;
  (void)hipMemsetAsync((unsigned char*)d_ws + WS_CTL, 0, 4096 * 4 + 8 * 64 * 4, stream);
  void* args[] = {&p};
  hipError_t e = hipLaunchCooperativeKernel((void*)fwd_kernel, dim3(grid_blocks), dim3(NTHREADS), args, LDS_BYTES, stream);
  if (e != hipSuccess) fprintf(stderr, "cooperative launch failed: %s (grid %d)\n", hipGetErrorString(e), grid_blocks);
}
```

```cpp
#include <hip/hip_runtime.h>
#include <hip/hip_cooperative_groups.h>
#include <cstdio>
#include <cstdint>
namespace cg = cooperative_groups;

typedef unsigned short u16;
#define DI __device__ __forceinline__
#define LAS __attribute__((address_space(3)))

constexpr int T = 16384, D = 1024, SEQ = 4096;
constexpr int DIN = 3072, DSB = 512;
constexpr int NEXP = 16384;
constexpr float EPS = 1e-6f;
constexpr int NWAVES = 8, NTHREADS = NWAVES * 64;

namespace pg8 {
#define PG8_LAS __attribute__((address_space(3)))
typedef unsigned short bf16_t;
typedef short bf16x8 __attribute__((ext_vector_type(8)));
typedef float f32x4 __attribute__((ext_vector_type(4)));
typedef unsigned u32x4 __attribute__((ext_vector_type(4)));
constexpr int BM = 256, BK = 64, HALF = 128, HTB = HALF * BK * 2  , STAGE_BYTES = 8 * HTB, NXCD = 8, WGM = 8;

__host__ __device__ __forceinline__ int lds_byte(int r, int c) { const int st = (r >> 4) * 2 + (c >> 5), rr = r & 15, cc = c & 31, ob = rr * 64 + cc * 2; return st * 1024 + (ob ^ (((ob >> 9) & 1) << 5)); }
__host__ __device__ __forceinline__ void stage_rc(int b, int& R, int& C) { const int st = b / 1024, sb = b % 1024, swz = sb ^ (((sb >> 9) & 1) << 5); R = (st >> 1) * 16 + swz / 64; C = (st & 1) * 32 + (swz % 64) / 2; }
__host__ __device__ __forceinline__ int perm32(int rho) { const int n = rho >> 4, i = rho & 15; return 8 * (i >> 2) + 4 * n + (i & 3); }

struct Unit { int pm, pn; };
struct Gemm { const bf16_t* A; const bf16_t* Bt; int M, N, K; };
struct StaticOrder {
    int nM, nN, nwg, G, c;
    __host__ __device__ void init(int M, int N, int G_, int c_) { nM = M / BM; nN = N / BM; nwg = nM * nN; G = G_; c = c_; }
    __host__ __device__ bool next(int i, Unit& u) const {
        const long L = (long)i * G + c; if (L >= nwg) return false;
        int wgid = (int)L; { const int q = nwg / NXCD, r = nwg % NXCD, xcd = wgid % NXCD, off = wgid / NXCD; wgid = (xcd < r ? xcd * (q + 1) : r * (q + 1) + (xcd - r) * q) + off; }
        const int nig = WGM * nN, gid = wgid / nig, fm = gid * WGM, gsz = (nM - fm) < WGM ? (nM - fm) : WGM;
        u.pm = fm + ((wgid % nig) % gsz); u.pn = (wgid % nig) / gsz; return true;
    }
    __device__ __forceinline__ void a_ready(const Unit&) const {}
    __device__ __forceinline__ void done(const Unit&) const {}
};
__device__ __forceinline__ unsigned cvt_pk_bf16(float lo, float hi) { unsigned r; asm volatile("v_cvt_pk_bf16_f32 %0, %1, %2" : "=v"(r) : "v"(lo), "v"(hi)); return r; }

struct EpiBf16S {
    static constexpr bool PERM = true, AFTER_DRAIN = false;
    bf16_t* O; int ldc; const float* rowss;
    __device__ __forceinline__ void operator()(const f32x4 (&acc)[2][2][4][2], const Unit& u, int wr, int wc, int fr, int fq) const {
        const int row0 = u.pm * BM + wr * 64 + fr, col0 = u.pn * BM + wc * 32 + 8 * fq;
#pragma unroll
        for (int ai = 0; ai < 2; ++ai)
#pragma unroll
            for (int m = 0; m < 4; ++m) { const int row = row0 + ai * HALF + m * 16; bf16_t* rowp = O + (size_t)row * ldc + col0;
                const float sc = rowss ? rsqrtf(rowss[row] * (1.f / 1024.f) + 1e-6f) : 1.f;
#pragma unroll
                for (int bj = 0; bj < 2; ++bj) { const f32x4 v0 = acc[ai][bj][m][0] * sc, v1 = acc[ai][bj][m][1] * sc;
                    u32x4 w; w.x = cvt_pk_bf16(v0[0], v0[1]); w.y = cvt_pk_bf16(v0[2], v0[3]); w.z = cvt_pk_bf16(v1[0], v1[1]); w.w = cvt_pk_bf16(v1[2], v1[3]);
                    *(u32x4*)(rowp + bj * HALF) = w; } }
    }
};
struct EpiResid {
    static constexpr bool PERM = true, AFTER_DRAIN = false;
    const float* resid; float* out32; bf16_t* xb; float* rowss; int ldc;
    __device__ __forceinline__ void operator()(const f32x4 (&acc)[2][2][4][2], const Unit& u, int wr, int wc, int fr, int fq) const {
        const int row0 = u.pm * BM + wr * 64 + fr, col0 = u.pn * BM + wc * 32 + 8 * fq;
#pragma unroll
        for (int ai = 0; ai < 2; ++ai)
#pragma unroll
            for (int m = 0; m < 4; ++m) { const int row = row0 + ai * HALF + m * 16; const size_t off = (size_t)row * ldc + col0; float ss = 0.f;
#pragma unroll
                for (int bj = 0; bj < 2; ++bj) {
                    const f32x4 r0 = *(const f32x4*)(resid + off + bj * HALF), r1 = *(const f32x4*)(resid + off + bj * HALF + 4);
                    const f32x4 o0 = r0 + acc[ai][bj][m][0], o1 = r1 + acc[ai][bj][m][1];
                    ss += o0[0] * o0[0] + o0[1] * o0[1] + o0[2] * o0[2] + o0[3] * o0[3] + o1[0] * o1[0] + o1[1] * o1[1] + o1[2] * o1[2] + o1[3] * o1[3];
                    u32x4 w; w.x = cvt_pk_bf16(o0[0], o0[1]); w.y = cvt_pk_bf16(o0[2], o0[3]); w.z = cvt_pk_bf16(o1[0], o1[1]); w.w = cvt_pk_bf16(o1[2], o1[3]);
                    *(u32x4*)(xb + off + bj * HALF) = w; }
                ss += __shfl_xor(ss, 16); ss += __shfl_xor(ss, 32);
                if (fq == 0) unsafeAtomicAdd(rowss + row, ss); }
    }
};
template <class Epi, class Sched, bool STAMP = false>
__device__ __forceinline__ void gemm_phase(PG8_LAS unsigned char* lds, const Gemm g, const Sched& S, const Epi& E, unsigned long long* stamps) {
    const int tid = threadIdx.x, wid = __builtin_amdgcn_readfirstlane(tid >> 6), lane = tid & 63, wr = wid >> 2, wc = wid & 3, fr = lane & 15, fq = lane >> 4;
    const int K = g.K, nt = K / BK;
    int ts_lo = 0, ts_hi = 0, nts = 0; const unsigned long long rt_entry = STAMP ? (unsigned long long)wall_clock64() : 0ull;
#define PG8_STAMP() do { if (STAMP && wid == 0 && nts < 64) { const unsigned long long _c = (unsigned long long)clock64(); \
        ts_lo = (lane == nts) ? (int)(unsigned)_c : ts_lo; ts_hi = (lane == nts) ? (int)(unsigned)(_c >> 32) : ts_hi; ++nts; } } while (0)
    PG8_STAMP();
    unsigned voffA[2], voffB[2];
#pragma unroll
    for (int i = 0; i < 2; ++i) { int R, C; stage_rc(tid * 16 + i * 8192, R, C); const int Rb = Epi::PERM ? ((R & ~31) + perm32(R & 31)) : R;
        voffA[i] = (unsigned)(R * K + C) * 2u; voffB[i] = (unsigned)(Rb * K + C) * 2u; }
    const size_t kstep = (size_t)(BK * 2);
    const size_t hstep = (size_t)HALF * K * 2;
    const size_t tstep = 2 * hstep;
    const unsigned ldsw = (unsigned)wid * 1024u;
    const int aoff = lds_byte(wr * 64 + fr, fq * 8), boff = lds_byte(wc * 32 + fr, fq * 8);
#define PG8_SA(b, h) (((b) * 2 + (h)) * HTB)
#define PG8_SB(b, h) ((4 + (b) * 2 + (h)) * HTB)
#define PG8_STAGE(bufoff, gbase, voff) do { _Pragma("unroll") for (int _i = 0; _i < 2; ++_i) \
        __builtin_amdgcn_global_load_lds((const unsigned*)((const char*)(gbase) + (voff)[_i]), (PG8_LAS unsigned*)(lds + (bufoff) + ldsw + _i * 8192), 16, 0, 0); } while (0)
#define PG8_LDA(dst, b, h) do { _Pragma("unroll") for (int m = 0; m < 4; ++m) _Pragma("unroll") for (int k = 0; k < 2; ++k) dst[m][k] = *(const PG8_LAS bf16x8*)(lds + PG8_SA(b, h) + aoff + m * 2048 + k * 1024); } while (0)
#define PG8_LDB(dst, b, h) do { _Pragma("unroll") for (int n = 0; n < 2; ++n) _Pragma("unroll") for (int k = 0; k < 2; ++k) dst[n][k] = *(const PG8_LAS bf16x8*)(lds + PG8_SB(b, h) + boff + n * 2048 + k * 1024); } while (0)
#define PG8_MMA(ai, bj, At, Bt) do { __builtin_amdgcn_s_setprio(1); _Pragma("unroll") for (int m = 0; m < 4; ++m) _Pragma("unroll") for (int n = 0; n < 2; ++n) _Pragma("unroll") for (int k = 0; k < 2; ++k) \
        acc[ai][bj][m][n] = __builtin_amdgcn_mfma_f32_16x16x32_bf16(Bt[n][k], At[m][k], acc[ai][bj][m][n], 0, 0, 0); __builtin_amdgcn_s_setprio(0); } while (0)
#define PG8_WAIT_V(n) asm volatile("s_waitcnt vmcnt(" #n ")" ::: "memory")
#define PG8_WAIT_L(n) asm volatile("s_waitcnt lgkmcnt(" #n ")" ::: "memory")
#define PG8_BAR __builtin_amdgcn_s_barrier()
#define PG8_SCHED __builtin_amdgcn_sched_barrier(0)
    Unit cur, nxt; int ui = 0;
    if (!S.next(0, cur)) return;
    f32x4 acc[2][2][4][2];
#pragma unroll
    for (int a = 0; a < 2; ++a)
#pragma unroll
        for (int b = 0; b < 2; ++b)
#pragma unroll
            for (int m = 0; m < 4; ++m)
#pragma unroll
                for (int n = 0; n < 2; ++n) acc[a][b][m][n] = (f32x4){0.f, 0.f, 0.f, 0.f};
    bf16x8 At[4][2], B0[2][2], B1[2][2];
    const char* cA = (const char*)g.A + (size_t)cur.pm * tstep; const char* cB = (const char*)g.Bt + (size_t)cur.pn * tstep;
    S.a_ready(cur);
    PG8_STAGE(PG8_SB(0, 0), cB, voffB); PG8_STAGE(PG8_SA(0, 0), cA, voffA); PG8_STAGE(PG8_SB(0, 1), cB + hstep, voffB); PG8_STAGE(PG8_SA(0, 1), cA + hstep, voffA);
    if (wr == 1) PG8_BAR;
    PG8_WAIT_V(4); PG8_BAR;
    PG8_STAGE(PG8_SB(1, 0), cB + kstep, voffB); PG8_STAGE(PG8_SA(1, 0), cA + kstep, voffA); PG8_STAGE(PG8_SB(1, 1), cB + hstep + kstep, voffB);
    PG8_WAIT_V(6); PG8_BAR;
    PG8_STAMP();
    for (;;) {
        const bool has_next = S.next(ui + 1, nxt);
        const char* nA = has_next ? (const char*)g.A + (size_t)nxt.pm * tstep : cA; const char* nB = has_next ? (const char*)g.Bt + (size_t)nxt.pn * tstep : cB;
        for (int t = 0; t < nt; t += 2) {
            const bool last = (t == nt - 2);
            const char* a1 = cA + (size_t)(t + 1) * kstep;
            const char* a2 = last ? nA : cA + (size_t)(t + 2) * kstep; const char* b2 = last ? nB : cB + (size_t)(t + 2) * kstep;
            const char* a3 = a2 + kstep; const char* b3 = b2 + kstep;
            if (last && has_next) S.a_ready(nxt);
            PG8_LDB(B0, 0, 0); PG8_SCHED; PG8_LDA(At, 0, 0); PG8_STAGE(PG8_SA(1, 1), a1 + hstep, voffA);
            PG8_WAIT_L(8); PG8_BAR; PG8_WAIT_L(0); PG8_MMA(0, 0, At, B0); PG8_BAR; PG8_SCHED;
            PG8_LDB(B1, 0, 1); PG8_STAGE(PG8_SB(0, 0), b2, voffB);
            PG8_BAR; PG8_WAIT_L(0); PG8_MMA(0, 1, At, B1); PG8_BAR;
            PG8_LDA(At, 0, 1); PG8_STAGE(PG8_SA(0, 0), a2, voffA);
            PG8_BAR; PG8_WAIT_L(0); PG8_MMA(1, 0, At, B0); PG8_BAR; PG8_SCHED;
            PG8_STAGE(PG8_SB(0, 1), b2 + hstep, voffB);
            PG8_WAIT_V(6); PG8_BAR; PG8_MMA(1, 1, At, B1); PG8_BAR;
            PG8_LDB(B0, 1, 0); PG8_SCHED; PG8_LDA(At, 1, 0); PG8_STAGE(PG8_SA(0, 1), a2 + hstep, voffA);
            PG8_WAIT_L(8); PG8_BAR; PG8_WAIT_L(0); PG8_MMA(0, 0, At, B0); PG8_BAR; PG8_SCHED;
            PG8_LDB(B1, 1, 1); PG8_STAGE(PG8_SB(1, 0), b3, voffB);
            PG8_BAR; PG8_WAIT_L(0); PG8_MMA(0, 1, At, B1); PG8_BAR;
            PG8_LDA(At, 1, 1); PG8_STAGE(PG8_SA(1, 0), a3, voffA);
            PG8_BAR; PG8_WAIT_L(0); PG8_MMA(1, 0, At, B0); PG8_BAR; PG8_SCHED;
            PG8_STAGE(PG8_SB(1, 1), b3 + hstep, voffB);
            PG8_WAIT_V(6); PG8_BAR; PG8_MMA(1, 1, At, B1); PG8_BAR;
        }
        PG8_STAMP();
        if constexpr (!Epi::AFTER_DRAIN) { E(acc, cur, wr, wc, fr, fq); S.done(cur); }
        PG8_STAMP();
        if (!has_next) break;
#pragma unroll
        for (int a = 0; a < 2; ++a)
#pragma unroll
            for (int b = 0; b < 2; ++b)
#pragma unroll
                for (int m = 0; m < 4; ++m)
#pragma unroll
                    for (int n = 0; n < 2; ++n) acc[a][b][m][n] = (f32x4){0.f, 0.f, 0.f, 0.f};
        cur = nxt; cA = nA; cB = nB; ++ui;
    }
    PG8_WAIT_V(0);
    if (wr == 0) PG8_BAR;
    PG8_BAR;
    if constexpr (Epi::AFTER_DRAIN) { E.fused(acc, cur, wr, wc, fr, fq, lds, wid, lane); S.done(cur); }
    PG8_STAMP();
    if (STAMP && wid == 0) { stamps[lane] = lane < nts ? (((unsigned long long)(unsigned)ts_hi << 32) | (unsigned)ts_lo) : 0ull;
        if (lane == 62) stamps[62] = rt_entry; if (lane == 63) stamps[63] = (unsigned long long)wall_clock64(); }
#undef PG8_STAMP
#undef PG8_SA
#undef PG8_SB
#undef PG8_STAGE
#undef PG8_LDA
#undef PG8_LDB
#undef PG8_MMA
#undef PG8_WAIT_V
#undef PG8_WAIT_L
#undef PG8_BAR
#undef PG8_SCHED
}
}


constexpr size_t MBy = 1u << 20;
constexpr size_t WS_WTIN = 0, WS_WTOUT = 6 * MBy, WS_WTQ = 8 * MBy, WS_CTL = 12 * MBy, WS_ROWSS = 12 * MBy + 65536, WS_ACT = 13 * MBy, WS_PROJ = 45 * MBy,
                 WS_SB = 141 * MBy, WS_IDX = 173 * MBy, WS_GATE = 181 * MBy, WS_U8 = 189 * MBy, WS_V8 = 205 * MBy, WS_PW = 221 * MBy,
                 WS_UINV = 12 * MBy + 262144, WS_VINV = 12 * MBy + 393216;
constexpr int VIMP = 136, VWAVE = 128 * VIMP + 2048;
constexpr int LDS_MISC = 8 * VWAVE, LDS_BYTES = 8 * VWAVE + 256;
static_assert(LDS_MISC >= pg8::STAGE_BYTES && LDS_BYTES <= 163840, "LDS budget");

struct Params {
  const float *x, *norm1_g, *w_in, *q_norm_g, *k_norm_g, *conv_w, *sb_out_g, *conv_out_g, *w_out, *norm2_g, *w_q, *sub_keys, *peer_u, *peer_v;
  float* out; unsigned char* ws; int ph_lo, ph_hi;
};

#define XB_TMO      128
#define XB_XCNT(j)  (256  + 64 * (j))
#define XB_XSUB(j)  (1280 + 64 * (j))
#define XB_XGEN(j)  (2304 + 64 * (j))
#define XB_TOP      3328
#define XB_TOPGEN   3392
#define XCD_BAR_WORDS 3456
#define XB_SPIN_CAP (1u << 18)
DI unsigned xb_ld(unsigned* p) { return __hip_atomic_load(p, __ATOMIC_RELAXED, __HIP_MEMORY_SCOPE_AGENT); }
DI unsigned xb_add(unsigned* p, unsigned v) { return __hip_atomic_fetch_add(p, v, __ATOMIC_RELAXED, __HIP_MEMORY_SCOPE_AGENT); }
DI unsigned xb_xcc_id() { return (unsigned)__builtin_amdgcn_s_getreg((3 << 11) | 20) & 0xFu; }
#define XB_SPIN(cond, bar) do { unsigned _sp = 0; while (cond) { __builtin_amdgcn_s_sleep(1); \
    if ((++_sp & 255u) == 0u) { if (xb_ld(&(bar)[XB_TMO])) break; if (_sp > XB_SPIN_CAP) { atomicAdd(&(bar)[XB_TMO], 1u); break; } } } } while (0)
struct XcdBarrier { unsigned* bar; unsigned x; volatile LAS unsigned* st; };
DI XcdBarrier xcd_barrier_post(unsigned* bar, volatile LAS unsigned* st) {
  XcdBarrier b; b.bar = bar; b.x = xb_xcc_id(); b.st = st;
  if (threadIdx.x == 0) (void)xb_add(&bar[XB_XCNT(b.x)], 1u);
  return b;
}
DI void xcd_barrier_complete(unsigned* bar, unsigned x, unsigned& nloc, unsigned& nx) {
  const unsigned G = gridDim.x * gridDim.y * gridDim.z;
  unsigned sum, cnt, mine, sp = 0u;
  for (;;) {
    sum = 0u; cnt = 0u; mine = 0u;
#pragma unroll
    for (unsigned j = 0; j < 16; ++j) { const unsigned c = xb_ld(&bar[XB_XCNT(j)]); sum += c; cnt += (c > 0u) ? 1u : 0u; mine = (j == x) ? c : mine; }
    if (sum == G) break;
    __builtin_amdgcn_s_sleep(1);
    if ((++sp & 255u) == 0u) { if (xb_ld(&bar[XB_TMO])) break; if (sp > XB_SPIN_CAP) { atomicAdd(&bar[XB_TMO], 1u); break; } }
  }
  nloc = mine > 0u ? mine : 1u; nx = cnt > 0u ? cnt : 1u;
}
DI void xcd_barrier(const XcdBarrier& b) {
  asm volatile("s_waitcnt vmcnt(0)" ::: "memory");
  __syncthreads();
  if (threadIdx.x == 0) {
    unsigned* bar = b.bar;
    __builtin_amdgcn_s_waitcnt(0);
    unsigned nloc = b.st[0], nx = b.st[1];
    if (nloc == 0u) { xcd_barrier_complete(bar, b.x, nloc, nx); b.st[0] = nloc; b.st[1] = nx; }
    const unsigned old = xb_add(&bar[XB_XSUB(b.x)], 1u);
    const unsigned gen = old / nloc;
    if (old + 1u == (gen + 1u) * nloc) {
      __builtin_amdgcn_fence(__ATOMIC_RELEASE, "agent");
      asm volatile("s_waitcnt vmcnt(0)" ::: "memory");
      const unsigned og = xb_add(&bar[XB_TOP], 1u);
      const unsigned tg = og / nx;
      if (og + 1u == (tg + 1u) * nx) xb_add(&bar[XB_TOPGEN], 1u);
      else XB_SPIN(xb_ld(&bar[XB_TOPGEN]) == tg, bar);
      __builtin_amdgcn_fence(__ATOMIC_ACQUIRE, "agent");
      xb_add(&bar[XB_XGEN(b.x)], 1u);
      asm volatile("s_waitcnt vmcnt(0)" ::: "memory");
    } else {
      XB_SPIN(xb_ld(&bar[XB_XGEN(b.x)]) == gen, bar);
      __builtin_amdgcn_fence(__ATOMIC_ACQUIRE, "agent");
      asm volatile("s_waitcnt vmcnt(0)" ::: "memory");
    }
  }
  __syncthreads();
}

DI u16 f2bf(float x) { unsigned u = __float_as_uint(x); u += 0x7fffu + ((u >> 16) & 1u); return (u16)(u >> 16); }
DI float bflo(unsigned w) { return __uint_as_float(w << 16); }
DI float bfhi(unsigned w) { return __uint_as_float(w & 0xffff0000u); }
DI unsigned pack2(float a, float b) { return (unsigned)f2bf(a) | ((unsigned)f2bf(b) << 16); }
DI float wave_sum(float v) {
#pragma unroll
  for (int o = 32; o >= 1; o >>= 1) v += __shfl_xor(v, o);
  return v;
}
DI float wave_max(float v) {
#pragma unroll
  for (int o = 32; o >= 1; o >>= 1) v = fmaxf(v, __shfl_xor(v, o));
  return v;
}
DI void unpack8(const uint4 w, float* f) {
  f[0] = bflo(w.x); f[1] = bfhi(w.x); f[2] = bflo(w.y); f[3] = bfhi(w.y); f[4] = bflo(w.z); f[5] = bfhi(w.z); f[6] = bflo(w.w); f[7] = bfhi(w.w);
}
DI uint4 pack8(const float* f) { uint4 o; o.x = pack2(f[0], f[1]); o.y = pack2(f[2], f[3]); o.z = pack2(f[4], f[5]); o.w = pack2(f[6], f[7]); return o; }

DI void transpose_convert(const float* __restrict__ W, u16* __restrict__ Wt, int K, int N, const float* __restrict__ rg, float* sm) {
  const int tid = threadIdx.x, tn_cnt = N / 64, ntile = (K / 64) * tn_cnt;
  for (int tile = blockIdx.x; tile < ntile; tile += gridDim.x) {
    const int tk = tile / tn_cnt, tn = tile % tn_cnt;
    __syncthreads();
#pragma unroll
    for (int r = 0; r < 8; ++r) { const int row = r * 8 + (tid >> 6), col = tid & 63;
      const float g = rg ? rg[tk * 64 + row] : 1.f;
      sm[row * 65 + col] = W[(size_t)(tk * 64 + row) * N + tn * 64 + col] * g; }
    __syncthreads();
#pragma unroll
    for (int r = 0; r < 8; ++r) { const int nrow = r * 8 + (tid >> 6), kcol = tid & 63; Wt[(size_t)(tn * 64 + nrow) * K + tk * 64 + kcol] = f2bf(sm[kcol * 65 + nrow]); }
  }
}
template <bool SLICED>
DI void convert_fp8_rows(const float* __restrict__ src, const float* __restrict__ cg, unsigned char* __restrict__ dst, float* __restrict__ inv_out) {
  const int lane = threadIdx.x & 63, gw = blockIdx.x * NWAVES + (threadIdx.x >> 6), nw = gridDim.x * NWAVES;
  float g[16];
#pragma unroll
  for (int j = 0; j < 16; ++j) g[j] = cg ? cg[16 * lane + j] : 1.f;
  for (int row = gw; row < NEXP; row += nw) {
    const float4* s = (const float4*)(src + (size_t)row * D + 16 * lane);
    float v[16];
#pragma unroll
    for (int k = 0; k < 4; ++k) { const float4 a = s[k]; v[4 * k] = a.x * g[4 * k]; v[4 * k + 1] = a.y * g[4 * k + 1]; v[4 * k + 2] = a.z * g[4 * k + 2]; v[4 * k + 3] = a.w * g[4 * k + 3]; }
    float am = 0.f;
#pragma unroll
    for (int j = 0; j < 16; ++j) am = fmaxf(am, fabsf(v[j]));
    am = wave_max(am);
    const float sc = am > 0.f ? 240.f / am : 1.f;
    uint4 o;
    { int w;
      w = __builtin_amdgcn_cvt_pk_fp8_f32(v[0] * sc, v[1] * sc, 0, false); w = __builtin_amdgcn_cvt_pk_fp8_f32(v[2] * sc, v[3] * sc, w, true); o.x = (unsigned)w;
      w = __builtin_amdgcn_cvt_pk_fp8_f32(v[4] * sc, v[5] * sc, 0, false); w = __builtin_amdgcn_cvt_pk_fp8_f32(v[6] * sc, v[7] * sc, w, true); o.y = (unsigned)w;
      w = __builtin_amdgcn_cvt_pk_fp8_f32(v[8] * sc, v[9] * sc, 0, false); w = __builtin_amdgcn_cvt_pk_fp8_f32(v[10] * sc, v[11] * sc, w, true); o.z = (unsigned)w;
      w = __builtin_amdgcn_cvt_pk_fp8_f32(v[12] * sc, v[13] * sc, 0, false); w = __builtin_amdgcn_cvt_pk_fp8_f32(v[14] * sc, v[15] * sc, w, true); o.w = (unsigned)w; }
    if (SLICED) *(uint4*)(dst + (size_t)(lane >> 3) * ((size_t)NEXP * 128) + (size_t)row * 128 + 16 * (lane & 7)) = o;
    else *(uint4*)(dst + (size_t)row * D + 16 * lane) = o;
    if (lane == 0) inv_out[row] = am > 0.f ? am * (1.f / 240.f) : 1.f;
  }
}
template <bool SLICED>
DI void convert_fp4_rows(const float* __restrict__ src, const float* __restrict__ cg, unsigned char* __restrict__ dst, float* __restrict__ inv_out) {
  const int lane = threadIdx.x & 63, gw = blockIdx.x * NWAVES + (threadIdx.x >> 6), nw = gridDim.x * NWAVES;
  float4 g[4];
#pragma unroll
  for (int k = 0; k < 4; ++k) g[k] = cg ? ((const float4*)cg)[lane + 64 * k] : make_float4(1.f, 1.f, 1.f, 1.f);
  for (int row0 = gw * 4; row0 < NEXP; row0 += nw * 4) {
    float4 a[4][4];
#pragma unroll
    for (int rr = 0; rr < 4; ++rr)
#pragma unroll
      for (int k = 0; k < 4; ++k) a[rr][k] = ((const float4*)(src + (size_t)(row0 + rr) * D))[lane + 64 * k];
#pragma unroll
    for (int rr = 0; rr < 4; ++rr) {
      float am = 0.f;
#pragma unroll
      for (int k = 0; k < 4; ++k) { a[rr][k].x *= g[k].x; a[rr][k].y *= g[k].y; a[rr][k].z *= g[k].z; a[rr][k].w *= g[k].w;
        am = fmaxf(fmaxf(am, fmaxf(fabsf(a[rr][k].x), fabsf(a[rr][k].y))), fmaxf(fabsf(a[rr][k].z), fabsf(a[rr][k].w))); }
      am = wave_max(am);
      const float sc = am > 0.f ? 6.f / am : 1.f;
      const int row = row0 + rr;
#pragma unroll
      for (int k = 0; k < 4; ++k) {
        unsigned w = 0u;
        w = __builtin_amdgcn_cvt_scalef32_pk_fp4_f32(w, a[rr][k].x * sc, a[rr][k].y * sc, 1.0f, 0); w = __builtin_amdgcn_cvt_scalef32_pk_fp4_f32(w, a[rr][k].z * sc, a[rr][k].w * sc, 1.0f, 1);
        if (SLICED) *(u16*)(dst + (size_t)k * ((size_t)NEXP * 128) + (size_t)row * 128 + 2 * lane) = (u16)w;
        else *(u16*)(dst + (size_t)row * 512 + 128 * k + 2 * lane) = (u16)w;
      }
      if (lane == 0) inv_out[row] = am > 0.f ? am * (1.f / 6.f) : 1.f;
    }
  }
}
DI void rmsnorm1024(const float* __restrict__ src, const float* __restrict__ g, u16* __restrict__ dst) {
  const int lane = threadIdx.x & 63, gw = blockIdx.x * NWAVES + (threadIdx.x >> 6), nw = gridDim.x * NWAVES;
  float4 gg[4];
#pragma unroll
  for (int j = 0; j < 4; ++j) gg[j] = ((const float4*)g)[lane + 64 * j];
  for (int row0 = gw * 4; row0 < T; row0 += nw * 4) {
    float4 v[4][4];
#pragma unroll
    for (int rr = 0; rr < 4; ++rr)
#pragma unroll
      for (int j = 0; j < 4; ++j) v[rr][j] = ((const float4*)(src + (size_t)(row0 + rr) * D))[lane + 64 * j];
#pragma unroll
    for (int rr = 0; rr < 4; ++rr) {
      float ss = 0.f;
#pragma unroll
      for (int j = 0; j < 4; ++j) ss += v[rr][j].x * v[rr][j].x + v[rr][j].y * v[rr][j].y + v[rr][j].z * v[rr][j].z + v[rr][j].w * v[rr][j].w;
      ss = wave_sum(ss);
      const float inv = rsqrtf(ss * (1.f / D) + EPS);
#pragma unroll
      for (int j = 0; j < 4; ++j) {
        uint2 o; o.x = pack2(v[rr][j].x * inv * gg[j].x, v[rr][j].y * inv * gg[j].y); o.y = pack2(v[rr][j].z * inv * gg[j].z, v[rr][j].w * inv * gg[j].w);
        *(uint2*)(dst + (size_t)(row0 + rr) * D + 4 * (lane + 64 * j)) = o;
      }
    }
  }
}

constexpr int VTP = 1028;
DI void postproj_phase(const Params& p, u16* __restrict__ proj, u16* __restrict__ mixed, u16* __restrict__ vt, unsigned char* smem) {
  const int lane = threadIdx.x & 63, wave = threadIdx.x >> 6;
  LAS unsigned char* tile = (LAS unsigned char*)smem;
  for (int chunk = blockIdx.x; chunk < T / 64; chunk += gridDim.x) {
    __syncthreads();
#pragma unroll 4
    for (int i = 0; i < 8; ++i) {
      const int tl = wave * 8 + i, t = chunk * 64 + tl;
      u16* row = proj + (size_t)t * DIN;
#pragma unroll
      for (int which = 0; which < 2; ++which) {
        float f[8]; unpack8(*(const uint4*)(row + which * 512 + 8 * lane), f);
        float ss = 0.f;
#pragma unroll
        for (int j = 0; j < 8; ++j) ss += f[j] * f[j];
        ss += __shfl_xor(ss, 1); ss += __shfl_xor(ss, 2); ss += __shfl_xor(ss, 4);
        const float inv = rsqrtf(ss * (1.f / 64.f) + EPS);
        const float* g = (which == 0 ? p.q_norm_g : p.k_norm_g) + 8 * (lane & 7);
#pragma unroll
        for (int j = 0; j < 8; ++j) f[j] = f[j] * inv * g[j];
        *(uint4*)(row + which * 512 + 8 * lane) = pack8(f);
      }
      { const uint4 v = *(const uint4*)(row + 1024 + 8 * lane);
        LAS unsigned* d = (LAS unsigned*)(tile + tl * VTP + 16 * lane); d[0] = v.x; d[1] = v.y; d[2] = v.z; d[3] = v.w; }
      const int c0 = 8 * lane, tpos = t & (SEQ - 1);
      float xc[8], bg[8], cg[8], y[8];
      unpack8(*(const uint4*)(row + 1536 + c0), xc); unpack8(*(const uint4*)(row + 2048 + c0), bg); unpack8(*(const uint4*)(row + 2560 + c0), cg);
#pragma unroll
      for (int j = 0; j < 8; ++j) y[j] = p.conv_w[2 * DSB + c0 + j] * (cg[j] * xc[j]);
      if (tpos >= 1) {
        float x1[8], c1[8]; unpack8(*(const uint4*)(row - DIN + 1536 + c0), x1); unpack8(*(const uint4*)(row - DIN + 2560 + c0), c1);
#pragma unroll
        for (int j = 0; j < 8; ++j) y[j] += p.conv_w[1 * DSB + c0 + j] * (c1[j] * x1[j]);
      }
      if (tpos >= 2) {
        float x2[8], c2[8]; unpack8(*(const uint4*)(row - 2 * DIN + 1536 + c0), x2); unpack8(*(const uint4*)(row - 2 * DIN + 2560 + c0), c2);
#pragma unroll
        for (int j = 0; j < 8; ++j) y[j] += p.conv_w[0 * DSB + c0 + j] * (c2[j] * x2[j]);
      }
      float ss = 0.f;
#pragma unroll
      for (int j = 0; j < 8; ++j) { y[j] *= bg[j]; ss += y[j] * y[j]; }
      ss = wave_sum(ss);
      const float inv = rsqrtf(ss * (1.f / DSB) + EPS);
#pragma unroll
      for (int j = 0; j < 8; ++j) y[j] = y[j] * inv * p.conv_out_g[c0 + j];
      *(uint4*)(mixed + (size_t)t * D + DSB + c0) = pack8(y);
    }
    __syncthreads();
    const int dg = lane >> 3, tg = lane & 7, bb = (chunk * 64) / SEQ, tp0 = (chunk * 64) & (SEQ - 1);
#pragma unroll
    for (int it = 0; it < 8; ++it) {
      const int d = it * 64 + wave * 8 + dg;
      unsigned w[4];
#pragma unroll
      for (int k = 0; k < 4; ++k) {
        const unsigned lo = *(const LAS u16*)(tile + (tg * 8 + 2 * k) * VTP + 2 * d), hi = *(const LAS u16*)(tile + (tg * 8 + 2 * k + 1) * VTP + 2 * d);
        w[k] = lo | (hi << 16);
      }
      *(uint4*)(vt + ((size_t)(bb * 512 + d)) * SEQ + tp0 + tg * 8) = make_uint4(w[0], w[1], w[2], w[3]);
    }
  }
}

typedef float f32x16_t __attribute__((ext_vector_type(16)));
typedef short bf16x8_t __attribute__((ext_vector_type(8)));
DI bf16x8_t pack_bf16x8(float a0, float a1, float a2, float a3, float a4, float a5, float a6, float a7) {
  pg8::u32x4 r;
  asm volatile("v_cvt_pk_bf16_f32 %0, %4, %5\n\tv_cvt_pk_bf16_f32 %1, %6, %7\n\tv_cvt_pk_bf16_f32 %2, %8, %9\n\tv_cvt_pk_bf16_f32 %3, %10, %11\n\ts_nop 1"
               : "=&v"(r[0]), "=&v"(r[1]), "=&v"(r[2]), "=&v"(r[3]) : "v"(a0), "v"(a1), "v"(a2), "v"(a3), "v"(a4), "v"(a5), "v"(a6), "v"(a7));
  return __builtin_bit_cast(bf16x8_t, r);
}
template <bool DIAG>
DI void attn_tile(const u16* __restrict__ kr, const u16* __restrict__ vr, const bf16x8_t (&qf)[4], int c, int hh, float& carry, f32x16_t& o0, f32x16_t& o1) {
  f32x16_t s;
#pragma unroll
  for (int r = 0; r < 16; ++r) s[r] = 0.f;
#pragma unroll
  for (int ks = 0; ks < 4; ++ks) s = __builtin_amdgcn_mfma_f32_32x32x16_bf16(*(const bf16x8_t*)(kr + 16 * ks), qf[ks], s, 0, 0, 0);
  const bf16x8_t v00 = *(const bf16x8_t*)(vr), v01 = *(const bf16x8_t*)(vr + 8), v10 = *(const bf16x8_t*)(vr + 32 * SEQ), v11 = *(const bf16x8_t*)(vr + 32 * SEQ + 8);
  float rr[16], be[16];
#pragma unroll
  for (int r = 0; r < 16; ++r) {
    const float e = __builtin_amdgcn_exp2f(fminf(s[r] * 0.18033688011112042f, 100.f));
    float x = __builtin_amdgcn_rcpf(1.f + e), b = e * x;
    if (DIAG) { const bool on = (16 * hh + r) < c; x = on ? x : 1.f; b = on ? b : 0.f; }
    rr[r] = x; be[r] = b;
  }
  float tot = ((rr[0] * rr[1]) * (rr[2] * rr[3])) * ((rr[4] * rr[5]) * (rr[6] * rr[7]));
  tot *= ((rr[8] * rr[9]) * (rr[10] * rr[11])) * ((rr[12] * rr[13]) * (rr[14] * rr[15]));
  const float oth = __shfl_xor(tot, 32);
  float P = hh ? carry : carry * oth;
  float a[16];
#pragma unroll
  for (int r = 15; r >= 0; --r) { a[r] = be[r] * P; P *= rr[r]; }
  carry = carry * tot * oth;
  const bf16x8_t af0 = pack_bf16x8(a[0], a[1], a[2], a[3], a[4], a[5], a[6], a[7]), af1 = pack_bf16x8(a[8], a[9], a[10], a[11], a[12], a[13], a[14], a[15]);
  o0 = __builtin_amdgcn_mfma_f32_32x32x16_bf16(v00, af0, o0, 0, 0, 0); o0 = __builtin_amdgcn_mfma_f32_32x32x16_bf16(v01, af1, o0, 0, 0, 0);
  o1 = __builtin_amdgcn_mfma_f32_32x32x16_bf16(v10, af0, o1, 0, 0, 0); o1 = __builtin_amdgcn_mfma_f32_32x32x16_bf16(v11, af1, o1, 0, 0, 0);
}
DI void attn_phase(const Params& p, const u16* __restrict__ proj, const u16* __restrict__ vt, u16* __restrict__ mixed, unsigned char* smem) {
  const int lane = threadIdx.x & 63, head = threadIdx.x >> 6, c = lane & 31, hh = lane >> 5;
  LAS float* red = (LAS float*)smem;
  const int kap = 16 * ((c >> 2) & 1) + (c & 3) + 4 * (c >> 3);
  for (int item = blockIdx.x; item < 4 * 128; item += gridDim.x) {
    const int b = item & 3, q0 = (127 - (item >> 2)) * 32;
    const size_t tq = (size_t)b * SEQ + q0 + c;
    bf16x8_t qf[4];
#pragma unroll
    for (int ks = 0; ks < 4; ++ks) qf[ks] = *(const bf16x8_t*)(proj + tq * DIN + head * 64 + 16 * ks + 8 * hh);
    f32x16_t o0, o1;
#pragma unroll
    for (int r = 0; r < 16; ++r) { o0[r] = 0.f; o1[r] = 0.f; }
    float carry = 1.f;
    const u16* kbase = proj + ((size_t)b * SEQ + kap) * DIN + 512 + head * 64 + 8 * hh;
    const u16* vbase = vt + ((size_t)(b * 512 + head * 64 + c)) * SEQ + 16 * hh;
    attn_tile<true>(kbase + (size_t)q0 * DIN, vbase + q0, qf, c, hh, carry, o0, o1);
    for (int tb = q0 - 32; tb >= 0; tb -= 32) {
      attn_tile<false>(kbase + (size_t)tb * DIN, vbase + tb, qf, c, hh, carry, o0, o1);
      if (__all(carry == 0.f)) break;
    }
    float ss = 0.f;
#pragma unroll
    for (int r = 0; r < 16; ++r) ss += o0[r] * o0[r] + o1[r] * o1[r];
    ss += __shfl_xor(ss, 32);
    __syncthreads();
    if (hh == 0) red[head * 32 + c] = ss;
    __syncthreads();
    float tot = 0.f;
#pragma unroll
    for (int h8 = 0; h8 < 8; ++h8) tot += red[h8 * 32 + c];
    const float inv = rsqrtf(tot * (1.f / DSB) + EPS);
    u16* orow = mixed + tq * D + head * 64 + 4 * hh;
    const float* g = p.sb_out_g + head * 64 + 4 * hh;
#pragma unroll
    for (int rg = 0; rg < 4; ++rg) {
      const float4 g0 = *(const float4*)(g + 8 * rg), g1 = *(const float4*)(g + 32 + 8 * rg);
      uint2 w0, w1;
      w0.x = pack2(o0[4 * rg] * inv * g0.x, o0[4 * rg + 1] * inv * g0.y); w0.y = pack2(o0[4 * rg + 2] * inv * g0.z, o0[4 * rg + 3] * inv * g0.w);
      w1.x = pack2(o1[4 * rg] * inv * g1.x, o1[4 * rg + 1] * inv * g1.y); w1.y = pack2(o1[4 * rg + 2] * inv * g1.z, o1[4 * rg + 3] * inv * g1.w);
      *(uint2*)(orow + 8 * rg) = w0; *(uint2*)(orow + 32 + 8 * rg) = w1;
    }
  }
}

#define SEL_DI DI
#define SEL_F2U(x) __float_as_uint(x)
#define SEL_U2F(x) __uint_as_float(x)

#define CE(a, b) do { const unsigned _h = (a) > (b) ? (a) : (b), _l = (a) > (b) ? (b) : (a); (a) = _h; (b) = _l; } while (0)
SEL_DI void sort16(unsigned (&v)[16]) {
  CE(v[0], v[1]); CE(v[2], v[3]); CE(v[0], v[2]); CE(v[1], v[3]); CE(v[1], v[2]); CE(v[4], v[5]); CE(v[6], v[7]); CE(v[4], v[6]);
  CE(v[5], v[7]); CE(v[5], v[6]); CE(v[0], v[4]); CE(v[2], v[6]); CE(v[2], v[4]); CE(v[1], v[5]); CE(v[3], v[7]); CE(v[3], v[5]);
  CE(v[1], v[2]); CE(v[3], v[4]); CE(v[5], v[6]); CE(v[8], v[9]); CE(v[10], v[11]); CE(v[8], v[10]); CE(v[9], v[11]); CE(v[9], v[10]);
  CE(v[12], v[13]); CE(v[14], v[15]); CE(v[12], v[14]); CE(v[13], v[15]); CE(v[13], v[14]); CE(v[8], v[12]); CE(v[10], v[14]); CE(v[10], v[12]);
  CE(v[9], v[13]); CE(v[11], v[15]); CE(v[11], v[13]); CE(v[9], v[10]); CE(v[11], v[12]); CE(v[13], v[14]); CE(v[0], v[8]); CE(v[4], v[12]);
  CE(v[4], v[8]); CE(v[2], v[10]); CE(v[6], v[14]); CE(v[6], v[10]); CE(v[2], v[4]); CE(v[6], v[8]); CE(v[10], v[12]); CE(v[1], v[9]);
  CE(v[5], v[13]); CE(v[5], v[9]); CE(v[3], v[11]); CE(v[7], v[15]); CE(v[7], v[11]); CE(v[3], v[5]); CE(v[7], v[9]); CE(v[11], v[13]);
  CE(v[1], v[2]); CE(v[3], v[4]); CE(v[5], v[6]); CE(v[7], v[8]); CE(v[9], v[10]); CE(v[11], v[12]); CE(v[13], v[14]);
}
SEL_DI void bitonic_merge16(unsigned (&v)[16]) {
#pragma unroll
  for (int d = 8; d >= 1; d >>= 1)
#pragma unroll
    for (int i = 0; i < 16; ++i) if ((i & d) == 0) CE(v[i], v[i + d]);
}
SEL_DI void merge_top16(unsigned (&a)[16], const unsigned (&b)[16]) {
#pragma unroll
  for (int i = 0; i < 16; ++i) a[i] = a[i] > b[15 - i] ? a[i] : b[15 - i];
  bitonic_merge16(a);
}
SEL_DI void top16_of_64(unsigned (&g0)[16], unsigned (&g1)[16], unsigned (&g2)[16], unsigned (&g3)[16]) {
  sort16(g0); sort16(g1); sort16(g2); sort16(g3);
  merge_top16(g0, g1); merge_top16(g2, g3); merge_top16(g0, g2);
}
SEL_DI unsigned cand_key(float a, float b, unsigned payload) {
  float s = a + b; s = s < 32.0f ? 32.0f : (s > 127.99f ? 127.99f : s);
  return ((SEL_F2U(s) << 8) & 0xFFFFC000u) | payload;
}
SEL_DI void stage2(const unsigned (&L1)[16], const unsigned (&L2)[16], unsigned (&R)[16]) {
  float f1[16], f2m[16]; unsigned P1[16], P2[16];
#pragma unroll
  for (int i = 0; i < 16; ++i) { f1[i] = SEL_U2F(L1[i] & ~127u); f2m[i] = SEL_U2F(L2[i] & ~127u) - 64.0f; P1[i] = (L1[i] & 127u) << 7; P2[i] = L2[i] & 127u; }
  unsigned K[64];
  K[0] = cand_key(f1[0], f2m[0], P1[0] | P2[0]);
  K[1] = cand_key(f1[0], f2m[1], P1[0] | P2[1]);
  K[2] = cand_key(f1[0], f2m[2], P1[0] | P2[2]);
  K[3] = cand_key(f1[0], f2m[3], P1[0] | P2[3]);
  K[4] = cand_key(f1[0], f2m[4], P1[0] | P2[4]);
  K[5] = cand_key(f1[0], f2m[5], P1[0] | P2[5]);
  K[6] = cand_key(f1[0], f2m[6], P1[0] | P2[6]);
  K[7] = cand_key(f1[0], f2m[7], P1[0] | P2[7]);
  K[8] = cand_key(f1[0], f2m[8], P1[0] | P2[8]);
  K[9] = cand_key(f1[0], f2m[9], P1[0] | P2[9]);
  K[10] = cand_key(f1[0], f2m[10], P1[0] | P2[10]);
  K[11] = cand_key(f1[0], f2m[11], P1[0] | P2[11]);
  K[12] = cand_key(f1[0], f2m[12], P1[0] | P2[12]);
  K[13] = cand_key(f1[0], f2m[13], P1[0] | P2[13]);
  K[14] = cand_key(f1[0], f2m[14], P1[0] | P2[14]);
  K[15] = cand_key(f1[0], f2m[15], P1[0] | P2[15]);
  K[16] = cand_key(f1[1], f2m[0], P1[1] | P2[0]);
  K[17] = cand_key(f1[1], f2m[1], P1[1] | P2[1]);
  K[18] = cand_key(f1[1], f2m[2], P1[1] | P2[2]);
  K[19] = cand_key(f1[1], f2m[3], P1[1] | P2[3]);
  K[20] = cand_key(f1[1], f2m[4], P1[1] | P2[4]);
  K[21] = cand_key(f1[1], f2m[5], P1[1] | P2[5]);
  K[22] = cand_key(f1[1], f2m[6], P1[1] | P2[6]);
  K[23] = cand_key(f1[1], f2m[7], P1[1] | P2[7]);
  K[24] = cand_key(f1[2], f2m[0], P1[2] | P2[0]);
  K[25] = cand_key(f1[2], f2m[1], P1[2] | P2[1]);
  K[26] = cand_key(f1[2], f2m[2], P1[2] | P2[2]);
  K[27] = cand_key(f1[2], f2m[3], P1[2] | P2[3]);
  K[28] = cand_key(f1[2], f2m[4], P1[2] | P2[4]);
  K[29] = cand_key(f1[3], f2m[0], P1[3] | P2[0]);
  K[30] = cand_key(f1[3], f2m[1], P1[3] | P2[1]);
  K[31] = cand_key(f1[3], f2m[2], P1[3] | P2[2]);
  K[32] = cand_key(f1[3], f2m[3], P1[3] | P2[3]);
  K[33] = cand_key(f1[4], f2m[0], P1[4] | P2[0]);
  K[34] = cand_key(f1[4], f2m[1], P1[4] | P2[1]);
  K[35] = cand_key(f1[4], f2m[2], P1[4] | P2[2]);
  K[36] = cand_key(f1[5], f2m[0], P1[5] | P2[0]);
  K[37] = cand_key(f1[5], f2m[1], P1[5] | P2[1]);
  K[38] = cand_key(f1[6], f2m[0], P1[6] | P2[0]);
  K[39] = cand_key(f1[6], f2m[1], P1[6] | P2[1]);
  K[40] = cand_key(f1[7], f2m[0], P1[7] | P2[0]);
  K[41] = cand_key(f1[7], f2m[1], P1[7] | P2[1]);
  K[42] = cand_key(f1[8], f2m[0], P1[8] | P2[0]);
  K[43] = cand_key(f1[9], f2m[0], P1[9] | P2[0]);
  K[44] = cand_key(f1[10], f2m[0], P1[10] | P2[0]);
  K[45] = cand_key(f1[11], f2m[0], P1[11] | P2[0]);
  K[46] = cand_key(f1[12], f2m[0], P1[12] | P2[0]);
  K[47] = cand_key(f1[13], f2m[0], P1[13] | P2[0]);
  K[48] = cand_key(f1[14], f2m[0], P1[14] | P2[0]);
  K[49] = cand_key(f1[15], f2m[0], P1[15] | P2[0]);
#pragma unroll
  for (int c = 50; c < 64; ++c) K[c] = 0u;
  unsigned g1[16], g2[16], g3[16];
#pragma unroll
  for (int i = 0; i < 16; ++i) { R[i] = K[i]; g1[i] = K[16 + i]; g2[i] = K[32 + i]; g3[i] = K[48 + i]; }
  sort16(R); sort16(g1); sort16(g2); CE(g3[0], g3[1]);
  merge_top16(R, g1);
  g2[15] = g2[15] > g3[0] ? g2[15] : g3[0]; g2[14] = g2[14] > g3[1] ? g2[14] : g3[1];
  bitonic_merge16(g2);
  merge_top16(R, g2);
}

constexpr int SKP = 272;
DI void stage1(const u16* __restrict__ qrow, const LAS unsigned char* sk, int tok, int hh, unsigned (&out)[16]) {
  f32x16_t acc[4];
#pragma unroll
  for (int kt = 0; kt < 4; ++kt)
#pragma unroll
    for (int r = 0; r < 16; ++r) acc[kt][r] = 64.0f;
#pragma unroll 1
  for (int ks = 0; ks < 8; ++ks) {
    const bf16x8_t bq = *(const bf16x8_t*)(qrow + 16 * ks + 8 * hh);
#pragma unroll
    for (int kt = 0; kt < 4; ++kt) {
      const bf16x8_t ak = *(const LAS bf16x8_t*)(sk + (32 * kt + tok) * SKP + (16 * ks + 8 * hh) * 2);
      acc[kt] = __builtin_amdgcn_mfma_f32_32x32x16_bf16(ak, bq, acc[kt], 0, 0, 0);
    }
  }
  unsigned g1[16], g2[16], g3[16];
#pragma unroll
  for (int r = 0; r < 16; ++r) {
    const unsigned ix = (unsigned)((r & 3) + 8 * (r >> 2));
    out[r] = (__float_as_uint(acc[0][r]) & ~127u) | ix; g1[r] = (__float_as_uint(acc[1][r]) & ~127u) | (32u + ix);
    g2[r] = (__float_as_uint(acc[2][r]) & ~127u) | (64u + ix); g3[r] = (__float_as_uint(acc[3][r]) & ~127u) | (96u + ix);
  }
  top16_of_64(out, g1, g2, g3);
  unsigned oth[16];
#pragma unroll
  for (int i = 0; i < 16; ++i) { out[i] |= (unsigned)(hh << 2); }
#pragma unroll
  for (int i = 0; i < 16; ++i) oth[i] = (unsigned)__shfl_xor((int)out[i], 32);
  merge_top16(out, oth);
}
DI void topk_phase(const Params& p, const u16* __restrict__ qp, const float* __restrict__ uinv, int* __restrict__ idx_out, float2* __restrict__ gu_out, unsigned char* smem) {
  const int tid = threadIdx.x;
  LAS unsigned char* sk = (LAS unsigned char*)smem;
  __syncthreads();
  for (int i = tid; i < 2 * 128 * 16; i += NTHREADS) {
    const int c = i & 15, row = i >> 4;
    const float4* s = (const float4*)(p.sub_keys + (size_t)row * 128 + c * 8);
    const float4 a = s[0], b = s[1];
    pg8::u32x4 o; o.x = pack2(a.x, a.y); o.y = pack2(a.z, a.w); o.z = pack2(b.x, b.y); o.w = pack2(b.z, b.w);
    *(LAS pg8::u32x4*)(sk + row * SKP + c * 16) = o;
  }
  __syncthreads();
  const int lane = tid & 63, tok = lane & 31, hh = lane >> 5, gw = blockIdx.x * NWAVES + (tid >> 6), nw = gridDim.x * NWAVES;
  for (int item = gw; item < (T / 32) * 4; item += nw) {
    const int t = (item >> 2) * 32 + tok, hp = item & 3;
    const u16* qt = qp + (size_t)t * 2048 + hp * 512;
    unsigned LA1[16], LA2[16], LB1[16], LB2[16];
    stage1(qt, sk, tok, hh, LA1);
    stage1(qt + 128, sk + 128 * SKP, tok, hh, LA2);
    stage1(qt + 256, sk, tok, hh, LB1);
    stage1(qt + 384, sk + 128 * SKP, tok, hh, LB2);
    unsigned L1[16], L2[16], R[16];
#pragma unroll
    for (int i = 0; i < 16; ++i) { L1[i] = hh ? LB1[i] : LA1[i]; L2[i] = hh ? LB2[i] : LA2[i]; }
    stage2(L1, L2, R);
    const int head = hp * 2 + hh;
    float ev[16], sum = 0.f;
    const float mx = __uint_as_float(0x42000000u | ((R[0] >> 14) << 6));
#pragma unroll
    for (int k = 0; k < 16; ++k) { ev[k] = __expf(__uint_as_float(0x42000000u | ((R[k] >> 14) << 6)) - mx); sum += ev[k]; }
    const float rs = 1.f / sum;
    int* io = idx_out + (size_t)t * 128 + head * 16; float2* go = gu_out + (size_t)t * 128 + head * 16;
#pragma unroll
    for (int k4 = 0; k4 < 4; ++k4) {
      int4 ex; ex.x = (int)(R[4 * k4] & 0x3FFFu); ex.y = (int)(R[4 * k4 + 1] & 0x3FFFu); ex.z = (int)(R[4 * k4 + 2] & 0x3FFFu); ex.w = (int)(R[4 * k4 + 3] & 0x3FFFu);
      ((int4*)io)[k4] = ex;
      float4 ga, gb; ga.x = ev[4 * k4] * rs; ga.y = uinv[ex.x]; ga.z = ev[4 * k4 + 1] * rs; ga.w = uinv[ex.y];
      gb.x = ev[4 * k4 + 2] * rs; gb.y = uinv[ex.z]; gb.z = ev[4 * k4 + 3] * rs; gb.w = uinv[ex.w];
      ((float4*)go)[2 * k4] = ga; ((float4*)go)[2 * k4 + 1] = gb;
    }
  }
}

typedef float f32x4_t __attribute__((ext_vector_type(4)));
typedef float f32x2_t __attribute__((ext_vector_type(2)));
typedef int i32x8_t __attribute__((ext_vector_type(8)));
constexpr int UIP = 132;
constexpr int UGP = 1032;
struct UBuf { uint4 r0, r1, r2, r3; unsigned e; float vi; };
#define U_LOAD(buf, g) do { const unsigned _e = myi[(g)]; const unsigned char* _r = U4 + (size_t)_e * 512 + xoff; \
    buf.r0 = *(const uint4*)(_r); buf.r1 = *(const uint4*)(_r + 128); buf.r2 = *(const uint4*)(_r + 256); buf.r3 = *(const uint4*)(_r + 384); \
    buf.e = _e; buf.vi = vinv[_e]; } while (0)
#define U_MMA(c, r, b) c = __builtin_amdgcn_mfma_scale_f32_16x16x128_f8f6f4((i32x8_t){(int)(r).x, (int)(r).y, (int)(r).z, (int)(r).w, 0, 0, 0, 0}, b, c, 4, 0, 0, 0x7F7F7F7F, 0, 0x7F7F7F7F)
#define U_COMP(buf, g) do { f32x4_t c = {0.f, 0.f, 0.f, 0.f}; \
    U_MMA(c, buf.r0, B0); U_MMA(c, buf.r1, B1); U_MMA(c, buf.r2, B2); U_MMA(c, buf.r3, B3); \
    const int rsel = pp & 3; const float v = rsel == 0 ? c[0] : rsel == 1 ? c[1] : rsel == 2 ? c[2] : c[3]; \
    const float vo = __shfl(v, (lane + 40) & 63); \
    if (pp < 8 && q == (pp >> 2)) { const f32x2_t gu2 = *(const LAS f32x2_t*)(myg + (g) * 8); \
      const float d = (v + vo) * gu2[1]; const float act = 0.5f * d * (1.f + erff(d * 0.70710678118654752f)); \
      uint2 o; o.x = buf.e; o.y = __float_as_uint(gu2[0] * act * buf.vi); pw[(size_t)tok * 128 + (g)] = o; } } while (0)
DI void peer_u_phase(const u16* __restrict__ xb, const float* __restrict__ rowss, const int* __restrict__ idx, const float2* __restrict__ gu,
                     const unsigned char* __restrict__ U4, const float* __restrict__ vinv, uint2* __restrict__ pw, unsigned char* smem) {
  const int lane = threadIdx.x & 63, wave = threadIdx.x >> 6, pp = lane & 15, q = lane >> 4, gw = blockIdx.x * NWAVES + wave, nw = gridDim.x * NWAVES;
  const int pi = pp & 7, x = q + 4 * (pp >> 3);
  const unsigned xoff = 16u * x;
  LAS unsigned* idl = (LAS unsigned*)(smem + wave * (8 * UIP * 4 + 8 * UGP));
  LAS unsigned char* gul = (LAS unsigned char*)(idl + 8 * UIP);
  const LAS unsigned* myi = idl + pi * UIP;
  const LAS unsigned char* myg = gul + pi * UGP;
  for (int unit = gw; unit < T / 8; unit += nw) {
    const int tok = unit * 8 + pi;
    __builtin_amdgcn_wave_barrier();
#pragma unroll
    for (int r8 = 0; r8 < 8; ++r8) {
      const int* ir = idx + (size_t)(unit * 8 + r8) * 128;
      idl[r8 * UIP + lane] = (unsigned)ir[lane]; idl[r8 * UIP + 64 + lane] = (unsigned)ir[64 + lane];
      const uint4 gv = ((const uint4*)(gu + (size_t)(unit * 8 + r8) * 128))[lane];
      pg8::u32x4 o; o.x = gv.x; o.y = gv.y; o.z = gv.z; o.w = gv.w; *(LAS pg8::u32x4*)(gul + r8 * UGP + lane * 16) = o;
    }
    __builtin_amdgcn_fence(__ATOMIC_RELEASE, "wavefront");
    __builtin_amdgcn_wave_barrier();
    const float inv = rsqrtf(rowss[tok] * (1.f / D) + EPS);
    i32x8_t B0, B1, B2, B3;
#define U_BUILD(Bv, i) do { const u16* sb = xb + (size_t)tok * D + 256 * (i) + 128 * (pp >> 3) + 16 * q; \
      _Pragma("unroll") for (int h = 0; h < 4; ++h) { float f[8]; unpack8(*(const uint4*)(sb + 64 * (h >> 1) + 8 * (h & 1)), f); int w; \
        w = __builtin_amdgcn_cvt_pk_fp8_f32(f[0] * inv, f[1] * inv, 0, false); w = __builtin_amdgcn_cvt_pk_fp8_f32(f[2] * inv, f[3] * inv, w, true); Bv[2 * h] = w; \
        w = __builtin_amdgcn_cvt_pk_fp8_f32(f[4] * inv, f[5] * inv, 0, false); w = __builtin_amdgcn_cvt_pk_fp8_f32(f[6] * inv, f[7] * inv, w, true); Bv[2 * h + 1] = w; } } while (0)
    U_BUILD(B0, 0); U_BUILD(B1, 1); U_BUILD(B2, 2); U_BUILD(B3, 3);
    UBuf b0, b1, b2, b3;
#define SB() __builtin_amdgcn_sched_barrier(0)
    U_LOAD(b0, 0); U_LOAD(b1, 1); U_LOAD(b2, 2); SB();
#pragma unroll 1
    for (int g = 0; g < 128; g += 4) {
      U_LOAD(b3, g + 3); SB(); U_COMP(b0, g); SB();
      U_LOAD(b0, (g + 4) & 127); SB(); U_COMP(b1, g + 1); SB();
      U_LOAD(b1, (g + 5) & 127); SB(); U_COMP(b2, g + 2); SB();
      U_LOAD(b2, (g + 6) & 127); SB(); U_COMP(b3, g + 3); SB();
    }
  }
}

typedef int i32x2_t __attribute__((ext_vector_type(2)));
DI void peer_v_phase(const uint2* __restrict__ pw, const unsigned char* __restrict__ V4, const u16* __restrict__ xb, float* __restrict__ out, unsigned char* smem) {
  const int lane = threadIdx.x & 63, wave = threadIdx.x >> 6, r = lane >> 3, c = lane & 7, n16 = lane & 15, kg = lane >> 4;
  LAS unsigned char* img = (LAS unsigned char*)smem + wave * VWAVE;
  LAS unsigned char* pbuf = img + 128 * VIMP;
  const int nunit = 4 * (T / 64);
  const int cnt = ((int)blockIdx.x < nunit) ? (nunit - 1 - (int)blockIdx.x) / (int)gridDim.x + 1 : 0, N = cnt * 8;
  if (N == 0) return;
#define V_TOK(n, jj, tt) do { const int _u = (int)blockIdx.x + ((n) >> 3) * (int)gridDim.x; jj = _u & 3; tt = (_u >> 2) * 64 + wave * 8 + ((n) & 7); } while (0)
#define V_LDPW(n) ({ int _j, _t; V_TOK(n, _j, _t); ((const uint4*)(pw + (size_t)_t * 128))[lane]; })
#define V_STAGE(n, pq, scv) do { LAS unsigned char* _b = pbuf + ((n) & 1) * 1024; \
    *(LAS i32x2_t*)(_b + 8 * lane) = (i32x2_t){(int)(pq).x, (int)(pq).z}; *(LAS i32x2_t*)(_b + 512 + 8 * lane) = (i32x2_t){(int)(pq).y, (int)(pq).w}; \
    const float _m = wave_max(fmaxf(fabsf(__uint_as_float((pq).y)), fabsf(__uint_as_float((pq).w)))); scv = _m > 0.f ? 224.f / _m : 1.f; } while (0)
#define V_GATHER(n) do { int _j, _t; V_TOK(n, _j, _t); const unsigned char* _vb = V4 + (size_t)_j * ((size_t)NEXP * 128) + 16 * c; const LAS unsigned* _e = (const LAS unsigned*)(pbuf + ((n) & 1) * 1024); \
    _Pragma("unroll") for (int i = 0; i < 16; ++i) G[i] = *(const uint4*)(_vb + (_e[8 * i + r] * 128u)); } while (0)
#define V_WRITEIMG() do { _Pragma("unroll") for (int i = 0; i < 16; ++i) { LAS unsigned char* _d = img + (8 * i + r) * VIMP + 16 * c; \
      *(LAS i32x2_t*)(_d) = (i32x2_t){(int)G[i].x, (int)G[i].y}; *(LAS i32x2_t*)(_d + 8) = (i32x2_t){(int)G[i].z, (int)G[i].w}; } } while (0)
  uint4 G[16];
  uint4 pq = V_LDPW(0);
  float sc_cur, sc_nxt;
  V_STAGE(0, pq, sc_cur); asm volatile("s_waitcnt lgkmcnt(0)" ::: "memory");
  if (N > 1) pq = V_LDPW(1);
  V_GATHER(0);
  V_WRITEIMG(); asm volatile("s_waitcnt lgkmcnt(0)" ::: "memory");
  for (int n = 0; n < N; ++n) {
    if (n + 1 < N) { V_STAGE(n + 1, pq, sc_nxt); asm volatile("s_waitcnt lgkmcnt(0)" ::: "memory"); if (n + 2 < N) pq = V_LDPW(n + 2); V_GATHER(n + 1); }
    __builtin_amdgcn_sched_barrier(0);
    int j, t; V_TOK(n, j, t);
    i32x8_t A;
    { const LAS float* wl = (const LAS float*)(pbuf + (n & 1) * 1024 + 512);
#pragma unroll
      for (int h = 0; h < 2; ++h)
#pragma unroll
        for (int d = 0; d < 4; ++d) { const f32x4_t w4 = *(const LAS f32x4_t*)(wl + 64 * h + 16 * kg + 4 * d);
          int w = __builtin_amdgcn_cvt_pk_fp8_f32(w4[0] * sc_cur, w4[1] * sc_cur, 0, false); w = __builtin_amdgcn_cvt_pk_fp8_f32(w4[2] * sc_cur, w4[3] * sc_cur, w, true);
          A[4 * h + d] = n16 == 0 ? w : 0; } }
    float val[16];
    const LAS unsigned char* ib = img + (32 * kg + n16) * VIMP;
#pragma unroll
    for (int ct = 0; ct < 16; ++ct) {
      const i32x2_t b0 = __builtin_amdgcn_ds_read_tr4_b64_v2i32((LAS i32x2_t*)(ib + 8 * ct)), b1 = __builtin_amdgcn_ds_read_tr4_b64_v2i32((LAS i32x2_t*)(ib + 16 * VIMP + 8 * ct));
      const f32x4_t z = {0.f, 0.f, 0.f, 0.f};
      const f32x4_t cc = __builtin_amdgcn_mfma_scale_f32_16x16x128_f8f6f4(A, (i32x8_t){b0[0], b0[1], b1[0], b1[1], 0, 0, 0, 0}, z, 0, 4, 0, 0x7F7F7F7F, 0, 0x7F7F7F7F);
      val[ct] = cc[0];
      asm volatile("" : "+v"(val[ct]));
    }
    LAS float* stg = (LAS float*)(pbuf + (n & 1) * 1024);
    if (lane < 16) {
#pragma unroll
      for (int ct = 0; ct < 16; ++ct) stg[16 * ct + lane] = val[ct];
    }
    asm volatile("s_waitcnt lgkmcnt(0)" ::: "memory");
    const f32x4_t s4 = *(const LAS f32x4_t*)(stg + 4 * lane);
    const float rs = 1.f / sc_cur;
    const uint2 xr = *(const uint2*)(xb + (size_t)t * D + 256 * j + 4 * lane);
    float4 o;
    o.x = bflo(xr.x) + s4[0] * rs; o.y = bfhi(xr.x) + s4[1] * rs; o.z = bflo(xr.y) + s4[2] * rs; o.w = bfhi(xr.y) + s4[3] * rs;
    *(float4*)(out + (size_t)t * D + 256 * j + 4 * lane) = o;
    __builtin_amdgcn_sched_barrier(0);
    asm volatile("s_waitcnt lgkmcnt(0)" ::: "memory");
    if (n + 1 < N) { V_WRITEIMG(); sc_cur = sc_nxt; }
    asm volatile("s_waitcnt lgkmcnt(0)" ::: "memory");
  }
}

constexpr int NPHASE = 9;
__global__ void __launch_bounds__(NTHREADS, 2) fwd_kernel(Params p) {
  extern __shared__ __attribute__((aligned(16))) unsigned char smem[];
  cg::grid_group grid = cg::this_grid();
  unsigned char* ws = p.ws;
  u16* wt_in = (u16*)(ws + WS_WTIN); u16* wt_out = (u16*)(ws + WS_WTOUT); u16* wt_q = (u16*)(ws + WS_WTQ);
  u16* act = (u16*)(ws + WS_ACT); u16* proj = (u16*)(ws + WS_PROJ);
  int* idx = (int*)(ws + WS_IDX); float2* gu = (float2*)(ws + WS_SB); unsigned char* U8 = ws + WS_U8; unsigned char* V8 = ws + WS_V8;
  uint2* pw = (uint2*)(ws + WS_PW); float* uinv = (float*)(ws + WS_UINV); float* vinv = (float*)(ws + WS_VINV);
  float* rowss = (float*)(ws + WS_ROWSS);
  volatile LAS unsigned* misc = (volatile LAS unsigned*)(LAS unsigned char*)(smem + LDS_MISC);
  if (threadIdx.x < 8) misc[threadIdx.x] = 0u;
  __syncthreads();
  XcdBarrier bar = xcd_barrier_post((unsigned*)(ws + WS_CTL), misc);
  PG8_LAS unsigned char* lds = (PG8_LAS unsigned char*)smem;
  const int lo = p.ph_lo, hi = p.ph_hi;
#define IN(k) (lo <= (k) && (k) < hi)
#define SEAM(k) do { if (IN(k) && IN((k) + 1)) xcd_barrier(bar); } while (0)
  if (IN(0)) {
    transpose_convert(p.w_in, wt_in, D, DIN, nullptr, (float*)smem);
    transpose_convert(p.w_out, wt_out, D, D, nullptr, (float*)smem);
    transpose_convert(p.w_q, wt_q, D, 2048, p.norm2_g, (float*)smem);
    convert_fp4_rows<false>(p.peer_u, p.norm2_g, U8, uinv);
    convert_fp4_rows<true>(p.peer_v, nullptr, V8, vinv);
    rmsnorm1024(p.x, p.norm1_g, act);
    for (int i = blockIdx.x * NTHREADS + threadIdx.x; i < T; i += gridDim.x * NTHREADS) rowss[i] = 0.f;
  }
  if (lo < 0) grid.sync();
  SEAM(0);
  if (IN(1)) { pg8::Gemm g{act, wt_in, T, DIN, D}; pg8::StaticOrder S; S.init(T, DIN, gridDim.x, blockIdx.x);
    pg8::EpiBf16S E{proj, DIN, nullptr}; pg8::gemm_phase<pg8::EpiBf16S, pg8::StaticOrder>(lds, g, S, E, nullptr); }
  SEAM(1);
  u16* vt = (u16*)(ws + WS_SB);
  if (IN(2)) postproj_phase(p, proj, act, vt, smem);
  SEAM(2);
  if (IN(3)) attn_phase(p, proj, vt, act, smem);
  SEAM(3);
  if (IN(4)) { pg8::Gemm g{act, wt_out, T, D, D}; pg8::StaticOrder S; S.init(T, D, gridDim.x, blockIdx.x);
    pg8::EpiResid E{p.x, p.out, proj, rowss, D}; pg8::gemm_phase<pg8::EpiResid, pg8::StaticOrder>(lds, g, S, E, nullptr); }
  SEAM(4);
  u16* xb = proj;
  u16* qp = proj + (size_t)T * D;
  if (IN(5)) { pg8::Gemm g{xb, wt_q, T, 2048, D}; pg8::StaticOrder S; S.init(T, 2048, gridDim.x, blockIdx.x);
    pg8::EpiBf16S E{qp, 2048, rowss}; pg8::gemm_phase<pg8::EpiBf16S, pg8::StaticOrder>(lds, g, S, E, nullptr); }
  SEAM(5);
  if (IN(6)) topk_phase(p, qp, uinv, idx, gu, smem);
  SEAM(6);
  if (IN(7)) peer_u_phase(xb, rowss, idx, gu, U8, vinv, pw, smem);
  SEAM(7);
  if (IN(8)) peer_v_phase(pw, V8, xb, p.out, smem);
}

extern "C" void kernel_launch(void* const* d_in, const int* in_sizes, int n_in, void* d_out, int out_size, void* d_ws, size_t ws_size,
                              hipStream_t stream) {
  static int grid_blocks = 0;
  if (!grid_blocks) {
    int dev = 0, cus = 0, per_cu = 0;
    (void)hipGetDevice(&dev);
    (void)hipDeviceGetAttribute(&cus, hipDeviceAttributeMultiprocessorCount, dev);
    (void)hipFuncSetAttribute((const void*)fwd_kernel, hipFuncAttributeMaxDynamicSharedMemorySize, LDS_BYTES);
    (void)hipOccupancyMaxActiveBlocksPerMultiprocessor(&per_cu, fwd_kernel, NTHREADS, LDS_BYTES);
    if (per_cu < 1) per_cu = 1;
    if (per_cu > 1) per_cu = 1;
    grid_blocks = cus * per_cu;
  }
  Params p{};
  p.x = (const float*)d_in[0]; p.norm1_g = (const float*)d_in[1]; p.w_in = (const float*)d_in[2]; p.q_norm_g = (const float*)d_in[3];
  p.k_norm_g = (const float*)d_in[4]; p.conv_w = (const float*)d_in[5]; p.sb_out_g = (const float*)d_in[6]; p.conv_out_g = (const float*)d_in[7];
  p.w_out = (const float*)d_in[8]; p.norm2_g = (const float*)d_in[9]; p.w_q = (const float*)d_in[10]; p.sub_keys = (const float*)d_in[11];
  p.peer_u = (const float*)d_in[12]; p.peer_v = (const float*)d_in[13];
  p.out = (float*)d_out; p.ws = (unsigned char*)d_ws;
  p.ph_lo = 0; p.ph_hi = NPHASE;
  (void)hipMemsetAsync((unsigned char*)d_ws + WS_CTL, 0, 4096 * 4 + 8 * 64 * 4, stream);
  void* args[] = {&p};
  hipError_t e = hipLaunchCooperativeKernel((void*)fwd_kernel, dim3(grid_blocks), dim3(NTHREADS), args, LDS_BYTES, stream);
  if (e != hipSuccess) fprintf(stderr, "cooperative launch failed: %s (grid %d)\n", hipGetErrorString(e), grid_blocks);
}
```

```cpp
#include <hip/hip_runtime.h>
#include <hip/hip_cooperative_groups.h>
#include <cstdio>
#include <cstdint>
namespace cg = cooperative_groups;

typedef unsigned short u16;
#define DI __device__ __forceinline__
#define LAS __attribute__((address_space(3)))

constexpr int T = 16384, D = 1024, SEQ = 4096;
constexpr int DIN = 3072, DSB = 512;
constexpr int NEXP = 16384;
constexpr float EPS = 1e-6f;
constexpr int NWAVES = 8, NTHREADS = NWAVES * 64;

namespace pg8 {
#define PG8_LAS __attribute__((address_space(3)))
typedef unsigned short bf16_t;
typedef short bf16x8 __attribute__((ext_vector_type(8)));
typedef float f32x4 __attribute__((ext_vector_type(4)));
typedef unsigned u32x4 __attribute__((ext_vector_type(4)));
constexpr int BM = 256, BK = 64, HALF = 128, HTB = HALF * BK * 2  , STAGE_BYTES = 8 * HTB, NXCD = 8, WGM = 8;

__host__ __device__ __forceinline__ int lds_byte(int r, int c) { const int st = (r >> 4) * 2 + (c >> 5), rr = r & 15, cc = c & 31, ob = rr * 64 + cc * 2; return st * 1024 + (ob ^ (((ob >> 9) & 1) << 5)); }
__host__ __device__ __forceinline__ void stage_rc(int b, int& R, int& C) { const int st = b / 1024, sb = b % 1024, swz = sb ^ (((sb >> 9) & 1) << 5); R = (st >> 1) * 16 + swz / 64; C = (st & 1) * 32 + (swz % 64) / 2; }
__host__ __device__ __forceinline__ int perm32(int rho) { const int n = rho >> 4, i = rho & 15; return 8 * (i >> 2) + 4 * n + (i & 3); }

struct Unit { int pm, pn; };
struct Gemm { const bf16_t* A; const bf16_t* Bt; int M, N, K; };
struct StaticOrder {
    int nM, nN, nwg, G, c;
    __host__ __device__ void init(int M, int N, int G_, int c_) { nM = M / BM; nN = N / BM; nwg = nM * nN; G = G_; c = c_; }
    __host__ __device__ bool next(int i, Unit& u) const {
        const long L = (long)i * G + c; if (L >= nwg) return false;
        int wgid = (int)L; { const int q = nwg / NXCD, r = nwg % NXCD, xcd = wgid % NXCD, off = wgid / NXCD; wgid = (xcd < r ? xcd * (q + 1) : r * (q + 1) + (xcd - r) * q) + off; }
        const int nig = WGM * nN, gid = wgid / nig, fm = gid * WGM, gsz = (nM - fm) < WGM ? (nM - fm) : WGM;
        u.pm = fm + ((wgid % nig) % gsz); u.pn = (wgid % nig) / gsz; return true;
    }
    __device__ __forceinline__ void a_ready(const Unit&) const {}
    __device__ __forceinline__ void done(const Unit&) const {}
};
__device__ __forceinline__ unsigned cvt_pk_bf16(float lo, float hi) { unsigned r; asm volatile("v_cvt_pk_bf16_f32 %0, %1, %2" : "=v"(r) : "v"(lo), "v"(hi)); return r; }

struct EpiBf16S {
    static constexpr bool PERM = true, AFTER_DRAIN = false;
    bf16_t* O; int ldc; const float* rowss;
    __device__ __forceinline__ void operator()(const f32x4 (&acc)[2][2][4][2], const Unit& u, int wr, int wc, int fr, int fq) const {
        const int row0 = u.pm * BM + wr * 64 + fr, col0 = u.pn * BM + wc * 32 + 8 * fq;
#pragma unroll
        for (int ai = 0; ai < 2; ++ai)
#pragma unroll
            for (int m = 0; m < 4; ++m) { const int row = row0 + ai * HALF + m * 16; bf16_t* rowp = O + (size_t)row * ldc + col0;
                const float sc = rowss ? rsqrtf(rowss[row] * (1.f / 1024.f) + 1e-6f) : 1.f;
#pragma unroll
                for (int bj = 0; bj < 2; ++bj) { const f32x4 v0 = acc[ai][bj][m][0] * sc, v1 = acc[ai][bj][m][1] * sc;
                    u32x4 w; w.x = cvt_pk_bf16(v0[0], v0[1]); w.y = cvt_pk_bf16(v0[2], v0[3]); w.z = cvt_pk_bf16(v1[0], v1[1]); w.w = cvt_pk_bf16(v1[2], v1[3]);
                    *(u32x4*)(rowp + bj * HALF) = w; } }
    }
};
struct EpiInProj {
    static constexpr bool PERM = true, AFTER_DRAIN = false;
    bf16_t* O; bf16_t* vt; float* ssq;
    __device__ __forceinline__ void operator()(const f32x4 (&acc)[2][2][4][2], const Unit& u, int wr, int wc, int fr, int fq) const {
        const int row0 = u.pm * BM + wr * 64 + fr, col0 = u.pn * BM + wc * 32 + 8 * fq, kind = u.pn >> 1;
#pragma unroll
        for (int ai = 0; ai < 2; ++ai)
#pragma unroll
            for (int m = 0; m < 4; ++m) { const int row = row0 + ai * HALF + m * 16; const int bb = row >> 12, ss = row & 4095;
#pragma unroll
                for (int bj = 0; bj < 2; ++bj) { const f32x4 v0 = acc[ai][bj][m][0], v1 = acc[ai][bj][m][1];
                    if (kind != 2) {
                        u32x4 w; w.x = cvt_pk_bf16(v0[0], v0[1]); w.y = cvt_pk_bf16(v0[2], v0[3]); w.z = cvt_pk_bf16(v1[0], v1[1]); w.w = cvt_pk_bf16(v1[2], v1[3]);
                        *(u32x4*)(O + (size_t)row * 3072 + col0 + bj * HALF) = w;
                        if (kind < 2) {
                            float sq = v0[0] * v0[0] + v0[1] * v0[1] + v0[2] * v0[2] + v0[3] * v0[3] + v1[0] * v1[0] + v1[1] * v1[1] + v1[2] * v1[2] + v1[3] * v1[3];
                            sq += __shfl_xor(sq, 16); sq += __shfl_xor(sq, 32);
                            const int head = (u.pn & 1) * 4 + bj * 2 + (wc >> 1);
                            if (fq == 0) unsafeAtomicAdd(ssq + ((size_t)(kind * 32 + bb * 8 + head)) * 4096 + ss, sq);
                        }
                    } else {
                        const int d0 = (u.pn & 1) * 256 + bj * HALF + wc * 32 + 8 * fq;
                        bf16_t* vp = vt + ((size_t)(bb * 512 + d0)) * 4096 + ss;
                        const unsigned w0 = cvt_pk_bf16(v0[0], v0[1]), w1 = cvt_pk_bf16(v0[2], v0[3]), w2 = cvt_pk_bf16(v1[0], v1[1]), w3 = cvt_pk_bf16(v1[2], v1[3]);
                        vp[0] = (bf16_t)w0; vp[4096] = (bf16_t)(w0 >> 16); vp[2 * 4096] = (bf16_t)w1; vp[3 * 4096] = (bf16_t)(w1 >> 16);
                        vp[4 * 4096] = (bf16_t)w2; vp[5 * 4096] = (bf16_t)(w2 >> 16); vp[6 * 4096] = (bf16_t)w3; vp[7 * 4096] = (bf16_t)(w3 >> 16);
                    } } }
    }
};
struct EpiResid {
    static constexpr bool PERM = true, AFTER_DRAIN = false;
    const float* resid; float* out32; bf16_t* xb; float* rowss; int ldc;
    __device__ __forceinline__ void operator()(const f32x4 (&acc)[2][2][4][2], const Unit& u, int wr, int wc, int fr, int fq) const {
        const int row0 = u.pm * BM + wr * 64 + fr, col0 = u.pn * BM + wc * 32 + 8 * fq;
#pragma unroll
        for (int ai = 0; ai < 2; ++ai)
#pragma unroll
            for (int m = 0; m < 4; ++m) { const int row = row0 + ai * HALF + m * 16; const size_t off = (size_t)row * ldc + col0; float ss = 0.f;
#pragma unroll
                for (int bj = 0; bj < 2; ++bj) {
                    const f32x4 r0 = *(const f32x4*)(resid + off + bj * HALF), r1 = *(const f32x4*)(resid + off + bj * HALF + 4);
                    const f32x4 o0 = r0 + acc[ai][bj][m][0], o1 = r1 + acc[ai][bj][m][1];
                    ss += o0[0] * o0[0] + o0[1] * o0[1] + o0[2] * o0[2] + o0[3] * o0[3] + o1[0] * o1[0] + o1[1] * o1[1] + o1[2] * o1[2] + o1[3] * o1[3];
                    u32x4 w; w.x = cvt_pk_bf16(o0[0], o0[1]); w.y = cvt_pk_bf16(o0[2], o0[3]); w.z = cvt_pk_bf16(o1[0], o1[1]); w.w = cvt_pk_bf16(o1[2], o1[3]);
                    *(u32x4*)(xb + off + bj * HALF) = w; }
                ss += __shfl_xor(ss, 16); ss += __shfl_xor(ss, 32);
                if (fq == 0) unsafeAtomicAdd(rowss + row, ss); }
    }
};
template <class Epi, class Sched, bool STAMP = false>
__device__ __forceinline__ void gemm_phase(PG8_LAS unsigned char* lds, const Gemm g, const Sched& S, const Epi& E, unsigned long long* stamps) {
    const int tid = threadIdx.x, wid = __builtin_amdgcn_readfirstlane(tid >> 6), lane = tid & 63, wr = wid >> 2, wc = wid & 3, fr = lane & 15, fq = lane >> 4;
    const int K = g.K, nt = K / BK;
    int ts_lo = 0, ts_hi = 0, nts = 0; const unsigned long long rt_entry = STAMP ? (unsigned long long)wall_clock64() : 0ull;
#define PG8_STAMP() do { if (STAMP && wid == 0 && nts < 64) { const unsigned long long _c = (unsigned long long)clock64(); \
        ts_lo = (lane == nts) ? (int)(unsigned)_c : ts_lo; ts_hi = (lane == nts) ? (int)(unsigned)(_c >> 32) : ts_hi; ++nts; } } while (0)
    PG8_STAMP();
    unsigned voffA[2], voffB[2];
#pragma unroll
    for (int i = 0; i < 2; ++i) { int R, C; stage_rc(tid * 16 + i * 8192, R, C); const int Rb = Epi::PERM ? ((R & ~31) + perm32(R & 31)) : R;
        voffA[i] = (unsigned)(R * K + C) * 2u; voffB[i] = (unsigned)(Rb * K + C) * 2u; }
    const size_t kstep = (size_t)(BK * 2);
    const size_t hstep = (size_t)HALF * K * 2;
    const size_t tstep = 2 * hstep;
    const unsigned ldsw = (unsigned)wid * 1024u;
    const int aoff = lds_byte(wr * 64 + fr, fq * 8), boff = lds_byte(wc * 32 + fr, fq * 8);
#define PG8_SA(b, h) (((b) * 2 + (h)) * HTB)
#define PG8_SB(b, h) ((4 + (b) * 2 + (h)) * HTB)
#define PG8_STAGE(bufoff, gbase, voff) do { _Pragma("unroll") for (int _i = 0; _i < 2; ++_i) \
        __builtin_amdgcn_global_load_lds((const unsigned*)((const char*)(gbase) + (voff)[_i]), (PG8_LAS unsigned*)(lds + (bufoff) + ldsw + _i * 8192), 16, 0, 0); } while (0)
#define PG8_LDA(dst, b, h) do { _Pragma("unroll") for (int m = 0; m < 4; ++m) _Pragma("unroll") for (int k = 0; k < 2; ++k) dst[m][k] = *(const PG8_LAS bf16x8*)(lds + PG8_SA(b, h) + aoff + m * 2048 + k * 1024); } while (0)
#define PG8_LDB(dst, b, h) do { _Pragma("unroll") for (int n = 0; n < 2; ++n) _Pragma("unroll") for (int k = 0; k < 2; ++k) dst[n][k] = *(const PG8_LAS bf16x8*)(lds + PG8_SB(b, h) + boff + n * 2048 + k * 1024); } while (0)
#define PG8_MMA(ai, bj, At, Bt) do { __builtin_amdgcn_s_setprio(1); _Pragma("unroll") for (int m = 0; m < 4; ++m) _Pragma("unroll") for (int n = 0; n < 2; ++n) _Pragma("unroll") for (int k = 0; k < 2; ++k) \
        acc[ai][bj][m][n] = __builtin_amdgcn_mfma_f32_16x16x32_bf16(Bt[n][k], At[m][k], acc[ai][bj][m][n], 0, 0, 0); __builtin_amdgcn_s_setprio(0); } while (0)
#define PG8_WAIT_V(n) asm volatile("s_waitcnt vmcnt(" #n ")" ::: "memory")
#define PG8_WAIT_L(n) asm volatile("s_waitcnt lgkmcnt(" #n ")" ::: "memory")
#define PG8_BAR __builtin_amdgcn_s_barrier()
#define PG8_SCHED __builtin_amdgcn_sched_barrier(0)
    Unit cur, nxt; int ui = 0;
    if (!S.next(0, cur)) return;
    f32x4 acc[2][2][4][2];
#pragma unroll
    for (int a = 0; a < 2; ++a)
#pragma unroll
        for (int b = 0; b < 2; ++b)
#pragma unroll
            for (int m = 0; m < 4; ++m)
#pragma unroll
                for (int n = 0; n < 2; ++n) acc[a][b][m][n] = (f32x4){0.f, 0.f, 0.f, 0.f};
    bf16x8 At[4][2], B0[2][2], B1[2][2];
    const char* cA = (const char*)g.A + (size_t)cur.pm * tstep; const char* cB = (const char*)g.Bt + (size_t)cur.pn * tstep;
    S.a_ready(cur);
    PG8_STAGE(PG8_SB(0, 0), cB, voffB); PG8_STAGE(PG8_SA(0, 0), cA, voffA); PG8_STAGE(PG8_SB(0, 1), cB + hstep, voffB); PG8_STAGE(PG8_SA(0, 1), cA + hstep, voffA);
    if (wr == 1) PG8_BAR;
    PG8_WAIT_V(4); PG8_BAR;
    PG8_STAGE(PG8_SB(1, 0), cB + kstep, voffB); PG8_STAGE(PG8_SA(1, 0), cA + kstep, voffA); PG8_STAGE(PG8_SB(1, 1), cB + hstep + kstep, voffB);
    PG8_WAIT_V(6); PG8_BAR;
    PG8_STAMP();
    for (;;) {
        const bool has_next = S.next(ui + 1, nxt);
        const char* nA = has_next ? (const char*)g.A + (size_t)nxt.pm * tstep : cA; const char* nB = has_next ? (const char*)g.Bt + (size_t)nxt.pn * tstep : cB;
        for (int t = 0; t < nt; t += 2) {
            const bool last = (t == nt - 2);
            const char* a1 = cA + (size_t)(t + 1) * kstep;
            const char* a2 = last ? nA : cA + (size_t)(t + 2) * kstep; const char* b2 = last ? nB : cB + (size_t)(t + 2) * kstep;
            const char* a3 = a2 + kstep; const char* b3 = b2 + kstep;
            if (last && has_next) S.a_ready(nxt);
            PG8_LDB(B0, 0, 0); PG8_SCHED; PG8_LDA(At, 0, 0); PG8_STAGE(PG8_SA(1, 1), a1 + hstep, voffA);
            PG8_WAIT_L(8); PG8_BAR; PG8_WAIT_L(0); PG8_MMA(0, 0, At, B0); PG8_BAR; PG8_SCHED;
            PG8_LDB(B1, 0, 1); PG8_STAGE(PG8_SB(0, 0), b2, voffB);
            PG8_BAR; PG8_WAIT_L(0); PG8_MMA(0, 1, At, B1); PG8_BAR;
            PG8_LDA(At, 0, 1); PG8_STAGE(PG8_SA(0, 0), a2, voffA);
            PG8_BAR; PG8_WAIT_L(0); PG8_MMA(1, 0, At, B0); PG8_BAR; PG8_SCHED;
            PG8_STAGE(PG8_SB(0, 1), b2 + hstep, voffB);
            PG8_WAIT_V(6); PG8_BAR; PG8_MMA(1, 1, At, B1); PG8_BAR;
            PG8_LDB(B0, 1, 0); PG8_SCHED; PG8_LDA(At, 1, 0); PG8_STAGE(PG8_SA(0, 1), a2 + hstep, voffA);
            PG8_WAIT_L(8); PG8_BAR; PG8_WAIT_L(0); PG8_MMA(0, 0, At, B0); PG8_BAR; PG8_SCHED;
            PG8_LDB(B1, 1, 1); PG8_STAGE(PG8_SB(1, 0), b3, voffB);
            PG8_BAR; PG8_WAIT_L(0); PG8_MMA(0, 1, At, B1); PG8_BAR;
            PG8_LDA(At, 1, 1); PG8_STAGE(PG8_SA(1, 0), a3, voffA);
            PG8_BAR; PG8_WAIT_L(0); PG8_MMA(1, 0, At, B0); PG8_BAR; PG8_SCHED;
            PG8_STAGE(PG8_SB(1, 1), b3 + hstep, voffB);
            PG8_WAIT_V(6); PG8_BAR; PG8_MMA(1, 1, At, B1); PG8_BAR;
        }
        PG8_STAMP();
        if constexpr (!Epi::AFTER_DRAIN) { E(acc, cur, wr, wc, fr, fq); S.done(cur); }
        PG8_STAMP();
        if (!has_next) break;
#pragma unroll
        for (int a = 0; a < 2; ++a)
#pragma unroll
            for (int b = 0; b < 2; ++b)
#pragma unroll
                for (int m = 0; m < 4; ++m)
#pragma unroll
                    for (int n = 0; n < 2; ++n) acc[a][b][m][n] = (f32x4){0.f, 0.f, 0.f, 0.f};
        cur = nxt; cA = nA; cB = nB; ++ui;
    }
    PG8_WAIT_V(0);
    if (wr == 0) PG8_BAR;
    PG8_BAR;
    if constexpr (Epi::AFTER_DRAIN) { E.fused(acc, cur, wr, wc, fr, fq, lds, wid, lane); S.done(cur); }
    PG8_STAMP();
    if (STAMP && wid == 0) { stamps[lane] = lane < nts ? (((unsigned long long)(unsigned)ts_hi << 32) | (unsigned)ts_lo) : 0ull;
        if (lane == 62) stamps[62] = rt_entry; if (lane == 63) stamps[63] = (unsigned long long)wall_clock64(); }
#undef PG8_STAMP
#undef PG8_SA
#undef PG8_SB
#undef PG8_STAGE
#undef PG8_LDA
#undef PG8_LDB
#undef PG8_MMA
#undef PG8_WAIT_V
#undef PG8_WAIT_L
#undef PG8_BAR
#undef PG8_SCHED
}
}


constexpr size_t MBy = 1u << 20;
constexpr size_t WS_WTIN = 0, WS_WTOUT = 6 * MBy, WS_WTQ = 8 * MBy, WS_CTL = 12 * MBy, WS_ROWSS = 12 * MBy + 65536, WS_ACT = 13 * MBy, WS_PROJ = 45 * MBy,
                 WS_SB = 141 * MBy, WS_IDX = 173 * MBy, WS_GATE = 181 * MBy, WS_U8 = 189 * MBy, WS_V8 = 205 * MBy, WS_PW = 221 * MBy,
                 WS_UINV = 12 * MBy + 262144, WS_VINV = 12 * MBy + 393216;
constexpr int VIMP = 136, VWAVE = 128 * VIMP + 2048;
constexpr int LDS_MISC = 8 * VWAVE, LDS_BYTES = 8 * VWAVE + 256;
static_assert(LDS_MISC >= pg8::STAGE_BYTES && LDS_BYTES <= 163840, "LDS budget");

struct Params {
  const float *x, *norm1_g, *w_in, *q_norm_g, *k_norm_g, *conv_w, *sb_out_g, *conv_out_g, *w_out, *norm2_g, *w_q, *sub_keys, *peer_u, *peer_v;
  float* out; unsigned char* ws; int ph_lo, ph_hi;
};

#define XB_TMO      128
#define XB_XCNT(j)  (256  + 64 * (j))
#define XB_XSUB(j)  (1280 + 64 * (j))
#define XB_XGEN(j)  (2304 + 64 * (j))
#define XB_TOP      3328
#define XB_TOPGEN   3392
#define XCD_BAR_WORDS 3456
#define XB_SPIN_CAP (1u << 18)
DI unsigned xb_ld(unsigned* p) { return __hip_atomic_load(p, __ATOMIC_RELAXED, __HIP_MEMORY_SCOPE_AGENT); }
DI unsigned xb_add(unsigned* p, unsigned v) { return __hip_atomic_fetch_add(p, v, __ATOMIC_RELAXED, __HIP_MEMORY_SCOPE_AGENT); }
DI unsigned xb_xcc_id() { return (unsigned)__builtin_amdgcn_s_getreg((3 << 11) | 20) & 0xFu; }
#define XB_SPIN(cond, bar) do { unsigned _sp = 0; while (cond) { __builtin_amdgcn_s_sleep(1); \
    if ((++_sp & 255u) == 0u) { if (xb_ld(&(bar)[XB_TMO])) break; if (_sp > XB_SPIN_CAP) { atomicAdd(&(bar)[XB_TMO], 1u); break; } } } } while (0)
struct XcdBarrier { unsigned* bar; unsigned x; volatile LAS unsigned* st; };
DI XcdBarrier xcd_barrier_post(unsigned* bar, volatile LAS unsigned* st) {
  XcdBarrier b; b.bar = bar; b.x = xb_xcc_id(); b.st = st;
  if (threadIdx.x == 0) (void)xb_add(&bar[XB_XCNT(b.x)], 1u);
  return b;
}
DI void xcd_barrier_complete(unsigned* bar, unsigned x, unsigned& nloc, unsigned& nx) {
  const unsigned G = gridDim.x * gridDim.y * gridDim.z;
  unsigned sum, cnt, mine, sp = 0u;
  for (;;) {
    sum = 0u; cnt = 0u; mine = 0u;
#pragma unroll
    for (unsigned j = 0; j < 16; ++j) { const unsigned c = xb_ld(&bar[XB_XCNT(j)]); sum += c; cnt += (c > 0u) ? 1u : 0u; mine = (j == x) ? c : mine; }
    if (sum == G) break;
    __builtin_amdgcn_s_sleep(1);
    if ((++sp & 255u) == 0u) { if (xb_ld(&bar[XB_TMO])) break; if (sp > XB_SPIN_CAP) { atomicAdd(&bar[XB_TMO], 1u); break; } }
  }
  nloc = mine > 0u ? mine : 1u; nx = cnt > 0u ? cnt : 1u;
}
DI void xcd_barrier(const XcdBarrier& b) {
  asm volatile("s_waitcnt vmcnt(0)" ::: "memory");
  __syncthreads();
  if (threadIdx.x == 0) {
    unsigned* bar = b.bar;
    __builtin_amdgcn_s_waitcnt(0);
    unsigned nloc = b.st[0], nx = b.st[1];
    if (nloc == 0u) { xcd_barrier_complete(bar, b.x, nloc, nx); b.st[0] = nloc; b.st[1] = nx; }
    const unsigned old = xb_add(&bar[XB_XSUB(b.x)], 1u);
    const unsigned gen = old / nloc;
    if (old + 1u == (gen + 1u) * nloc) {
      __builtin_amdgcn_fence(__ATOMIC_RELEASE, "agent");
      asm volatile("s_waitcnt vmcnt(0)" ::: "memory");
      const unsigned og = xb_add(&bar[XB_TOP], 1u);
      const unsigned tg = og / nx;
      if (og + 1u == (tg + 1u) * nx) xb_add(&bar[XB_TOPGEN], 1u);
      else XB_SPIN(xb_ld(&bar[XB_TOPGEN]) == tg, bar);
      __builtin_amdgcn_fence(__ATOMIC_ACQUIRE, "agent");
      xb_add(&bar[XB_XGEN(b.x)], 1u);
      asm volatile("s_waitcnt vmcnt(0)" ::: "memory");
    } else {
      XB_SPIN(xb_ld(&bar[XB_XGEN(b.x)]) == gen, bar);
      __builtin_amdgcn_fence(__ATOMIC_ACQUIRE, "agent");
      asm volatile("s_waitcnt vmcnt(0)" ::: "memory");
    }
  }
  __syncthreads();
}

DI u16 f2bf(float x) { unsigned u = __float_as_uint(x); u += 0x7fffu + ((u >> 16) & 1u); return (u16)(u >> 16); }
DI float bflo(unsigned w) { return __uint_as_float(w << 16); }
DI float bfhi(unsigned w) { return __uint_as_float(w & 0xffff0000u); }
DI unsigned pack2(float a, float b) { return (unsigned)f2bf(a) | ((unsigned)f2bf(b) << 16); }
DI float wave_sum(float v) {
#pragma unroll
  for (int o = 32; o >= 1; o >>= 1) v += __shfl_xor(v, o);
  return v;
}
DI float wave_max(float v) {
#pragma unroll
  for (int o = 32; o >= 1; o >>= 1) v = fmaxf(v, __shfl_xor(v, o));
  return v;
}
DI void unpack8(const uint4 w, float* f) {
  f[0] = bflo(w.x); f[1] = bfhi(w.x); f[2] = bflo(w.y); f[3] = bfhi(w.y); f[4] = bflo(w.z); f[5] = bfhi(w.z); f[6] = bflo(w.w); f[7] = bfhi(w.w);
}
DI uint4 pack8(const float* f) { uint4 o; o.x = pack2(f[0], f[1]); o.y = pack2(f[2], f[3]); o.z = pack2(f[4], f[5]); o.w = pack2(f[6], f[7]); return o; }

DI void transpose_convert(const float* __restrict__ W, u16* __restrict__ Wt, int K, int N, const float* __restrict__ rg, float* sm) {
  const int tid = threadIdx.x, tn_cnt = N / 64, ntile = (K / 64) * tn_cnt;
  for (int tile = blockIdx.x; tile < ntile; tile += gridDim.x) {
    const int tk = tile / tn_cnt, tn = tile % tn_cnt;
    __syncthreads();
#pragma unroll
    for (int r = 0; r < 8; ++r) { const int row = r * 8 + (tid >> 6), col = tid & 63;
      const float g = rg ? rg[tk * 64 + row] : 1.f;
      sm[row * 65 + col] = W[(size_t)(tk * 64 + row) * N + tn * 64 + col] * g; }
    __syncthreads();
#pragma unroll
    for (int r = 0; r < 8; ++r) { const int nrow = r * 8 + (tid >> 6), kcol = tid & 63; Wt[(size_t)(tn * 64 + nrow) * K + tk * 64 + kcol] = f2bf(sm[kcol * 65 + nrow]); }
  }
}
template <bool SLICED>
DI void convert_fp8_rows(const float* __restrict__ src, const float* __restrict__ cg, unsigned char* __restrict__ dst, float* __restrict__ inv_out) {
  const int lane = threadIdx.x & 63, gw = blockIdx.x * NWAVES + (threadIdx.x >> 6), nw = gridDim.x * NWAVES;
  float g[16];
#pragma unroll
  for (int j = 0; j < 16; ++j) g[j] = cg ? cg[16 * lane + j] : 1.f;
  for (int row = gw; row < NEXP; row += nw) {
    const float4* s = (const float4*)(src + (size_t)row * D + 16 * lane);
    float v[16];
#pragma unroll
    for (int k = 0; k < 4; ++k) { const float4 a = s[k]; v[4 * k] = a.x * g[4 * k]; v[4 * k + 1] = a.y * g[4 * k + 1]; v[4 * k + 2] = a.z * g[4 * k + 2]; v[4 * k + 3] = a.w * g[4 * k + 3]; }
    float am = 0.f;
#pragma unroll
    for (int j = 0; j < 16; ++j) am = fmaxf(am, fabsf(v[j]));
    am = wave_max(am);
    const float sc = am > 0.f ? 240.f / am : 1.f;
    uint4 o;
    { int w;
      w = __builtin_amdgcn_cvt_pk_fp8_f32(v[0] * sc, v[1] * sc, 0, false); w = __builtin_amdgcn_cvt_pk_fp8_f32(v[2] * sc, v[3] * sc, w, true); o.x = (unsigned)w;
      w = __builtin_amdgcn_cvt_pk_fp8_f32(v[4] * sc, v[5] * sc, 0, false); w = __builtin_amdgcn_cvt_pk_fp8_f32(v[6] * sc, v[7] * sc, w, true); o.y = (unsigned)w;
      w = __builtin_amdgcn_cvt_pk_fp8_f32(v[8] * sc, v[9] * sc, 0, false); w = __builtin_amdgcn_cvt_pk_fp8_f32(v[10] * sc, v[11] * sc, w, true); o.z = (unsigned)w;
      w = __builtin_amdgcn_cvt_pk_fp8_f32(v[12] * sc, v[13] * sc, 0, false); w = __builtin_amdgcn_cvt_pk_fp8_f32(v[14] * sc, v[15] * sc, w, true); o.w = (unsigned)w; }
    if (SLICED) *(uint4*)(dst + (size_t)(lane >> 3) * ((size_t)NEXP * 128) + (size_t)row * 128 + 16 * (lane & 7)) = o;
    else *(uint4*)(dst + (size_t)row * D + 16 * lane) = o;
    if (lane == 0) inv_out[row] = am > 0.f ? am * (1.f / 240.f) : 1.f;
  }
}
template <bool SLICED>
DI void convert_fp4_rows(const float* __restrict__ src, const float* __restrict__ cg, unsigned char* __restrict__ dst, float* __restrict__ inv_out) {
  const int lane = threadIdx.x & 63, gw = blockIdx.x * NWAVES + (threadIdx.x >> 6), nw = gridDim.x * NWAVES;
  float4 g[4];
#pragma unroll
  for (int k = 0; k < 4; ++k) g[k] = cg ? ((const float4*)cg)[lane + 64 * k] : make_float4(1.f, 1.f, 1.f, 1.f);
  for (int row0 = gw * 4; row0 < NEXP; row0 += nw * 4) {
    float4 a[4][4];
#pragma unroll
    for (int rr = 0; rr < 4; ++rr)
#pragma unroll
      for (int k = 0; k < 4; ++k) a[rr][k] = ((const float4*)(src + (size_t)(row0 + rr) * D))[lane + 64 * k];
#pragma unroll
    for (int rr = 0; rr < 4; ++rr) {
      float am = 0.f;
#pragma unroll
      for (int k = 0; k < 4; ++k) { a[rr][k].x *= g[k].x; a[rr][k].y *= g[k].y; a[rr][k].z *= g[k].z; a[rr][k].w *= g[k].w;
        am = fmaxf(fmaxf(am, fmaxf(fabsf(a[rr][k].x), fabsf(a[rr][k].y))), fmaxf(fabsf(a[rr][k].z), fabsf(a[rr][k].w))); }
      am = wave_max(am);
      const float sc = am > 0.f ? 6.f / am : 1.f;
      const int row = row0 + rr;
#pragma unroll
      for (int k = 0; k < 4; ++k) {
        unsigned w = 0u;
        w = __builtin_amdgcn_cvt_scalef32_pk_fp4_f32(w, a[rr][k].x * sc, a[rr][k].y * sc, 1.0f, 0); w = __builtin_amdgcn_cvt_scalef32_pk_fp4_f32(w, a[rr][k].z * sc, a[rr][k].w * sc, 1.0f, 1);
        if (SLICED) *(u16*)(dst + (size_t)k * ((size_t)NEXP * 128) + (size_t)row * 128 + 2 * lane) = (u16)w;
        else *(u16*)(dst + (size_t)row * 512 + 128 * k + 2 * lane) = (u16)w;
      }
      if (lane == 0) inv_out[row] = am > 0.f ? am * (1.f / 6.f) : 1.f;
    }
  }
}
DI void rmsnorm1024(const float* __restrict__ src, const float* __restrict__ g, u16* __restrict__ dst) {
  const int lane = threadIdx.x & 63, gw = blockIdx.x * NWAVES + (threadIdx.x >> 6), nw = gridDim.x * NWAVES;
  float4 gg[4];
#pragma unroll
  for (int j = 0; j < 4; ++j) gg[j] = ((const float4*)g)[lane + 64 * j];
  for (int row0 = gw * 4; row0 < T; row0 += nw * 4) {
    float4 v[4][4];
#pragma unroll
    for (int rr = 0; rr < 4; ++rr)
#pragma unroll
      for (int j = 0; j < 4; ++j) v[rr][j] = ((const float4*)(src + (size_t)(row0 + rr) * D))[lane + 64 * j];
#pragma unroll
    for (int rr = 0; rr < 4; ++rr) {
      float ss = 0.f;
#pragma unroll
      for (int j = 0; j < 4; ++j) ss += v[rr][j].x * v[rr][j].x + v[rr][j].y * v[rr][j].y + v[rr][j].z * v[rr][j].z + v[rr][j].w * v[rr][j].w;
      ss = wave_sum(ss);
      const float inv = rsqrtf(ss * (1.f / D) + EPS);
#pragma unroll
      for (int j = 0; j < 4; ++j) {
        uint2 o; o.x = pack2(v[rr][j].x * inv * gg[j].x, v[rr][j].y * inv * gg[j].y); o.y = pack2(v[rr][j].z * inv * gg[j].z, v[rr][j].w * inv * gg[j].w);
        *(uint2*)(dst + (size_t)(row0 + rr) * D + 4 * (lane + 64 * j)) = o;
      }
    }
  }
}

DI void conv_tokens(const Params& p, const u16* __restrict__ proj, u16* __restrict__ mixed) {
  const int lane = threadIdx.x & 63, gw = blockIdx.x * NWAVES + (threadIdx.x >> 6), nw = gridDim.x * NWAVES;
  const int c0 = 8 * lane;
  float w0[8], w1[8], w2[8], go[8];
#pragma unroll
  for (int j = 0; j < 8; ++j) { w0[j] = p.conv_w[c0 + j]; w1[j] = p.conv_w[DSB + c0 + j]; w2[j] = p.conv_w[2 * DSB + c0 + j]; go[j] = p.conv_out_g[c0 + j]; }
#pragma unroll 2
  for (int t = gw; t < T; t += nw) {
    const u16* row = proj + (size_t)t * DIN;
    const int tpos = t & (SEQ - 1);
    float xc[8], bg[8], cg[8], y[8];
    unpack8(*(const uint4*)(row + 1536 + c0), xc); unpack8(*(const uint4*)(row + 2048 + c0), bg); unpack8(*(const uint4*)(row + 2560 + c0), cg);
#pragma unroll
    for (int j = 0; j < 8; ++j) y[j] = w2[j] * (cg[j] * xc[j]);
    if (tpos >= 1) {
      float x1[8], c1[8]; unpack8(*(const uint4*)(row - DIN + 1536 + c0), x1); unpack8(*(const uint4*)(row - DIN + 2560 + c0), c1);
#pragma unroll
      for (int j = 0; j < 8; ++j) y[j] += w1[j] * (c1[j] * x1[j]);
    }
    if (tpos >= 2) {
      float x2[8], c2[8]; unpack8(*(const uint4*)(row - 2 * DIN + 1536 + c0), x2); unpack8(*(const uint4*)(row - 2 * DIN + 2560 + c0), c2);
#pragma unroll
      for (int j = 0; j < 8; ++j) y[j] += w0[j] * (c2[j] * x2[j]);
    }
    float ss = 0.f;
#pragma unroll
    for (int j = 0; j < 8; ++j) { y[j] *= bg[j]; ss += y[j] * y[j]; }
    ss = wave_sum(ss);
    const float inv = rsqrtf(ss * (1.f / DSB) + EPS);
#pragma unroll
    for (int j = 0; j < 8; ++j) y[j] = y[j] * inv * go[j];
    *(uint4*)(mixed + (size_t)t * D + DSB + c0) = pack8(y);
  }
}

typedef float f32x16_t __attribute__((ext_vector_type(16)));
typedef short bf16x8_t __attribute__((ext_vector_type(8)));
DI bf16x8_t pack_bf16x8(float a0, float a1, float a2, float a3, float a4, float a5, float a6, float a7) {
  pg8::u32x4 r;
  asm volatile("v_cvt_pk_bf16_f32 %0, %4, %5\n\tv_cvt_pk_bf16_f32 %1, %6, %7\n\tv_cvt_pk_bf16_f32 %2, %8, %9\n\tv_cvt_pk_bf16_f32 %3, %10, %11\n\ts_nop 1"
               : "=&v"(r[0]), "=&v"(r[1]), "=&v"(r[2]), "=&v"(r[3]) : "v"(a0), "v"(a1), "v"(a2), "v"(a3), "v"(a4), "v"(a5), "v"(a6), "v"(a7));
  return __builtin_bit_cast(bf16x8_t, r);
}
template <bool DIAG>
DI void attn_tile(const u16* __restrict__ kr, const u16* __restrict__ vr, const float* __restrict__ ksq, const bf16x8_t (&qf)[4], int c, int hh, float& carry, f32x16_t& o0, f32x16_t& o1) {
  f32x16_t s;
#pragma unroll
  for (int r = 0; r < 16; ++r) s[r] = 0.f;
#pragma unroll
  for (int ks = 0; ks < 4; ++ks) s = __builtin_amdgcn_mfma_f32_32x32x16_bf16(*(const bf16x8_t*)(kr + 16 * ks), qf[ks], s, 0, 0, 0);
  const bf16x8_t v00 = *(const bf16x8_t*)(vr), v01 = *(const bf16x8_t*)(vr + 8), v10 = *(const bf16x8_t*)(vr + 32 * SEQ), v11 = *(const bf16x8_t*)(vr + 32 * SEQ + 8);
  float ik[16];
#pragma unroll
  for (int r4 = 0; r4 < 4; ++r4) { const float4 q4 = ((const float4*)ksq)[r4];
    ik[4 * r4] = rsqrtf(q4.x * (1.f / 64.f) + EPS); ik[4 * r4 + 1] = rsqrtf(q4.y * (1.f / 64.f) + EPS); ik[4 * r4 + 2] = rsqrtf(q4.z * (1.f / 64.f) + EPS); ik[4 * r4 + 3] = rsqrtf(q4.w * (1.f / 64.f) + EPS); }
  float rr[16], be[16];
#pragma unroll
  for (int r = 0; r < 16; ++r) {
    const float e = __builtin_amdgcn_exp2f(fminf(s[r] * ik[r] * 0.18033688011112042f, 100.f));
    float x = __builtin_amdgcn_rcpf(1.f + e), b = e * x;
    if (DIAG) { const bool on = (16 * hh + r) < c; x = on ? x : 1.f; b = on ? b : 0.f; }
    rr[r] = x; be[r] = b;
  }
  float tot = ((rr[0] * rr[1]) * (rr[2] * rr[3])) * ((rr[4] * rr[5]) * (rr[6] * rr[7]));
  tot *= ((rr[8] * rr[9]) * (rr[10] * rr[11])) * ((rr[12] * rr[13]) * (rr[14] * rr[15]));
  const float oth = __shfl_xor(tot, 32);
  float P = hh ? carry : carry * oth;
  float a[16];
#pragma unroll
  for (int r = 15; r >= 0; --r) { a[r] = be[r] * P; P *= rr[r]; }
  carry = carry * tot * oth;
  const bf16x8_t af0 = pack_bf16x8(a[0], a[1], a[2], a[3], a[4], a[5], a[6], a[7]), af1 = pack_bf16x8(a[8], a[9], a[10], a[11], a[12], a[13], a[14], a[15]);
  o0 = __builtin_amdgcn_mfma_f32_32x32x16_bf16(v00, af0, o0, 0, 0, 0); o0 = __builtin_amdgcn_mfma_f32_32x32x16_bf16(v01, af1, o0, 0, 0, 0);
  o1 = __builtin_amdgcn_mfma_f32_32x32x16_bf16(v10, af0, o1, 0, 0, 0); o1 = __builtin_amdgcn_mfma_f32_32x32x16_bf16(v11, af1, o1, 0, 0, 0);
}
DI void attn_phase(const Params& p, const u16* __restrict__ proj, const u16* __restrict__ vt, const float* __restrict__ ssq, u16* __restrict__ mixed, unsigned char* smem) {
  const int lane = threadIdx.x & 63, head = threadIdx.x >> 6, c = lane & 31, hh = lane >> 5;
  LAS float* red = (LAS float*)smem;
  const int kap = 16 * ((c >> 2) & 1) + (c & 3) + 4 * (c >> 3);
  float gqk[32];
#pragma unroll
  for (int ks = 0; ks < 4; ++ks)
#pragma unroll
    for (int j = 0; j < 8; ++j) gqk[8 * ks + j] = p.q_norm_g[16 * ks + 8 * hh + j] * p.k_norm_g[16 * ks + 8 * hh + j];
  for (int item = blockIdx.x; item < 4 * 128; item += gridDim.x) {
    const int b = item & 3, q0 = (127 - (item >> 2)) * 32;
    const size_t tq = (size_t)b * SEQ + q0 + c;
    const float* qsq = ssq + ((size_t)(b * 8 + head)) * SEQ;
    const float* ksqb = ssq + ((size_t)(32 + b * 8 + head)) * SEQ + 16 * hh;
    const float iq = rsqrtf(qsq[q0 + c] * (1.f / 64.f) + EPS);
    bf16x8_t qf[4];
#pragma unroll
    for (int ks = 0; ks < 4; ++ks) { float f[8]; unpack8(*(const uint4*)(proj + tq * DIN + head * 64 + 16 * ks + 8 * hh), f);
      qf[ks] = pack_bf16x8(f[0] * iq * gqk[8 * ks], f[1] * iq * gqk[8 * ks + 1], f[2] * iq * gqk[8 * ks + 2], f[3] * iq * gqk[8 * ks + 3],
                           f[4] * iq * gqk[8 * ks + 4], f[5] * iq * gqk[8 * ks + 5], f[6] * iq * gqk[8 * ks + 6], f[7] * iq * gqk[8 * ks + 7]); }
    f32x16_t o0, o1;
#pragma unroll
    for (int r = 0; r < 16; ++r) { o0[r] = 0.f; o1[r] = 0.f; }
    float carry = 1.f;
    const u16* kbase = proj + ((size_t)b * SEQ + kap) * DIN + 512 + head * 64 + 8 * hh;
    const u16* vbase = vt + ((size_t)(b * 512 + head * 64 + c)) * SEQ + 16 * hh;
    attn_tile<true>(kbase + (size_t)q0 * DIN, vbase + q0, ksqb + q0, qf, c, hh, carry, o0, o1);
    for (int tb = q0 - 32; tb >= 0; tb -= 32) {
      attn_tile<false>(kbase + (size_t)tb * DIN, vbase + tb, ksqb + tb, qf, c, hh, carry, o0, o1);
      if (__all(carry == 0.f)) break;
    }
    float ss = 0.f;
#pragma unroll
    for (int r = 0; r < 16; ++r) ss += o0[r] * o0[r] + o1[r] * o1[r];
    ss += __shfl_xor(ss, 32);
    __syncthreads();
    if (hh == 0) red[head * 32 + c] = ss;
    __syncthreads();
    float tot = 0.f;
#pragma unroll
    for (int h8 = 0; h8 < 8; ++h8) tot += red[h8 * 32 + c];
    const float inv = rsqrtf(tot * (1.f / DSB) + EPS);
    u16* orow = mixed + tq * D + head * 64 + 4 * hh;
    const float* g = p.sb_out_g + head * 64 + 4 * hh;
#pragma unroll
    for (int rg = 0; rg < 4; ++rg) {
      const float4 g0 = *(const float4*)(g + 8 * rg), g1 = *(const float4*)(g + 32 + 8 * rg);
      uint2 w0, w1;
      w0.x = pack2(o0[4 * rg] * inv * g0.x, o0[4 * rg + 1] * inv * g0.y); w0.y = pack2(o0[4 * rg + 2] * inv * g0.z, o0[4 * rg + 3] * inv * g0.w);
      w1.x = pack2(o1[4 * rg] * inv * g1.x, o1[4 * rg + 1] * inv * g1.y); w1.y = pack2(o1[4 * rg + 2] * inv * g1.z, o1[4 * rg + 3] * inv * g1.w);
      *(uint2*)(orow + 8 * rg) = w0; *(uint2*)(orow + 32 + 8 * rg) = w1;
    }
  }
}

#define SEL_DI DI
#define SEL_F2U(x) __float_as_uint(x)
#define SEL_U2F(x) __uint_as_float(x)

#define CE(a, b) do { const unsigned _h = (a) > (b) ? (a) : (b), _l = (a) > (b) ? (b) : (a); (a) = _h; (b) = _l; } while (0)
SEL_DI void sort16(unsigned (&v)[16]) {
  CE(v[0], v[1]); CE(v[2], v[3]); CE(v[0], v[2]); CE(v[1], v[3]); CE(v[1], v[2]); CE(v[4], v[5]); CE(v[6], v[7]); CE(v[4], v[6]);
  CE(v[5], v[7]); CE(v[5], v[6]); CE(v[0], v[4]); CE(v[2], v[6]); CE(v[2], v[4]); CE(v[1], v[5]); CE(v[3], v[7]); CE(v[3], v[5]);
  CE(v[1], v[2]); CE(v[3], v[4]); CE(v[5], v[6]); CE(v[8], v[9]); CE(v[10], v[11]); CE(v[8], v[10]); CE(v[9], v[11]); CE(v[9], v[10]);
  CE(v[12], v[13]); CE(v[14], v[15]); CE(v[12], v[14]); CE(v[13], v[15]); CE(v[13], v[14]); CE(v[8], v[12]); CE(v[10], v[14]); CE(v[10], v[12]);
  CE(v[9], v[13]); CE(v[11], v[15]); CE(v[11], v[13]); CE(v[9], v[10]); CE(v[11], v[12]); CE(v[13], v[14]); CE(v[0], v[8]); CE(v[4], v[12]);
  CE(v[4], v[8]); CE(v[2], v[10]); CE(v[6], v[14]); CE(v[6], v[10]); CE(v[2], v[4]); CE(v[6], v[8]); CE(v[10], v[12]); CE(v[1], v[9]);
  CE(v[5], v[13]); CE(v[5], v[9]); CE(v[3], v[11]); CE(v[7], v[15]); CE(v[7], v[11]); CE(v[3], v[5]); CE(v[7], v[9]); CE(v[11], v[13]);
  CE(v[1], v[2]); CE(v[3], v[4]); CE(v[5], v[6]); CE(v[7], v[8]); CE(v[9], v[10]); CE(v[11], v[12]); CE(v[13], v[14]);
}
SEL_DI void bitonic_merge16(unsigned (&v)[16]) {
#pragma unroll
  for (int d = 8; d >= 1; d >>= 1)
#pragma unroll
    for (int i = 0; i < 16; ++i) if ((i & d) == 0) CE(v[i], v[i + d]);
}
SEL_DI void merge_top16(unsigned (&a)[16], const unsigned (&b)[16]) {
#pragma unroll
  for (int i = 0; i < 16; ++i) a[i] = a[i] > b[15 - i] ? a[i] : b[15 - i];
  bitonic_merge16(a);
}
SEL_DI void top16_of_64(unsigned (&g0)[16], unsigned (&g1)[16], unsigned (&g2)[16], unsigned (&g3)[16]) {
  sort16(g0); sort16(g1); sort16(g2); sort16(g3);
  merge_top16(g0, g1); merge_top16(g2, g3); merge_top16(g0, g2);
}
SEL_DI unsigned cand_key(float a, float b, unsigned payload) {
  float s = a + b; s = s < 32.0f ? 32.0f : (s > 127.99f ? 127.99f : s);
  return ((SEL_F2U(s) << 8) & 0xFFFFC000u) | payload;
}
SEL_DI void stage2(const unsigned (&L1)[16], const unsigned (&L2)[16], unsigned (&R)[16]) {
  float f1[16], f2m[16]; unsigned P1[16], P2[16];
#pragma unroll
  for (int i = 0; i < 16; ++i) { f1[i] = SEL_U2F(L1[i] & ~127u); f2m[i] = SEL_U2F(L2[i] & ~127u) - 64.0f; P1[i] = (L1[i] & 127u) << 7; P2[i] = L2[i] & 127u; }
  unsigned K[64];
  K[0] = cand_key(f1[0], f2m[0], P1[0] | P2[0]);
  K[1] = cand_key(f1[0], f2m[1], P1[0] | P2[1]);
  K[2] = cand_key(f1[0], f2m[2], P1[0] | P2[2]);
  K[3] = cand_key(f1[0], f2m[3], P1[0] | P2[3]);
  K[4] = cand_key(f1[0], f2m[4], P1[0] | P2[4]);
  K[5] = cand_key(f1[0], f2m[5], P1[0] | P2[5]);
  K[6] = cand_key(f1[0], f2m[6], P1[0] | P2[6]);
  K[7] = cand_key(f1[0], f2m[7], P1[0] | P2[7]);
  K[8] = cand_key(f1[0], f2m[8], P1[0] | P2[8]);
  K[9] = cand_key(f1[0], f2m[9], P1[0] | P2[9]);
  K[10] = cand_key(f1[0], f2m[10], P1[0] | P2[10]);
  K[11] = cand_key(f1[0], f2m[11], P1[0] | P2[11]);
  K[12] = cand_key(f1[0], f2m[12], P1[0] | P2[12]);
  K[13] = cand_key(f1[0], f2m[13], P1[0] | P2[13]);
  K[14] = cand_key(f1[0], f2m[14], P1[0] | P2[14]);
  K[15] = cand_key(f1[0], f2m[15], P1[0] | P2[15]);
  K[16] = cand_key(f1[1], f2m[0], P1[1] | P2[0]);
  K[17] = cand_key(f1[1], f2m[1], P1[1] | P2[1]);
  K[18] = cand_key(f1[1], f2m[2], P1[1] | P2[2]);
  K[19] = cand_key(f1[1], f2m[3], P1[1] | P2[3]);
  K[20] = cand_key(f1[1], f2m[4], P1[1] | P2[4]);
  K[21] = cand_key(f1[1], f2m[5], P1[1] | P2[5]);
  K[22] = cand_key(f1[1], f2m[6], P1[1] | P2[6]);
  K[23] = cand_key(f1[1], f2m[7], P1[1] | P2[7]);
  K[24] = cand_key(f1[2], f2m[0], P1[2] | P2[0]);
  K[25] = cand_key(f1[2], f2m[1], P1[2] | P2[1]);
  K[26] = cand_key(f1[2], f2m[2], P1[2] | P2[2]);
  K[27] = cand_key(f1[2], f2m[3], P1[2] | P2[3]);
  K[28] = cand_key(f1[2], f2m[4], P1[2] | P2[4]);
  K[29] = cand_key(f1[3], f2m[0], P1[3] | P2[0]);
  K[30] = cand_key(f1[3], f2m[1], P1[3] | P2[1]);
  K[31] = cand_key(f1[3], f2m[2], P1[3] | P2[2]);
  K[32] = cand_key(f1[3], f2m[3], P1[3] | P2[3]);
  K[33] = cand_key(f1[4], f2m[0], P1[4] | P2[0]);
  K[34] = cand_key(f1[4], f2m[1], P1[4] | P2[1]);
  K[35] = cand_key(f1[4], f2m[2], P1[4] | P2[2]);
  K[36] = cand_key(f1[5], f2m[0], P1[5] | P2[0]);
  K[37] = cand_key(f1[5], f2m[1], P1[5] | P2[1]);
  K[38] = cand_key(f1[6], f2m[0], P1[6] | P2[0]);
  K[39] = cand_key(f1[6], f2m[1], P1[6] | P2[1]);
  K[40] = cand_key(f1[7], f2m[0], P1[7] | P2[0]);
  K[41] = cand_key(f1[7], f2m[1], P1[7] | P2[1]);
  K[42] = cand_key(f1[8], f2m[0], P1[8] | P2[0]);
  K[43] = cand_key(f1[9], f2m[0], P1[9] | P2[0]);
  K[44] = cand_key(f1[10], f2m[0], P1[10] | P2[0]);
  K[45] = cand_key(f1[11], f2m[0], P1[11] | P2[0]);
  K[46] = cand_key(f1[12], f2m[0], P1[12] | P2[0]);
  K[47] = cand_key(f1[13], f2m[0], P1[13] | P2[0]);
  K[48] = cand_key(f1[14], f2m[0], P1[14] | P2[0]);
  K[49] = cand_key(f1[15], f2m[0], P1[15] | P2[0]);
#pragma unroll
  for (int c = 50; c < 64; ++c) K[c] = 0u;
  unsigned g1[16], g2[16], g3[16];
#pragma unroll
  for (int i = 0; i < 16; ++i) { R[i] = K[i]; g1[i] = K[16 + i]; g2[i] = K[32 + i]; g3[i] = K[48 + i]; }
  sort16(R); sort16(g1); sort16(g2); CE(g3[0], g3[1]);
  merge_top16(R, g1);
  g2[15] = g2[15] > g3[0] ? g2[15] : g3[0]; g2[14] = g2[14] > g3[1] ? g2[14] : g3[1];
  bitonic_merge16(g2);
  merge_top16(R, g2);
}

constexpr int SKP = 272;
struct QFrag { bf16x8_t f[8]; };
DI QFrag stage1_load(const u16* __restrict__ qrow, int hh) { QFrag q;
#pragma unroll
  for (int ks = 0; ks < 8; ++ks) q.f[ks] = *(const bf16x8_t*)(qrow + 16 * ks + 8 * hh);
  return q; }
DI void stage1(const QFrag& qfr, const LAS unsigned char* sk, int tok, int hh, unsigned (&out)[16]) {
  f32x16_t acc[4];
#pragma unroll
  for (int kt = 0; kt < 4; ++kt)
#pragma unroll
    for (int r = 0; r < 16; ++r) acc[kt][r] = 64.0f;
#pragma unroll
  for (int ks = 0; ks < 8; ++ks) {
#pragma unroll
    for (int kt = 0; kt < 4; ++kt) {
      const bf16x8_t ak = *(const LAS bf16x8_t*)(sk + (32 * kt + tok) * SKP + (16 * ks + 8 * hh) * 2);
      acc[kt] = __builtin_amdgcn_mfma_f32_32x32x16_bf16(ak, qfr.f[ks], acc[kt], 0, 0, 0);
    }
    __builtin_amdgcn_sched_barrier(0);
  }
  unsigned g1[16], g2[16], g3[16];
#pragma unroll
  for (int r = 0; r < 16; ++r) {
    const unsigned ix = (unsigned)((r & 3) + 8 * (r >> 2));
    out[r] = (__float_as_uint(acc[0][r]) & ~127u) | ix; g1[r] = (__float_as_uint(acc[1][r]) & ~127u) | (32u + ix);
    g2[r] = (__float_as_uint(acc[2][r]) & ~127u) | (64u + ix); g3[r] = (__float_as_uint(acc[3][r]) & ~127u) | (96u + ix);
  }
  top16_of_64(out, g1, g2, g3);
  unsigned oth[16];
#pragma unroll
  for (int i = 0; i < 16; ++i) { out[i] |= (unsigned)(hh << 2); }
#pragma unroll
  for (int i = 0; i < 16; ++i) oth[i] = (unsigned)__shfl_xor((int)out[i], 32);
  merge_top16(out, oth);
}
DI void topk_phase(const Params& p, const u16* __restrict__ qp, const float* __restrict__ uinv, int* __restrict__ idx_out, float2* __restrict__ gu_out, unsigned char* smem) {
  const int tid = threadIdx.x;
  LAS unsigned char* sk = (LAS unsigned char*)smem;
  __syncthreads();
#pragma unroll
  for (int i = tid; i < 2 * 128 * 16; i += NTHREADS) {
    const int c = i & 15, row = i >> 4;
    const float4* s = (const float4*)(p.sub_keys + (size_t)row * 128 + c * 8);
    const float4 a = s[0], b = s[1];
    pg8::u32x4 o; o.x = pack2(a.x, a.y); o.y = pack2(a.z, a.w); o.z = pack2(b.x, b.y); o.w = pack2(b.z, b.w);
    *(LAS pg8::u32x4*)(sk + row * SKP + c * 16) = o;
  }
  __syncthreads();
  const int lane = tid & 63, tok = lane & 31, hh = lane >> 5, gw = blockIdx.x * NWAVES + (tid >> 6), nw = gridDim.x * NWAVES;
  for (int item = gw; item < (T / 32) * 4; item += nw) {
    const int t = (item >> 2) * 32 + tok, hp = item & 3;
    const u16* qt = qp + (size_t)t * 2048 + hp * 512;
    unsigned LA1[16], LA2[16], LB1[16], LB2[16];
    { QFrag fa = stage1_load(qt, hh), fb = stage1_load(qt + 128, hh);
      stage1(fa, sk, tok, hh, LA1); fa = stage1_load(qt + 256, hh);
      stage1(fb, sk + 128 * SKP, tok, hh, LA2); fb = stage1_load(qt + 384, hh);
      stage1(fa, sk, tok, hh, LB1);
      stage1(fb, sk + 128 * SKP, tok, hh, LB2); }
    unsigned L1[16], L2[16], R[16];
#pragma unroll
    for (int i = 0; i < 16; ++i) { L1[i] = hh ? LB1[i] : LA1[i]; L2[i] = hh ? LB2[i] : LA2[i]; }
    stage2(L1, L2, R);
    const int head = hp * 2 + hh;
    float ev[16], sum = 0.f;
    const float mx = __uint_as_float(0x42000000u | ((R[0] >> 14) << 6));
#pragma unroll
    for (int k = 0; k < 16; ++k) { ev[k] = __expf(__uint_as_float(0x42000000u | ((R[k] >> 14) << 6)) - mx); sum += ev[k]; }
    const float rs = 1.f / sum;
    int* io = idx_out + (size_t)t * 128 + head * 16; float2* go = gu_out + (size_t)t * 128 + head * 16;
#pragma unroll
    for (int k4 = 0; k4 < 4; ++k4) {
      int4 ex; ex.x = (int)(R[4 * k4] & 0x3FFFu); ex.y = (int)(R[4 * k4 + 1] & 0x3FFFu); ex.z = (int)(R[4 * k4 + 2] & 0x3FFFu); ex.w = (int)(R[4 * k4 + 3] & 0x3FFFu);
      ((int4*)io)[k4] = ex;
      float4 ga, gb; ga.x = ev[4 * k4] * rs; ga.y = uinv[ex.x]; ga.z = ev[4 * k4 + 1] * rs; ga.w = uinv[ex.y];
      gb.x = ev[4 * k4 + 2] * rs; gb.y = uinv[ex.z]; gb.z = ev[4 * k4 + 3] * rs; gb.w = uinv[ex.w];
      ((float4*)go)[2 * k4] = ga; ((float4*)go)[2 * k4 + 1] = gb;
    }
  }
}

typedef float f32x4_t __attribute__((ext_vector_type(4)));
typedef float f32x2_t __attribute__((ext_vector_type(2)));
typedef int i32x8_t __attribute__((ext_vector_type(8)));
constexpr int UIP = 132;
constexpr int UGP = 1032;
struct UBuf { uint4 r0, r1, r2, r3; unsigned e; float vi; };
#define U_LOAD(buf, g) do { const unsigned _e = myi[(g)]; const unsigned char* _r = U4 + (size_t)_e * 512 + xoff; \
    buf.r0 = *(const uint4*)(_r); buf.r1 = *(const uint4*)(_r + 128); buf.r2 = *(const uint4*)(_r + 256); buf.r3 = *(const uint4*)(_r + 384); \
    buf.e = _e; buf.vi = vinv[_e]; } while (0)
#define U_MMA(c, r, b) c = __builtin_amdgcn_mfma_scale_f32_16x16x128_f8f6f4((i32x8_t){(int)(r).x, (int)(r).y, (int)(r).z, (int)(r).w, 0, 0, 0, 0}, b, c, 4, 0, 0, 0x7F7F7F7F, 0, 0x7F7F7F7F)
#define U_COMP(buf, g) do { f32x4_t c = {0.f, 0.f, 0.f, 0.f}; \
    U_MMA(c, buf.r0, B0); U_MMA(c, buf.r1, B1); U_MMA(c, buf.r2, B2); U_MMA(c, buf.r3, B3); \
    const int rsel = pp & 3; const float v = rsel == 0 ? c[0] : rsel == 1 ? c[1] : rsel == 2 ? c[2] : c[3]; \
    const float vo = __shfl(v, (lane + 40) & 63); \
    if (pp < 8 && q == (pp >> 2)) { const f32x2_t gu2 = *(const LAS f32x2_t*)(myg + (g) * 8); \
      const float d = (v + vo) * gu2[1]; const float act = 0.5f * d * (1.f + erff(d * 0.70710678118654752f)); \
      uint2 o; o.x = buf.e; o.y = __float_as_uint(gu2[0] * act * buf.vi); pw[(size_t)tok * 128 + (g)] = o; } } while (0)
DI void peer_u_phase(const u16* __restrict__ xb, const float* __restrict__ rowss, const int* __restrict__ idx, const float2* __restrict__ gu,
                     const unsigned char* __restrict__ U4, const float* __restrict__ vinv, uint2* __restrict__ pw, unsigned char* smem) {
  const int lane = threadIdx.x & 63, wave = threadIdx.x >> 6, pp = lane & 15, q = lane >> 4, gw = blockIdx.x * NWAVES + wave, nw = gridDim.x * NWAVES;
  const int pi = pp & 7, x = q + 4 * (pp >> 3);
  const unsigned xoff = 16u * x;
  LAS unsigned* idl = (LAS unsigned*)(smem + wave * (8 * UIP * 4 + 8 * UGP));
  LAS unsigned char* gul = (LAS unsigned char*)(idl + 8 * UIP);
  const LAS unsigned* myi = idl + pi * UIP;
  const LAS unsigned char* myg = gul + pi * UGP;
  for (int unit = gw; unit < T / 8; unit += nw) {
    const int tok = unit * 8 + pi;
    __builtin_amdgcn_wave_barrier();
#pragma unroll
    for (int r8 = 0; r8 < 8; ++r8) {
      const int* ir = idx + (size_t)(unit * 8 + r8) * 128;
      idl[r8 * UIP + lane] = (unsigned)ir[lane]; idl[r8 * UIP + 64 + lane] = (unsigned)ir[64 + lane];
      const uint4 gv = ((const uint4*)(gu + (size_t)(unit * 8 + r8) * 128))[lane];
      pg8::u32x4 o; o.x = gv.x; o.y = gv.y; o.z = gv.z; o.w = gv.w; *(LAS pg8::u32x4*)(gul + r8 * UGP + lane * 16) = o;
    }
    __builtin_amdgcn_fence(__ATOMIC_RELEASE, "wavefront");
    __builtin_amdgcn_wave_barrier();
    const float inv = rsqrtf(rowss[tok] * (1.f / D) + EPS);
    i32x8_t B0, B1, B2, B3;
#define U_BUILD(Bv, i) do { const u16* sb = xb + (size_t)tok * D + 256 * (i) + 128 * (pp >> 3) + 16 * q; \
      _Pragma("unroll") for (int h = 0; h < 4; ++h) { float f[8]; unpack8(*(const uint4*)(sb + 64 * (h >> 1) + 8 * (h & 1)), f); int w; \
        w = __builtin_amdgcn_cvt_pk_fp8_f32(f[0] * inv, f[1] * inv, 0, false); w = __builtin_amdgcn_cvt_pk_fp8_f32(f[2] * inv, f[3] * inv, w, true); Bv[2 * h] = w; \
        w = __builtin_amdgcn_cvt_pk_fp8_f32(f[4] * inv, f[5] * inv, 0, false); w = __builtin_amdgcn_cvt_pk_fp8_f32(f[6] * inv, f[7] * inv, w, true); Bv[2 * h + 1] = w; } } while (0)
    U_BUILD(B0, 0); U_BUILD(B1, 1); U_BUILD(B2, 2); U_BUILD(B3, 3);
    UBuf b0, b1, b2, b3;
#define SB() __builtin_amdgcn_sched_barrier(0)
    U_LOAD(b0, 0); U_LOAD(b1, 1); U_LOAD(b2, 2); SB();
#pragma unroll 1
    for (int g = 0; g < 128; g += 4) {
      U_LOAD(b3, g + 3); SB(); U_COMP(b0, g); SB();
      U_LOAD(b0, (g + 4) & 127); SB(); U_COMP(b1, g + 1); SB();
      U_LOAD(b1, (g + 5) & 127); SB(); U_COMP(b2, g + 2); SB();
      U_LOAD(b2, (g + 6) & 127); SB(); U_COMP(b3, g + 3); SB();
    }
  }
}

typedef int i32x2_t __attribute__((ext_vector_type(2)));
DI void peer_v_phase(const uint2* __restrict__ pw, const unsigned char* __restrict__ V4, const u16* __restrict__ xb, float* __restrict__ out, unsigned char* smem) {
  const int lane = threadIdx.x & 63, wave = threadIdx.x >> 6, r = lane >> 3, c = lane & 7, n16 = lane & 15, kg = lane >> 4;
  LAS unsigned char* img = (LAS unsigned char*)smem + wave * VWAVE;
  LAS unsigned char* pbuf = img + 128 * VIMP;
  const int nunit = 4 * (T / 64);
  const int cnt = ((int)blockIdx.x < nunit) ? (nunit - 1 - (int)blockIdx.x) / (int)gridDim.x + 1 : 0, N = cnt * 8;
  if (N == 0) return;
#define V_TOK(n, jj, tt) do { const int _u = (int)blockIdx.x + ((n) >> 3) * (int)gridDim.x; jj = _u & 3; tt = (_u >> 2) * 64 + wave * 8 + ((n) & 7); } while (0)
#define V_LDPW(n) ({ int _j, _t; V_TOK(n, _j, _t); ((const uint4*)(pw + (size_t)_t * 128))[lane]; })
#define V_STAGE(n, pq, scv) do { LAS unsigned char* _b = pbuf + ((n) & 1) * 1024; \
    *(LAS i32x2_t*)(_b + 8 * lane) = (i32x2_t){(int)(pq).x, (int)(pq).z}; *(LAS i32x2_t*)(_b + 512 + 8 * lane) = (i32x2_t){(int)(pq).y, (int)(pq).w}; \
    const float _m = wave_max(fmaxf(fabsf(__uint_as_float((pq).y)), fabsf(__uint_as_float((pq).w)))); scv = _m > 0.f ? 224.f / _m : 1.f; } while (0)
#define V_GATHER(n) do { int _j, _t; V_TOK(n, _j, _t); const unsigned char* _vb = V4 + (size_t)_j * ((size_t)NEXP * 128) + 16 * c; const LAS unsigned* _e = (const LAS unsigned*)(pbuf + ((n) & 1) * 1024); \
    _Pragma("unroll") for (int i = 0; i < 16; ++i) G[i] = *(const uint4*)(_vb + (_e[8 * i + r] * 128u)); } while (0)
#define V_WRITEIMG() do { _Pragma("unroll") for (int i = 0; i < 16; ++i) { LAS unsigned char* _d = img + (8 * i + r) * VIMP + 16 * c; \
      *(LAS i32x2_t*)(_d) = (i32x2_t){(int)G[i].x, (int)G[i].y}; *(LAS i32x2_t*)(_d + 8) = (i32x2_t){(int)G[i].z, (int)G[i].w}; } } while (0)
  uint4 G[16];
  uint4 pq = V_LDPW(0);
  float sc_cur, sc_nxt;
  V_STAGE(0, pq, sc_cur); asm volatile("s_waitcnt lgkmcnt(0)" ::: "memory");
  if (N > 1) pq = V_LDPW(1);
  V_GATHER(0);
  V_WRITEIMG(); asm volatile("s_waitcnt lgkmcnt(0)" ::: "memory");
  for (int n = 0; n < N; ++n) {
    if (n + 1 < N) { V_STAGE(n + 1, pq, sc_nxt); asm volatile("s_waitcnt lgkmcnt(0)" ::: "memory"); if (n + 2 < N) pq = V_LDPW(n + 2); V_GATHER(n + 1); }
    __builtin_amdgcn_sched_barrier(0);
    int j, t; V_TOK(n, j, t);
    i32x8_t A;
    { const LAS float* wl = (const LAS float*)(pbuf + (n & 1) * 1024 + 512);
#pragma unroll
      for (int h = 0; h < 2; ++h)
#pragma unroll
        for (int d = 0; d < 4; ++d) { const f32x4_t w4 = *(const LAS f32x4_t*)(wl + 64 * h + 16 * kg + 4 * d);
          int w = __builtin_amdgcn_cvt_pk_fp8_f32(w4[0] * sc_cur, w4[1] * sc_cur, 0, false); w = __builtin_amdgcn_cvt_pk_fp8_f32(w4[2] * sc_cur, w4[3] * sc_cur, w, true);
          A[4 * h + d] = n16 == 0 ? w : 0; } }
    float val[16];
    const LAS unsigned char* ib = img + (32 * kg + n16) * VIMP;
#pragma unroll
    for (int ct = 0; ct < 16; ++ct) {
      const i32x2_t b0 = __builtin_amdgcn_ds_read_tr4_b64_v2i32((LAS i32x2_t*)(ib + 8 * ct)), b1 = __builtin_amdgcn_ds_read_tr4_b64_v2i32((LAS i32x2_t*)(ib + 16 * VIMP + 8 * ct));
      const f32x4_t z = {0.f, 0.f, 0.f, 0.f};
      const f32x4_t cc = __builtin_amdgcn_mfma_scale_f32_16x16x128_f8f6f4(A, (i32x8_t){b0[0], b0[1], b1[0], b1[1], 0, 0, 0, 0}, z, 0, 4, 0, 0x7F7F7F7F, 0, 0x7F7F7F7F);
      val[ct] = cc[0];
      asm volatile("" : "+v"(val[ct]));
    }
    LAS float* stg = (LAS float*)(pbuf + (n & 1) * 1024);
    if (lane < 16) {
#pragma unroll
      for (int ct = 0; ct < 16; ++ct) stg[16 * ct + lane] = val[ct];
    }
    asm volatile("s_waitcnt lgkmcnt(0)" ::: "memory");
    const f32x4_t s4 = *(const LAS f32x4_t*)(stg + 4 * lane);
    const float rs = 1.f / sc_cur;
    const uint2 xr = *(const uint2*)(xb + (size_t)t * D + 256 * j + 4 * lane);
    float4 o;
    o.x = bflo(xr.x) + s4[0] * rs; o.y = bfhi(xr.x) + s4[1] * rs; o.z = bflo(xr.y) + s4[2] * rs; o.w = bfhi(xr.y) + s4[3] * rs;
    *(float4*)(out + (size_t)t * D + 256 * j + 4 * lane) = o;
    __builtin_amdgcn_sched_barrier(0);
    asm volatile("s_waitcnt lgkmcnt(0)" ::: "memory");
    if (n + 1 < N) { V_WRITEIMG(); sc_cur = sc_nxt; }
    asm volatile("s_waitcnt lgkmcnt(0)" ::: "memory");
  }
}

constexpr int NPHASE = 8;
__global__ void __launch_bounds__(NTHREADS, 2) fwd_kernel(Params p) {
  extern __shared__ __attribute__((aligned(16))) unsigned char smem[];
  cg::grid_group grid = cg::this_grid();
  unsigned char* ws = p.ws;
  u16* wt_in = (u16*)(ws + WS_WTIN); u16* wt_out = (u16*)(ws + WS_WTOUT); u16* wt_q = (u16*)(ws + WS_WTQ);
  u16* act = (u16*)(ws + WS_ACT); u16* proj = (u16*)(ws + WS_PROJ);
  int* idx = (int*)(ws + WS_IDX); float2* gu = (float2*)(ws + WS_SB); unsigned char* U8 = ws + WS_U8; unsigned char* V8 = ws + WS_V8;
  uint2* pw = (uint2*)(ws + WS_PW); float* uinv = (float*)(ws + WS_UINV); float* vinv = (float*)(ws + WS_VINV);
  float* rowss = (float*)(ws + WS_ROWSS);
  volatile LAS unsigned* misc = (volatile LAS unsigned*)(LAS unsigned char*)(smem + LDS_MISC);
  if (threadIdx.x < 8) misc[threadIdx.x] = 0u;
  __syncthreads();
  XcdBarrier bar = xcd_barrier_post((unsigned*)(ws + WS_CTL), misc);
  PG8_LAS unsigned char* lds = (PG8_LAS unsigned char*)smem;
  const int lo = p.ph_lo, hi = p.ph_hi;
#define IN(k) (lo <= (k) && (k) < hi)
#define SEAM(k) do { if (IN(k) && IN((k) + 1)) xcd_barrier(bar); } while (0)
  if (IN(0)) {
    transpose_convert(p.w_in, wt_in, D, DIN, nullptr, (float*)smem);
    transpose_convert(p.w_out, wt_out, D, D, nullptr, (float*)smem);
    transpose_convert(p.w_q, wt_q, D, 2048, p.norm2_g, (float*)smem);
    convert_fp4_rows<false>(p.peer_u, p.norm2_g, U8, uinv);
    convert_fp4_rows<true>(p.peer_v, nullptr, V8, vinv);
    rmsnorm1024(p.x, p.norm1_g, act);
    for (int i = blockIdx.x * NTHREADS + threadIdx.x; i < T; i += gridDim.x * NTHREADS) rowss[i] = 0.f;
    for (int i = blockIdx.x * NTHREADS + threadIdx.x; i < 2 * 32 * SEQ; i += gridDim.x * NTHREADS) ((float*)(ws + WS_SB + 16 * MBy))[i] = 0.f;
  }
  if (lo < 0) grid.sync();
  SEAM(0);
  u16* vt = (u16*)(ws + WS_SB);
  float* ssq = (float*)(ws + WS_SB + 16 * MBy);
  if (IN(1)) { pg8::Gemm g{act, wt_in, T, DIN, D}; pg8::StaticOrder S; S.init(T, DIN, gridDim.x, blockIdx.x);
    pg8::EpiInProj E{proj, vt, ssq}; pg8::gemm_phase<pg8::EpiInProj, pg8::StaticOrder>(lds, g, S, E, nullptr); }
  SEAM(1);
  if (IN(2)) { attn_phase(p, proj, vt, ssq, act, smem); conv_tokens(p, proj, act); }
  SEAM(2);
  if (IN(3)) { pg8::Gemm g{act, wt_out, T, D, D}; pg8::StaticOrder S; S.init(T, D, gridDim.x, blockIdx.x);
    pg8::EpiResid E{p.x, p.out, proj, rowss, D}; pg8::gemm_phase<pg8::EpiResid, pg8::StaticOrder>(lds, g, S, E, nullptr); }
  SEAM(3);
  u16* xb = proj;
  u16* qp = proj + (size_t)T * D;
  if (IN(4)) { pg8::Gemm g{xb, wt_q, T, 2048, D}; pg8::StaticOrder S; S.init(T, 2048, gridDim.x, blockIdx.x);
    pg8::EpiBf16S E{qp, 2048, rowss}; pg8::gemm_phase<pg8::EpiBf16S, pg8::StaticOrder>(lds, g, S, E, nullptr); }
  SEAM(4);
  if (IN(5)) topk_phase(p, qp, uinv, idx, gu, smem);
  SEAM(5);
  if (IN(6)) peer_u_phase(xb, rowss, idx, gu, U8, vinv, pw, smem);
  SEAM(6);
  if (IN(7)) peer_v_phase(pw, V8, xb, p.out, smem);
}

extern "C" void kernel_launch(void* const* d_in, const int* in_sizes, int n_in, void* d_out, int out_size, void* d_ws, size_t ws_size,
                              hipStream_t stream) {
  static int grid_blocks = 0;
  if (!grid_blocks) {
    int dev = 0, cus = 0, per_cu = 0;
    (void)hipGetDevice(&dev);
    (void)hipDeviceGetAttribute(&cus, hipDeviceAttributeMultiprocessorCount, dev);
    (void)hipFuncSetAttribute((const void*)fwd_kernel, hipFuncAttributeMaxDynamicSharedMemorySize, LDS_BYTES);
    (void)hipOccupancyMaxActiveBlocksPerMultiprocessor(&per_cu, fwd_kernel, NTHREADS, LDS_BYTES);
    if (per_cu < 1) per_cu = 1;
    if (per_cu > 1) per_cu = 1;
    grid_blocks = cus * per_cu;
  }
  Params p{};
  p.x = (const float*)d_in[0]; p.norm1_g = (const float*)d_in[1]; p.w_in = (const float*)d_in[2]; p.q_norm_g = (const float*)d_in[3];
  p.k_norm_g = (const float*)d_in[4]; p.conv_w = (const float*)d_in[5]; p.sb_out_g = (const float*)d_in[6]; p.conv_out_g = (const float*)d_in[7];
  p.w_out = (const float*)d_in[8]; p.norm2_g = (const float*)d_in[9]; p.w_q = (const float*)d_in[10]; p.sub_keys = (const float*)d_in[11];
  p.peer_u = (const float*)d_in[12]; p.peer_v = (const float*)d_in[13];
  p.out = (float*)d_out; p.ws = (unsigned char*)d_ws;
  p.ph_lo = 0; p.ph_hi = NPHASE;
  (void)hipMemsetAsync((unsigned char*)d_ws + WS_CTL, 0, 4096 * 4 + 8 * 64 * 4, stream);
  void* args[] = {&p};
  hipError_t e = hipLaunchCooperativeKernel((void*)fwd_kernel, dim3(grid_blocks), dim3(NTHREADS), args, LDS_BYTES, stream);
  if (e != hipSuccess) fprintf(stderr, "cooperative launch failed: %s (grid %d)\n", hipGetErrorString(e), grid_blocks);
}
```

```cpp
#include <hip/hip_runtime.h>
#include <hip/hip_cooperative_groups.h>
#include <cstdio>
#include <cstdint>
namespace cg = cooperative_groups;

typedef unsigned short u16;
#define DI __device__ __forceinline__
#define LAS __attribute__((address_space(3)))

constexpr int T = 16384, D = 1024, SEQ = 4096;
constexpr int DIN = 3072, DSB = 512;
constexpr int NEXP = 16384;
constexpr float EPS = 1e-6f;
constexpr int NWAVES = 8, NTHREADS = NWAVES * 64;

namespace pg8 {
#define PG8_LAS __attribute__((address_space(3)))
typedef unsigned short bf16_t;
typedef short bf16x8 __attribute__((ext_vector_type(8)));
typedef float f32x4 __attribute__((ext_vector_type(4)));
typedef unsigned u32x4 __attribute__((ext_vector_type(4)));
constexpr int BM = 256, BK = 64, HALF = 128, HTB = HALF * BK * 2  , STAGE_BYTES = 8 * HTB, NXCD = 8, WGM = 8;

__host__ __device__ __forceinline__ int lds_byte(int r, int c) { const int st = (r >> 4) * 2 + (c >> 5), rr = r & 15, cc = c & 31, ob = rr * 64 + cc * 2; return st * 1024 + (ob ^ (((ob >> 9) & 1) << 5)); }
__host__ __device__ __forceinline__ void stage_rc(int b, int& R, int& C) { const int st = b / 1024, sb = b % 1024, swz = sb ^ (((sb >> 9) & 1) << 5); R = (st >> 1) * 16 + swz / 64; C = (st & 1) * 32 + (swz % 64) / 2; }
__host__ __device__ __forceinline__ int perm32(int rho) { const int n = rho >> 4, i = rho & 15; return 8 * (i >> 2) + 4 * n + (i & 3); }

struct Unit { int pm, pn; };
struct Gemm { const bf16_t* A; const bf16_t* Bt; int M, N, K; };
struct StaticOrder {
    int nM, nN, nwg, G, c;
    __host__ __device__ void init(int M, int N, int G_, int c_) { nM = M / BM; nN = N / BM; nwg = nM * nN; G = G_; c = c_; }
    __host__ __device__ bool next(int i, Unit& u) const {
        const long L = (long)i * G + c; if (L >= nwg) return false;
        int wgid = (int)L; { const int q = nwg / NXCD, r = nwg % NXCD, xcd = wgid % NXCD, off = wgid / NXCD; wgid = (xcd < r ? xcd * (q + 1) : r * (q + 1) + (xcd - r) * q) + off; }
        const int nig = WGM * nN, gid = wgid / nig, fm = gid * WGM, gsz = (nM - fm) < WGM ? (nM - fm) : WGM;
        u.pm = fm + ((wgid % nig) % gsz); u.pn = (wgid % nig) / gsz; return true;
    }
    __device__ __forceinline__ void a_ready(const Unit&) const {}
    __device__ __forceinline__ void done(const Unit&) const {}
};
__device__ __forceinline__ unsigned cvt_pk_bf16(float lo, float hi) { unsigned r; asm volatile("v_cvt_pk_bf16_f32 %0, %1, %2" : "=v"(r) : "v"(lo), "v"(hi)); return r; }

struct EpiBf16S {
    static constexpr bool PERM = true, AFTER_DRAIN = false;
    bf16_t* O; int ldc; const float* rowss;
    __device__ __forceinline__ void operator()(const f32x4 (&acc)[2][2][4][2], const Unit& u, int wr, int wc, int fr, int fq) const {
        const int row0 = u.pm * BM + wr * 64 + fr, col0 = u.pn * BM + wc * 32 + 8 * fq;
#pragma unroll
        for (int ai = 0; ai < 2; ++ai)
#pragma unroll
            for (int m = 0; m < 4; ++m) { const int row = row0 + ai * HALF + m * 16; bf16_t* rowp = O + (size_t)row * ldc + col0;
                const float sc = rowss ? rsqrtf(rowss[row] * (1.f / 1024.f) + 1e-6f) : 1.f;
#pragma unroll
                for (int bj = 0; bj < 2; ++bj) { const f32x4 v0 = acc[ai][bj][m][0] * sc, v1 = acc[ai][bj][m][1] * sc;
                    u32x4 w; w.x = cvt_pk_bf16(v0[0], v0[1]); w.y = cvt_pk_bf16(v0[2], v0[3]); w.z = cvt_pk_bf16(v1[0], v1[1]); w.w = cvt_pk_bf16(v1[2], v1[3]);
                    *(u32x4*)(rowp + bj * HALF) = w; } }
    }
};
struct EpiInProj {
    static constexpr bool PERM = true, AFTER_DRAIN = false;
    bf16_t* O; bf16_t* vt; float* ssq;
    __device__ __forceinline__ void operator()(const f32x4 (&acc)[2][2][4][2], const Unit& u, int wr, int wc, int fr, int fq) const {
        const int row0 = u.pm * BM + wr * 64 + fr, col0 = u.pn * BM + wc * 32 + 8 * fq, kind = u.pn >> 1;
#pragma unroll
        for (int ai = 0; ai < 2; ++ai)
#pragma unroll
            for (int m = 0; m < 4; ++m) { const int row = row0 + ai * HALF + m * 16; const int bb = row >> 12, ss = row & 4095;
#pragma unroll
                for (int bj = 0; bj < 2; ++bj) { const f32x4 v0 = acc[ai][bj][m][0], v1 = acc[ai][bj][m][1];
                    if (kind != 2) {
                        u32x4 w; w.x = cvt_pk_bf16(v0[0], v0[1]); w.y = cvt_pk_bf16(v0[2], v0[3]); w.z = cvt_pk_bf16(v1[0], v1[1]); w.w = cvt_pk_bf16(v1[2], v1[3]);
                        *(u32x4*)(O + (size_t)row * 3072 + col0 + bj * HALF) = w;
                        if (kind < 2) {
                            float sq = v0[0] * v0[0] + v0[1] * v0[1] + v0[2] * v0[2] + v0[3] * v0[3] + v1[0] * v1[0] + v1[1] * v1[1] + v1[2] * v1[2] + v1[3] * v1[3];
                            sq += __shfl_xor(sq, 16); sq += __shfl_xor(sq, 32);
                            const int head = (u.pn & 1) * 4 + bj * 2 + (wc >> 1);
                            if (fq == 0) unsafeAtomicAdd(ssq + ((size_t)(kind * 32 + bb * 8 + head)) * 4096 + ss, sq);
                        }
                    } else {
                        const int d0 = (u.pn & 1) * 256 + bj * HALF + wc * 32 + 8 * fq;
                        bf16_t* vp = vt + ((size_t)(bb * 512 + d0)) * 4096 + ss;
                        const unsigned w0 = cvt_pk_bf16(v0[0], v0[1]), w1 = cvt_pk_bf16(v0[2], v0[3]), w2 = cvt_pk_bf16(v1[0], v1[1]), w3 = cvt_pk_bf16(v1[2], v1[3]);
                        vp[0] = (bf16_t)w0; vp[4096] = (bf16_t)(w0 >> 16); vp[2 * 4096] = (bf16_t)w1; vp[3 * 4096] = (bf16_t)(w1 >> 16);
                        vp[4 * 4096] = (bf16_t)w2; vp[5 * 4096] = (bf16_t)(w2 >> 16); vp[6 * 4096] = (bf16_t)w3; vp[7 * 4096] = (bf16_t)(w3 >> 16);
                    } } }
    }
};
struct EpiResid {
    static constexpr bool PERM = true, AFTER_DRAIN = false;
    const float* resid; float* out32; bf16_t* xb; float* rowss; int ldc;
    __device__ __forceinline__ void operator()(const f32x4 (&acc)[2][2][4][2], const Unit& u, int wr, int wc, int fr, int fq) const {
        const int row0 = u.pm * BM + wr * 64 + fr, col0 = u.pn * BM + wc * 32 + 8 * fq;
#pragma unroll
        for (int ai = 0; ai < 2; ++ai)
#pragma unroll
            for (int m = 0; m < 4; ++m) { const int row = row0 + ai * HALF + m * 16; const size_t off = (size_t)row * ldc + col0; float ss = 0.f;
#pragma unroll
                for (int bj = 0; bj < 2; ++bj) {
                    const f32x4 r0 = *(const f32x4*)(resid + off + bj * HALF), r1 = *(const f32x4*)(resid + off + bj * HALF + 4);
                    const f32x4 o0 = r0 + acc[ai][bj][m][0], o1 = r1 + acc[ai][bj][m][1];
                    ss += o0[0] * o0[0] + o0[1] * o0[1] + o0[2] * o0[2] + o0[3] * o0[3] + o1[0] * o1[0] + o1[1] * o1[1] + o1[2] * o1[2] + o1[3] * o1[3];
                    u32x4 w; w.x = cvt_pk_bf16(o0[0], o0[1]); w.y = cvt_pk_bf16(o0[2], o0[3]); w.z = cvt_pk_bf16(o1[0], o1[1]); w.w = cvt_pk_bf16(o1[2], o1[3]);
                    *(u32x4*)(xb + off + bj * HALF) = w; }
                ss += __shfl_xor(ss, 16); ss += __shfl_xor(ss, 32);
                if (fq == 0) unsafeAtomicAdd(rowss + row, ss); }
    }
};
template <class Epi, class Sched, bool STAMP = false>
__device__ __forceinline__ void gemm_phase(PG8_LAS unsigned char* lds, const Gemm g, const Sched& S, const Epi& E, unsigned long long* stamps) {
    const int tid = threadIdx.x, wid = __builtin_amdgcn_readfirstlane(tid >> 6), lane = tid & 63, wr = wid >> 2, wc = wid & 3, fr = lane & 15, fq = lane >> 4;
    const int K = g.K, nt = K / BK;
    int ts_lo = 0, ts_hi = 0, nts = 0; const unsigned long long rt_entry = STAMP ? (unsigned long long)wall_clock64() : 0ull;
#define PG8_STAMP() do { if (STAMP && wid == 0 && nts < 64) { const unsigned long long _c = (unsigned long long)clock64(); \
        ts_lo = (lane == nts) ? (int)(unsigned)_c : ts_lo; ts_hi = (lane == nts) ? (int)(unsigned)(_c >> 32) : ts_hi; ++nts; } } while (0)
    PG8_STAMP();
    unsigned voffA[2], voffB[2];
#pragma unroll
    for (int i = 0; i < 2; ++i) { int R, C; stage_rc(tid * 16 + i * 8192, R, C); const int Rb = Epi::PERM ? ((R & ~31) + perm32(R & 31)) : R;
        voffA[i] = (unsigned)(R * K + C) * 2u; voffB[i] = (unsigned)(Rb * K + C) * 2u; }
    const size_t kstep = (size_t)(BK * 2);
    const size_t hstep = (size_t)HALF * K * 2;
    const size_t tstep = 2 * hstep;
    const unsigned ldsw = (unsigned)wid * 1024u;
    const int aoff = lds_byte(wr * 64 + fr, fq * 8), boff = lds_byte(wc * 32 + fr, fq * 8);
#define PG8_SA(b, h) (((b) * 2 + (h)) * HTB)
#define PG8_SB(b, h) ((4 + (b) * 2 + (h)) * HTB)
#define PG8_STAGE(bufoff, gbase, voff) do { _Pragma("unroll") for (int _i = 0; _i < 2; ++_i) \
        __builtin_amdgcn_global_load_lds((const unsigned*)((const char*)(gbase) + (voff)[_i]), (PG8_LAS unsigned*)(lds + (bufoff) + ldsw + _i * 8192), 16, 0, 0); } while (0)
#define PG8_LDA(dst, b, h) do { _Pragma("unroll") for (int m = 0; m < 4; ++m) _Pragma("unroll") for (int k = 0; k < 2; ++k) dst[m][k] = *(const PG8_LAS bf16x8*)(lds + PG8_SA(b, h) + aoff + m * 2048 + k * 1024); } while (0)
#define PG8_LDB(dst, b, h) do { _Pragma("unroll") for (int n = 0; n < 2; ++n) _Pragma("unroll") for (int k = 0; k < 2; ++k) dst[n][k] = *(const PG8_LAS bf16x8*)(lds + PG8_SB(b, h) + boff + n * 2048 + k * 1024); } while (0)
#define PG8_MMA(ai, bj, At, Bt) do { __builtin_amdgcn_s_setprio(1); _Pragma("unroll") for (int m = 0; m < 4; ++m) _Pragma("unroll") for (int n = 0; n < 2; ++n) _Pragma("unroll") for (int k = 0; k < 2; ++k) \
        acc[ai][bj][m][n] = __builtin_amdgcn_mfma_f32_16x16x32_bf16(Bt[n][k], At[m][k], acc[ai][bj][m][n], 0, 0, 0); __builtin_amdgcn_s_setprio(0); } while (0)
#define PG8_WAIT_V(n) asm volatile("s_waitcnt vmcnt(" #n ")" ::: "memory")
#define PG8_WAIT_L(n) asm volatile("s_waitcnt lgkmcnt(" #n ")" ::: "memory")
#define PG8_BAR __builtin_amdgcn_s_barrier()
#define PG8_SCHED __builtin_amdgcn_sched_barrier(0)
    Unit cur, nxt; int ui = 0;
    if (!S.next(0, cur)) return;
    f32x4 acc[2][2][4][2];
#pragma unroll
    for (int a = 0; a < 2; ++a)
#pragma unroll
        for (int b = 0; b < 2; ++b)
#pragma unroll
            for (int m = 0; m < 4; ++m)
#pragma unroll
                for (int n = 0; n < 2; ++n) acc[a][b][m][n] = (f32x4){0.f, 0.f, 0.f, 0.f};
    bf16x8 At[4][2], B0[2][2], B1[2][2];
    const char* cA = (const char*)g.A + (size_t)cur.pm * tstep; const char* cB = (const char*)g.Bt + (size_t)cur.pn * tstep;
    S.a_ready(cur);
    PG8_STAGE(PG8_SB(0, 0), cB, voffB); PG8_STAGE(PG8_SA(0, 0), cA, voffA); PG8_STAGE(PG8_SB(0, 1), cB + hstep, voffB); PG8_STAGE(PG8_SA(0, 1), cA + hstep, voffA);
    if (wr == 1) PG8_BAR;
    PG8_WAIT_V(4); PG8_BAR;
    PG8_STAGE(PG8_SB(1, 0), cB + kstep, voffB); PG8_STAGE(PG8_SA(1, 0), cA + kstep, voffA); PG8_STAGE(PG8_SB(1, 1), cB + hstep + kstep, voffB);
    PG8_WAIT_V(6); PG8_BAR;
    PG8_STAMP();
    for (;;) {
        const bool has_next = S.next(ui + 1, nxt);
        const char* nA = has_next ? (const char*)g.A + (size_t)nxt.pm * tstep : cA; const char* nB = has_next ? (const char*)g.Bt + (size_t)nxt.pn * tstep : cB;
        for (int t = 0; t < nt; t += 2) {
            const bool last = (t == nt - 2);
            const char* a1 = cA + (size_t)(t + 1) * kstep;
            const char* a2 = last ? nA : cA + (size_t)(t + 2) * kstep; const char* b2 = last ? nB : cB + (size_t)(t + 2) * kstep;
            const char* a3 = a2 + kstep; const char* b3 = b2 + kstep;
            if (last && has_next) S.a_ready(nxt);
            PG8_LDB(B0, 0, 0); PG8_SCHED; PG8_LDA(At, 0, 0); PG8_STAGE(PG8_SA(1, 1), a1 + hstep, voffA);
            PG8_WAIT_L(8); PG8_BAR; PG8_WAIT_L(0); PG8_MMA(0, 0, At, B0); PG8_BAR; PG8_SCHED;
            PG8_LDB(B1, 0, 1); PG8_STAGE(PG8_SB(0, 0), b2, voffB);
            PG8_BAR; PG8_WAIT_L(0); PG8_MMA(0, 1, At, B1); PG8_BAR;
            PG8_LDA(At, 0, 1); PG8_STAGE(PG8_SA(0, 0), a2, voffA);
            PG8_BAR; PG8_WAIT_L(0); PG8_MMA(1, 0, At, B0); PG8_BAR; PG8_SCHED;
            PG8_STAGE(PG8_SB(0, 1), b2 + hstep, voffB);
            PG8_WAIT_V(6); PG8_BAR; PG8_MMA(1, 1, At, B1); PG8_BAR;
            PG8_LDB(B0, 1, 0); PG8_SCHED; PG8_LDA(At, 1, 0); PG8_STAGE(PG8_SA(0, 1), a2 + hstep, voffA);
            PG8_WAIT_L(8); PG8_BAR; PG8_WAIT_L(0); PG8_MMA(0, 0, At, B0); PG8_BAR; PG8_SCHED;
            PG8_LDB(B1, 1, 1); PG8_STAGE(PG8_SB(1, 0), b3, voffB);
            PG8_BAR; PG8_WAIT_L(0); PG8_MMA(0, 1, At, B1); PG8_BAR;
            PG8_LDA(At, 1, 1); PG8_STAGE(PG8_SA(1, 0), a3, voffA);
            PG8_BAR; PG8_WAIT_L(0); PG8_MMA(1, 0, At, B0); PG8_BAR; PG8_SCHED;
            PG8_STAGE(PG8_SB(1, 1), b3 + hstep, voffB);
            PG8_WAIT_V(6); PG8_BAR; PG8_MMA(1, 1, At, B1); PG8_BAR;
        }
        PG8_STAMP();
        if constexpr (!Epi::AFTER_DRAIN) { E(acc, cur, wr, wc, fr, fq); S.done(cur); }
        PG8_STAMP();
        if (!has_next) break;
#pragma unroll
        for (int a = 0; a < 2; ++a)
#pragma unroll
            for (int b = 0; b < 2; ++b)
#pragma unroll
                for (int m = 0; m < 4; ++m)
#pragma unroll
                    for (int n = 0; n < 2; ++n) acc[a][b][m][n] = (f32x4){0.f, 0.f, 0.f, 0.f};
        cur = nxt; cA = nA; cB = nB; ++ui;
    }
    PG8_WAIT_V(0);
    if (wr == 0) PG8_BAR;
    PG8_BAR;
    if constexpr (Epi::AFTER_DRAIN) { E.fused(acc, cur, wr, wc, fr, fq, lds, wid, lane); S.done(cur); }
    PG8_STAMP();
    if (STAMP && wid == 0) { stamps[lane] = lane < nts ? (((unsigned long long)(unsigned)ts_hi << 32) | (unsigned)ts_lo) : 0ull;
        if (lane == 62) stamps[62] = rt_entry; if (lane == 63) stamps[63] = (unsigned long long)wall_clock64(); }
#undef PG8_STAMP
#undef PG8_SA
#undef PG8_SB
#undef PG8_STAGE
#undef PG8_LDA
#undef PG8_LDB
#undef PG8_MMA
#undef PG8_WAIT_V
#undef PG8_WAIT_L
#undef PG8_BAR
#undef PG8_SCHED
}
}


constexpr size_t MBy = 1u << 20;
constexpr size_t WS_WTIN = 0, WS_WTOUT = 6 * MBy, WS_WTQ = 8 * MBy, WS_CTL = 12 * MBy, WS_ROWSS = 12 * MBy + 65536, WS_ACT = 13 * MBy, WS_PROJ = 45 * MBy,
                 WS_SB = 141 * MBy, WS_IDX = 173 * MBy, WS_GATE = 181 * MBy, WS_U8 = 189 * MBy, WS_V8 = 205 * MBy, WS_PW = 221 * MBy,
                 WS_UINV = 12 * MBy + 262144, WS_VINV = 12 * MBy + 393216;
constexpr int VIMP = 136, VWAVE = 128 * VIMP + 2048;
constexpr int LDS_MISC = 8 * VWAVE, LDS_BYTES = 8 * VWAVE + 256;
static_assert(LDS_MISC >= pg8::STAGE_BYTES && LDS_BYTES <= 163840, "LDS budget");

struct Params {
  const float *x, *norm1_g, *w_in, *q_norm_g, *k_norm_g, *conv_w, *sb_out_g, *conv_out_g, *w_out, *norm2_g, *w_q, *sub_keys, *peer_u, *peer_v;
  float* out; unsigned char* ws; int ph_lo, ph_hi;
};

#define XB_TMO      128
#define XB_XCNT(j)  (256  + 64 * (j))
#define XB_XSUB(j)  (1280 + 64 * (j))
#define XB_XGEN(j)  (2304 + 64 * (j))
#define XB_TOP      3328
#define XB_TOPGEN   3392
#define XCD_BAR_WORDS 3456
#define XB_SPIN_CAP (1u << 18)
DI unsigned xb_ld(unsigned* p) { return __hip_atomic_load(p, __ATOMIC_RELAXED, __HIP_MEMORY_SCOPE_AGENT); }
DI unsigned xb_add(unsigned* p, unsigned v) { return __hip_atomic_fetch_add(p, v, __ATOMIC_RELAXED, __HIP_MEMORY_SCOPE_AGENT); }
DI unsigned xb_xcc_id() { return (unsigned)__builtin_amdgcn_s_getreg((3 << 11) | 20) & 0xFu; }
#define XB_SPIN(cond, bar) do { unsigned _sp = 0; while (cond) { __builtin_amdgcn_s_sleep(1); \
    if ((++_sp & 255u) == 0u) { if (xb_ld(&(bar)[XB_TMO])) break; if (_sp > XB_SPIN_CAP) { atomicAdd(&(bar)[XB_TMO], 1u); break; } } } } while (0)
struct XcdBarrier { unsigned* bar; unsigned x; volatile LAS unsigned* st; };
DI XcdBarrier xcd_barrier_post(unsigned* bar, volatile LAS unsigned* st) {
  XcdBarrier b; b.bar = bar; b.x = xb_xcc_id(); b.st = st;
  if (threadIdx.x == 0) (void)xb_add(&bar[XB_XCNT(b.x)], 1u);
  return b;
}
DI void xcd_barrier_complete(unsigned* bar, unsigned x, unsigned& nloc, unsigned& nx) {
  const unsigned G = gridDim.x * gridDim.y * gridDim.z;
  unsigned sum, cnt, mine, sp = 0u;
  for (;;) {
    sum = 0u; cnt = 0u; mine = 0u;
#pragma unroll
    for (unsigned j = 0; j < 16; ++j) { const unsigned c = xb_ld(&bar[XB_XCNT(j)]); sum += c; cnt += (c > 0u) ? 1u : 0u; mine = (j == x) ? c : mine; }
    if (sum == G) break;
    __builtin_amdgcn_s_sleep(1);
    if ((++sp & 255u) == 0u) { if (xb_ld(&bar[XB_TMO])) break; if (sp > XB_SPIN_CAP) { atomicAdd(&bar[XB_TMO], 1u); break; } }
  }
  nloc = mine > 0u ? mine : 1u; nx = cnt > 0u ? cnt : 1u;
}
DI void xcd_barrier(const XcdBarrier& b) {
  asm volatile("s_waitcnt vmcnt(0)" ::: "memory");
  __syncthreads();
  if (threadIdx.x == 0) {
    unsigned* bar = b.bar;
    __builtin_amdgcn_s_waitcnt(0);
    unsigned nloc = b.st[0], nx = b.st[1];
    if (nloc == 0u) { xcd_barrier_complete(bar, b.x, nloc, nx); b.st[0] = nloc; b.st[1] = nx; }
    const unsigned old = xb_add(&bar[XB_XSUB(b.x)], 1u);
    const unsigned gen = old / nloc;
    if (old + 1u == (gen + 1u) * nloc) {
      __builtin_amdgcn_fence(__ATOMIC_RELEASE, "agent");
      asm volatile("s_waitcnt vmcnt(0)" ::: "memory");
      const unsigned og = xb_add(&bar[XB_TOP], 1u);
      const unsigned tg = og / nx;
      if (og + 1u == (tg + 1u) * nx) xb_add(&bar[XB_TOPGEN], 1u);
      else XB_SPIN(xb_ld(&bar[XB_TOPGEN]) == tg, bar);
      __builtin_amdgcn_fence(__ATOMIC_ACQUIRE, "agent");
      xb_add(&bar[XB_XGEN(b.x)], 1u);
      asm volatile("s_waitcnt vmcnt(0)" ::: "memory");
    } else {
      XB_SPIN(xb_ld(&bar[XB_XGEN(b.x)]) == gen, bar);
      __builtin_amdgcn_fence(__ATOMIC_ACQUIRE, "agent");
      asm volatile("s_waitcnt vmcnt(0)" ::: "memory");
    }
  }
  __syncthreads();
}

DI u16 f2bf(float x) { unsigned u = __float_as_uint(x); u += 0x7fffu + ((u >> 16) & 1u); return (u16)(u >> 16); }
DI float bflo(unsigned w) { return __uint_as_float(w << 16); }
DI float bfhi(unsigned w) { return __uint_as_float(w & 0xffff0000u); }
DI unsigned pack2(float a, float b) { return (unsigned)f2bf(a) | ((unsigned)f2bf(b) << 16); }
DI float wave_sum(float v) {
#pragma unroll
  for (int o = 32; o >= 1; o >>= 1) v += __shfl_xor(v, o);
  return v;
}
DI float wave_max(float v) {
#pragma unroll
  for (int o = 32; o >= 1; o >>= 1) v = fmaxf(v, __shfl_xor(v, o));
  return v;
}
DI void unpack8(const uint4 w, float* f) {
  f[0] = bflo(w.x); f[1] = bfhi(w.x); f[2] = bflo(w.y); f[3] = bfhi(w.y); f[4] = bflo(w.z); f[5] = bfhi(w.z); f[6] = bflo(w.w); f[7] = bfhi(w.w);
}
DI uint4 pack8(const float* f) { uint4 o; o.x = pack2(f[0], f[1]); o.y = pack2(f[2], f[3]); o.z = pack2(f[4], f[5]); o.w = pack2(f[6], f[7]); return o; }

DI void transpose_convert(const float* __restrict__ W, u16* __restrict__ Wt, int K, int N, const float* __restrict__ rg, float* sm) {
  const int tid = threadIdx.x, tn_cnt = N / 64, ntile = (K / 64) * tn_cnt;
  for (int tile = blockIdx.x; tile < ntile; tile += gridDim.x) {
    const int tk = tile / tn_cnt, tn = tile % tn_cnt;
    __syncthreads();
#pragma unroll
    for (int r = 0; r < 2; ++r) { const int row = r * 32 + (tid >> 4), c4 = (tid & 15) * 4;
      const float g = rg ? rg[tk * 64 + row] : 1.f;
      const float4 v = *(const float4*)(W + (size_t)(tk * 64 + row) * N + tn * 64 + c4);
      sm[row * 65 + c4] = v.x * g; sm[row * 65 + c4 + 1] = v.y * g; sm[row * 65 + c4 + 2] = v.z * g; sm[row * 65 + c4 + 3] = v.w * g; }
    __syncthreads();
    { const int n = tid & 63, k0 = (tid >> 6) * 8;
      float f[8];
#pragma unroll
      for (int j = 0; j < 8; ++j) f[j] = sm[(k0 + j) * 65 + n];
      *(uint4*)(Wt + (size_t)(tn * 64 + n) * K + tk * 64 + k0) = pack8(f); }
  }
}
template <bool SLICED>
DI void convert_fp8_rows(const float* __restrict__ src, const float* __restrict__ cg, unsigned char* __restrict__ dst, float* __restrict__ inv_out) {
  const int lane = threadIdx.x & 63, gw = blockIdx.x * NWAVES + (threadIdx.x >> 6), nw = gridDim.x * NWAVES;
  float g[16];
#pragma unroll
  for (int j = 0; j < 16; ++j) g[j] = cg ? cg[16 * lane + j] : 1.f;
  for (int row = gw; row < NEXP; row += nw) {
    const float4* s = (const float4*)(src + (size_t)row * D + 16 * lane);
    float v[16];
#pragma unroll
    for (int k = 0; k < 4; ++k) { const float4 a = s[k]; v[4 * k] = a.x * g[4 * k]; v[4 * k + 1] = a.y * g[4 * k + 1]; v[4 * k + 2] = a.z * g[4 * k + 2]; v[4 * k + 3] = a.w * g[4 * k + 3]; }
    float am = 0.f;
#pragma unroll
    for (int j = 0; j < 16; ++j) am = fmaxf(am, fabsf(v[j]));
    am = wave_max(am);
    const float sc = am > 0.f ? 240.f / am : 1.f;
    uint4 o;
    { int w;
      w = __builtin_amdgcn_cvt_pk_fp8_f32(v[0] * sc, v[1] * sc, 0, false); w = __builtin_amdgcn_cvt_pk_fp8_f32(v[2] * sc, v[3] * sc, w, true); o.x = (unsigned)w;
      w = __builtin_amdgcn_cvt_pk_fp8_f32(v[4] * sc, v[5] * sc, 0, false); w = __builtin_amdgcn_cvt_pk_fp8_f32(v[6] * sc, v[7] * sc, w, true); o.y = (unsigned)w;
      w = __builtin_amdgcn_cvt_pk_fp8_f32(v[8] * sc, v[9] * sc, 0, false); w = __builtin_amdgcn_cvt_pk_fp8_f32(v[10] * sc, v[11] * sc, w, true); o.z = (unsigned)w;
      w = __builtin_amdgcn_cvt_pk_fp8_f32(v[12] * sc, v[13] * sc, 0, false); w = __builtin_amdgcn_cvt_pk_fp8_f32(v[14] * sc, v[15] * sc, w, true); o.w = (unsigned)w; }
    if (SLICED) *(uint4*)(dst + (size_t)(lane >> 3) * ((size_t)NEXP * 128) + (size_t)row * 128 + 16 * (lane & 7)) = o;
    else *(uint4*)(dst + (size_t)row * D + 16 * lane) = o;
    if (lane == 0) inv_out[row] = am > 0.f ? am * (1.f / 240.f) : 1.f;
  }
}
template <bool SLICED>
DI void convert_fp4_rows(const float* __restrict__ src, const float* __restrict__ cg, unsigned char* __restrict__ dst, float* __restrict__ inv_out) {
  const int lane = threadIdx.x & 63, gw = blockIdx.x * NWAVES + (threadIdx.x >> 6), nw = gridDim.x * NWAVES;
  float4 g[4];
#pragma unroll
  for (int k = 0; k < 4; ++k) g[k] = cg ? ((const float4*)cg)[lane + 64 * k] : make_float4(1.f, 1.f, 1.f, 1.f);
  for (int row0 = gw * 4; row0 < NEXP; row0 += nw * 4) {
    float4 a[4][4];
#pragma unroll
    for (int rr = 0; rr < 4; ++rr)
#pragma unroll
      for (int k = 0; k < 4; ++k) a[rr][k] = ((const float4*)(src + (size_t)(row0 + rr) * D))[lane + 64 * k];
#pragma unroll
    for (int rr = 0; rr < 4; ++rr) {
      float am = 0.f;
#pragma unroll
      for (int k = 0; k < 4; ++k) { a[rr][k].x *= g[k].x; a[rr][k].y *= g[k].y; a[rr][k].z *= g[k].z; a[rr][k].w *= g[k].w;
        am = fmaxf(fmaxf(am, fmaxf(fabsf(a[rr][k].x), fabsf(a[rr][k].y))), fmaxf(fabsf(a[rr][k].z), fabsf(a[rr][k].w))); }
      am = wave_max(am);
      const float sc = am > 0.f ? 6.f / am : 1.f;
      const int row = row0 + rr;
#pragma unroll
      for (int k = 0; k < 4; ++k) {
        unsigned w = 0u;
        w = __builtin_amdgcn_cvt_scalef32_pk_fp4_f32(w, a[rr][k].x * sc, a[rr][k].y * sc, 1.0f, 0); w = __builtin_amdgcn_cvt_scalef32_pk_fp4_f32(w, a[rr][k].z * sc, a[rr][k].w * sc, 1.0f, 1);
        if (SLICED) *(u16*)(dst + (size_t)k * ((size_t)NEXP * 128) + (size_t)row * 128 + 2 * lane) = (u16)w;
        else *(u16*)(dst + (size_t)row * 512 + 128 * k + 2 * lane) = (u16)w;
      }
      if (lane == 0) inv_out[row] = am > 0.f ? am * (1.f / 6.f) : 1.f;
    }
  }
}
DI void rmsnorm1024(const float* __restrict__ src, const float* __restrict__ g, u16* __restrict__ dst) {
  const int lane = threadIdx.x & 63, gw = blockIdx.x * NWAVES + (threadIdx.x >> 6), nw = gridDim.x * NWAVES;
  float4 gg[4];
#pragma unroll
  for (int j = 0; j < 4; ++j) gg[j] = ((const float4*)g)[lane + 64 * j];
  for (int row0 = gw * 4; row0 < T; row0 += nw * 4) {
    float4 v[4][4];
#pragma unroll
    for (int rr = 0; rr < 4; ++rr)
#pragma unroll
      for (int j = 0; j < 4; ++j) v[rr][j] = ((const float4*)(src + (size_t)(row0 + rr) * D))[lane + 64 * j];
#pragma unroll
    for (int rr = 0; rr < 4; ++rr) {
      float ss = 0.f;
#pragma unroll
      for (int j = 0; j < 4; ++j) ss += v[rr][j].x * v[rr][j].x + v[rr][j].y * v[rr][j].y + v[rr][j].z * v[rr][j].z + v[rr][j].w * v[rr][j].w;
      ss = wave_sum(ss);
      const float inv = rsqrtf(ss * (1.f / D) + EPS);
#pragma unroll
      for (int j = 0; j < 4; ++j) {
        uint2 o; o.x = pack2(v[rr][j].x * inv * gg[j].x, v[rr][j].y * inv * gg[j].y); o.y = pack2(v[rr][j].z * inv * gg[j].z, v[rr][j].w * inv * gg[j].w);
        *(uint2*)(dst + (size_t)(row0 + rr) * D + 4 * (lane + 64 * j)) = o;
      }
    }
  }
}

DI void conv_tokens(const Params& p, const u16* __restrict__ proj, u16* __restrict__ mixed) {
  const int lane = threadIdx.x & 63, gw = blockIdx.x * NWAVES + (threadIdx.x >> 6), nw = gridDim.x * NWAVES;
  const int c0 = 8 * lane;
  float w0[8], w1[8], w2[8], go[8];
#pragma unroll
  for (int j = 0; j < 8; ++j) { w0[j] = p.conv_w[c0 + j]; w1[j] = p.conv_w[DSB + c0 + j]; w2[j] = p.conv_w[2 * DSB + c0 + j]; go[j] = p.conv_out_g[c0 + j]; }
#pragma unroll 2
  for (int t = gw; t < T; t += nw) {
    const u16* row = proj + (size_t)t * DIN;
    const int tpos = t & (SEQ - 1);
    float xc[8], bg[8], cg[8], y[8];
    unpack8(*(const uint4*)(row + 1536 + c0), xc); unpack8(*(const uint4*)(row + 2048 + c0), bg); unpack8(*(const uint4*)(row + 2560 + c0), cg);
#pragma unroll
    for (int j = 0; j < 8; ++j) y[j] = w2[j] * (cg[j] * xc[j]);
    if (tpos >= 1) {
      float x1[8], c1[8]; unpack8(*(const uint4*)(row - DIN + 1536 + c0), x1); unpack8(*(const uint4*)(row - DIN + 2560 + c0), c1);
#pragma unroll
      for (int j = 0; j < 8; ++j) y[j] += w1[j] * (c1[j] * x1[j]);
    }
    if (tpos >= 2) {
      float x2[8], c2[8]; unpack8(*(const uint4*)(row - 2 * DIN + 1536 + c0), x2); unpack8(*(const uint4*)(row - 2 * DIN + 2560 + c0), c2);
#pragma unroll
      for (int j = 0; j < 8; ++j) y[j] += w0[j] * (c2[j] * x2[j]);
    }
    float ss = 0.f;
#pragma unroll
    for (int j = 0; j < 8; ++j) { y[j] *= bg[j]; ss += y[j] * y[j]; }
    ss = wave_sum(ss);
    const float inv = rsqrtf(ss * (1.f / DSB) + EPS);
#pragma unroll
    for (int j = 0; j < 8; ++j) y[j] = y[j] * inv * go[j];
    *(uint4*)(mixed + (size_t)t * D + DSB + c0) = pack8(y);
  }
}

typedef float f32x16_t __attribute__((ext_vector_type(16)));
typedef short bf16x8_t __attribute__((ext_vector_type(8)));
DI bf16x8_t pack_bf16x8(float a0, float a1, float a2, float a3, float a4, float a5, float a6, float a7) {
  pg8::u32x4 r;
  asm volatile("v_cvt_pk_bf16_f32 %0, %4, %5\n\tv_cvt_pk_bf16_f32 %1, %6, %7\n\tv_cvt_pk_bf16_f32 %2, %8, %9\n\tv_cvt_pk_bf16_f32 %3, %10, %11\n\ts_nop 1"
               : "=&v"(r[0]), "=&v"(r[1]), "=&v"(r[2]), "=&v"(r[3]) : "v"(a0), "v"(a1), "v"(a2), "v"(a3), "v"(a4), "v"(a5), "v"(a6), "v"(a7));
  return __builtin_bit_cast(bf16x8_t, r);
}
struct AttnKV { bf16x8_t k0, k1, k2, k3, v00, v01, v10, v11; float ik[16]; };
DI void attn_load(AttnKV& f, const u16* __restrict__ kr, const u16* __restrict__ vr, const float* __restrict__ ksq) {
  f.k0 = *(const bf16x8_t*)(kr); f.k1 = *(const bf16x8_t*)(kr + 16); f.k2 = *(const bf16x8_t*)(kr + 32); f.k3 = *(const bf16x8_t*)(kr + 48);
  f.v00 = *(const bf16x8_t*)(vr); f.v01 = *(const bf16x8_t*)(vr + 8); f.v10 = *(const bf16x8_t*)(vr + 32 * SEQ); f.v11 = *(const bf16x8_t*)(vr + 32 * SEQ + 8);
#pragma unroll
  for (int r4 = 0; r4 < 4; ++r4) { const float4 q4 = ((const float4*)ksq)[r4];
    f.ik[4 * r4] = rsqrtf(q4.x * (1.f / 64.f) + EPS); f.ik[4 * r4 + 1] = rsqrtf(q4.y * (1.f / 64.f) + EPS); f.ik[4 * r4 + 2] = rsqrtf(q4.z * (1.f / 64.f) + EPS); f.ik[4 * r4 + 3] = rsqrtf(q4.w * (1.f / 64.f) + EPS); }
}
template <bool DIAG>
DI void attn_half(const AttnKV& f, const bf16x8_t (&qf)[4], int c, int hh, float& carry, f32x16_t& o0, f32x16_t& o1) {
  f32x16_t s;
#pragma unroll
  for (int r = 0; r < 16; ++r) s[r] = 0.f;
  s = __builtin_amdgcn_mfma_f32_32x32x16_bf16(f.k0, qf[0], s, 0, 0, 0); s = __builtin_amdgcn_mfma_f32_32x32x16_bf16(f.k1, qf[1], s, 0, 0, 0);
  s = __builtin_amdgcn_mfma_f32_32x32x16_bf16(f.k2, qf[2], s, 0, 0, 0); s = __builtin_amdgcn_mfma_f32_32x32x16_bf16(f.k3, qf[3], s, 0, 0, 0);
  float rr[16], be[16];
#pragma unroll
  for (int r = 0; r < 16; ++r) {
    const float e = __builtin_amdgcn_exp2f(fminf(s[r] * f.ik[r] * 0.18033688011112042f, 100.f));
    float x = __builtin_amdgcn_rcpf(1.f + e), b = e * x;
    if (DIAG) { const bool on = (16 * hh + r) < c; x = on ? x : 1.f; b = on ? b : 0.f; }
    rr[r] = x; be[r] = b;
  }
  float tot = ((rr[0] * rr[1]) * (rr[2] * rr[3])) * ((rr[4] * rr[5]) * (rr[6] * rr[7]));
  tot *= ((rr[8] * rr[9]) * (rr[10] * rr[11])) * ((rr[12] * rr[13]) * (rr[14] * rr[15]));
  const float oth = __shfl_xor(tot, 32);
  float P = hh ? carry : carry * oth;
  float a[16];
#pragma unroll
  for (int r = 15; r >= 0; --r) { a[r] = be[r] * P; P *= rr[r]; }
  carry = carry * tot * oth;
  const bf16x8_t af0 = pack_bf16x8(a[0], a[1], a[2], a[3], a[4], a[5], a[6], a[7]), af1 = pack_bf16x8(a[8], a[9], a[10], a[11], a[12], a[13], a[14], a[15]);
  o0 = __builtin_amdgcn_mfma_f32_32x32x16_bf16(f.v00, af0, o0, 0, 0, 0); o0 = __builtin_amdgcn_mfma_f32_32x32x16_bf16(f.v01, af1, o0, 0, 0, 0);
  o1 = __builtin_amdgcn_mfma_f32_32x32x16_bf16(f.v10, af0, o1, 0, 0, 0); o1 = __builtin_amdgcn_mfma_f32_32x32x16_bf16(f.v11, af1, o1, 0, 0, 0);
}
DI void attn_phase(const Params& p, const u16* __restrict__ proj, const u16* __restrict__ vt, const float* __restrict__ ssq, u16* __restrict__ mixed, unsigned char* smem) {
  const int lane = threadIdx.x & 63, head = threadIdx.x >> 6, c = lane & 31, hh = lane >> 5;
  LAS float* red = (LAS float*)smem;
  const int kap = 16 * ((c >> 2) & 1) + (c & 3) + 4 * (c >> 3);
  for (int item = blockIdx.x; item < 4 * 64; item += gridDim.x) {
    const int b = item & 3, q0 = (63 - (item >> 2)) * 64;
    const size_t tq = (size_t)b * SEQ + q0 + c;
    const float* qsq = ssq + ((size_t)(b * 8 + head)) * SEQ;
    const float* ksqb = ssq + ((size_t)(32 + b * 8 + head)) * SEQ + 16 * hh;
    bf16x8_t qL[4], qU[4];
#pragma unroll
    for (int up = 0; up < 2; ++up) {
      const float iq = rsqrtf(qsq[q0 + 32 * up + c] * (1.f / 64.f) + EPS);
#pragma unroll
      for (int ks = 0; ks < 4; ++ks) { float f[8]; unpack8(*(const uint4*)(proj + (tq + 32 * up) * DIN + head * 64 + 16 * ks + 8 * hh), f);
        float gq[8];
        { const float4 qa = *(const float4*)(p.q_norm_g + 16 * ks + 8 * hh), qb = *(const float4*)(p.q_norm_g + 16 * ks + 8 * hh + 4), ka = *(const float4*)(p.k_norm_g + 16 * ks + 8 * hh), kb = *(const float4*)(p.k_norm_g + 16 * ks + 8 * hh + 4);
          gq[0] = qa.x * ka.x * iq; gq[1] = qa.y * ka.y * iq; gq[2] = qa.z * ka.z * iq; gq[3] = qa.w * ka.w * iq; gq[4] = qb.x * kb.x * iq; gq[5] = qb.y * kb.y * iq; gq[6] = qb.z * kb.z * iq; gq[7] = qb.w * kb.w * iq; }
        const bf16x8_t v = pack_bf16x8(f[0] * gq[0], f[1] * gq[1], f[2] * gq[2], f[3] * gq[3], f[4] * gq[4], f[5] * gq[5], f[6] * gq[6], f[7] * gq[7]);
        if (up) qU[ks] = v; else qL[ks] = v; }
    }
    f32x16_t oL0, oL1, oU0, oU1;
#pragma unroll
    for (int r = 0; r < 16; ++r) { oL0[r] = 0.f; oL1[r] = 0.f; oU0[r] = 0.f; oU1[r] = 0.f; }
    float cL = 1.f, cU = 1.f;
    const u16* kbase = proj + ((size_t)b * SEQ + kap) * DIN + 512 + head * 64 + 8 * hh;
    const u16* vbase = vt + ((size_t)(b * 512 + head * 64 + c)) * SEQ + 16 * hh;
    AttnKV kv;
    attn_load(kv, kbase + (size_t)(q0 + 32) * DIN, vbase + q0 + 32, ksqb + q0 + 32);
    attn_half<true>(kv, qU, c, hh, cU, oU0, oU1);
    attn_load(kv, kbase + (size_t)q0 * DIN, vbase + q0, ksqb + q0);
    attn_half<false>(kv, qU, c, hh, cU, oU0, oU1);
    attn_half<true>(kv, qL, c, hh, cL, oL0, oL1);
    for (int tb = q0 - 32; tb >= 0; tb -= 32) {
      attn_load(kv, kbase + (size_t)tb * DIN, vbase + tb, ksqb + tb);
      const bool uz = __all(cU == 0.f);
      if (!uz) attn_half<false>(kv, qU, c, hh, cU, oU0, oU1);
      attn_half<false>(kv, qL, c, hh, cL, oL0, oL1);
      if (uz && __all(cL == 0.f)) break;
    }
    float sL = 0.f, sU = 0.f;
#pragma unroll
    for (int r = 0; r < 16; ++r) { sL += oL0[r] * oL0[r] + oL1[r] * oL1[r]; sU += oU0[r] * oU0[r] + oU1[r] * oU1[r]; }
    sL += __shfl_xor(sL, 32); sU += __shfl_xor(sU, 32);
    __syncthreads();
    if (hh == 0) { red[head * 64 + c] = sL; red[head * 64 + 32 + c] = sU; }
    __syncthreads();
    float tL = 0.f, tU = 0.f;
#pragma unroll
    for (int h8 = 0; h8 < 8; ++h8) { tL += red[h8 * 64 + c]; tU += red[h8 * 64 + 32 + c]; }
    const float* g = p.sb_out_g + head * 64 + 4 * hh;
#pragma unroll
    for (int up = 0; up < 2; ++up) {
      const float inv = rsqrtf((up ? tU : tL) * (1.f / DSB) + EPS);
      u16* orow = mixed + (tq + 32 * up) * D + head * 64 + 4 * hh;
#pragma unroll
      for (int rg = 0; rg < 4; ++rg) {
        const float4 g0 = *(const float4*)(g + 8 * rg), g1 = *(const float4*)(g + 32 + 8 * rg);
        const float a0 = up ? oU0[4 * rg] : oL0[4 * rg], a1 = up ? oU0[4 * rg + 1] : oL0[4 * rg + 1], a2 = up ? oU0[4 * rg + 2] : oL0[4 * rg + 2], a3 = up ? oU0[4 * rg + 3] : oL0[4 * rg + 3];
        const float b0 = up ? oU1[4 * rg] : oL1[4 * rg], b1 = up ? oU1[4 * rg + 1] : oL1[4 * rg + 1], b2 = up ? oU1[4 * rg + 2] : oL1[4 * rg + 2], b3 = up ? oU1[4 * rg + 3] : oL1[4 * rg + 3];
        uint2 w0, w1;
        w0.x = pack2(a0 * inv * g0.x, a1 * inv * g0.y); w0.y = pack2(a2 * inv * g0.z, a3 * inv * g0.w);
        w1.x = pack2(b0 * inv * g1.x, b1 * inv * g1.y); w1.y = pack2(b2 * inv * g1.z, b3 * inv * g1.w);
        *(uint2*)(orow + 8 * rg) = w0; *(uint2*)(orow + 32 + 8 * rg) = w1;
      }
    }
  }
}
#define SEL_DI DI
#define SEL_F2U(x) __float_as_uint(x)
#define SEL_U2F(x) __uint_as_float(x)

#define CE(a, b) do { const unsigned _h = (a) > (b) ? (a) : (b), _l = (a) > (b) ? (b) : (a); (a) = _h; (b) = _l; } while (0)
SEL_DI void sort16(unsigned (&v)[16]) {
  CE(v[0], v[1]); CE(v[2], v[3]); CE(v[0], v[2]); CE(v[1], v[3]); CE(v[1], v[2]); CE(v[4], v[5]); CE(v[6], v[7]); CE(v[4], v[6]);
  CE(v[5], v[7]); CE(v[5], v[6]); CE(v[0], v[4]); CE(v[2], v[6]); CE(v[2], v[4]); CE(v[1], v[5]); CE(v[3], v[7]); CE(v[3], v[5]);
  CE(v[1], v[2]); CE(v[3], v[4]); CE(v[5], v[6]); CE(v[8], v[9]); CE(v[10], v[11]); CE(v[8], v[10]); CE(v[9], v[11]); CE(v[9], v[10]);
  CE(v[12], v[13]); CE(v[14], v[15]); CE(v[12], v[14]); CE(v[13], v[15]); CE(v[13], v[14]); CE(v[8], v[12]); CE(v[10], v[14]); CE(v[10], v[12]);
  CE(v[9], v[13]); CE(v[11], v[15]); CE(v[11], v[13]); CE(v[9], v[10]); CE(v[11], v[12]); CE(v[13], v[14]); CE(v[0], v[8]); CE(v[4], v[12]);
  CE(v[4], v[8]); CE(v[2], v[10]); CE(v[6], v[14]); CE(v[6], v[10]); CE(v[2], v[4]); CE(v[6], v[8]); CE(v[10], v[12]); CE(v[1], v[9]);
  CE(v[5], v[13]); CE(v[5], v[9]); CE(v[3], v[11]); CE(v[7], v[15]); CE(v[7], v[11]); CE(v[3], v[5]); CE(v[7], v[9]); CE(v[11], v[13]);
  CE(v[1], v[2]); CE(v[3], v[4]); CE(v[5], v[6]); CE(v[7], v[8]); CE(v[9], v[10]); CE(v[11], v[12]); CE(v[13], v[14]);
}
SEL_DI void bitonic_merge16(unsigned (&v)[16]) {
#pragma unroll
  for (int d = 8; d >= 1; d >>= 1)
#pragma unroll
    for (int i = 0; i < 16; ++i) if ((i & d) == 0) CE(v[i], v[i + d]);
}
SEL_DI void merge_top16(unsigned (&a)[16], const unsigned (&b)[16]) {
#pragma unroll
  for (int i = 0; i < 16; ++i) a[i] = a[i] > b[15 - i] ? a[i] : b[15 - i];
  bitonic_merge16(a);
}
SEL_DI void top16_of_64(unsigned (&g0)[16], unsigned (&g1)[16], unsigned (&g2)[16], unsigned (&g3)[16]) {
  sort16(g0); sort16(g1); sort16(g2); sort16(g3);
  merge_top16(g0, g1); merge_top16(g2, g3); merge_top16(g0, g2);
}
SEL_DI unsigned cand_key(float a, float b, unsigned payload) {
  float s = a + b; s = s < 32.0f ? 32.0f : (s > 127.99f ? 127.99f : s);
  return ((SEL_F2U(s) << 8) & 0xFFFFC000u) | payload;
}
SEL_DI void stage2(const unsigned (&L1)[16], const unsigned (&L2)[16], unsigned (&R)[16]) {
  float f1[16], f2m[16]; unsigned P1[16], P2[16];
#pragma unroll
  for (int i = 0; i < 16; ++i) { f1[i] = SEL_U2F(L1[i] & ~127u); f2m[i] = SEL_U2F(L2[i] & ~127u) - 64.0f; P1[i] = (L1[i] & 127u) << 7; P2[i] = L2[i] & 127u; }
  unsigned K[64];
  K[0] = cand_key(f1[0], f2m[0], P1[0] | P2[0]);
  K[1] = cand_key(f1[0], f2m[1], P1[0] | P2[1]);
  K[2] = cand_key(f1[0], f2m[2], P1[0] | P2[2]);
  K[3] = cand_key(f1[0], f2m[3], P1[0] | P2[3]);
  K[4] = cand_key(f1[0], f2m[4], P1[0] | P2[4]);
  K[5] = cand_key(f1[0], f2m[5], P1[0] | P2[5]);
  K[6] = cand_key(f1[0], f2m[6], P1[0] | P2[6]);
  K[7] = cand_key(f1[0], f2m[7], P1[0] | P2[7]);
  K[8] = cand_key(f1[0], f2m[8], P1[0] | P2[8]);
  K[9] = cand_key(f1[0], f2m[9], P1[0] | P2[9]);
  K[10] = cand_key(f1[0], f2m[10], P1[0] | P2[10]);
  K[11] = cand_key(f1[0], f2m[11], P1[0] | P2[11]);
  K[12] = cand_key(f1[0], f2m[12], P1[0] | P2[12]);
  K[13] = cand_key(f1[0], f2m[13], P1[0] | P2[13]);
  K[14] = cand_key(f1[0], f2m[14], P1[0] | P2[14]);
  K[15] = cand_key(f1[0], f2m[15], P1[0] | P2[15]);
  K[16] = cand_key(f1[1], f2m[0], P1[1] | P2[0]);
  K[17] = cand_key(f1[1], f2m[1], P1[1] | P2[1]);
  K[18] = cand_key(f1[1], f2m[2], P1[1] | P2[2]);
  K[19] = cand_key(f1[1], f2m[3], P1[1] | P2[3]);
  K[20] = cand_key(f1[1], f2m[4], P1[1] | P2[4]);
  K[21] = cand_key(f1[1], f2m[5], P1[1] | P2[5]);
  K[22] = cand_key(f1[1], f2m[6], P1[1] | P2[6]);
  K[23] = cand_key(f1[1], f2m[7], P1[1] | P2[7]);
  K[24] = cand_key(f1[2], f2m[0], P1[2] | P2[0]);
  K[25] = cand_key(f1[2], f2m[1], P1[2] | P2[1]);
  K[26] = cand_key(f1[2], f2m[2], P1[2] | P2[2]);
  K[27] = cand_key(f1[2], f2m[3], P1[2] | P2[3]);
  K[28] = cand_key(f1[2], f2m[4], P1[2] | P2[4]);
  K[29] = cand_key(f1[3], f2m[0], P1[3] | P2[0]);
  K[30] = cand_key(f1[3], f2m[1], P1[3] | P2[1]);
  K[31] = cand_key(f1[3], f2m[2], P1[3] | P2[2]);
  K[32] = cand_key(f1[3], f2m[3], P1[3] | P2[3]);
  K[33] = cand_key(f1[4], f2m[0], P1[4] | P2[0]);
  K[34] = cand_key(f1[4], f2m[1], P1[4] | P2[1]);
  K[35] = cand_key(f1[4], f2m[2], P1[4] | P2[2]);
  K[36] = cand_key(f1[5], f2m[0], P1[5] | P2[0]);
  K[37] = cand_key(f1[5], f2m[1], P1[5] | P2[1]);
  K[38] = cand_key(f1[6], f2m[0], P1[6] | P2[0]);
  K[39] = cand_key(f1[6], f2m[1], P1[6] | P2[1]);
  K[40] = cand_key(f1[7], f2m[0], P1[7] | P2[0]);
  K[41] = cand_key(f1[7], f2m[1], P1[7] | P2[1]);
  K[42] = cand_key(f1[8], f2m[0], P1[8] | P2[0]);
  K[43] = cand_key(f1[9], f2m[0], P1[9] | P2[0]);
  K[44] = cand_key(f1[10], f2m[0], P1[10] | P2[0]);
  K[45] = cand_key(f1[11], f2m[0], P1[11] | P2[0]);
  K[46] = cand_key(f1[12], f2m[0], P1[12] | P2[0]);
  K[47] = cand_key(f1[13], f2m[0], P1[13] | P2[0]);
  K[48] = cand_key(f1[14], f2m[0], P1[14] | P2[0]);
  K[49] = cand_key(f1[15], f2m[0], P1[15] | P2[0]);
#pragma unroll
  for (int c = 50; c < 64; ++c) K[c] = 0u;
  unsigned g1[16], g2[16], g3[16];
#pragma unroll
  for (int i = 0; i < 16; ++i) { R[i] = K[i]; g1[i] = K[16 + i]; g2[i] = K[32 + i]; g3[i] = K[48 + i]; }
  sort16(R); sort16(g1); sort16(g2); CE(g3[0], g3[1]);
  merge_top16(R, g1);
  g2[15] = g2[15] > g3[0] ? g2[15] : g3[0]; g2[14] = g2[14] > g3[1] ? g2[14] : g3[1];
  bitonic_merge16(g2);
  merge_top16(R, g2);
}

constexpr int SKP = 272;
struct QFrag { bf16x8_t f[8]; };
DI QFrag stage1_load(const u16* __restrict__ qrow, int hh) { QFrag q;
#pragma unroll
  for (int ks = 0; ks < 8; ++ks) q.f[ks] = *(const bf16x8_t*)(qrow + 16 * ks + 8 * hh);
  return q; }
DI void stage1(const QFrag& qfr, const LAS unsigned char* sk, int tok, int hh, unsigned (&out)[16]) {
  f32x16_t acc[4];
#pragma unroll
  for (int kt = 0; kt < 4; ++kt)
#pragma unroll
    for (int r = 0; r < 16; ++r) acc[kt][r] = 64.0f;
#pragma unroll
  for (int ks = 0; ks < 8; ++ks) {
#pragma unroll
    for (int kt = 0; kt < 4; ++kt) {
      const bf16x8_t ak = *(const LAS bf16x8_t*)(sk + (32 * kt + tok) * SKP + (16 * ks + 8 * hh) * 2);
      acc[kt] = __builtin_amdgcn_mfma_f32_32x32x16_bf16(ak, qfr.f[ks], acc[kt], 0, 0, 0);
    }
    __builtin_amdgcn_sched_barrier(0);
  }
  unsigned g1[16], g2[16], g3[16];
#pragma unroll
  for (int r = 0; r < 16; ++r) {
    const unsigned ix = (unsigned)((r & 3) + 8 * (r >> 2));
    out[r] = (__float_as_uint(acc[0][r]) & ~127u) | ix; g1[r] = (__float_as_uint(acc[1][r]) & ~127u) | (32u + ix);
    g2[r] = (__float_as_uint(acc[2][r]) & ~127u) | (64u + ix); g3[r] = (__float_as_uint(acc[3][r]) & ~127u) | (96u + ix);
  }
  top16_of_64(out, g1, g2, g3);
  unsigned oth[16];
#pragma unroll
  for (int i = 0; i < 16; ++i) { out[i] |= (unsigned)(hh << 2); }
#pragma unroll
  for (int i = 0; i < 16; ++i) oth[i] = (unsigned)__shfl_xor((int)out[i], 32);
  merge_top16(out, oth);
}
DI void topk_phase(const Params& p, const u16* __restrict__ qp, const float* __restrict__ uinv, int* __restrict__ idx_out, float2* __restrict__ gu_out, unsigned char* smem) {
  const int tid = threadIdx.x;
  LAS unsigned char* sk = (LAS unsigned char*)smem;
  __syncthreads();
#pragma unroll
  for (int i = tid; i < 2 * 128 * 16; i += NTHREADS) {
    const int c = i & 15, row = i >> 4;
    const float4* s = (const float4*)(p.sub_keys + (size_t)row * 128 + c * 8);
    const float4 a = s[0], b = s[1];
    pg8::u32x4 o; o.x = pack2(a.x, a.y); o.y = pack2(a.z, a.w); o.z = pack2(b.x, b.y); o.w = pack2(b.z, b.w);
    *(LAS pg8::u32x4*)(sk + row * SKP + c * 16) = o;
  }
  __syncthreads();
  const int lane = tid & 63, tok = lane & 31, hh = lane >> 5, gw = blockIdx.x * NWAVES + (tid >> 6), nw = gridDim.x * NWAVES;
  for (int item = gw; item < (T / 32) * 4; item += nw) {
    const int t = (item >> 2) * 32 + tok, hp = item & 3;
    const u16* qt = qp + (size_t)t * 2048 + hp * 512;
    unsigned LA1[16], LA2[16], LB1[16], LB2[16];
    { QFrag fa = stage1_load(qt, hh), fb = stage1_load(qt + 128, hh);
      stage1(fa, sk, tok, hh, LA1); fa = stage1_load(qt + 256, hh);
      stage1(fb, sk + 128 * SKP, tok, hh, LA2); fb = stage1_load(qt + 384, hh);
      stage1(fa, sk, tok, hh, LB1);
      stage1(fb, sk + 128 * SKP, tok, hh, LB2); }
    unsigned L1[16], L2[16], R[16];
#pragma unroll
    for (int i = 0; i < 16; ++i) { L1[i] = hh ? LB1[i] : LA1[i]; L2[i] = hh ? LB2[i] : LA2[i]; }
    stage2(L1, L2, R);
    const int head = hp * 2 + hh;
    float ev[16], sum = 0.f;
    const float mx = __uint_as_float(0x42000000u | ((R[0] >> 14) << 6));
#pragma unroll
    for (int k = 0; k < 16; ++k) { ev[k] = __expf(__uint_as_float(0x42000000u | ((R[k] >> 14) << 6)) - mx); sum += ev[k]; }
    const float rs = 1.f / sum;
    int* io = idx_out + (size_t)t * 128 + head * 16; float2* go = gu_out + (size_t)t * 128 + head * 16;
#pragma unroll
    for (int k4 = 0; k4 < 4; ++k4) {
      int4 ex; ex.x = (int)(R[4 * k4] & 0x3FFFu); ex.y = (int)(R[4 * k4 + 1] & 0x3FFFu); ex.z = (int)(R[4 * k4 + 2] & 0x3FFFu); ex.w = (int)(R[4 * k4 + 3] & 0x3FFFu);
      ((int4*)io)[k4] = ex;
      float4 ga, gb; ga.x = ev[4 * k4] * rs; ga.y = uinv[ex.x]; ga.z = ev[4 * k4 + 1] * rs; ga.w = uinv[ex.y];
      gb.x = ev[4 * k4 + 2] * rs; gb.y = uinv[ex.z]; gb.z = ev[4 * k4 + 3] * rs; gb.w = uinv[ex.w];
      ((float4*)go)[2 * k4] = ga; ((float4*)go)[2 * k4 + 1] = gb;
    }
  }
}

typedef float f32x4_t __attribute__((ext_vector_type(4)));
typedef float f32x2_t __attribute__((ext_vector_type(2)));
typedef int i32x8_t __attribute__((ext_vector_type(8)));
constexpr int UIP = 132;
constexpr int UGP = 1032;
struct UBuf { uint4 r0, r1, r2, r3; unsigned e; float vi; };
#define U_LOAD(buf, g) do { const unsigned _e = myi[(g)]; const LAS unsigned* _il = idl + (lane >> 5) * UIP + (g); const unsigned _lo = 16u * (lane & 31); \
    buf.r0 = *(const uint4*)(U4 + (size_t)_il[0] * 512 + _lo); buf.r1 = *(const uint4*)(U4 + (size_t)_il[2 * UIP] * 512 + _lo); \
    buf.r2 = *(const uint4*)(U4 + (size_t)_il[4 * UIP] * 512 + _lo); buf.r3 = *(const uint4*)(U4 + (size_t)_il[6 * UIP] * 512 + _lo); \
    buf.e = _e; buf.vi = vinv[_e]; } while (0)
#define U_ST(i, r) do { pg8::u32x4 _o; _o.x = (r).x; _o.y = (r).y; _o.z = (r).z; _o.w = (r).w; *(LAS pg8::u32x4*)(gst + (2 * (i) + (lane >> 5)) * 528 + 16 * (lane & 31)) = _o; } while (0)
#define U_LD(j) (*(const LAS pg8::u32x4*)(gld + 128 * (j)))
#define U_MMA(c, r, b) c = __builtin_amdgcn_mfma_scale_f32_16x16x128_f8f6f4((i32x8_t){(int)(r).x, (int)(r).y, (int)(r).z, (int)(r).w, 0, 0, 0, 0}, b, c, 4, 0, 0, 0x7F7F7F7F, 0, 0x7F7F7F7F)
#define U_COMP(buf, g) do { f32x4_t c = {0.f, 0.f, 0.f, 0.f}; \
    U_ST(0, buf.r0); U_ST(1, buf.r1); U_ST(2, buf.r2); U_ST(3, buf.r3); asm volatile("s_waitcnt lgkmcnt(0)" ::: "memory"); \
    { const pg8::u32x4 a0 = U_LD(0), a1 = U_LD(1), a2 = U_LD(2), a3 = U_LD(3); asm volatile("s_waitcnt lgkmcnt(0)" ::: "memory"); \
      U_MMA(c, a0, B0); U_MMA(c, a1, B1); U_MMA(c, a2, B2); U_MMA(c, a3, B3); } \
    const int rsel = pp & 3; const float v = rsel == 0 ? c[0] : rsel == 1 ? c[1] : rsel == 2 ? c[2] : c[3]; \
    const float vo = __shfl(v, (lane + 40) & 63); \
    if (pp < 8 && q == (pp >> 2)) { const f32x2_t gu2 = *(const LAS f32x2_t*)(myg + (g) * 8); \
      const float d = (v + vo) * gu2[1]; const float act = 0.5f * d * (1.f + erff(d * 0.70710678118654752f)); \
      uint2 o; o.x = buf.e; o.y = __float_as_uint(gu2[0] * act * buf.vi); pw[(size_t)tok * 128 + (g)] = o; } } while (0)
DI void peer_u_phase(const u16* __restrict__ xb, const float* __restrict__ rowss, const int* __restrict__ idx, const float2* __restrict__ gu,
                     const unsigned char* __restrict__ U4, const float* __restrict__ vinv, uint2* __restrict__ pw, unsigned char* smem) {
  const int lane = threadIdx.x & 63, wave = threadIdx.x >> 6, pp = lane & 15, q = lane >> 4, gw = blockIdx.x * NWAVES + wave, nw = gridDim.x * NWAVES;
  const int pi = pp & 7, x = q + 4 * (pp >> 3);
  const unsigned xoff = 16u * x;
  LAS unsigned* idl = (LAS unsigned*)(smem + wave * (8 * UIP * 4 + 8 * UGP + 8 * 528));
  LAS unsigned char* gul = (LAS unsigned char*)(idl + 8 * UIP);
  LAS unsigned char* gst = gul + 8 * UGP;
  const LAS unsigned char* gld = gst + pi * 528 + 16 * x;
  const LAS unsigned* myi = idl + pi * UIP;
  const LAS unsigned char* myg = gul + pi * UGP;
  for (int unit = gw; unit < T / 8; unit += nw) {
    const int tok = unit * 8 + pi;
    __builtin_amdgcn_wave_barrier();
#pragma unroll
    for (int r8 = 0; r8 < 8; ++r8) {
      const int* ir = idx + (size_t)(unit * 8 + r8) * 128;
      idl[r8 * UIP + lane] = (unsigned)ir[lane]; idl[r8 * UIP + 64 + lane] = (unsigned)ir[64 + lane];
      const uint4 gv = ((const uint4*)(gu + (size_t)(unit * 8 + r8) * 128))[lane];
      pg8::u32x4 o; o.x = gv.x; o.y = gv.y; o.z = gv.z; o.w = gv.w; *(LAS pg8::u32x4*)(gul + r8 * UGP + lane * 16) = o;
    }
    __builtin_amdgcn_fence(__ATOMIC_RELEASE, "wavefront");
    __builtin_amdgcn_wave_barrier();
    const float inv = rsqrtf(rowss[tok] * (1.f / D) + EPS);
    i32x8_t B0, B1, B2, B3;
#define U_BUILD(Bv, i) do { const u16* sb = xb + (size_t)tok * D + 256 * (i) + 128 * (pp >> 3) + 16 * q; \
      _Pragma("unroll") for (int h = 0; h < 4; ++h) { float f[8]; unpack8(*(const uint4*)(sb + 64 * (h >> 1) + 8 * (h & 1)), f); int w; \
        w = __builtin_amdgcn_cvt_pk_fp8_f32(f[0] * inv, f[1] * inv, 0, false); w = __builtin_amdgcn_cvt_pk_fp8_f32(f[2] * inv, f[3] * inv, w, true); Bv[2 * h] = w; \
        w = __builtin_amdgcn_cvt_pk_fp8_f32(f[4] * inv, f[5] * inv, 0, false); w = __builtin_amdgcn_cvt_pk_fp8_f32(f[6] * inv, f[7] * inv, w, true); Bv[2 * h + 1] = w; } } while (0)
    U_BUILD(B0, 0); U_BUILD(B1, 1); U_BUILD(B2, 2); U_BUILD(B3, 3);
    UBuf b0, b1, b2, b3;
#define SB() __builtin_amdgcn_sched_barrier(0)
    U_LOAD(b0, 0); U_LOAD(b1, 1); U_LOAD(b2, 2); SB();
#pragma unroll 1
    for (int g = 0; g < 128; g += 4) {
      U_LOAD(b3, g + 3); SB(); U_COMP(b0, g); SB();
      U_LOAD(b0, (g + 4) & 127); SB(); U_COMP(b1, g + 1); SB();
      U_LOAD(b1, (g + 5) & 127); SB(); U_COMP(b2, g + 2); SB();
      U_LOAD(b2, (g + 6) & 127); SB(); U_COMP(b3, g + 3); SB();
    }
  }
}

typedef int i32x2_t __attribute__((ext_vector_type(2)));
DI void peer_v_phase(const uint2* __restrict__ pw, const unsigned char* __restrict__ V4, const u16* __restrict__ xb, float* __restrict__ out, unsigned char* smem) {
  const int lane = threadIdx.x & 63, wave = threadIdx.x >> 6, r = lane >> 3, c = lane & 7, n16 = lane & 15, kg = lane >> 4;
  LAS unsigned char* img = (LAS unsigned char*)smem + wave * VWAVE;
  LAS unsigned char* pbuf = img + 128 * VIMP;
  const int nunit = 4 * (T / 64);
  const int cnt = ((int)blockIdx.x < nunit) ? (nunit - 1 - (int)blockIdx.x) / (int)gridDim.x + 1 : 0, N = cnt * 8;
  if (N == 0) return;
#define V_TOK(n, jj, tt) do { const int _u = (int)blockIdx.x + ((n) >> 3) * (int)gridDim.x; jj = _u & 3; tt = (_u >> 2) * 64 + wave * 8 + ((n) & 7); } while (0)
#define V_LDPW(n) ({ int _j, _t; V_TOK(n, _j, _t); ((const uint4*)(pw + (size_t)_t * 128))[lane]; })
#define V_STAGE(n, pq, scv) do { LAS unsigned char* _b = pbuf + ((n) & 1) * 1024; \
    *(LAS i32x2_t*)(_b + 8 * lane) = (i32x2_t){(int)(pq).x, (int)(pq).z}; *(LAS i32x2_t*)(_b + 512 + 8 * lane) = (i32x2_t){(int)(pq).y, (int)(pq).w}; \
    const float _m = wave_max(fmaxf(fabsf(__uint_as_float((pq).y)), fabsf(__uint_as_float((pq).w)))); scv = _m > 0.f ? 224.f / _m : 1.f; } while (0)
#define V_GATHER(n) do { int _j, _t; V_TOK(n, _j, _t); const unsigned char* _vb = V4 + (size_t)_j * ((size_t)NEXP * 128) + 16 * c; const LAS unsigned* _e = (const LAS unsigned*)(pbuf + ((n) & 1) * 1024); \
    _Pragma("unroll") for (int i = 0; i < 16; ++i) G[i] = *(const uint4*)(_vb + (_e[8 * i + r] * 128u)); } while (0)
#define V_WRITEIMG() do { _Pragma("unroll") for (int i = 0; i < 16; ++i) { LAS unsigned char* _d = img + (8 * i + r) * VIMP + 16 * c; \
      *(LAS i32x2_t*)(_d) = (i32x2_t){(int)G[i].x, (int)G[i].y}; *(LAS i32x2_t*)(_d + 8) = (i32x2_t){(int)G[i].z, (int)G[i].w}; } } while (0)
  uint4 G[16];
  uint4 pq = V_LDPW(0);
  float sc_cur, sc_nxt;
  V_STAGE(0, pq, sc_cur); asm volatile("s_waitcnt lgkmcnt(0)" ::: "memory");
  if (N > 1) pq = V_LDPW(1);
  V_GATHER(0);
  V_WRITEIMG(); asm volatile("s_waitcnt lgkmcnt(0)" ::: "memory");
  for (int n = 0; n < N; ++n) {
    if (n + 1 < N) { V_STAGE(n + 1, pq, sc_nxt); asm volatile("s_waitcnt lgkmcnt(0)" ::: "memory"); if (n + 2 < N) pq = V_LDPW(n + 2); V_GATHER(n + 1); }
    __builtin_amdgcn_sched_barrier(0);
    int j, t; V_TOK(n, j, t);
    i32x8_t A;
    { const LAS float* wl = (const LAS float*)(pbuf + (n & 1) * 1024 + 512);
#pragma unroll
      for (int h = 0; h < 2; ++h)
#pragma unroll
        for (int d = 0; d < 4; ++d) { const f32x4_t w4 = *(const LAS f32x4_t*)(wl + 64 * h + 16 * kg + 4 * d);
          int w = __builtin_amdgcn_cvt_pk_fp8_f32(w4[0] * sc_cur, w4[1] * sc_cur, 0, false); w = __builtin_amdgcn_cvt_pk_fp8_f32(w4[2] * sc_cur, w4[3] * sc_cur, w, true);
          A[4 * h + d] = n16 == 0 ? w : 0; } }
    float val[16];
    const LAS unsigned char* ib = img + (32 * kg + n16) * VIMP;
#pragma unroll
    for (int ct = 0; ct < 16; ++ct) {
      const i32x2_t b0 = __builtin_amdgcn_ds_read_tr4_b64_v2i32((LAS i32x2_t*)(ib + 8 * ct)), b1 = __builtin_amdgcn_ds_read_tr4_b64_v2i32((LAS i32x2_t*)(ib + 16 * VIMP + 8 * ct));
      const f32x4_t z = {0.f, 0.f, 0.f, 0.f};
      const f32x4_t cc = __builtin_amdgcn_mfma_scale_f32_16x16x128_f8f6f4(A, (i32x8_t){b0[0], b0[1], b1[0], b1[1], 0, 0, 0, 0}, z, 0, 4, 0, 0x7F7F7F7F, 0, 0x7F7F7F7F);
      val[ct] = cc[0];
      asm volatile("" : "+v"(val[ct]));
    }
    LAS float* stg = (LAS float*)(pbuf + (n & 1) * 1024);
    if (lane < 16) {
#pragma unroll
      for (int ct = 0; ct < 16; ++ct) stg[16 * ct + lane] = val[ct];
    }
    asm volatile("s_waitcnt lgkmcnt(0)" ::: "memory");
    const f32x4_t s4 = *(const LAS f32x4_t*)(stg + 4 * lane);
    const float rs = 1.f / sc_cur;
    const uint2 xr = *(const uint2*)(xb + (size_t)t * D + 256 * j + 4 * lane);
    float4 o;
    o.x = bflo(xr.x) + s4[0] * rs; o.y = bfhi(xr.x) + s4[1] * rs; o.z = bflo(xr.y) + s4[2] * rs; o.w = bfhi(xr.y) + s4[3] * rs;
    *(float4*)(out + (size_t)t * D + 256 * j + 4 * lane) = o;
    __builtin_amdgcn_sched_barrier(0);
    asm volatile("s_waitcnt lgkmcnt(0)" ::: "memory");
    if (n + 1 < N) { V_WRITEIMG(); sc_cur = sc_nxt; }
    asm volatile("s_waitcnt lgkmcnt(0)" ::: "memory");
  }
}

constexpr int NPHASE = 8;
__global__ void __launch_bounds__(NTHREADS, 2) fwd_kernel(Params p) {
  extern __shared__ __attribute__((aligned(16))) unsigned char smem[];
  cg::grid_group grid = cg::this_grid();
  unsigned char* ws = p.ws;
  u16* wt_in = (u16*)(ws + WS_WTIN); u16* wt_out = (u16*)(ws + WS_WTOUT); u16* wt_q = (u16*)(ws + WS_WTQ);
  u16* act = (u16*)(ws + WS_ACT); u16* proj = (u16*)(ws + WS_PROJ);
  int* idx = (int*)(ws + WS_IDX); float2* gu = (float2*)(ws + WS_SB); unsigned char* U8 = ws + WS_U8; unsigned char* V8 = ws + WS_V8;
  uint2* pw = (uint2*)(ws + WS_PW); float* uinv = (float*)(ws + WS_UINV); float* vinv = (float*)(ws + WS_VINV);
  float* rowss = (float*)(ws + WS_ROWSS);
  volatile LAS unsigned* misc = (volatile LAS unsigned*)(LAS unsigned char*)(smem + LDS_MISC);
  if (threadIdx.x < 8) misc[threadIdx.x] = 0u;
  __syncthreads();
  XcdBarrier bar = xcd_barrier_post((unsigned*)(ws + WS_CTL), misc);
  PG8_LAS unsigned char* lds = (PG8_LAS unsigned char*)smem;
  const int lo = p.ph_lo, hi = p.ph_hi;
#define IN(k) (lo <= (k) && (k) < hi)
#define SEAM(k) do { if (IN(k) && IN((k) + 1)) xcd_barrier(bar); } while (0)
  if (IN(0)) {
    transpose_convert(p.w_in, wt_in, D, DIN, nullptr, (float*)smem);
    transpose_convert(p.w_out, wt_out, D, D, nullptr, (float*)smem);
    transpose_convert(p.w_q, wt_q, D, 2048, p.norm2_g, (float*)smem);
    convert_fp4_rows<false>(p.peer_u, p.norm2_g, U8, uinv);
    convert_fp4_rows<true>(p.peer_v, nullptr, V8, vinv);
    rmsnorm1024(p.x, p.norm1_g, act);
    for (int i = blockIdx.x * NTHREADS + threadIdx.x; i < T; i += gridDim.x * NTHREADS) rowss[i] = 0.f;
    for (int i = blockIdx.x * NTHREADS + threadIdx.x; i < 2 * 32 * SEQ; i += gridDim.x * NTHREADS) ((float*)(ws + WS_SB + 16 * MBy))[i] = 0.f;
  }
  if (lo < 0) grid.sync();
  SEAM(0);
  u16* vt = (u16*)(ws + WS_SB);
  float* ssq = (float*)(ws + WS_SB + 16 * MBy);
  if (IN(1)) { pg8::Gemm g{act, wt_in, T, DIN, D}; pg8::StaticOrder S; S.init(T, DIN, gridDim.x, blockIdx.x);
    pg8::EpiInProj E{proj, vt, ssq}; pg8::gemm_phase<pg8::EpiInProj, pg8::StaticOrder>(lds, g, S, E, nullptr); }
  SEAM(1);
  if (IN(2)) { attn_phase(p, proj, vt, ssq, act, smem); conv_tokens(p, proj, act); }
  SEAM(2);
  if (IN(3)) { pg8::Gemm g{act, wt_out, T, D, D}; pg8::StaticOrder S; S.init(T, D, gridDim.x, blockIdx.x);
    pg8::EpiResid E{p.x, p.out, proj, rowss, D}; pg8::gemm_phase<pg8::EpiResid, pg8::StaticOrder>(lds, g, S, E, nullptr); }
  SEAM(3);
  u16* xb = proj;
  u16* qp = proj + (size_t)T * D;
  if (IN(4)) { pg8::Gemm g{xb, wt_q, T, 2048, D}; pg8::StaticOrder S; S.init(T, 2048, gridDim.x, blockIdx.x);
    pg8::EpiBf16S E{qp, 2048, rowss}; pg8::gemm_phase<pg8::EpiBf16S, pg8::StaticOrder>(lds, g, S, E, nullptr); }
  SEAM(4);
  if (IN(5)) topk_phase(p, qp, uinv, idx, gu, smem);
  SEAM(5);
  if (IN(6)) peer_u_phase(xb, rowss, idx, gu, U8, vinv, pw, smem);
  SEAM(6);
  if (IN(7)) peer_v_phase(pw, V8, xb, p.out, smem);
}

extern "C" void kernel_launch(void* const* d_in, const int* in_sizes, int n_in, void* d_out, int out_size, void* d_ws, size_t ws_size,
                              hipStream_t stream) {
  static int grid_blocks = 0;
  if (!grid_blocks) {
    int dev = 0, cus = 0, per_cu = 0;
    (void)hipGetDevice(&dev);
    (void)hipDeviceGetAttribute(&cus, hipDeviceAttributeMultiprocessorCount, dev);
    (void)hipFuncSetAttribute((const void*)fwd_kernel, hipFuncAttributeMaxDynamicSharedMemorySize, LDS_BYTES);
    (void)hipOccupancyMaxActiveBlocksPerMultiprocessor(&per_cu, fwd_kernel, NTHREADS, LDS_BYTES);
    if (per_cu < 1) per_cu = 1;
    if (per_cu > 1) per_cu = 1;
    grid_blocks = cus * per_cu;
  }
  Params p{};
  p.x = (const float*)d_in[0]; p.norm1_g = (const float*)d_in[1]; p.w_in = (const float*)d_in[2]; p.q_norm_g = (const float*)d_in[3];
  p.k_norm_g = (const float*)d_in[4]; p.conv_w = (const float*)d_in[5]; p.sb_out_g = (const float*)d_in[6]; p.conv_out_g = (const float*)d_in[7];
  p.w_out = (const float*)d_in[8]; p.norm2_g = (const float*)d_in[9]; p.w_q = (const float*)d_in[10]; p.sub_keys = (const float*)d_in[11];
  p.peer_u = (const float*)d_in[12]; p.peer_v = (const float*)d_in[13];
  p.out = (float*)d_out; p.ws = (unsigned char*)d_ws;
  p.ph_lo = 0; p.ph_hi = NPHASE;
  (void)hipMemsetAsync((unsigned char*)d_ws + WS_CTL, 0, 4096 * 4 + 8 * 64 * 4, stream);
  void* args[] = {&p};
  hipError_t e = hipLaunchCooperativeKernel((void*)fwd_kernel, dim3(grid_blocks), dim3(NTHREADS), args, LDS_BYTES, stream);
  if (e != hipSuccess) fprintf(stderr, "cooperative launch failed: %s (grid %d)\n", hipGetErrorString(e), grid_blocks);
}
```

```cpp
#include <hip/hip_runtime.h>
#include <hip/hip_cooperative_groups.h>
#include <cstdio>
#include <cstdint>
namespace cg = cooperative_groups;

typedef unsigned short u16;
#define DI __device__ __forceinline__
#define LAS __attribute__((address_space(3)))

constexpr int T = 16384, D = 1024, SEQ = 4096;
constexpr int DIN = 3072, DSB = 512;
constexpr int NEXP = 16384;
constexpr float EPS = 1e-6f;
constexpr int NWAVES = 8, NTHREADS = NWAVES * 64;

namespace pg8 {
#define PG8_LAS __attribute__((address_space(3)))
typedef unsigned short bf16_t;
typedef short bf16x8 __attribute__((ext_vector_type(8)));
typedef float f32x4 __attribute__((ext_vector_type(4)));
typedef unsigned u32x4 __attribute__((ext_vector_type(4)));
constexpr int BM = 256, BK = 64, HALF = 128, HTB = HALF * BK * 2  , STAGE_BYTES = 8 * HTB, NXCD = 8, WGM = 8;

__host__ __device__ __forceinline__ int lds_byte(int r, int c) { const int st = (r >> 4) * 2 + (c >> 5), rr = r & 15, cc = c & 31, ob = rr * 64 + cc * 2; return st * 1024 + (ob ^ (((ob >> 9) & 1) << 5)); }
__host__ __device__ __forceinline__ void stage_rc(int b, int& R, int& C) { const int st = b / 1024, sb = b % 1024, swz = sb ^ (((sb >> 9) & 1) << 5); R = (st >> 1) * 16 + swz / 64; C = (st & 1) * 32 + (swz % 64) / 2; }
__host__ __device__ __forceinline__ int perm32(int rho) { const int n = rho >> 4, i = rho & 15; return 8 * (i >> 2) + 4 * n + (i & 3); }

struct Unit { int pm, pn; };
struct Gemm { const bf16_t* A; const bf16_t* Bt; int M, N, K; };
struct StaticOrder {
    int nM, nN, nwg, G, c;
    __host__ __device__ void init(int M, int N, int G_, int c_) { nM = M / BM; nN = N / BM; nwg = nM * nN; G = G_; c = c_; }
    __host__ __device__ bool next(int i, Unit& u) const {
        const long L = (long)i * G + c; if (L >= nwg) return false;
        int wgid = (int)L; { const int q = nwg / NXCD, r = nwg % NXCD, xcd = wgid % NXCD, off = wgid / NXCD; wgid = (xcd < r ? xcd * (q + 1) : r * (q + 1) + (xcd - r) * q) + off; }
        const int nig = WGM * nN, gid = wgid / nig, fm = gid * WGM, gsz = (nM - fm) < WGM ? (nM - fm) : WGM;
        u.pm = fm + ((wgid % nig) % gsz); u.pn = (wgid % nig) / gsz; return true;
    }
    __device__ __forceinline__ void a_ready(const Unit&) const {}
    __device__ __forceinline__ void done(const Unit&) const {}
};
__device__ __forceinline__ unsigned cvt_pk_bf16(float lo, float hi) { unsigned r; asm volatile("v_cvt_pk_bf16_f32 %0, %1, %2" : "=v"(r) : "v"(lo), "v"(hi)); return r; }

struct EpiBf16S {
    static constexpr bool PERM = true, AFTER_DRAIN = false;
    bf16_t* O; int ldc; const float* rowss;
    __device__ __forceinline__ void operator()(const f32x4 (&acc)[2][2][4][2], const Unit& u, int wr, int wc, int fr, int fq) const {
        const int row0 = u.pm * BM + wr * 64 + fr, col0 = u.pn * BM + wc * 32 + 8 * fq;
#pragma unroll
        for (int ai = 0; ai < 2; ++ai)
#pragma unroll
            for (int m = 0; m < 4; ++m) { const int row = row0 + ai * HALF + m * 16; bf16_t* rowp = O + (size_t)row * ldc + col0;
                const float sc = rowss ? rsqrtf(rowss[row] * (1.f / 1024.f) + 1e-6f) : 1.f;
#pragma unroll
                for (int bj = 0; bj < 2; ++bj) { const f32x4 v0 = acc[ai][bj][m][0] * sc, v1 = acc[ai][bj][m][1] * sc;
                    u32x4 w; w.x = cvt_pk_bf16(v0[0], v0[1]); w.y = cvt_pk_bf16(v0[2], v0[3]); w.z = cvt_pk_bf16(v1[0], v1[1]); w.w = cvt_pk_bf16(v1[2], v1[3]);
                    *(u32x4*)(rowp + bj * HALF) = w; } }
    }
};
struct EpiInProj {
    static constexpr bool PERM = true, AFTER_DRAIN = false;
    bf16_t* O; bf16_t* vt; float* ssq;
    __device__ __forceinline__ void operator()(const f32x4 (&acc)[2][2][4][2], const Unit& u, int wr, int wc, int fr, int fq) const {
        const int row0 = u.pm * BM + wr * 64 + fr, col0 = u.pn * BM + wc * 32 + 8 * fq, kind = u.pn >> 1;
#pragma unroll
        for (int ai = 0; ai < 2; ++ai)
#pragma unroll
            for (int m = 0; m < 4; ++m) { const int row = row0 + ai * HALF + m * 16; const int bb = row >> 12, ss = row & 4095;
#pragma unroll
                for (int bj = 0; bj < 2; ++bj) { const f32x4 v0 = acc[ai][bj][m][0], v1 = acc[ai][bj][m][1];
                    if (kind != 2) {
                        u32x4 w; w.x = cvt_pk_bf16(v0[0], v0[1]); w.y = cvt_pk_bf16(v0[2], v0[3]); w.z = cvt_pk_bf16(v1[0], v1[1]); w.w = cvt_pk_bf16(v1[2], v1[3]);
                        *(u32x4*)(O + (size_t)row * 3072 + col0 + bj * HALF) = w;
                        if (kind < 2) {
                            float sq = v0[0] * v0[0] + v0[1] * v0[1] + v0[2] * v0[2] + v0[3] * v0[3] + v1[0] * v1[0] + v1[1] * v1[1] + v1[2] * v1[2] + v1[3] * v1[3];
                            sq += __shfl_xor(sq, 16); sq += __shfl_xor(sq, 32);
                            const int head = (u.pn & 1) * 4 + bj * 2 + (wc >> 1);
                            if (fq == 0) unsafeAtomicAdd(ssq + ((size_t)(kind * 32 + bb * 8 + head)) * 4096 + ss, sq);
                        }
                    } else {
                        const int d0 = (u.pn & 1) * 256 + bj * HALF + wc * 32 + 8 * fq;
                        bf16_t* vp = vt + ((size_t)(bb * 512 + d0)) * 4096 + ss;
                        const unsigned w0 = cvt_pk_bf16(v0[0], v0[1]), w1 = cvt_pk_bf16(v0[2], v0[3]), w2 = cvt_pk_bf16(v1[0], v1[1]), w3 = cvt_pk_bf16(v1[2], v1[3]);
                        vp[0] = (bf16_t)w0; vp[4096] = (bf16_t)(w0 >> 16); vp[2 * 4096] = (bf16_t)w1; vp[3 * 4096] = (bf16_t)(w1 >> 16);
                        vp[4 * 4096] = (bf16_t)w2; vp[5 * 4096] = (bf16_t)(w2 >> 16); vp[6 * 4096] = (bf16_t)w3; vp[7 * 4096] = (bf16_t)(w3 >> 16);
                    } } }
    }
};
struct EpiResid {
    static constexpr bool PERM = true, AFTER_DRAIN = false;
    const float* resid; float* out32; bf16_t* xb; float* rowss; int ldc;
    __device__ __forceinline__ void operator()(const f32x4 (&acc)[2][2][4][2], const Unit& u, int wr, int wc, int fr, int fq) const {
        const int row0 = u.pm * BM + wr * 64 + fr, col0 = u.pn * BM + wc * 32 + 8 * fq;
#pragma unroll
        for (int ai = 0; ai < 2; ++ai)
#pragma unroll
            for (int m = 0; m < 4; ++m) { const int row = row0 + ai * HALF + m * 16; const size_t off = (size_t)row * ldc + col0; float ss = 0.f;
#pragma unroll
                for (int bj = 0; bj < 2; ++bj) {
                    const f32x4 r0 = *(const f32x4*)(resid + off + bj * HALF), r1 = *(const f32x4*)(resid + off + bj * HALF + 4);
                    const f32x4 o0 = r0 + acc[ai][bj][m][0], o1 = r1 + acc[ai][bj][m][1];
                    ss += o0[0] * o0[0] + o0[1] * o0[1] + o0[2] * o0[2] + o0[3] * o0[3] + o1[0] * o1[0] + o1[1] * o1[1] + o1[2] * o1[2] + o1[3] * o1[3];
                    u32x4 w; w.x = cvt_pk_bf16(o0[0], o0[1]); w.y = cvt_pk_bf16(o0[2], o0[3]); w.z = cvt_pk_bf16(o1[0], o1[1]); w.w = cvt_pk_bf16(o1[2], o1[3]);
                    *(u32x4*)(xb + off + bj * HALF) = w; }
                ss += __shfl_xor(ss, 16); ss += __shfl_xor(ss, 32);
                if (fq == 0) unsafeAtomicAdd(rowss + row, ss); }
    }
};
template <class Epi, class Sched, bool STAMP = false>
__device__ __forceinline__ void gemm_phase(PG8_LAS unsigned char* lds, const Gemm g, const Sched& S, const Epi& E, unsigned long long* stamps) {
    const int tid = threadIdx.x, wid = __builtin_amdgcn_readfirstlane(tid >> 6), lane = tid & 63, wr = wid >> 2, wc = wid & 3, fr = lane & 15, fq = lane >> 4;
    const int K = g.K, nt = K / BK;
    int ts_lo = 0, ts_hi = 0, nts = 0; const unsigned long long rt_entry = STAMP ? (unsigned long long)wall_clock64() : 0ull;
#define PG8_STAMP() do { if (STAMP && wid == 0 && nts < 64) { const unsigned long long _c = (unsigned long long)clock64(); \
        ts_lo = (lane == nts) ? (int)(unsigned)_c : ts_lo; ts_hi = (lane == nts) ? (int)(unsigned)(_c >> 32) : ts_hi; ++nts; } } while (0)
    PG8_STAMP();
    unsigned voffA[2], voffB[2];
#pragma unroll
    for (int i = 0; i < 2; ++i) { int R, C; stage_rc(tid * 16 + i * 8192, R, C); const int Rb = Epi::PERM ? ((R & ~31) + perm32(R & 31)) : R;
        voffA[i] = (unsigned)(R * K + C) * 2u; voffB[i] = (unsigned)(Rb * K + C) * 2u; }
    const size_t kstep = (size_t)(BK * 2);
    const size_t hstep = (size_t)HALF * K * 2;
    const size_t tstep = 2 * hstep;
    const unsigned ldsw = (unsigned)wid * 1024u;
    const int aoff = lds_byte(wr * 64 + fr, fq * 8), boff = lds_byte(wc * 32 + fr, fq * 8);
#define PG8_SA(b, h) (((b) * 2 + (h)) * HTB)
#define PG8_SB(b, h) ((4 + (b) * 2 + (h)) * HTB)
#define PG8_STAGE(bufoff, gbase, voff) do { _Pragma("unroll") for (int _i = 0; _i < 2; ++_i) \
        __builtin_amdgcn_global_load_lds((const unsigned*)((const char*)(gbase) + (voff)[_i]), (PG8_LAS unsigned*)(lds + (bufoff) + ldsw + _i * 8192), 16, 0, 0); } while (0)
#define PG8_LDA(dst, b, h) do { _Pragma("unroll") for (int m = 0; m < 4; ++m) _Pragma("unroll") for (int k = 0; k < 2; ++k) dst[m][k] = *(const PG8_LAS bf16x8*)(lds + PG8_SA(b, h) + aoff + m * 2048 + k * 1024); } while (0)
#define PG8_LDB(dst, b, h) do { _Pragma("unroll") for (int n = 0; n < 2; ++n) _Pragma("unroll") for (int k = 0; k < 2; ++k) dst[n][k] = *(const PG8_LAS bf16x8*)(lds + PG8_SB(b, h) + boff + n * 2048 + k * 1024); } while (0)
#define PG8_MMA(ai, bj, At, Bt) do { __builtin_amdgcn_s_setprio(1); _Pragma("unroll") for (int m = 0; m < 4; ++m) _Pragma("unroll") for (int n = 0; n < 2; ++n) _Pragma("unroll") for (int k = 0; k < 2; ++k) \
        acc[ai][bj][m][n] = __builtin_amdgcn_mfma_f32_16x16x32_bf16(Bt[n][k], At[m][k], acc[ai][bj][m][n], 0, 0, 0); __builtin_amdgcn_s_setprio(0); } while (0)
#define PG8_WAIT_V(n) asm volatile("s_waitcnt vmcnt(" #n ")" ::: "memory")
#define PG8_WAIT_L(n) asm volatile("s_waitcnt lgkmcnt(" #n ")" ::: "memory")
#define PG8_BAR __builtin_amdgcn_s_barrier()
#define PG8_SCHED __builtin_amdgcn_sched_barrier(0)
    Unit cur, nxt; int ui = 0;
    if (!S.next(0, cur)) return;
    f32x4 acc[2][2][4][2];
#pragma unroll
    for (int a = 0; a < 2; ++a)
#pragma unroll
        for (int b = 0; b < 2; ++b)
#pragma unroll
            for (int m = 0; m < 4; ++m)
#pragma unroll
                for (int n = 0; n < 2; ++n) acc[a][b][m][n] = (f32x4){0.f, 0.f, 0.f, 0.f};
    bf16x8 At[4][2], B0[2][2], B1[2][2];
    const char* cA = (const char*)g.A + (size_t)cur.pm * tstep; const char* cB = (const char*)g.Bt + (size_t)cur.pn * tstep;
    S.a_ready(cur);
    PG8_STAGE(PG8_SB(0, 0), cB, voffB); PG8_STAGE(PG8_SA(0, 0), cA, voffA); PG8_STAGE(PG8_SB(0, 1), cB + hstep, voffB); PG8_STAGE(PG8_SA(0, 1), cA + hstep, voffA);
    if (wr == 1) PG8_BAR;
    PG8_WAIT_V(4); PG8_BAR;
    PG8_STAGE(PG8_SB(1, 0), cB + kstep, voffB); PG8_STAGE(PG8_SA(1, 0), cA + kstep, voffA); PG8_STAGE(PG8_SB(1, 1), cB + hstep + kstep, voffB);
    PG8_WAIT_V(6); PG8_BAR;
    PG8_STAMP();
    for (;;) {
        const bool has_next = S.next(ui + 1, nxt);
        const char* nA = has_next ? (const char*)g.A + (size_t)nxt.pm * tstep : cA; const char* nB = has_next ? (const char*)g.Bt + (size_t)nxt.pn * tstep : cB;
        for (int t = 0; t < nt; t += 2) {
            const bool last = (t == nt - 2);
            const char* a1 = cA + (size_t)(t + 1) * kstep;
            const char* a2 = last ? nA : cA + (size_t)(t + 2) * kstep; const char* b2 = last ? nB : cB + (size_t)(t + 2) * kstep;
            const char* a3 = a2 + kstep; const char* b3 = b2 + kstep;
            if (last && has_next) S.a_ready(nxt);
            PG8_LDB(B0, 0, 0); PG8_SCHED; PG8_LDA(At, 0, 0); PG8_STAGE(PG8_SA(1, 1), a1 + hstep, voffA);
            PG8_WAIT_L(8); PG8_BAR; PG8_WAIT_L(0); PG8_MMA(0, 0, At, B0); PG8_BAR; PG8_SCHED;
            PG8_LDB(B1, 0, 1); PG8_STAGE(PG8_SB(0, 0), b2, voffB);
            PG8_BAR; PG8_WAIT_L(0); PG8_MMA(0, 1, At, B1); PG8_BAR;
            PG8_LDA(At, 0, 1); PG8_STAGE(PG8_SA(0, 0), a2, voffA);
            PG8_BAR; PG8_WAIT_L(0); PG8_MMA(1, 0, At, B0); PG8_BAR; PG8_SCHED;
            PG8_STAGE(PG8_SB(0, 1), b2 + hstep, voffB);
            PG8_WAIT_V(6); PG8_BAR; PG8_MMA(1, 1, At, B1); PG8_BAR;
            PG8_LDB(B0, 1, 0); PG8_SCHED; PG8_LDA(At, 1, 0); PG8_STAGE(PG8_SA(0, 1), a2 + hstep, voffA);
            PG8_WAIT_L(8); PG8_BAR; PG8_WAIT_L(0); PG8_MMA(0, 0, At, B0); PG8_BAR; PG8_SCHED;
            PG8_LDB(B1, 1, 1); PG8_STAGE(PG8_SB(1, 0), b3, voffB);
            PG8_BAR; PG8_WAIT_L(0); PG8_MMA(0, 1, At, B1); PG8_BAR;
            PG8_LDA(At, 1, 1); PG8_STAGE(PG8_SA(1, 0), a3, voffA);
            PG8_BAR; PG8_WAIT_L(0); PG8_MMA(1, 0, At, B0); PG8_BAR; PG8_SCHED;
            PG8_STAGE(PG8_SB(1, 1), b3 + hstep, voffB);
            PG8_WAIT_V(6); PG8_BAR; PG8_MMA(1, 1, At, B1); PG8_BAR;
        }
        PG8_STAMP();
        if constexpr (!Epi::AFTER_DRAIN) { E(acc, cur, wr, wc, fr, fq); S.done(cur); }
        PG8_STAMP();
        if (!has_next) break;
#pragma unroll
        for (int a = 0; a < 2; ++a)
#pragma unroll
            for (int b = 0; b < 2; ++b)
#pragma unroll
                for (int m = 0; m < 4; ++m)
#pragma unroll
                    for (int n = 0; n < 2; ++n) acc[a][b][m][n] = (f32x4){0.f, 0.f, 0.f, 0.f};
        cur = nxt; cA = nA; cB = nB; ++ui;
    }
    PG8_WAIT_V(0);
    if (wr == 0) PG8_BAR;
    PG8_BAR;
    if constexpr (Epi::AFTER_DRAIN) { E.fused(acc, cur, wr, wc, fr, fq, lds, wid, lane); S.done(cur); }
    PG8_STAMP();
    if (STAMP && wid == 0) { stamps[lane] = lane < nts ? (((unsigned long long)(unsigned)ts_hi << 32) | (unsigned)ts_lo) : 0ull;
        if (lane == 62) stamps[62] = rt_entry; if (lane == 63) stamps[63] = (unsigned long long)wall_clock64(); }
#undef PG8_STAMP
#undef PG8_SA
#undef PG8_SB
#undef PG8_STAGE
#undef PG8_LDA
#undef PG8_LDB
#undef PG8_MMA
#undef PG8_WAIT_V
#undef PG8_WAIT_L
#undef PG8_BAR
#undef PG8_SCHED
}
}


constexpr size_t MBy = 1u << 20;
constexpr size_t WS_WTIN = 0, WS_WTOUT = 6 * MBy, WS_WTQ = 8 * MBy, WS_CTL = 12 * MBy, WS_ROWSS = 12 * MBy + 65536, WS_ACT = 13 * MBy, WS_PROJ = 45 * MBy,
                 WS_SB = 141 * MBy, WS_IDX = 173 * MBy, WS_GATE = 181 * MBy, WS_U8 = 189 * MBy, WS_V8 = 205 * MBy, WS_PW = 221 * MBy,
                 WS_UINV = 12 * MBy + 262144, WS_VINV = 12 * MBy + 393216;
constexpr int VIMP = 136, VWAVE = 128 * VIMP + 2048;
constexpr int LDS_MISC = 8 * VWAVE, LDS_BYTES = 8 * VWAVE + 256;
static_assert(LDS_MISC >= pg8::STAGE_BYTES && LDS_BYTES <= 163840, "LDS budget");

struct Params {
  const float *x, *norm1_g, *w_in, *q_norm_g, *k_norm_g, *conv_w, *sb_out_g, *conv_out_g, *w_out, *norm2_g, *w_q, *sub_keys, *peer_u, *peer_v;
  float* out; unsigned char* ws; int ph_lo, ph_hi;
};

#define XB_TMO      128
#define XB_XCNT(j)  (256  + 64 * (j))
#define XB_XSUB(j)  (1280 + 64 * (j))
#define XB_XGEN(j)  (2304 + 64 * (j))
#define XB_TOP      3328
#define XB_TOPGEN   3392
#define XCD_BAR_WORDS 3456
#define XB_SPIN_CAP (1u << 18)
DI unsigned xb_ld(unsigned* p) { return __hip_atomic_load(p, __ATOMIC_RELAXED, __HIP_MEMORY_SCOPE_AGENT); }
DI unsigned xb_add(unsigned* p, unsigned v) { return __hip_atomic_fetch_add(p, v, __ATOMIC_RELAXED, __HIP_MEMORY_SCOPE_AGENT); }
DI unsigned xb_xcc_id() { return (unsigned)__builtin_amdgcn_s_getreg((3 << 11) | 20) & 0xFu; }
#define XB_SPIN(cond, bar) do { unsigned _sp = 0; while (cond) { __builtin_amdgcn_s_sleep(1); \
    if ((++_sp & 255u) == 0u) { if (xb_ld(&(bar)[XB_TMO])) break; if (_sp > XB_SPIN_CAP) { atomicAdd(&(bar)[XB_TMO], 1u); break; } } } } while (0)
struct XcdBarrier { unsigned* bar; unsigned x; volatile LAS unsigned* st; };
DI XcdBarrier xcd_barrier_post(unsigned* bar, volatile LAS unsigned* st) {
  XcdBarrier b; b.bar = bar; b.x = xb_xcc_id(); b.st = st;
  if (threadIdx.x == 0) (void)xb_add(&bar[XB_XCNT(b.x)], 1u);
  return b;
}
DI void xcd_barrier_complete(unsigned* bar, unsigned x, unsigned& nloc, unsigned& nx) {
  const unsigned G = gridDim.x * gridDim.y * gridDim.z;
  unsigned sum, cnt, mine, sp = 0u;
  for (;;) {
    sum = 0u; cnt = 0u; mine = 0u;
#pragma unroll
    for (unsigned j = 0; j < 16; ++j) { const unsigned c = xb_ld(&bar[XB_XCNT(j)]); sum += c; cnt += (c > 0u) ? 1u : 0u; mine = (j == x) ? c : mine; }
    if (sum == G) break;
    __builtin_amdgcn_s_sleep(1);
    if ((++sp & 255u) == 0u) { if (xb_ld(&bar[XB_TMO])) break; if (sp > XB_SPIN_CAP) { atomicAdd(&bar[XB_TMO], 1u); break; } }
  }
  nloc = mine > 0u ? mine : 1u; nx = cnt > 0u ? cnt : 1u;
}
DI void xcd_barrier(const XcdBarrier& b) {
  asm volatile("s_waitcnt vmcnt(0)" ::: "memory");
  __syncthreads();
  if (threadIdx.x == 0) {
    unsigned* bar = b.bar;
    __builtin_amdgcn_s_waitcnt(0);
    unsigned nloc = b.st[0], nx = b.st[1];
    if (nloc == 0u) { xcd_barrier_complete(bar, b.x, nloc, nx); b.st[0] = nloc; b.st[1] = nx; }
    const unsigned old = xb_add(&bar[XB_XSUB(b.x)], 1u);
    const unsigned gen = old / nloc;
    if (old + 1u == (gen + 1u) * nloc) {
      __builtin_amdgcn_fence(__ATOMIC_RELEASE, "agent");
      asm volatile("s_waitcnt vmcnt(0)" ::: "memory");
      const unsigned og = xb_add(&bar[XB_TOP], 1u);
      const unsigned tg = og / nx;
      if (og + 1u == (tg + 1u) * nx) xb_add(&bar[XB_TOPGEN], 1u);
      else XB_SPIN(xb_ld(&bar[XB_TOPGEN]) == tg, bar);
      __builtin_amdgcn_fence(__ATOMIC_ACQUIRE, "agent");
      xb_add(&bar[XB_XGEN(b.x)], 1u);
      asm volatile("s_waitcnt vmcnt(0)" ::: "memory");
    } else {
      XB_SPIN(xb_ld(&bar[XB_XGEN(b.x)]) == gen, bar);
      __builtin_amdgcn_fence(__ATOMIC_ACQUIRE, "agent");
      asm volatile("s_waitcnt vmcnt(0)" ::: "memory");
    }
  }
  __syncthreads();
}

DI u16 f2bf(float x) { unsigned u = __float_as_uint(x); u += 0x7fffu + ((u >> 16) & 1u); return (u16)(u >> 16); }
DI float bflo(unsigned w) { return __uint_as_float(w << 16); }
DI float bfhi(unsigned w) { return __uint_as_float(w & 0xffff0000u); }
DI unsigned pack2(float a, float b) { return (unsigned)f2bf(a) | ((unsigned)f2bf(b) << 16); }
DI float wave_sum(float v) {
#pragma unroll
  for (int o = 32; o >= 1; o >>= 1) v += __shfl_xor(v, o);
  return v;
}
DI float wave_max(float v) {
#pragma unroll
  for (int o = 32; o >= 1; o >>= 1) v = fmaxf(v, __shfl_xor(v, o));
  return v;
}
DI void unpack8(const uint4 w, float* f) {
  f[0] = bflo(w.x); f[1] = bfhi(w.x); f[2] = bflo(w.y); f[3] = bfhi(w.y); f[4] = bflo(w.z); f[5] = bfhi(w.z); f[6] = bflo(w.w); f[7] = bfhi(w.w);
}
DI uint4 pack8(const float* f) { uint4 o; o.x = pack2(f[0], f[1]); o.y = pack2(f[2], f[3]); o.z = pack2(f[4], f[5]); o.w = pack2(f[6], f[7]); return o; }

DI void transpose_convert(const float* __restrict__ W, u16* __restrict__ Wt, int K, int N, const float* __restrict__ rg, float* sm) {
  const int tid = threadIdx.x, tn_cnt = N / 64, ntile = (K / 64) * tn_cnt;
  for (int tile = blockIdx.x; tile < ntile; tile += gridDim.x) {
    const int tk = tile / tn_cnt, tn = tile % tn_cnt;
    __syncthreads();
#pragma unroll
    for (int r = 0; r < 2; ++r) { const int row = r * 32 + (tid >> 4), c4 = (tid & 15) * 4;
      const float g = rg ? rg[tk * 64 + row] : 1.f;
      const float4 v = *(const float4*)(W + (size_t)(tk * 64 + row) * N + tn * 64 + c4);
      sm[row * 65 + c4] = v.x * g; sm[row * 65 + c4 + 1] = v.y * g; sm[row * 65 + c4 + 2] = v.z * g; sm[row * 65 + c4 + 3] = v.w * g; }
    __syncthreads();
    { const int n = tid & 63, k0 = (tid >> 6) * 8;
      float f[8];
#pragma unroll
      for (int j = 0; j < 8; ++j) f[j] = sm[(k0 + j) * 65 + n];
      *(uint4*)(Wt + (size_t)(tn * 64 + n) * K + tk * 64 + k0) = pack8(f); }
  }
}
template <bool SLICED>
DI void convert_fp4_rows(const float* __restrict__ src, const float* __restrict__ cg, unsigned char* __restrict__ dst, float* __restrict__ inv_out) {
  const int lane = threadIdx.x & 63, gw = blockIdx.x * NWAVES + (threadIdx.x >> 6), nw = gridDim.x * NWAVES;
  float4 g[4];
#pragma unroll
  for (int k = 0; k < 4; ++k) g[k] = cg ? ((const float4*)cg)[lane + 64 * k] : make_float4(1.f, 1.f, 1.f, 1.f);
  for (int row0 = gw * 4; row0 < NEXP; row0 += nw * 4) {
    float4 a[4][4];
#pragma unroll
    for (int rr = 0; rr < 4; ++rr)
#pragma unroll
      for (int k = 0; k < 4; ++k) a[rr][k] = ((const float4*)(src + (size_t)(row0 + rr) * D))[lane + 64 * k];
#pragma unroll
    for (int rr = 0; rr < 4; ++rr) {
      float am = 0.f;
#pragma unroll
      for (int k = 0; k < 4; ++k) { a[rr][k].x *= g[k].x; a[rr][k].y *= g[k].y; a[rr][k].z *= g[k].z; a[rr][k].w *= g[k].w;
        am = fmaxf(fmaxf(am, fmaxf(fabsf(a[rr][k].x), fabsf(a[rr][k].y))), fmaxf(fabsf(a[rr][k].z), fabsf(a[rr][k].w))); }
      am = wave_max(am);
      const float sc = am > 0.f ? 6.f / am : 1.f;
      const int row = row0 + rr;
#pragma unroll
      for (int k = 0; k < 4; ++k) {
        unsigned w = 0u;
        w = __builtin_amdgcn_cvt_scalef32_pk_fp4_f32(w, a[rr][k].x * sc, a[rr][k].y * sc, 1.0f, 0); w = __builtin_amdgcn_cvt_scalef32_pk_fp4_f32(w, a[rr][k].z * sc, a[rr][k].w * sc, 1.0f, 1);
        if (SLICED) *(u16*)(dst + (size_t)k * ((size_t)NEXP * 128) + (size_t)row * 128 + 2 * lane) = (u16)w;
        else *(u16*)(dst + (size_t)row * 512 + 128 * k + 2 * lane) = (u16)w;
      }
      if (lane == 0) inv_out[row] = am > 0.f ? am * (1.f / 6.f) : 1.f;
    }
  }
}
DI void rmsnorm1024(const float* __restrict__ src, const float* __restrict__ g, u16* __restrict__ dst) {
  const int lane = threadIdx.x & 63, gw = blockIdx.x * NWAVES + (threadIdx.x >> 6), nw = gridDim.x * NWAVES;
  float4 gg[4];
#pragma unroll
  for (int j = 0; j < 4; ++j) gg[j] = ((const float4*)g)[lane + 64 * j];
  for (int row0 = gw * 4; row0 < T; row0 += nw * 4) {
    float4 v[4][4];
#pragma unroll
    for (int rr = 0; rr < 4; ++rr)
#pragma unroll
      for (int j = 0; j < 4; ++j) v[rr][j] = ((const float4*)(src + (size_t)(row0 + rr) * D))[lane + 64 * j];
#pragma unroll
    for (int rr = 0; rr < 4; ++rr) {
      float ss = 0.f;
#pragma unroll
      for (int j = 0; j < 4; ++j) ss += v[rr][j].x * v[rr][j].x + v[rr][j].y * v[rr][j].y + v[rr][j].z * v[rr][j].z + v[rr][j].w * v[rr][j].w;
      ss = wave_sum(ss);
      const float inv = rsqrtf(ss * (1.f / D) + EPS);
#pragma unroll
      for (int j = 0; j < 4; ++j) {
        uint2 o; o.x = pack2(v[rr][j].x * inv * gg[j].x, v[rr][j].y * inv * gg[j].y); o.y = pack2(v[rr][j].z * inv * gg[j].z, v[rr][j].w * inv * gg[j].w);
        *(uint2*)(dst + (size_t)(row0 + rr) * D + 4 * (lane + 64 * j)) = o;
      }
    }
  }
}

DI void conv_tokens(const Params& p, const u16* __restrict__ proj, u16* __restrict__ mixed) {
  const int lane = threadIdx.x & 63, gw = blockIdx.x * NWAVES + (threadIdx.x >> 6), nw = gridDim.x * NWAVES;
  const int c0 = 8 * lane;
  float w0[8], w1[8], w2[8], go[8];
#pragma unroll
  for (int j = 0; j < 8; ++j) { w0[j] = p.conv_w[c0 + j]; w1[j] = p.conv_w[DSB + c0 + j]; w2[j] = p.conv_w[2 * DSB + c0 + j]; go[j] = p.conv_out_g[c0 + j]; }
#pragma unroll 2
  for (int t = gw; t < T; t += nw) {
    const u16* row = proj + (size_t)t * DIN;
    const int tpos = t & (SEQ - 1);
    float xc[8], bg[8], cg[8], y[8];
    unpack8(*(const uint4*)(row + 1536 + c0), xc); unpack8(*(const uint4*)(row + 2048 + c0), bg); unpack8(*(const uint4*)(row + 2560 + c0), cg);
#pragma unroll
    for (int j = 0; j < 8; ++j) y[j] = w2[j] * (cg[j] * xc[j]);
    if (tpos >= 1) {
      float x1[8], c1[8]; unpack8(*(const uint4*)(row - DIN + 1536 + c0), x1); unpack8(*(const uint4*)(row - DIN + 2560 + c0), c1);
#pragma unroll
      for (int j = 0; j < 8; ++j) y[j] += w1[j] * (c1[j] * x1[j]);
    }
    if (tpos >= 2) {
      float x2[8], c2[8]; unpack8(*(const uint4*)(row - 2 * DIN + 1536 + c0), x2); unpack8(*(const uint4*)(row - 2 * DIN + 2560 + c0), c2);
#pragma unroll
      for (int j = 0; j < 8; ++j) y[j] += w0[j] * (c2[j] * x2[j]);
    }
    float ss = 0.f;
#pragma unroll
    for (int j = 0; j < 8; ++j) { y[j] *= bg[j]; ss += y[j] * y[j]; }
    ss = wave_sum(ss);
    const float inv = rsqrtf(ss * (1.f / DSB) + EPS);
#pragma unroll
    for (int j = 0; j < 8; ++j) y[j] = y[j] * inv * go[j];
    *(uint4*)(mixed + (size_t)t * D + DSB + c0) = pack8(y);
  }
}

typedef float f32x16_t __attribute__((ext_vector_type(16)));
typedef short bf16x8_t __attribute__((ext_vector_type(8)));
DI bf16x8_t pack_bf16x8(float a0, float a1, float a2, float a3, float a4, float a5, float a6, float a7) {
  pg8::u32x4 r;
  asm volatile("v_cvt_pk_bf16_f32 %0, %4, %5\n\tv_cvt_pk_bf16_f32 %1, %6, %7\n\tv_cvt_pk_bf16_f32 %2, %8, %9\n\tv_cvt_pk_bf16_f32 %3, %10, %11\n\ts_nop 1"
               : "=&v"(r[0]), "=&v"(r[1]), "=&v"(r[2]), "=&v"(r[3]) : "v"(a0), "v"(a1), "v"(a2), "v"(a3), "v"(a4), "v"(a5), "v"(a6), "v"(a7));
  return __builtin_bit_cast(bf16x8_t, r);
}
struct AttnKV { bf16x8_t k0, k1, k2, k3, v00, v01, v10, v11; float ik[16]; };
DI void attn_load(AttnKV& f, const u16* __restrict__ kr, const u16* __restrict__ vr, const float* __restrict__ ksq) {
  f.k0 = *(const bf16x8_t*)(kr); f.k1 = *(const bf16x8_t*)(kr + 16); f.k2 = *(const bf16x8_t*)(kr + 32); f.k3 = *(const bf16x8_t*)(kr + 48);
  f.v00 = *(const bf16x8_t*)(vr); f.v01 = *(const bf16x8_t*)(vr + 8); f.v10 = *(const bf16x8_t*)(vr + 32 * SEQ); f.v11 = *(const bf16x8_t*)(vr + 32 * SEQ + 8);
#pragma unroll
  for (int r4 = 0; r4 < 4; ++r4) { const float4 q4 = ((const float4*)ksq)[r4];
    f.ik[4 * r4] = rsqrtf(q4.x * (1.f / 64.f) + EPS); f.ik[4 * r4 + 1] = rsqrtf(q4.y * (1.f / 64.f) + EPS); f.ik[4 * r4 + 2] = rsqrtf(q4.z * (1.f / 64.f) + EPS); f.ik[4 * r4 + 3] = rsqrtf(q4.w * (1.f / 64.f) + EPS); }
}
template <bool DIAG>
DI void attn_half(const AttnKV& f, const bf16x8_t (&qf)[4], int c, int hh, float& carry, f32x16_t& o0, f32x16_t& o1) {
  f32x16_t s;
#pragma unroll
  for (int r = 0; r < 16; ++r) s[r] = 0.f;
  s = __builtin_amdgcn_mfma_f32_32x32x16_bf16(f.k0, qf[0], s, 0, 0, 0); s = __builtin_amdgcn_mfma_f32_32x32x16_bf16(f.k1, qf[1], s, 0, 0, 0);
  s = __builtin_amdgcn_mfma_f32_32x32x16_bf16(f.k2, qf[2], s, 0, 0, 0); s = __builtin_amdgcn_mfma_f32_32x32x16_bf16(f.k3, qf[3], s, 0, 0, 0);
  float rr[16], be[16];
#pragma unroll
  for (int r = 0; r < 16; ++r) {
    const float e = __builtin_amdgcn_exp2f(fminf(s[r] * f.ik[r] * 0.18033688011112042f, 100.f));
    float x = __builtin_amdgcn_rcpf(1.f + e), b = e * x;
    if (DIAG) { const bool on = (16 * hh + r) < c; x = on ? x : 1.f; b = on ? b : 0.f; }
    rr[r] = x; be[r] = b;
  }
  float tot = ((rr[0] * rr[1]) * (rr[2] * rr[3])) * ((rr[4] * rr[5]) * (rr[6] * rr[7]));
  tot *= ((rr[8] * rr[9]) * (rr[10] * rr[11])) * ((rr[12] * rr[13]) * (rr[14] * rr[15]));
  const float oth = __shfl_xor(tot, 32);
  float P = hh ? carry : carry * oth;
  float a[16];
#pragma unroll
  for (int r = 15; r >= 0; --r) { a[r] = be[r] * P; P *= rr[r]; }
  carry = carry * tot * oth;
  const bf16x8_t af0 = pack_bf16x8(a[0], a[1], a[2], a[3], a[4], a[5], a[6], a[7]), af1 = pack_bf16x8(a[8], a[9], a[10], a[11], a[12], a[13], a[14], a[15]);
  o0 = __builtin_amdgcn_mfma_f32_32x32x16_bf16(f.v00, af0, o0, 0, 0, 0); o0 = __builtin_amdgcn_mfma_f32_32x32x16_bf16(f.v01, af1, o0, 0, 0, 0);
  o1 = __builtin_amdgcn_mfma_f32_32x32x16_bf16(f.v10, af0, o1, 0, 0, 0); o1 = __builtin_amdgcn_mfma_f32_32x32x16_bf16(f.v11, af1, o1, 0, 0, 0);
}
DI void attn_phase(const Params& p, const u16* __restrict__ proj, const u16* __restrict__ vt, const float* __restrict__ ssq, u16* __restrict__ mixed, unsigned char* smem) {
  const int lane = threadIdx.x & 63, head = threadIdx.x >> 6, c = lane & 31, hh = lane >> 5;
  LAS float* red = (LAS float*)smem;
  const int kap = 16 * ((c >> 2) & 1) + (c & 3) + 4 * (c >> 3);
  for (int item = blockIdx.x; item < 4 * 64; item += gridDim.x) {
    const int b = item & 3, q0 = (63 - (item >> 2)) * 64;
    const size_t tq = (size_t)b * SEQ + q0 + c;
    const float* qsq = ssq + ((size_t)(b * 8 + head)) * SEQ;
    const float* ksqb = ssq + ((size_t)(32 + b * 8 + head)) * SEQ + 16 * hh;
    bf16x8_t qL[4], qU[4];
#pragma unroll
    for (int up = 0; up < 2; ++up) {
      const float iq = rsqrtf(qsq[q0 + 32 * up + c] * (1.f / 64.f) + EPS);
#pragma unroll
      for (int ks = 0; ks < 4; ++ks) { float f[8]; unpack8(*(const uint4*)(proj + (tq + 32 * up) * DIN + head * 64 + 16 * ks + 8 * hh), f);
        float gq[8];
        { const float4 qa = *(const float4*)(p.q_norm_g + 16 * ks + 8 * hh), qb = *(const float4*)(p.q_norm_g + 16 * ks + 8 * hh + 4), ka = *(const float4*)(p.k_norm_g + 16 * ks + 8 * hh), kb = *(const float4*)(p.k_norm_g + 16 * ks + 8 * hh + 4);
          gq[0] = qa.x * ka.x * iq; gq[1] = qa.y * ka.y * iq; gq[2] = qa.z * ka.z * iq; gq[3] = qa.w * ka.w * iq; gq[4] = qb.x * kb.x * iq; gq[5] = qb.y * kb.y * iq; gq[6] = qb.z * kb.z * iq; gq[7] = qb.w * kb.w * iq; }
        const bf16x8_t v = pack_bf16x8(f[0] * gq[0], f[1] * gq[1], f[2] * gq[2], f[3] * gq[3], f[4] * gq[4], f[5] * gq[5], f[6] * gq[6], f[7] * gq[7]);
        if (up) qU[ks] = v; else qL[ks] = v; }
    }
    f32x16_t oL0, oL1, oU0, oU1;
#pragma unroll
    for (int r = 0; r < 16; ++r) { oL0[r] = 0.f; oL1[r] = 0.f; oU0[r] = 0.f; oU1[r] = 0.f; }
    float cL = 1.f, cU = 1.f;
    const u16* kbase = proj + ((size_t)b * SEQ + kap) * DIN + 512 + head * 64 + 8 * hh;
    const u16* vbase = vt + ((size_t)(b * 512 + head * 64 + c)) * SEQ + 16 * hh;
    AttnKV kv;
    attn_load(kv, kbase + (size_t)(q0 + 32) * DIN, vbase + q0 + 32, ksqb + q0 + 32);
    attn_half<true>(kv, qU, c, hh, cU, oU0, oU1);
    attn_load(kv, kbase + (size_t)q0 * DIN, vbase + q0, ksqb + q0);
    attn_half<false>(kv, qU, c, hh, cU, oU0, oU1);
    attn_half<true>(kv, qL, c, hh, cL, oL0, oL1);
    for (int tb = q0 - 32; tb >= 0; tb -= 32) {
      attn_load(kv, kbase + (size_t)tb * DIN, vbase + tb, ksqb + tb);
      const bool uz = __all(cU == 0.f);
      if (!uz) attn_half<false>(kv, qU, c, hh, cU, oU0, oU1);
      attn_half<false>(kv, qL, c, hh, cL, oL0, oL1);
      if (uz && __all(cL == 0.f)) break;
    }
    float sL = 0.f, sU = 0.f;
#pragma unroll
    for (int r = 0; r < 16; ++r) { sL += oL0[r] * oL0[r] + oL1[r] * oL1[r]; sU += oU0[r] * oU0[r] + oU1[r] * oU1[r]; }
    sL += __shfl_xor(sL, 32); sU += __shfl_xor(sU, 32);
    __syncthreads();
    if (hh == 0) { red[head * 64 + c] = sL; red[head * 64 + 32 + c] = sU; }
    __syncthreads();
    float tL = 0.f, tU = 0.f;
#pragma unroll
    for (int h8 = 0; h8 < 8; ++h8) { tL += red[h8 * 64 + c]; tU += red[h8 * 64 + 32 + c]; }
    const float* g = p.sb_out_g + head * 64 + 4 * hh;
#pragma unroll
    for (int up = 0; up < 2; ++up) {
      const float inv = rsqrtf((up ? tU : tL) * (1.f / DSB) + EPS);
      u16* orow = mixed + (tq + 32 * up) * D + head * 64 + 4 * hh;
#pragma unroll
      for (int rg = 0; rg < 4; ++rg) {
        const float4 g0 = *(const float4*)(g + 8 * rg), g1 = *(const float4*)(g + 32 + 8 * rg);
        const float a0 = up ? oU0[4 * rg] : oL0[4 * rg], a1 = up ? oU0[4 * rg + 1] : oL0[4 * rg + 1], a2 = up ? oU0[4 * rg + 2] : oL0[4 * rg + 2], a3 = up ? oU0[4 * rg + 3] : oL0[4 * rg + 3];
        const float b0 = up ? oU1[4 * rg] : oL1[4 * rg], b1 = up ? oU1[4 * rg + 1] : oL1[4 * rg + 1], b2 = up ? oU1[4 * rg + 2] : oL1[4 * rg + 2], b3 = up ? oU1[4 * rg + 3] : oL1[4 * rg + 3];
        uint2 w0, w1;
        w0.x = pack2(a0 * inv * g0.x, a1 * inv * g0.y); w0.y = pack2(a2 * inv * g0.z, a3 * inv * g0.w);
        w1.x = pack2(b0 * inv * g1.x, b1 * inv * g1.y); w1.y = pack2(b2 * inv * g1.z, b3 * inv * g1.w);
        *(uint2*)(orow + 8 * rg) = w0; *(uint2*)(orow + 32 + 8 * rg) = w1;
      }
    }
  }
}
#define SEL_DI DI
#define SEL_F2U(x) __float_as_uint(x)
#define SEL_U2F(x) __uint_as_float(x)

#define CE(a, b) do { const unsigned _h = (a) > (b) ? (a) : (b), _l = (a) > (b) ? (b) : (a); (a) = _h; (b) = _l; } while (0)
SEL_DI void sort16(unsigned (&v)[16]) {
  CE(v[0], v[1]); CE(v[2], v[3]); CE(v[0], v[2]); CE(v[1], v[3]); CE(v[1], v[2]); CE(v[4], v[5]); CE(v[6], v[7]); CE(v[4], v[6]);
  CE(v[5], v[7]); CE(v[5], v[6]); CE(v[0], v[4]); CE(v[2], v[6]); CE(v[2], v[4]); CE(v[1], v[5]); CE(v[3], v[7]); CE(v[3], v[5]);
  CE(v[1], v[2]); CE(v[3], v[4]); CE(v[5], v[6]); CE(v[8], v[9]); CE(v[10], v[11]); CE(v[8], v[10]); CE(v[9], v[11]); CE(v[9], v[10]);
  CE(v[12], v[13]); CE(v[14], v[15]); CE(v[12], v[14]); CE(v[13], v[15]); CE(v[13], v[14]); CE(v[8], v[12]); CE(v[10], v[14]); CE(v[10], v[12]);
  CE(v[9], v[13]); CE(v[11], v[15]); CE(v[11], v[13]); CE(v[9], v[10]); CE(v[11], v[12]); CE(v[13], v[14]); CE(v[0], v[8]); CE(v[4], v[12]);
  CE(v[4], v[8]); CE(v[2], v[10]); CE(v[6], v[14]); CE(v[6], v[10]); CE(v[2], v[4]); CE(v[6], v[8]); CE(v[10], v[12]); CE(v[1], v[9]);
  CE(v[5], v[13]); CE(v[5], v[9]); CE(v[3], v[11]); CE(v[7], v[15]); CE(v[7], v[11]); CE(v[3], v[5]); CE(v[7], v[9]); CE(v[11], v[13]);
  CE(v[1], v[2]); CE(v[3], v[4]); CE(v[5], v[6]); CE(v[7], v[8]); CE(v[9], v[10]); CE(v[11], v[12]); CE(v[13], v[14]);
}
SEL_DI void bitonic_merge16(unsigned (&v)[16]) {
#pragma unroll
  for (int d = 8; d >= 1; d >>= 1)
#pragma unroll
    for (int i = 0; i < 16; ++i) if ((i & d) == 0) CE(v[i], v[i + d]);
}
SEL_DI void merge_top16(unsigned (&a)[16], const unsigned (&b)[16]) {
#pragma unroll
  for (int i = 0; i < 16; ++i) a[i] = a[i] > b[15 - i] ? a[i] : b[15 - i];
  bitonic_merge16(a);
}
SEL_DI void top16_of_64(unsigned (&g0)[16], unsigned (&g1)[16], unsigned (&g2)[16], unsigned (&g3)[16]) {
  sort16(g0); sort16(g1); sort16(g2); sort16(g3);
  merge_top16(g0, g1); merge_top16(g2, g3); merge_top16(g0, g2);
}
SEL_DI unsigned cand_key(float a, float b, unsigned payload) {
  float s = a + b; s = s < 32.0f ? 32.0f : (s > 127.99f ? 127.99f : s);
  return ((SEL_F2U(s) << 8) & 0xFFFFC000u) | payload;
}
SEL_DI void stage2(const unsigned (&L1)[16], const unsigned (&L2)[16], unsigned (&R)[16]) {
  float f1[16], f2m[16]; unsigned P1[16], P2[16];
#pragma unroll
  for (int i = 0; i < 16; ++i) { f1[i] = SEL_U2F(L1[i] & ~127u); f2m[i] = SEL_U2F(L2[i] & ~127u) - 64.0f; P1[i] = (L1[i] & 127u) << 7; P2[i] = L2[i] & 127u; }
  unsigned K[64];
  K[0] = cand_key(f1[0], f2m[0], P1[0] | P2[0]);
  K[1] = cand_key(f1[0], f2m[1], P1[0] | P2[1]);
  K[2] = cand_key(f1[0], f2m[2], P1[0] | P2[2]);
  K[3] = cand_key(f1[0], f2m[3], P1[0] | P2[3]);
  K[4] = cand_key(f1[0], f2m[4], P1[0] | P2[4]);
  K[5] = cand_key(f1[0], f2m[5], P1[0] | P2[5]);
  K[6] = cand_key(f1[0], f2m[6], P1[0] | P2[6]);
  K[7] = cand_key(f1[0], f2m[7], P1[0] | P2[7]);
  K[8] = cand_key(f1[0], f2m[8], P1[0] | P2[8]);
  K[9] = cand_key(f1[0], f2m[9], P1[0] | P2[9]);
  K[10] = cand_key(f1[0], f2m[10], P1[0] | P2[10]);
  K[11] = cand_key(f1[0], f2m[11], P1[0] | P2[11]);
  K[12] = cand_key(f1[0], f2m[12], P1[0] | P2[12]);
  K[13] = cand_key(f1[0], f2m[13], P1[0] | P2[13]);
  K[14] = cand_key(f1[0], f2m[14], P1[0] | P2[14]);
  K[15] = cand_key(f1[0], f2m[15], P1[0] | P2[15]);
  K[16] = cand_key(f1[1], f2m[0], P1[1] | P2[0]);
  K[17] = cand_key(f1[1], f2m[1], P1[1] | P2[1]);
  K[18] = cand_key(f1[1], f2m[2], P1[1] | P2[2]);
  K[19] = cand_key(f1[1], f2m[3], P1[1] | P2[3]);
  K[20] = cand_key(f1[1], f2m[4], P1[1] | P2[4]);
  K[21] = cand_key(f1[1], f2m[5], P1[1] | P2[5]);
  K[22] = cand_key(f1[1], f2m[6], P1[1] | P2[6]);
  K[23] = cand_key(f1[1], f2m[7], P1[1] | P2[7]);
  K[24] = cand_key(f1[2], f2m[0], P1[2] | P2[0]);
  K[25] = cand_key(f1[2], f2m[1], P1[2] | P2[1]);
  K[26] = cand_key(f1[2], f2m[2], P1[2] | P2[2]);
  K[27] = cand_key(f1[2], f2m[3], P1[2] | P2[3]);
  K[28] = cand_key(f1[2], f2m[4], P1[2] | P2[4]);
  K[29] = cand_key(f1[3], f2m[0], P1[3] | P2[0]);
  K[30] = cand_key(f1[3], f2m[1], P1[3] | P2[1]);
  K[31] = cand_key(f1[3], f2m[2], P1[3] | P2[2]);
  K[32] = cand_key(f1[3], f2m[3], P1[3] | P2[3]);
  K[33] = cand_key(f1[4], f2m[0], P1[4] | P2[0]);
  K[34] = cand_key(f1[4], f2m[1], P1[4] | P2[1]);
  K[35] = cand_key(f1[4], f2m[2], P1[4] | P2[2]);
  K[36] = cand_key(f1[5], f2m[0], P1[5] | P2[0]);
  K[37] = cand_key(f1[5], f2m[1], P1[5] | P2[1]);
  K[38] = cand_key(f1[6], f2m[0], P1[6] | P2[0]);
  K[39] = cand_key(f1[6], f2m[1], P1[6] | P2[1]);
  K[40] = cand_key(f1[7], f2m[0], P1[7] | P2[0]);
  K[41] = cand_key(f1[7], f2m[1], P1[7] | P2[1]);
  K[42] = cand_key(f1[8], f2m[0], P1[8] | P2[0]);
  K[43] = cand_key(f1[9], f2m[0], P1[9] | P2[0]);
  K[44] = cand_key(f1[10], f2m[0], P1[10] | P2[0]);
  K[45] = cand_key(f1[11], f2m[0], P1[11] | P2[0]);
  K[46] = cand_key(f1[12], f2m[0], P1[12] | P2[0]);
  K[47] = cand_key(f1[13], f2m[0], P1[13] | P2[0]);
  K[48] = cand_key(f1[14], f2m[0], P1[14] | P2[0]);
  K[49] = cand_key(f1[15], f2m[0], P1[15] | P2[0]);
#pragma unroll
  for (int c = 50; c < 64; ++c) K[c] = 0u;
  unsigned g1[16], g2[16], g3[16];
#pragma unroll
  for (int i = 0; i < 16; ++i) { R[i] = K[i]; g1[i] = K[16 + i]; g2[i] = K[32 + i]; g3[i] = K[48 + i]; }
  sort16(R); sort16(g1); sort16(g2); CE(g3[0], g3[1]);
  merge_top16(R, g1);
  g2[15] = g2[15] > g3[0] ? g2[15] : g3[0]; g2[14] = g2[14] > g3[1] ? g2[14] : g3[1];
  bitonic_merge16(g2);
  merge_top16(R, g2);
}

constexpr int SKP = 272;
struct QFrag { bf16x8_t f[8]; };
DI QFrag stage1_load(const u16* __restrict__ qrow, int hh) { QFrag q;
#pragma unroll
  for (int ks = 0; ks < 8; ++ks) q.f[ks] = *(const bf16x8_t*)(qrow + 16 * ks + 8 * hh);
  return q; }
DI void stage1(const QFrag& qfr, const LAS unsigned char* sk, int tok, int hh, unsigned (&out)[16]) {
  f32x16_t acc[4];
#pragma unroll
  for (int kt = 0; kt < 4; ++kt)
#pragma unroll
    for (int r = 0; r < 16; ++r) acc[kt][r] = 64.0f;
#pragma unroll
  for (int ks = 0; ks < 8; ++ks) {
#pragma unroll
    for (int kt = 0; kt < 4; ++kt) {
      const bf16x8_t ak = *(const LAS bf16x8_t*)(sk + (32 * kt + tok) * SKP + (16 * ks + 8 * hh) * 2);
      acc[kt] = __builtin_amdgcn_mfma_f32_32x32x16_bf16(ak, qfr.f[ks], acc[kt], 0, 0, 0);
    }
    __builtin_amdgcn_sched_barrier(0);
  }
  unsigned g1[16], g2[16], g3[16];
#pragma unroll
  for (int r = 0; r < 16; ++r) {
    const unsigned ix = (unsigned)((r & 3) + 8 * (r >> 2));
    out[r] = (__float_as_uint(acc[0][r]) & ~127u) | ix; g1[r] = (__float_as_uint(acc[1][r]) & ~127u) | (32u + ix);
    g2[r] = (__float_as_uint(acc[2][r]) & ~127u) | (64u + ix); g3[r] = (__float_as_uint(acc[3][r]) & ~127u) | (96u + ix);
  }
  top16_of_64(out, g1, g2, g3);
  unsigned oth[16];
#pragma unroll
  for (int i = 0; i < 16; ++i) { out[i] |= (unsigned)(hh << 2); }
#pragma unroll
  for (int i = 0; i < 16; ++i) oth[i] = (unsigned)__shfl_xor((int)out[i], 32);
  merge_top16(out, oth);
}
DI void topk_phase(const Params& p, const u16* __restrict__ qp, const float* __restrict__ uinv, int* __restrict__ idx_out, float2* __restrict__ gu_out, unsigned char* smem) {
  const int tid = threadIdx.x;
  LAS unsigned char* sk = (LAS unsigned char*)smem;
  __syncthreads();
#pragma unroll
  for (int i = tid; i < 2 * 128 * 16; i += NTHREADS) {
    const int c = i & 15, row = i >> 4;
    const float4* s = (const float4*)(p.sub_keys + (size_t)row * 128 + c * 8);
    const float4 a = s[0], b = s[1];
    pg8::u32x4 o; o.x = pack2(a.x, a.y); o.y = pack2(a.z, a.w); o.z = pack2(b.x, b.y); o.w = pack2(b.z, b.w);
    *(LAS pg8::u32x4*)(sk + row * SKP + c * 16) = o;
  }
  __syncthreads();
  const int lane = tid & 63, tok = lane & 31, hh = lane >> 5, gw = blockIdx.x * NWAVES + (tid >> 6), nw = gridDim.x * NWAVES;
  for (int item = gw; item < (T / 32) * 4; item += nw) {
    const int t = (item >> 2) * 32 + tok, hp = item & 3;
    const u16* qt = qp + (size_t)t * 2048 + hp * 512;
    unsigned LA1[16], LA2[16], LB1[16], LB2[16];
    { QFrag fa = stage1_load(qt, hh), fb = stage1_load(qt + 128, hh);
      stage1(fa, sk, tok, hh, LA1); fa = stage1_load(qt + 256, hh);
      stage1(fb, sk + 128 * SKP, tok, hh, LA2); fb = stage1_load(qt + 384, hh);
      stage1(fa, sk, tok, hh, LB1);
      stage1(fb, sk + 128 * SKP, tok, hh, LB2); }
    unsigned L1[16], L2[16], R[16];
#pragma unroll
    for (int i = 0; i < 16; ++i) { L1[i] = hh ? LB1[i] : LA1[i]; L2[i] = hh ? LB2[i] : LA2[i]; }
    stage2(L1, L2, R);
    const int head = hp * 2 + hh;
    float ev[16], sum = 0.f;
    const float mx = __uint_as_float(0x42000000u | ((R[0] >> 14) << 6));
#pragma unroll
    for (int k = 0; k < 16; ++k) { ev[k] = __expf(__uint_as_float(0x42000000u | ((R[k] >> 14) << 6)) - mx); sum += ev[k]; }
    const float rs = 1.f / sum;
    int* io = idx_out + (size_t)t * 128 + head * 16; float2* go = gu_out + (size_t)t * 128 + head * 16;
#pragma unroll
    for (int k4 = 0; k4 < 4; ++k4) {
      int4 ex; ex.x = (int)(R[4 * k4] & 0x3FFFu); ex.y = (int)(R[4 * k4 + 1] & 0x3FFFu); ex.z = (int)(R[4 * k4 + 2] & 0x3FFFu); ex.w = (int)(R[4 * k4 + 3] & 0x3FFFu);
      ((int4*)io)[k4] = ex;
      float4 ga, gb; ga.x = ev[4 * k4] * rs; ga.y = uinv[ex.x]; ga.z = ev[4 * k4 + 1] * rs; ga.w = uinv[ex.y];
      gb.x = ev[4 * k4 + 2] * rs; gb.y = uinv[ex.z]; gb.z = ev[4 * k4 + 3] * rs; gb.w = uinv[ex.w];
      ((float4*)go)[2 * k4] = ga; ((float4*)go)[2 * k4 + 1] = gb;
    }
  }
}

typedef float f32x4_t __attribute__((ext_vector_type(4)));
typedef float f32x2_t __attribute__((ext_vector_type(2)));
typedef int i32x8_t __attribute__((ext_vector_type(8)));
constexpr int UIP = 132;
constexpr int UGP = 1032;
struct UBuf { uint4 r0, r1, r2, r3; unsigned e; float vi; };
#define U_LOAD(buf, g) do { const unsigned _e = myi[(g)]; const LAS unsigned* _il = idl + (lane >> 5) * UIP + (g); const unsigned _lo = 16u * (lane & 31); \
    buf.r0 = *(const uint4*)(U4 + (size_t)_il[0] * 512 + _lo); buf.r1 = *(const uint4*)(U4 + (size_t)_il[2 * UIP] * 512 + _lo); \
    buf.r2 = *(const uint4*)(U4 + (size_t)_il[4 * UIP] * 512 + _lo); buf.r3 = *(const uint4*)(U4 + (size_t)_il[6 * UIP] * 512 + _lo); \
    buf.e = _e; buf.vi = vinv[_e]; } while (0)
#define U_ST(i, r) do { pg8::u32x4 _o; _o.x = (r).x; _o.y = (r).y; _o.z = (r).z; _o.w = (r).w; *(LAS pg8::u32x4*)(gst + (2 * (i) + (lane >> 5)) * 528 + 16 * (lane & 31)) = _o; } while (0)
#define U_LD(j) (*(const LAS pg8::u32x4*)(gld + 128 * (j)))
#define U_MMA(c, r, b) c = __builtin_amdgcn_mfma_scale_f32_16x16x128_f8f6f4((i32x8_t){(int)(r).x, (int)(r).y, (int)(r).z, (int)(r).w, 0, 0, 0, 0}, b, c, 4, 0, 0, 0x7F7F7F7F, 0, 0x7F7F7F7F)
#define U_COMP(buf, g) do { f32x4_t c = {0.f, 0.f, 0.f, 0.f}; \
    U_ST(0, buf.r0); U_ST(1, buf.r1); U_ST(2, buf.r2); U_ST(3, buf.r3); asm volatile("s_waitcnt lgkmcnt(0)" ::: "memory"); \
    { const pg8::u32x4 a0 = U_LD(0), a1 = U_LD(1), a2 = U_LD(2), a3 = U_LD(3); asm volatile("s_waitcnt lgkmcnt(0)" ::: "memory"); \
      U_MMA(c, a0, B0); U_MMA(c, a1, B1); U_MMA(c, a2, B2); U_MMA(c, a3, B3); } \
    const int rsel = pp & 3; const float v = rsel == 0 ? c[0] : rsel == 1 ? c[1] : rsel == 2 ? c[2] : c[3]; \
    const float vo = __shfl(v, (lane + 40) & 63); \
    if (pp < 8 && q == (pp >> 2)) { const f32x2_t gu2 = *(const LAS f32x2_t*)(myg + (g) * 8); \
      const float d = (v + vo) * gu2[1]; const float act = 0.5f * d * (1.f + erff(d * 0.70710678118654752f)); \
      uint2 o; o.x = buf.e; o.y = __float_as_uint(gu2[0] * act * buf.vi); pw[(size_t)tok * 128 + (g)] = o; } } while (0)
DI void peer_u_phase(const u16* __restrict__ xb, const float* __restrict__ rowss, const int* __restrict__ idx, const float2* __restrict__ gu,
                     const unsigned char* __restrict__ U4, const float* __restrict__ vinv, uint2* __restrict__ pw, unsigned char* smem) {
  const int lane = threadIdx.x & 63, wave = threadIdx.x >> 6, pp = lane & 15, q = lane >> 4, gw = blockIdx.x * NWAVES + wave, nw = gridDim.x * NWAVES;
  const int pi = pp & 7, x = q + 4 * (pp >> 3);
  const unsigned xoff = 16u * x;
  LAS unsigned* idl = (LAS unsigned*)(smem + wave * (8 * UIP * 4 + 8 * UGP + 8 * 528));
  LAS unsigned char* gul = (LAS unsigned char*)(idl + 8 * UIP);
  LAS unsigned char* gst = gul + 8 * UGP;
  const LAS unsigned char* gld = gst + pi * 528 + 16 * x;
  const LAS unsigned* myi = idl + pi * UIP;
  const LAS unsigned char* myg = gul + pi * UGP;
  for (int unit = gw; unit < T / 8; unit += nw) {
    const int tok = unit * 8 + pi;
    __builtin_amdgcn_wave_barrier();
#pragma unroll
    for (int r8 = 0; r8 < 8; ++r8) {
      const int* ir = idx + (size_t)(unit * 8 + r8) * 128;
      idl[r8 * UIP + lane] = (unsigned)ir[lane]; idl[r8 * UIP + 64 + lane] = (unsigned)ir[64 + lane];
      const uint4 gv = ((const uint4*)(gu + (size_t)(unit * 8 + r8) * 128))[lane];
      pg8::u32x4 o; o.x = gv.x; o.y = gv.y; o.z = gv.z; o.w = gv.w; *(LAS pg8::u32x4*)(gul + r8 * UGP + lane * 16) = o;
    }
    __builtin_amdgcn_fence(__ATOMIC_RELEASE, "wavefront");
    __builtin_amdgcn_wave_barrier();
    const float inv = rsqrtf(rowss[tok] * (1.f / D) + EPS);
    i32x8_t B0, B1, B2, B3;
#define U_BUILD(Bv, i) do { const u16* sb = xb + (size_t)tok * D + 256 * (i) + 128 * (pp >> 3) + 16 * q; \
      _Pragma("unroll") for (int h = 0; h < 4; ++h) { float f[8]; unpack8(*(const uint4*)(sb + 64 * (h >> 1) + 8 * (h & 1)), f); int w; \
        w = __builtin_amdgcn_cvt_pk_fp8_f32(f[0] * inv, f[1] * inv, 0, false); w = __builtin_amdgcn_cvt_pk_fp8_f32(f[2] * inv, f[3] * inv, w, true); Bv[2 * h] = w; \
        w = __builtin_amdgcn_cvt_pk_fp8_f32(f[4] * inv, f[5] * inv, 0, false); w = __builtin_amdgcn_cvt_pk_fp8_f32(f[6] * inv, f[7] * inv, w, true); Bv[2 * h + 1] = w; } } while (0)
    U_BUILD(B0, 0); U_BUILD(B1, 1); U_BUILD(B2, 2); U_BUILD(B3, 3);
    UBuf b0, b1, b2, b3;
#define SB() __builtin_amdgcn_sched_barrier(0)
    U_LOAD(b0, 0); U_LOAD(b1, 1); U_LOAD(b2, 2); SB();
#pragma unroll 1
    for (int g = 0; g < 128; g += 4) {
      U_LOAD(b3, g + 3); SB(); U_COMP(b0, g); SB();
      U_LOAD(b0, (g + 4) & 127); SB(); U_COMP(b1, g + 1); SB();
      U_LOAD(b1, (g + 5) & 127); SB(); U_COMP(b2, g + 2); SB();
      U_LOAD(b2, (g + 6) & 127); SB(); U_COMP(b3, g + 3); SB();
    }
  }
}

typedef int i32x2_t __attribute__((ext_vector_type(2)));
DI void peer_v_phase(const uint2* __restrict__ pw, const unsigned char* __restrict__ V4, const u16* __restrict__ xb, float* __restrict__ out, unsigned char* smem) {
  const int lane = threadIdx.x & 63, wave = threadIdx.x >> 6, r = lane >> 3, c = lane & 7, n16 = lane & 15, kg = lane >> 4;
  LAS unsigned char* img = (LAS unsigned char*)smem + wave * VWAVE;
  LAS unsigned char* pbuf = img + 128 * VIMP;
  const int nunit = 4 * (T / 64);
  const int cnt = ((int)blockIdx.x < nunit) ? (nunit - 1 - (int)blockIdx.x) / (int)gridDim.x + 1 : 0, N = cnt * 8;
  if (N == 0) return;
#define V_TOK(n, jj, tt) do { const int _u = (int)blockIdx.x + ((n) >> 3) * (int)gridDim.x; jj = _u & 3; tt = (_u >> 2) * 64 + wave * 8 + ((n) & 7); } while (0)
#define V_LDPW(n) ({ int _j, _t; V_TOK(n, _j, _t); ((const uint4*)(pw + (size_t)_t * 128))[lane]; })
#define V_STAGE(n, pq, scv) do { LAS unsigned char* _b = pbuf + ((n) & 1) * 1024; \
    *(LAS i32x2_t*)(_b + 8 * lane) = (i32x2_t){(int)(pq).x, (int)(pq).z}; *(LAS i32x2_t*)(_b + 512 + 8 * lane) = (i32x2_t){(int)(pq).y, (int)(pq).w}; \
    const float _m = wave_max(fmaxf(fabsf(__uint_as_float((pq).y)), fabsf(__uint_as_float((pq).w)))); scv = _m > 0.f ? 224.f / _m : 1.f; } while (0)
#define V_GATHER(n) do { int _j, _t; V_TOK(n, _j, _t); const unsigned char* _vb = V4 + (size_t)_j * ((size_t)NEXP * 128) + 16 * c; const LAS unsigned* _e = (const LAS unsigned*)(pbuf + ((n) & 1) * 1024); \
    _Pragma("unroll") for (int i = 0; i < 16; ++i) G[i] = *(const uint4*)(_vb + (_e[8 * i + r] * 128u)); } while (0)
#define V_WRITEIMG() do { _Pragma("unroll") for (int i = 0; i < 16; ++i) { LAS unsigned char* _d = img + (8 * i + r) * VIMP + 16 * c; \
      *(LAS i32x2_t*)(_d) = (i32x2_t){(int)G[i].x, (int)G[i].y}; *(LAS i32x2_t*)(_d + 8) = (i32x2_t){(int)G[i].z, (int)G[i].w}; } } while (0)
  uint4 G[16];
  uint4 pq = V_LDPW(0);
  float sc_cur, sc_nxt;
  V_STAGE(0, pq, sc_cur); asm volatile("s_waitcnt lgkmcnt(0)" ::: "memory");
  if (N > 1) pq = V_LDPW(1);
  V_GATHER(0);
  V_WRITEIMG(); asm volatile("s_waitcnt lgkmcnt(0)" ::: "memory");
  for (int n = 0; n < N; ++n) {
    if (n + 1 < N) { V_STAGE(n + 1, pq, sc_nxt); asm volatile("s_waitcnt lgkmcnt(0)" ::: "memory"); if (n + 2 < N) pq = V_LDPW(n + 2); V_GATHER(n + 1); }
    __builtin_amdgcn_sched_barrier(0);
    int j, t; V_TOK(n, j, t);
    i32x8_t A;
    { const LAS float* wl = (const LAS float*)(pbuf + (n & 1) * 1024 + 512);
#pragma unroll
      for (int h = 0; h < 2; ++h)
#pragma unroll
        for (int d = 0; d < 4; ++d) { const f32x4_t w4 = *(const LAS f32x4_t*)(wl + 64 * h + 16 * kg + 4 * d);
          int w = __builtin_amdgcn_cvt_pk_fp8_f32(w4[0] * sc_cur, w4[1] * sc_cur, 0, false); w = __builtin_amdgcn_cvt_pk_fp8_f32(w4[2] * sc_cur, w4[3] * sc_cur, w, true);
          A[4 * h + d] = n16 == 0 ? w : 0; } }
    float val[16];
    const LAS unsigned char* ib = img + (32 * kg + n16) * VIMP;
#pragma unroll
    for (int ct = 0; ct < 16; ++ct) {
      const i32x2_t b0 = __builtin_amdgcn_ds_read_tr4_b64_v2i32((LAS i32x2_t*)(ib + 8 * ct)), b1 = __builtin_amdgcn_ds_read_tr4_b64_v2i32((LAS i32x2_t*)(ib + 16 * VIMP + 8 * ct));
      const f32x4_t z = {0.f, 0.f, 0.f, 0.f};
      const f32x4_t cc = __builtin_amdgcn_mfma_scale_f32_16x16x128_f8f6f4(A, (i32x8_t){b0[0], b0[1], b1[0], b1[1], 0, 0, 0, 0}, z, 0, 4, 0, 0x7F7F7F7F, 0, 0x7F7F7F7F);
      val[ct] = cc[0];
      asm volatile("" : "+v"(val[ct]));
    }
    LAS float* stg = (LAS float*)(pbuf + (n & 1) * 1024);
    if (lane < 16) {
#pragma unroll
      for (int ct = 0; ct < 16; ++ct) stg[16 * ct + lane] = val[ct];
    }
    asm volatile("s_waitcnt lgkmcnt(0)" ::: "memory");
    const f32x4_t s4 = *(const LAS f32x4_t*)(stg + 4 * lane);
    const float rs = 1.f / sc_cur;
    const uint2 xr = *(const uint2*)(xb + (size_t)t * D + 256 * j + 4 * lane);
    float4 o;
    o.x = bflo(xr.x) + s4[0] * rs; o.y = bfhi(xr.x) + s4[1] * rs; o.z = bflo(xr.y) + s4[2] * rs; o.w = bfhi(xr.y) + s4[3] * rs;
    *(float4*)(out + (size_t)t * D + 256 * j + 4 * lane) = o;
    __builtin_amdgcn_sched_barrier(0);
    asm volatile("s_waitcnt lgkmcnt(0)" ::: "memory");
    if (n + 1 < N) { V_WRITEIMG(); sc_cur = sc_nxt; }
    asm volatile("s_waitcnt lgkmcnt(0)" ::: "memory");
  }
}

constexpr int NPHASE = 8;
__global__ void __launch_bounds__(NTHREADS, 2) fwd_kernel(Params p) {
  extern __shared__ __attribute__((aligned(16))) unsigned char smem[];
  cg::grid_group grid = cg::this_grid();
  unsigned char* ws = p.ws;
  u16* wt_in = (u16*)(ws + WS_WTIN); u16* wt_out = (u16*)(ws + WS_WTOUT); u16* wt_q = (u16*)(ws + WS_WTQ);
  u16* act = (u16*)(ws + WS_ACT); u16* proj = (u16*)(ws + WS_PROJ);
  int* idx = (int*)(ws + WS_IDX); float2* gu = (float2*)(ws + WS_SB); unsigned char* U8 = ws + WS_U8; unsigned char* V8 = ws + WS_V8;
  uint2* pw = (uint2*)(ws + WS_PW); float* uinv = (float*)(ws + WS_UINV); float* vinv = (float*)(ws + WS_VINV);
  float* rowss = (float*)(ws + WS_ROWSS);
  volatile LAS unsigned* misc = (volatile LAS unsigned*)(LAS unsigned char*)(smem + LDS_MISC);
  if (threadIdx.x < 8) misc[threadIdx.x] = 0u;
  __syncthreads();
  XcdBarrier bar = xcd_barrier_post((unsigned*)(ws + WS_CTL), misc);
  PG8_LAS unsigned char* lds = (PG8_LAS unsigned char*)smem;
  const int lo = p.ph_lo, hi = p.ph_hi;
#define IN(k) (lo <= (k) && (k) < hi)
#define SEAM(k) do { if (IN(k) && IN((k) + 1)) xcd_barrier(bar); } while (0)
  if (IN(0)) {
    transpose_convert(p.w_in, wt_in, D, DIN, nullptr, (float*)smem);
    transpose_convert(p.w_out, wt_out, D, D, nullptr, (float*)smem);
    transpose_convert(p.w_q, wt_q, D, 2048, p.norm2_g, (float*)smem);
    convert_fp4_rows<false>(p.peer_u, p.norm2_g, U8, uinv);
    convert_fp4_rows<true>(p.peer_v, nullptr, V8, vinv);
    rmsnorm1024(p.x, p.norm1_g, act);
    for (int i = blockIdx.x * NTHREADS + threadIdx.x; i < T; i += gridDim.x * NTHREADS) rowss[i] = 0.f;
    for (int i = blockIdx.x * NTHREADS + threadIdx.x; i < 2 * 32 * SEQ; i += gridDim.x * NTHREADS) ((float*)(ws + WS_SB + 16 * MBy))[i] = 0.f;
  }
  if (lo < 0) grid.sync();
  SEAM(0);
  u16* vt = (u16*)(ws + WS_SB);
  float* ssq = (float*)(ws + WS_SB + 16 * MBy);
  if (IN(1)) { pg8::Gemm g{act, wt_in, T, DIN, D}; pg8::StaticOrder S; S.init(T, DIN, gridDim.x, blockIdx.x);
    pg8::EpiInProj E{proj, vt, ssq}; pg8::gemm_phase<pg8::EpiInProj, pg8::StaticOrder>(lds, g, S, E, nullptr); }
  SEAM(1);
  if (IN(2)) { attn_phase(p, proj, vt, ssq, act, smem); conv_tokens(p, proj, act); }
  SEAM(2);
  if (IN(3)) { pg8::Gemm g{act, wt_out, T, D, D}; pg8::StaticOrder S; S.init(T, D, gridDim.x, blockIdx.x);
    pg8::EpiResid E{p.x, p.out, proj, rowss, D}; pg8::gemm_phase<pg8::EpiResid, pg8::StaticOrder>(lds, g, S, E, nullptr); }
  SEAM(3);
  u16* xb = proj;
  u16* qp = proj + (size_t)T * D;
  if (IN(4)) { pg8::Gemm g{xb, wt_q, T, 2048, D}; pg8::StaticOrder S; S.init(T, 2048, gridDim.x, blockIdx.x);
    pg8::EpiBf16S E{qp, 2048, rowss}; pg8::gemm_phase<pg8::EpiBf16S, pg8::StaticOrder>(lds, g, S, E, nullptr); }
  SEAM(4);
  if (IN(5)) topk_phase(p, qp, uinv, idx, gu, smem);
  SEAM(5);
  if (IN(6)) peer_u_phase(xb, rowss, idx, gu, U8, vinv, pw, smem);
  SEAM(6);
  if (IN(7)) peer_v_phase(pw, V8, xb, p.out, smem);
}

extern "C" void kernel_launch(void* const* d_in, const int* in_sizes, int n_in, void* d_out, int out_size, void* d_ws, size_t ws_size,
                              hipStream_t stream) {
  static int grid_blocks = 0;
  if (!grid_blocks) {
    int dev = 0, cus = 0, per_cu = 0;
    (void)hipGetDevice(&dev);
    (void)hipDeviceGetAttribute(&cus, hipDeviceAttributeMultiprocessorCount, dev);
    (void)hipFuncSetAttribute((const void*)fwd_kernel, hipFuncAttributeMaxDynamicSharedMemorySize, LDS_BYTES);
    (void)hipOccupancyMaxActiveBlocksPerMultiprocessor(&per_cu, fwd_kernel, NTHREADS, LDS_BYTES);
    if (per_cu < 1) per_cu = 1;
    if (per_cu > 1) per_cu = 1;
    grid_blocks = cus * per_cu;
  }
  Params p{};
  p.x = (const float*)d_in[0]; p.norm1_g = (const float*)d_in[1]; p.w_in = (const float*)d_in[2]; p.q_norm_g = (const float*)d_in[3];
  p.k_norm_g = (const float*)d_in[4]; p.conv_w = (const float*)d_in[5]; p.sb_out_g = (const float*)d_in[6]; p.conv_out_g = (const float*)d_in[7];
  p.w_out = (const float*)d_in[8]; p.norm2_g = (const float*)d_in[9]; p.w_q = (const float*)d_in[10]; p.sub_keys = (const float*)d_in[11];
  p.peer_u = (const float*)d_in[12]; p.peer_v = (const float*)d_in[13];
  p.out = (float*)d_out; p.ws = (unsigned char*)d_ws;
  p.ph_lo = 0; p.ph_hi = NPHASE;
  (void)hipMemsetAsync((unsigned char*)d_ws + WS_CTL, 0, 4096 * 4 + 8 * 64 * 4, stream);
  void* args[] = {&p};
  hipError_t e = hipLaunchCooperativeKernel((void*)fwd_kernel, dim3(grid_blocks), dim3(NTHREADS), args, LDS_BYTES, stream);
  if (e != hipSuccess) fprintf(stderr, "cooperative launch failed: %s (grid %d)\n", hipGetErrorString(e), grid_blocks);
}
```

```cpp
#include <hip/hip_runtime.h>
#include <hip/hip_cooperative_groups.h>
#include <cstdio>
#include <cstdint>
namespace cg = cooperative_groups;

typedef unsigned short u16;
#define DI __device__ __forceinline__
#define LAS __attribute__((address_space(3)))

constexpr int T = 16384, D = 1024, SEQ = 4096;
constexpr int DIN = 3072, DSB = 512;
constexpr int NEXP = 16384;
constexpr float EPS = 1e-6f;
constexpr int NWAVES = 8, NTHREADS = NWAVES * 64;

namespace pg8 {
#define PG8_LAS __attribute__((address_space(3)))
typedef unsigned short bf16_t;
typedef short bf16x8 __attribute__((ext_vector_type(8)));
typedef float f32x4 __attribute__((ext_vector_type(4)));
typedef unsigned u32x4 __attribute__((ext_vector_type(4)));
constexpr int BM = 256, BK = 64, HALF = 128, HTB = HALF * BK * 2  , STAGE_BYTES = 8 * HTB, NXCD = 8, WGM = 8;

__host__ __device__ __forceinline__ int lds_byte(int r, int c) { const int st = (r >> 4) * 2 + (c >> 5), rr = r & 15, cc = c & 31, ob = rr * 64 + cc * 2; return st * 1024 + (ob ^ (((ob >> 9) & 1) << 5)); }
__host__ __device__ __forceinline__ void stage_rc(int b, int& R, int& C) { const int st = b / 1024, sb = b % 1024, swz = sb ^ (((sb >> 9) & 1) << 5); R = (st >> 1) * 16 + swz / 64; C = (st & 1) * 32 + (swz % 64) / 2; }
__host__ __device__ __forceinline__ int perm32(int rho) { const int n = rho >> 4, i = rho & 15; return 8 * (i >> 2) + 4 * n + (i & 3); }

struct Unit { int pm, pn; };
struct Gemm { const bf16_t* A; const bf16_t* Bt; int M, N, K; };
struct StaticOrder {
    int nM, nN, nwg, G, c;
    __host__ __device__ void init(int M, int N, int G_, int c_) { nM = M / BM; nN = N / BM; nwg = nM * nN; G = G_; c = c_; }
    __host__ __device__ bool next(int i, Unit& u) const {
        const long L = (long)i * G + c; if (L >= nwg) return false;
        int wgid = (int)L; { const int q = nwg / NXCD, r = nwg % NXCD, xcd = wgid % NXCD, off = wgid / NXCD; wgid = (xcd < r ? xcd * (q + 1) : r * (q + 1) + (xcd - r) * q) + off; }
        const int nig = WGM * nN, gid = wgid / nig, fm = gid * WGM, gsz = (nM - fm) < WGM ? (nM - fm) : WGM;
        u.pm = fm + ((wgid % nig) % gsz); u.pn = (wgid % nig) / gsz; return true;
    }
    __device__ __forceinline__ void a_ready(const Unit&) const {}
    __device__ __forceinline__ void done(const Unit&) const {}
};
__device__ __forceinline__ unsigned cvt_pk_bf16(float lo, float hi) { unsigned r; asm volatile("v_cvt_pk_bf16_f32 %0, %1, %2" : "=v"(r) : "v"(lo), "v"(hi)); return r; }

struct EpiBf16S {
    static constexpr bool PERM = true, AFTER_DRAIN = false;
    bf16_t* O; int ldc; const float* rowss;
    __device__ __forceinline__ void operator()(const f32x4 (&acc)[2][2][4][2], const Unit& u, int wr, int wc, int fr, int fq) const {
        const int row0 = u.pm * BM + wr * 64 + fr, col0 = u.pn * BM + wc * 32 + 8 * fq;
#pragma unroll
        for (int ai = 0; ai < 2; ++ai)
#pragma unroll
            for (int m = 0; m < 4; ++m) { const int row = row0 + ai * HALF + m * 16; bf16_t* rowp = O + (size_t)row * ldc + col0;
                const float sc = rowss ? rsqrtf(rowss[row] * (1.f / 1024.f) + 1e-6f) : 1.f;
#pragma unroll
                for (int bj = 0; bj < 2; ++bj) { const f32x4 v0 = acc[ai][bj][m][0] * sc, v1 = acc[ai][bj][m][1] * sc;
                    u32x4 w; w.x = cvt_pk_bf16(v0[0], v0[1]); w.y = cvt_pk_bf16(v0[2], v0[3]); w.z = cvt_pk_bf16(v1[0], v1[1]); w.w = cvt_pk_bf16(v1[2], v1[3]);
                    *(u32x4*)(rowp + bj * HALF) = w; } }
    }
};
struct EpiInProj {
    static constexpr bool PERM = true, AFTER_DRAIN = false;
    bf16_t* O; bf16_t* vt; float* ssq;
    __device__ __forceinline__ void operator()(const f32x4 (&acc)[2][2][4][2], const Unit& u, int wr, int wc, int fr, int fq) const {
        const int row0 = u.pm * BM + wr * 64 + fr, col0 = u.pn * BM + wc * 32 + 8 * fq, kind = u.pn >> 1;
#pragma unroll
        for (int ai = 0; ai < 2; ++ai)
#pragma unroll
            for (int m = 0; m < 4; ++m) { const int row = row0 + ai * HALF + m * 16; const int bb = row >> 12, ss = row & 4095;
#pragma unroll
                for (int bj = 0; bj < 2; ++bj) { const f32x4 v0 = acc[ai][bj][m][0], v1 = acc[ai][bj][m][1];
                    if (kind != 2) {
                        u32x4 w; w.x = cvt_pk_bf16(v0[0], v0[1]); w.y = cvt_pk_bf16(v0[2], v0[3]); w.z = cvt_pk_bf16(v1[0], v1[1]); w.w = cvt_pk_bf16(v1[2], v1[3]);
                        *(u32x4*)(O + (size_t)row * 3072 + col0 + bj * HALF) = w;
                        if (kind < 2) {
                            float sq = v0[0] * v0[0] + v0[1] * v0[1] + v0[2] * v0[2] + v0[3] * v0[3] + v1[0] * v1[0] + v1[1] * v1[1] + v1[2] * v1[2] + v1[3] * v1[3];
                            sq += __shfl_xor(sq, 16); sq += __shfl_xor(sq, 32);
                            const int head = (u.pn & 1) * 4 + bj * 2 + (wc >> 1);
                            if (fq == 0) unsafeAtomicAdd(ssq + ((size_t)(kind * 32 + bb * 8 + head)) * 4096 + ss, sq);
                        }
                    } else {
                        const int d0 = (u.pn & 1) * 256 + bj * HALF + wc * 32 + 8 * fq;
                        bf16_t* vp = vt + ((size_t)(bb * 512 + d0)) * 4096 + ss;
                        const unsigned w0 = cvt_pk_bf16(v0[0], v0[1]), w1 = cvt_pk_bf16(v0[2], v0[3]), w2 = cvt_pk_bf16(v1[0], v1[1]), w3 = cvt_pk_bf16(v1[2], v1[3]);
                        vp[0] = (bf16_t)w0; vp[4096] = (bf16_t)(w0 >> 16); vp[2 * 4096] = (bf16_t)w1; vp[3 * 4096] = (bf16_t)(w1 >> 16);
                        vp[4 * 4096] = (bf16_t)w2; vp[5 * 4096] = (bf16_t)(w2 >> 16); vp[6 * 4096] = (bf16_t)w3; vp[7 * 4096] = (bf16_t)(w3 >> 16);
                    } } }
    }
};
struct EpiResid {
    static constexpr bool PERM = true, AFTER_DRAIN = false;
    const float* resid; float* out32; bf16_t* xb; float* rowss; int ldc;
    __device__ __forceinline__ void operator()(const f32x4 (&acc)[2][2][4][2], const Unit& u, int wr, int wc, int fr, int fq) const {
        const int row0 = u.pm * BM + wr * 64 + fr, col0 = u.pn * BM + wc * 32 + 8 * fq;
#pragma unroll
        for (int ai = 0; ai < 2; ++ai)
#pragma unroll
            for (int m = 0; m < 4; ++m) { const int row = row0 + ai * HALF + m * 16; const size_t off = (size_t)row * ldc + col0; float ss = 0.f;
#pragma unroll
                for (int bj = 0; bj < 2; ++bj) {
                    const f32x4 r0 = *(const f32x4*)(resid + off + bj * HALF), r1 = *(const f32x4*)(resid + off + bj * HALF + 4);
                    const f32x4 o0 = r0 + acc[ai][bj][m][0], o1 = r1 + acc[ai][bj][m][1];
                    ss += o0[0] * o0[0] + o0[1] * o0[1] + o0[2] * o0[2] + o0[3] * o0[3] + o1[0] * o1[0] + o1[1] * o1[1] + o1[2] * o1[2] + o1[3] * o1[3];
                    u32x4 w; w.x = cvt_pk_bf16(o0[0], o0[1]); w.y = cvt_pk_bf16(o0[2], o0[3]); w.z = cvt_pk_bf16(o1[0], o1[1]); w.w = cvt_pk_bf16(o1[2], o1[3]);
                    *(u32x4*)(xb + off + bj * HALF) = w; }
                ss += __shfl_xor(ss, 16); ss += __shfl_xor(ss, 32);
                if (fq == 0) unsafeAtomicAdd(rowss + row, ss); }
    }
};
template <class Epi, class Sched, bool STAMP = false>
__device__ __forceinline__ void gemm_phase(PG8_LAS unsigned char* lds, const Gemm g, const Sched& S, const Epi& E, unsigned long long* stamps) {
    const int tid = threadIdx.x, wid = __builtin_amdgcn_readfirstlane(tid >> 6), lane = tid & 63, wr = wid >> 2, wc = wid & 3, fr = lane & 15, fq = lane >> 4;
    const int K = g.K, nt = K / BK;
    int ts_lo = 0, ts_hi = 0, nts = 0; const unsigned long long rt_entry = STAMP ? (unsigned long long)wall_clock64() : 0ull;
#define PG8_STAMP() do { if (STAMP && wid == 0 && nts < 64) { const unsigned long long _c = (unsigned long long)clock64(); \
        ts_lo = (lane == nts) ? (int)(unsigned)_c : ts_lo; ts_hi = (lane == nts) ? (int)(unsigned)(_c >> 32) : ts_hi; ++nts; } } while (0)
    PG8_STAMP();
    unsigned voffA[2], voffB[2];
#pragma unroll
    for (int i = 0; i < 2; ++i) { int R, C; stage_rc(tid * 16 + i * 8192, R, C); const int Rb = Epi::PERM ? ((R & ~31) + perm32(R & 31)) : R;
        voffA[i] = (unsigned)(R * K + C) * 2u; voffB[i] = (unsigned)(Rb * K + C) * 2u; }
    const size_t kstep = (size_t)(BK * 2);
    const size_t hstep = (size_t)HALF * K * 2;
    const size_t tstep = 2 * hstep;
    const unsigned ldsw = (unsigned)wid * 1024u;
    const int aoff = lds_byte(wr * 64 + fr, fq * 8), boff = lds_byte(wc * 32 + fr, fq * 8);
#define PG8_SA(b, h) (((b) * 2 + (h)) * HTB)
#define PG8_SB(b, h) ((4 + (b) * 2 + (h)) * HTB)
#define PG8_STAGE(bufoff, gbase, voff) do { _Pragma("unroll") for (int _i = 0; _i < 2; ++_i) \
        __builtin_amdgcn_global_load_lds((const unsigned*)((const char*)(gbase) + (voff)[_i]), (PG8_LAS unsigned*)(lds + (bufoff) + ldsw + _i * 8192), 16, 0, 0); } while (0)
#define PG8_LDA(dst, b, h) do { _Pragma("unroll") for (int m = 0; m < 4; ++m) _Pragma("unroll") for (int k = 0; k < 2; ++k) dst[m][k] = *(const PG8_LAS bf16x8*)(lds + PG8_SA(b, h) + aoff + m * 2048 + k * 1024); } while (0)
#define PG8_LDB(dst, b, h) do { _Pragma("unroll") for (int n = 0; n < 2; ++n) _Pragma("unroll") for (int k = 0; k < 2; ++k) dst[n][k] = *(const PG8_LAS bf16x8*)(lds + PG8_SB(b, h) + boff + n * 2048 + k * 1024); } while (0)
#define PG8_MMA(ai, bj, At, Bt) do { __builtin_amdgcn_s_setprio(1); _Pragma("unroll") for (int m = 0; m < 4; ++m) _Pragma("unroll") for (int n = 0; n < 2; ++n) _Pragma("unroll") for (int k = 0; k < 2; ++k) \
        acc[ai][bj][m][n] = __builtin_amdgcn_mfma_f32_16x16x32_bf16(Bt[n][k], At[m][k], acc[ai][bj][m][n], 0, 0, 0); __builtin_amdgcn_s_setprio(0); } while (0)
#define PG8_WAIT_V(n) asm volatile("s_waitcnt vmcnt(" #n ")" ::: "memory")
#define PG8_WAIT_L(n) asm volatile("s_waitcnt lgkmcnt(" #n ")" ::: "memory")
#define PG8_BAR __builtin_amdgcn_s_barrier()
#define PG8_SCHED __builtin_amdgcn_sched_barrier(0)
    Unit cur, nxt; int ui = 0;
    if (!S.next(0, cur)) return;
    f32x4 acc[2][2][4][2];
#pragma unroll
    for (int a = 0; a < 2; ++a)
#pragma unroll
        for (int b = 0; b < 2; ++b)
#pragma unroll
            for (int m = 0; m < 4; ++m)
#pragma unroll
                for (int n = 0; n < 2; ++n) acc[a][b][m][n] = (f32x4){0.f, 0.f, 0.f, 0.f};
    bf16x8 At[4][2], B0[2][2], B1[2][2];
    const char* cA = (const char*)g.A + (size_t)cur.pm * tstep; const char* cB = (const char*)g.Bt + (size_t)cur.pn * tstep;
    S.a_ready(cur);
    PG8_STAGE(PG8_SB(0, 0), cB, voffB); PG8_STAGE(PG8_SA(0, 0), cA, voffA); PG8_STAGE(PG8_SB(0, 1), cB + hstep, voffB); PG8_STAGE(PG8_SA(0, 1), cA + hstep, voffA);
    if (wr == 1) PG8_BAR;
    PG8_WAIT_V(4); PG8_BAR;
    PG8_STAGE(PG8_SB(1, 0), cB + kstep, voffB); PG8_STAGE(PG8_SA(1, 0), cA + kstep, voffA); PG8_STAGE(PG8_SB(1, 1), cB + hstep + kstep, voffB);
    PG8_WAIT_V(6); PG8_BAR;
    PG8_STAMP();
    for (;;) {
        const bool has_next = S.next(ui + 1, nxt);
        const char* nA = has_next ? (const char*)g.A + (size_t)nxt.pm * tstep : cA; const char* nB = has_next ? (const char*)g.Bt + (size_t)nxt.pn * tstep : cB;
        for (int t = 0; t < nt; t += 2) {
            const bool last = (t == nt - 2);
            const char* a1 = cA + (size_t)(t + 1) * kstep;
            const char* a2 = last ? nA : cA + (size_t)(t + 2) * kstep; const char* b2 = last ? nB : cB + (size_t)(t + 2) * kstep;
            const char* a3 = a2 + kstep; const char* b3 = b2 + kstep;
            if (last && has_next) S.a_ready(nxt);
            PG8_LDB(B0, 0, 0); PG8_SCHED; PG8_LDA(At, 0, 0); PG8_STAGE(PG8_SA(1, 1), a1 + hstep, voffA);
            PG8_WAIT_L(8); PG8_BAR; PG8_WAIT_L(0); PG8_MMA(0, 0, At, B0); PG8_BAR; PG8_SCHED;
            PG8_LDB(B1, 0, 1); PG8_STAGE(PG8_SB(0, 0), b2, voffB);
            PG8_BAR; PG8_WAIT_L(0); PG8_MMA(0, 1, At, B1); PG8_BAR;
            PG8_LDA(At, 0, 1); PG8_STAGE(PG8_SA(0, 0), a2, voffA);
            PG8_BAR; PG8_WAIT_L(0); PG8_MMA(1, 0, At, B0); PG8_BAR; PG8_SCHED;
            PG8_STAGE(PG8_SB(0, 1), b2 + hstep, voffB);
            PG8_WAIT_V(6); PG8_BAR; PG8_MMA(1, 1, At, B1); PG8_BAR;
            PG8_LDB(B0, 1, 0); PG8_SCHED; PG8_LDA(At, 1, 0); PG8_STAGE(PG8_SA(0, 1), a2 + hstep, voffA);
            PG8_WAIT_L(8); PG8_BAR; PG8_WAIT_L(0); PG8_MMA(0, 0, At, B0); PG8_BAR; PG8_SCHED;
            PG8_LDB(B1, 1, 1); PG8_STAGE(PG8_SB(1, 0), b3, voffB);
            PG8_BAR; PG8_WAIT_L(0); PG8_MMA(0, 1, At, B1); PG8_BAR;
            PG8_LDA(At, 1, 1); PG8_STAGE(PG8_SA(1, 0), a3, voffA);
            PG8_BAR; PG8_WAIT_L(0); PG8_MMA(1, 0, At, B0); PG8_BAR; PG8_SCHED;
            PG8_STAGE(PG8_SB(1, 1), b3 + hstep, voffB);
            PG8_WAIT_V(6); PG8_BAR; PG8_MMA(1, 1, At, B1); PG8_BAR;
        }
        PG8_STAMP();
        if constexpr (!Epi::AFTER_DRAIN) { E(acc, cur, wr, wc, fr, fq); S.done(cur); }
        PG8_STAMP();
        if (!has_next) break;
#pragma unroll
        for (int a = 0; a < 2; ++a)
#pragma unroll
            for (int b = 0; b < 2; ++b)
#pragma unroll
                for (int m = 0; m < 4; ++m)
#pragma unroll
                    for (int n = 0; n < 2; ++n) acc[a][b][m][n] = (f32x4){0.f, 0.f, 0.f, 0.f};
        cur = nxt; cA = nA; cB = nB; ++ui;
    }
    PG8_WAIT_V(0);
    if (wr == 0) PG8_BAR;
    PG8_BAR;
    if constexpr (Epi::AFTER_DRAIN) { E.fused(acc, cur, wr, wc, fr, fq, lds, wid, lane); S.done(cur); }
    PG8_STAMP();
    if (STAMP && wid == 0) { stamps[lane] = lane < nts ? (((unsigned long long)(unsigned)ts_hi << 32) | (unsigned)ts_lo) : 0ull;
        if (lane == 62) stamps[62] = rt_entry; if (lane == 63) stamps[63] = (unsigned long long)wall_clock64(); }
#undef PG8_STAMP
#undef PG8_SA
#undef PG8_SB
#undef PG8_STAGE
#undef PG8_LDA
#undef PG8_LDB
#undef PG8_MMA
#undef PG8_WAIT_V
#undef PG8_WAIT_L
#undef PG8_BAR
#undef PG8_SCHED
}
}


constexpr size_t MBy = 1u << 20;
constexpr size_t WS_WTIN = 0, WS_WTOUT = 6 * MBy, WS_WTQ = 8 * MBy, WS_CTL = 12 * MBy, WS_ROWSS = 12 * MBy + 65536, WS_ACT = 13 * MBy, WS_PROJ = 45 * MBy,
                 WS_SB = 141 * MBy, WS_IDX = 173 * MBy, WS_GATE = 181 * MBy, WS_U8 = 189 * MBy, WS_V8 = 205 * MBy, WS_PW = 221 * MBy,
                 WS_UINV = 12 * MBy + 262144, WS_VINV = 12 * MBy + 393216;
constexpr int VIMP = 136, VWAVE = 128 * VIMP + 2048;
constexpr int LDS_MISC = 8 * VWAVE, LDS_BYTES = 8 * VWAVE + 256;
static_assert(LDS_MISC >= pg8::STAGE_BYTES && LDS_BYTES <= 163840, "LDS budget");

struct Params {
  const float *x, *norm1_g, *w_in, *q_norm_g, *k_norm_g, *conv_w, *sb_out_g, *conv_out_g, *w_out, *norm2_g, *w_q, *sub_keys, *peer_u, *peer_v;
  float* out; unsigned char* ws; int ph_lo, ph_hi;
};

#define XB_TMO      128
#define XB_XCNT(j)  (256  + 64 * (j))
#define XB_XSUB(j)  (1280 + 64 * (j))
#define XB_XGEN(j)  (2304 + 64 * (j))
#define XB_TOP      3328
#define XB_TOPGEN   3392
#define XCD_BAR_WORDS 3456
#define XB_SPIN_CAP (1u << 18)
DI unsigned xb_ld(unsigned* p) { return __hip_atomic_load(p, __ATOMIC_RELAXED, __HIP_MEMORY_SCOPE_AGENT); }
DI unsigned xb_add(unsigned* p, unsigned v) { return __hip_atomic_fetch_add(p, v, __ATOMIC_RELAXED, __HIP_MEMORY_SCOPE_AGENT); }
DI unsigned xb_xcc_id() { return (unsigned)__builtin_amdgcn_s_getreg((3 << 11) | 20) & 0xFu; }
#define XB_SPIN(cond, bar) do { unsigned _sp = 0; while (cond) { __builtin_amdgcn_s_sleep(1); \
    if ((++_sp & 255u) == 0u) { if (xb_ld(&(bar)[XB_TMO])) break; if (_sp > XB_SPIN_CAP) { atomicAdd(&(bar)[XB_TMO], 1u); break; } } } } while (0)
struct XcdBarrier { unsigned* bar; unsigned x; volatile LAS unsigned* st; };
DI XcdBarrier xcd_barrier_post(unsigned* bar, volatile LAS unsigned* st) {
  XcdBarrier b; b.bar = bar; b.x = xb_xcc_id(); b.st = st;
  if (threadIdx.x == 0) (void)xb_add(&bar[XB_XCNT(b.x)], 1u);
  return b;
}
DI void xcd_barrier_complete(unsigned* bar, unsigned x, unsigned& nloc, unsigned& nx) {
  const unsigned G = gridDim.x * gridDim.y * gridDim.z;
  unsigned sum, cnt, mine, sp = 0u;
  for (;;) {
    sum = 0u; cnt = 0u; mine = 0u;
#pragma unroll
    for (unsigned j = 0; j < 16; ++j) { const unsigned c = xb_ld(&bar[XB_XCNT(j)]); sum += c; cnt += (c > 0u) ? 1u : 0u; mine = (j == x) ? c : mine; }
    if (sum == G) break;
    __builtin_amdgcn_s_sleep(1);
    if ((++sp & 255u) == 0u) { if (xb_ld(&bar[XB_TMO])) break; if (sp > XB_SPIN_CAP) { atomicAdd(&bar[XB_TMO], 1u); break; } }
  }
  nloc = mine > 0u ? mine : 1u; nx = cnt > 0u ? cnt : 1u;
}
DI void xcd_barrier(const XcdBarrier& b) {
  asm volatile("s_waitcnt vmcnt(0)" ::: "memory");
  __syncthreads();
  if (threadIdx.x == 0) {
    unsigned* bar = b.bar;
    __builtin_amdgcn_s_waitcnt(0);
    unsigned nloc = b.st[0], nx = b.st[1];
    if (nloc == 0u) { xcd_barrier_complete(bar, b.x, nloc, nx); b.st[0] = nloc; b.st[1] = nx; }
    const unsigned old = xb_add(&bar[XB_XSUB(b.x)], 1u);
    const unsigned gen = old / nloc;
    if (old + 1u == (gen + 1u) * nloc) {
      __builtin_amdgcn_fence(__ATOMIC_RELEASE, "agent");
      asm volatile("s_waitcnt vmcnt(0)" ::: "memory");
      const unsigned og = xb_add(&bar[XB_TOP], 1u);
      const unsigned tg = og / nx;
      if (og + 1u == (tg + 1u) * nx) xb_add(&bar[XB_TOPGEN], 1u);
      else XB_SPIN(xb_ld(&bar[XB_TOPGEN]) == tg, bar);
      __builtin_amdgcn_fence(__ATOMIC_ACQUIRE, "agent");
      xb_add(&bar[XB_XGEN(b.x)], 1u);
      asm volatile("s_waitcnt vmcnt(0)" ::: "memory");
    } else {
      XB_SPIN(xb_ld(&bar[XB_XGEN(b.x)]) == gen, bar);
      __builtin_amdgcn_fence(__ATOMIC_ACQUIRE, "agent");
      asm volatile("s_waitcnt vmcnt(0)" ::: "memory");
    }
  }
  __syncthreads();
}

DI u16 f2bf(float x) { unsigned u = __float_as_uint(x); u += 0x7fffu + ((u >> 16) & 1u); return (u16)(u >> 16); }
DI float bflo(unsigned w) { return __uint_as_float(w << 16); }
DI float bfhi(unsigned w) { return __uint_as_float(w & 0xffff0000u); }
DI unsigned pack2(float a, float b) { return (unsigned)f2bf(a) | ((unsigned)f2bf(b) << 16); }
DI float wave_sum(float v) {
#pragma unroll
  for (int o = 32; o >= 1; o >>= 1) v += __shfl_xor(v, o);
  return v;
}
DI float wave_max(float v) {
#pragma unroll
  for (int o = 32; o >= 1; o >>= 1) v = fmaxf(v, __shfl_xor(v, o));
  return v;
}
DI void unpack8(const uint4 w, float* f) {
  f[0] = bflo(w.x); f[1] = bfhi(w.x); f[2] = bflo(w.y); f[3] = bfhi(w.y); f[4] = bflo(w.z); f[5] = bfhi(w.z); f[6] = bflo(w.w); f[7] = bfhi(w.w);
}
DI uint4 pack8(const float* f) { uint4 o; o.x = pack2(f[0], f[1]); o.y = pack2(f[2], f[3]); o.z = pack2(f[4], f[5]); o.w = pack2(f[6], f[7]); return o; }

DI void transpose_convert(const float* __restrict__ W, u16* __restrict__ Wt, int K, int N, const float* __restrict__ rg, float* sm) {
  const int tid = threadIdx.x, tn_cnt = N / 64, ntile = (K / 64) * tn_cnt;
  for (int tile = blockIdx.x; tile < ntile; tile += gridDim.x) {
    const int tk = tile / tn_cnt, tn = tile % tn_cnt;
    __syncthreads();
#pragma unroll
    for (int r = 0; r < 2; ++r) { const int row = r * 32 + (tid >> 4), c4 = (tid & 15) * 4;
      const float g = rg ? rg[tk * 64 + row] : 1.f;
      const float4 v = *(const float4*)(W + (size_t)(tk * 64 + row) * N + tn * 64 + c4);
      sm[row * 65 + c4] = v.x * g; sm[row * 65 + c4 + 1] = v.y * g; sm[row * 65 + c4 + 2] = v.z * g; sm[row * 65 + c4 + 3] = v.w * g; }
    __syncthreads();
    { const int n = tid & 63, k0 = (tid >> 6) * 8;
      float f[8];
#pragma unroll
      for (int j = 0; j < 8; ++j) f[j] = sm[(k0 + j) * 65 + n];
      *(uint4*)(Wt + (size_t)(tn * 64 + n) * K + tk * 64 + k0) = pack8(f); }
  }
}
template <bool SLICED>
DI void convert_fp4_rows(const float* __restrict__ src, const float* __restrict__ cg, unsigned char* __restrict__ dst, float* __restrict__ inv_out) {
  const int lane = threadIdx.x & 63, gw = blockIdx.x * NWAVES + (threadIdx.x >> 6), nw = gridDim.x * NWAVES;
  float4 g[4];
#pragma unroll
  for (int k = 0; k < 4; ++k) g[k] = cg ? ((const float4*)cg)[lane + 64 * k] : make_float4(1.f, 1.f, 1.f, 1.f);
  for (int row0 = gw * 4; row0 < NEXP; row0 += nw * 4) {
    float4 a[4][4];
#pragma unroll
    for (int rr = 0; rr < 4; ++rr)
#pragma unroll
      for (int k = 0; k < 4; ++k) a[rr][k] = ((const float4*)(src + (size_t)(row0 + rr) * D))[lane + 64 * k];
#pragma unroll
    for (int rr = 0; rr < 4; ++rr) {
      float am = 0.f;
#pragma unroll
      for (int k = 0; k < 4; ++k) { a[rr][k].x *= g[k].x; a[rr][k].y *= g[k].y; a[rr][k].z *= g[k].z; a[rr][k].w *= g[k].w;
        am = fmaxf(fmaxf(am, fmaxf(fabsf(a[rr][k].x), fabsf(a[rr][k].y))), fmaxf(fabsf(a[rr][k].z), fabsf(a[rr][k].w))); }
      am = wave_max(am);
      const float sc = am > 0.f ? 6.f / am : 1.f;
      const int row = row0 + rr;
#pragma unroll
      for (int k = 0; k < 4; ++k) {
        unsigned w = 0u;
        w = __builtin_amdgcn_cvt_scalef32_pk_fp4_f32(w, a[rr][k].x * sc, a[rr][k].y * sc, 1.0f, 0); w = __builtin_amdgcn_cvt_scalef32_pk_fp4_f32(w, a[rr][k].z * sc, a[rr][k].w * sc, 1.0f, 1);
        if (SLICED) *(u16*)(dst + (size_t)k * ((size_t)NEXP * 128) + (size_t)row * 128 + 2 * lane) = (u16)w;
        else *(u16*)(dst + (size_t)row * 512 + 128 * k + 2 * lane) = (u16)w;
      }
      if (lane == 0) inv_out[row] = am > 0.f ? am * (1.f / 6.f) : 1.f;
    }
  }
}
DI void rmsnorm1024(const float* __restrict__ src, const float* __restrict__ g, u16* __restrict__ dst) {
  const int lane = threadIdx.x & 63, gw = blockIdx.x * NWAVES + (threadIdx.x >> 6), nw = gridDim.x * NWAVES;
  float4 gg[4];
#pragma unroll
  for (int j = 0; j < 4; ++j) gg[j] = ((const float4*)g)[lane + 64 * j];
  for (int row0 = gw * 4; row0 < T; row0 += nw * 4) {
    float4 v[4][4];
#pragma unroll
    for (int rr = 0; rr < 4; ++rr)
#pragma unroll
      for (int j = 0; j < 4; ++j) v[rr][j] = ((const float4*)(src + (size_t)(row0 + rr) * D))[lane + 64 * j];
#pragma unroll
    for (int rr = 0; rr < 4; ++rr) {
      float ss = 0.f;
#pragma unroll
      for (int j = 0; j < 4; ++j) ss += v[rr][j].x * v[rr][j].x + v[rr][j].y * v[rr][j].y + v[rr][j].z * v[rr][j].z + v[rr][j].w * v[rr][j].w;
      ss = wave_sum(ss);
      const float inv = rsqrtf(ss * (1.f / D) + EPS);
#pragma unroll
      for (int j = 0; j < 4; ++j) {
        uint2 o; o.x = pack2(v[rr][j].x * inv * gg[j].x, v[rr][j].y * inv * gg[j].y); o.y = pack2(v[rr][j].z * inv * gg[j].z, v[rr][j].w * inv * gg[j].w);
        *(uint2*)(dst + (size_t)(row0 + rr) * D + 4 * (lane + 64 * j)) = o;
      }
    }
  }
}

DI void conv_tokens(const Params& p, const u16* __restrict__ proj, u16* __restrict__ mixed) {
  const int lane = threadIdx.x & 63, gw = blockIdx.x * NWAVES + (threadIdx.x >> 6), nw = gridDim.x * NWAVES;
  const int c0 = 8 * lane;
  float w0[8], w1[8], w2[8], go[8];
#pragma unroll
  for (int j = 0; j < 8; ++j) { w0[j] = p.conv_w[c0 + j]; w1[j] = p.conv_w[DSB + c0 + j]; w2[j] = p.conv_w[2 * DSB + c0 + j]; go[j] = p.conv_out_g[c0 + j]; }
#pragma unroll 2
  for (int t = gw; t < T; t += nw) {
    const u16* row = proj + (size_t)t * DIN;
    const int tpos = t & (SEQ - 1);
    float xc[8], bg[8], cg[8], y[8];
    unpack8(*(const uint4*)(row + 1536 + c0), xc); unpack8(*(const uint4*)(row + 2048 + c0), bg); unpack8(*(const uint4*)(row + 2560 + c0), cg);
#pragma unroll
    for (int j = 0; j < 8; ++j) y[j] = w2[j] * (cg[j] * xc[j]);
    if (tpos >= 1) {
      float x1[8], c1[8]; unpack8(*(const uint4*)(row - DIN + 1536 + c0), x1); unpack8(*(const uint4*)(row - DIN + 2560 + c0), c1);
#pragma unroll
      for (int j = 0; j < 8; ++j) y[j] += w1[j] * (c1[j] * x1[j]);
    }
    if (tpos >= 2) {
      float x2[8], c2[8]; unpack8(*(const uint4*)(row - 2 * DIN + 1536 + c0), x2); unpack8(*(const uint4*)(row - 2 * DIN + 2560 + c0), c2);
#pragma unroll
      for (int j = 0; j < 8; ++j) y[j] += w0[j] * (c2[j] * x2[j]);
    }
    float ss = 0.f;
#pragma unroll
    for (int j = 0; j < 8; ++j) { y[j] *= bg[j]; ss += y[j] * y[j]; }
    ss = wave_sum(ss);
    const float inv = rsqrtf(ss * (1.f / DSB) + EPS);
#pragma unroll
    for (int j = 0; j < 8; ++j) y[j] = y[j] * inv * go[j];
    *(uint4*)(mixed + (size_t)t * D + DSB + c0) = pack8(y);
  }
}

typedef float f32x16_t __attribute__((ext_vector_type(16)));
typedef short bf16x8_t __attribute__((ext_vector_type(8)));
DI bf16x8_t pack_bf16x8(float a0, float a1, float a2, float a3, float a4, float a5, float a6, float a7) {
  pg8::u32x4 r;
  asm volatile("v_cvt_pk_bf16_f32 %0, %4, %5\n\tv_cvt_pk_bf16_f32 %1, %6, %7\n\tv_cvt_pk_bf16_f32 %2, %8, %9\n\tv_cvt_pk_bf16_f32 %3, %10, %11\n\ts_nop 1"
               : "=&v"(r[0]), "=&v"(r[1]), "=&v"(r[2]), "=&v"(r[3]) : "v"(a0), "v"(a1), "v"(a2), "v"(a3), "v"(a4), "v"(a5), "v"(a6), "v"(a7));
  return __builtin_bit_cast(bf16x8_t, r);
}
struct AttnKV { bf16x8_t k0, k1, k2, k3, v00, v01, v10, v11; float ik[16]; };
DI void attn_load(AttnKV& f, const u16* __restrict__ kr, const u16* __restrict__ vr, const float* __restrict__ ksq) {
  f.k0 = *(const bf16x8_t*)(kr); f.k1 = *(const bf16x8_t*)(kr + 16); f.k2 = *(const bf16x8_t*)(kr + 32); f.k3 = *(const bf16x8_t*)(kr + 48);
  f.v00 = *(const bf16x8_t*)(vr); f.v01 = *(const bf16x8_t*)(vr + 8); f.v10 = *(const bf16x8_t*)(vr + 32 * SEQ); f.v11 = *(const bf16x8_t*)(vr + 32 * SEQ + 8);
#pragma unroll
  for (int r4 = 0; r4 < 4; ++r4) { const float4 q4 = ((const float4*)ksq)[r4];
    f.ik[4 * r4] = rsqrtf(q4.x * (1.f / 64.f) + EPS); f.ik[4 * r4 + 1] = rsqrtf(q4.y * (1.f / 64.f) + EPS); f.ik[4 * r4 + 2] = rsqrtf(q4.z * (1.f / 64.f) + EPS); f.ik[4 * r4 + 3] = rsqrtf(q4.w * (1.f / 64.f) + EPS); }
}
template <bool DIAG>
DI void attn_half(const AttnKV& f, const bf16x8_t (&qf)[4], int c, int hh, float& carry, f32x16_t& o0, f32x16_t& o1) {
  f32x16_t s;
#pragma unroll
  for (int r = 0; r < 16; ++r) s[r] = 0.f;
  s = __builtin_amdgcn_mfma_f32_32x32x16_bf16(f.k0, qf[0], s, 0, 0, 0); s = __builtin_amdgcn_mfma_f32_32x32x16_bf16(f.k1, qf[1], s, 0, 0, 0);
  s = __builtin_amdgcn_mfma_f32_32x32x16_bf16(f.k2, qf[2], s, 0, 0, 0); s = __builtin_amdgcn_mfma_f32_32x32x16_bf16(f.k3, qf[3], s, 0, 0, 0);
  float rr[16], be[16];
#pragma unroll
  for (int r = 0; r < 16; ++r) {
    const float e = __builtin_amdgcn_exp2f(fminf(s[r] * f.ik[r] * 0.18033688011112042f, 100.f));
    float x = __builtin_amdgcn_rcpf(1.f + e), b = e * x;
    if (DIAG) { const bool on = (16 * hh + r) < c; x = on ? x : 1.f; b = on ? b : 0.f; }
    rr[r] = x; be[r] = b;
  }
  float tot = ((rr[0] * rr[1]) * (rr[2] * rr[3])) * ((rr[4] * rr[5]) * (rr[6] * rr[7]));
  tot *= ((rr[8] * rr[9]) * (rr[10] * rr[11])) * ((rr[12] * rr[13]) * (rr[14] * rr[15]));
  const float oth = __shfl_xor(tot, 32);
  float P = hh ? carry : carry * oth;
  float a[16];
#pragma unroll
  for (int r = 15; r >= 0; --r) { a[r] = be[r] * P; P *= rr[r]; }
  carry = carry * tot * oth;
  const bf16x8_t af0 = pack_bf16x8(a[0], a[1], a[2], a[3], a[4], a[5], a[6], a[7]), af1 = pack_bf16x8(a[8], a[9], a[10], a[11], a[12], a[13], a[14], a[15]);
  o0 = __builtin_amdgcn_mfma_f32_32x32x16_bf16(f.v00, af0, o0, 0, 0, 0); o0 = __builtin_amdgcn_mfma_f32_32x32x16_bf16(f.v01, af1, o0, 0, 0, 0);
  o1 = __builtin_amdgcn_mfma_f32_32x32x16_bf16(f.v10, af0, o1, 0, 0, 0); o1 = __builtin_amdgcn_mfma_f32_32x32x16_bf16(f.v11, af1, o1, 0, 0, 0);
}
DI void attn_phase(const Params& p, const u16* __restrict__ proj, const u16* __restrict__ vt, const float* __restrict__ ssq, u16* __restrict__ mixed, unsigned char* smem) {
  const int lane = threadIdx.x & 63, head = threadIdx.x >> 6, c = lane & 31, hh = lane >> 5;
  LAS float* red = (LAS float*)smem;
  const int kap = 16 * ((c >> 2) & 1) + (c & 3) + 4 * (c >> 3);
  for (int item = blockIdx.x; item < 4 * 64; item += gridDim.x) {
    const int b = item & 3, q0 = (63 - (item >> 2)) * 64;
    const size_t tq = (size_t)b * SEQ + q0 + c;
    const float* qsq = ssq + ((size_t)(b * 8 + head)) * SEQ;
    const float* ksqb = ssq + ((size_t)(32 + b * 8 + head)) * SEQ + 16 * hh;
    bf16x8_t qL[4], qU[4];
#pragma unroll
    for (int up = 0; up < 2; ++up) {
      const float iq = rsqrtf(qsq[q0 + 32 * up + c] * (1.f / 64.f) + EPS);
#pragma unroll
      for (int ks = 0; ks < 4; ++ks) { float f[8]; unpack8(*(const uint4*)(proj + (tq + 32 * up) * DIN + head * 64 + 16 * ks + 8 * hh), f);
        float gq[8];
        { const float4 qa = *(const float4*)(p.q_norm_g + 16 * ks + 8 * hh), qb = *(const float4*)(p.q_norm_g + 16 * ks + 8 * hh + 4), ka = *(const float4*)(p.k_norm_g + 16 * ks + 8 * hh), kb = *(const float4*)(p.k_norm_g + 16 * ks + 8 * hh + 4);
          gq[0] = qa.x * ka.x * iq; gq[1] = qa.y * ka.y * iq; gq[2] = qa.z * ka.z * iq; gq[3] = qa.w * ka.w * iq; gq[4] = qb.x * kb.x * iq; gq[5] = qb.y * kb.y * iq; gq[6] = qb.z * kb.z * iq; gq[7] = qb.w * kb.w * iq; }
        const bf16x8_t v = pack_bf16x8(f[0] * gq[0], f[1] * gq[1], f[2] * gq[2], f[3] * gq[3], f[4] * gq[4], f[5] * gq[5], f[6] * gq[6], f[7] * gq[7]);
        if (up) qU[ks] = v; else qL[ks] = v; }
    }
    f32x16_t oL0, oL1, oU0, oU1;
#pragma unroll
    for (int r = 0; r < 16; ++r) { oL0[r] = 0.f; oL1[r] = 0.f; oU0[r] = 0.f; oU1[r] = 0.f; }
    float cL = 1.f, cU = 1.f;
    const u16* kbase = proj + ((size_t)b * SEQ + kap) * DIN + 512 + head * 64 + 8 * hh;
    const u16* vbase = vt + ((size_t)(b * 512 + head * 64 + c)) * SEQ + 16 * hh;
    AttnKV kv;
    attn_load(kv, kbase + (size_t)(q0 + 32) * DIN, vbase + q0 + 32, ksqb + q0 + 32);
    attn_half<true>(kv, qU, c, hh, cU, oU0, oU1);
    attn_load(kv, kbase + (size_t)q0 * DIN, vbase + q0, ksqb + q0);
    attn_half<false>(kv, qU, c, hh, cU, oU0, oU1);
    attn_half<true>(kv, qL, c, hh, cL, oL0, oL1);
    for (int tb = q0 - 32; tb >= 0; tb -= 32) {
      attn_load(kv, kbase + (size_t)tb * DIN, vbase + tb, ksqb + tb);
      const bool uz = __all(cU == 0.f);
      if (!uz) attn_half<false>(kv, qU, c, hh, cU, oU0, oU1);
      attn_half<false>(kv, qL, c, hh, cL, oL0, oL1);
      if (uz && __all(cL == 0.f)) break;
    }
    float sL = 0.f, sU = 0.f;
#pragma unroll
    for (int r = 0; r < 16; ++r) { sL += oL0[r] * oL0[r] + oL1[r] * oL1[r]; sU += oU0[r] * oU0[r] + oU1[r] * oU1[r]; }
    sL += __shfl_xor(sL, 32); sU += __shfl_xor(sU, 32);
    __syncthreads();
    if (hh == 0) { red[head * 64 + c] = sL; red[head * 64 + 32 + c] = sU; }
    __syncthreads();
    float tL = 0.f, tU = 0.f;
#pragma unroll
    for (int h8 = 0; h8 < 8; ++h8) { tL += red[h8 * 64 + c]; tU += red[h8 * 64 + 32 + c]; }
    const float* g = p.sb_out_g + head * 64 + 4 * hh;
#pragma unroll
    for (int up = 0; up < 2; ++up) {
      const float inv = rsqrtf((up ? tU : tL) * (1.f / DSB) + EPS);
      u16* orow = mixed + (tq + 32 * up) * D + head * 64 + 4 * hh;
#pragma unroll
      for (int rg = 0; rg < 4; ++rg) {
        const float4 g0 = *(const float4*)(g + 8 * rg), g1 = *(const float4*)(g + 32 + 8 * rg);
        const float a0 = up ? oU0[4 * rg] : oL0[4 * rg], a1 = up ? oU0[4 * rg + 1] : oL0[4 * rg + 1], a2 = up ? oU0[4 * rg + 2] : oL0[4 * rg + 2], a3 = up ? oU0[4 * rg + 3] : oL0[4 * rg + 3];
        const float b0 = up ? oU1[4 * rg] : oL1[4 * rg], b1 = up ? oU1[4 * rg + 1] : oL1[4 * rg + 1], b2 = up ? oU1[4 * rg + 2] : oL1[4 * rg + 2], b3 = up ? oU1[4 * rg + 3] : oL1[4 * rg + 3];
        uint2 w0, w1;
        w0.x = pack2(a0 * inv * g0.x, a1 * inv * g0.y); w0.y = pack2(a2 * inv * g0.z, a3 * inv * g0.w);
        w1.x = pack2(b0 * inv * g1.x, b1 * inv * g1.y); w1.y = pack2(b2 * inv * g1.z, b3 * inv * g1.w);
        *(uint2*)(orow + 8 * rg) = w0; *(uint2*)(orow + 32 + 8 * rg) = w1;
      }
    }
  }
}
#define SEL_DI DI
#define SEL_F2U(x) __float_as_uint(x)
#define SEL_U2F(x) __uint_as_float(x)

#define CE(a, b) do { const unsigned _h = (a) > (b) ? (a) : (b), _l = (a) > (b) ? (b) : (a); (a) = _h; (b) = _l; } while (0)
SEL_DI void sort16(unsigned (&v)[16]) {
  CE(v[0], v[1]); CE(v[2], v[3]); CE(v[0], v[2]); CE(v[1], v[3]); CE(v[1], v[2]); CE(v[4], v[5]); CE(v[6], v[7]); CE(v[4], v[6]);
  CE(v[5], v[7]); CE(v[5], v[6]); CE(v[0], v[4]); CE(v[2], v[6]); CE(v[2], v[4]); CE(v[1], v[5]); CE(v[3], v[7]); CE(v[3], v[5]);
  CE(v[1], v[2]); CE(v[3], v[4]); CE(v[5], v[6]); CE(v[8], v[9]); CE(v[10], v[11]); CE(v[8], v[10]); CE(v[9], v[11]); CE(v[9], v[10]);
  CE(v[12], v[13]); CE(v[14], v[15]); CE(v[12], v[14]); CE(v[13], v[15]); CE(v[13], v[14]); CE(v[8], v[12]); CE(v[10], v[14]); CE(v[10], v[12]);
  CE(v[9], v[13]); CE(v[11], v[15]); CE(v[11], v[13]); CE(v[9], v[10]); CE(v[11], v[12]); CE(v[13], v[14]); CE(v[0], v[8]); CE(v[4], v[12]);
  CE(v[4], v[8]); CE(v[2], v[10]); CE(v[6], v[14]); CE(v[6], v[10]); CE(v[2], v[4]); CE(v[6], v[8]); CE(v[10], v[12]); CE(v[1], v[9]);
  CE(v[5], v[13]); CE(v[5], v[9]); CE(v[3], v[11]); CE(v[7], v[15]); CE(v[7], v[11]); CE(v[3], v[5]); CE(v[7], v[9]); CE(v[11], v[13]);
  CE(v[1], v[2]); CE(v[3], v[4]); CE(v[5], v[6]); CE(v[7], v[8]); CE(v[9], v[10]); CE(v[11], v[12]); CE(v[13], v[14]);
}
SEL_DI void bitonic_merge16(unsigned (&v)[16]) {
#pragma unroll
  for (int d = 8; d >= 1; d >>= 1)
#pragma unroll
    for (int i = 0; i < 16; ++i) if ((i & d) == 0) CE(v[i], v[i + d]);
}
SEL_DI void merge_top16(unsigned (&a)[16], const unsigned (&b)[16]) {
#pragma unroll
  for (int i = 0; i < 16; ++i) a[i] = a[i] > b[15 - i] ? a[i] : b[15 - i];
  bitonic_merge16(a);
}
SEL_DI void top16_of_64(unsigned (&g0)[16], unsigned (&g1)[16], unsigned (&g2)[16], unsigned (&g3)[16]) {
  sort16(g0); sort16(g1); sort16(g2); sort16(g3);
  merge_top16(g0, g1); merge_top16(g2, g3); merge_top16(g0, g2);
}
SEL_DI unsigned cand_key(float a, float b, unsigned payload) {
  float s = a + b; s = s < 32.0f ? 32.0f : (s > 127.99f ? 127.99f : s);
  return ((SEL_F2U(s) << 8) & 0xFFFFC000u) | payload;
}
SEL_DI void stage2(const unsigned (&L1)[16], const unsigned (&L2)[16], unsigned (&R)[16]) {
  float f1[16], f2m[16]; unsigned P1[16], P2[16];
#pragma unroll
  for (int i = 0; i < 16; ++i) { f1[i] = SEL_U2F(L1[i] & ~127u); f2m[i] = SEL_U2F(L2[i] & ~127u) - 64.0f; P1[i] = (L1[i] & 127u) << 7; P2[i] = L2[i] & 127u; }
  unsigned K[64];
  K[0] = cand_key(f1[0], f2m[0], P1[0] | P2[0]);
  K[1] = cand_key(f1[0], f2m[1], P1[0] | P2[1]);
  K[2] = cand_key(f1[0], f2m[2], P1[0] | P2[2]);
  K[3] = cand_key(f1[0], f2m[3], P1[0] | P2[3]);
  K[4] = cand_key(f1[0], f2m[4], P1[0] | P2[4]);
  K[5] = cand_key(f1[0], f2m[5], P1[0] | P2[5]);
  K[6] = cand_key(f1[0], f2m[6], P1[0] | P2[6]);
  K[7] = cand_key(f1[0], f2m[7], P1[0] | P2[7]);
  K[8] = cand_key(f1[0], f2m[8], P1[0] | P2[8]);
  K[9] = cand_key(f1[0], f2m[9], P1[0] | P2[9]);
  K[10] = cand_key(f1[0], f2m[10], P1[0] | P2[10]);
  K[11] = cand_key(f1[0], f2m[11], P1[0] | P2[11]);
  K[12] = cand_key(f1[0], f2m[12], P1[0] | P2[12]);
  K[13] = cand_key(f1[0], f2m[13], P1[0] | P2[13]);
  K[14] = cand_key(f1[0], f2m[14], P1[0] | P2[14]);
  K[15] = cand_key(f1[0], f2m[15], P1[0] | P2[15]);
  K[16] = cand_key(f1[1], f2m[0], P1[1] | P2[0]);
  K[17] = cand_key(f1[1], f2m[1], P1[1] | P2[1]);
  K[18] = cand_key(f1[1], f2m[2], P1[1] | P2[2]);
  K[19] = cand_key(f1[1], f2m[3], P1[1] | P2[3]);
  K[20] = cand_key(f1[1], f2m[4], P1[1] | P2[4]);
  K[21] = cand_key(f1[1], f2m[5], P1[1] | P2[5]);
  K[22] = cand_key(f1[1], f2m[6], P1[1] | P2[6]);
  K[23] = cand_key(f1[1], f2m[7], P1[1] | P2[7]);
  K[24] = cand_key(f1[2], f2m[0], P1[2] | P2[0]);
  K[25] = cand_key(f1[2], f2m[1], P1[2] | P2[1]);
  K[26] = cand_key(f1[2], f2m[2], P1[2] | P2[2]);
  K[27] = cand_key(f1[2], f2m[3], P1[2] | P2[3]);
  K[28] = cand_key(f1[2], f2m[4], P1[2] | P2[4]);
  K[29] = cand_key(f1[3], f2m[0], P1[3] | P2[0]);
  K[30] = cand_key(f1[3], f2m[1], P1[3] | P2[1]);
  K[31] = cand_key(f1[3], f2m[2], P1[3] | P2[2]);
  K[32] = cand_key(f1[3], f2m[3], P1[3] | P2[3]);
  K[33] = cand_key(f1[4], f2m[0], P1[4] | P2[0]);
  K[34] = cand_key(f1[4], f2m[1], P1[4] | P2[1]);
  K[35] = cand_key(f1[4], f2m[2], P1[4] | P2[2]);
  K[36] = cand_key(f1[5], f2m[0], P1[5] | P2[0]);
  K[37] = cand_key(f1[5], f2m[1], P1[5] | P2[1]);
  K[38] = cand_key(f1[6], f2m[0], P1[6] | P2[0]);
  K[39] = cand_key(f1[6], f2m[1], P1[6] | P2[1]);
  K[40] = cand_key(f1[7], f2m[0], P1[7] | P2[0]);
  K[41] = cand_key(f1[7], f2m[1], P1[7] | P2[1]);
  K[42] = cand_key(f1[8], f2m[0], P1[8] | P2[0]);
  K[43] = cand_key(f1[9], f2m[0], P1[9] | P2[0]);
  K[44] = cand_key(f1[10], f2m[0], P1[10] | P2[0]);
  K[45] = cand_key(f1[11], f2m[0], P1[11] | P2[0]);
  K[46] = cand_key(f1[12], f2m[0], P1[12] | P2[0]);
  K[47] = cand_key(f1[13], f2m[0], P1[13] | P2[0]);
  K[48] = cand_key(f1[14], f2m[0], P1[14] | P2[0]);
  K[49] = cand_key(f1[15], f2m[0], P1[15] | P2[0]);
#pragma unroll
  for (int c = 50; c < 64; ++c) K[c] = 0u;
  unsigned g1[16], g2[16], g3[16];
#pragma unroll
  for (int i = 0; i < 16; ++i) { R[i] = K[i]; g1[i] = K[16 + i]; g2[i] = K[32 + i]; g3[i] = K[48 + i]; }
  sort16(R); sort16(g1); sort16(g2); CE(g3[0], g3[1]);
  merge_top16(R, g1);
  g2[15] = g2[15] > g3[0] ? g2[15] : g3[0]; g2[14] = g2[14] > g3[1] ? g2[14] : g3[1];
  bitonic_merge16(g2);
  merge_top16(R, g2);
}

constexpr int SKP = 272;
struct QFrag { bf16x8_t f[8]; };
DI QFrag stage1_load(const u16* __restrict__ qrow, int hh) { QFrag q;
#pragma unroll
  for (int ks = 0; ks < 8; ++ks) q.f[ks] = *(const bf16x8_t*)(qrow + 16 * ks + 8 * hh);
  return q; }
DI void stage1(const QFrag& qfr, const LAS unsigned char* sk, int tok, int hh, unsigned (&out)[16]) {
  f32x16_t acc[4];
#pragma unroll
  for (int kt = 0; kt < 4; ++kt)
#pragma unroll
    for (int r = 0; r < 16; ++r) acc[kt][r] = 64.0f;
#pragma unroll
  for (int ks = 0; ks < 8; ++ks) {
#pragma unroll
    for (int kt = 0; kt < 4; ++kt) {
      const bf16x8_t ak = *(const LAS bf16x8_t*)(sk + (32 * kt + tok) * SKP + (16 * ks + 8 * hh) * 2);
      acc[kt] = __builtin_amdgcn_mfma_f32_32x32x16_bf16(ak, qfr.f[ks], acc[kt], 0, 0, 0);
    }
    __builtin_amdgcn_sched_barrier(0);
  }
  unsigned g1[16], g2[16], g3[16];
#pragma unroll
  for (int r = 0; r < 16; ++r) {
    const unsigned ix = (unsigned)((r & 3) + 8 * (r >> 2));
    out[r] = (__float_as_uint(acc[0][r]) & ~127u) | ix; g1[r] = (__float_as_uint(acc[1][r]) & ~127u) | (32u + ix);
    g2[r] = (__float_as_uint(acc[2][r]) & ~127u) | (64u + ix); g3[r] = (__float_as_uint(acc[3][r]) & ~127u) | (96u + ix);
  }
  top16_of_64(out, g1, g2, g3);
  unsigned oth[16];
#pragma unroll
  for (int i = 0; i < 16; ++i) { out[i] |= (unsigned)(hh << 2); }
#pragma unroll
  for (int i = 0; i < 16; ++i) oth[i] = (unsigned)__shfl_xor((int)out[i], 32);
  merge_top16(out, oth);
}
DI void topk_phase(const Params& p, const u16* __restrict__ qp, const float* __restrict__ uinv, int* __restrict__ idx_out, float2* __restrict__ gu_out, unsigned char* smem) {
  const int tid = threadIdx.x;
  LAS unsigned char* sk = (LAS unsigned char*)smem;
  __syncthreads();
#pragma unroll
  for (int i = tid; i < 2 * 128 * 16; i += NTHREADS) {
    const int c = i & 15, row = i >> 4;
    const float4* s = (const float4*)(p.sub_keys + (size_t)row * 128 + c * 8);
    const float4 a = s[0], b = s[1];
    pg8::u32x4 o; o.x = pack2(a.x, a.y); o.y = pack2(a.z, a.w); o.z = pack2(b.x, b.y); o.w = pack2(b.z, b.w);
    *(LAS pg8::u32x4*)(sk + row * SKP + c * 16) = o;
  }
  __syncthreads();
  const int lane = tid & 63, tok = lane & 31, hh = lane >> 5, gw = blockIdx.x * NWAVES + (tid >> 6), nw = gridDim.x * NWAVES;
  for (int item = gw; item < (T / 32) * 4; item += nw) {
    const int t = (item >> 2) * 32 + tok, hp = item & 3;
    const u16* qt = qp + (size_t)t * 2048 + hp * 512;
    unsigned LA1[16], LA2[16], LB1[16], LB2[16];
    { QFrag fa = stage1_load(qt, hh), fb = stage1_load(qt + 128, hh);
      stage1(fa, sk, tok, hh, LA1); fa = stage1_load(qt + 256, hh);
      stage1(fb, sk + 128 * SKP, tok, hh, LA2); fb = stage1_load(qt + 384, hh);
      stage1(fa, sk, tok, hh, LB1);
      stage1(fb, sk + 128 * SKP, tok, hh, LB2); }
    unsigned L1[16], L2[16], R[16];
#pragma unroll
    for (int i = 0; i < 16; ++i) { L1[i] = hh ? LB1[i] : LA1[i]; L2[i] = hh ? LB2[i] : LA2[i]; }
    stage2(L1, L2, R);
    const int head = hp * 2 + hh;
    float ev[16], sum = 0.f;
    const float mx = __uint_as_float(0x42000000u | ((R[0] >> 14) << 6));
#pragma unroll
    for (int k = 0; k < 16; ++k) { ev[k] = __expf(__uint_as_float(0x42000000u | ((R[k] >> 14) << 6)) - mx); sum += ev[k]; }
    const float rs = 1.f / sum;
    int* io = idx_out + (size_t)t * 128 + head * 16; float2* go = gu_out + (size_t)t * 128 + head * 16;
#pragma unroll
    for (int k4 = 0; k4 < 4; ++k4) {
      int4 ex; ex.x = (int)(R[4 * k4] & 0x3FFFu); ex.y = (int)(R[4 * k4 + 1] & 0x3FFFu); ex.z = (int)(R[4 * k4 + 2] & 0x3FFFu); ex.w = (int)(R[4 * k4 + 3] & 0x3FFFu);
      ((int4*)io)[k4] = ex;
      float4 ga, gb; ga.x = ev[4 * k4] * rs; ga.y = uinv[ex.x]; ga.z = ev[4 * k4 + 1] * rs; ga.w = uinv[ex.y];
      gb.x = ev[4 * k4 + 2] * rs; gb.y = uinv[ex.z]; gb.z = ev[4 * k4 + 3] * rs; gb.w = uinv[ex.w];
      ((float4*)go)[2 * k4] = ga; ((float4*)go)[2 * k4 + 1] = gb;
    }
  }
}

typedef float f32x4_t __attribute__((ext_vector_type(4)));
typedef float f32x2_t __attribute__((ext_vector_type(2)));
typedef int i32x8_t __attribute__((ext_vector_type(8)));
constexpr int UIP = 132;
constexpr int UGP = 1032;
struct UBuf { uint4 r0, r1, r2, r3; unsigned e; float vi; };
#define U_LOAD(buf, g) do { const unsigned _e = myi[(g)]; const LAS unsigned* _il = idl + (lane >> 5) * UIP + (g); const unsigned _lo = 16u * (lane & 31); \
    buf.r0 = *(const uint4*)(U4 + (size_t)_il[0] * 512 + _lo); buf.r1 = *(const uint4*)(U4 + (size_t)_il[2 * UIP] * 512 + _lo); \
    buf.r2 = *(const uint4*)(U4 + (size_t)_il[4 * UIP] * 512 + _lo); buf.r3 = *(const uint4*)(U4 + (size_t)_il[6 * UIP] * 512 + _lo); \
    buf.e = _e; buf.vi = vinv[_e]; } while (0)
#define U_ST(i, r) do { pg8::u32x4 _o; _o.x = (r).x; _o.y = (r).y; _o.z = (r).z; _o.w = (r).w; *(LAS pg8::u32x4*)(gst + (2 * (i) + (lane >> 5)) * 528 + 16 * (lane & 31)) = _o; } while (0)
#define U_LD(j) (*(const LAS pg8::u32x4*)(gld + 128 * (j)))
#define U_MMA(c, r, b) c = __builtin_amdgcn_mfma_scale_f32_16x16x128_f8f6f4((i32x8_t){(int)(r).x, (int)(r).y, (int)(r).z, (int)(r).w, 0, 0, 0, 0}, b, c, 4, 0, 0, 0x7F7F7F7F, 0, 0x7F7F7F7F)
#define U_COMP(buf, g) do { f32x4_t c = {0.f, 0.f, 0.f, 0.f}; \
    U_ST(0, buf.r0); U_ST(1, buf.r1); U_ST(2, buf.r2); U_ST(3, buf.r3); asm volatile("" ::: "memory"); \
    { const pg8::u32x4 a0 = U_LD(0), a1 = U_LD(1), a2 = U_LD(2), a3 = U_LD(3); asm volatile("" ::: "memory"); \
      U_MMA(c, a0, B0); U_MMA(c, a1, B1); U_MMA(c, a2, B2); U_MMA(c, a3, B3); } \
    const int rsel = pp & 3; const float v = rsel == 0 ? c[0] : rsel == 1 ? c[1] : rsel == 2 ? c[2] : c[3]; \
    const float vo = __shfl(v, (lane + 40) & 63); \
    if (pp < 8 && q == (pp >> 2)) { const f32x2_t gu2 = *(const LAS f32x2_t*)(myg + (g) * 8); \
      const float d = (v + vo) * gu2[1]; const float act = 0.5f * d * (1.f + erff(d * 0.70710678118654752f)); \
      uint2 o; o.x = buf.e; o.y = __float_as_uint(gu2[0] * act * buf.vi); pw[(size_t)tok * 128 + (g)] = o; } } while (0)
DI void peer_u_phase(const u16* __restrict__ xb, const float* __restrict__ rowss, const int* __restrict__ idx, const float2* __restrict__ gu,
                     const unsigned char* __restrict__ U4, const float* __restrict__ vinv, uint2* __restrict__ pw, unsigned char* smem) {
  const int lane = threadIdx.x & 63, wave = threadIdx.x >> 6, pp = lane & 15, q = lane >> 4, gw = blockIdx.x * NWAVES + wave, nw = gridDim.x * NWAVES;
  const int pi = pp & 7, x = q + 4 * (pp >> 3);
  const unsigned xoff = 16u * x;
  LAS unsigned* idl = (LAS unsigned*)(smem + wave * (8 * UIP * 4 + 8 * UGP + 8 * 528));
  LAS unsigned char* gul = (LAS unsigned char*)(idl + 8 * UIP);
  LAS unsigned char* gst = gul + 8 * UGP;
  const LAS unsigned char* gld = gst + pi * 528 + 16 * x;
  const LAS unsigned* myi = idl + pi * UIP;
  const LAS unsigned char* myg = gul + pi * UGP;
  for (int unit = gw; unit < T / 8; unit += nw) {
    const int tok = unit * 8 + pi;
    __builtin_amdgcn_wave_barrier();
#pragma unroll
    for (int r8 = 0; r8 < 8; ++r8) {
      const int* ir = idx + (size_t)(unit * 8 + r8) * 128;
      idl[r8 * UIP + lane] = (unsigned)ir[lane]; idl[r8 * UIP + 64 + lane] = (unsigned)ir[64 + lane];
      const uint4 gv = ((const uint4*)(gu + (size_t)(unit * 8 + r8) * 128))[lane];
      pg8::u32x4 o; o.x = gv.x; o.y = gv.y; o.z = gv.z; o.w = gv.w; *(LAS pg8::u32x4*)(gul + r8 * UGP + lane * 16) = o;
    }
    __builtin_amdgcn_fence(__ATOMIC_RELEASE, "wavefront");
    __builtin_amdgcn_wave_barrier();
    const float inv = rsqrtf(rowss[tok] * (1.f / D) + EPS);
    i32x8_t B0, B1, B2, B3;
#define U_BUILD(Bv, i) do { const u16* sb = xb + (size_t)tok * D + 256 * (i) + 128 * (pp >> 3) + 16 * q; \
      _Pragma("unroll") for (int h = 0; h < 4; ++h) { float f[8]; unpack8(*(const uint4*)(sb + 64 * (h >> 1) + 8 * (h & 1)), f); int w; \
        w = __builtin_amdgcn_cvt_pk_fp8_f32(f[0] * inv, f[1] * inv, 0, false); w = __builtin_amdgcn_cvt_pk_fp8_f32(f[2] * inv, f[3] * inv, w, true); Bv[2 * h] = w; \
        w = __builtin_amdgcn_cvt_pk_fp8_f32(f[4] * inv, f[5] * inv, 0, false); w = __builtin_amdgcn_cvt_pk_fp8_f32(f[6] * inv, f[7] * inv, w, true); Bv[2 * h + 1] = w; } } while (0)
    U_BUILD(B0, 0); U_BUILD(B1, 1); U_BUILD(B2, 2); U_BUILD(B3, 3);
    UBuf b0, b1, b2, b3;
#define SB() __builtin_amdgcn_sched_barrier(0)
    U_LOAD(b0, 0); U_LOAD(b1, 1); U_LOAD(b2, 2); SB();
#pragma unroll 1
    for (int g = 0; g < 128; g += 4) {
      U_LOAD(b3, g + 3); SB(); U_COMP(b0, g); SB();
      U_LOAD(b0, (g + 4) & 127); SB(); U_COMP(b1, g + 1); SB();
      U_LOAD(b1, (g + 5) & 127); SB(); U_COMP(b2, g + 2); SB();
      U_LOAD(b2, (g + 6) & 127); SB(); U_COMP(b3, g + 3); SB();
    }
  }
}

typedef int i32x2_t __attribute__((ext_vector_type(2)));
DI void peer_v_phase(const uint2* __restrict__ pw, const unsigned char* __restrict__ V4, const u16* __restrict__ xb, float* __restrict__ out, unsigned char* smem) {
  const int lane = threadIdx.x & 63, wave = threadIdx.x >> 6, r = lane >> 3, c = lane & 7, n16 = lane & 15, kg = lane >> 4;
  LAS unsigned char* img = (LAS unsigned char*)smem + wave * VWAVE;
  LAS unsigned char* pbuf = img + 128 * VIMP;
  const int nunit = 4 * (T / 64);
  const int cnt = ((int)blockIdx.x < nunit) ? (nunit - 1 - (int)blockIdx.x) / (int)gridDim.x + 1 : 0, N = cnt * 8;
  if (N == 0) return;
#define V_TOK(n, jj, tt) do { const int _u = (int)blockIdx.x + ((n) >> 3) * (int)gridDim.x; jj = _u & 3; tt = (_u >> 2) * 64 + wave * 8 + ((n) & 7); } while (0)
#define V_LDPW(n) ({ int _j, _t; V_TOK(n, _j, _t); ((const uint4*)(pw + (size_t)_t * 128))[lane]; })
#define V_STAGE(n, pq, scv) do { LAS unsigned char* _b = pbuf + ((n) & 1) * 1024; \
    *(LAS i32x2_t*)(_b + 8 * lane) = (i32x2_t){(int)(pq).x, (int)(pq).z}; *(LAS i32x2_t*)(_b + 512 + 8 * lane) = (i32x2_t){(int)(pq).y, (int)(pq).w}; \
    const float _m = wave_max(fmaxf(fabsf(__uint_as_float((pq).y)), fabsf(__uint_as_float((pq).w)))); scv = _m > 0.f ? 224.f / _m : 1.f; } while (0)
#define V_GATHER(n) do { int _j, _t; V_TOK(n, _j, _t); const unsigned char* _vb = V4 + (size_t)_j * ((size_t)NEXP * 128) + 16 * c; const LAS unsigned* _e = (const LAS unsigned*)(pbuf + ((n) & 1) * 1024); \
    _Pragma("unroll") for (int i = 0; i < 16; ++i) G[i] = *(const uint4*)(_vb + (_e[8 * i + r] * 128u)); } while (0)
#define V_WRITEIMG() do { _Pragma("unroll") for (int i = 0; i < 16; ++i) { LAS unsigned char* _d = img + (8 * i + r) * VIMP + 16 * c; \
      *(LAS i32x2_t*)(_d) = (i32x2_t){(int)G[i].x, (int)G[i].y}; *(LAS i32x2_t*)(_d + 8) = (i32x2_t){(int)G[i].z, (int)G[i].w}; } } while (0)
  uint4 G[16];
  uint4 pq = V_LDPW(0);
  float sc_cur, sc_nxt;
  V_STAGE(0, pq, sc_cur); asm volatile("" ::: "memory");
  if (N > 1) pq = V_LDPW(1);
  V_GATHER(0);
  V_WRITEIMG(); asm volatile("" ::: "memory");
  for (int n = 0; n < N; ++n) {
    int j, t; V_TOK(n, j, t);
    const uint2 xr = *(const uint2*)(xb + (size_t)t * D + 256 * j + 4 * lane);
    if (n + 1 < N) { V_STAGE(n + 1, pq, sc_nxt); asm volatile("" ::: "memory"); if (n + 2 < N) pq = V_LDPW(n + 2); V_GATHER(n + 1); }
    __builtin_amdgcn_sched_barrier(0);
    i32x8_t A;
    { const LAS float* wl = (const LAS float*)(pbuf + (n & 1) * 1024 + 512);
#pragma unroll
      for (int h = 0; h < 2; ++h)
#pragma unroll
        for (int d = 0; d < 4; ++d) { const f32x4_t w4 = *(const LAS f32x4_t*)(wl + 64 * h + 16 * kg + 4 * d);
          int w = __builtin_amdgcn_cvt_pk_fp8_f32(w4[0] * sc_cur, w4[1] * sc_cur, 0, false); w = __builtin_amdgcn_cvt_pk_fp8_f32(w4[2] * sc_cur, w4[3] * sc_cur, w, true);
          A[4 * h + d] = n16 == 0 ? w : 0; } }
    float val[16];
    const LAS unsigned char* ib = img + (32 * kg + n16) * VIMP;
    i32x2_t tb0[16], tb1[16];
#pragma unroll
    for (int ct = 0; ct < 16; ++ct) { tb0[ct] = __builtin_amdgcn_ds_read_tr4_b64_v2i32((LAS i32x2_t*)(ib + 8 * ct)); tb1[ct] = __builtin_amdgcn_ds_read_tr4_b64_v2i32((LAS i32x2_t*)(ib + 16 * VIMP + 8 * ct)); }
#pragma unroll
    for (int ct = 0; ct < 16; ++ct) {
      const f32x4_t z = {0.f, 0.f, 0.f, 0.f};
      const f32x4_t cc = __builtin_amdgcn_mfma_scale_f32_16x16x128_f8f6f4(A, (i32x8_t){tb0[ct][0], tb0[ct][1], tb1[ct][0], tb1[ct][1], 0, 0, 0, 0}, z, 0, 4, 0, 0x7F7F7F7F, 0, 0x7F7F7F7F);
      val[ct] = cc[0];
    }
    asm volatile("" : "+v"(val[0]), "+v"(val[1]), "+v"(val[2]), "+v"(val[3]), "+v"(val[4]), "+v"(val[5]), "+v"(val[6]), "+v"(val[7]),
                      "+v"(val[8]), "+v"(val[9]), "+v"(val[10]), "+v"(val[11]), "+v"(val[12]), "+v"(val[13]), "+v"(val[14]), "+v"(val[15]));
    LAS float* stg = (LAS float*)(pbuf + (n & 1) * 1024);
    if (lane < 16) {
#pragma unroll
      for (int ct = 0; ct < 16; ++ct) stg[16 * ct + lane] = val[ct];
    }
    asm volatile("" ::: "memory");
    const f32x4_t s4 = *(const LAS f32x4_t*)(stg + 4 * lane);
    const float rs = 1.f / sc_cur;
    float4 o;
    o.x = bflo(xr.x) + s4[0] * rs; o.y = bfhi(xr.x) + s4[1] * rs; o.z = bflo(xr.y) + s4[2] * rs; o.w = bfhi(xr.y) + s4[3] * rs;
    *(float4*)(out + (size_t)t * D + 256 * j + 4 * lane) = o;
    __builtin_amdgcn_sched_barrier(0);
    asm volatile("" ::: "memory");
    if (n + 1 < N) { V_WRITEIMG(); sc_cur = sc_nxt; }
    asm volatile("" ::: "memory");
  }
}

constexpr int NPHASE = 8;
__global__ void __launch_bounds__(NTHREADS, 2) fwd_kernel(Params p) {
  extern __shared__ __attribute__((aligned(16))) unsigned char smem[];
  cg::grid_group grid = cg::this_grid();
  unsigned char* ws = p.ws;
  u16* wt_in = (u16*)(ws + WS_WTIN); u16* wt_out = (u16*)(ws + WS_WTOUT); u16* wt_q = (u16*)(ws + WS_WTQ);
  u16* act = (u16*)(ws + WS_ACT); u16* proj = (u16*)(ws + WS_PROJ);
  int* idx = (int*)(ws + WS_IDX); float2* gu = (float2*)(ws + WS_SB); unsigned char* U8 = ws + WS_U8; unsigned char* V8 = ws + WS_V8;
  uint2* pw = (uint2*)(ws + WS_PW); float* uinv = (float*)(ws + WS_UINV); float* vinv = (float*)(ws + WS_VINV);
  float* rowss = (float*)(ws + WS_ROWSS);
  volatile LAS unsigned* misc = (volatile LAS unsigned*)(LAS unsigned char*)(smem + LDS_MISC);
  if (threadIdx.x < 8) misc[threadIdx.x] = 0u;
  __syncthreads();
  XcdBarrier bar = xcd_barrier_post((unsigned*)(ws + WS_CTL), misc);
  PG8_LAS unsigned char* lds = (PG8_LAS unsigned char*)smem;
  const int lo = p.ph_lo, hi = p.ph_hi;
#define IN(k) (lo <= (k) && (k) < hi)
#define SEAM(k) do { if (IN(k) && IN((k) + 1)) xcd_barrier(bar); } while (0)
  if (IN(0)) {
    transpose_convert(p.w_in, wt_in, D, DIN, nullptr, (float*)smem);
    transpose_convert(p.w_out, wt_out, D, D, nullptr, (float*)smem);
    transpose_convert(p.w_q, wt_q, D, 2048, p.norm2_g, (float*)smem);
    convert_fp4_rows<false>(p.peer_u, p.norm2_g, U8, uinv);
    convert_fp4_rows<true>(p.peer_v, nullptr, V8, vinv);
    rmsnorm1024(p.x, p.norm1_g, act);
    for (int i = blockIdx.x * NTHREADS + threadIdx.x; i < T; i += gridDim.x * NTHREADS) rowss[i] = 0.f;
    for (int i = blockIdx.x * NTHREADS + threadIdx.x; i < 2 * 32 * SEQ; i += gridDim.x * NTHREADS) ((float*)(ws + WS_SB + 16 * MBy))[i] = 0.f;
  }
  if (lo < 0) grid.sync();
  SEAM(0);
  u16* vt = (u16*)(ws + WS_SB);
  float* ssq = (float*)(ws + WS_SB + 16 * MBy);
  if (IN(1)) { pg8::Gemm g{act, wt_in, T, DIN, D}; pg8::StaticOrder S; S.init(T, DIN, gridDim.x, blockIdx.x);
    pg8::EpiInProj E{proj, vt, ssq}; pg8::gemm_phase<pg8::EpiInProj, pg8::StaticOrder>(lds, g, S, E, nullptr); }
  SEAM(1);
  if (IN(2)) { attn_phase(p, proj, vt, ssq, act, smem); conv_tokens(p, proj, act); }
  SEAM(2);
  if (IN(3)) { pg8::Gemm g{act, wt_out, T, D, D}; pg8::StaticOrder S; S.init(T, D, gridDim.x, blockIdx.x);
    pg8::EpiResid E{p.x, p.out, proj, rowss, D}; pg8::gemm_phase<pg8::EpiResid, pg8::StaticOrder>(lds, g, S, E, nullptr); }
  SEAM(3);
  u16* xb = proj;
  u16* qp = proj + (size_t)T * D;
  if (IN(4)) { pg8::Gemm g{xb, wt_q, T, 2048, D}; pg8::StaticOrder S; S.init(T, 2048, gridDim.x, blockIdx.x);
    pg8::EpiBf16S E{qp, 2048, rowss}; pg8::gemm_phase<pg8::EpiBf16S, pg8::StaticOrder>(lds, g, S, E, nullptr); }
  SEAM(4);
  if (IN(5)) topk_phase(p, qp, uinv, idx, gu, smem);
  SEAM(5);
  if (IN(6)) peer_u_phase(xb, rowss, idx, gu, U8, vinv, pw, smem);
  SEAM(6);
  if (IN(7)) peer_v_phase(pw, V8, xb, p.out, smem);
}

extern "C" void kernel_launch(void* const* d_in, const int* in_sizes, int n_in, void* d_out, int out_size, void* d_ws, size_t ws_size,
                              hipStream_t stream) {
  static int grid_blocks = 0;
  if (!grid_blocks) {
    int dev = 0, cus = 0, per_cu = 0;
    (void)hipGetDevice(&dev);
    (void)hipDeviceGetAttribute(&cus, hipDeviceAttributeMultiprocessorCount, dev);
    (void)hipFuncSetAttribute((const void*)fwd_kernel, hipFuncAttributeMaxDynamicSharedMemorySize, LDS_BYTES);
    (void)hipOccupancyMaxActiveBlocksPerMultiprocessor(&per_cu, fwd_kernel, NTHREADS, LDS_BYTES);
    if (per_cu < 1) per_cu = 1;
    if (per_cu > 1) per_cu = 1;
    grid_blocks = cus * per_cu;
  }
  Params p{};
  p.x = (const float*)d_in[0]; p.norm1_g = (const float*)d_in[1]; p.w_in = (const float*)d_in[2]; p.q_norm_g = (const float*)d_in[3];
  p.k_norm_g = (const float*)d_in[4]; p.conv_w = (const float*)d_in[5]; p.sb_out_g = (const float*)d_in[6]; p.conv_out_g = (const float*)d_in[7];
  p.w_out = (const float*)d_in[8]; p.norm2_g = (const float*)d_in[9]; p.w_q = (const float*)d_in[10]; p.sub_keys = (const float*)d_in[11];
  p.peer_u = (const float*)d_in[12]; p.peer_v = (const float*)d_in[13];
  p.out = (float*)d_out; p.ws = (unsigned char*)d_ws;
  p.ph_lo = 0; p.ph_hi = NPHASE;
  (void)hipMemsetAsync((unsigned char*)d_ws + WS_CTL, 0, 4096 * 4 + 8 * 64 * 4, stream);
  void* args[] = {&p};
  hipError_t e = hipLaunchCooperativeKernel((void*)fwd_kernel, dim3(grid_blocks), dim3(NTHREADS), args, LDS_BYTES, stream);
  if (e != hipSuccess) fprintf(stderr, "cooperative launch failed: %s (grid %d)\n", hipGetErrorString(e), grid_blocks);
}
```

```cpp
#include <hip/hip_runtime.h>
#include <hip/hip_cooperative_groups.h>
#include <cstdio>
#include <cstdint>
namespace cg = cooperative_groups;

typedef unsigned short u16;
#define DI __device__ __forceinline__
#define LAS __attribute__((address_space(3)))

constexpr int T = 16384, D = 1024, SEQ = 4096;
constexpr int DIN = 3072, DSB = 512;
constexpr int NEXP = 16384;
constexpr float EPS = 1e-6f;
constexpr int NWAVES = 8, NTHREADS = NWAVES * 64;

namespace pg8 {
#define PG8_LAS __attribute__((address_space(3)))
typedef unsigned short bf16_t;
typedef short bf16x8 __attribute__((ext_vector_type(8)));
typedef float f32x4 __attribute__((ext_vector_type(4)));
typedef unsigned u32x4 __attribute__((ext_vector_type(4)));
constexpr int BM = 256, BK = 64, HALF = 128, HTB = HALF * BK * 2  , STAGE_BYTES = 8 * HTB, NXCD = 8, WGM = 8;

__host__ __device__ __forceinline__ int lds_byte(int r, int c) { const int st = (r >> 4) * 2 + (c >> 5), rr = r & 15, cc = c & 31, ob = rr * 64 + cc * 2; return st * 1024 + (ob ^ (((ob >> 9) & 1) << 5)); }
__host__ __device__ __forceinline__ void stage_rc(int b, int& R, int& C) { const int st = b / 1024, sb = b % 1024, swz = sb ^ (((sb >> 9) & 1) << 5); R = (st >> 1) * 16 + swz / 64; C = (st & 1) * 32 + (swz % 64) / 2; }
__host__ __device__ __forceinline__ int perm32(int rho) { const int n = rho >> 4, i = rho & 15; return 8 * (i >> 2) + 4 * n + (i & 3); }

struct Unit { int pm, pn; };
struct Gemm { const bf16_t* A; const bf16_t* Bt; int M, N, K; };
struct StaticOrder {
    int nM, nN, nwg, G, c;
    __host__ __device__ void init(int M, int N, int G_, int c_) { nM = M / BM; nN = N / BM; nwg = nM * nN; G = G_; c = c_; }
    __host__ __device__ bool next(int i, Unit& u) const {
        const long L = (long)i * G + c; if (L >= nwg) return false;
        int wgid = (int)L; { const int q = nwg / NXCD, r = nwg % NXCD, xcd = wgid % NXCD, off = wgid / NXCD; wgid = (xcd < r ? xcd * (q + 1) : r * (q + 1) + (xcd - r) * q) + off; }
        const int nig = WGM * nN, gid = wgid / nig, fm = gid * WGM, gsz = (nM - fm) < WGM ? (nM - fm) : WGM;
        u.pm = fm + ((wgid % nig) % gsz); u.pn = (wgid % nig) / gsz; return true;
    }
    __device__ __forceinline__ void a_ready(const Unit&) const {}
    __device__ __forceinline__ void done(const Unit&) const {}
};
__device__ __forceinline__ unsigned cvt_pk_bf16(float lo, float hi) { unsigned r; asm volatile("v_cvt_pk_bf16_f32 %0, %1, %2" : "=v"(r) : "v"(lo), "v"(hi)); return r; }

struct EpiBf16S {
    static constexpr bool PERM = true, AFTER_DRAIN = false;
    bf16_t* O; int ldc; const float* rowss;
    __device__ __forceinline__ void operator()(const f32x4 (&acc)[2][2][4][2], const Unit& u, int wr, int wc, int fr, int fq) const {
        const int row0 = u.pm * BM + wr * 64 + fr, col0 = u.pn * BM + wc * 32 + 8 * fq;
#pragma unroll
        for (int ai = 0; ai < 2; ++ai)
#pragma unroll
            for (int m = 0; m < 4; ++m) { const int row = row0 + ai * HALF + m * 16; bf16_t* rowp = O + (size_t)row * ldc + col0;
                const float sc = rowss ? rsqrtf(rowss[row] * (1.f / 1024.f) + 1e-6f) : 1.f;
#pragma unroll
                for (int bj = 0; bj < 2; ++bj) { const f32x4 v0 = acc[ai][bj][m][0] * sc, v1 = acc[ai][bj][m][1] * sc;
                    u32x4 w; w.x = cvt_pk_bf16(v0[0], v0[1]); w.y = cvt_pk_bf16(v0[2], v0[3]); w.z = cvt_pk_bf16(v1[0], v1[1]); w.w = cvt_pk_bf16(v1[2], v1[3]);
                    *(u32x4*)(rowp + bj * HALF) = w; } }
    }
};
struct EpiInProj {
    static constexpr bool PERM = true, AFTER_DRAIN = false;
    bf16_t* O; bf16_t* vt; float* ssq;
    __device__ __forceinline__ void operator()(const f32x4 (&acc)[2][2][4][2], const Unit& u, int wr, int wc, int fr, int fq) const {
        const int row0 = u.pm * BM + wr * 64 + fr, col0 = u.pn * BM + wc * 32 + 8 * fq, kind = u.pn >> 1;
#pragma unroll
        for (int ai = 0; ai < 2; ++ai)
#pragma unroll
            for (int m = 0; m < 4; ++m) { const int row = row0 + ai * HALF + m * 16; const int bb = row >> 12, ss = row & 4095;
#pragma unroll
                for (int bj = 0; bj < 2; ++bj) { const f32x4 v0 = acc[ai][bj][m][0], v1 = acc[ai][bj][m][1];
                    if (kind != 2) {
                        u32x4 w; w.x = cvt_pk_bf16(v0[0], v0[1]); w.y = cvt_pk_bf16(v0[2], v0[3]); w.z = cvt_pk_bf16(v1[0], v1[1]); w.w = cvt_pk_bf16(v1[2], v1[3]);
                        *(u32x4*)(O + (size_t)row * 3072 + col0 + bj * HALF) = w;
                        if (kind < 2) {
                            float sq = v0[0] * v0[0] + v0[1] * v0[1] + v0[2] * v0[2] + v0[3] * v0[3] + v1[0] * v1[0] + v1[1] * v1[1] + v1[2] * v1[2] + v1[3] * v1[3];
                            sq += __shfl_xor(sq, 16); sq += __shfl_xor(sq, 32);
                            const int head = (u.pn & 1) * 4 + bj * 2 + (wc >> 1);
                            if (fq == 0) unsafeAtomicAdd(ssq + ((size_t)(kind * 32 + bb * 8 + head)) * 4096 + ss, sq);
                        }
                    } else {
                        const int d0 = (u.pn & 1) * 256 + bj * HALF + wc * 32 + 8 * fq;
                        bf16_t* vp = vt + ((size_t)(bb * 512 + d0)) * 4096 + ss;
                        const unsigned w0 = cvt_pk_bf16(v0[0], v0[1]), w1 = cvt_pk_bf16(v0[2], v0[3]), w2 = cvt_pk_bf16(v1[0], v1[1]), w3 = cvt_pk_bf16(v1[2], v1[3]);
                        vp[0] = (bf16_t)w0; vp[4096] = (bf16_t)(w0 >> 16); vp[2 * 4096] = (bf16_t)w1; vp[3 * 4096] = (bf16_t)(w1 >> 16);
                        vp[4 * 4096] = (bf16_t)w2; vp[5 * 4096] = (bf16_t)(w2 >> 16); vp[6 * 4096] = (bf16_t)w3; vp[7 * 4096] = (bf16_t)(w3 >> 16);
                    } } }
    }
};
struct EpiResid {
    static constexpr bool PERM = true, AFTER_DRAIN = false;
    const float* resid; float* out32; bf16_t* xb; float* rowss; int ldc;
    __device__ __forceinline__ void operator()(const f32x4 (&acc)[2][2][4][2], const Unit& u, int wr, int wc, int fr, int fq) const {
        const int row0 = u.pm * BM + wr * 64 + fr, col0 = u.pn * BM + wc * 32 + 8 * fq;
#pragma unroll
        for (int ai = 0; ai < 2; ++ai)
#pragma unroll
            for (int m = 0; m < 4; ++m) { const int row = row0 + ai * HALF + m * 16; const size_t off = (size_t)row * ldc + col0; float ss = 0.f;
#pragma unroll
                for (int bj = 0; bj < 2; ++bj) {
                    const f32x4 r0 = __builtin_nontemporal_load((const f32x4*)(resid + off + bj * HALF)), r1 = __builtin_nontemporal_load((const f32x4*)(resid + off + bj * HALF + 4));
                    const f32x4 o0 = r0 + acc[ai][bj][m][0], o1 = r1 + acc[ai][bj][m][1];
                    ss += o0[0] * o0[0] + o0[1] * o0[1] + o0[2] * o0[2] + o0[3] * o0[3] + o1[0] * o1[0] + o1[1] * o1[1] + o1[2] * o1[2] + o1[3] * o1[3];
                    u32x4 w; w.x = cvt_pk_bf16(o0[0], o0[1]); w.y = cvt_pk_bf16(o0[2], o0[3]); w.z = cvt_pk_bf16(o1[0], o1[1]); w.w = cvt_pk_bf16(o1[2], o1[3]);
                    *(u32x4*)(xb + off + bj * HALF) = w; }
                ss += __shfl_xor(ss, 16); ss += __shfl_xor(ss, 32);
                if (fq == 0) unsafeAtomicAdd(rowss + row, ss); }
    }
};
template <class Epi, class Sched, bool STAMP = false>
__device__ __forceinline__ void gemm_phase(PG8_LAS unsigned char* lds, const Gemm g, const Sched& S, const Epi& E, unsigned long long* stamps) {
    const int tid = threadIdx.x, wid = __builtin_amdgcn_readfirstlane(tid >> 6), lane = tid & 63, wr = wid >> 2, wc = wid & 3, fr = lane & 15, fq = lane >> 4;
    const int K = g.K, nt = K / BK;
    int ts_lo = 0, ts_hi = 0, nts = 0; const unsigned long long rt_entry = STAMP ? (unsigned long long)wall_clock64() : 0ull;
#define PG8_STAMP() do { if (STAMP && wid == 0 && nts < 64) { const unsigned long long _c = (unsigned long long)clock64(); \
        ts_lo = (lane == nts) ? (int)(unsigned)_c : ts_lo; ts_hi = (lane == nts) ? (int)(unsigned)(_c >> 32) : ts_hi; ++nts; } } while (0)
    PG8_STAMP();
    unsigned voffA[2], voffB[2];
#pragma unroll
    for (int i = 0; i < 2; ++i) { int R, C; stage_rc(tid * 16 + i * 8192, R, C); const int Rb = Epi::PERM ? ((R & ~31) + perm32(R & 31)) : R;
        voffA[i] = (unsigned)(R * K + C) * 2u; voffB[i] = (unsigned)(Rb * K + C) * 2u; }
    const size_t kstep = (size_t)(BK * 2);
    const size_t hstep = (size_t)HALF * K * 2;
    const size_t tstep = 2 * hstep;
    const unsigned ldsw = (unsigned)wid * 1024u;
    const int aoff = lds_byte(wr * 64 + fr, fq * 8), boff = lds_byte(wc * 32 + fr, fq * 8);
#define PG8_SA(b, h) (((b) * 2 + (h)) * HTB)
#define PG8_SB(b, h) ((4 + (b) * 2 + (h)) * HTB)
#define PG8_STAGE(bufoff, gbase, voff) do { _Pragma("unroll") for (int _i = 0; _i < 2; ++_i) \
        __builtin_amdgcn_global_load_lds((const unsigned*)((const char*)(gbase) + (voff)[_i]), (PG8_LAS unsigned*)(lds + (bufoff) + ldsw + _i * 8192), 16, 0, 0); } while (0)
#define PG8_LDA(dst, b, h) do { _Pragma("unroll") for (int m = 0; m < 4; ++m) _Pragma("unroll") for (int k = 0; k < 2; ++k) dst[m][k] = *(const PG8_LAS bf16x8*)(lds + PG8_SA(b, h) + aoff + m * 2048 + k * 1024); } while (0)
#define PG8_LDB(dst, b, h) do { _Pragma("unroll") for (int n = 0; n < 2; ++n) _Pragma("unroll") for (int k = 0; k < 2; ++k) dst[n][k] = *(const PG8_LAS bf16x8*)(lds + PG8_SB(b, h) + boff + n * 2048 + k * 1024); } while (0)
#define PG8_MMA(ai, bj, At, Bt) do { __builtin_amdgcn_s_setprio(1); _Pragma("unroll") for (int m = 0; m < 4; ++m) _Pragma("unroll") for (int n = 0; n < 2; ++n) _Pragma("unroll") for (int k = 0; k < 2; ++k) \
        acc[ai][bj][m][n] = __builtin_amdgcn_mfma_f32_16x16x32_bf16(Bt[n][k], At[m][k], acc[ai][bj][m][n], 0, 0, 0); __builtin_amdgcn_s_setprio(0); } while (0)
#define PG8_WAIT_V(n) asm volatile("s_waitcnt vmcnt(" #n ")" ::: "memory")
#define PG8_WAIT_L(n) asm volatile("s_waitcnt lgkmcnt(" #n ")" ::: "memory")
#define PG8_BAR __builtin_amdgcn_s_barrier()
#define PG8_SCHED __builtin_amdgcn_sched_barrier(0)
    Unit cur, nxt; int ui = 0;
    if (!S.next(0, cur)) return;
    f32x4 acc[2][2][4][2];
#pragma unroll
    for (int a = 0; a < 2; ++a)
#pragma unroll
        for (int b = 0; b < 2; ++b)
#pragma unroll
            for (int m = 0; m < 4; ++m)
#pragma unroll
                for (int n = 0; n < 2; ++n) acc[a][b][m][n] = (f32x4){0.f, 0.f, 0.f, 0.f};
    bf16x8 At[4][2], B0[2][2], B1[2][2];
    const char* cA = (const char*)g.A + (size_t)cur.pm * tstep; const char* cB = (const char*)g.Bt + (size_t)cur.pn * tstep;
    S.a_ready(cur);
    PG8_STAGE(PG8_SB(0, 0), cB, voffB); PG8_STAGE(PG8_SA(0, 0), cA, voffA); PG8_STAGE(PG8_SB(0, 1), cB + hstep, voffB); PG8_STAGE(PG8_SA(0, 1), cA + hstep, voffA);
    if (wr == 1) PG8_BAR;
    PG8_WAIT_V(4); PG8_BAR;
    PG8_STAGE(PG8_SB(1, 0), cB + kstep, voffB); PG8_STAGE(PG8_SA(1, 0), cA + kstep, voffA); PG8_STAGE(PG8_SB(1, 1), cB + hstep + kstep, voffB);
    PG8_WAIT_V(6); PG8_BAR;
    PG8_STAMP();
    for (;;) {
        const bool has_next = S.next(ui + 1, nxt);
        const char* nA = has_next ? (const char*)g.A + (size_t)nxt.pm * tstep : cA; const char* nB = has_next ? (const char*)g.Bt + (size_t)nxt.pn * tstep : cB;
        for (int t = 0; t < nt; t += 2) {
            const bool last = (t == nt - 2);
            const char* a1 = cA + (size_t)(t + 1) * kstep;
            const char* a2 = last ? nA : cA + (size_t)(t + 2) * kstep; const char* b2 = last ? nB : cB + (size_t)(t + 2) * kstep;
            const char* a3 = a2 + kstep; const char* b3 = b2 + kstep;
            if (last && has_next) S.a_ready(nxt);
            PG8_LDB(B0, 0, 0); PG8_SCHED; PG8_LDA(At, 0, 0); PG8_STAGE(PG8_SA(1, 1), a1 + hstep, voffA);
            PG8_WAIT_L(8); PG8_BAR; PG8_WAIT_L(0); PG8_MMA(0, 0, At, B0); PG8_BAR; PG8_SCHED;
            PG8_LDB(B1, 0, 1); PG8_STAGE(PG8_SB(0, 0), b2, voffB);
            PG8_BAR; PG8_WAIT_L(0); PG8_MMA(0, 1, At, B1); PG8_BAR;
            PG8_LDA(At, 0, 1); PG8_STAGE(PG8_SA(0, 0), a2, voffA);
            PG8_BAR; PG8_WAIT_L(0); PG8_MMA(1, 0, At, B0); PG8_BAR; PG8_SCHED;
            PG8_STAGE(PG8_SB(0, 1), b2 + hstep, voffB);
            PG8_WAIT_V(6); PG8_BAR; PG8_MMA(1, 1, At, B1); PG8_BAR;
            PG8_LDB(B0, 1, 0); PG8_SCHED; PG8_LDA(At, 1, 0); PG8_STAGE(PG8_SA(0, 1), a2 + hstep, voffA);
            PG8_WAIT_L(8); PG8_BAR; PG8_WAIT_L(0); PG8_MMA(0, 0, At, B0); PG8_BAR; PG8_SCHED;
            PG8_LDB(B1, 1, 1); PG8_STAGE(PG8_SB(1, 0), b3, voffB);
            PG8_BAR; PG8_WAIT_L(0); PG8_MMA(0, 1, At, B1); PG8_BAR;
            PG8_LDA(At, 1, 1); PG8_STAGE(PG8_SA(1, 0), a3, voffA);
            PG8_BAR; PG8_WAIT_L(0); PG8_MMA(1, 0, At, B0); PG8_BAR; PG8_SCHED;
            PG8_STAGE(PG8_SB(1, 1), b3 + hstep, voffB);
            PG8_WAIT_V(6); PG8_BAR; PG8_MMA(1, 1, At, B1); PG8_BAR;
        }
        PG8_STAMP();
        if constexpr (!Epi::AFTER_DRAIN) { E(acc, cur, wr, wc, fr, fq); S.done(cur); }
        PG8_STAMP();
        if (!has_next) break;
#pragma unroll
        for (int a = 0; a < 2; ++a)
#pragma unroll
            for (int b = 0; b < 2; ++b)
#pragma unroll
                for (int m = 0; m < 4; ++m)
#pragma unroll
                    for (int n = 0; n < 2; ++n) acc[a][b][m][n] = (f32x4){0.f, 0.f, 0.f, 0.f};
        cur = nxt; cA = nA; cB = nB; ++ui;
    }
    PG8_WAIT_V(0);
    if (wr == 0) PG8_BAR;
    PG8_BAR;
    if constexpr (Epi::AFTER_DRAIN) { E.fused(acc, cur, wr, wc, fr, fq, lds, wid, lane); S.done(cur); }
    PG8_STAMP();
    if (STAMP && wid == 0) { stamps[lane] = lane < nts ? (((unsigned long long)(unsigned)ts_hi << 32) | (unsigned)ts_lo) : 0ull;
        if (lane == 62) stamps[62] = rt_entry; if (lane == 63) stamps[63] = (unsigned long long)wall_clock64(); }
#undef PG8_STAMP
#undef PG8_SA
#undef PG8_SB
#undef PG8_STAGE
#undef PG8_LDA
#undef PG8_LDB
#undef PG8_MMA
#undef PG8_WAIT_V
#undef PG8_WAIT_L
#undef PG8_BAR
#undef PG8_SCHED
}
}


constexpr size_t MBy = 1u << 20;
constexpr size_t WS_WTIN = 0, WS_WTOUT = 6 * MBy, WS_WTQ = 8 * MBy, WS_CTL = 12 * MBy, WS_ROWSS = 12 * MBy + 65536, WS_ACT = 13 * MBy, WS_PROJ = 45 * MBy,
                 WS_SB = 141 * MBy, WS_IDX = 173 * MBy, WS_GATE = 181 * MBy, WS_U8 = 189 * MBy, WS_V8 = 205 * MBy, WS_PW = 221 * MBy,
                 WS_UINV = 12 * MBy + 262144, WS_VINV = 12 * MBy + 393216;
constexpr int VIMP = 136, VWAVE = 128 * VIMP + 2048;
constexpr int LDS_MISC = 8 * VWAVE, LDS_BYTES = 8 * VWAVE + 256;
static_assert(LDS_MISC >= pg8::STAGE_BYTES && LDS_BYTES <= 163840, "LDS budget");

struct Params {
  const float *x, *norm1_g, *w_in, *q_norm_g, *k_norm_g, *conv_w, *sb_out_g, *conv_out_g, *w_out, *norm2_g, *w_q, *sub_keys, *peer_u, *peer_v;
  float* out; unsigned char* ws; int ph_lo, ph_hi;
};

#define XB_TMO      128
#define XB_XCNT(j)  (256  + 64 * (j))
#define XB_XSUB(j)  (1280 + 64 * (j))
#define XB_XGEN(j)  (2304 + 64 * (j))
#define XB_TOP      3328
#define XB_TOPGEN   3392
#define XCD_BAR_WORDS 3456
#define XB_SPIN_CAP (1u << 18)
DI unsigned xb_ld(unsigned* p) { return __hip_atomic_load(p, __ATOMIC_RELAXED, __HIP_MEMORY_SCOPE_AGENT); }
DI unsigned xb_add(unsigned* p, unsigned v) { return __hip_atomic_fetch_add(p, v, __ATOMIC_RELAXED, __HIP_MEMORY_SCOPE_AGENT); }
DI unsigned xb_xcc_id() { return (unsigned)__builtin_amdgcn_s_getreg((3 << 11) | 20) & 0xFu; }
#define XB_SPIN(cond, bar) do { unsigned _sp = 0; while (cond) { __builtin_amdgcn_s_sleep(1); \
    if ((++_sp & 255u) == 0u) { if (xb_ld(&(bar)[XB_TMO])) break; if (_sp > XB_SPIN_CAP) { atomicAdd(&(bar)[XB_TMO], 1u); break; } } } } while (0)
struct XcdBarrier { unsigned* bar; unsigned x; volatile LAS unsigned* st; };
DI XcdBarrier xcd_barrier_post(unsigned* bar, volatile LAS unsigned* st) {
  XcdBarrier b; b.bar = bar; b.x = xb_xcc_id(); b.st = st;
  if (threadIdx.x == 0) (void)xb_add(&bar[XB_XCNT(b.x)], 1u);
  return b;
}
DI void xcd_barrier_complete(unsigned* bar, unsigned x, unsigned& nloc, unsigned& nx) {
  const unsigned G = gridDim.x * gridDim.y * gridDim.z;
  unsigned sum, cnt, mine, sp = 0u;
  for (;;) {
    sum = 0u; cnt = 0u; mine = 0u;
#pragma unroll
    for (unsigned j = 0; j < 16; ++j) { const unsigned c = xb_ld(&bar[XB_XCNT(j)]); sum += c; cnt += (c > 0u) ? 1u : 0u; mine = (j == x) ? c : mine; }
    if (sum == G) break;
    __builtin_amdgcn_s_sleep(1);
    if ((++sp & 255u) == 0u) { if (xb_ld(&bar[XB_TMO])) break; if (sp > XB_SPIN_CAP) { atomicAdd(&bar[XB_TMO], 1u); break; } }
  }
  nloc = mine > 0u ? mine : 1u; nx = cnt > 0u ? cnt : 1u;
}
DI void xcd_barrier(const XcdBarrier& b) {
  asm volatile("s_waitcnt vmcnt(0)" ::: "memory");
  __syncthreads();
  if (threadIdx.x == 0) {
    unsigned* bar = b.bar;
    __builtin_amdgcn_s_waitcnt(0);
    unsigned nloc = b.st[0], nx = b.st[1];
    if (nloc == 0u) { xcd_barrier_complete(bar, b.x, nloc, nx); b.st[0] = nloc; b.st[1] = nx; }
    const unsigned old = xb_add(&bar[XB_XSUB(b.x)], 1u);
    const unsigned gen = old / nloc;
    if (old + 1u == (gen + 1u) * nloc) {
      __builtin_amdgcn_fence(__ATOMIC_RELEASE, "agent");
      asm volatile("s_waitcnt vmcnt(0)" ::: "memory");
      const unsigned og = xb_add(&bar[XB_TOP], 1u);
      const unsigned tg = og / nx;
      if (og + 1u == (tg + 1u) * nx) xb_add(&bar[XB_TOPGEN], 1u);
      else XB_SPIN(xb_ld(&bar[XB_TOPGEN]) == tg, bar);
      __builtin_amdgcn_fence(__ATOMIC_ACQUIRE, "agent");
      xb_add(&bar[XB_XGEN(b.x)], 1u);
      asm volatile("s_waitcnt vmcnt(0)" ::: "memory");
    } else {
      XB_SPIN(xb_ld(&bar[XB_XGEN(b.x)]) == gen, bar);
      __builtin_amdgcn_fence(__ATOMIC_ACQUIRE, "agent");
      asm volatile("s_waitcnt vmcnt(0)" ::: "memory");
    }
  }
  __syncthreads();
}

DI u16 f2bf(float x) { unsigned u = __float_as_uint(x); u += 0x7fffu + ((u >> 16) & 1u); return (u16)(u >> 16); }
DI float bflo(unsigned w) { return __uint_as_float(w << 16); }
DI float bfhi(unsigned w) { return __uint_as_float(w & 0xffff0000u); }
DI unsigned pack2(float a, float b) { return (unsigned)f2bf(a) | ((unsigned)f2bf(b) << 16); }
DI float wave_sum(float v) {
#pragma unroll
  for (int o = 32; o >= 1; o >>= 1) v += __shfl_xor(v, o);
  return v;
}
DI float wave_max(float v) {
#pragma unroll
  for (int o = 32; o >= 1; o >>= 1) v = fmaxf(v, __shfl_xor(v, o));
  return v;
}
DI void unpack8(const uint4 w, float* f) {
  f[0] = bflo(w.x); f[1] = bfhi(w.x); f[2] = bflo(w.y); f[3] = bfhi(w.y); f[4] = bflo(w.z); f[5] = bfhi(w.z); f[6] = bflo(w.w); f[7] = bfhi(w.w);
}
DI uint4 pack8(const float* f) { uint4 o; o.x = pack2(f[0], f[1]); o.y = pack2(f[2], f[3]); o.z = pack2(f[4], f[5]); o.w = pack2(f[6], f[7]); return o; }


DI float4 ld_nt_f4(const float4* p) { typedef float f4v __attribute__((ext_vector_type(4))); const f4v v = __builtin_nontemporal_load((const f4v*)p); return make_float4(v.x, v.y, v.z, v.w); }

DI void transpose_convert(const float* __restrict__ W, u16* __restrict__ Wt, int K, int N, const float* __restrict__ rg, float* sm) {
  const int tid = threadIdx.x, tn_cnt = N / 64, ntile = (K / 64) * tn_cnt;
  for (int tile = blockIdx.x; tile < ntile; tile += gridDim.x) {
    const int tk = tile / tn_cnt, tn = tile % tn_cnt;
    __syncthreads();
#pragma unroll
    for (int r = 0; r < 2; ++r) { const int row = r * 32 + (tid >> 4), c4 = (tid & 15) * 4;
      const float g = rg ? rg[tk * 64 + row] : 1.f;
      const float4 v = ld_nt_f4((const float4*)(W + (size_t)(tk * 64 + row) * N + tn * 64 + c4));
      sm[row * 65 + c4] = v.x * g; sm[row * 65 + c4 + 1] = v.y * g; sm[row * 65 + c4 + 2] = v.z * g; sm[row * 65 + c4 + 3] = v.w * g; }
    __syncthreads();
    { const int n = tid & 63, k0 = (tid >> 6) * 8;
      float f[8];
#pragma unroll
      for (int j = 0; j < 8; ++j) f[j] = sm[(k0 + j) * 65 + n];
      *(uint4*)(Wt + (size_t)(tn * 64 + n) * K + tk * 64 + k0) = pack8(f); }
  }
}
template <bool SLICED>
DI void convert_fp4_rows(const float* __restrict__ src, const float* __restrict__ cg, unsigned char* __restrict__ dst, float* __restrict__ inv_out) {
  const int lane = threadIdx.x & 63, gw = blockIdx.x * NWAVES + (threadIdx.x >> 6), nw = gridDim.x * NWAVES;
  float4 g[4];
#pragma unroll
  for (int k = 0; k < 4; ++k) g[k] = cg ? ((const float4*)cg)[lane + 64 * k] : make_float4(1.f, 1.f, 1.f, 1.f);
  for (int row0 = gw * 4; row0 < NEXP; row0 += nw * 4) {
    float4 a[4][4];
#pragma unroll
    for (int rr = 0; rr < 4; ++rr)
#pragma unroll
      for (int k = 0; k < 4; ++k) a[rr][k] = ld_nt_f4((const float4*)(src + (size_t)(row0 + rr) * D) + lane + 64 * k);
#pragma unroll
    for (int rr = 0; rr < 4; ++rr) {
      float am = 0.f;
#pragma unroll
      for (int k = 0; k < 4; ++k) { a[rr][k].x *= g[k].x; a[rr][k].y *= g[k].y; a[rr][k].z *= g[k].z; a[rr][k].w *= g[k].w;
        am = fmaxf(fmaxf(am, fmaxf(fabsf(a[rr][k].x), fabsf(a[rr][k].y))), fmaxf(fabsf(a[rr][k].z), fabsf(a[rr][k].w))); }
      am = wave_max(am);
      const float sc = am > 0.f ? 6.f / am : 1.f;
      const int row = row0 + rr;
#pragma unroll
      for (int k = 0; k < 4; ++k) {
        unsigned w = 0u;
        w = __builtin_amdgcn_cvt_scalef32_pk_fp4_f32(w, a[rr][k].x * sc, a[rr][k].y * sc, 1.0f, 0); w = __builtin_amdgcn_cvt_scalef32_pk_fp4_f32(w, a[rr][k].z * sc, a[rr][k].w * sc, 1.0f, 1);
        if (SLICED) *(u16*)(dst + (size_t)k * ((size_t)NEXP * 128) + (size_t)row * 128 + 2 * lane) = (u16)w;
        else *(u16*)(dst + (size_t)row * 512 + 128 * k + 2 * lane) = (u16)w;
      }
      if (lane == 0) inv_out[row] = am > 0.f ? am * (1.f / 6.f) : 1.f;
    }
  }
}
DI void rmsnorm1024(const float* __restrict__ src, const float* __restrict__ g, u16* __restrict__ dst) {
  const int lane = threadIdx.x & 63, gw = blockIdx.x * NWAVES + (threadIdx.x >> 6), nw = gridDim.x * NWAVES;
  float4 gg[4];
#pragma unroll
  for (int j = 0; j < 4; ++j) gg[j] = ((const float4*)g)[lane + 64 * j];
  for (int row0 = gw * 4; row0 < T; row0 += nw * 4) {
    float4 v[4][4];
#pragma unroll
    for (int rr = 0; rr < 4; ++rr)
#pragma unroll
      for (int j = 0; j < 4; ++j) v[rr][j] = ld_nt_f4((const float4*)(src + (size_t)(row0 + rr) * D) + lane + 64 * j);
#pragma unroll
    for (int rr = 0; rr < 4; ++rr) {
      float ss = 0.f;
#pragma unroll
      for (int j = 0; j < 4; ++j) ss += v[rr][j].x * v[rr][j].x + v[rr][j].y * v[rr][j].y + v[rr][j].z * v[rr][j].z + v[rr][j].w * v[rr][j].w;
      ss = wave_sum(ss);
      const float inv = rsqrtf(ss * (1.f / D) + EPS);
#pragma unroll
      for (int j = 0; j < 4; ++j) {
        uint2 o; o.x = pack2(v[rr][j].x * inv * gg[j].x, v[rr][j].y * inv * gg[j].y); o.y = pack2(v[rr][j].z * inv * gg[j].z, v[rr][j].w * inv * gg[j].w);
        *(uint2*)(dst + (size_t)(row0 + rr) * D + 4 * (lane + 64 * j)) = o;
      }
    }
  }
}

DI void conv_tokens(const Params& p, const u16* __restrict__ proj, u16* __restrict__ mixed) {
  const int lane = threadIdx.x & 63, gw = blockIdx.x * NWAVES + (threadIdx.x >> 6), nw = gridDim.x * NWAVES;
  const int c0 = 8 * lane;
  float w0[8], w1[8], w2[8], go[8];
#pragma unroll
  for (int j = 0; j < 8; ++j) { w0[j] = p.conv_w[c0 + j]; w1[j] = p.conv_w[DSB + c0 + j]; w2[j] = p.conv_w[2 * DSB + c0 + j]; go[j] = p.conv_out_g[c0 + j]; }
#pragma unroll 2
  for (int t = gw; t < T; t += nw) {
    const u16* row = proj + (size_t)t * DIN;
    const int tpos = t & (SEQ - 1);
    float xc[8], bg[8], cg[8], y[8];
    unpack8(*(const uint4*)(row + 1536 + c0), xc); unpack8(*(const uint4*)(row + 2048 + c0), bg); unpack8(*(const uint4*)(row + 2560 + c0), cg);
#pragma unroll
    for (int j = 0; j < 8; ++j) y[j] = w2[j] * (cg[j] * xc[j]);
    if (tpos >= 1) {
      float x1[8], c1[8]; unpack8(*(const uint4*)(row - DIN + 1536 + c0), x1); unpack8(*(const uint4*)(row - DIN + 2560 + c0), c1);
#pragma unroll
      for (int j = 0; j < 8; ++j) y[j] += w1[j] * (c1[j] * x1[j]);
    }
    if (tpos >= 2) {
      float x2[8], c2[8]; unpack8(*(const uint4*)(row - 2 * DIN + 1536 + c0), x2); unpack8(*(const uint4*)(row - 2 * DIN + 2560 + c0), c2);
#pragma unroll
      for (int j = 0; j < 8; ++j) y[j] += w0[j] * (c2[j] * x2[j]);
    }
    float ss = 0.f;
#pragma unroll
    for (int j = 0; j < 8; ++j) { y[j] *= bg[j]; ss += y[j] * y[j]; }
    ss = wave_sum(ss);
    const float inv = rsqrtf(ss * (1.f / DSB) + EPS);
#pragma unroll
    for (int j = 0; j < 8; ++j) y[j] = y[j] * inv * go[j];
    *(uint4*)(mixed + (size_t)t * D + DSB + c0) = pack8(y);
  }
}

typedef float f32x16_t __attribute__((ext_vector_type(16)));
typedef short bf16x8_t __attribute__((ext_vector_type(8)));
DI bf16x8_t pack_bf16x8(float a0, float a1, float a2, float a3, float a4, float a5, float a6, float a7) {
  pg8::u32x4 r;
  asm volatile("v_cvt_pk_bf16_f32 %0, %4, %5\n\tv_cvt_pk_bf16_f32 %1, %6, %7\n\tv_cvt_pk_bf16_f32 %2, %8, %9\n\tv_cvt_pk_bf16_f32 %3, %10, %11\n\ts_nop 1"
               : "=&v"(r[0]), "=&v"(r[1]), "=&v"(r[2]), "=&v"(r[3]) : "v"(a0), "v"(a1), "v"(a2), "v"(a3), "v"(a4), "v"(a5), "v"(a6), "v"(a7));
  return __builtin_bit_cast(bf16x8_t, r);
}
struct AttnKV { bf16x8_t k0, k1, k2, k3, v00, v01, v10, v11; float ik[16]; };
DI void attn_load(AttnKV& f, const u16* __restrict__ kr, const u16* __restrict__ vr, const float* __restrict__ ksq) {
  f.k0 = *(const bf16x8_t*)(kr); f.k1 = *(const bf16x8_t*)(kr + 16); f.k2 = *(const bf16x8_t*)(kr + 32); f.k3 = *(const bf16x8_t*)(kr + 48);
  f.v00 = *(const bf16x8_t*)(vr); f.v01 = *(const bf16x8_t*)(vr + 8); f.v10 = *(const bf16x8_t*)(vr + 32 * SEQ); f.v11 = *(const bf16x8_t*)(vr + 32 * SEQ + 8);
#pragma unroll
  for (int r4 = 0; r4 < 4; ++r4) { const float4 q4 = ((const float4*)ksq)[r4];
    f.ik[4 * r4] = rsqrtf(q4.x * (1.f / 64.f) + EPS); f.ik[4 * r4 + 1] = rsqrtf(q4.y * (1.f / 64.f) + EPS); f.ik[4 * r4 + 2] = rsqrtf(q4.z * (1.f / 64.f) + EPS); f.ik[4 * r4 + 3] = rsqrtf(q4.w * (1.f / 64.f) + EPS); }
}
template <bool DIAG>
DI void attn_half(const AttnKV& f, const bf16x8_t (&qf)[4], int c, int hh, float& carry, f32x16_t& o0, f32x16_t& o1) {
  f32x16_t s;
#pragma unroll
  for (int r = 0; r < 16; ++r) s[r] = 0.f;
  s = __builtin_amdgcn_mfma_f32_32x32x16_bf16(f.k0, qf[0], s, 0, 0, 0); s = __builtin_amdgcn_mfma_f32_32x32x16_bf16(f.k1, qf[1], s, 0, 0, 0);
  s = __builtin_amdgcn_mfma_f32_32x32x16_bf16(f.k2, qf[2], s, 0, 0, 0); s = __builtin_amdgcn_mfma_f32_32x32x16_bf16(f.k3, qf[3], s, 0, 0, 0);
  float rr[16], be[16];
#pragma unroll
  for (int r = 0; r < 16; ++r) {
    const float e = __builtin_amdgcn_exp2f(fminf(s[r] * f.ik[r] * 0.18033688011112042f, 100.f));
    float x = __builtin_amdgcn_rcpf(1.f + e), b = e * x;
    if (DIAG) { const bool on = (16 * hh + r) < c; x = on ? x : 1.f; b = on ? b : 0.f; }
    rr[r] = x; be[r] = b;
  }
  float tot = ((rr[0] * rr[1]) * (rr[2] * rr[3])) * ((rr[4] * rr[5]) * (rr[6] * rr[7]));
  tot *= ((rr[8] * rr[9]) * (rr[10] * rr[11])) * ((rr[12] * rr[13]) * (rr[14] * rr[15]));
  const float oth = __shfl_xor(tot, 32);
  float P = hh ? carry : carry * oth;
  float a[16];
#pragma unroll
  for (int r = 15; r >= 0; --r) { a[r] = be[r] * P; P *= rr[r]; }
  carry = carry * tot * oth;
  const bf16x8_t af0 = pack_bf16x8(a[0], a[1], a[2], a[3], a[4], a[5], a[6], a[7]), af1 = pack_bf16x8(a[8], a[9], a[10], a[11], a[12], a[13], a[14], a[15]);
  o0 = __builtin_amdgcn_mfma_f32_32x32x16_bf16(f.v00, af0, o0, 0, 0, 0); o0 = __builtin_amdgcn_mfma_f32_32x32x16_bf16(f.v01, af1, o0, 0, 0, 0);
  o1 = __builtin_amdgcn_mfma_f32_32x32x16_bf16(f.v10, af0, o1, 0, 0, 0); o1 = __builtin_amdgcn_mfma_f32_32x32x16_bf16(f.v11, af1, o1, 0, 0, 0);
}
DI void attn_phase(const Params& p, const u16* __restrict__ proj, const u16* __restrict__ vt, const float* __restrict__ ssq, u16* __restrict__ mixed, unsigned char* smem) {
  const int lane = threadIdx.x & 63, head = threadIdx.x >> 6, c = lane & 31, hh = lane >> 5;
  LAS float* red = (LAS float*)smem;
  const int kap = 16 * ((c >> 2) & 1) + (c & 3) + 4 * (c >> 3);
  for (int item = blockIdx.x; item < 4 * 64; item += gridDim.x) {
    const int b = item & 3, q0 = (63 - (item >> 2)) * 64;
    const size_t tq = (size_t)b * SEQ + q0 + c;
    const float* qsq = ssq + ((size_t)(b * 8 + head)) * SEQ;
    const float* ksqb = ssq + ((size_t)(32 + b * 8 + head)) * SEQ + 16 * hh;
    bf16x8_t qL[4], qU[4];
#pragma unroll
    for (int up = 0; up < 2; ++up) {
      const float iq = rsqrtf(qsq[q0 + 32 * up + c] * (1.f / 64.f) + EPS);
#pragma unroll
      for (int ks = 0; ks < 4; ++ks) { float f[8]; unpack8(*(const uint4*)(proj + (tq + 32 * up) * DIN + head * 64 + 16 * ks + 8 * hh), f);
        float gq[8];
        { const float4 qa = *(const float4*)(p.q_norm_g + 16 * ks + 8 * hh), qb = *(const float4*)(p.q_norm_g + 16 * ks + 8 * hh + 4), ka = *(const float4*)(p.k_norm_g + 16 * ks + 8 * hh), kb = *(const float4*)(p.k_norm_g + 16 * ks + 8 * hh + 4);
          gq[0] = qa.x * ka.x * iq; gq[1] = qa.y * ka.y * iq; gq[2] = qa.z * ka.z * iq; gq[3] = qa.w * ka.w * iq; gq[4] = qb.x * kb.x * iq; gq[5] = qb.y * kb.y * iq; gq[6] = qb.z * kb.z * iq; gq[7] = qb.w * kb.w * iq; }
        const bf16x8_t v = pack_bf16x8(f[0] * gq[0], f[1] * gq[1], f[2] * gq[2], f[3] * gq[3], f[4] * gq[4], f[5] * gq[5], f[6] * gq[6], f[7] * gq[7]);
        if (up) qU[ks] = v; else qL[ks] = v; }
    }
    f32x16_t oL0, oL1, oU0, oU1;
#pragma unroll
    for (int r = 0; r < 16; ++r) { oL0[r] = 0.f; oL1[r] = 0.f; oU0[r] = 0.f; oU1[r] = 0.f; }
    float cL = 1.f, cU = 1.f;
    const u16* kbase = proj + ((size_t)b * SEQ + kap) * DIN + 512 + head * 64 + 8 * hh;
    const u16* vbase = vt + ((size_t)(b * 512 + head * 64 + c)) * SEQ + 16 * hh;
    AttnKV kv;
    attn_load(kv, kbase + (size_t)(q0 + 32) * DIN, vbase + q0 + 32, ksqb + q0 + 32);
    attn_half<true>(kv, qU, c, hh, cU, oU0, oU1);
    attn_load(kv, kbase + (size_t)q0 * DIN, vbase + q0, ksqb + q0);
    attn_half<false>(kv, qU, c, hh, cU, oU0, oU1);
    attn_half<true>(kv, qL, c, hh, cL, oL0, oL1);
    for (int tb = q0 - 32; tb >= 0; tb -= 32) {
      attn_load(kv, kbase + (size_t)tb * DIN, vbase + tb, ksqb + tb);
      const bool uz = __all(cU == 0.f);
      if (!uz) attn_half<false>(kv, qU, c, hh, cU, oU0, oU1);
      attn_half<false>(kv, qL, c, hh, cL, oL0, oL1);
      if (uz && __all(cL == 0.f)) break;
    }
    float sL = 0.f, sU = 0.f;
#pragma unroll
    for (int r = 0; r < 16; ++r) { sL += oL0[r] * oL0[r] + oL1[r] * oL1[r]; sU += oU0[r] * oU0[r] + oU1[r] * oU1[r]; }
    sL += __shfl_xor(sL, 32); sU += __shfl_xor(sU, 32);
    __syncthreads();
    if (hh == 0) { red[head * 64 + c] = sL; red[head * 64 + 32 + c] = sU; }
    __syncthreads();
    float tL = 0.f, tU = 0.f;
#pragma unroll
    for (int h8 = 0; h8 < 8; ++h8) { tL += red[h8 * 64 + c]; tU += red[h8 * 64 + 32 + c]; }
    const float* g = p.sb_out_g + head * 64 + 4 * hh;
#pragma unroll
    for (int up = 0; up < 2; ++up) {
      const float inv = rsqrtf((up ? tU : tL) * (1.f / DSB) + EPS);
      u16* orow = mixed + (tq + 32 * up) * D + head * 64 + 4 * hh;
#pragma unroll
      for (int rg = 0; rg < 4; ++rg) {
        const float4 g0 = *(const float4*)(g + 8 * rg), g1 = *(const float4*)(g + 32 + 8 * rg);
        const float a0 = up ? oU0[4 * rg] : oL0[4 * rg], a1 = up ? oU0[4 * rg + 1] : oL0[4 * rg + 1], a2 = up ? oU0[4 * rg + 2] : oL0[4 * rg + 2], a3 = up ? oU0[4 * rg + 3] : oL0[4 * rg + 3];
        const float b0 = up ? oU1[4 * rg] : oL1[4 * rg], b1 = up ? oU1[4 * rg + 1] : oL1[4 * rg + 1], b2 = up ? oU1[4 * rg + 2] : oL1[4 * rg + 2], b3 = up ? oU1[4 * rg + 3] : oL1[4 * rg + 3];
        uint2 w0, w1;
        w0.x = pack2(a0 * inv * g0.x, a1 * inv * g0.y); w0.y = pack2(a2 * inv * g0.z, a3 * inv * g0.w);
        w1.x = pack2(b0 * inv * g1.x, b1 * inv * g1.y); w1.y = pack2(b2 * inv * g1.z, b3 * inv * g1.w);
        *(uint2*)(orow + 8 * rg) = w0; *(uint2*)(orow + 32 + 8 * rg) = w1;
      }
    }
  }
}
#define SEL_DI DI
#define SEL_F2U(x) __float_as_uint(x)
#define SEL_U2F(x) __uint_as_float(x)

#define CE(a, b) do { const unsigned _h = (a) > (b) ? (a) : (b), _l = (a) > (b) ? (b) : (a); (a) = _h; (b) = _l; } while (0)
SEL_DI void sort16(unsigned (&v)[16]) {
  CE(v[0], v[1]); CE(v[2], v[3]); CE(v[0], v[2]); CE(v[1], v[3]); CE(v[1], v[2]); CE(v[4], v[5]); CE(v[6], v[7]); CE(v[4], v[6]);
  CE(v[5], v[7]); CE(v[5], v[6]); CE(v[0], v[4]); CE(v[2], v[6]); CE(v[2], v[4]); CE(v[1], v[5]); CE(v[3], v[7]); CE(v[3], v[5]);
  CE(v[1], v[2]); CE(v[3], v[4]); CE(v[5], v[6]); CE(v[8], v[9]); CE(v[10], v[11]); CE(v[8], v[10]); CE(v[9], v[11]); CE(v[9], v[10]);
  CE(v[12], v[13]); CE(v[14], v[15]); CE(v[12], v[14]); CE(v[13], v[15]); CE(v[13], v[14]); CE(v[8], v[12]); CE(v[10], v[14]); CE(v[10], v[12]);
  CE(v[9], v[13]); CE(v[11], v[15]); CE(v[11], v[13]); CE(v[9], v[10]); CE(v[11], v[12]); CE(v[13], v[14]); CE(v[0], v[8]); CE(v[4], v[12]);
  CE(v[4], v[8]); CE(v[2], v[10]); CE(v[6], v[14]); CE(v[6], v[10]); CE(v[2], v[4]); CE(v[6], v[8]); CE(v[10], v[12]); CE(v[1], v[9]);
  CE(v[5], v[13]); CE(v[5], v[9]); CE(v[3], v[11]); CE(v[7], v[15]); CE(v[7], v[11]); CE(v[3], v[5]); CE(v[7], v[9]); CE(v[11], v[13]);
  CE(v[1], v[2]); CE(v[3], v[4]); CE(v[5], v[6]); CE(v[7], v[8]); CE(v[9], v[10]); CE(v[11], v[12]); CE(v[13], v[14]);
}
SEL_DI void bitonic_merge16(unsigned (&v)[16]) {
#pragma unroll
  for (int d = 8; d >= 1; d >>= 1)
#pragma unroll
    for (int i = 0; i < 16; ++i) if ((i & d) == 0) CE(v[i], v[i + d]);
}
SEL_DI void merge_top16(unsigned (&a)[16], const unsigned (&b)[16]) {
#pragma unroll
  for (int i = 0; i < 16; ++i) a[i] = a[i] > b[15 - i] ? a[i] : b[15 - i];
  bitonic_merge16(a);
}
SEL_DI void top16_of_64(unsigned (&g0)[16], unsigned (&g1)[16], unsigned (&g2)[16], unsigned (&g3)[16]) {
  sort16(g0); sort16(g1); sort16(g2); sort16(g3);
  merge_top16(g0, g1); merge_top16(g2, g3); merge_top16(g0, g2);
}
SEL_DI unsigned cand_key(float a, float b, unsigned payload) {
  float s = a + b; s = s < 32.0f ? 32.0f : (s > 127.99f ? 127.99f : s);
  return ((SEL_F2U(s) << 8) & 0xFFFFC000u) | payload;
}
SEL_DI void stage2(const unsigned (&L1)[16], const unsigned (&L2)[16], unsigned (&R)[16]) {
  float f1[16], f2m[16]; unsigned P1[16], P2[16];
#pragma unroll
  for (int i = 0; i < 16; ++i) { f1[i] = SEL_U2F(L1[i] & ~127u); f2m[i] = SEL_U2F(L2[i] & ~127u) - 64.0f; P1[i] = (L1[i] & 127u) << 7; P2[i] = L2[i] & 127u; }
  unsigned K[64];
  K[0] = cand_key(f1[0], f2m[0], P1[0] | P2[0]);
  K[1] = cand_key(f1[0], f2m[1], P1[0] | P2[1]);
  K[2] = cand_key(f1[0], f2m[2], P1[0] | P2[2]);
  K[3] = cand_key(f1[0], f2m[3], P1[0] | P2[3]);
  K[4] = cand_key(f1[0], f2m[4], P1[0] | P2[4]);
  K[5] = cand_key(f1[0], f2m[5], P1[0] | P2[5]);
  K[6] = cand_key(f1[0], f2m[6], P1[0] | P2[6]);
  K[7] = cand_key(f1[0], f2m[7], P1[0] | P2[7]);
  K[8] = cand_key(f1[0], f2m[8], P1[0] | P2[8]);
  K[9] = cand_key(f1[0], f2m[9], P1[0] | P2[9]);
  K[10] = cand_key(f1[0], f2m[10], P1[0] | P2[10]);
  K[11] = cand_key(f1[0], f2m[11], P1[0] | P2[11]);
  K[12] = cand_key(f1[0], f2m[12], P1[0] | P2[12]);
  K[13] = cand_key(f1[0], f2m[13], P1[0] | P2[13]);
  K[14] = cand_key(f1[0], f2m[14], P1[0] | P2[14]);
  K[15] = cand_key(f1[0], f2m[15], P1[0] | P2[15]);
  K[16] = cand_key(f1[1], f2m[0], P1[1] | P2[0]);
  K[17] = cand_key(f1[1], f2m[1], P1[1] | P2[1]);
  K[18] = cand_key(f1[1], f2m[2], P1[1] | P2[2]);
  K[19] = cand_key(f1[1], f2m[3], P1[1] | P2[3]);
  K[20] = cand_key(f1[1], f2m[4], P1[1] | P2[4]);
  K[21] = cand_key(f1[1], f2m[5], P1[1] | P2[5]);
  K[22] = cand_key(f1[1], f2m[6], P1[1] | P2[6]);
  K[23] = cand_key(f1[1], f2m[7], P1[1] | P2[7]);
  K[24] = cand_key(f1[2], f2m[0], P1[2] | P2[0]);
  K[25] = cand_key(f1[2], f2m[1], P1[2] | P2[1]);
  K[26] = cand_key(f1[2], f2m[2], P1[2] | P2[2]);
  K[27] = cand_key(f1[2], f2m[3], P1[2] | P2[3]);
  K[28] = cand_key(f1[2], f2m[4], P1[2] | P2[4]);
  K[29] = cand_key(f1[3], f2m[0], P1[3] | P2[0]);
  K[30] = cand_key(f1[3], f2m[1], P1[3] | P2[1]);
  K[31] = cand_key(f1[3], f2m[2], P1[3] | P2[2]);
  K[32] = cand_key(f1[3], f2m[3], P1[3] | P2[3]);
  K[33] = cand_key(f1[4], f2m[0], P1[4] | P2[0]);
  K[34] = cand_key(f1[4], f2m[1], P1[4] | P2[1]);
  K[35] = cand_key(f1[4], f2m[2], P1[4] | P2[2]);
  K[36] = cand_key(f1[5], f2m[0], P1[5] | P2[0]);
  K[37] = cand_key(f1[5], f2m[1], P1[5] | P2[1]);
  K[38] = cand_key(f1[6], f2m[0], P1[6] | P2[0]);
  K[39] = cand_key(f1[6], f2m[1], P1[6] | P2[1]);
  K[40] = cand_key(f1[7], f2m[0], P1[7] | P2[0]);
  K[41] = cand_key(f1[7], f2m[1], P1[7] | P2[1]);
  K[42] = cand_key(f1[8], f2m[0], P1[8] | P2[0]);
  K[43] = cand_key(f1[9], f2m[0], P1[9] | P2[0]);
  K[44] = cand_key(f1[10], f2m[0], P1[10] | P2[0]);
  K[45] = cand_key(f1[11], f2m[0], P1[11] | P2[0]);
  K[46] = cand_key(f1[12], f2m[0], P1[12] | P2[0]);
  K[47] = cand_key(f1[13], f2m[0], P1[13] | P2[0]);
  K[48] = cand_key(f1[14], f2m[0], P1[14] | P2[0]);
  K[49] = cand_key(f1[15], f2m[0], P1[15] | P2[0]);
#pragma unroll
  for (int c = 50; c < 64; ++c) K[c] = 0u;
  unsigned g1[16], g2[16], g3[16];
#pragma unroll
  for (int i = 0; i < 16; ++i) { R[i] = K[i]; g1[i] = K[16 + i]; g2[i] = K[32 + i]; g3[i] = K[48 + i]; }
  sort16(R); sort16(g1); sort16(g2); CE(g3[0], g3[1]);
  merge_top16(R, g1);
  g2[15] = g2[15] > g3[0] ? g2[15] : g3[0]; g2[14] = g2[14] > g3[1] ? g2[14] : g3[1];
  bitonic_merge16(g2);
  merge_top16(R, g2);
}

constexpr int SKP = 272;
struct QFrag { bf16x8_t f[8]; };
DI QFrag stage1_load(const u16* __restrict__ qrow, int hh) { QFrag q;
#pragma unroll
  for (int ks = 0; ks < 8; ++ks) q.f[ks] = *(const bf16x8_t*)(qrow + 16 * ks + 8 * hh);
  return q; }
DI void stage1(const QFrag& qfr, const LAS unsigned char* sk, int tok, int hh, unsigned (&out)[16]) {
  f32x16_t acc[4];
#pragma unroll
  for (int kt = 0; kt < 4; ++kt)
#pragma unroll
    for (int r = 0; r < 16; ++r) acc[kt][r] = 64.0f;
#pragma unroll
  for (int ks = 0; ks < 8; ++ks) {
#pragma unroll
    for (int kt = 0; kt < 4; ++kt) {
      const bf16x8_t ak = *(const LAS bf16x8_t*)(sk + (32 * kt + tok) * SKP + (16 * ks + 8 * hh) * 2);
      acc[kt] = __builtin_amdgcn_mfma_f32_32x32x16_bf16(ak, qfr.f[ks], acc[kt], 0, 0, 0);
    }
    __builtin_amdgcn_sched_barrier(0);
  }
  unsigned g1[16], g2[16], g3[16];
#pragma unroll
  for (int r = 0; r < 16; ++r) {
    const unsigned ix = (unsigned)((r & 3) + 8 * (r >> 2));
    out[r] = (__float_as_uint(acc[0][r]) & ~127u) | ix; g1[r] = (__float_as_uint(acc[1][r]) & ~127u) | (32u + ix);
    g2[r] = (__float_as_uint(acc[2][r]) & ~127u) | (64u + ix); g3[r] = (__float_as_uint(acc[3][r]) & ~127u) | (96u + ix);
  }
  top16_of_64(out, g1, g2, g3);
  unsigned oth[16];
#pragma unroll
  for (int i = 0; i < 16; ++i) { out[i] |= (unsigned)(hh << 2); }
#pragma unroll
  for (int i = 0; i < 16; ++i) oth[i] = (unsigned)__shfl_xor((int)out[i], 32);
  merge_top16(out, oth);
}
DI void topk_phase(const Params& p, const u16* __restrict__ qp, const float* __restrict__ uinv, int* __restrict__ idx_out, float2* __restrict__ gu_out, unsigned char* smem) {
  const int tid = threadIdx.x;
  LAS unsigned char* sk = (LAS unsigned char*)smem;
  __syncthreads();
#pragma unroll
  for (int i = tid; i < 2 * 128 * 16; i += NTHREADS) {
    const int c = i & 15, row = i >> 4;
    const float4* s = (const float4*)(p.sub_keys + (size_t)row * 128 + c * 8);
    const float4 a = s[0], b = s[1];
    pg8::u32x4 o; o.x = pack2(a.x, a.y); o.y = pack2(a.z, a.w); o.z = pack2(b.x, b.y); o.w = pack2(b.z, b.w);
    *(LAS pg8::u32x4*)(sk + row * SKP + c * 16) = o;
  }
  __syncthreads();
  const int lane = tid & 63, tok = lane & 31, hh = lane >> 5, gw = blockIdx.x * NWAVES + (tid >> 6), nw = gridDim.x * NWAVES;
  for (int item = gw; item < (T / 32) * 4; item += nw) {
    const int t = (item >> 2) * 32 + tok, hp = item & 3;
    const u16* qt = qp + (size_t)t * 2048 + hp * 512;
    unsigned LA1[16], LA2[16], LB1[16], LB2[16];
    { QFrag fa = stage1_load(qt, hh), fb = stage1_load(qt + 128, hh);
      stage1(fa, sk, tok, hh, LA1); fa = stage1_load(qt + 256, hh);
      stage1(fb, sk + 128 * SKP, tok, hh, LA2); fb = stage1_load(qt + 384, hh);
      stage1(fa, sk, tok, hh, LB1);
      stage1(fb, sk + 128 * SKP, tok, hh, LB2); }
    unsigned L1[16], L2[16], R[16];
#pragma unroll
    for (int i = 0; i < 16; ++i) { L1[i] = hh ? LB1[i] : LA1[i]; L2[i] = hh ? LB2[i] : LA2[i]; }
    stage2(L1, L2, R);
    const int head = hp * 2 + hh;
    float ev[16], sum = 0.f;
    const float mx = __uint_as_float(0x42000000u | ((R[0] >> 14) << 6));
#pragma unroll
    for (int k = 0; k < 16; ++k) { ev[k] = __expf(__uint_as_float(0x42000000u | ((R[k] >> 14) << 6)) - mx); sum += ev[k]; }
    const float rs = 1.f / sum;
    int* io = idx_out + (size_t)t * 128 + head * 16; float2* go = gu_out + (size_t)t * 128 + head * 16;
#pragma unroll
    for (int k4 = 0; k4 < 4; ++k4) {
      int4 ex; ex.x = (int)(R[4 * k4] & 0x3FFFu); ex.y = (int)(R[4 * k4 + 1] & 0x3FFFu); ex.z = (int)(R[4 * k4 + 2] & 0x3FFFu); ex.w = (int)(R[4 * k4 + 3] & 0x3FFFu);
      ((int4*)io)[k4] = ex;
      float4 ga, gb; ga.x = ev[4 * k4] * rs; ga.y = uinv[ex.x]; ga.z = ev[4 * k4 + 1] * rs; ga.w = uinv[ex.y];
      gb.x = ev[4 * k4 + 2] * rs; gb.y = uinv[ex.z]; gb.z = ev[4 * k4 + 3] * rs; gb.w = uinv[ex.w];
      ((float4*)go)[2 * k4] = ga; ((float4*)go)[2 * k4 + 1] = gb;
    }
  }
}

typedef float f32x4_t __attribute__((ext_vector_type(4)));
typedef float f32x2_t __attribute__((ext_vector_type(2)));
typedef int i32x8_t __attribute__((ext_vector_type(8)));
constexpr int UIP = 132;
constexpr int UGP = 1032;
struct UBuf { uint4 r0, r1, r2, r3; unsigned e; float vi; };
#define U_LOAD(buf, g) do { const unsigned _e = myi[(g)]; const LAS unsigned* _il = idl + (lane >> 5) * UIP + (g); const unsigned _lo = 16u * (lane & 31); \
    buf.r0 = *(const uint4*)(U4 + (size_t)_il[0] * 512 + _lo); buf.r1 = *(const uint4*)(U4 + (size_t)_il[2 * UIP] * 512 + _lo); \
    buf.r2 = *(const uint4*)(U4 + (size_t)_il[4 * UIP] * 512 + _lo); buf.r3 = *(const uint4*)(U4 + (size_t)_il[6 * UIP] * 512 + _lo); \
    buf.e = _e; buf.vi = vinv[_e]; } while (0)
#define U_ST(i, r) do { pg8::u32x4 _o; _o.x = (r).x; _o.y = (r).y; _o.z = (r).z; _o.w = (r).w; *(LAS pg8::u32x4*)(gst + (2 * (i) + (lane >> 5)) * 528 + 16 * (lane & 31)) = _o; } while (0)
#define U_LD(j) (*(const LAS pg8::u32x4*)(gld + 128 * (j)))
#define U_MMA(c, r, b) c = __builtin_amdgcn_mfma_scale_f32_16x16x128_f8f6f4((i32x8_t){(int)(r).x, (int)(r).y, (int)(r).z, (int)(r).w, 0, 0, 0, 0}, b, c, 4, 0, 0, 0x7F7F7F7F, 0, 0x7F7F7F7F)
#define U_COMP(buf, g) do { f32x4_t c = {0.f, 0.f, 0.f, 0.f}; \
    U_ST(0, buf.r0); U_ST(1, buf.r1); U_ST(2, buf.r2); U_ST(3, buf.r3); asm volatile("" ::: "memory"); \
    { const pg8::u32x4 a0 = U_LD(0), a1 = U_LD(1), a2 = U_LD(2), a3 = U_LD(3); asm volatile("" ::: "memory"); \
      U_MMA(c, a0, B0); U_MMA(c, a1, B1); U_MMA(c, a2, B2); U_MMA(c, a3, B3); } \
    const int rsel = pp & 3; const float v = rsel == 0 ? c[0] : rsel == 1 ? c[1] : rsel == 2 ? c[2] : c[3]; \
    const float vo = __shfl(v, (lane + 40) & 63); \
    if (pp < 8 && q == (pp >> 2)) { const f32x2_t gu2 = *(const LAS f32x2_t*)(myg + (g) * 8); \
      const float d = (v + vo) * gu2[1]; const float act = 0.5f * d * (1.f + erff(d * 0.70710678118654752f)); \
      uint2 o; o.x = buf.e; o.y = __float_as_uint(gu2[0] * act * buf.vi); pw[(size_t)tok * 128 + (g)] = o; } } while (0)
DI void peer_u_phase(const u16* __restrict__ xb, const float* __restrict__ rowss, const int* __restrict__ idx, const float2* __restrict__ gu,
                     const unsigned char* __restrict__ U4, const float* __restrict__ vinv, uint2* __restrict__ pw, unsigned char* smem) {
  const int lane = threadIdx.x & 63, wave = threadIdx.x >> 6, pp = lane & 15, q = lane >> 4, gw = blockIdx.x * NWAVES + wave, nw = gridDim.x * NWAVES;
  const int pi = pp & 7, x = q + 4 * (pp >> 3);
  const unsigned xoff = 16u * x;
  LAS unsigned* idl = (LAS unsigned*)(smem + wave * (8 * UIP * 4 + 8 * UGP + 8 * 528));
  LAS unsigned char* gul = (LAS unsigned char*)(idl + 8 * UIP);
  LAS unsigned char* gst = gul + 8 * UGP;
  const LAS unsigned char* gld = gst + pi * 528 + 16 * x;
  const LAS unsigned* myi = idl + pi * UIP;
  const LAS unsigned char* myg = gul + pi * UGP;
  for (int unit = gw; unit < T / 8; unit += nw) {
    const int tok = unit * 8 + pi;
    __builtin_amdgcn_wave_barrier();
#pragma unroll
    for (int r8 = 0; r8 < 8; ++r8) {
      const int* ir = idx + (size_t)(unit * 8 + r8) * 128;
      idl[r8 * UIP + lane] = (unsigned)ir[lane]; idl[r8 * UIP + 64 + lane] = (unsigned)ir[64 + lane];
      const uint4 gv = ((const uint4*)(gu + (size_t)(unit * 8 + r8) * 128))[lane];
      pg8::u32x4 o; o.x = gv.x; o.y = gv.y; o.z = gv.z; o.w = gv.w; *(LAS pg8::u32x4*)(gul + r8 * UGP + lane * 16) = o;
    }
    __builtin_amdgcn_fence(__ATOMIC_RELEASE, "wavefront");
    __builtin_amdgcn_wave_barrier();
    const float inv = rsqrtf(rowss[tok] * (1.f / D) + EPS);
    i32x8_t B0, B1, B2, B3;
#define U_BUILD(Bv, i) do { const u16* sb = xb + (size_t)tok * D + 256 * (i) + 128 * (pp >> 3) + 16 * q; \
      _Pragma("unroll") for (int h = 0; h < 4; ++h) { float f[8]; unpack8(*(const uint4*)(sb + 64 * (h >> 1) + 8 * (h & 1)), f); int w; \
        w = __builtin_amdgcn_cvt_pk_fp8_f32(f[0] * inv, f[1] * inv, 0, false); w = __builtin_amdgcn_cvt_pk_fp8_f32(f[2] * inv, f[3] * inv, w, true); Bv[2 * h] = w; \
        w = __builtin_amdgcn_cvt_pk_fp8_f32(f[4] * inv, f[5] * inv, 0, false); w = __builtin_amdgcn_cvt_pk_fp8_f32(f[6] * inv, f[7] * inv, w, true); Bv[2 * h + 1] = w; } } while (0)
    U_BUILD(B0, 0); U_BUILD(B1, 1); U_BUILD(B2, 2); U_BUILD(B3, 3);
    UBuf b0, b1, b2, b3;
#define SB() __builtin_amdgcn_sched_barrier(0)
    U_LOAD(b0, 0); U_LOAD(b1, 1); U_LOAD(b2, 2); SB();
#pragma unroll 1
    for (int g = 0; g < 128; g += 4) {
      U_LOAD(b3, g + 3); SB(); U_COMP(b0, g); SB();
      U_LOAD(b0, (g + 4) & 127); SB(); U_COMP(b1, g + 1); SB();
      U_LOAD(b1, (g + 5) & 127); SB(); U_COMP(b2, g + 2); SB();
      U_LOAD(b2, (g + 6) & 127); SB(); U_COMP(b3, g + 3); SB();
    }
  }
}

typedef int i32x2_t __attribute__((ext_vector_type(2)));
DI void peer_v_phase(const uint2* __restrict__ pw, const unsigned char* __restrict__ V4, const u16* __restrict__ xb, float* __restrict__ out, unsigned char* smem) {
  const int lane = threadIdx.x & 63, wave = threadIdx.x >> 6, r = lane >> 3, c = lane & 7, n16 = lane & 15, kg = lane >> 4;
  LAS unsigned char* img = (LAS unsigned char*)smem + wave * VWAVE;
  LAS unsigned char* pbuf = img + 128 * VIMP;
  const int nunit = 4 * (T / 64);
  const int cnt = ((int)blockIdx.x < nunit) ? (nunit - 1 - (int)blockIdx.x) / (int)gridDim.x + 1 : 0, N = cnt * 8;
  if (N == 0) return;
#define V_TOK(n, jj, tt) do { const int _u = (int)blockIdx.x + ((n) >> 3) * (int)gridDim.x; jj = _u & 3; tt = (_u >> 2) * 64 + wave * 8 + ((n) & 7); } while (0)
#define V_LDPW(n) ({ int _j, _t; V_TOK(n, _j, _t); ((const uint4*)(pw + (size_t)_t * 128))[lane]; })
#define V_STAGE(n, pq, scv) do { LAS unsigned char* _b = pbuf + ((n) & 1) * 1024; \
    *(LAS i32x2_t*)(_b + 8 * lane) = (i32x2_t){(int)(pq).x, (int)(pq).z}; *(LAS i32x2_t*)(_b + 512 + 8 * lane) = (i32x2_t){(int)(pq).y, (int)(pq).w}; \
    const float _m = wave_max(fmaxf(fabsf(__uint_as_float((pq).y)), fabsf(__uint_as_float((pq).w)))); scv = _m > 0.f ? 224.f / _m : 1.f; } while (0)
#define V_GATHER(n) do { int _j, _t; V_TOK(n, _j, _t); const unsigned char* _vb = V4 + (size_t)_j * ((size_t)NEXP * 128) + 16 * c; const LAS unsigned* _e = (const LAS unsigned*)(pbuf + ((n) & 1) * 1024); \
    _Pragma("unroll") for (int i = 0; i < 16; ++i) G[i] = *(const uint4*)(_vb + (_e[8 * i + r] * 128u)); } while (0)
#define V_WRITEIMG() do { _Pragma("unroll") for (int i = 0; i < 16; ++i) { LAS unsigned char* _d = img + (8 * i + r) * VIMP + 16 * c; \
      *(LAS i32x2_t*)(_d) = (i32x2_t){(int)G[i].x, (int)G[i].y}; *(LAS i32x2_t*)(_d + 8) = (i32x2_t){(int)G[i].z, (int)G[i].w}; } } while (0)
  uint4 G[16];
  uint4 pq = V_LDPW(0);
  float sc_cur, sc_nxt;
  V_STAGE(0, pq, sc_cur); asm volatile("" ::: "memory");
  if (N > 1) pq = V_LDPW(1);
  V_GATHER(0);
  V_WRITEIMG(); asm volatile("" ::: "memory");
  for (int n = 0; n < N; ++n) {
    int j, t; V_TOK(n, j, t);
    const uint2 xr = *(const uint2*)(xb + (size_t)t * D + 256 * j + 4 * lane);
    if (n + 1 < N) { V_STAGE(n + 1, pq, sc_nxt); asm volatile("" ::: "memory"); if (n + 2 < N) pq = V_LDPW(n + 2); V_GATHER(n + 1); }
    __builtin_amdgcn_sched_barrier(0);
    i32x8_t A;
    { const LAS float* wl = (const LAS float*)(pbuf + (n & 1) * 1024 + 512);
#pragma unroll
      for (int h = 0; h < 2; ++h)
#pragma unroll
        for (int d = 0; d < 4; ++d) { const f32x4_t w4 = *(const LAS f32x4_t*)(wl + 64 * h + 16 * kg + 4 * d);
          int w = __builtin_amdgcn_cvt_pk_fp8_f32(w4[0] * sc_cur, w4[1] * sc_cur, 0, false); w = __builtin_amdgcn_cvt_pk_fp8_f32(w4[2] * sc_cur, w4[3] * sc_cur, w, true);
          A[4 * h + d] = n16 == 0 ? w : 0; } }
    float val[16];
    const LAS unsigned char* ib = img + (32 * kg + n16) * VIMP;
    i32x2_t tb0[16], tb1[16];
#pragma unroll
    for (int ct = 0; ct < 16; ++ct) { tb0[ct] = __builtin_amdgcn_ds_read_tr4_b64_v2i32((LAS i32x2_t*)(ib + 8 * ct)); tb1[ct] = __builtin_amdgcn_ds_read_tr4_b64_v2i32((LAS i32x2_t*)(ib + 16 * VIMP + 8 * ct)); }
#pragma unroll
    for (int ct = 0; ct < 16; ++ct) {
      const f32x4_t z = {0.f, 0.f, 0.f, 0.f};
      const f32x4_t cc = __builtin_amdgcn_mfma_scale_f32_16x16x128_f8f6f4(A, (i32x8_t){tb0[ct][0], tb0[ct][1], tb1[ct][0], tb1[ct][1], 0, 0, 0, 0}, z, 0, 4, 0, 0x7F7F7F7F, 0, 0x7F7F7F7F);
      val[ct] = cc[0];
    }
    asm volatile("" : "+v"(val[0]), "+v"(val[1]), "+v"(val[2]), "+v"(val[3]), "+v"(val[4]), "+v"(val[5]), "+v"(val[6]), "+v"(val[7]),
                      "+v"(val[8]), "+v"(val[9]), "+v"(val[10]), "+v"(val[11]), "+v"(val[12]), "+v"(val[13]), "+v"(val[14]), "+v"(val[15]));
    LAS float* stg = (LAS float*)(pbuf + (n & 1) * 1024);
    if (lane < 16) {
#pragma unroll
      for (int ct = 0; ct < 16; ++ct) stg[16 * ct + lane] = val[ct];
    }
    asm volatile("" ::: "memory");
    const f32x4_t s4 = *(const LAS f32x4_t*)(stg + 4 * lane);
    const float rs = 1.f / sc_cur;
    float4 o;
    o.x = bflo(xr.x) + s4[0] * rs; o.y = bfhi(xr.x) + s4[1] * rs; o.z = bflo(xr.y) + s4[2] * rs; o.w = bfhi(xr.y) + s4[3] * rs;
    { typedef float f4v __attribute__((ext_vector_type(4))); const f4v ov = {o.x, o.y, o.z, o.w}; __builtin_nontemporal_store(ov, (f4v*)(out + (size_t)t * D + 256 * j + 4 * lane)); }
    __builtin_amdgcn_sched_barrier(0);
    asm volatile("" ::: "memory");
    if (n + 1 < N) { V_WRITEIMG(); sc_cur = sc_nxt; }
    asm volatile("" ::: "memory");
  }
}

constexpr int NPHASE = 8;
__global__ void __launch_bounds__(NTHREADS, 2) fwd_kernel(Params p) {
  extern __shared__ __attribute__((aligned(16))) unsigned char smem[];
  cg::grid_group grid = cg::this_grid();
  unsigned char* ws = p.ws;
  u16* wt_in = (u16*)(ws + WS_WTIN); u16* wt_out = (u16*)(ws + WS_WTOUT); u16* wt_q = (u16*)(ws + WS_WTQ);
  u16* act = (u16*)(ws + WS_ACT); u16* proj = (u16*)(ws + WS_PROJ);
  int* idx = (int*)(ws + WS_IDX); float2* gu = (float2*)(ws + WS_SB); unsigned char* U8 = ws + WS_U8; unsigned char* V8 = ws + WS_V8;
  uint2* pw = (uint2*)(ws + WS_PW); float* uinv = (float*)(ws + WS_UINV); float* vinv = (float*)(ws + WS_VINV);
  float* rowss = (float*)(ws + WS_ROWSS);
  volatile LAS unsigned* misc = (volatile LAS unsigned*)(LAS unsigned char*)(smem + LDS_MISC);
  if (threadIdx.x < 8) misc[threadIdx.x] = 0u;
  __syncthreads();
  XcdBarrier bar = xcd_barrier_post((unsigned*)(ws + WS_CTL), misc);
  PG8_LAS unsigned char* lds = (PG8_LAS unsigned char*)smem;
  const int lo = p.ph_lo, hi = p.ph_hi;
#define IN(k) (lo <= (k) && (k) < hi)
#define SEAM(k) do { if (IN(k) && IN((k) + 1)) xcd_barrier(bar); } while (0)
  if (IN(0)) {
    transpose_convert(p.w_in, wt_in, D, DIN, nullptr, (float*)smem);
    transpose_convert(p.w_out, wt_out, D, D, nullptr, (float*)smem);
    transpose_convert(p.w_q, wt_q, D, 2048, p.norm2_g, (float*)smem);
    convert_fp4_rows<false>(p.peer_u, p.norm2_g, U8, uinv);
    convert_fp4_rows<true>(p.peer_v, nullptr, V8, vinv);
    rmsnorm1024(p.x, p.norm1_g, act);
    for (int i = blockIdx.x * NTHREADS + threadIdx.x; i < T; i += gridDim.x * NTHREADS) rowss[i] = 0.f;
    for (int i = blockIdx.x * NTHREADS + threadIdx.x; i < 2 * 32 * SEQ; i += gridDim.x * NTHREADS) ((float*)(ws + WS_SB + 16 * MBy))[i] = 0.f;
  }
  if (lo < 0) grid.sync();
  SEAM(0);
  u16* vt = (u16*)(ws + WS_SB);
  float* ssq = (float*)(ws + WS_SB + 16 * MBy);
  if (IN(1)) { pg8::Gemm g{act, wt_in, T, DIN, D}; pg8::StaticOrder S; S.init(T, DIN, gridDim.x, blockIdx.x);
    pg8::EpiInProj E{proj, vt, ssq}; pg8::gemm_phase<pg8::EpiInProj, pg8::StaticOrder>(lds, g, S, E, nullptr); }
  SEAM(1);
  if (IN(2)) { attn_phase(p, proj, vt, ssq, act, smem); conv_tokens(p, proj, act); }
  SEAM(2);
  if (IN(3)) { pg8::Gemm g{act, wt_out, T, D, D}; pg8::StaticOrder S; S.init(T, D, gridDim.x, blockIdx.x);
    pg8::EpiResid E{p.x, p.out, proj, rowss, D}; pg8::gemm_phase<pg8::EpiResid, pg8::StaticOrder>(lds, g, S, E, nullptr); }
  SEAM(3);
  u16* xb = proj;
  u16* qp = proj + (size_t)T * D;
  if (IN(4)) { pg8::Gemm g{xb, wt_q, T, 2048, D}; pg8::StaticOrder S; S.init(T, 2048, gridDim.x, blockIdx.x);
    pg8::EpiBf16S E{qp, 2048, rowss}; pg8::gemm_phase<pg8::EpiBf16S, pg8::StaticOrder>(lds, g, S, E, nullptr); }
  SEAM(4);
  if (IN(5)) topk_phase(p, qp, uinv, idx, gu, smem);
  SEAM(5);
  if (IN(6)) peer_u_phase(xb, rowss, idx, gu, U8, vinv, pw, smem);
  SEAM(6);
  if (IN(7)) peer_v_phase(pw, V8, xb, p.out, smem);
}

extern "C" void kernel_launch(void* const* d_in, const int* in_sizes, int n_in, void* d_out, int out_size, void* d_ws, size_t ws_size,
                              hipStream_t stream) {
  static int grid_blocks = 0;
  if (!grid_blocks) {
    int dev = 0, cus = 0, per_cu = 0;
    (void)hipGetDevice(&dev);
    (void)hipDeviceGetAttribute(&cus, hipDeviceAttributeMultiprocessorCount, dev);
    (void)hipFuncSetAttribute((const void*)fwd_kernel, hipFuncAttributeMaxDynamicSharedMemorySize, LDS_BYTES);
    (void)hipOccupancyMaxActiveBlocksPerMultiprocessor(&per_cu, fwd_kernel, NTHREADS, LDS_BYTES);
    if (per_cu < 1) per_cu = 1;
    if (per_cu > 1) per_cu = 1;
    grid_blocks = cus * per_cu;
  }
  Params p{};
  p.x = (const float*)d_in[0]; p.norm1_g = (const float*)d_in[1]; p.w_in = (const float*)d_in[2]; p.q_norm_g = (const float*)d_in[3];
  p.k_norm_g = (const float*)d_in[4]; p.conv_w = (const float*)d_in[5]; p.sb_out_g = (const float*)d_in[6]; p.conv_out_g = (const float*)d_in[7];
  p.w_out = (const float*)d_in[8]; p.norm2_g = (const float*)d_in[9]; p.w_q = (const float*)d_in[10]; p.sub_keys = (const float*)d_in[11];
  p.peer_u = (const float*)d_in[12]; p.peer_v = (const float*)d_in[13];
  p.out = (float*)d_out; p.ws = (unsigned char*)d_ws;
  p.ph_lo = 0; p.ph_hi = NPHASE;
  (void)hipMemsetAsync((unsigned char*)d_ws + WS_CTL, 0, 4096 * 4 + 8 * 64 * 4, stream);
  void* args[] = {&p};
  hipError_t e = hipLaunchCooperativeKernel((void*)fwd_kernel, dim3(grid_blocks), dim3(NTHREADS), args, LDS_BYTES, stream);
  if (e != hipSuccess) fprintf(stderr, "cooperative launch failed: %s (grid %d)\n", hipGetErrorString(e), grid_blocks);
}
```

```cpp
#include <hip/hip_runtime.h>
#include <hip/hip_cooperative_groups.h>
#include <cstdio>
#include <cstdint>
namespace cg = cooperative_groups;

typedef unsigned short u16;
#define DI __device__ __forceinline__
#define LAS __attribute__((address_space(3)))

constexpr int T = 16384, D = 1024, SEQ = 4096;
constexpr int DIN = 3072, DSB = 512;
constexpr int NEXP = 16384;
constexpr float EPS = 1e-6f;
constexpr int NWAVES = 8, NTHREADS = NWAVES * 64;

namespace pg8 {
#define PG8_LAS __attribute__((address_space(3)))
typedef unsigned short bf16_t;
typedef short bf16x8 __attribute__((ext_vector_type(8)));
typedef float f32x4 __attribute__((ext_vector_type(4)));
typedef unsigned u32x4 __attribute__((ext_vector_type(4)));
constexpr int BM = 256, BK = 64, HALF = 128, HTB = HALF * BK * 2  , STAGE_BYTES = 8 * HTB, NXCD = 8, WGM = 8;

__host__ __device__ __forceinline__ int lds_byte(int r, int c) { const int st = (r >> 4) * 2 + (c >> 5), rr = r & 15, cc = c & 31, ob = rr * 64 + cc * 2; return st * 1024 + (ob ^ (((ob >> 9) & 1) << 5)); }
__host__ __device__ __forceinline__ void stage_rc(int b, int& R, int& C) { const int st = b / 1024, sb = b % 1024, swz = sb ^ (((sb >> 9) & 1) << 5); R = (st >> 1) * 16 + swz / 64; C = (st & 1) * 32 + (swz % 64) / 2; }
__host__ __device__ __forceinline__ int perm32(int rho) { const int n = rho >> 4, i = rho & 15; return 8 * (i >> 2) + 4 * n + (i & 3); }

struct Unit { int pm, pn; };
struct Gemm { const bf16_t* A; const bf16_t* Bt; int M, N, K; };
struct StaticOrder {
    int nM, nN, nwg, G, c;
    __host__ __device__ void init(int M, int N, int G_, int c_) { nM = M / BM; nN = N / BM; nwg = nM * nN; G = G_; c = c_; }
    __host__ __device__ bool next(int i, Unit& u) const {
        const long L = (long)i * G + c; if (L >= nwg) return false;
        int wgid = (int)L; { const int q = nwg / NXCD, r = nwg % NXCD, xcd = wgid % NXCD, off = wgid / NXCD; wgid = (xcd < r ? xcd * (q + 1) : r * (q + 1) + (xcd - r) * q) + off; }
        const int nig = WGM * nN, gid = wgid / nig, fm = gid * WGM, gsz = (nM - fm) < WGM ? (nM - fm) : WGM;
        u.pm = fm + ((wgid % nig) % gsz); u.pn = (wgid % nig) / gsz; return true;
    }
    __device__ __forceinline__ void a_ready(const Unit&) const {}
    __device__ __forceinline__ void done(const Unit&) const {}
};
__device__ __forceinline__ unsigned cvt_pk_bf16(float lo, float hi) { unsigned r; asm volatile("v_cvt_pk_bf16_f32 %0, %1, %2" : "=v"(r) : "v"(lo), "v"(hi)); return r; }

struct EpiBf16S {
    static constexpr bool PERM = true, AFTER_DRAIN = false;
    bf16_t* O; int ldc; const float* rowss;
    __device__ __forceinline__ void operator()(const f32x4 (&acc)[2][2][4][2], const Unit& u, int wr, int wc, int fr, int fq) const {
        const int row0 = u.pm * BM + wr * 64 + fr, col0 = u.pn * BM + wc * 32 + 8 * fq;
#pragma unroll
        for (int ai = 0; ai < 2; ++ai)
#pragma unroll
            for (int m = 0; m < 4; ++m) { const int row = row0 + ai * HALF + m * 16; bf16_t* rowp = O + (size_t)row * ldc + col0;
                const float sc = rowss ? rsqrtf(rowss[row] * (1.f / 1024.f) + 1e-6f) : 1.f;
#pragma unroll
                for (int bj = 0; bj < 2; ++bj) { const f32x4 v0 = acc[ai][bj][m][0] * sc, v1 = acc[ai][bj][m][1] * sc;
                    u32x4 w; w.x = cvt_pk_bf16(v0[0], v0[1]); w.y = cvt_pk_bf16(v0[2], v0[3]); w.z = cvt_pk_bf16(v1[0], v1[1]); w.w = cvt_pk_bf16(v1[2], v1[3]);
                    *(u32x4*)(rowp + bj * HALF) = w; } }
    }
};
struct EpiInProj {
    static constexpr bool PERM = true, AFTER_DRAIN = false;
    bf16_t* O; bf16_t* vt; float* ssq; PG8_LAS unsigned char* xl;
    __device__ __forceinline__ void operator()(const f32x4 (&acc)[2][2][4][2], const Unit& u, int wr, int wc, int fr, int fq) const {
        const int row0 = u.pm * BM + wr * 64 + fr, col0 = u.pn * BM + wc * 32 + 8 * fq, kind = u.pn >> 1;
        if (kind != 2) {
#pragma unroll
            for (int ai = 0; ai < 2; ++ai)
#pragma unroll
                for (int m = 0; m < 4; ++m) { const int row = row0 + ai * HALF + m * 16; const int bb = row >> 12, ss = row & 4095;
#pragma unroll
                    for (int bj = 0; bj < 2; ++bj) { const f32x4 v0 = acc[ai][bj][m][0], v1 = acc[ai][bj][m][1];
                        u32x4 w; w.x = cvt_pk_bf16(v0[0], v0[1]); w.y = cvt_pk_bf16(v0[2], v0[3]); w.z = cvt_pk_bf16(v1[0], v1[1]); w.w = cvt_pk_bf16(v1[2], v1[3]);
                        *(u32x4*)(O + (size_t)row * 3072 + col0 + bj * HALF) = w;
                        if (kind < 2) {
                            float sq = v0[0] * v0[0] + v0[1] * v0[1] + v0[2] * v0[2] + v0[3] * v0[3] + v1[0] * v1[0] + v1[1] * v1[1] + v1[2] * v1[2] + v1[3] * v1[3];
                            sq += __shfl_xor(sq, 16); sq += __shfl_xor(sq, 32);
                            const int head = (u.pn & 1) * 4 + bj * 2 + (wc >> 1);
                            if (fq == 0) unsafeAtomicAdd(ssq + ((size_t)(kind * 32 + bb * 8 + head)) * 4096 + ss, sq);
                        } } }
        } else {
            const int lane = fr + 16 * fq;
#pragma unroll
            for (int ai = 0; ai < 2; ++ai)
#pragma unroll
                for (int bj = 0; bj < 2; ++bj) {
                    const int d0w = (u.pn & 1) * 256 + bj * HALF + wc * 32;
#pragma unroll
                    for (int mh = 0; mh < 2; ++mh) {
#pragma unroll
                        for (int mm = 0; mm < 2; ++mm) { const f32x4 v0 = acc[ai][bj][2 * mh + mm][0], v1 = acc[ai][bj][2 * mh + mm][1];
                            const unsigned w0 = cvt_pk_bf16(v0[0], v0[1]), w1 = cvt_pk_bf16(v0[2], v0[3]), w2 = cvt_pk_bf16(v1[0], v1[1]), w3 = cvt_pk_bf16(v1[2], v1[3]);
                            PG8_LAS unsigned char* wp = xl + (8 * fq) * 80 + 2 * (16 * mm + fr);
                            *(PG8_LAS bf16_t*)(wp) = (bf16_t)w0; *(PG8_LAS bf16_t*)(wp + 80) = (bf16_t)(w0 >> 16); *(PG8_LAS bf16_t*)(wp + 160) = (bf16_t)w1; *(PG8_LAS bf16_t*)(wp + 240) = (bf16_t)(w1 >> 16);
                            *(PG8_LAS bf16_t*)(wp + 320) = (bf16_t)w2; *(PG8_LAS bf16_t*)(wp + 400) = (bf16_t)(w2 >> 16); *(PG8_LAS bf16_t*)(wp + 480) = (bf16_t)w3; *(PG8_LAS bf16_t*)(wp + 560) = (bf16_t)(w3 >> 16); }
                        asm volatile("" ::: "memory");
                        const int rowb = u.pm * BM + wr * 64 + ai * HALF + 32 * mh, bb = rowb >> 12, ssb = rowb & 4095;
#pragma unroll
                        for (int k = 0; k < 2; ++k) { const int id = lane + 64 * k, dd = id >> 2, tc = id & 3;
                            const u32x4 w = *(const PG8_LAS u32x4*)(xl + dd * 80 + 16 * tc);
                            *(u32x4*)(vt + ((size_t)(bb * 512 + d0w + dd)) * 4096 + ssb + 8 * tc) = w; }
                        asm volatile("" ::: "memory");
                    } }
        }
    }
};
struct EpiResid {
    static constexpr bool PERM = true, AFTER_DRAIN = false;
    const float* resid; float* out32; bf16_t* xb; float* rowss; int ldc;
    __device__ __forceinline__ void operator()(const f32x4 (&acc)[2][2][4][2], const Unit& u, int wr, int wc, int fr, int fq) const {
        const int row0 = u.pm * BM + wr * 64 + fr, col0 = u.pn * BM + wc * 32 + 8 * fq;
#pragma unroll
        for (int ai = 0; ai < 2; ++ai)
#pragma unroll
            for (int m = 0; m < 4; ++m) { const int row = row0 + ai * HALF + m * 16; const size_t off = (size_t)row * ldc + col0; float ss = 0.f;
#pragma unroll
                for (int bj = 0; bj < 2; ++bj) {
                    const f32x4 r0 = __builtin_nontemporal_load((const f32x4*)(resid + off + bj * HALF)), r1 = __builtin_nontemporal_load((const f32x4*)(resid + off + bj * HALF + 4));
                    const f32x4 o0 = r0 + acc[ai][bj][m][0], o1 = r1 + acc[ai][bj][m][1];
                    ss += o0[0] * o0[0] + o0[1] * o0[1] + o0[2] * o0[2] + o0[3] * o0[3] + o1[0] * o1[0] + o1[1] * o1[1] + o1[2] * o1[2] + o1[3] * o1[3];
                    u32x4 w; w.x = cvt_pk_bf16(o0[0], o0[1]); w.y = cvt_pk_bf16(o0[2], o0[3]); w.z = cvt_pk_bf16(o1[0], o1[1]); w.w = cvt_pk_bf16(o1[2], o1[3]);
                    *(u32x4*)(xb + off + bj * HALF) = w; }
                ss += __shfl_xor(ss, 16); ss += __shfl_xor(ss, 32);
                if (fq == 0) unsafeAtomicAdd(rowss + row, ss); }
    }
};
template <class Epi, class Sched, bool STAMP = false>
__device__ __forceinline__ void gemm_phase(PG8_LAS unsigned char* lds, const Gemm g, const Sched& S, const Epi& E, unsigned long long* stamps) {
    const int tid = threadIdx.x, wid = __builtin_amdgcn_readfirstlane(tid >> 6), lane = tid & 63, wr = wid >> 2, wc = wid & 3, fr = lane & 15, fq = lane >> 4;
    const int K = g.K, nt = K / BK;
    int ts_lo = 0, ts_hi = 0, nts = 0; const unsigned long long rt_entry = STAMP ? (unsigned long long)wall_clock64() : 0ull;
#define PG8_STAMP() do { if (STAMP && wid == 0 && nts < 64) { const unsigned long long _c = (unsigned long long)clock64(); \
        ts_lo = (lane == nts) ? (int)(unsigned)_c : ts_lo; ts_hi = (lane == nts) ? (int)(unsigned)(_c >> 32) : ts_hi; ++nts; } } while (0)
    PG8_STAMP();
    unsigned voffA[2], voffB[2];
#pragma unroll
    for (int i = 0; i < 2; ++i) { int R, C; stage_rc(tid * 16 + i * 8192, R, C); const int Rb = Epi::PERM ? ((R & ~31) + perm32(R & 31)) : R;
        voffA[i] = (unsigned)(R * K + C) * 2u; voffB[i] = (unsigned)(Rb * K + C) * 2u; }
    const size_t kstep = (size_t)(BK * 2);
    const size_t hstep = (size_t)HALF * K * 2;
    const size_t tstep = 2 * hstep;
    const unsigned ldsw = (unsigned)wid * 1024u;
    const int aoff = lds_byte(wr * 64 + fr, fq * 8), boff = lds_byte(wc * 32 + fr, fq * 8);
#define PG8_SA(b, h) (((b) * 2 + (h)) * HTB)
#define PG8_SB(b, h) ((4 + (b) * 2 + (h)) * HTB)
#define PG8_STAGE(bufoff, gbase, voff) do { _Pragma("unroll") for (int _i = 0; _i < 2; ++_i) \
        __builtin_amdgcn_global_load_lds((const unsigned*)((const char*)(gbase) + (voff)[_i]), (PG8_LAS unsigned*)(lds + (bufoff) + ldsw + _i * 8192), 16, 0, 0); } while (0)
#define PG8_LDA(dst, b, h) do { _Pragma("unroll") for (int m = 0; m < 4; ++m) _Pragma("unroll") for (int k = 0; k < 2; ++k) dst[m][k] = *(const PG8_LAS bf16x8*)(lds + PG8_SA(b, h) + aoff + m * 2048 + k * 1024); } while (0)
#define PG8_LDB(dst, b, h) do { _Pragma("unroll") for (int n = 0; n < 2; ++n) _Pragma("unroll") for (int k = 0; k < 2; ++k) dst[n][k] = *(const PG8_LAS bf16x8*)(lds + PG8_SB(b, h) + boff + n * 2048 + k * 1024); } while (0)
#define PG8_MMA(ai, bj, At, Bt) do { __builtin_amdgcn_s_setprio(1); _Pragma("unroll") for (int m = 0; m < 4; ++m) _Pragma("unroll") for (int n = 0; n < 2; ++n) _Pragma("unroll") for (int k = 0; k < 2; ++k) \
        acc[ai][bj][m][n] = __builtin_amdgcn_mfma_f32_16x16x32_bf16(Bt[n][k], At[m][k], acc[ai][bj][m][n], 0, 0, 0); __builtin_amdgcn_s_setprio(0); } while (0)
#define PG8_WAIT_V(n) asm volatile("s_waitcnt vmcnt(" #n ")" ::: "memory")
#define PG8_WAIT_L(n) asm volatile("s_waitcnt lgkmcnt(" #n ")" ::: "memory")
#define PG8_BAR __builtin_amdgcn_s_barrier()
#define PG8_SCHED __builtin_amdgcn_sched_barrier(0)
    Unit cur, nxt; int ui = 0;
    if (!S.next(0, cur)) return;
    f32x4 acc[2][2][4][2];
#pragma unroll
    for (int a = 0; a < 2; ++a)
#pragma unroll
        for (int b = 0; b < 2; ++b)
#pragma unroll
            for (int m = 0; m < 4; ++m)
#pragma unroll
                for (int n = 0; n < 2; ++n) acc[a][b][m][n] = (f32x4){0.f, 0.f, 0.f, 0.f};
    bf16x8 At[4][2], B0[2][2], B1[2][2];
    const char* cA = (const char*)g.A + (size_t)cur.pm * tstep; const char* cB = (const char*)g.Bt + (size_t)cur.pn * tstep;
    S.a_ready(cur);
    PG8_STAGE(PG8_SB(0, 0), cB, voffB); PG8_STAGE(PG8_SA(0, 0), cA, voffA); PG8_STAGE(PG8_SB(0, 1), cB + hstep, voffB); PG8_STAGE(PG8_SA(0, 1), cA + hstep, voffA);
    if (wr == 1) PG8_BAR;
    PG8_WAIT_V(4); PG8_BAR;
    PG8_STAGE(PG8_SB(1, 0), cB + kstep, voffB); PG8_STAGE(PG8_SA(1, 0), cA + kstep, voffA); PG8_STAGE(PG8_SB(1, 1), cB + hstep + kstep, voffB);
    PG8_WAIT_V(6); PG8_BAR;
    PG8_STAMP();
    for (;;) {
        const bool has_next = S.next(ui + 1, nxt);
        const char* nA = has_next ? (const char*)g.A + (size_t)nxt.pm * tstep : cA; const char* nB = has_next ? (const char*)g.Bt + (size_t)nxt.pn * tstep : cB;
        for (int t = 0; t < nt; t += 2) {
            const bool last = (t == nt - 2);
            const char* a1 = cA + (size_t)(t + 1) * kstep;
            const char* a2 = last ? nA : cA + (size_t)(t + 2) * kstep; const char* b2 = last ? nB : cB + (size_t)(t + 2) * kstep;
            const char* a3 = a2 + kstep; const char* b3 = b2 + kstep;
            if (last && has_next) S.a_ready(nxt);
            PG8_LDB(B0, 0, 0); PG8_SCHED; PG8_LDA(At, 0, 0); PG8_STAGE(PG8_SA(1, 1), a1 + hstep, voffA);
            PG8_WAIT_L(8); PG8_BAR; PG8_WAIT_L(0); PG8_MMA(0, 0, At, B0); PG8_BAR; PG8_SCHED;
            PG8_LDB(B1, 0, 1); PG8_STAGE(PG8_SB(0, 0), b2, voffB);
            PG8_BAR; PG8_WAIT_L(0); PG8_MMA(0, 1, At, B1); PG8_BAR;
            PG8_LDA(At, 0, 1); PG8_STAGE(PG8_SA(0, 0), a2, voffA);
            PG8_BAR; PG8_WAIT_L(0); PG8_MMA(1, 0, At, B0); PG8_BAR; PG8_SCHED;
            PG8_STAGE(PG8_SB(0, 1), b2 + hstep, voffB);
            PG8_WAIT_V(6); PG8_BAR; PG8_MMA(1, 1, At, B1); PG8_BAR;
            PG8_LDB(B0, 1, 0); PG8_SCHED; PG8_LDA(At, 1, 0); PG8_STAGE(PG8_SA(0, 1), a2 + hstep, voffA);
            PG8_WAIT_L(8); PG8_BAR; PG8_WAIT_L(0); PG8_MMA(0, 0, At, B0); PG8_BAR; PG8_SCHED;
            PG8_LDB(B1, 1, 1); PG8_STAGE(PG8_SB(1, 0), b3, voffB);
            PG8_BAR; PG8_WAIT_L(0); PG8_MMA(0, 1, At, B1); PG8_BAR;
            PG8_LDA(At, 1, 1); PG8_STAGE(PG8_SA(1, 0), a3, voffA);
            PG8_BAR; PG8_WAIT_L(0); PG8_MMA(1, 0, At, B0); PG8_BAR; PG8_SCHED;
            PG8_STAGE(PG8_SB(1, 1), b3 + hstep, voffB);
            PG8_WAIT_V(6); PG8_BAR; PG8_MMA(1, 1, At, B1); PG8_BAR;
        }
        PG8_STAMP();
        if constexpr (!Epi::AFTER_DRAIN) { E(acc, cur, wr, wc, fr, fq); S.done(cur); }
        PG8_STAMP();
        if (!has_next) break;
#pragma unroll
        for (int a = 0; a < 2; ++a)
#pragma unroll
            for (int b = 0; b < 2; ++b)
#pragma unroll
                for (int m = 0; m < 4; ++m)
#pragma unroll
                    for (int n = 0; n < 2; ++n) acc[a][b][m][n] = (f32x4){0.f, 0.f, 0.f, 0.f};
        cur = nxt; cA = nA; cB = nB; ++ui;
    }
    PG8_WAIT_V(0);
    if (wr == 0) PG8_BAR;
    PG8_BAR;
    if constexpr (Epi::AFTER_DRAIN) { E.fused(acc, cur, wr, wc, fr, fq, lds, wid, lane); S.done(cur); }
    PG8_STAMP();
    if (STAMP && wid == 0) { stamps[lane] = lane < nts ? (((unsigned long long)(unsigned)ts_hi << 32) | (unsigned)ts_lo) : 0ull;
        if (lane == 62) stamps[62] = rt_entry; if (lane == 63) stamps[63] = (unsigned long long)wall_clock64(); }
#undef PG8_STAMP
#undef PG8_SA
#undef PG8_SB
#undef PG8_STAGE
#undef PG8_LDA
#undef PG8_LDB
#undef PG8_MMA
#undef PG8_WAIT_V
#undef PG8_WAIT_L
#undef PG8_BAR
#undef PG8_SCHED
}
}


constexpr size_t MBy = 1u << 20;
constexpr size_t WS_WTIN = 0, WS_WTOUT = 6 * MBy, WS_WTQ = 8 * MBy, WS_CTL = 12 * MBy, WS_ROWSS = 12 * MBy + 65536, WS_ACT = 13 * MBy, WS_PROJ = 45 * MBy,
                 WS_SB = 141 * MBy, WS_IDX = 173 * MBy, WS_GATE = 181 * MBy, WS_U8 = 189 * MBy, WS_V8 = 205 * MBy, WS_PW = 221 * MBy,
                 WS_UINV = 12 * MBy + 262144, WS_VINV = 12 * MBy + 393216;
constexpr int VIMP = 136, VWAVE = 128 * VIMP + 2048;
constexpr int LDS_MISC = 8 * VWAVE, LDS_BYTES = 8 * VWAVE + 256;
static_assert(LDS_MISC >= pg8::STAGE_BYTES && LDS_BYTES <= 163840, "LDS budget");

struct Params {
  const float *x, *norm1_g, *w_in, *q_norm_g, *k_norm_g, *conv_w, *sb_out_g, *conv_out_g, *w_out, *norm2_g, *w_q, *sub_keys, *peer_u, *peer_v;
  float* out; unsigned char* ws; int ph_lo, ph_hi;
};

#define XB_TMO      128
#define XB_XCNT(j)  (256  + 64 * (j))
#define XB_XSUB(j)  (1280 + 64 * (j))
#define XB_XGEN(j)  (2304 + 64 * (j))
#define XB_TOP      3328
#define XB_TOPGEN   3392
#define XCD_BAR_WORDS 3456
#define XB_SPIN_CAP (1u << 18)
DI unsigned xb_ld(unsigned* p) { return __hip_atomic_load(p, __ATOMIC_RELAXED, __HIP_MEMORY_SCOPE_AGENT); }
DI unsigned xb_add(unsigned* p, unsigned v) { return __hip_atomic_fetch_add(p, v, __ATOMIC_RELAXED, __HIP_MEMORY_SCOPE_AGENT); }
DI unsigned xb_xcc_id() { return (unsigned)__builtin_amdgcn_s_getreg((3 << 11) | 20) & 0xFu; }
#define XB_SPIN(cond, bar) do { unsigned _sp = 0; while (cond) { __builtin_amdgcn_s_sleep(1); \
    if ((++_sp & 255u) == 0u) { if (xb_ld(&(bar)[XB_TMO])) break; if (_sp > XB_SPIN_CAP) { atomicAdd(&(bar)[XB_TMO], 1u); break; } } } } while (0)
struct XcdBarrier { unsigned* bar; unsigned x; volatile LAS unsigned* st; };
DI XcdBarrier xcd_barrier_post(unsigned* bar, volatile LAS unsigned* st) {
  XcdBarrier b; b.bar = bar; b.x = xb_xcc_id(); b.st = st;
  if (threadIdx.x == 0) (void)xb_add(&bar[XB_XCNT(b.x)], 1u);
  return b;
}
DI void xcd_barrier_complete(unsigned* bar, unsigned x, unsigned& nloc, unsigned& nx) {
  const unsigned G = gridDim.x * gridDim.y * gridDim.z;
  unsigned sum, cnt, mine, sp = 0u;
  for (;;) {
    sum = 0u; cnt = 0u; mine = 0u;
#pragma unroll
    for (unsigned j = 0; j < 16; ++j) { const unsigned c = xb_ld(&bar[XB_XCNT(j)]); sum += c; cnt += (c > 0u) ? 1u : 0u; mine = (j == x) ? c : mine; }
    if (sum == G) break;
    __builtin_amdgcn_s_sleep(1);
    if ((++sp & 255u) == 0u) { if (xb_ld(&bar[XB_TMO])) break; if (sp > XB_SPIN_CAP) { atomicAdd(&bar[XB_TMO], 1u); break; } }
  }
  nloc = mine > 0u ? mine : 1u; nx = cnt > 0u ? cnt : 1u;
}
DI void xcd_barrier(const XcdBarrier& b) {
  asm volatile("s_waitcnt vmcnt(0)" ::: "memory");
  __syncthreads();
  if (threadIdx.x == 0) {
    unsigned* bar = b.bar;
    __builtin_amdgcn_s_waitcnt(0);
    unsigned nloc = b.st[0], nx = b.st[1];
    if (nloc == 0u) { xcd_barrier_complete(bar, b.x, nloc, nx); b.st[0] = nloc; b.st[1] = nx; }
    const unsigned old = xb_add(&bar[XB_XSUB(b.x)], 1u);
    const unsigned gen = old / nloc;
    if (old + 1u == (gen + 1u) * nloc) {
      __builtin_amdgcn_fence(__ATOMIC_RELEASE, "agent");
      asm volatile("s_waitcnt vmcnt(0)" ::: "memory");
      const unsigned og = xb_add(&bar[XB_TOP], 1u);
      const unsigned tg = og / nx;
      if (og + 1u == (tg + 1u) * nx) xb_add(&bar[XB_TOPGEN], 1u);
      else XB_SPIN(xb_ld(&bar[XB_TOPGEN]) == tg, bar);
      __builtin_amdgcn_fence(__ATOMIC_ACQUIRE, "agent");
      xb_add(&bar[XB_XGEN(b.x)], 1u);
      asm volatile("s_waitcnt vmcnt(0)" ::: "memory");
    } else {
      XB_SPIN(xb_ld(&bar[XB_XGEN(b.x)]) == gen, bar);
      __builtin_amdgcn_fence(__ATOMIC_ACQUIRE, "agent");
      asm volatile("s_waitcnt vmcnt(0)" ::: "memory");
    }
  }
  __syncthreads();
}

DI u16 f2bf(float x) { unsigned u = __float_as_uint(x); u += 0x7fffu + ((u >> 16) & 1u); return (u16)(u >> 16); }
DI float bflo(unsigned w) { return __uint_as_float(w << 16); }
DI float bfhi(unsigned w) { return __uint_as_float(w & 0xffff0000u); }
DI unsigned pack2(float a, float b) { return (unsigned)f2bf(a) | ((unsigned)f2bf(b) << 16); }
DI float wave_sum(float v) {
#pragma unroll
  for (int o = 32; o >= 1; o >>= 1) v += __shfl_xor(v, o);
  return v;
}
DI float wave_max(float v) {
#pragma unroll
  for (int o = 32; o >= 1; o >>= 1) v = fmaxf(v, __shfl_xor(v, o));
  return v;
}
DI void unpack8(const uint4 w, float* f) {
  f[0] = bflo(w.x); f[1] = bfhi(w.x); f[2] = bflo(w.y); f[3] = bfhi(w.y); f[4] = bflo(w.z); f[5] = bfhi(w.z); f[6] = bflo(w.w); f[7] = bfhi(w.w);
}
DI uint4 pack8(const float* f) { uint4 o; o.x = pack2(f[0], f[1]); o.y = pack2(f[2], f[3]); o.z = pack2(f[4], f[5]); o.w = pack2(f[6], f[7]); return o; }


DI float4 ld_nt_f4(const float4* p) { typedef float f4v __attribute__((ext_vector_type(4))); const f4v v = __builtin_nontemporal_load((const f4v*)p); return make_float4(v.x, v.y, v.z, v.w); }

DI void transpose_convert(const float* __restrict__ W, u16* __restrict__ Wt, int K, int N, const float* __restrict__ rg, float* sm) {
  const int tid = threadIdx.x, tn_cnt = N / 64, ntile = (K / 64) * tn_cnt;
  for (int tile = blockIdx.x; tile < ntile; tile += gridDim.x) {
    const int tk = tile / tn_cnt, tn = tile % tn_cnt;
    __syncthreads();
#pragma unroll
    for (int r = 0; r < 2; ++r) { const int row = r * 32 + (tid >> 4), c4 = (tid & 15) * 4;
      const float g = rg ? rg[tk * 64 + row] : 1.f;
      const float4 v = ld_nt_f4((const float4*)(W + (size_t)(tk * 64 + row) * N + tn * 64 + c4));
      sm[row * 65 + c4] = v.x * g; sm[row * 65 + c4 + 1] = v.y * g; sm[row * 65 + c4 + 2] = v.z * g; sm[row * 65 + c4 + 3] = v.w * g; }
    __syncthreads();
    { const int n = tid & 63, k0 = (tid >> 6) * 8;
      float f[8];
#pragma unroll
      for (int j = 0; j < 8; ++j) f[j] = sm[(k0 + j) * 65 + n];
      *(uint4*)(Wt + (size_t)(tn * 64 + n) * K + tk * 64 + k0) = pack8(f); }
  }
}
template <bool SLICED>
DI void convert_fp4_rows(const float* __restrict__ src, const float* __restrict__ cg, unsigned char* __restrict__ dst, float* __restrict__ inv_out) {
  const int lane = threadIdx.x & 63, gw = blockIdx.x * NWAVES + (threadIdx.x >> 6), nw = gridDim.x * NWAVES;
  float4 g[4];
#pragma unroll
  for (int k = 0; k < 4; ++k) g[k] = cg ? ((const float4*)cg)[lane + 64 * k] : make_float4(1.f, 1.f, 1.f, 1.f);
  for (int row0 = gw * 4; row0 < NEXP; row0 += nw * 4) {
    float4 a[4][4];
#pragma unroll
    for (int rr = 0; rr < 4; ++rr)
#pragma unroll
      for (int k = 0; k < 4; ++k) a[rr][k] = ld_nt_f4((const float4*)(src + (size_t)(row0 + rr) * D) + lane + 64 * k);
#pragma unroll
    for (int rr = 0; rr < 4; ++rr) {
      float am = 0.f;
#pragma unroll
      for (int k = 0; k < 4; ++k) { a[rr][k].x *= g[k].x; a[rr][k].y *= g[k].y; a[rr][k].z *= g[k].z; a[rr][k].w *= g[k].w;
        am = fmaxf(fmaxf(am, fmaxf(fabsf(a[rr][k].x), fabsf(a[rr][k].y))), fmaxf(fabsf(a[rr][k].z), fabsf(a[rr][k].w))); }
      am = wave_max(am);
      const float sc = am > 0.f ? 6.f / am : 1.f;
      const int row = row0 + rr;
#pragma unroll
      for (int k = 0; k < 4; ++k) {
        unsigned w = 0u;
        w = __builtin_amdgcn_cvt_scalef32_pk_fp4_f32(w, a[rr][k].x * sc, a[rr][k].y * sc, 1.0f, 0); w = __builtin_amdgcn_cvt_scalef32_pk_fp4_f32(w, a[rr][k].z * sc, a[rr][k].w * sc, 1.0f, 1);
        if (SLICED) *(u16*)(dst + (size_t)k * ((size_t)NEXP * 128) + (size_t)row * 128 + 2 * lane) = (u16)w;
        else *(u16*)(dst + (size_t)row * 512 + 128 * k + 2 * lane) = (u16)w;
      }
      if (lane == 0) inv_out[row] = am > 0.f ? am * (1.f / 6.f) : 1.f;
    }
  }
}
DI void rmsnorm1024(const float* __restrict__ src, const float* __restrict__ g, u16* __restrict__ dst) {
  const int lane = threadIdx.x & 63, gw = blockIdx.x * NWAVES + (threadIdx.x >> 6), nw = gridDim.x * NWAVES;
  float4 gg[4];
#pragma unroll
  for (int j = 0; j < 4; ++j) gg[j] = ((const float4*)g)[lane + 64 * j];
  for (int row0 = gw * 4; row0 < T; row0 += nw * 4) {
    float4 v[4][4];
#pragma unroll
    for (int rr = 0; rr < 4; ++rr)
#pragma unroll
      for (int j = 0; j < 4; ++j) v[rr][j] = ld_nt_f4((const float4*)(src + (size_t)(row0 + rr) * D) + lane + 64 * j);
#pragma unroll
    for (int rr = 0; rr < 4; ++rr) {
      float ss = 0.f;
#pragma unroll
      for (int j = 0; j < 4; ++j) ss += v[rr][j].x * v[rr][j].x + v[rr][j].y * v[rr][j].y + v[rr][j].z * v[rr][j].z + v[rr][j].w * v[rr][j].w;
      ss = wave_sum(ss);
      const float inv = rsqrtf(ss * (1.f / D) + EPS);
#pragma unroll
      for (int j = 0; j < 4; ++j) {
        uint2 o; o.x = pack2(v[rr][j].x * inv * gg[j].x, v[rr][j].y * inv * gg[j].y); o.y = pack2(v[rr][j].z * inv * gg[j].z, v[rr][j].w * inv * gg[j].w);
        *(uint2*)(dst + (size_t)(row0 + rr) * D + 4 * (lane + 64 * j)) = o;
      }
    }
  }
}

DI void conv_tokens(const Params& p, const u16* __restrict__ proj, u16* __restrict__ mixed) {
  const int lane = threadIdx.x & 63, gw = blockIdx.x * NWAVES + (threadIdx.x >> 6), nw = gridDim.x * NWAVES;
  const int c0 = 8 * lane;
  float w0[8], w1[8], w2[8], go[8];
#pragma unroll
  for (int j = 0; j < 8; ++j) { w0[j] = p.conv_w[c0 + j]; w1[j] = p.conv_w[DSB + c0 + j]; w2[j] = p.conv_w[2 * DSB + c0 + j]; go[j] = p.conv_out_g[c0 + j]; }
#pragma unroll 2
  for (int t = gw; t < T; t += nw) {
    const u16* row = proj + (size_t)t * DIN;
    const int tpos = t & (SEQ - 1);
    float xc[8], bg[8], cg[8], y[8];
    unpack8(*(const uint4*)(row + 1536 + c0), xc); unpack8(*(const uint4*)(row + 2048 + c0), bg); unpack8(*(const uint4*)(row + 2560 + c0), cg);
#pragma unroll
    for (int j = 0; j < 8; ++j) y[j] = w2[j] * (cg[j] * xc[j]);
    if (tpos >= 1) {
      float x1[8], c1[8]; unpack8(*(const uint4*)(row - DIN + 1536 + c0), x1); unpack8(*(const uint4*)(row - DIN + 2560 + c0), c1);
#pragma unroll
      for (int j = 0; j < 8; ++j) y[j] += w1[j] * (c1[j] * x1[j]);
    }
    if (tpos >= 2) {
      float x2[8], c2[8]; unpack8(*(const uint4*)(row - 2 * DIN + 1536 + c0), x2); unpack8(*(const uint4*)(row - 2 * DIN + 2560 + c0), c2);
#pragma unroll
      for (int j = 0; j < 8; ++j) y[j] += w0[j] * (c2[j] * x2[j]);
    }
    float ss = 0.f;
#pragma unroll
    for (int j = 0; j < 8; ++j) { y[j] *= bg[j]; ss += y[j] * y[j]; }
    ss = wave_sum(ss);
    const float inv = rsqrtf(ss * (1.f / DSB) + EPS);
#pragma unroll
    for (int j = 0; j < 8; ++j) y[j] = y[j] * inv * go[j];
    *(uint4*)(mixed + (size_t)t * D + DSB + c0) = pack8(y);
  }
}

typedef float f32x16_t __attribute__((ext_vector_type(16)));
typedef short bf16x8_t __attribute__((ext_vector_type(8)));
DI bf16x8_t pack_bf16x8(float a0, float a1, float a2, float a3, float a4, float a5, float a6, float a7) {
  pg8::u32x4 r;
  asm volatile("v_cvt_pk_bf16_f32 %0, %4, %5\n\tv_cvt_pk_bf16_f32 %1, %6, %7\n\tv_cvt_pk_bf16_f32 %2, %8, %9\n\tv_cvt_pk_bf16_f32 %3, %10, %11\n\ts_nop 1"
               : "=&v"(r[0]), "=&v"(r[1]), "=&v"(r[2]), "=&v"(r[3]) : "v"(a0), "v"(a1), "v"(a2), "v"(a3), "v"(a4), "v"(a5), "v"(a6), "v"(a7));
  return __builtin_bit_cast(bf16x8_t, r);
}
struct AttnKV { bf16x8_t k0, k1, k2, k3, v00, v01, v10, v11; float ik[16]; };
DI void attn_load(AttnKV& f, const u16* __restrict__ kr, const u16* __restrict__ vr, const float* __restrict__ ksq) {
  f.k0 = *(const bf16x8_t*)(kr); f.k1 = *(const bf16x8_t*)(kr + 16); f.k2 = *(const bf16x8_t*)(kr + 32); f.k3 = *(const bf16x8_t*)(kr + 48);
  f.v00 = *(const bf16x8_t*)(vr); f.v01 = *(const bf16x8_t*)(vr + 8); f.v10 = *(const bf16x8_t*)(vr + 32 * SEQ); f.v11 = *(const bf16x8_t*)(vr + 32 * SEQ + 8);
#pragma unroll
  for (int r4 = 0; r4 < 4; ++r4) { const float4 q4 = ((const float4*)ksq)[r4];
    f.ik[4 * r4] = rsqrtf(q4.x * (1.f / 64.f) + EPS); f.ik[4 * r4 + 1] = rsqrtf(q4.y * (1.f / 64.f) + EPS); f.ik[4 * r4 + 2] = rsqrtf(q4.z * (1.f / 64.f) + EPS); f.ik[4 * r4 + 3] = rsqrtf(q4.w * (1.f / 64.f) + EPS); }
}
template <bool DIAG>
DI void attn_half(const AttnKV& f, const bf16x8_t (&qf)[4], int c, int hh, float& carry, f32x16_t& o0, f32x16_t& o1) {
  f32x16_t s;
#pragma unroll
  for (int r = 0; r < 16; ++r) s[r] = 0.f;
  s = __builtin_amdgcn_mfma_f32_32x32x16_bf16(f.k0, qf[0], s, 0, 0, 0); s = __builtin_amdgcn_mfma_f32_32x32x16_bf16(f.k1, qf[1], s, 0, 0, 0);
  s = __builtin_amdgcn_mfma_f32_32x32x16_bf16(f.k2, qf[2], s, 0, 0, 0); s = __builtin_amdgcn_mfma_f32_32x32x16_bf16(f.k3, qf[3], s, 0, 0, 0);
  float rr[16], be[16];
#pragma unroll
  for (int r = 0; r < 16; ++r) {
    const float e = __builtin_amdgcn_exp2f(fminf(s[r] * f.ik[r] * 0.18033688011112042f, 100.f));
    float x = __builtin_amdgcn_rcpf(1.f + e), b = e * x;
    if (DIAG) { const bool on = (16 * hh + r) < c; x = on ? x : 1.f; b = on ? b : 0.f; }
    rr[r] = x; be[r] = b;
  }
  float tot = ((rr[0] * rr[1]) * (rr[2] * rr[3])) * ((rr[4] * rr[5]) * (rr[6] * rr[7]));
  tot *= ((rr[8] * rr[9]) * (rr[10] * rr[11])) * ((rr[12] * rr[13]) * (rr[14] * rr[15]));
  const float oth = __shfl_xor(tot, 32);
  float P = hh ? carry : carry * oth;
  float a[16];
#pragma unroll
  for (int r = 15; r >= 0; --r) { a[r] = be[r] * P; P *= rr[r]; }
  carry = carry * tot * oth;
  const bf16x8_t af0 = pack_bf16x8(a[0], a[1], a[2], a[3], a[4], a[5], a[6], a[7]), af1 = pack_bf16x8(a[8], a[9], a[10], a[11], a[12], a[13], a[14], a[15]);
  o0 = __builtin_amdgcn_mfma_f32_32x32x16_bf16(f.v00, af0, o0, 0, 0, 0); o0 = __builtin_amdgcn_mfma_f32_32x32x16_bf16(f.v01, af1, o0, 0, 0, 0);
  o1 = __builtin_amdgcn_mfma_f32_32x32x16_bf16(f.v10, af0, o1, 0, 0, 0); o1 = __builtin_amdgcn_mfma_f32_32x32x16_bf16(f.v11, af1, o1, 0, 0, 0);
}
DI void attn_phase(const Params& p, const u16* __restrict__ proj, const u16* __restrict__ vt, const float* __restrict__ ssq, u16* __restrict__ mixed, unsigned char* smem) {
  const int lane = threadIdx.x & 63, head = threadIdx.x >> 6, c = lane & 31, hh = lane >> 5;
  LAS float* red = (LAS float*)smem;
  const int kap = 16 * ((c >> 2) & 1) + (c & 3) + 4 * (c >> 3);
  for (int item = blockIdx.x; item < 4 * 64; item += gridDim.x) {
    const int b = item & 3, q0 = (63 - (item >> 2)) * 64;
    const size_t tq = (size_t)b * SEQ + q0 + c;
    const float* qsq = ssq + ((size_t)(b * 8 + head)) * SEQ;
    const float* ksqb = ssq + ((size_t)(32 + b * 8 + head)) * SEQ + 16 * hh;
    bf16x8_t qL[4], qU[4];
#pragma unroll
    for (int up = 0; up < 2; ++up) {
      const float iq = rsqrtf(qsq[q0 + 32 * up + c] * (1.f / 64.f) + EPS);
#pragma unroll
      for (int ks = 0; ks < 4; ++ks) { float f[8]; unpack8(*(const uint4*)(proj + (tq + 32 * up) * DIN + head * 64 + 16 * ks + 8 * hh), f);
        float gq[8];
        { const float4 qa = *(const float4*)(p.q_norm_g + 16 * ks + 8 * hh), qb = *(const float4*)(p.q_norm_g + 16 * ks + 8 * hh + 4), ka = *(const float4*)(p.k_norm_g + 16 * ks + 8 * hh), kb = *(const float4*)(p.k_norm_g + 16 * ks + 8 * hh + 4);
          gq[0] = qa.x * ka.x * iq; gq[1] = qa.y * ka.y * iq; gq[2] = qa.z * ka.z * iq; gq[3] = qa.w * ka.w * iq; gq[4] = qb.x * kb.x * iq; gq[5] = qb.y * kb.y * iq; gq[6] = qb.z * kb.z * iq; gq[7] = qb.w * kb.w * iq; }
        const bf16x8_t v = pack_bf16x8(f[0] * gq[0], f[1] * gq[1], f[2] * gq[2], f[3] * gq[3], f[4] * gq[4], f[5] * gq[5], f[6] * gq[6], f[7] * gq[7]);
        if (up) qU[ks] = v; else qL[ks] = v; }
    }
    f32x16_t oL0, oL1, oU0, oU1;
#pragma unroll
    for (int r = 0; r < 16; ++r) { oL0[r] = 0.f; oL1[r] = 0.f; oU0[r] = 0.f; oU1[r] = 0.f; }
    float cL = 1.f, cU = 1.f;
    const u16* kbase = proj + ((size_t)b * SEQ + kap) * DIN + 512 + head * 64 + 8 * hh;
    const u16* vbase = vt + ((size_t)(b * 512 + head * 64 + c)) * SEQ + 16 * hh;
    AttnKV kv;
    attn_load(kv, kbase + (size_t)(q0 + 32) * DIN, vbase + q0 + 32, ksqb + q0 + 32);
    attn_half<true>(kv, qU, c, hh, cU, oU0, oU1);
    attn_load(kv, kbase + (size_t)q0 * DIN, vbase + q0, ksqb + q0);
    attn_half<false>(kv, qU, c, hh, cU, oU0, oU1);
    attn_half<true>(kv, qL, c, hh, cL, oL0, oL1);
    for (int tb = q0 - 32; tb >= 0; tb -= 32) {
      attn_load(kv, kbase + (size_t)tb * DIN, vbase + tb, ksqb + tb);
      const bool uz = __all(cU == 0.f);
      if (!uz) attn_half<false>(kv, qU, c, hh, cU, oU0, oU1);
      attn_half<false>(kv, qL, c, hh, cL, oL0, oL1);
      if (uz && __all(cL == 0.f)) break;
    }
    float sL = 0.f, sU = 0.f;
#pragma unroll
    for (int r = 0; r < 16; ++r) { sL += oL0[r] * oL0[r] + oL1[r] * oL1[r]; sU += oU0[r] * oU0[r] + oU1[r] * oU1[r]; }
    sL += __shfl_xor(sL, 32); sU += __shfl_xor(sU, 32);
    __syncthreads();
    if (hh == 0) { red[head * 64 + c] = sL; red[head * 64 + 32 + c] = sU; }
    __syncthreads();
    float tL = 0.f, tU = 0.f;
#pragma unroll
    for (int h8 = 0; h8 < 8; ++h8) { tL += red[h8 * 64 + c]; tU += red[h8 * 64 + 32 + c]; }
    const float* g = p.sb_out_g + head * 64 + 4 * hh;
#pragma unroll
    for (int up = 0; up < 2; ++up) {
      const float inv = rsqrtf((up ? tU : tL) * (1.f / DSB) + EPS);
      u16* orow = mixed + (tq + 32 * up) * D + head * 64 + 4 * hh;
#pragma unroll
      for (int rg = 0; rg < 4; ++rg) {
        const float4 g0 = *(const float4*)(g + 8 * rg), g1 = *(const float4*)(g + 32 + 8 * rg);
        const float a0 = up ? oU0[4 * rg] : oL0[4 * rg], a1 = up ? oU0[4 * rg + 1] : oL0[4 * rg + 1], a2 = up ? oU0[4 * rg + 2] : oL0[4 * rg + 2], a3 = up ? oU0[4 * rg + 3] : oL0[4 * rg + 3];
        const float b0 = up ? oU1[4 * rg] : oL1[4 * rg], b1 = up ? oU1[4 * rg + 1] : oL1[4 * rg + 1], b2 = up ? oU1[4 * rg + 2] : oL1[4 * rg + 2], b3 = up ? oU1[4 * rg + 3] : oL1[4 * rg + 3];
        uint2 w0, w1;
        w0.x = pack2(a0 * inv * g0.x, a1 * inv * g0.y); w0.y = pack2(a2 * inv * g0.z, a3 * inv * g0.w);
        w1.x = pack2(b0 * inv * g1.x, b1 * inv * g1.y); w1.y = pack2(b2 * inv * g1.z, b3 * inv * g1.w);
        *(uint2*)(orow + 8 * rg) = w0; *(uint2*)(orow + 32 + 8 * rg) = w1;
      }
    }
  }
}
#define SEL_DI DI
#define SEL_F2U(x) __float_as_uint(x)
#define SEL_U2F(x) __uint_as_float(x)

#define CE(a, b) do { const unsigned _h = (a) > (b) ? (a) : (b), _l = (a) > (b) ? (b) : (a); (a) = _h; (b) = _l; } while (0)
SEL_DI void sort16(unsigned (&v)[16]) {
  CE(v[0], v[1]); CE(v[2], v[3]); CE(v[0], v[2]); CE(v[1], v[3]); CE(v[1], v[2]); CE(v[4], v[5]); CE(v[6], v[7]); CE(v[4], v[6]);
  CE(v[5], v[7]); CE(v[5], v[6]); CE(v[0], v[4]); CE(v[2], v[6]); CE(v[2], v[4]); CE(v[1], v[5]); CE(v[3], v[7]); CE(v[3], v[5]);
  CE(v[1], v[2]); CE(v[3], v[4]); CE(v[5], v[6]); CE(v[8], v[9]); CE(v[10], v[11]); CE(v[8], v[10]); CE(v[9], v[11]); CE(v[9], v[10]);
  CE(v[12], v[13]); CE(v[14], v[15]); CE(v[12], v[14]); CE(v[13], v[15]); CE(v[13], v[14]); CE(v[8], v[12]); CE(v[10], v[14]); CE(v[10], v[12]);
  CE(v[9], v[13]); CE(v[11], v[15]); CE(v[11], v[13]); CE(v[9], v[10]); CE(v[11], v[12]); CE(v[13], v[14]); CE(v[0], v[8]); CE(v[4], v[12]);
  CE(v[4], v[8]); CE(v[2], v[10]); CE(v[6], v[14]); CE(v[6], v[10]); CE(v[2], v[4]); CE(v[6], v[8]); CE(v[10], v[12]); CE(v[1], v[9]);
  CE(v[5], v[13]); CE(v[5], v[9]); CE(v[3], v[11]); CE(v[7], v[15]); CE(v[7], v[11]); CE(v[3], v[5]); CE(v[7], v[9]); CE(v[11], v[13]);
  CE(v[1], v[2]); CE(v[3], v[4]); CE(v[5], v[6]); CE(v[7], v[8]); CE(v[9], v[10]); CE(v[11], v[12]); CE(v[13], v[14]);
}
SEL_DI void bitonic_merge16(unsigned (&v)[16]) {
#pragma unroll
  for (int d = 8; d >= 1; d >>= 1)
#pragma unroll
    for (int i = 0; i < 16; ++i) if ((i & d) == 0) CE(v[i], v[i + d]);
}
SEL_DI void merge_top16(unsigned (&a)[16], const unsigned (&b)[16]) {
#pragma unroll
  for (int i = 0; i < 16; ++i) a[i] = a[i] > b[15 - i] ? a[i] : b[15 - i];
  bitonic_merge16(a);
}
SEL_DI void top16_of_64(unsigned (&g0)[16], unsigned (&g1)[16], unsigned (&g2)[16], unsigned (&g3)[16]) {
  sort16(g0); sort16(g1); sort16(g2); sort16(g3);
  merge_top16(g0, g1); merge_top16(g2, g3); merge_top16(g0, g2);
}
SEL_DI unsigned cand_key(float a, float b, unsigned payload) {
  float s = a + b; s = s < 32.0f ? 32.0f : (s > 127.99f ? 127.99f : s);
  return ((SEL_F2U(s) << 8) & 0xFFFFC000u) | payload;
}
SEL_DI void stage2(const unsigned (&L1)[16], const unsigned (&L2)[16], unsigned (&R)[16]) {
  float f1[16], f2m[16]; unsigned P1[16], P2[16];
#pragma unroll
  for (int i = 0; i < 16; ++i) { f1[i] = SEL_U2F(L1[i] & ~127u); f2m[i] = SEL_U2F(L2[i] & ~127u) - 64.0f; P1[i] = (L1[i] & 127u) << 7; P2[i] = L2[i] & 127u; }
  unsigned K[64];
  K[0] = cand_key(f1[0], f2m[0], P1[0] | P2[0]);
  K[1] = cand_key(f1[0], f2m[1], P1[0] | P2[1]);
  K[2] = cand_key(f1[0], f2m[2], P1[0] | P2[2]);
  K[3] = cand_key(f1[0], f2m[3], P1[0] | P2[3]);
  K[4] = cand_key(f1[0], f2m[4], P1[0] | P2[4]);
  K[5] = cand_key(f1[0], f2m[5], P1[0] | P2[5]);
  K[6] = cand_key(f1[0], f2m[6], P1[0] | P2[6]);
  K[7] = cand_key(f1[0], f2m[7], P1[0] | P2[7]);
  K[8] = cand_key(f1[0], f2m[8], P1[0] | P2[8]);
  K[9] = cand_key(f1[0], f2m[9], P1[0] | P2[9]);
  K[10] = cand_key(f1[0], f2m[10], P1[0] | P2[10]);
  K[11] = cand_key(f1[0], f2m[11], P1[0] | P2[11]);
  K[12] = cand_key(f1[0], f2m[12], P1[0] | P2[12]);
  K[13] = cand_key(f1[0], f2m[13], P1[0] | P2[13]);
  K[14] = cand_key(f1[0], f2m[14], P1[0] | P2[14]);
  K[15] = cand_key(f1[0], f2m[15], P1[0] | P2[15]);
  K[16] = cand_key(f1[1], f2m[0], P1[1] | P2[0]);
  K[17] = cand_key(f1[1], f2m[1], P1[1] | P2[1]);
  K[18] = cand_key(f1[1], f2m[2], P1[1] | P2[2]);
  K[19] = cand_key(f1[1], f2m[3], P1[1] | P2[3]);
  K[20] = cand_key(f1[1], f2m[4], P1[1] | P2[4]);
  K[21] = cand_key(f1[1], f2m[5], P1[1] | P2[5]);
  K[22] = cand_key(f1[1], f2m[6], P1[1] | P2[6]);
  K[23] = cand_key(f1[1], f2m[7], P1[1] | P2[7]);
  K[24] = cand_key(f1[2], f2m[0], P1[2] | P2[0]);
  K[25] = cand_key(f1[2], f2m[1], P1[2] | P2[1]);
  K[26] = cand_key(f1[2], f2m[2], P1[2] | P2[2]);
  K[27] = cand_key(f1[2], f2m[3], P1[2] | P2[3]);
  K[28] = cand_key(f1[2], f2m[4], P1[2] | P2[4]);
  K[29] = cand_key(f1[3], f2m[0], P1[3] | P2[0]);
  K[30] = cand_key(f1[3], f2m[1], P1[3] | P2[1]);
  K[31] = cand_key(f1[3], f2m[2], P1[3] | P2[2]);
  K[32] = cand_key(f1[3], f2m[3], P1[3] | P2[3]);
  K[33] = cand_key(f1[4], f2m[0], P1[4] | P2[0]);
  K[34] = cand_key(f1[4], f2m[1], P1[4] | P2[1]);
  K[35] = cand_key(f1[4], f2m[2], P1[4] | P2[2]);
  K[36] = cand_key(f1[5], f2m[0], P1[5] | P2[0]);
  K[37] = cand_key(f1[5], f2m[1], P1[5] | P2[1]);
  K[38] = cand_key(f1[6], f2m[0], P1[6] | P2[0]);
  K[39] = cand_key(f1[6], f2m[1], P1[6] | P2[1]);
  K[40] = cand_key(f1[7], f2m[0], P1[7] | P2[0]);
  K[41] = cand_key(f1[7], f2m[1], P1[7] | P2[1]);
  K[42] = cand_key(f1[8], f2m[0], P1[8] | P2[0]);
  K[43] = cand_key(f1[9], f2m[0], P1[9] | P2[0]);
  K[44] = cand_key(f1[10], f2m[0], P1[10] | P2[0]);
  K[45] = cand_key(f1[11], f2m[0], P1[11] | P2[0]);
  K[46] = cand_key(f1[12], f2m[0], P1[12] | P2[0]);
  K[47] = cand_key(f1[13], f2m[0], P1[13] | P2[0]);
  K[48] = cand_key(f1[14], f2m[0], P1[14] | P2[0]);
  K[49] = cand_key(f1[15], f2m[0], P1[15] | P2[0]);
#pragma unroll
  for (int c = 50; c < 64; ++c) K[c] = 0u;
  unsigned g1[16], g2[16], g3[16];
#pragma unroll
  for (int i = 0; i < 16; ++i) { R[i] = K[i]; g1[i] = K[16 + i]; g2[i] = K[32 + i]; g3[i] = K[48 + i]; }
  sort16(R); sort16(g1); sort16(g2); CE(g3[0], g3[1]);
  merge_top16(R, g1);
  g2[15] = g2[15] > g3[0] ? g2[15] : g3[0]; g2[14] = g2[14] > g3[1] ? g2[14] : g3[1];
  bitonic_merge16(g2);
  merge_top16(R, g2);
}

constexpr int SKP = 272;
struct QFrag { bf16x8_t f[8]; };
DI QFrag stage1_load(const u16* __restrict__ qrow, int hh) { QFrag q;
#pragma unroll
  for (int ks = 0; ks < 8; ++ks) q.f[ks] = *(const bf16x8_t*)(qrow + 16 * ks + 8 * hh);
  return q; }
DI void stage1(const QFrag& qfr, const LAS unsigned char* sk, int tok, int hh, unsigned (&out)[16]) {
  f32x16_t acc[4];
#pragma unroll
  for (int kt = 0; kt < 4; ++kt)
#pragma unroll
    for (int r = 0; r < 16; ++r) acc[kt][r] = 64.0f;
#pragma unroll
  for (int ks = 0; ks < 8; ++ks) {
#pragma unroll
    for (int kt = 0; kt < 4; ++kt) {
      const bf16x8_t ak = *(const LAS bf16x8_t*)(sk + (32 * kt + tok) * SKP + (16 * ks + 8 * hh) * 2);
      acc[kt] = __builtin_amdgcn_mfma_f32_32x32x16_bf16(ak, qfr.f[ks], acc[kt], 0, 0, 0);
    }
    __builtin_amdgcn_sched_barrier(0);
  }
  unsigned g1[16], g2[16], g3[16];
#pragma unroll
  for (int r = 0; r < 16; ++r) {
    const unsigned ix = (unsigned)((r & 3) + 8 * (r >> 2));
    out[r] = (__float_as_uint(acc[0][r]) & ~127u) | ix; g1[r] = (__float_as_uint(acc[1][r]) & ~127u) | (32u + ix);
    g2[r] = (__float_as_uint(acc[2][r]) & ~127u) | (64u + ix); g3[r] = (__float_as_uint(acc[3][r]) & ~127u) | (96u + ix);
  }
  top16_of_64(out, g1, g2, g3);
  unsigned oth[16];
#pragma unroll
  for (int i = 0; i < 16; ++i) { out[i] |= (unsigned)(hh << 2); }
#pragma unroll
  for (int i = 0; i < 16; ++i) oth[i] = (unsigned)__shfl_xor((int)out[i], 32);
  merge_top16(out, oth);
}
DI void topk_phase(const Params& p, const u16* __restrict__ qp, const float* __restrict__ uinv, int* __restrict__ idx_out, float2* __restrict__ gu_out, unsigned char* smem) {
  const int tid = threadIdx.x;
  LAS unsigned char* sk = (LAS unsigned char*)smem;
  __syncthreads();
#pragma unroll
  for (int i = tid; i < 2 * 128 * 16; i += NTHREADS) {
    const int c = i & 15, row = i >> 4;
    const float4* s = (const float4*)(p.sub_keys + (size_t)row * 128 + c * 8);
    const float4 a = s[0], b = s[1];
    pg8::u32x4 o; o.x = pack2(a.x, a.y); o.y = pack2(a.z, a.w); o.z = pack2(b.x, b.y); o.w = pack2(b.z, b.w);
    *(LAS pg8::u32x4*)(sk + row * SKP + c * 16) = o;
  }
  __syncthreads();
  const int lane = tid & 63, tok = lane & 31, hh = lane >> 5, gw = blockIdx.x * NWAVES + (tid >> 6), nw = gridDim.x * NWAVES;
  for (int item = gw; item < (T / 32) * 4; item += nw) {
    const int t = (item >> 2) * 32 + tok, hp = item & 3;
    const u16* qt = qp + (size_t)t * 2048 + hp * 512;
    unsigned LA1[16], LA2[16], LB1[16], LB2[16];
    { QFrag fa = stage1_load(qt, hh), fb = stage1_load(qt + 128, hh);
      stage1(fa, sk, tok, hh, LA1); fa = stage1_load(qt + 256, hh);
      stage1(fb, sk + 128 * SKP, tok, hh, LA2); fb = stage1_load(qt + 384, hh);
      stage1(fa, sk, tok, hh, LB1);
      stage1(fb, sk + 128 * SKP, tok, hh, LB2); }
    unsigned L1[16], L2[16], R[16];
#pragma unroll
    for (int i = 0; i < 16; ++i) { L1[i] = hh ? LB1[i] : LA1[i]; L2[i] = hh ? LB2[i] : LA2[i]; }
    stage2(L1, L2, R);
    const int head = hp * 2 + hh;
    float ev[16], sum = 0.f;
    const float mx = __uint_as_float(0x42000000u | ((R[0] >> 14) << 6));
#pragma unroll
    for (int k = 0; k < 16; ++k) { ev[k] = __expf(__uint_as_float(0x42000000u | ((R[k] >> 14) << 6)) - mx); sum += ev[k]; }
    const float rs = 1.f / sum;
    int* io = idx_out + (size_t)t * 128 + head * 16; float2* go = gu_out + (size_t)t * 128 + head * 16;
#pragma unroll
    for (int k4 = 0; k4 < 4; ++k4) {
      int4 ex; ex.x = (int)(R[4 * k4] & 0x3FFFu); ex.y = (int)(R[4 * k4 + 1] & 0x3FFFu); ex.z = (int)(R[4 * k4 + 2] & 0x3FFFu); ex.w = (int)(R[4 * k4 + 3] & 0x3FFFu);
      ((int4*)io)[k4] = ex;
      float4 ga, gb; ga.x = ev[4 * k4] * rs; ga.y = uinv[ex.x]; ga.z = ev[4 * k4 + 1] * rs; ga.w = uinv[ex.y];
      gb.x = ev[4 * k4 + 2] * rs; gb.y = uinv[ex.z]; gb.z = ev[4 * k4 + 3] * rs; gb.w = uinv[ex.w];
      ((float4*)go)[2 * k4] = ga; ((float4*)go)[2 * k4 + 1] = gb;
    }
  }
}

typedef float f32x4_t __attribute__((ext_vector_type(4)));
typedef float f32x2_t __attribute__((ext_vector_type(2)));
typedef int i32x8_t __attribute__((ext_vector_type(8)));
constexpr int UIP = 132;
constexpr int UGP = 1032;
struct UBuf { uint4 r0, r1, r2, r3; unsigned e; float vi; };
#define U_LOAD(buf, g) do { const unsigned _e = myi[(g)]; const LAS unsigned* _il = idl + (lane >> 5) * UIP + (g); const unsigned _lo = 16u * (lane & 31); \
    buf.r0 = *(const uint4*)(U4 + (size_t)_il[0] * 512 + _lo); buf.r1 = *(const uint4*)(U4 + (size_t)_il[2 * UIP] * 512 + _lo); \
    buf.r2 = *(const uint4*)(U4 + (size_t)_il[4 * UIP] * 512 + _lo); buf.r3 = *(const uint4*)(U4 + (size_t)_il[6 * UIP] * 512 + _lo); \
    buf.e = _e; buf.vi = vinv[_e]; } while (0)
#define U_ST(i, r) do { pg8::u32x4 _o; _o.x = (r).x; _o.y = (r).y; _o.z = (r).z; _o.w = (r).w; *(LAS pg8::u32x4*)(gst + (2 * (i) + (lane >> 5)) * 528 + 16 * (lane & 31)) = _o; } while (0)
#define U_LD(j) (*(const LAS pg8::u32x4*)(gld + 128 * (j)))
#define U_MMA(c, r, b) c = __builtin_amdgcn_mfma_scale_f32_16x16x128_f8f6f4((i32x8_t){(int)(r).x, (int)(r).y, (int)(r).z, (int)(r).w, 0, 0, 0, 0}, b, c, 4, 0, 0, 0x7F7F7F7F, 0, 0x7F7F7F7F)
#define U_COMP(buf, g) do { f32x4_t c = {0.f, 0.f, 0.f, 0.f}; \
    U_ST(0, buf.r0); U_ST(1, buf.r1); U_ST(2, buf.r2); U_ST(3, buf.r3); asm volatile("" ::: "memory"); \
    { const pg8::u32x4 a0 = U_LD(0), a1 = U_LD(1), a2 = U_LD(2), a3 = U_LD(3); asm volatile("" ::: "memory"); \
      U_MMA(c, a0, B0); U_MMA(c, a1, B1); U_MMA(c, a2, B2); U_MMA(c, a3, B3); } \
    const int rsel = pp & 3; const float v = rsel == 0 ? c[0] : rsel == 1 ? c[1] : rsel == 2 ? c[2] : c[3]; \
    const float vo = __shfl(v, (lane + 40) & 63); \
    if (pp < 8 && q == (pp >> 2)) { const f32x2_t gu2 = *(const LAS f32x2_t*)(myg + (g) * 8); \
      const float d = (v + vo) * gu2[1]; const float act = 0.5f * d * (1.f + erff(d * 0.70710678118654752f)); \
      uint2 o; o.x = buf.e; o.y = __float_as_uint(gu2[0] * act * buf.vi); pw[(size_t)tok * 128 + (g)] = o; } } while (0)
DI void peer_u_phase(const u16* __restrict__ xb, const float* __restrict__ rowss, const int* __restrict__ idx, const float2* __restrict__ gu,
                     const unsigned char* __restrict__ U4, const float* __restrict__ vinv, uint2* __restrict__ pw, unsigned char* smem) {
  const int lane = threadIdx.x & 63, wave = threadIdx.x >> 6, pp = lane & 15, q = lane >> 4, gw = blockIdx.x * NWAVES + wave, nw = gridDim.x * NWAVES;
  const int pi = pp & 7, x = q + 4 * (pp >> 3);
  const unsigned xoff = 16u * x;
  LAS unsigned* idl = (LAS unsigned*)(smem + wave * (8 * UIP * 4 + 8 * UGP + 8 * 528));
  LAS unsigned char* gul = (LAS unsigned char*)(idl + 8 * UIP);
  LAS unsigned char* gst = gul + 8 * UGP;
  const LAS unsigned char* gld = gst + pi * 528 + 16 * x;
  const LAS unsigned* myi = idl + pi * UIP;
  const LAS unsigned char* myg = gul + pi * UGP;
  for (int unit = gw; unit < T / 8; unit += nw) {
    const int tok = unit * 8 + pi;
    __builtin_amdgcn_wave_barrier();
#pragma unroll
    for (int r8 = 0; r8 < 8; ++r8) {
      const int* ir = idx + (size_t)(unit * 8 + r8) * 128;
      idl[r8 * UIP + lane] = (unsigned)ir[lane]; idl[r8 * UIP + 64 + lane] = (unsigned)ir[64 + lane];
      const uint4 gv = ((const uint4*)(gu + (size_t)(unit * 8 + r8) * 128))[lane];
      pg8::u32x4 o; o.x = gv.x; o.y = gv.y; o.z = gv.z; o.w = gv.w; *(LAS pg8::u32x4*)(gul + r8 * UGP + lane * 16) = o;
    }
    __builtin_amdgcn_fence(__ATOMIC_RELEASE, "wavefront");
    __builtin_amdgcn_wave_barrier();
    const float inv = rsqrtf(rowss[tok] * (1.f / D) + EPS);
    i32x8_t B0, B1, B2, B3;
#define U_BUILD(Bv, i) do { const u16* sb = xb + (size_t)tok * D + 256 * (i) + 128 * (pp >> 3) + 16 * q; \
      _Pragma("unroll") for (int h = 0; h < 4; ++h) { float f[8]; unpack8(*(const uint4*)(sb + 64 * (h >> 1) + 8 * (h & 1)), f); int w; \
        w = __builtin_amdgcn_cvt_pk_fp8_f32(f[0] * inv, f[1] * inv, 0, false); w = __builtin_amdgcn_cvt_pk_fp8_f32(f[2] * inv, f[3] * inv, w, true); Bv[2 * h] = w; \
        w = __builtin_amdgcn_cvt_pk_fp8_f32(f[4] * inv, f[5] * inv, 0, false); w = __builtin_amdgcn_cvt_pk_fp8_f32(f[6] * inv, f[7] * inv, w, true); Bv[2 * h + 1] = w; } } while (0)
    U_BUILD(B0, 0); U_BUILD(B1, 1); U_BUILD(B2, 2); U_BUILD(B3, 3);
    UBuf b0, b1, b2, b3;
#define SB() __builtin_amdgcn_sched_barrier(0)
    U_LOAD(b0, 0); U_LOAD(b1, 1); U_LOAD(b2, 2); SB();
#pragma unroll 1
    for (int g = 0; g < 128; g += 4) {
      U_LOAD(b3, g + 3); SB(); U_COMP(b0, g); SB();
      U_LOAD(b0, (g + 4) & 127); SB(); U_COMP(b1, g + 1); SB();
      U_LOAD(b1, (g + 5) & 127); SB(); U_COMP(b2, g + 2); SB();
      U_LOAD(b2, (g + 6) & 127); SB(); U_COMP(b3, g + 3); SB();
    }
  }
}

typedef int i32x2_t __attribute__((ext_vector_type(2)));
template <bool LOCAL>
DI void peer_v_phase(const uint2* __restrict__ pw, const unsigned char* __restrict__ V4, const u16* __restrict__ xb, float* __restrict__ out, unsigned char* smem) {
  const int lane = threadIdx.x & 63, wave = threadIdx.x >> 6, r = lane >> 3, c = lane & 7, n16 = lane & 15, kg = lane >> 4;
  LAS unsigned char* img = (LAS unsigned char*)smem + wave * VWAVE;
  LAS unsigned char* pbuf = img + 128 * VIMP;
  const int nunit = 4 * (T / 64);
  const int cnt = LOCAL ? 4 : (((int)blockIdx.x < nunit) ? (nunit - 1 - (int)blockIdx.x) / (int)gridDim.x + 1 : 0), N = cnt * 8;
  if (N == 0) return;
#define V_TOK(n, jj, tt) do { if (LOCAL) { jj = (n) >> 3; tt = (int)blockIdx.x * 64 + wave * 8 + ((n) & 7); } else { const int _u = (int)blockIdx.x + ((n) >> 3) * (int)gridDim.x; jj = _u & 3; tt = (_u >> 2) * 64 + wave * 8 + ((n) & 7); } } while (0)
#define V_LDPW(n) ({ int _j, _t; V_TOK(n, _j, _t); ((const uint4*)(pw + (size_t)_t * 128))[lane]; })
#define V_STAGE(n, pq, scv) do { LAS unsigned char* _b = pbuf + ((n) & 1) * 1024; \
    *(LAS i32x2_t*)(_b + 8 * lane) = (i32x2_t){(int)(pq).x, (int)(pq).z}; *(LAS i32x2_t*)(_b + 512 + 8 * lane) = (i32x2_t){(int)(pq).y, (int)(pq).w}; \
    const float _m = wave_max(fmaxf(fabsf(__uint_as_float((pq).y)), fabsf(__uint_as_float((pq).w)))); scv = _m > 0.f ? 224.f / _m : 1.f; } while (0)
#define V_GATHER(n) do { int _j, _t; V_TOK(n, _j, _t); const unsigned char* _vb = V4 + (size_t)_j * ((size_t)NEXP * 128) + 16 * c; const LAS unsigned* _e = (const LAS unsigned*)(pbuf + ((n) & 1) * 1024); \
    _Pragma("unroll") for (int i = 0; i < 16; ++i) G[i] = *(const uint4*)(_vb + (_e[8 * i + r] * 128u)); } while (0)
#define V_WRITEIMG() do { _Pragma("unroll") for (int i = 0; i < 16; ++i) { LAS unsigned char* _d = img + (8 * i + r) * VIMP + 16 * c; \
      *(LAS i32x2_t*)(_d) = (i32x2_t){(int)G[i].x, (int)G[i].y}; *(LAS i32x2_t*)(_d + 8) = (i32x2_t){(int)G[i].z, (int)G[i].w}; } } while (0)
  uint4 G[16];
  uint4 pq = V_LDPW(0);
  float sc_cur, sc_nxt;
  V_STAGE(0, pq, sc_cur); asm volatile("" ::: "memory");
  if (N > 1) pq = V_LDPW(1);
  V_GATHER(0);
  V_WRITEIMG(); asm volatile("" ::: "memory");
  for (int n = 0; n < N; ++n) {
    int j, t; V_TOK(n, j, t);
    const uint2 xr = *(const uint2*)(xb + (size_t)t * D + 256 * j + 4 * lane);
    if (n + 1 < N) { V_STAGE(n + 1, pq, sc_nxt); asm volatile("" ::: "memory"); if (n + 2 < N) pq = V_LDPW(n + 2); V_GATHER(n + 1); }
    __builtin_amdgcn_sched_barrier(0);
    i32x8_t A;
    { const LAS float* wl = (const LAS float*)(pbuf + (n & 1) * 1024 + 512);
#pragma unroll
      for (int h = 0; h < 2; ++h)
#pragma unroll
        for (int d = 0; d < 4; ++d) { const f32x4_t w4 = *(const LAS f32x4_t*)(wl + 64 * h + 16 * kg + 4 * d);
          int w = __builtin_amdgcn_cvt_pk_fp8_f32(w4[0] * sc_cur, w4[1] * sc_cur, 0, false); w = __builtin_amdgcn_cvt_pk_fp8_f32(w4[2] * sc_cur, w4[3] * sc_cur, w, true);
          A[4 * h + d] = n16 == 0 ? w : 0; } }
    float val[16];
    const LAS unsigned char* ib = img + (32 * kg + n16) * VIMP;
    i32x2_t tb0[16], tb1[16];
#pragma unroll
    for (int ct = 0; ct < 16; ++ct) { tb0[ct] = __builtin_amdgcn_ds_read_tr4_b64_v2i32((LAS i32x2_t*)(ib + 8 * ct)); tb1[ct] = __builtin_amdgcn_ds_read_tr4_b64_v2i32((LAS i32x2_t*)(ib + 16 * VIMP + 8 * ct)); }
#pragma unroll
    for (int ct = 0; ct < 16; ++ct) {
      const f32x4_t z = {0.f, 0.f, 0.f, 0.f};
      const f32x4_t cc = __builtin_amdgcn_mfma_scale_f32_16x16x128_f8f6f4(A, (i32x8_t){tb0[ct][0], tb0[ct][1], tb1[ct][0], tb1[ct][1], 0, 0, 0, 0}, z, 0, 4, 0, 0x7F7F7F7F, 0, 0x7F7F7F7F);
      val[ct] = cc[0];
    }
    asm volatile("" : "+v"(val[0]), "+v"(val[1]), "+v"(val[2]), "+v"(val[3]), "+v"(val[4]), "+v"(val[5]), "+v"(val[6]), "+v"(val[7]),
                      "+v"(val[8]), "+v"(val[9]), "+v"(val[10]), "+v"(val[11]), "+v"(val[12]), "+v"(val[13]), "+v"(val[14]), "+v"(val[15]));
    LAS float* stg = (LAS float*)(pbuf + (n & 1) * 1024);
    if (lane < 16) {
#pragma unroll
      for (int ct = 0; ct < 16; ++ct) stg[16 * ct + lane] = val[ct];
    }
    asm volatile("" ::: "memory");
    const f32x4_t s4 = *(const LAS f32x4_t*)(stg + 4 * lane);
    const float rs = 1.f / sc_cur;
    float4 o;
    o.x = bflo(xr.x) + s4[0] * rs; o.y = bfhi(xr.x) + s4[1] * rs; o.z = bflo(xr.y) + s4[2] * rs; o.w = bfhi(xr.y) + s4[3] * rs;
    { typedef float f4v __attribute__((ext_vector_type(4))); const f4v ov = {o.x, o.y, o.z, o.w}; __builtin_nontemporal_store(ov, (f4v*)(out + (size_t)t * D + 256 * j + 4 * lane)); }
    __builtin_amdgcn_sched_barrier(0);
    asm volatile("" ::: "memory");
    if (n + 1 < N) { V_WRITEIMG(); sc_cur = sc_nxt; }
    asm volatile("" ::: "memory");
  }
}

constexpr int NPHASE = 8;
__global__ void __launch_bounds__(NTHREADS, 2) fwd_kernel(Params p) {
  extern __shared__ __attribute__((aligned(16))) unsigned char smem[];
  cg::grid_group grid = cg::this_grid();
  unsigned char* ws = p.ws;
  u16* wt_in = (u16*)(ws + WS_WTIN); u16* wt_out = (u16*)(ws + WS_WTOUT); u16* wt_q = (u16*)(ws + WS_WTQ);
  u16* act = (u16*)(ws + WS_ACT); u16* proj = (u16*)(ws + WS_PROJ);
  int* idx = (int*)(ws + WS_IDX); float2* gu = (float2*)(ws + WS_SB); unsigned char* U8 = ws + WS_U8; unsigned char* V8 = ws + WS_V8;
  uint2* pw = (uint2*)(ws + WS_PW); float* uinv = (float*)(ws + WS_UINV); float* vinv = (float*)(ws + WS_VINV);
  float* rowss = (float*)(ws + WS_ROWSS);
  volatile LAS unsigned* misc = (volatile LAS unsigned*)(LAS unsigned char*)(smem + LDS_MISC);
  if (threadIdx.x < 8) misc[threadIdx.x] = 0u;
  __syncthreads();
  XcdBarrier bar = xcd_barrier_post((unsigned*)(ws + WS_CTL), misc);
  PG8_LAS unsigned char* lds = (PG8_LAS unsigned char*)smem;
  const int lo = p.ph_lo, hi = p.ph_hi;
#define IN(k) (lo <= (k) && (k) < hi)
#define SEAM(k) do { if (IN(k) && IN((k) + 1)) xcd_barrier(bar); } while (0)
  if (IN(0)) {
    transpose_convert(p.w_in, wt_in, D, DIN, nullptr, (float*)smem);
    transpose_convert(p.w_out, wt_out, D, D, nullptr, (float*)smem);
    transpose_convert(p.w_q, wt_q, D, 2048, p.norm2_g, (float*)smem);
    convert_fp4_rows<false>(p.peer_u, p.norm2_g, U8, uinv);
    convert_fp4_rows<true>(p.peer_v, nullptr, V8, vinv);
    rmsnorm1024(p.x, p.norm1_g, act);
    for (int i = blockIdx.x * NTHREADS + threadIdx.x; i < T; i += gridDim.x * NTHREADS) rowss[i] = 0.f;
    for (int i = blockIdx.x * NTHREADS + threadIdx.x; i < 2 * 32 * SEQ; i += gridDim.x * NTHREADS) ((float*)(ws + WS_SB + 16 * MBy))[i] = 0.f;
  }
  if (lo < 0) grid.sync();
  SEAM(0);
  u16* vt = (u16*)(ws + WS_SB);
  float* ssq = (float*)(ws + WS_SB + 16 * MBy);
  if (IN(1)) { pg8::Gemm g{act, wt_in, T, DIN, D}; pg8::StaticOrder S; S.init(T, DIN, gridDim.x, blockIdx.x);
    pg8::EpiInProj E{proj, vt, ssq, lds + pg8::STAGE_BYTES + (threadIdx.x >> 6) * 2560}; pg8::gemm_phase<pg8::EpiInProj, pg8::StaticOrder>(lds, g, S, E, nullptr); }
  SEAM(1);
  if (IN(2)) { attn_phase(p, proj, vt, ssq, act, smem); conv_tokens(p, proj, act); }
  SEAM(2);
  if (IN(3)) { pg8::Gemm g{act, wt_out, T, D, D}; pg8::StaticOrder S; S.init(T, D, gridDim.x, blockIdx.x);
    pg8::EpiResid E{p.x, p.out, proj, rowss, D}; pg8::gemm_phase<pg8::EpiResid, pg8::StaticOrder>(lds, g, S, E, nullptr); }
  SEAM(3);
  u16* xb = proj;
  u16* qp = proj + (size_t)T * D;
  if (IN(4)) { pg8::Gemm g{xb, wt_q, T, 2048, D}; pg8::StaticOrder S; S.init(T, 2048, gridDim.x, blockIdx.x);
    pg8::EpiBf16S E{qp, 2048, rowss}; pg8::gemm_phase<pg8::EpiBf16S, pg8::StaticOrder>(lds, g, S, E, nullptr); }
  SEAM(4);
  const bool local = (gridDim.x == T / 64) && IN(5) && IN(6) && IN(7);
#define LSEAM() do { asm volatile("s_waitcnt vmcnt(0)" ::: "memory"); __builtin_amdgcn_fence(__ATOMIC_RELEASE, "workgroup"); __syncthreads(); __builtin_amdgcn_fence(__ATOMIC_ACQUIRE, "workgroup"); } while (0)
  if (IN(5)) topk_phase(p, qp, uinv, idx, gu, smem);
  if (local) LSEAM(); else SEAM(5);
  if (IN(6)) peer_u_phase(xb, rowss, idx, gu, U8, vinv, pw, smem);
  if (local) LSEAM(); else SEAM(6);
  if (IN(7)) { if (local) peer_v_phase<true>(pw, V8, xb, p.out, smem); else peer_v_phase<false>(pw, V8, xb, p.out, smem); }
}

extern "C" void kernel_launch(void* const* d_in, const int* in_sizes, int n_in, void* d_out, int out_size, void* d_ws, size_t ws_size,
                              hipStream_t stream) {
  static int grid_blocks = 0;
  if (!grid_blocks) {
    int dev = 0, cus = 0, per_cu = 0;
    (void)hipGetDevice(&dev);
    (void)hipDeviceGetAttribute(&cus, hipDeviceAttributeMultiprocessorCount, dev);
    (void)hipFuncSetAttribute((const void*)fwd_kernel, hipFuncAttributeMaxDynamicSharedMemorySize, LDS_BYTES);
    (void)hipOccupancyMaxActiveBlocksPerMultiprocessor(&per_cu, fwd_kernel, NTHREADS, LDS_BYTES);
    if (per_cu < 1) per_cu = 1;
    if (per_cu > 1) per_cu = 1;
    grid_blocks = cus * per_cu;
  }
  Params p{};
  p.x = (const float*)d_in[0]; p.norm1_g = (const float*)d_in[1]; p.w_in = (const float*)d_in[2]; p.q_norm_g = (const float*)d_in[3];
  p.k_norm_g = (const float*)d_in[4]; p.conv_w = (const float*)d_in[5]; p.sb_out_g = (const float*)d_in[6]; p.conv_out_g = (const float*)d_in[7];
  p.w_out = (const float*)d_in[8]; p.norm2_g = (const float*)d_in[9]; p.w_q = (const float*)d_in[10]; p.sub_keys = (const float*)d_in[11];
  p.peer_u = (const float*)d_in[12]; p.peer_v = (const float*)d_in[13];
  p.out = (float*)d_out; p.ws = (unsigned char*)d_ws;
  p.ph_lo = 0; p.ph_hi = NPHASE;
  (void)hipMemsetAsync((unsigned char*)d_ws + WS_CTL, 0, 4096 * 4 + 8 * 64 * 4, stream);
  void* args[] = {&p};
  hipError_t e = hipLaunchCooperativeKernel((void*)fwd_kernel, dim3(grid_blocks), dim3(NTHREADS), args, LDS_BYTES, stream);
  if (e != hipSuccess) fprintf(stderr, "cooperative launch failed: %s (grid %d)\n", hipGetErrorString(e), grid_blocks);
}
```

```cpp
#include <hip/hip_runtime.h>
#include <hip/hip_cooperative_groups.h>
#include <cstdio>
#include <cstdint>
namespace cg = cooperative_groups;

typedef unsigned short u16;
#define DI __device__ __forceinline__
#define LAS __attribute__((address_space(3)))

constexpr int T = 16384, D = 1024, SEQ = 4096;
constexpr int DIN = 3072, DSB = 512;
constexpr int NEXP = 16384;
constexpr float EPS = 1e-6f;
constexpr int NWAVES = 8, NTHREADS = NWAVES * 64;

namespace pg8 {
#define PG8_LAS __attribute__((address_space(3)))
typedef unsigned short bf16_t;
typedef short bf16x8 __attribute__((ext_vector_type(8)));
typedef float f32x4 __attribute__((ext_vector_type(4)));
typedef unsigned u32x4 __attribute__((ext_vector_type(4)));
constexpr int BM = 256, BK = 64, HALF = 128, HTB = HALF * BK * 2  , STAGE_BYTES = 8 * HTB, NXCD = 8, WGM = 8;

__host__ __device__ __forceinline__ int lds_byte(int r, int c) { const int st = (r >> 4) * 2 + (c >> 5), rr = r & 15, cc = c & 31, ob = rr * 64 + cc * 2; return st * 1024 + (ob ^ (((ob >> 9) & 1) << 5)); }
__host__ __device__ __forceinline__ void stage_rc(int b, int& R, int& C) { const int st = b / 1024, sb = b % 1024, swz = sb ^ (((sb >> 9) & 1) << 5); R = (st >> 1) * 16 + swz / 64; C = (st & 1) * 32 + (swz % 64) / 2; }
__host__ __device__ __forceinline__ int perm32(int rho) { const int n = rho >> 4, i = rho & 15; return 8 * (i >> 2) + 4 * n + (i & 3); }

struct Unit { int pm, pn; };
struct Gemm { const bf16_t* A; const bf16_t* Bt; int M, N, K; };
struct StaticOrder {
    int nM, nN, nwg, G, c;
    __host__ __device__ void init(int M, int N, int G_, int c_) { nM = M / BM; nN = N / BM; nwg = nM * nN; G = G_; c = c_; }
    __host__ __device__ bool next(int i, Unit& u) const {
        const long L = (long)i * G + c; if (L >= nwg) return false;
        int wgid = (int)L; { const int q = nwg / NXCD, r = nwg % NXCD, xcd = wgid % NXCD, off = wgid / NXCD; wgid = (xcd < r ? xcd * (q + 1) : r * (q + 1) + (xcd - r) * q) + off; }
        const int nig = WGM * nN, gid = wgid / nig, fm = gid * WGM, gsz = (nM - fm) < WGM ? (nM - fm) : WGM;
        u.pm = fm + ((wgid % nig) % gsz); u.pn = (wgid % nig) / gsz; return true;
    }
    __device__ __forceinline__ void a_ready(const Unit&) const {}
    __device__ __forceinline__ void done(const Unit&) const {}
};
__device__ __forceinline__ unsigned cvt_pk_bf16(float lo, float hi) { unsigned r; asm volatile("v_cvt_pk_bf16_f32 %0, %1, %2" : "=v"(r) : "v"(lo), "v"(hi)); return r; }

struct EpiBf16S {
    static constexpr bool PERM = true, AFTER_DRAIN = false;
    bf16_t* O; int ldc; const float* rowss;
    __device__ __forceinline__ void operator()(const f32x4 (&acc)[2][2][4][2], const Unit& u, int wr, int wc, int fr, int fq) const {
        const int row0 = u.pm * BM + wr * 64 + fr, col0 = u.pn * BM + wc * 32 + 8 * fq;
#pragma unroll
        for (int ai = 0; ai < 2; ++ai)
#pragma unroll
            for (int m = 0; m < 4; ++m) { const int row = row0 + ai * HALF + m * 16; bf16_t* rowp = O + (size_t)row * ldc + col0;
                const float sc = rowss ? rsqrtf(rowss[row] * (1.f / 1024.f) + 1e-6f) : 1.f;
#pragma unroll
                for (int bj = 0; bj < 2; ++bj) { const f32x4 v0 = acc[ai][bj][m][0] * sc, v1 = acc[ai][bj][m][1] * sc;
                    u32x4 w; w.x = cvt_pk_bf16(v0[0], v0[1]); w.y = cvt_pk_bf16(v0[2], v0[3]); w.z = cvt_pk_bf16(v1[0], v1[1]); w.w = cvt_pk_bf16(v1[2], v1[3]);
                    *(u32x4*)(rowp + bj * HALF) = w; } }
    }
};
struct EpiInProj {
    static constexpr bool PERM = true, AFTER_DRAIN = false;
    bf16_t* O; bf16_t* vt; bf16_t* kf; float* ssq; PG8_LAS unsigned char* xl;
    __device__ __forceinline__ void operator()(const f32x4 (&acc)[2][2][4][2], const Unit& u, int wr, int wc, int fr, int fq) const {
        const int row0 = u.pm * BM + wr * 64 + fr, col0 = u.pn * BM + wc * 32 + 8 * fq, kind = u.pn >> 1;
        if (kind != 2) {
#pragma unroll
            for (int ai = 0; ai < 2; ++ai)
#pragma unroll
                for (int m = 0; m < 4; ++m) { const int row = row0 + ai * HALF + m * 16; const int bb = row >> 12, ss = row & 4095;
#pragma unroll
                    for (int bj = 0; bj < 2; ++bj) { const f32x4 v0 = acc[ai][bj][m][0], v1 = acc[ai][bj][m][1];
                        u32x4 w; w.x = cvt_pk_bf16(v0[0], v0[1]); w.y = cvt_pk_bf16(v0[2], v0[3]); w.z = cvt_pk_bf16(v1[0], v1[1]); w.w = cvt_pk_bf16(v1[2], v1[3]);
                        if (kind == 1) {
                            const int kp = ss & 31, rho = (kp & 3) + 4 * (kp >> 4) + 8 * ((kp >> 2) & 3);
                            *(u32x4*)(kf + (((((size_t)(bb * 8 + (u.pn & 1) * 4 + bj * 2 + (wc >> 1))) * 128 + (ss >> 5)) * 4 + (wc & 1) * 2 + (fq >> 1)) * 64 + rho + 32 * (fq & 1)) * 8) = w;
                        } else *(u32x4*)(O + (size_t)row * 3072 + col0 + bj * HALF) = w;
                        if (kind < 2) {
                            float sq = v0[0] * v0[0] + v0[1] * v0[1] + v0[2] * v0[2] + v0[3] * v0[3] + v1[0] * v1[0] + v1[1] * v1[1] + v1[2] * v1[2] + v1[3] * v1[3];
                            sq += __shfl_xor(sq, 16); sq += __shfl_xor(sq, 32);
                            const int head = (u.pn & 1) * 4 + bj * 2 + (wc >> 1);
                            if (fq == 0) unsafeAtomicAdd(ssq + ((size_t)(kind * 32 + bb * 8 + head)) * 4096 + ss, sq);
                        } } }
        } else {
            const int lane = fr + 16 * fq;
#pragma unroll
            for (int ai = 0; ai < 2; ++ai)
#pragma unroll
                for (int bj = 0; bj < 2; ++bj) {
                    const int d0w = (u.pn & 1) * 256 + bj * HALF + wc * 32;
#pragma unroll
                    for (int mh = 0; mh < 2; ++mh) {
#pragma unroll
                        for (int mm = 0; mm < 2; ++mm) { const f32x4 v0 = acc[ai][bj][2 * mh + mm][0], v1 = acc[ai][bj][2 * mh + mm][1];
                            const unsigned w0 = cvt_pk_bf16(v0[0], v0[1]), w1 = cvt_pk_bf16(v0[2], v0[3]), w2 = cvt_pk_bf16(v1[0], v1[1]), w3 = cvt_pk_bf16(v1[2], v1[3]);
                            PG8_LAS unsigned char* wp = xl + (8 * fq) * 80 + 2 * (16 * mm + fr);
                            *(PG8_LAS bf16_t*)(wp) = (bf16_t)w0; *(PG8_LAS bf16_t*)(wp + 80) = (bf16_t)(w0 >> 16); *(PG8_LAS bf16_t*)(wp + 160) = (bf16_t)w1; *(PG8_LAS bf16_t*)(wp + 240) = (bf16_t)(w1 >> 16);
                            *(PG8_LAS bf16_t*)(wp + 320) = (bf16_t)w2; *(PG8_LAS bf16_t*)(wp + 400) = (bf16_t)(w2 >> 16); *(PG8_LAS bf16_t*)(wp + 480) = (bf16_t)w3; *(PG8_LAS bf16_t*)(wp + 560) = (bf16_t)(w3 >> 16); }
                        asm volatile("" ::: "memory");
                        const int rowb = u.pm * BM + wr * 64 + ai * HALF + 32 * mh, bb = rowb >> 12, ssb = rowb & 4095;
#pragma unroll
                        for (int k = 0; k < 2; ++k) { const int id = lane + 64 * k, dd = id >> 2, tc = id & 3;
                            const u32x4 w = *(const PG8_LAS u32x4*)(xl + dd * 80 + 16 * tc);
                            const int dg = d0w + dd;
                            *(u32x4*)(vt + (((((size_t)(bb * 8 + (dg >> 6))) * 128 + (ssb >> 5)) * 4 + 2 * ((dg >> 5) & 1) + (tc & 1)) * 64 + (dg & 31) + 32 * (tc >> 1)) * 8) = w; }
                        asm volatile("" ::: "memory");
                    } }
        }
    }
};
struct EpiResid {
    static constexpr bool PERM = true, AFTER_DRAIN = false;
    const float* resid; float* out32; bf16_t* xb; float* rowss; int ldc;
    __device__ __forceinline__ void operator()(const f32x4 (&acc)[2][2][4][2], const Unit& u, int wr, int wc, int fr, int fq) const {
        const int row0 = u.pm * BM + wr * 64 + fr, col0 = u.pn * BM + wc * 32 + 8 * fq;
#pragma unroll
        for (int ai = 0; ai < 2; ++ai)
#pragma unroll
            for (int m = 0; m < 4; ++m) { const int row = row0 + ai * HALF + m * 16; const size_t off = (size_t)row * ldc + col0; float ss = 0.f;
#pragma unroll
                for (int bj = 0; bj < 2; ++bj) {
                    const f32x4 r0 = __builtin_nontemporal_load((const f32x4*)(resid + off + bj * HALF)), r1 = __builtin_nontemporal_load((const f32x4*)(resid + off + bj * HALF + 4));
                    const f32x4 o0 = r0 + acc[ai][bj][m][0], o1 = r1 + acc[ai][bj][m][1];
                    ss += o0[0] * o0[0] + o0[1] * o0[1] + o0[2] * o0[2] + o0[3] * o0[3] + o1[0] * o1[0] + o1[1] * o1[1] + o1[2] * o1[2] + o1[3] * o1[3];
                    u32x4 w; w.x = cvt_pk_bf16(o0[0], o0[1]); w.y = cvt_pk_bf16(o0[2], o0[3]); w.z = cvt_pk_bf16(o1[0], o1[1]); w.w = cvt_pk_bf16(o1[2], o1[3]);
                    *(u32x4*)(xb + off + bj * HALF) = w; }
                ss += __shfl_xor(ss, 16); ss += __shfl_xor(ss, 32);
                if (fq == 0) unsafeAtomicAdd(rowss + row, ss); }
    }
};
template <class Epi, class Sched, bool STAMP = false>
__device__ __forceinline__ void gemm_phase(PG8_LAS unsigned char* lds, const Gemm g, const Sched& S, const Epi& E, unsigned long long* stamps) {
    const int tid = threadIdx.x, wid = __builtin_amdgcn_readfirstlane(tid >> 6), lane = tid & 63, wr = wid >> 2, wc = wid & 3, fr = lane & 15, fq = lane >> 4;
    const int K = g.K, nt = K / BK;
    int ts_lo = 0, ts_hi = 0, nts = 0; const unsigned long long rt_entry = STAMP ? (unsigned long long)wall_clock64() : 0ull;
#define PG8_STAMP() do { if (STAMP && wid == 0 && nts < 64) { const unsigned long long _c = (unsigned long long)clock64(); \
        ts_lo = (lane == nts) ? (int)(unsigned)_c : ts_lo; ts_hi = (lane == nts) ? (int)(unsigned)(_c >> 32) : ts_hi; ++nts; } } while (0)
    PG8_STAMP();
    unsigned voffA[2], voffB[2];
#pragma unroll
    for (int i = 0; i < 2; ++i) { int R, C; stage_rc(tid * 16 + i * 8192, R, C); const int Rb = Epi::PERM ? ((R & ~31) + perm32(R & 31)) : R;
        voffA[i] = (unsigned)(R * K + C) * 2u; voffB[i] = (unsigned)(Rb * K + C) * 2u; }
    const size_t kstep = (size_t)(BK * 2);
    const size_t hstep = (size_t)HALF * K * 2;
    const size_t tstep = 2 * hstep;
    const unsigned ldsw = (unsigned)wid * 1024u;
    const int aoff = lds_byte(wr * 64 + fr, fq * 8), boff = lds_byte(wc * 32 + fr, fq * 8);
#define PG8_SA(b, h) (((b) * 2 + (h)) * HTB)
#define PG8_SB(b, h) ((4 + (b) * 2 + (h)) * HTB)
#define PG8_STAGE(bufoff, gbase, voff) do { _Pragma("unroll") for (int _i = 0; _i < 2; ++_i) \
        __builtin_amdgcn_global_load_lds((const unsigned*)((const char*)(gbase) + (voff)[_i]), (PG8_LAS unsigned*)(lds + (bufoff) + ldsw + _i * 8192), 16, 0, 0); } while (0)
#define PG8_LDA(dst, b, h) do { _Pragma("unroll") for (int m = 0; m < 4; ++m) _Pragma("unroll") for (int k = 0; k < 2; ++k) dst[m][k] = *(const PG8_LAS bf16x8*)(lds + PG8_SA(b, h) + aoff + m * 2048 + k * 1024); } while (0)
#define PG8_LDB(dst, b, h) do { _Pragma("unroll") for (int n = 0; n < 2; ++n) _Pragma("unroll") for (int k = 0; k < 2; ++k) dst[n][k] = *(const PG8_LAS bf16x8*)(lds + PG8_SB(b, h) + boff + n * 2048 + k * 1024); } while (0)
#define PG8_MMA(ai, bj, At, Bt) do { __builtin_amdgcn_s_setprio(1); _Pragma("unroll") for (int m = 0; m < 4; ++m) _Pragma("unroll") for (int n = 0; n < 2; ++n) _Pragma("unroll") for (int k = 0; k < 2; ++k) \
        acc[ai][bj][m][n] = __builtin_amdgcn_mfma_f32_16x16x32_bf16(Bt[n][k], At[m][k], acc[ai][bj][m][n], 0, 0, 0); __builtin_amdgcn_s_setprio(0); } while (0)
#define PG8_WAIT_V(n) asm volatile("s_waitcnt vmcnt(" #n ")" ::: "memory")
#define PG8_WAIT_L(n) asm volatile("s_waitcnt lgkmcnt(" #n ")" ::: "memory")
#define PG8_BAR __builtin_amdgcn_s_barrier()
#define PG8_SCHED __builtin_amdgcn_sched_barrier(0)
    Unit cur, nxt; int ui = 0;
    if (!S.next(0, cur)) return;
    f32x4 acc[2][2][4][2];
#pragma unroll
    for (int a = 0; a < 2; ++a)
#pragma unroll
        for (int b = 0; b < 2; ++b)
#pragma unroll
            for (int m = 0; m < 4; ++m)
#pragma unroll
                for (int n = 0; n < 2; ++n) acc[a][b][m][n] = (f32x4){0.f, 0.f, 0.f, 0.f};
    bf16x8 At[4][2], B0[2][2], B1[2][2];
    const char* cA = (const char*)g.A + (size_t)cur.pm * tstep; const char* cB = (const char*)g.Bt + (size_t)cur.pn * tstep;
    S.a_ready(cur);
    PG8_STAGE(PG8_SB(0, 0), cB, voffB); PG8_STAGE(PG8_SA(0, 0), cA, voffA); PG8_STAGE(PG8_SB(0, 1), cB + hstep, voffB); PG8_STAGE(PG8_SA(0, 1), cA + hstep, voffA);
    if (wr == 1) PG8_BAR;
    PG8_WAIT_V(4); PG8_BAR;
    PG8_STAGE(PG8_SB(1, 0), cB + kstep, voffB); PG8_STAGE(PG8_SA(1, 0), cA + kstep, voffA); PG8_STAGE(PG8_SB(1, 1), cB + hstep + kstep, voffB);
    PG8_WAIT_V(6); PG8_BAR;
    PG8_STAMP();
    for (;;) {
        const bool has_next = S.next(ui + 1, nxt);
        const char* nA = has_next ? (const char*)g.A + (size_t)nxt.pm * tstep : cA; const char* nB = has_next ? (const char*)g.Bt + (size_t)nxt.pn * tstep : cB;
        for (int t = 0; t < nt; t += 2) {
            const bool last = (t == nt - 2);
            const char* a1 = cA + (size_t)(t + 1) * kstep;
            const char* a2 = last ? nA : cA + (size_t)(t + 2) * kstep; const char* b2 = last ? nB : cB + (size_t)(t + 2) * kstep;
            const char* a3 = a2 + kstep; const char* b3 = b2 + kstep;
            if (last && has_next) S.a_ready(nxt);
            PG8_LDB(B0, 0, 0); PG8_SCHED; PG8_LDA(At, 0, 0); PG8_STAGE(PG8_SA(1, 1), a1 + hstep, voffA);
            PG8_WAIT_L(8); PG8_BAR; PG8_WAIT_L(0); PG8_MMA(0, 0, At, B0); PG8_BAR; PG8_SCHED;
            PG8_LDB(B1, 0, 1); PG8_STAGE(PG8_SB(0, 0), b2, voffB);
            PG8_BAR; PG8_WAIT_L(0); PG8_MMA(0, 1, At, B1); PG8_BAR;
            PG8_LDA(At, 0, 1); PG8_STAGE(PG8_SA(0, 0), a2, voffA);
            PG8_BAR; PG8_WAIT_L(0); PG8_MMA(1, 0, At, B0); PG8_BAR; PG8_SCHED;
            PG8_STAGE(PG8_SB(0, 1), b2 + hstep, voffB);
            PG8_WAIT_V(6); PG8_BAR; PG8_MMA(1, 1, At, B1); PG8_BAR;
            PG8_LDB(B0, 1, 0); PG8_SCHED; PG8_LDA(At, 1, 0); PG8_STAGE(PG8_SA(0, 1), a2 + hstep, voffA);
            PG8_WAIT_L(8); PG8_BAR; PG8_WAIT_L(0); PG8_MMA(0, 0, At, B0); PG8_BAR; PG8_SCHED;
            PG8_LDB(B1, 1, 1); PG8_STAGE(PG8_SB(1, 0), b3, voffB);
            PG8_BAR; PG8_WAIT_L(0); PG8_MMA(0, 1, At, B1); PG8_BAR;
            PG8_LDA(At, 1, 1); PG8_STAGE(PG8_SA(1, 0), a3, voffA);
            PG8_BAR; PG8_WAIT_L(0); PG8_MMA(1, 0, At, B0); PG8_BAR; PG8_SCHED;
            PG8_STAGE(PG8_SB(1, 1), b3 + hstep, voffB);
            PG8_WAIT_V(6); PG8_BAR; PG8_MMA(1, 1, At, B1); PG8_BAR;
        }
        PG8_STAMP();
        if constexpr (!Epi::AFTER_DRAIN) { E(acc, cur, wr, wc, fr, fq); S.done(cur); }
        PG8_STAMP();
        if (!has_next) break;
#pragma unroll
        for (int a = 0; a < 2; ++a)
#pragma unroll
            for (int b = 0; b < 2; ++b)
#pragma unroll
                for (int m = 0; m < 4; ++m)
#pragma unroll
                    for (int n = 0; n < 2; ++n) acc[a][b][m][n] = (f32x4){0.f, 0.f, 0.f, 0.f};
        cur = nxt; cA = nA; cB = nB; ++ui;
    }
    PG8_WAIT_V(0);
    if (wr == 0) PG8_BAR;
    PG8_BAR;
    if constexpr (Epi::AFTER_DRAIN) { E.fused(acc, cur, wr, wc, fr, fq, lds, wid, lane); S.done(cur); }
    PG8_STAMP();
    if (STAMP && wid == 0) { stamps[lane] = lane < nts ? (((unsigned long long)(unsigned)ts_hi << 32) | (unsigned)ts_lo) : 0ull;
        if (lane == 62) stamps[62] = rt_entry; if (lane == 63) stamps[63] = (unsigned long long)wall_clock64(); }
#undef PG8_STAMP
#undef PG8_SA
#undef PG8_SB
#undef PG8_STAGE
#undef PG8_LDA
#undef PG8_LDB
#undef PG8_MMA
#undef PG8_WAIT_V
#undef PG8_WAIT_L
#undef PG8_BAR
#undef PG8_SCHED
}
}


constexpr size_t MBy = 1u << 20;
constexpr size_t WS_WTIN = 0, WS_WTOUT = 6 * MBy, WS_WTQ = 8 * MBy, WS_CTL = 12 * MBy, WS_ROWSS = 12 * MBy + 65536, WS_ACT = 13 * MBy, WS_PROJ = 45 * MBy,
                 WS_SB = 141 * MBy, WS_IDX = 173 * MBy, WS_GATE = 181 * MBy, WS_U8 = 189 * MBy, WS_V8 = 205 * MBy, WS_PW = 221 * MBy,
                 WS_UINV = 12 * MBy + 262144, WS_VINV = 12 * MBy + 393216;
constexpr int VIMP = 136, VWAVE = 128 * VIMP + 2048;
constexpr int LDS_MISC = 8 * VWAVE, LDS_BYTES = 8 * VWAVE + 256;
static_assert(LDS_MISC >= pg8::STAGE_BYTES && LDS_BYTES <= 163840, "LDS budget");

struct Params {
  const float *x, *norm1_g, *w_in, *q_norm_g, *k_norm_g, *conv_w, *sb_out_g, *conv_out_g, *w_out, *norm2_g, *w_q, *sub_keys, *peer_u, *peer_v;
  float* out; unsigned char* ws; int ph_lo, ph_hi;
};

#define XB_TMO      128
#define XB_XCNT(j)  (256  + 64 * (j))
#define XB_XSUB(j)  (1280 + 64 * (j))
#define XB_XGEN(j)  (2304 + 64 * (j))
#define XB_TOP      3328
#define XB_TOPGEN   3392
#define XCD_BAR_WORDS 3456
#define XB_SPIN_CAP (1u << 18)
DI unsigned xb_ld(unsigned* p) { return __hip_atomic_load(p, __ATOMIC_RELAXED, __HIP_MEMORY_SCOPE_AGENT); }
DI unsigned xb_add(unsigned* p, unsigned v) { return __hip_atomic_fetch_add(p, v, __ATOMIC_RELAXED, __HIP_MEMORY_SCOPE_AGENT); }
DI unsigned xb_xcc_id() { return (unsigned)__builtin_amdgcn_s_getreg((3 << 11) | 20) & 0xFu; }
#define XB_SPIN(cond, bar) do { unsigned _sp = 0; while (cond) { __builtin_amdgcn_s_sleep(1); \
    if ((++_sp & 255u) == 0u) { if (xb_ld(&(bar)[XB_TMO])) break; if (_sp > XB_SPIN_CAP) { atomicAdd(&(bar)[XB_TMO], 1u); break; } } } } while (0)
struct XcdBarrier { unsigned* bar; unsigned x; volatile LAS unsigned* st; };
DI XcdBarrier xcd_barrier_post(unsigned* bar, volatile LAS unsigned* st) {
  XcdBarrier b; b.bar = bar; b.x = xb_xcc_id(); b.st = st;
  if (threadIdx.x == 0) (void)xb_add(&bar[XB_XCNT(b.x)], 1u);
  return b;
}
DI void xcd_barrier_complete(unsigned* bar, unsigned x, unsigned& nloc, unsigned& nx) {
  const unsigned G = gridDim.x * gridDim.y * gridDim.z;
  unsigned sum, cnt, mine, sp = 0u;
  for (;;) {
    sum = 0u; cnt = 0u; mine = 0u;
#pragma unroll
    for (unsigned j = 0; j < 16; ++j) { const unsigned c = xb_ld(&bar[XB_XCNT(j)]); sum += c; cnt += (c > 0u) ? 1u : 0u; mine = (j == x) ? c : mine; }
    if (sum == G) break;
    __builtin_amdgcn_s_sleep(1);
    if ((++sp & 255u) == 0u) { if (xb_ld(&bar[XB_TMO])) break; if (sp > XB_SPIN_CAP) { atomicAdd(&bar[XB_TMO], 1u); break; } }
  }
  nloc = mine > 0u ? mine : 1u; nx = cnt > 0u ? cnt : 1u;
}
DI void xcd_barrier(const XcdBarrier& b) {
  asm volatile("s_waitcnt vmcnt(0)" ::: "memory");
  __syncthreads();
  if (threadIdx.x == 0) {
    unsigned* bar = b.bar;
    __builtin_amdgcn_s_waitcnt(0);
    unsigned nloc = b.st[0], nx = b.st[1];
    if (nloc == 0u) { xcd_barrier_complete(bar, b.x, nloc, nx); b.st[0] = nloc; b.st[1] = nx; }
    const unsigned old = xb_add(&bar[XB_XSUB(b.x)], 1u);
    const unsigned gen = old / nloc;
    if (old + 1u == (gen + 1u) * nloc) {
      __builtin_amdgcn_fence(__ATOMIC_RELEASE, "agent");
      asm volatile("s_waitcnt vmcnt(0)" ::: "memory");
      const unsigned og = xb_add(&bar[XB_TOP], 1u);
      const unsigned tg = og / nx;
      if (og + 1u == (tg + 1u) * nx) xb_add(&bar[XB_TOPGEN], 1u);
      else XB_SPIN(xb_ld(&bar[XB_TOPGEN]) == tg, bar);
      __builtin_amdgcn_fence(__ATOMIC_ACQUIRE, "agent");
      xb_add(&bar[XB_XGEN(b.x)], 1u);
      asm volatile("s_waitcnt vmcnt(0)" ::: "memory");
    } else {
      XB_SPIN(xb_ld(&bar[XB_XGEN(b.x)]) == gen, bar);
      __builtin_amdgcn_fence(__ATOMIC_ACQUIRE, "agent");
      asm volatile("s_waitcnt vmcnt(0)" ::: "memory");
    }
  }
  __syncthreads();
}

DI u16 f2bf(float x) { unsigned u = __float_as_uint(x); u += 0x7fffu + ((u >> 16) & 1u); return (u16)(u >> 16); }
DI float bflo(unsigned w) { return __uint_as_float(w << 16); }
DI float bfhi(unsigned w) { return __uint_as_float(w & 0xffff0000u); }
DI unsigned pack2(float a, float b) { return (unsigned)f2bf(a) | ((unsigned)f2bf(b) << 16); }
DI float wave_sum(float v) {
#pragma unroll
  for (int o = 32; o >= 1; o >>= 1) v += __shfl_xor(v, o);
  return v;
}
DI float wave_max(float v) {
#pragma unroll
  for (int o = 32; o >= 1; o >>= 1) v = fmaxf(v, __shfl_xor(v, o));
  return v;
}
DI void unpack8(const uint4 w, float* f) {
  f[0] = bflo(w.x); f[1] = bfhi(w.x); f[2] = bflo(w.y); f[3] = bfhi(w.y); f[4] = bflo(w.z); f[5] = bfhi(w.z); f[6] = bflo(w.w); f[7] = bfhi(w.w);
}
DI uint4 pack8(const float* f) { uint4 o; o.x = pack2(f[0], f[1]); o.y = pack2(f[2], f[3]); o.z = pack2(f[4], f[5]); o.w = pack2(f[6], f[7]); return o; }


DI float4 ld_nt_f4(const float4* p) { typedef float f4v __attribute__((ext_vector_type(4))); const f4v v = __builtin_nontemporal_load((const f4v*)p); return make_float4(v.x, v.y, v.z, v.w); }

DI void transpose_convert(const float* __restrict__ W, u16* __restrict__ Wt, int K, int N, const float* __restrict__ rg, float* sm) {
  const int tid = threadIdx.x, tn_cnt = N / 64, ntile = (K / 64) * tn_cnt;
  for (int tile = blockIdx.x; tile < ntile; tile += gridDim.x) {
    const int tk = tile / tn_cnt, tn = tile % tn_cnt;
    __syncthreads();
#pragma unroll
    for (int r = 0; r < 2; ++r) { const int row = r * 32 + (tid >> 4), c4 = (tid & 15) * 4;
      const float g = rg ? rg[tk * 64 + row] : 1.f;
      const float4 v = ld_nt_f4((const float4*)(W + (size_t)(tk * 64 + row) * N + tn * 64 + c4));
      sm[row * 65 + c4] = v.x * g; sm[row * 65 + c4 + 1] = v.y * g; sm[row * 65 + c4 + 2] = v.z * g; sm[row * 65 + c4 + 3] = v.w * g; }
    __syncthreads();
    { const int n = tid & 63, k0 = (tid >> 6) * 8;
      float f[8];
#pragma unroll
      for (int j = 0; j < 8; ++j) f[j] = sm[(k0 + j) * 65 + n];
      *(uint4*)(Wt + (size_t)(tn * 64 + n) * K + tk * 64 + k0) = pack8(f); }
  }
}
template <bool SLICED>
DI void convert_fp4_rows(const float* __restrict__ src, const float* __restrict__ cg, unsigned char* __restrict__ dst, float* __restrict__ inv_out) {
  const int lane = threadIdx.x & 63, gw = blockIdx.x * NWAVES + (threadIdx.x >> 6), nw = gridDim.x * NWAVES;
  float4 g[4];
#pragma unroll
  for (int k = 0; k < 4; ++k) g[k] = cg ? ((const float4*)cg)[lane + 64 * k] : make_float4(1.f, 1.f, 1.f, 1.f);
  for (int row0 = gw * 4; row0 < NEXP; row0 += nw * 4) {
    float4 a[4][4];
#pragma unroll
    for (int rr = 0; rr < 4; ++rr)
#pragma unroll
      for (int k = 0; k < 4; ++k) a[rr][k] = ld_nt_f4((const float4*)(src + (size_t)(row0 + rr) * D) + lane + 64 * k);
#pragma unroll
    for (int rr = 0; rr < 4; ++rr) {
      float am = 0.f;
#pragma unroll
      for (int k = 0; k < 4; ++k) { a[rr][k].x *= g[k].x; a[rr][k].y *= g[k].y; a[rr][k].z *= g[k].z; a[rr][k].w *= g[k].w;
        am = fmaxf(fmaxf(am, fmaxf(fabsf(a[rr][k].x), fabsf(a[rr][k].y))), fmaxf(fabsf(a[rr][k].z), fabsf(a[rr][k].w))); }
      am = wave_max(am);
      const float sc = am > 0.f ? 6.f / am : 1.f;
      const int row = row0 + rr;
#pragma unroll
      for (int k = 0; k < 4; ++k) {
        unsigned w = 0u;
        w = __builtin_amdgcn_cvt_scalef32_pk_fp4_f32(w, a[rr][k].x * sc, a[rr][k].y * sc, 1.0f, 0); w = __builtin_amdgcn_cvt_scalef32_pk_fp4_f32(w, a[rr][k].z * sc, a[rr][k].w * sc, 1.0f, 1);
        if (SLICED) *(u16*)(dst + (size_t)k * ((size_t)NEXP * 128) + (size_t)row * 128 + 2 * lane) = (u16)w;
        else *(u16*)(dst + (size_t)row * 512 + 128 * k + 2 * lane) = (u16)w;
      }
      if (lane == 0) inv_out[row] = am > 0.f ? am * (1.f / 6.f) : 1.f;
    }
  }
}
DI void rmsnorm1024(const float* __restrict__ src, const float* __restrict__ g, u16* __restrict__ dst) {
  const int lane = threadIdx.x & 63, gw = blockIdx.x * NWAVES + (threadIdx.x >> 6), nw = gridDim.x * NWAVES;
  float4 gg[4];
#pragma unroll
  for (int j = 0; j < 4; ++j) gg[j] = ((const float4*)g)[lane + 64 * j];
  for (int row0 = gw * 4; row0 < T; row0 += nw * 4) {
    float4 v[4][4];
#pragma unroll
    for (int rr = 0; rr < 4; ++rr)
#pragma unroll
      for (int j = 0; j < 4; ++j) v[rr][j] = ld_nt_f4((const float4*)(src + (size_t)(row0 + rr) * D) + lane + 64 * j);
#pragma unroll
    for (int rr = 0; rr < 4; ++rr) {
      float ss = 0.f;
#pragma unroll
      for (int j = 0; j < 4; ++j) ss += v[rr][j].x * v[rr][j].x + v[rr][j].y * v[rr][j].y + v[rr][j].z * v[rr][j].z + v[rr][j].w * v[rr][j].w;
      ss = wave_sum(ss);
      const float inv = rsqrtf(ss * (1.f / D) + EPS);
#pragma unroll
      for (int j = 0; j < 4; ++j) {
        uint2 o; o.x = pack2(v[rr][j].x * inv * gg[j].x, v[rr][j].y * inv * gg[j].y); o.y = pack2(v[rr][j].z * inv * gg[j].z, v[rr][j].w * inv * gg[j].w);
        *(uint2*)(dst + (size_t)(row0 + rr) * D + 4 * (lane + 64 * j)) = o;
      }
    }
  }
}

DI void conv_tokens(const Params& p, const u16* __restrict__ proj, u16* __restrict__ mixed) {
  const int lane = threadIdx.x & 63, gw = blockIdx.x * NWAVES + (threadIdx.x >> 6), nw = gridDim.x * NWAVES;
  const int c0 = 8 * lane;
  float w0[8], w1[8], w2[8], go[8];
#pragma unroll
  for (int j = 0; j < 8; ++j) { w0[j] = p.conv_w[c0 + j]; w1[j] = p.conv_w[DSB + c0 + j]; w2[j] = p.conv_w[2 * DSB + c0 + j]; go[j] = p.conv_out_g[c0 + j]; }
#pragma unroll 2
  for (int t = gw; t < T; t += nw) {
    const u16* row = proj + (size_t)t * DIN;
    const int tpos = t & (SEQ - 1);
    float xc[8], bg[8], cg[8], y[8];
    unpack8(*(const uint4*)(row + 1536 + c0), xc); unpack8(*(const uint4*)(row + 2048 + c0), bg); unpack8(*(const uint4*)(row + 2560 + c0), cg);
#pragma unroll
    for (int j = 0; j < 8; ++j) y[j] = w2[j] * (cg[j] * xc[j]);
    if (tpos >= 1) {
      float x1[8], c1[8]; unpack8(*(const uint4*)(row - DIN + 1536 + c0), x1); unpack8(*(const uint4*)(row - DIN + 2560 + c0), c1);
#pragma unroll
      for (int j = 0; j < 8; ++j) y[j] += w1[j] * (c1[j] * x1[j]);
    }
    if (tpos >= 2) {
      float x2[8], c2[8]; unpack8(*(const uint4*)(row - 2 * DIN + 1536 + c0), x2); unpack8(*(const uint4*)(row - 2 * DIN + 2560 + c0), c2);
#pragma unroll
      for (int j = 0; j < 8; ++j) y[j] += w0[j] * (c2[j] * x2[j]);
    }
    float ss = 0.f;
#pragma unroll
    for (int j = 0; j < 8; ++j) { y[j] *= bg[j]; ss += y[j] * y[j]; }
    ss = wave_sum(ss);
    const float inv = rsqrtf(ss * (1.f / DSB) + EPS);
#pragma unroll
    for (int j = 0; j < 8; ++j) y[j] = y[j] * inv * go[j];
    *(uint4*)(mixed + (size_t)t * D + DSB + c0) = pack8(y);
  }
}

typedef float f32x16_t __attribute__((ext_vector_type(16)));
typedef short bf16x8_t __attribute__((ext_vector_type(8)));
DI bf16x8_t pack_bf16x8(float a0, float a1, float a2, float a3, float a4, float a5, float a6, float a7) {
  pg8::u32x4 r;
  asm volatile("v_cvt_pk_bf16_f32 %0, %4, %5\n\tv_cvt_pk_bf16_f32 %1, %6, %7\n\tv_cvt_pk_bf16_f32 %2, %8, %9\n\tv_cvt_pk_bf16_f32 %3, %10, %11\n\ts_nop 1"
               : "=&v"(r[0]), "=&v"(r[1]), "=&v"(r[2]), "=&v"(r[3]) : "v"(a0), "v"(a1), "v"(a2), "v"(a3), "v"(a4), "v"(a5), "v"(a6), "v"(a7));
  return __builtin_bit_cast(bf16x8_t, r);
}
struct AttnKV { bf16x8_t k0, k1, k2, k3, v00, v01, v10, v11; float ik[16]; };
DI void attn_load(AttnKV& f, const bf16x8_t* __restrict__ kr, const bf16x8_t* __restrict__ vr, const float* __restrict__ ksq) {
  f.k0 = kr[0]; f.k1 = kr[64]; f.k2 = kr[128]; f.k3 = kr[192];
  f.v00 = vr[0]; f.v01 = vr[64]; f.v10 = vr[128]; f.v11 = vr[192];
#pragma unroll
  for (int r4 = 0; r4 < 4; ++r4) { const float4 q4 = ((const float4*)ksq)[r4];
    f.ik[4 * r4] = rsqrtf(q4.x * (1.f / 64.f) + EPS); f.ik[4 * r4 + 1] = rsqrtf(q4.y * (1.f / 64.f) + EPS); f.ik[4 * r4 + 2] = rsqrtf(q4.z * (1.f / 64.f) + EPS); f.ik[4 * r4 + 3] = rsqrtf(q4.w * (1.f / 64.f) + EPS); }
}
template <bool DIAG>
DI void attn_half(const AttnKV& f, const bf16x8_t (&qf)[4], int c, int hh, float& carry, f32x16_t& o0, f32x16_t& o1) {
  f32x16_t s;
#pragma unroll
  for (int r = 0; r < 16; ++r) s[r] = 0.f;
  s = __builtin_amdgcn_mfma_f32_32x32x16_bf16(f.k0, qf[0], s, 0, 0, 0); s = __builtin_amdgcn_mfma_f32_32x32x16_bf16(f.k1, qf[1], s, 0, 0, 0);
  s = __builtin_amdgcn_mfma_f32_32x32x16_bf16(f.k2, qf[2], s, 0, 0, 0); s = __builtin_amdgcn_mfma_f32_32x32x16_bf16(f.k3, qf[3], s, 0, 0, 0);
  float rr[16], be[16];
#pragma unroll
  for (int r = 0; r < 16; ++r) {
    const float e = __builtin_amdgcn_exp2f(fminf(s[r] * f.ik[r] * 0.18033688011112042f, 100.f));
    float x = __builtin_amdgcn_rcpf(1.f + e), b = e * x;
    if (DIAG) { const bool on = (16 * hh + r) < c; x = on ? x : 1.f; b = on ? b : 0.f; }
    rr[r] = x; be[r] = b;
  }
  float tot = ((rr[0] * rr[1]) * (rr[2] * rr[3])) * ((rr[4] * rr[5]) * (rr[6] * rr[7]));
  tot *= ((rr[8] * rr[9]) * (rr[10] * rr[11])) * ((rr[12] * rr[13]) * (rr[14] * rr[15]));
  const float oth = __shfl_xor(tot, 32);
  float P = hh ? carry : carry * oth;
  float a[16];
#pragma unroll
  for (int r = 15; r >= 0; --r) { a[r] = be[r] * P; P *= rr[r]; }
  carry = carry * tot * oth;
  const bf16x8_t af0 = pack_bf16x8(a[0], a[1], a[2], a[3], a[4], a[5], a[6], a[7]), af1 = pack_bf16x8(a[8], a[9], a[10], a[11], a[12], a[13], a[14], a[15]);
  o0 = __builtin_amdgcn_mfma_f32_32x32x16_bf16(f.v00, af0, o0, 0, 0, 0); o0 = __builtin_amdgcn_mfma_f32_32x32x16_bf16(f.v01, af1, o0, 0, 0, 0);
  o1 = __builtin_amdgcn_mfma_f32_32x32x16_bf16(f.v10, af0, o1, 0, 0, 0); o1 = __builtin_amdgcn_mfma_f32_32x32x16_bf16(f.v11, af1, o1, 0, 0, 0);
}
DI void attn_phase(const Params& p, const u16* __restrict__ proj, const u16* __restrict__ kf, const u16* __restrict__ vt, const float* __restrict__ ssq, u16* __restrict__ mixed, unsigned char* smem) {
  const int lane = threadIdx.x & 63, head = threadIdx.x >> 6, c = lane & 31, hh = lane >> 5;
  LAS float* red = (LAS float*)smem;
  for (int item = blockIdx.x; item < 4 * 64; item += gridDim.x) {
    const int b = item & 3, q0 = (63 - (item >> 2)) * 64;
    const size_t tq = (size_t)b * SEQ + q0 + c;
    const float* qsq = ssq + ((size_t)(b * 8 + head)) * SEQ;
    const float* ksqb = ssq + ((size_t)(32 + b * 8 + head)) * SEQ + 16 * hh;
    bf16x8_t qL[4], qU[4];
#pragma unroll
    for (int up = 0; up < 2; ++up) {
      const float iq = rsqrtf(qsq[q0 + 32 * up + c] * (1.f / 64.f) + EPS);
#pragma unroll
      for (int ks = 0; ks < 4; ++ks) { float f[8]; unpack8(*(const uint4*)(proj + (tq + 32 * up) * DIN + head * 64 + 16 * ks + 8 * hh), f);
        float gq[8];
        { const float4 qa = *(const float4*)(p.q_norm_g + 16 * ks + 8 * hh), qb = *(const float4*)(p.q_norm_g + 16 * ks + 8 * hh + 4), ka = *(const float4*)(p.k_norm_g + 16 * ks + 8 * hh), kb = *(const float4*)(p.k_norm_g + 16 * ks + 8 * hh + 4);
          gq[0] = qa.x * ka.x * iq; gq[1] = qa.y * ka.y * iq; gq[2] = qa.z * ka.z * iq; gq[3] = qa.w * ka.w * iq; gq[4] = qb.x * kb.x * iq; gq[5] = qb.y * kb.y * iq; gq[6] = qb.z * kb.z * iq; gq[7] = qb.w * kb.w * iq; }
        const bf16x8_t v = pack_bf16x8(f[0] * gq[0], f[1] * gq[1], f[2] * gq[2], f[3] * gq[3], f[4] * gq[4], f[5] * gq[5], f[6] * gq[6], f[7] * gq[7]);
        if (up) qU[ks] = v; else qL[ks] = v; }
    }
    f32x16_t oL0, oL1, oU0, oU1;
#pragma unroll
    for (int r = 0; r < 16; ++r) { oL0[r] = 0.f; oL1[r] = 0.f; oU0[r] = 0.f; oU1[r] = 0.f; }
    float cL = 1.f, cU = 1.f;
    const bf16x8_t* kbase = (const bf16x8_t*)kf + ((size_t)(b * 8 + head) * 128) * 256 + lane;
    const bf16x8_t* vbase = (const bf16x8_t*)vt + ((size_t)(b * 8 + head) * 128) * 256 + lane;
    AttnKV kv;
    attn_load(kv, kbase + (q0 + 32) * 8, vbase + (q0 + 32) * 8, ksqb + q0 + 32);
    attn_half<true>(kv, qU, c, hh, cU, oU0, oU1);
    attn_load(kv, kbase + q0 * 8, vbase + q0 * 8, ksqb + q0);
    attn_half<false>(kv, qU, c, hh, cU, oU0, oU1);
    attn_half<true>(kv, qL, c, hh, cL, oL0, oL1);
    for (int tb = q0 - 32; tb >= 0; tb -= 32) {
      attn_load(kv, kbase + tb * 8, vbase + tb * 8, ksqb + tb);
      const bool uz = __all(cU == 0.f);
      if (!uz) attn_half<false>(kv, qU, c, hh, cU, oU0, oU1);
      attn_half<false>(kv, qL, c, hh, cL, oL0, oL1);
      if (uz && __all(cL == 0.f)) break;
    }
    float sL = 0.f, sU = 0.f;
#pragma unroll
    for (int r = 0; r < 16; ++r) { sL += oL0[r] * oL0[r] + oL1[r] * oL1[r]; sU += oU0[r] * oU0[r] + oU1[r] * oU1[r]; }
    sL += __shfl_xor(sL, 32); sU += __shfl_xor(sU, 32);
    __syncthreads();
    if (hh == 0) { red[head * 64 + c] = sL; red[head * 64 + 32 + c] = sU; }
    __syncthreads();
    float tL = 0.f, tU = 0.f;
#pragma unroll
    for (int h8 = 0; h8 < 8; ++h8) { tL += red[h8 * 64 + c]; tU += red[h8 * 64 + 32 + c]; }
    const float* g = p.sb_out_g + head * 64 + 4 * hh;
#pragma unroll
    for (int up = 0; up < 2; ++up) {
      const float inv = rsqrtf((up ? tU : tL) * (1.f / DSB) + EPS);
      u16* orow = mixed + (tq + 32 * up) * D + head * 64 + 4 * hh;
#pragma unroll
      for (int rg = 0; rg < 4; ++rg) {
        const float4 g0 = *(const float4*)(g + 8 * rg), g1 = *(const float4*)(g + 32 + 8 * rg);
        const float a0 = up ? oU0[4 * rg] : oL0[4 * rg], a1 = up ? oU0[4 * rg + 1] : oL0[4 * rg + 1], a2 = up ? oU0[4 * rg + 2] : oL0[4 * rg + 2], a3 = up ? oU0[4 * rg + 3] : oL0[4 * rg + 3];
        const float b0 = up ? oU1[4 * rg] : oL1[4 * rg], b1 = up ? oU1[4 * rg + 1] : oL1[4 * rg + 1], b2 = up ? oU1[4 * rg + 2] : oL1[4 * rg + 2], b3 = up ? oU1[4 * rg + 3] : oL1[4 * rg + 3];
        uint2 w0, w1;
        w0.x = pack2(a0 * inv * g0.x, a1 * inv * g0.y); w0.y = pack2(a2 * inv * g0.z, a3 * inv * g0.w);
        w1.x = pack2(b0 * inv * g1.x, b1 * inv * g1.y); w1.y = pack2(b2 * inv * g1.z, b3 * inv * g1.w);
        *(uint2*)(orow + 8 * rg) = w0; *(uint2*)(orow + 32 + 8 * rg) = w1;
      }
    }
  }
}
#define SEL_DI DI
#define SEL_F2U(x) __float_as_uint(x)
#define SEL_U2F(x) __uint_as_float(x)

#define CE(a, b) do { const unsigned _h = (a) > (b) ? (a) : (b), _l = (a) > (b) ? (b) : (a); (a) = _h; (b) = _l; } while (0)
SEL_DI void sort16(unsigned (&v)[16]) {
  CE(v[0], v[1]); CE(v[2], v[3]); CE(v[0], v[2]); CE(v[1], v[3]); CE(v[1], v[2]); CE(v[4], v[5]); CE(v[6], v[7]); CE(v[4], v[6]);
  CE(v[5], v[7]); CE(v[5], v[6]); CE(v[0], v[4]); CE(v[2], v[6]); CE(v[2], v[4]); CE(v[1], v[5]); CE(v[3], v[7]); CE(v[3], v[5]);
  CE(v[1], v[2]); CE(v[3], v[4]); CE(v[5], v[6]); CE(v[8], v[9]); CE(v[10], v[11]); CE(v[8], v[10]); CE(v[9], v[11]); CE(v[9], v[10]);
  CE(v[12], v[13]); CE(v[14], v[15]); CE(v[12], v[14]); CE(v[13], v[15]); CE(v[13], v[14]); CE(v[8], v[12]); CE(v[10], v[14]); CE(v[10], v[12]);
  CE(v[9], v[13]); CE(v[11], v[15]); CE(v[11], v[13]); CE(v[9], v[10]); CE(v[11], v[12]); CE(v[13], v[14]); CE(v[0], v[8]); CE(v[4], v[12]);
  CE(v[4], v[8]); CE(v[2], v[10]); CE(v[6], v[14]); CE(v[6], v[10]); CE(v[2], v[4]); CE(v[6], v[8]); CE(v[10], v[12]); CE(v[1], v[9]);
  CE(v[5], v[13]); CE(v[5], v[9]); CE(v[3], v[11]); CE(v[7], v[15]); CE(v[7], v[11]); CE(v[3], v[5]); CE(v[7], v[9]); CE(v[11], v[13]);
  CE(v[1], v[2]); CE(v[3], v[4]); CE(v[5], v[6]); CE(v[7], v[8]); CE(v[9], v[10]); CE(v[11], v[12]); CE(v[13], v[14]);
}
SEL_DI void bitonic_merge16(unsigned (&v)[16]) {
#pragma unroll
  for (int d = 8; d >= 1; d >>= 1)
#pragma unroll
    for (int i = 0; i < 16; ++i) if ((i & d) == 0) CE(v[i], v[i + d]);
}
SEL_DI void merge_top16(unsigned (&a)[16], const unsigned (&b)[16]) {
#pragma unroll
  for (int i = 0; i < 16; ++i) a[i] = a[i] > b[15 - i] ? a[i] : b[15 - i];
  bitonic_merge16(a);
}
SEL_DI void top16_of_64(unsigned (&g0)[16], unsigned (&g1)[16], unsigned (&g2)[16], unsigned (&g3)[16]) {
  sort16(g0); sort16(g1); sort16(g2); sort16(g3);
  merge_top16(g0, g1); merge_top16(g2, g3); merge_top16(g0, g2);
}
SEL_DI unsigned cand_key(float a, float b, unsigned payload) {
  float s = a + b; s = s < 32.0f ? 32.0f : (s > 127.99f ? 127.99f : s);
  return ((SEL_F2U(s) << 8) & 0xFFFFC000u) | payload;
}
SEL_DI void stage2(const unsigned (&L1)[16], const unsigned (&L2)[16], unsigned (&R)[16]) {
  float f1[16], f2m[16]; unsigned P1[16], P2[16];
#pragma unroll
  for (int i = 0; i < 16; ++i) { f1[i] = SEL_U2F(L1[i] & ~127u); f2m[i] = SEL_U2F(L2[i] & ~127u) - 64.0f; P1[i] = (L1[i] & 127u) << 7; P2[i] = L2[i] & 127u; }
  unsigned K[64];
  K[0] = cand_key(f1[0], f2m[0], P1[0] | P2[0]);
  K[1] = cand_key(f1[0], f2m[1], P1[0] | P2[1]);
  K[2] = cand_key(f1[0], f2m[2], P1[0] | P2[2]);
  K[3] = cand_key(f1[0], f2m[3], P1[0] | P2[3]);
  K[4] = cand_key(f1[0], f2m[4], P1[0] | P2[4]);
  K[5] = cand_key(f1[0], f2m[5], P1[0] | P2[5]);
  K[6] = cand_key(f1[0], f2m[6], P1[0] | P2[6]);
  K[7] = cand_key(f1[0], f2m[7], P1[0] | P2[7]);
  K[8] = cand_key(f1[0], f2m[8], P1[0] | P2[8]);
  K[9] = cand_key(f1[0], f2m[9], P1[0] | P2[9]);
  K[10] = cand_key(f1[0], f2m[10], P1[0] | P2[10]);
  K[11] = cand_key(f1[0], f2m[11], P1[0] | P2[11]);
  K[12] = cand_key(f1[0], f2m[12], P1[0] | P2[12]);
  K[13] = cand_key(f1[0], f2m[13], P1[0] | P2[13]);
  K[14] = cand_key(f1[0], f2m[14], P1[0] | P2[14]);
  K[15] = cand_key(f1[0], f2m[15], P1[0] | P2[15]);
  K[16] = cand_key(f1[1], f2m[0], P1[1] | P2[0]);
  K[17] = cand_key(f1[1], f2m[1], P1[1] | P2[1]);
  K[18] = cand_key(f1[1], f2m[2], P1[1] | P2[2]);
  K[19] = cand_key(f1[1], f2m[3], P1[1] | P2[3]);
  K[20] = cand_key(f1[1], f2m[4], P1[1] | P2[4]);
  K[21] = cand_key(f1[1], f2m[5], P1[1] | P2[5]);
  K[22] = cand_key(f1[1], f2m[6], P1[1] | P2[6]);
  K[23] = cand_key(f1[1], f2m[7], P1[1] | P2[7]);
  K[24] = cand_key(f1[2], f2m[0], P1[2] | P2[0]);
  K[25] = cand_key(f1[2], f2m[1], P1[2] | P2[1]);
  K[26] = cand_key(f1[2], f2m[2], P1[2] | P2[2]);
  K[27] = cand_key(f1[2], f2m[3], P1[2] | P2[3]);
  K[28] = cand_key(f1[2], f2m[4], P1[2] | P2[4]);
  K[29] = cand_key(f1[3], f2m[0], P1[3] | P2[0]);
  K[30] = cand_key(f1[3], f2m[1], P1[3] | P2[1]);
  K[31] = cand_key(f1[3], f2m[2], P1[3] | P2[2]);
  K[32] = cand_key(f1[3], f2m[3], P1[3] | P2[3]);
  K[33] = cand_key(f1[4], f2m[0], P1[4] | P2[0]);
  K[34] = cand_key(f1[4], f2m[1], P1[4] | P2[1]);
  K[35] = cand_key(f1[4], f2m[2], P1[4] | P2[2]);
  K[36] = cand_key(f1[5], f2m[0], P1[5] | P2[0]);
  K[37] = cand_key(f1[5], f2m[1], P1[5] | P2[1]);
  K[38] = cand_key(f1[6], f2m[0], P1[6] | P2[0]);
  K[39] = cand_key(f1[6], f2m[1], P1[6] | P2[1]);
  K[40] = cand_key(f1[7], f2m[0], P1[7] | P2[0]);
  K[41] = cand_key(f1[7], f2m[1], P1[7] | P2[1]);
  K[42] = cand_key(f1[8], f2m[0], P1[8] | P2[0]);
  K[43] = cand_key(f1[9], f2m[0], P1[9] | P2[0]);
  K[44] = cand_key(f1[10], f2m[0], P1[10] | P2[0]);
  K[45] = cand_key(f1[11], f2m[0], P1[11] | P2[0]);
  K[46] = cand_key(f1[12], f2m[0], P1[12] | P2[0]);
  K[47] = cand_key(f1[13], f2m[0], P1[13] | P2[0]);
  K[48] = cand_key(f1[14], f2m[0], P1[14] | P2[0]);
  K[49] = cand_key(f1[15], f2m[0], P1[15] | P2[0]);
#pragma unroll
  for (int c = 50; c < 64; ++c) K[c] = 0u;
  unsigned g1[16], g2[16], g3[16];
#pragma unroll
  for (int i = 0; i < 16; ++i) { R[i] = K[i]; g1[i] = K[16 + i]; g2[i] = K[32 + i]; g3[i] = K[48 + i]; }
  sort16(R); sort16(g1); sort16(g2); CE(g3[0], g3[1]);
  merge_top16(R, g1);
  g2[15] = g2[15] > g3[0] ? g2[15] : g3[0]; g2[14] = g2[14] > g3[1] ? g2[14] : g3[1];
  bitonic_merge16(g2);
  merge_top16(R, g2);
}

constexpr int SKP = 272;
struct QFrag { bf16x8_t f[8]; };
DI QFrag stage1_load(const u16* __restrict__ qrow, int hh) { QFrag q;
#pragma unroll
  for (int ks = 0; ks < 8; ++ks) q.f[ks] = *(const bf16x8_t*)(qrow + 16 * ks + 8 * hh);
  return q; }
DI void stage1(const QFrag& qfr, const LAS unsigned char* sk, int tok, int hh, unsigned (&out)[16]) {
  f32x16_t acc[4];
#pragma unroll
  for (int kt = 0; kt < 4; ++kt)
#pragma unroll
    for (int r = 0; r < 16; ++r) acc[kt][r] = 64.0f;
#pragma unroll
  for (int ks = 0; ks < 8; ++ks) {
#pragma unroll
    for (int kt = 0; kt < 4; ++kt) {
      const bf16x8_t ak = *(const LAS bf16x8_t*)(sk + (32 * kt + tok) * SKP + (16 * ks + 8 * hh) * 2);
      acc[kt] = __builtin_amdgcn_mfma_f32_32x32x16_bf16(ak, qfr.f[ks], acc[kt], 0, 0, 0);
    }
    __builtin_amdgcn_sched_barrier(0);
  }
  unsigned g1[16], g2[16], g3[16];
#pragma unroll
  for (int r = 0; r < 16; ++r) {
    const unsigned ix = (unsigned)((r & 3) + 8 * (r >> 2));
    out[r] = (__float_as_uint(acc[0][r]) & ~127u) | ix; g1[r] = (__float_as_uint(acc[1][r]) & ~127u) | (32u + ix);
    g2[r] = (__float_as_uint(acc[2][r]) & ~127u) | (64u + ix); g3[r] = (__float_as_uint(acc[3][r]) & ~127u) | (96u + ix);
  }
  top16_of_64(out, g1, g2, g3);
  unsigned oth[16];
#pragma unroll
  for (int i = 0; i < 16; ++i) { out[i] |= (unsigned)(hh << 2); }
#pragma unroll
  for (int i = 0; i < 16; ++i) oth[i] = (unsigned)__shfl_xor((int)out[i], 32);
  merge_top16(out, oth);
}
DI void topk_phase(const Params& p, const u16* __restrict__ qp, const float* __restrict__ uinv, int* __restrict__ idx_out, float2* __restrict__ gu_out, unsigned char* smem) {
  const int tid = threadIdx.x;
  LAS unsigned char* sk = (LAS unsigned char*)smem;
  __syncthreads();
#pragma unroll
  for (int i = tid; i < 2 * 128 * 16; i += NTHREADS) {
    const int c = i & 15, row = i >> 4;
    const float4* s = (const float4*)(p.sub_keys + (size_t)row * 128 + c * 8);
    const float4 a = s[0], b = s[1];
    pg8::u32x4 o; o.x = pack2(a.x, a.y); o.y = pack2(a.z, a.w); o.z = pack2(b.x, b.y); o.w = pack2(b.z, b.w);
    *(LAS pg8::u32x4*)(sk + row * SKP + c * 16) = o;
  }
  __syncthreads();
  const int lane = tid & 63, tok = lane & 31, hh = lane >> 5, gw = blockIdx.x * NWAVES + (tid >> 6), nw = gridDim.x * NWAVES;
  for (int item = gw; item < (T / 32) * 4; item += nw) {
    const int t = (item >> 2) * 32 + tok, hp = item & 3;
    const u16* qt = qp + (size_t)t * 2048 + hp * 512;
    unsigned LA1[16], LA2[16], LB1[16], LB2[16];
    { QFrag fa = stage1_load(qt, hh), fb = stage1_load(qt + 128, hh);
      stage1(fa, sk, tok, hh, LA1); fa = stage1_load(qt + 256, hh);
      stage1(fb, sk + 128 * SKP, tok, hh, LA2); fb = stage1_load(qt + 384, hh);
      stage1(fa, sk, tok, hh, LB1);
      stage1(fb, sk + 128 * SKP, tok, hh, LB2); }
    unsigned L1[16], L2[16], R[16];
#pragma unroll
    for (int i = 0; i < 16; ++i) { L1[i] = hh ? LB1[i] : LA1[i]; L2[i] = hh ? LB2[i] : LA2[i]; }
    stage2(L1, L2, R);
    const int head = hp * 2 + hh;
    float ev[16], sum = 0.f;
    const float mx = __uint_as_float(0x42000000u | ((R[0] >> 14) << 6));
#pragma unroll
    for (int k = 0; k < 16; ++k) { ev[k] = __expf(__uint_as_float(0x42000000u | ((R[k] >> 14) << 6)) - mx); sum += ev[k]; }
    const float rs = 1.f / sum;
    int* io = idx_out + (size_t)t * 128 + head * 16; float2* go = gu_out + (size_t)t * 128 + head * 16;
#pragma unroll
    for (int k4 = 0; k4 < 4; ++k4) {
      int4 ex; ex.x = (int)(R[4 * k4] & 0x3FFFu); ex.y = (int)(R[4 * k4 + 1] & 0x3FFFu); ex.z = (int)(R[4 * k4 + 2] & 0x3FFFu); ex.w = (int)(R[4 * k4 + 3] & 0x3FFFu);
      ((int4*)io)[k4] = ex;
      float4 ga, gb; ga.x = ev[4 * k4] * rs; ga.y = uinv[ex.x]; ga.z = ev[4 * k4 + 1] * rs; ga.w = uinv[ex.y];
      gb.x = ev[4 * k4 + 2] * rs; gb.y = uinv[ex.z]; gb.z = ev[4 * k4 + 3] * rs; gb.w = uinv[ex.w];
      ((float4*)go)[2 * k4] = ga; ((float4*)go)[2 * k4 + 1] = gb;
    }
  }
}

typedef float f32x4_t __attribute__((ext_vector_type(4)));
typedef float f32x2_t __attribute__((ext_vector_type(2)));
typedef int i32x8_t __attribute__((ext_vector_type(8)));
constexpr int UIP = 132;
constexpr int UGP = 1032;
struct UBuf { uint4 r0, r1, r2, r3; unsigned e; float vi; };
#define U_LOAD(buf, g) do { const unsigned _e = myi[(g)]; const LAS unsigned* _il = idl + (lane >> 5) * UIP + (g); const unsigned _lo = 16u * (lane & 31); \
    buf.r0 = *(const uint4*)(U4 + (size_t)_il[0] * 512 + _lo); buf.r1 = *(const uint4*)(U4 + (size_t)_il[2 * UIP] * 512 + _lo); \
    buf.r2 = *(const uint4*)(U4 + (size_t)_il[4 * UIP] * 512 + _lo); buf.r3 = *(const uint4*)(U4 + (size_t)_il[6 * UIP] * 512 + _lo); \
    buf.e = _e; buf.vi = vinv[_e]; } while (0)
#define U_ST(i, r) do { pg8::u32x4 _o; _o.x = (r).x; _o.y = (r).y; _o.z = (r).z; _o.w = (r).w; *(LAS pg8::u32x4*)(gst + (2 * (i) + (lane >> 5)) * 528 + 16 * (lane & 31)) = _o; } while (0)
#define U_LD(j) (*(const LAS pg8::u32x4*)(gld + 128 * (j)))
#define U_MMA(c, r, b) c = __builtin_amdgcn_mfma_scale_f32_16x16x128_f8f6f4((i32x8_t){(int)(r).x, (int)(r).y, (int)(r).z, (int)(r).w, 0, 0, 0, 0}, b, c, 4, 0, 0, 0x7F7F7F7F, 0, 0x7F7F7F7F)
#define U_COMP(buf, g) do { f32x4_t c = {0.f, 0.f, 0.f, 0.f}; \
    U_ST(0, buf.r0); U_ST(1, buf.r1); U_ST(2, buf.r2); U_ST(3, buf.r3); asm volatile("" ::: "memory"); \
    { const pg8::u32x4 a0 = U_LD(0), a1 = U_LD(1), a2 = U_LD(2), a3 = U_LD(3); asm volatile("" ::: "memory"); \
      U_MMA(c, a0, B0); U_MMA(c, a1, B1); U_MMA(c, a2, B2); U_MMA(c, a3, B3); } \
    const int rsel = pp & 3; const float v = rsel == 0 ? c[0] : rsel == 1 ? c[1] : rsel == 2 ? c[2] : c[3]; \
    const float vo = __shfl(v, (lane + 40) & 63); \
    if (pp < 8 && q == (pp >> 2)) { const f32x2_t gu2 = *(const LAS f32x2_t*)(myg + (g) * 8); \
      const float d = (v + vo) * gu2[1]; const float act = 0.5f * d * (1.f + erff(d * 0.70710678118654752f)); \
      uint2 o; o.x = buf.e; o.y = __float_as_uint(gu2[0] * act * buf.vi); pw[(size_t)tok * 128 + (g)] = o; } } while (0)
DI void peer_u_phase(const u16* __restrict__ xb, const float* __restrict__ rowss, const int* __restrict__ idx, const float2* __restrict__ gu,
                     const unsigned char* __restrict__ U4, const float* __restrict__ vinv, uint2* __restrict__ pw, unsigned char* smem) {
  const int lane = threadIdx.x & 63, wave = threadIdx.x >> 6, pp = lane & 15, q = lane >> 4, gw = blockIdx.x * NWAVES + wave, nw = gridDim.x * NWAVES;
  const int pi = pp & 7, x = q + 4 * (pp >> 3);
  const unsigned xoff = 16u * x;
  LAS unsigned* idl = (LAS unsigned*)(smem + wave * (8 * UIP * 4 + 8 * UGP + 8 * 528));
  LAS unsigned char* gul = (LAS unsigned char*)(idl + 8 * UIP);
  LAS unsigned char* gst = gul + 8 * UGP;
  const LAS unsigned char* gld = gst + pi * 528 + 16 * x;
  const LAS unsigned* myi = idl + pi * UIP;
  const LAS unsigned char* myg = gul + pi * UGP;
  for (int unit = gw; unit < T / 8; unit += nw) {
    const int tok = unit * 8 + pi;
    __builtin_amdgcn_wave_barrier();
#pragma unroll
    for (int r8 = 0; r8 < 8; ++r8) {
      const int* ir = idx + (size_t)(unit * 8 + r8) * 128;
      idl[r8 * UIP + lane] = (unsigned)ir[lane]; idl[r8 * UIP + 64 + lane] = (unsigned)ir[64 + lane];
      const uint4 gv = ((const uint4*)(gu + (size_t)(unit * 8 + r8) * 128))[lane];
      pg8::u32x4 o; o.x = gv.x; o.y = gv.y; o.z = gv.z; o.w = gv.w; *(LAS pg8::u32x4*)(gul + r8 * UGP + lane * 16) = o;
    }
    __builtin_amdgcn_fence(__ATOMIC_RELEASE, "wavefront");
    __builtin_amdgcn_wave_barrier();
    const float inv = rsqrtf(rowss[tok] * (1.f / D) + EPS);
    i32x8_t B0, B1, B2, B3;
#define U_BUILD(Bv, i) do { const u16* sb = xb + (size_t)tok * D + 256 * (i) + 128 * (pp >> 3) + 16 * q; \
      _Pragma("unroll") for (int h = 0; h < 4; ++h) { float f[8]; unpack8(*(const uint4*)(sb + 64 * (h >> 1) + 8 * (h & 1)), f); int w; \
        w = __builtin_amdgcn_cvt_pk_fp8_f32(f[0] * inv, f[1] * inv, 0, false); w = __builtin_amdgcn_cvt_pk_fp8_f32(f[2] * inv, f[3] * inv, w, true); Bv[2 * h] = w; \
        w = __builtin_amdgcn_cvt_pk_fp8_f32(f[4] * inv, f[5] * inv, 0, false); w = __builtin_amdgcn_cvt_pk_fp8_f32(f[6] * inv, f[7] * inv, w, true); Bv[2 * h + 1] = w; } } while (0)
    U_BUILD(B0, 0); U_BUILD(B1, 1); U_BUILD(B2, 2); U_BUILD(B3, 3);
    UBuf b0, b1, b2, b3;
#define SB() __builtin_amdgcn_sched_barrier(0)
    U_LOAD(b0, 0); U_LOAD(b1, 1); U_LOAD(b2, 2); SB();
#pragma unroll 1
    for (int g = 0; g < 128; g += 4) {
      U_LOAD(b3, g + 3); SB(); U_COMP(b0, g); SB();
      U_LOAD(b0, (g + 4) & 127); SB(); U_COMP(b1, g + 1); SB();
      U_LOAD(b1, (g + 5) & 127); SB(); U_COMP(b2, g + 2); SB();
      U_LOAD(b2, (g + 6) & 127); SB(); U_COMP(b3, g + 3); SB();
    }
  }
}

typedef int i32x2_t __attribute__((ext_vector_type(2)));
template <bool LOCAL>
DI void peer_v_phase(const uint2* __restrict__ pw, const unsigned char* __restrict__ V4, const u16* __restrict__ xb, float* __restrict__ out, unsigned char* smem) {
  const int lane = threadIdx.x & 63, wave = threadIdx.x >> 6, r = lane >> 3, c = lane & 7, n16 = lane & 15, kg = lane >> 4;
  LAS unsigned char* img = (LAS unsigned char*)smem + wave * VWAVE;
  LAS unsigned char* pbuf = img + 128 * VIMP;
  const int nunit = 4 * (T / 64);
  const int cnt = LOCAL ? 4 : (((int)blockIdx.x < nunit) ? (nunit - 1 - (int)blockIdx.x) / (int)gridDim.x + 1 : 0), N = cnt * 8;
  if (N == 0) return;
#define V_TOK(n, jj, tt) do { if (LOCAL) { jj = (n) >> 3; tt = (int)blockIdx.x * 64 + wave * 8 + ((n) & 7); } else { const int _u = (int)blockIdx.x + ((n) >> 3) * (int)gridDim.x; jj = _u & 3; tt = (_u >> 2) * 64 + wave * 8 + ((n) & 7); } } while (0)
#define V_LDPW(n) ({ int _j, _t; V_TOK(n, _j, _t); ((const uint4*)(pw + (size_t)_t * 128))[lane]; })
#define V_STAGE(n, pq, scv) do { LAS unsigned char* _b = pbuf + ((n) & 1) * 1024; \
    *(LAS i32x2_t*)(_b + 8 * lane) = (i32x2_t){(int)(pq).x, (int)(pq).z}; *(LAS i32x2_t*)(_b + 512 + 8 * lane) = (i32x2_t){(int)(pq).y, (int)(pq).w}; \
    const float _m = wave_max(fmaxf(fabsf(__uint_as_float((pq).y)), fabsf(__uint_as_float((pq).w)))); scv = _m > 0.f ? 224.f / _m : 1.f; } while (0)
#define V_GATHER(n) do { int _j, _t; V_TOK(n, _j, _t); const unsigned char* _vb = V4 + (size_t)_j * ((size_t)NEXP * 128) + 16 * c; const LAS unsigned* _e = (const LAS unsigned*)(pbuf + ((n) & 1) * 1024); \
    _Pragma("unroll") for (int i = 0; i < 16; ++i) G[i] = *(const uint4*)(_vb + (_e[8 * i + r] * 128u)); } while (0)
#define V_WRITEIMG() do { _Pragma("unroll") for (int i = 0; i < 16; ++i) { LAS unsigned char* _d = img + (8 * i + r) * VIMP + 16 * c; \
      *(LAS i32x2_t*)(_d) = (i32x2_t){(int)G[i].x, (int)G[i].y}; *(LAS i32x2_t*)(_d + 8) = (i32x2_t){(int)G[i].z, (int)G[i].w}; } } while (0)
  uint4 G[16];
  uint4 pq = V_LDPW(0);
  float sc_cur, sc_nxt;
  V_STAGE(0, pq, sc_cur); asm volatile("" ::: "memory");
  if (N > 1) pq = V_LDPW(1);
  V_GATHER(0);
  V_WRITEIMG(); asm volatile("" ::: "memory");
  for (int n = 0; n < N; ++n) {
    int j, t; V_TOK(n, j, t);
    const uint2 xr = *(const uint2*)(xb + (size_t)t * D + 256 * j + 4 * lane);
    if (n + 1 < N) { V_STAGE(n + 1, pq, sc_nxt); asm volatile("" ::: "memory"); if (n + 2 < N) pq = V_LDPW(n + 2); V_GATHER(n + 1); }
    __builtin_amdgcn_sched_barrier(0);
    i32x8_t A;
    { const LAS float* wl = (const LAS float*)(pbuf + (n & 1) * 1024 + 512);
#pragma unroll
      for (int h = 0; h < 2; ++h)
#pragma unroll
        for (int d = 0; d < 4; ++d) { const f32x4_t w4 = *(const LAS f32x4_t*)(wl + 64 * h + 16 * kg + 4 * d);
          int w = __builtin_amdgcn_cvt_pk_fp8_f32(w4[0] * sc_cur, w4[1] * sc_cur, 0, false); w = __builtin_amdgcn_cvt_pk_fp8_f32(w4[2] * sc_cur, w4[3] * sc_cur, w, true);
          A[4 * h + d] = n16 == 0 ? w : 0; } }
    float val[16];
    const LAS unsigned char* ib = img + (32 * kg + n16) * VIMP;
    i32x2_t tb0[16], tb1[16];
#pragma unroll
    for (int ct = 0; ct < 16; ++ct) { tb0[ct] = __builtin_amdgcn_ds_read_tr4_b64_v2i32((LAS i32x2_t*)(ib + 8 * ct)); tb1[ct] = __builtin_amdgcn_ds_read_tr4_b64_v2i32((LAS i32x2_t*)(ib + 16 * VIMP + 8 * ct)); }
#pragma unroll
    for (int ct = 0; ct < 16; ++ct) {
      const f32x4_t z = {0.f, 0.f, 0.f, 0.f};
      const f32x4_t cc = __builtin_amdgcn_mfma_scale_f32_16x16x128_f8f6f4(A, (i32x8_t){tb0[ct][0], tb0[ct][1], tb1[ct][0], tb1[ct][1], 0, 0, 0, 0}, z, 0, 4, 0, 0x7F7F7F7F, 0, 0x7F7F7F7F);
      val[ct] = cc[0];
    }
    asm volatile("" : "+v"(val[0]), "+v"(val[1]), "+v"(val[2]), "+v"(val[3]), "+v"(val[4]), "+v"(val[5]), "+v"(val[6]), "+v"(val[7]),
                      "+v"(val[8]), "+v"(val[9]), "+v"(val[10]), "+v"(val[11]), "+v"(val[12]), "+v"(val[13]), "+v"(val[14]), "+v"(val[15]));
    LAS float* stg = (LAS float*)(pbuf + (n & 1) * 1024);
    if (lane < 16) {
#pragma unroll
      for (int ct = 0; ct < 16; ++ct) stg[16 * ct + lane] = val[ct];
    }
    asm volatile("" ::: "memory");
    const f32x4_t s4 = *(const LAS f32x4_t*)(stg + 4 * lane);
    const float rs = 1.f / sc_cur;
    float4 o;
    o.x = bflo(xr.x) + s4[0] * rs; o.y = bfhi(xr.x) + s4[1] * rs; o.z = bflo(xr.y) + s4[2] * rs; o.w = bfhi(xr.y) + s4[3] * rs;
    { typedef float f4v __attribute__((ext_vector_type(4))); const f4v ov = {o.x, o.y, o.z, o.w}; __builtin_nontemporal_store(ov, (f4v*)(out + (size_t)t * D + 256 * j + 4 * lane)); }
    __builtin_amdgcn_sched_barrier(0);
    asm volatile("" ::: "memory");
    if (n + 1 < N) { V_WRITEIMG(); sc_cur = sc_nxt; }
    asm volatile("" ::: "memory");
  }
}

constexpr int NPHASE = 8;
__global__ void __launch_bounds__(NTHREADS, 2) fwd_kernel(Params p) {
  extern __shared__ __attribute__((aligned(16))) unsigned char smem[];
  cg::grid_group grid = cg::this_grid();
  unsigned char* ws = p.ws;
  u16* wt_in = (u16*)(ws + WS_WTIN); u16* wt_out = (u16*)(ws + WS_WTOUT); u16* wt_q = (u16*)(ws + WS_WTQ);
  u16* act = (u16*)(ws + WS_ACT); u16* proj = (u16*)(ws + WS_PROJ);
  int* idx = (int*)(ws + WS_IDX); float2* gu = (float2*)(ws + WS_SB); unsigned char* U8 = ws + WS_U8; unsigned char* V8 = ws + WS_V8;
  uint2* pw = (uint2*)(ws + WS_PW); float* uinv = (float*)(ws + WS_UINV); float* vinv = (float*)(ws + WS_VINV);
  float* rowss = (float*)(ws + WS_ROWSS);
  volatile LAS unsigned* misc = (volatile LAS unsigned*)(LAS unsigned char*)(smem + LDS_MISC);
  if (threadIdx.x < 8) misc[threadIdx.x] = 0u;
  __syncthreads();
  XcdBarrier bar = xcd_barrier_post((unsigned*)(ws + WS_CTL), misc);
  PG8_LAS unsigned char* lds = (PG8_LAS unsigned char*)smem;
  const int lo = p.ph_lo, hi = p.ph_hi;
#define IN(k) (lo <= (k) && (k) < hi)
#define SEAM(k) do { if (IN(k) && IN((k) + 1)) xcd_barrier(bar); } while (0)
  if (IN(0)) {
    transpose_convert(p.w_in, wt_in, D, DIN, nullptr, (float*)smem);
    transpose_convert(p.w_out, wt_out, D, D, nullptr, (float*)smem);
    transpose_convert(p.w_q, wt_q, D, 2048, p.norm2_g, (float*)smem);
    convert_fp4_rows<false>(p.peer_u, p.norm2_g, U8, uinv);
    convert_fp4_rows<true>(p.peer_v, nullptr, V8, vinv);
    rmsnorm1024(p.x, p.norm1_g, act);
    for (int i = blockIdx.x * NTHREADS + threadIdx.x; i < T; i += gridDim.x * NTHREADS) rowss[i] = 0.f;
    for (int i = blockIdx.x * NTHREADS + threadIdx.x; i < 2 * 32 * SEQ; i += gridDim.x * NTHREADS) ((float*)(ws + WS_SB + 16 * MBy))[i] = 0.f;
  }
  if (lo < 0) grid.sync();
  SEAM(0);
  u16* vt = (u16*)(ws + WS_SB);
  u16* kfr = (u16*)(ws + WS_IDX);
  float* ssq = (float*)(ws + WS_SB + 16 * MBy);
  if (IN(1)) { pg8::Gemm g{act, wt_in, T, DIN, D}; pg8::StaticOrder S; S.init(T, DIN, gridDim.x, blockIdx.x);
    pg8::EpiInProj E{proj, vt, kfr, ssq, lds + pg8::STAGE_BYTES + (threadIdx.x >> 6) * 2560}; pg8::gemm_phase<pg8::EpiInProj, pg8::StaticOrder>(lds, g, S, E, nullptr); }
  SEAM(1);
  if (IN(2)) { attn_phase(p, proj, kfr, vt, ssq, act, smem); conv_tokens(p, proj, act); }
  SEAM(2);
  if (IN(3)) { pg8::Gemm g{act, wt_out, T, D, D}; pg8::StaticOrder S; S.init(T, D, gridDim.x, blockIdx.x);
    pg8::EpiResid E{p.x, p.out, proj, rowss, D}; pg8::gemm_phase<pg8::EpiResid, pg8::StaticOrder>(lds, g, S, E, nullptr); }
  SEAM(3);
  u16* xb = proj;
  u16* qp = proj + (size_t)T * D;
  if (IN(4)) { pg8::Gemm g{xb, wt_q, T, 2048, D}; pg8::StaticOrder S; S.init(T, 2048, gridDim.x, blockIdx.x);
    pg8::EpiBf16S E{qp, 2048, rowss}; pg8::gemm_phase<pg8::EpiBf16S, pg8::StaticOrder>(lds, g, S, E, nullptr); }
  SEAM(4);
  const bool local = (gridDim.x == T / 64) && IN(5) && IN(6) && IN(7);
#define LSEAM() do { asm volatile("s_waitcnt vmcnt(0)" ::: "memory"); __builtin_amdgcn_fence(__ATOMIC_RELEASE, "workgroup"); __syncthreads(); __builtin_amdgcn_fence(__ATOMIC_ACQUIRE, "workgroup"); } while (0)
  if (IN(5)) topk_phase(p, qp, uinv, idx, gu, smem);
  if (local) LSEAM(); else SEAM(5);
  if (IN(6)) peer_u_phase(xb, rowss, idx, gu, U8, vinv, pw, smem);
  if (local) LSEAM(); else SEAM(6);
  if (IN(7)) { if (local) peer_v_phase<true>(pw, V8, xb, p.out, smem); else peer_v_phase<false>(pw, V8, xb, p.out, smem); }
}

extern "C" void kernel_launch(void* const* d_in, const int* in_sizes, int n_in, void* d_out, int out_size, void* d_ws, size_t ws_size,
                              hipStream_t stream) {
  static int grid_blocks = 0;
  if (!grid_blocks) {
    int dev = 0, cus = 0, per_cu = 0;
    (void)hipGetDevice(&dev);
    (void)hipDeviceGetAttribute(&cus, hipDeviceAttributeMultiprocessorCount, dev);
    (void)hipFuncSetAttribute((const void*)fwd_kernel, hipFuncAttributeMaxDynamicSharedMemorySize, LDS_BYTES);
    (void)hipOccupancyMaxActiveBlocksPerMultiprocessor(&per_cu, fwd_kernel, NTHREADS, LDS_BYTES);
    if (per_cu < 1) per_cu = 1;
    if (per_cu > 1) per_cu = 1;
    grid_blocks = cus * per_cu;
  }
  Params p{};
  p.x = (const float*)d_in[0]; p.norm1_g = (const float*)d_in[1]; p.w_in = (const float*)d_in[2]; p.q_norm_g = (const float*)d_in[3];
  p.k_norm_g = (const float*)d_in[4]; p.conv_w = (const float*)d_in[5]; p.sb_out_g = (const float*)d_in[6]; p.conv_out_g = (const float*)d_in[7];
  p.w_out = (const float*)d_in[8]; p.norm2_g = (const float*)d_in[9]; p.w_q = (const float*)d_in[10]; p.sub_keys = (const float*)d_in[11];
  p.peer_u = (const float*)d_in[12]; p.peer_v = (const float*)d_in[13];
  p.out = (float*)d_out; p.ws = (unsigned char*)d_ws;
  p.ph_lo = 0; p.ph_hi = NPHASE;
  (void)hipMemsetAsync((unsigned char*)d_ws + WS_CTL, 0, 4096 * 4 + 8 * 64 * 4, stream);
  void* args[] = {&p};
  hipError_t e = hipLaunchCooperativeKernel((void*)fwd_kernel, dim3(grid_blocks), dim3(NTHREADS), args, LDS_BYTES, stream);
  if (e != hipSuccess) fprintf(stderr, "cooperative launch failed: %s (grid %d)\n", hipGetErrorString(e), grid_blocks);
}
```

```cpp
#include <hip/hip_runtime.h>
#include <hip/hip_cooperative_groups.h>
#include <cstdio>
#include <cstdint>
namespace cg = cooperative_groups;

typedef unsigned short u16;
#define DI __device__ __forceinline__
#define LAS __attribute__((address_space(3)))

constexpr int T = 16384, D = 1024, SEQ = 4096;
constexpr int DIN = 3072, DSB = 512;
constexpr int NEXP = 16384;
constexpr float EPS = 1e-6f;
constexpr int NWAVES = 8, NTHREADS = NWAVES * 64;

namespace pg8 {
#define PG8_LAS __attribute__((address_space(3)))
typedef unsigned short bf16_t;
typedef short bf16x8 __attribute__((ext_vector_type(8)));
typedef float f32x4 __attribute__((ext_vector_type(4)));
typedef unsigned u32x4 __attribute__((ext_vector_type(4)));
constexpr int BM = 256, BK = 64, HALF = 128, HTB = HALF * BK * 2  , STAGE_BYTES = 8 * HTB, NXCD = 8, WGM = 8;

__host__ __device__ __forceinline__ int lds_byte(int r, int c) { const int st = (r >> 4) * 2 + (c >> 5), rr = r & 15, cc = c & 31, ob = rr * 64 + cc * 2; return st * 1024 + (ob ^ (((ob >> 9) & 1) << 5)); }
__host__ __device__ __forceinline__ void stage_rc(int b, int& R, int& C) { const int st = b / 1024, sb = b % 1024, swz = sb ^ (((sb >> 9) & 1) << 5); R = (st >> 1) * 16 + swz / 64; C = (st & 1) * 32 + (swz % 64) / 2; }
__host__ __device__ __forceinline__ int perm32(int rho) { const int n = rho >> 4, i = rho & 15; return 8 * (i >> 2) + 4 * n + (i & 3); }

struct Unit { int pm, pn; };
struct Gemm { const bf16_t* A; const bf16_t* Bt; int M, N, K; };
struct StaticOrder {
    int nM, nN, nwg, G, c;
    __host__ __device__ void init(int M, int N, int G_, int c_) { nM = M / BM; nN = N / BM; nwg = nM * nN; G = G_; c = c_; }
    __host__ __device__ bool next(int i, Unit& u) const {
        const long L = (long)i * G + c; if (L >= nwg) return false;
        int wgid = (int)L; { const int q = nwg / NXCD, r = nwg % NXCD, xcd = wgid % NXCD, off = wgid / NXCD; wgid = (xcd < r ? xcd * (q + 1) : r * (q + 1) + (xcd - r) * q) + off; }
        const int nig = WGM * nN, gid = wgid / nig, fm = gid * WGM, gsz = (nM - fm) < WGM ? (nM - fm) : WGM;
        u.pm = fm + ((wgid % nig) % gsz); u.pn = (wgid % nig) / gsz; return true;
    }
    __device__ __forceinline__ void a_ready(const Unit&) const {}
    __device__ __forceinline__ void done(const Unit&) const {}
};
__device__ __forceinline__ unsigned cvt_pk_bf16(float lo, float hi) { unsigned r; asm volatile("v_cvt_pk_bf16_f32 %0, %1, %2" : "=v"(r) : "v"(lo), "v"(hi)); return r; }

struct EpiBf16S {
    static constexpr bool PERM = true, AFTER_DRAIN = false;
    bf16_t* O; int ldc; const float* rowss;
    __device__ __forceinline__ void operator()(const f32x4 (&acc)[2][2][4][2], const Unit& u, int wr, int wc, int fr, int fq) const {
        const int row0 = u.pm * BM + wr * 64 + fr, col0 = u.pn * BM + wc * 32 + 8 * fq;
#pragma unroll
        for (int ai = 0; ai < 2; ++ai)
#pragma unroll
            for (int m = 0; m < 4; ++m) { const int row = row0 + ai * HALF + m * 16; bf16_t* rowp = O + (size_t)row * ldc + col0;
                const float sc = rowss ? rsqrtf(rowss[row] * (1.f / 1024.f) + 1e-6f) : 1.f;
#pragma unroll
                for (int bj = 0; bj < 2; ++bj) { const f32x4 v0 = acc[ai][bj][m][0] * sc, v1 = acc[ai][bj][m][1] * sc;
                    u32x4 w; w.x = cvt_pk_bf16(v0[0], v0[1]); w.y = cvt_pk_bf16(v0[2], v0[3]); w.z = cvt_pk_bf16(v1[0], v1[1]); w.w = cvt_pk_bf16(v1[2], v1[3]);
                    *(u32x4*)(rowp + bj * HALF) = w; } }
    }
};
struct EpiInProj {
    static constexpr bool PERM = true, AFTER_DRAIN = false;
    bf16_t* O; bf16_t* vt; bf16_t* kf; float* ssq; PG8_LAS unsigned char* xl;
    __device__ __forceinline__ void operator()(const f32x4 (&acc)[2][2][4][2], const Unit& u, int wr, int wc, int fr, int fq) const {
        const int row0 = u.pm * BM + wr * 64 + fr, col0 = u.pn * BM + wc * 32 + 8 * fq, kind = u.pn >> 1;
        if (kind != 2) {
#pragma unroll
            for (int ai = 0; ai < 2; ++ai)
#pragma unroll
                for (int m = 0; m < 4; ++m) { const int row = row0 + ai * HALF + m * 16; const int bb = row >> 12, ss = row & 4095;
#pragma unroll
                    for (int bj = 0; bj < 2; ++bj) { const f32x4 v0 = acc[ai][bj][m][0], v1 = acc[ai][bj][m][1];
                        u32x4 w; w.x = cvt_pk_bf16(v0[0], v0[1]); w.y = cvt_pk_bf16(v0[2], v0[3]); w.z = cvt_pk_bf16(v1[0], v1[1]); w.w = cvt_pk_bf16(v1[2], v1[3]);
                        if (kind == 1) {
                            const int kp = ss & 31, rho = (kp & 3) + 4 * (kp >> 4) + 8 * ((kp >> 2) & 3);
                            *(u32x4*)(kf + (((((size_t)(bb * 8 + (u.pn & 1) * 4 + bj * 2 + (wc >> 1))) * 128 + (ss >> 5)) * 4 + (wc & 1) * 2 + (fq >> 1)) * 64 + rho + 32 * (fq & 1)) * 8) = w;
                        } else *(u32x4*)(O + (size_t)row * 3072 + col0 + bj * HALF) = w;
                        if (kind < 2) {
                            float sq = v0[0] * v0[0] + v0[1] * v0[1] + v0[2] * v0[2] + v0[3] * v0[3] + v1[0] * v1[0] + v1[1] * v1[1] + v1[2] * v1[2] + v1[3] * v1[3];
                            sq += __shfl_xor(sq, 16); sq += __shfl_xor(sq, 32);
                            const int head = (u.pn & 1) * 4 + bj * 2 + (wc >> 1);
                            if (fq == 0) unsafeAtomicAdd(ssq + ((size_t)(kind * 32 + bb * 8 + head)) * 4096 + ss, sq);
                        } } }
        } else {
            const int lane = fr + 16 * fq;
#pragma unroll
            for (int ai = 0; ai < 2; ++ai)
#pragma unroll
                for (int bj = 0; bj < 2; ++bj) {
                    const int d0w = (u.pn & 1) * 256 + bj * HALF + wc * 32;
#pragma unroll
                    for (int mh = 0; mh < 2; ++mh) {
#pragma unroll
                        for (int mm = 0; mm < 2; ++mm) { const f32x4 v0 = acc[ai][bj][2 * mh + mm][0], v1 = acc[ai][bj][2 * mh + mm][1];
                            const unsigned w0 = cvt_pk_bf16(v0[0], v0[1]), w1 = cvt_pk_bf16(v0[2], v0[3]), w2 = cvt_pk_bf16(v1[0], v1[1]), w3 = cvt_pk_bf16(v1[2], v1[3]);
                            PG8_LAS unsigned char* wp = xl + (8 * fq) * 80 + 2 * (16 * mm + fr);
                            *(PG8_LAS bf16_t*)(wp) = (bf16_t)w0; *(PG8_LAS bf16_t*)(wp + 80) = (bf16_t)(w0 >> 16); *(PG8_LAS bf16_t*)(wp + 160) = (bf16_t)w1; *(PG8_LAS bf16_t*)(wp + 240) = (bf16_t)(w1 >> 16);
                            *(PG8_LAS bf16_t*)(wp + 320) = (bf16_t)w2; *(PG8_LAS bf16_t*)(wp + 400) = (bf16_t)(w2 >> 16); *(PG8_LAS bf16_t*)(wp + 480) = (bf16_t)w3; *(PG8_LAS bf16_t*)(wp + 560) = (bf16_t)(w3 >> 16); }
                        asm volatile("" ::: "memory");
                        const int rowb = u.pm * BM + wr * 64 + ai * HALF + 32 * mh, bb = rowb >> 12, ssb = rowb & 4095;
#pragma unroll
                        for (int k = 0; k < 2; ++k) { const int id = lane + 64 * k, dd = id >> 2, tc = id & 3;
                            const u32x4 w = *(const PG8_LAS u32x4*)(xl + dd * 80 + 16 * tc);
                            const int dg = d0w + dd;
                            *(u32x4*)(vt + (((((size_t)(bb * 8 + (dg >> 6))) * 128 + (ssb >> 5)) * 4 + 2 * ((dg >> 5) & 1) + (tc & 1)) * 64 + (dg & 31) + 32 * (tc >> 1)) * 8) = w; }
                        asm volatile("" ::: "memory");
                    } }
        }
    }
};
struct EpiResid {
    static constexpr bool PERM = true, AFTER_DRAIN = false;
    const float* resid; float* out32; bf16_t* xb; float* rowss; int ldc;
    __device__ __forceinline__ void operator()(const f32x4 (&acc)[2][2][4][2], const Unit& u, int wr, int wc, int fr, int fq) const {
        const int row0 = u.pm * BM + wr * 64 + fr, col0 = u.pn * BM + wc * 32 + 8 * fq;
#pragma unroll
        for (int ai = 0; ai < 2; ++ai)
#pragma unroll
            for (int m = 0; m < 4; ++m) { const int row = row0 + ai * HALF + m * 16; const size_t off = (size_t)row * ldc + col0; float ss = 0.f;
#pragma unroll
                for (int bj = 0; bj < 2; ++bj) {
                    const f32x4 r0 = __builtin_nontemporal_load((const f32x4*)(resid + off + bj * HALF)), r1 = __builtin_nontemporal_load((const f32x4*)(resid + off + bj * HALF + 4));
                    const f32x4 o0 = r0 + acc[ai][bj][m][0], o1 = r1 + acc[ai][bj][m][1];
                    ss += o0[0] * o0[0] + o0[1] * o0[1] + o0[2] * o0[2] + o0[3] * o0[3] + o1[0] * o1[0] + o1[1] * o1[1] + o1[2] * o1[2] + o1[3] * o1[3];
                    u32x4 w; w.x = cvt_pk_bf16(o0[0], o0[1]); w.y = cvt_pk_bf16(o0[2], o0[3]); w.z = cvt_pk_bf16(o1[0], o1[1]); w.w = cvt_pk_bf16(o1[2], o1[3]);
                    *(u32x4*)(xb + off + bj * HALF) = w; }
                ss += __shfl_xor(ss, 16); ss += __shfl_xor(ss, 32);
                if (fq == 0) unsafeAtomicAdd(rowss + row, ss); }
    }
};
template <class Epi, class Sched, bool STAMP = false>
__device__ __forceinline__ void gemm_phase(PG8_LAS unsigned char* lds, const Gemm g, const Sched& S, const Epi& E, unsigned long long* stamps) {
    const int tid = threadIdx.x, wid = __builtin_amdgcn_readfirstlane(tid >> 6), lane = tid & 63, wr = wid >> 2, wc = wid & 3, fr = lane & 15, fq = lane >> 4;
    const int K = g.K, nt = K / BK;
    int ts_lo = 0, ts_hi = 0, nts = 0; const unsigned long long rt_entry = STAMP ? (unsigned long long)wall_clock64() : 0ull;
#define PG8_STAMP() do { if (STAMP && wid == 0 && nts < 64) { const unsigned long long _c = (unsigned long long)clock64(); \
        ts_lo = (lane == nts) ? (int)(unsigned)_c : ts_lo; ts_hi = (lane == nts) ? (int)(unsigned)(_c >> 32) : ts_hi; ++nts; } } while (0)
    PG8_STAMP();
    unsigned voffA[2], voffB[2];
#pragma unroll
    for (int i = 0; i < 2; ++i) { int R, C; stage_rc(tid * 16 + i * 8192, R, C); const int Rb = Epi::PERM ? ((R & ~31) + perm32(R & 31)) : R;
        voffA[i] = (unsigned)(R * K + C) * 2u; voffB[i] = (unsigned)(Rb * K + C) * 2u; }
    const size_t kstep = (size_t)(BK * 2);
    const size_t hstep = (size_t)HALF * K * 2;
    const size_t tstep = 2 * hstep;
    const unsigned ldsw = (unsigned)wid * 1024u;
    const int aoff = lds_byte(wr * 64 + fr, fq * 8), boff = lds_byte(wc * 32 + fr, fq * 8);
#define PG8_SA(b, h) (((b) * 2 + (h)) * HTB)
#define PG8_SB(b, h) ((4 + (b) * 2 + (h)) * HTB)
#define PG8_STAGE(bufoff, gbase, voff) do { _Pragma("unroll") for (int _i = 0; _i < 2; ++_i) \
        __builtin_amdgcn_global_load_lds((const unsigned*)((const char*)(gbase) + (voff)[_i]), (PG8_LAS unsigned*)(lds + (bufoff) + ldsw + _i * 8192), 16, 0, 0); } while (0)
#define PG8_LDA(dst, b, h) do { _Pragma("unroll") for (int m = 0; m < 4; ++m) _Pragma("unroll") for (int k = 0; k < 2; ++k) dst[m][k] = *(const PG8_LAS bf16x8*)(lds + PG8_SA(b, h) + aoff + m * 2048 + k * 1024); } while (0)
#define PG8_LDB(dst, b, h) do { _Pragma("unroll") for (int n = 0; n < 2; ++n) _Pragma("unroll") for (int k = 0; k < 2; ++k) dst[n][k] = *(const PG8_LAS bf16x8*)(lds + PG8_SB(b, h) + boff + n * 2048 + k * 1024); } while (0)
#define PG8_MMA(ai, bj, At, Bt) do { __builtin_amdgcn_s_setprio(1); _Pragma("unroll") for (int m = 0; m < 4; ++m) _Pragma("unroll") for (int n = 0; n < 2; ++n) _Pragma("unroll") for (int k = 0; k < 2; ++k) \
        acc[ai][bj][m][n] = __builtin_amdgcn_mfma_f32_16x16x32_bf16(Bt[n][k], At[m][k], acc[ai][bj][m][n], 0, 0, 0); __builtin_amdgcn_s_setprio(0); } while (0)
#define PG8_WAIT_V(n) asm volatile("s_waitcnt vmcnt(" #n ")" ::: "memory")
#define PG8_WAIT_L(n) asm volatile("s_waitcnt lgkmcnt(" #n ")" ::: "memory")
#define PG8_BAR __builtin_amdgcn_s_barrier()
#define PG8_SCHED __builtin_amdgcn_sched_barrier(0)
    Unit cur, nxt; int ui = 0;
    if (!S.next(0, cur)) return;
    f32x4 acc[2][2][4][2];
#pragma unroll
    for (int a = 0; a < 2; ++a)
#pragma unroll
        for (int b = 0; b < 2; ++b)
#pragma unroll
            for (int m = 0; m < 4; ++m)
#pragma unroll
                for (int n = 0; n < 2; ++n) acc[a][b][m][n] = (f32x4){0.f, 0.f, 0.f, 0.f};
    bf16x8 At[4][2], B0[2][2], B1[2][2];
    const char* cA = (const char*)g.A + (size_t)cur.pm * tstep; const char* cB = (const char*)g.Bt + (size_t)cur.pn * tstep;
    S.a_ready(cur);
    PG8_STAGE(PG8_SB(0, 0), cB, voffB); PG8_STAGE(PG8_SA(0, 0), cA, voffA); PG8_STAGE(PG8_SB(0, 1), cB + hstep, voffB); PG8_STAGE(PG8_SA(0, 1), cA + hstep, voffA);
    if (wr == 1) PG8_BAR;
    PG8_WAIT_V(4); PG8_BAR;
    PG8_STAGE(PG8_SB(1, 0), cB + kstep, voffB); PG8_STAGE(PG8_SA(1, 0), cA + kstep, voffA); PG8_STAGE(PG8_SB(1, 1), cB + hstep + kstep, voffB);
    PG8_WAIT_V(6); PG8_BAR;
    PG8_STAMP();
    for (;;) {
        const bool has_next = S.next(ui + 1, nxt);
        const char* nA = has_next ? (const char*)g.A + (size_t)nxt.pm * tstep : cA; const char* nB = has_next ? (const char*)g.Bt + (size_t)nxt.pn * tstep : cB;
        for (int t = 0; t < nt; t += 2) {
            const bool last = (t == nt - 2);
            const char* a1 = cA + (size_t)(t + 1) * kstep;
            const char* a2 = last ? nA : cA + (size_t)(t + 2) * kstep; const char* b2 = last ? nB : cB + (size_t)(t + 2) * kstep;
            const char* a3 = a2 + kstep; const char* b3 = b2 + kstep;
            if (last && has_next) S.a_ready(nxt);
            PG8_LDB(B0, 0, 0); PG8_SCHED; PG8_LDA(At, 0, 0); PG8_STAGE(PG8_SA(1, 1), a1 + hstep, voffA);
            PG8_WAIT_L(8); PG8_BAR; PG8_WAIT_L(0); PG8_MMA(0, 0, At, B0); PG8_BAR; PG8_SCHED;
            PG8_LDB(B1, 0, 1); PG8_STAGE(PG8_SB(0, 0), b2, voffB);
            PG8_BAR; PG8_WAIT_L(0); PG8_MMA(0, 1, At, B1); PG8_BAR;
            PG8_LDA(At, 0, 1); PG8_STAGE(PG8_SA(0, 0), a2, voffA);
            PG8_BAR; PG8_WAIT_L(0); PG8_MMA(1, 0, At, B0); PG8_BAR; PG8_SCHED;
            PG8_STAGE(PG8_SB(0, 1), b2 + hstep, voffB);
            PG8_WAIT_V(6); PG8_BAR; PG8_MMA(1, 1, At, B1); PG8_BAR;
            PG8_LDB(B0, 1, 0); PG8_SCHED; PG8_LDA(At, 1, 0); PG8_STAGE(PG8_SA(0, 1), a2 + hstep, voffA);
            PG8_WAIT_L(8); PG8_BAR; PG8_WAIT_L(0); PG8_MMA(0, 0, At, B0); PG8_BAR; PG8_SCHED;
            PG8_LDB(B1, 1, 1); PG8_STAGE(PG8_SB(1, 0), b3, voffB);
            PG8_BAR; PG8_WAIT_L(0); PG8_MMA(0, 1, At, B1); PG8_BAR;
            PG8_LDA(At, 1, 1); PG8_STAGE(PG8_SA(1, 0), a3, voffA);
            PG8_BAR; PG8_WAIT_L(0); PG8_MMA(1, 0, At, B0); PG8_BAR; PG8_SCHED;
            PG8_STAGE(PG8_SB(1, 1), b3 + hstep, voffB);
            PG8_WAIT_V(6); PG8_BAR; PG8_MMA(1, 1, At, B1); PG8_BAR;
        }
        PG8_STAMP();
        if constexpr (!Epi::AFTER_DRAIN) { E(acc, cur, wr, wc, fr, fq); S.done(cur); }
        PG8_STAMP();
        if (!has_next) break;
#pragma unroll
        for (int a = 0; a < 2; ++a)
#pragma unroll
            for (int b = 0; b < 2; ++b)
#pragma unroll
                for (int m = 0; m < 4; ++m)
#pragma unroll
                    for (int n = 0; n < 2; ++n) acc[a][b][m][n] = (f32x4){0.f, 0.f, 0.f, 0.f};
        cur = nxt; cA = nA; cB = nB; ++ui;
    }
    PG8_WAIT_V(0);
    if (wr == 0) PG8_BAR;
    PG8_BAR;
    if constexpr (Epi::AFTER_DRAIN) { E.fused(acc, cur, wr, wc, fr, fq, lds, wid, lane); S.done(cur); }
    PG8_STAMP();
    if (STAMP && wid == 0) { stamps[lane] = lane < nts ? (((unsigned long long)(unsigned)ts_hi << 32) | (unsigned)ts_lo) : 0ull;
        if (lane == 62) stamps[62] = rt_entry; if (lane == 63) stamps[63] = (unsigned long long)wall_clock64(); }
#undef PG8_STAMP
#undef PG8_SA
#undef PG8_SB
#undef PG8_STAGE
#undef PG8_LDA
#undef PG8_LDB
#undef PG8_MMA
#undef PG8_WAIT_V
#undef PG8_WAIT_L
#undef PG8_BAR
#undef PG8_SCHED
}
}


constexpr size_t MBy = 1u << 20;
constexpr size_t WS_WTIN = 0, WS_WTOUT = 6 * MBy, WS_WTQ = 8 * MBy, WS_CTL = 12 * MBy, WS_ROWSS = 12 * MBy + 65536, WS_ACT = 13 * MBy, WS_PROJ = 45 * MBy,
                 WS_SB = 141 * MBy, WS_IDX = 173 * MBy, WS_GATE = 181 * MBy, WS_U8 = 189 * MBy, WS_V8 = 205 * MBy, WS_PW = 221 * MBy,
                 WS_UINV = 12 * MBy + 262144, WS_VINV = 12 * MBy + 393216;
constexpr int VIMP = 136, VWAVE = 128 * VIMP + 2048;
constexpr int LDS_MISC = 8 * VWAVE, LDS_BYTES = 8 * VWAVE + 256;
static_assert(LDS_MISC >= pg8::STAGE_BYTES && LDS_BYTES <= 163840, "LDS budget");

struct Params {
  const float *x, *norm1_g, *w_in, *q_norm_g, *k_norm_g, *conv_w, *sb_out_g, *conv_out_g, *w_out, *norm2_g, *w_q, *sub_keys, *peer_u, *peer_v;
  float* out; unsigned char* ws; int ph_lo, ph_hi;
};

#define XB_TMO      128
#define XB_XCNT(j)  (256  + 64 * (j))
#define XB_XSUB(j)  (1280 + 64 * (j))
#define XB_XGEN(j)  (2304 + 64 * (j))
#define XB_TOP      3328
#define XB_TOPGEN   3392
#define XCD_BAR_WORDS 3456
#define XB_SPIN_CAP (1u << 18)
DI unsigned xb_ld(unsigned* p) { return __hip_atomic_load(p, __ATOMIC_RELAXED, __HIP_MEMORY_SCOPE_AGENT); }
DI unsigned xb_add(unsigned* p, unsigned v) { return __hip_atomic_fetch_add(p, v, __ATOMIC_RELAXED, __HIP_MEMORY_SCOPE_AGENT); }
DI unsigned xb_xcc_id() { return (unsigned)__builtin_amdgcn_s_getreg((3 << 11) | 20) & 0xFu; }
#define XB_SPIN(cond, bar) do { unsigned _sp = 0; while (cond) { __builtin_amdgcn_s_sleep(1); \
    if ((++_sp & 255u) == 0u) { if (xb_ld(&(bar)[XB_TMO])) break; if (_sp > XB_SPIN_CAP) { atomicAdd(&(bar)[XB_TMO], 1u); break; } } } } while (0)
struct XcdBarrier { unsigned* bar; unsigned x; volatile LAS unsigned* st; };
DI XcdBarrier xcd_barrier_post(unsigned* bar, volatile LAS unsigned* st) {
  XcdBarrier b; b.bar = bar; b.x = xb_xcc_id(); b.st = st;
  if (threadIdx.x == 0) (void)xb_add(&bar[XB_XCNT(b.x)], 1u);
  return b;
}
DI void xcd_barrier_complete(unsigned* bar, unsigned x, unsigned& nloc, unsigned& nx) {
  const unsigned G = gridDim.x * gridDim.y * gridDim.z;
  unsigned sum, cnt, mine, sp = 0u;
  for (;;) {
    sum = 0u; cnt = 0u; mine = 0u;
#pragma unroll
    for (unsigned j = 0; j < 16; ++j) { const unsigned c = xb_ld(&bar[XB_XCNT(j)]); sum += c; cnt += (c > 0u) ? 1u : 0u; mine = (j == x) ? c : mine; }
    if (sum == G) break;
    __builtin_amdgcn_s_sleep(1);
    if ((++sp & 255u) == 0u) { if (xb_ld(&bar[XB_TMO])) break; if (sp > XB_SPIN_CAP) { atomicAdd(&bar[XB_TMO], 1u); break; } }
  }
  nloc = mine > 0u ? mine : 1u; nx = cnt > 0u ? cnt : 1u;
}
DI void xcd_barrier(const XcdBarrier& b) {
  asm volatile("s_waitcnt vmcnt(0)" ::: "memory");
  __syncthreads();
  if (threadIdx.x == 0) {
    unsigned* bar = b.bar;
    __builtin_amdgcn_s_waitcnt(0);
    unsigned nloc = b.st[0], nx = b.st[1];
    if (nloc == 0u) { xcd_barrier_complete(bar, b.x, nloc, nx); b.st[0] = nloc; b.st[1] = nx; }
    const unsigned old = xb_add(&bar[XB_XSUB(b.x)], 1u);
    const unsigned gen = old / nloc;
    if (old + 1u == (gen + 1u) * nloc) {
      __builtin_amdgcn_fence(__ATOMIC_RELEASE, "agent");
      asm volatile("s_waitcnt vmcnt(0)" ::: "memory");
      const unsigned og = xb_add(&bar[XB_TOP], 1u);
      const unsigned tg = og / nx;
      if (og + 1u == (tg + 1u) * nx) xb_add(&bar[XB_TOPGEN], 1u);
      else XB_SPIN(xb_ld(&bar[XB_TOPGEN]) == tg, bar);
      __builtin_amdgcn_fence(__ATOMIC_ACQUIRE, "agent");
      xb_add(&bar[XB_XGEN(b.x)], 1u);
      asm volatile("s_waitcnt vmcnt(0)" ::: "memory");
    } else {
      XB_SPIN(xb_ld(&bar[XB_XGEN(b.x)]) == gen, bar);
      __builtin_amdgcn_fence(__ATOMIC_ACQUIRE, "agent");
      asm volatile("s_waitcnt vmcnt(0)" ::: "memory");
    }
  }
  __syncthreads();
}

DI u16 f2bf(float x) { unsigned u = __float_as_uint(x); u += 0x7fffu + ((u >> 16) & 1u); return (u16)(u >> 16); }
DI float bflo(unsigned w) { return __uint_as_float(w << 16); }
DI float bfhi(unsigned w) { return __uint_as_float(w & 0xffff0000u); }
DI unsigned pack2(float a, float b) { return (unsigned)f2bf(a) | ((unsigned)f2bf(b) << 16); }
DI float wave_sum(float v) {
#pragma unroll
  for (int o = 32; o >= 1; o >>= 1) v += __shfl_xor(v, o);
  return v;
}
DI float wave_max(float v) {
#pragma unroll
  for (int o = 32; o >= 1; o >>= 1) v = fmaxf(v, __shfl_xor(v, o));
  return v;
}
DI void unpack8(const uint4 w, float* f) {
  f[0] = bflo(w.x); f[1] = bfhi(w.x); f[2] = bflo(w.y); f[3] = bfhi(w.y); f[4] = bflo(w.z); f[5] = bfhi(w.z); f[6] = bflo(w.w); f[7] = bfhi(w.w);
}
DI uint4 pack8(const float* f) { uint4 o; o.x = pack2(f[0], f[1]); o.y = pack2(f[2], f[3]); o.z = pack2(f[4], f[5]); o.w = pack2(f[6], f[7]); return o; }


DI float4 ld_nt_f4(const float4* p) { typedef float f4v __attribute__((ext_vector_type(4))); const f4v v = __builtin_nontemporal_load((const f4v*)p); return make_float4(v.x, v.y, v.z, v.w); }

DI void transpose_convert(const float* __restrict__ W, u16* __restrict__ Wt, int K, int N, const float* __restrict__ rg, float* sm) {
  const int tid = threadIdx.x, tn_cnt = N / 64, ntile = (K / 64) * tn_cnt;
  for (int tile = blockIdx.x; tile < ntile; tile += gridDim.x) {
    const int tk = tile / tn_cnt, tn = tile % tn_cnt;
    __syncthreads();
#pragma unroll
    for (int r = 0; r < 2; ++r) { const int row = r * 32 + (tid >> 4), c4 = (tid & 15) * 4;
      const float g = rg ? rg[tk * 64 + row] : 1.f;
      const float4 v = ld_nt_f4((const float4*)(W + (size_t)(tk * 64 + row) * N + tn * 64 + c4));
      sm[row * 65 + c4] = v.x * g; sm[row * 65 + c4 + 1] = v.y * g; sm[row * 65 + c4 + 2] = v.z * g; sm[row * 65 + c4 + 3] = v.w * g; }
    __syncthreads();
    { const int n = tid & 63, k0 = (tid >> 6) * 8;
      float f[8];
#pragma unroll
      for (int j = 0; j < 8; ++j) f[j] = sm[(k0 + j) * 65 + n];
      *(uint4*)(Wt + (size_t)(tn * 64 + n) * K + tk * 64 + k0) = pack8(f); }
  }
}
template <bool SLICED>
DI void convert_fp4_rows(const float* __restrict__ src, const float* __restrict__ cg, unsigned char* __restrict__ dst, float* __restrict__ inv_out) {
  const int lane = threadIdx.x & 63, gw = blockIdx.x * NWAVES + (threadIdx.x >> 6), nw = gridDim.x * NWAVES;
  float4 g[4];
#pragma unroll
  for (int k = 0; k < 4; ++k) g[k] = cg ? ((const float4*)cg)[lane + 64 * k] : make_float4(1.f, 1.f, 1.f, 1.f);
  for (int row0 = gw * 4; row0 < NEXP; row0 += nw * 4) {
    float4 a[4][4];
#pragma unroll
    for (int rr = 0; rr < 4; ++rr)
#pragma unroll
      for (int k = 0; k < 4; ++k) a[rr][k] = ld_nt_f4((const float4*)(src + (size_t)(row0 + rr) * D) + lane + 64 * k);
#pragma unroll
    for (int rr = 0; rr < 4; ++rr) {
      float am = 0.f;
#pragma unroll
      for (int k = 0; k < 4; ++k) { a[rr][k].x *= g[k].x; a[rr][k].y *= g[k].y; a[rr][k].z *= g[k].z; a[rr][k].w *= g[k].w;
        am = fmaxf(fmaxf(am, fmaxf(fabsf(a[rr][k].x), fabsf(a[rr][k].y))), fmaxf(fabsf(a[rr][k].z), fabsf(a[rr][k].w))); }
      am = wave_max(am);
      const float sc = am > 0.f ? 6.f / am : 1.f;
      const int row = row0 + rr;
#pragma unroll
      for (int k = 0; k < 4; ++k) {
        unsigned w = 0u;
        w = __builtin_amdgcn_cvt_scalef32_pk_fp4_f32(w, a[rr][k].x * sc, a[rr][k].y * sc, 1.0f, 0); w = __builtin_amdgcn_cvt_scalef32_pk_fp4_f32(w, a[rr][k].z * sc, a[rr][k].w * sc, 1.0f, 1);
        if (SLICED) *(u16*)(dst + (size_t)k * ((size_t)NEXP * 128) + (size_t)row * 128 + 2 * lane) = (u16)w;
        else *(u16*)(dst + (size_t)row * 512 + 128 * k + 2 * lane) = (u16)w;
      }
      if (lane == 0) inv_out[row] = am > 0.f ? am * (1.f / 6.f) : 1.f;
    }
  }
}
DI void rmsnorm1024(const float* __restrict__ src, const float* __restrict__ g, u16* __restrict__ dst) {
  const int lane = threadIdx.x & 63, gw = blockIdx.x * NWAVES + (threadIdx.x >> 6), nw = gridDim.x * NWAVES;
  float4 gg[4];
#pragma unroll
  for (int j = 0; j < 4; ++j) gg[j] = ((const float4*)g)[lane + 64 * j];
  for (int row0 = gw * 4; row0 < T; row0 += nw * 4) {
    float4 v[4][4];
#pragma unroll
    for (int rr = 0; rr < 4; ++rr)
#pragma unroll
      for (int j = 0; j < 4; ++j) v[rr][j] = ld_nt_f4((const float4*)(src + (size_t)(row0 + rr) * D) + lane + 64 * j);
#pragma unroll
    for (int rr = 0; rr < 4; ++rr) {
      float ss = 0.f;
#pragma unroll
      for (int j = 0; j < 4; ++j) ss += v[rr][j].x * v[rr][j].x + v[rr][j].y * v[rr][j].y + v[rr][j].z * v[rr][j].z + v[rr][j].w * v[rr][j].w;
      ss = wave_sum(ss);
      const float inv = rsqrtf(ss * (1.f / D) + EPS);
#pragma unroll
      for (int j = 0; j < 4; ++j) {
        uint2 o; o.x = pack2(v[rr][j].x * inv * gg[j].x, v[rr][j].y * inv * gg[j].y); o.y = pack2(v[rr][j].z * inv * gg[j].z, v[rr][j].w * inv * gg[j].w);
        *(uint2*)(dst + (size_t)(row0 + rr) * D + 4 * (lane + 64 * j)) = o;
      }
    }
  }
}

DI void conv_tokens(const Params& p, const u16* __restrict__ proj, u16* __restrict__ mixed) {
  const int lane = threadIdx.x & 63, gw = blockIdx.x * NWAVES + (threadIdx.x >> 6), nw = gridDim.x * NWAVES;
  const int c0 = 8 * lane;
  float w0[8], w1[8], w2[8], go[8];
#pragma unroll
  for (int j = 0; j < 8; ++j) { w0[j] = p.conv_w[c0 + j]; w1[j] = p.conv_w[DSB + c0 + j]; w2[j] = p.conv_w[2 * DSB + c0 + j]; go[j] = p.conv_out_g[c0 + j]; }
  for (int t0 = gw * 8; t0 < T; t0 += nw * 8) {
    const u16* row = proj + (size_t)t0 * DIN + c0;
    const bool first = (t0 & (SEQ - 1)) == 0;
    uint4 X[10], C[10], B[8];
#pragma unroll
    for (int i = 0; i < 10; ++i) { X[i] = *(const uint4*)(row + (ptrdiff_t)(i - 2) * DIN + 1536); C[i] = *(const uint4*)(row + (ptrdiff_t)(i - 2) * DIN + 2560); }
#pragma unroll
    for (int i = 0; i < 8; ++i) B[i] = *(const uint4*)(row + (size_t)i * DIN + 2048);
    float pa[8], pb[8], pc[8];
    { float a[8], b[8]; unpack8(X[0], a); unpack8(C[0], b);
#pragma unroll
      for (int j = 0; j < 8; ++j) pa[j] = first ? 0.f : a[j] * b[j];
      unpack8(X[1], a); unpack8(C[1], b);
#pragma unroll
      for (int j = 0; j < 8; ++j) pb[j] = first ? 0.f : a[j] * b[j]; }
#pragma unroll
    for (int i = 0; i < 8; ++i) {
      float a[8], b[8], bg[8], y[8]; unpack8(X[i + 2], a); unpack8(C[i + 2], b); unpack8(B[i], bg);
      float ss = 0.f;
#pragma unroll
      for (int j = 0; j < 8; ++j) { pc[j] = a[j] * b[j]; y[j] = (w2[j] * pc[j] + w1[j] * pb[j] + w0[j] * pa[j]) * bg[j]; ss += y[j] * y[j]; pa[j] = pb[j]; pb[j] = pc[j]; }
      ss = wave_sum(ss);
      const float inv = rsqrtf(ss * (1.f / DSB) + EPS);
#pragma unroll
      for (int j = 0; j < 8; ++j) y[j] = y[j] * inv * go[j];
      *(uint4*)(mixed + (size_t)(t0 + i) * D + DSB + c0) = pack8(y);
    }
  }
}

typedef float f32x16_t __attribute__((ext_vector_type(16)));
typedef short bf16x8_t __attribute__((ext_vector_type(8)));
DI bf16x8_t pack_bf16x8(float a0, float a1, float a2, float a3, float a4, float a5, float a6, float a7) {
  pg8::u32x4 r;
  asm volatile("v_cvt_pk_bf16_f32 %0, %4, %5\n\tv_cvt_pk_bf16_f32 %1, %6, %7\n\tv_cvt_pk_bf16_f32 %2, %8, %9\n\tv_cvt_pk_bf16_f32 %3, %10, %11\n\ts_nop 1"
               : "=&v"(r[0]), "=&v"(r[1]), "=&v"(r[2]), "=&v"(r[3]) : "v"(a0), "v"(a1), "v"(a2), "v"(a3), "v"(a4), "v"(a5), "v"(a6), "v"(a7));
  return __builtin_bit_cast(bf16x8_t, r);
}
struct AttnKV { bf16x8_t k0, k1, k2, k3, v00, v01, v10, v11; float kq; };
DI void attn_load(AttnKV& f, const unsigned char* __restrict__ kf, const unsigned char* __restrict__ vf, unsigned off, const float* __restrict__ ksq, unsigned koff) {
  const bf16x8_t* kr = (const bf16x8_t*)(kf + off); const bf16x8_t* vr = (const bf16x8_t*)(vf + off);
  f.k0 = kr[0]; f.k1 = kr[64]; f.k2 = kr[128]; f.k3 = kr[192];
  f.v00 = vr[0]; f.v01 = vr[64]; f.v10 = vr[128]; f.v11 = vr[192];
  f.kq = *(const float*)((const unsigned char*)ksq + koff);
}
DI void attn_fin(const AttnKV& f, float (&ik)[16], LAS float* wl, int lane, int hh) {
  const float v = rsqrtf(f.kq * (1.f / 64.f) + EPS) * 0.18033688011112042f;
  asm volatile("" ::: "memory");
  if (lane < 32) wl[lane] = v;
  asm volatile("" ::: "memory");
#pragma unroll
  for (int r4 = 0; r4 < 4; ++r4) { const pg8::f32x4 q4 = ((const LAS pg8::f32x4*)(wl + 16 * hh))[r4]; ik[4 * r4] = q4[0]; ik[4 * r4 + 1] = q4[1]; ik[4 * r4 + 2] = q4[2]; ik[4 * r4 + 3] = q4[3]; }
  asm volatile("" ::: "memory");
}
template <bool DIAG>
DI void attn_half(const AttnKV& f, const float (&ik)[16], const bf16x8_t (&qf)[4], int c, int hh, float& carry, f32x16_t& o0, f32x16_t& o1) {
  f32x16_t s;
#pragma unroll
  for (int r = 0; r < 16; ++r) s[r] = 0.f;
  s = __builtin_amdgcn_mfma_f32_32x32x16_bf16(f.k0, qf[0], s, 0, 0, 0); s = __builtin_amdgcn_mfma_f32_32x32x16_bf16(f.k1, qf[1], s, 0, 0, 0);
  s = __builtin_amdgcn_mfma_f32_32x32x16_bf16(f.k2, qf[2], s, 0, 0, 0); s = __builtin_amdgcn_mfma_f32_32x32x16_bf16(f.k3, qf[3], s, 0, 0, 0);
  float rr[16];
#pragma unroll
  for (int r = 0; r < 16; ++r) {
    const float e = __builtin_amdgcn_exp2f(s[r] * ik[r]);
    float x = __builtin_amdgcn_rcpf(1.f + e);
    if (DIAG) x = (16 * hh + r) < c ? x : 1.f;
    rr[r] = x;
  }
  float tot = ((rr[0] * rr[1]) * (rr[2] * rr[3])) * ((rr[4] * rr[5]) * (rr[6] * rr[7]));
  tot *= ((rr[8] * rr[9]) * (rr[10] * rr[11])) * ((rr[12] * rr[13]) * (rr[14] * rr[15]));
  const float oth = __shfl_xor(tot, 32);
  float P = hh ? carry : carry * oth;
  float a[16];
#pragma unroll
  for (int r = 15; r >= 0; --r) { const float Pn = P * rr[r]; a[r] = P - Pn; P = Pn; }
  carry = carry * tot * oth;
  const bf16x8_t af0 = pack_bf16x8(a[0], a[1], a[2], a[3], a[4], a[5], a[6], a[7]), af1 = pack_bf16x8(a[8], a[9], a[10], a[11], a[12], a[13], a[14], a[15]);
  o0 = __builtin_amdgcn_mfma_f32_32x32x16_bf16(f.v00, af0, o0, 0, 0, 0); o0 = __builtin_amdgcn_mfma_f32_32x32x16_bf16(f.v01, af1, o0, 0, 0, 0);
  o1 = __builtin_amdgcn_mfma_f32_32x32x16_bf16(f.v10, af0, o1, 0, 0, 0); o1 = __builtin_amdgcn_mfma_f32_32x32x16_bf16(f.v11, af1, o1, 0, 0, 0);
}
DI void attn_phase(const Params& p, const u16* __restrict__ proj, const u16* __restrict__ kf, const u16* __restrict__ vt, const float* __restrict__ ssq, u16* __restrict__ mixed, unsigned char* smem) {
  const int lane = threadIdx.x & 63, head = threadIdx.x >> 6, c = lane & 31, hh = lane >> 5;
  LAS float* red = (LAS float*)smem;
  LAS float* wl = (LAS float*)(smem + 2048 + head * 128);
  for (int item = blockIdx.x; item < 4 * 64; item += gridDim.x) {
    const int b = item & 3, q0 = (63 - (item >> 2)) * 64;
    const size_t tq = (size_t)b * SEQ + q0 + c;
    const float* qsq = ssq + ((size_t)(b * 8 + head)) * SEQ;
    bf16x8_t qL[4], qU[4];
#pragma unroll
    for (int up = 0; up < 2; ++up) {
      const float iq = rsqrtf(qsq[q0 + 32 * up + c] * (1.f / 64.f) + EPS);
#pragma unroll
      for (int ks = 0; ks < 4; ++ks) { float f[8]; unpack8(*(const uint4*)(proj + (tq + 32 * up) * DIN + head * 64 + 16 * ks + 8 * hh), f);
        float gq[8];
        { const float4 qa = *(const float4*)(p.q_norm_g + 16 * ks + 8 * hh), qb = *(const float4*)(p.q_norm_g + 16 * ks + 8 * hh + 4), ka = *(const float4*)(p.k_norm_g + 16 * ks + 8 * hh), kb = *(const float4*)(p.k_norm_g + 16 * ks + 8 * hh + 4);
          gq[0] = qa.x * ka.x * iq; gq[1] = qa.y * ka.y * iq; gq[2] = qa.z * ka.z * iq; gq[3] = qa.w * ka.w * iq; gq[4] = qb.x * kb.x * iq; gq[5] = qb.y * kb.y * iq; gq[6] = qb.z * kb.z * iq; gq[7] = qb.w * kb.w * iq; }
        const bf16x8_t v = pack_bf16x8(f[0] * gq[0], f[1] * gq[1], f[2] * gq[2], f[3] * gq[3], f[4] * gq[4], f[5] * gq[5], f[6] * gq[6], f[7] * gq[7]);
        if (up) qU[ks] = v; else qL[ks] = v; }
    }
    f32x16_t oL0, oL1, oU0, oU1;
#pragma unroll
    for (int r = 0; r < 16; ++r) { oL0[r] = 0.f; oL1[r] = 0.f; oU0[r] = 0.f; oU1[r] = 0.f; }
    float cL = 1.f, cU = 1.f;
    const unsigned fbase = ((unsigned)(b * 8 + head) * 128u * 256u + (unsigned)lane) * 16u;
    const unsigned kqbase = ((unsigned)(32 + b * 8 + head) * SEQ + (unsigned)c) * 4u;
    AttnKV ka, kb;
    float ik[16];
#define ATT_LOAD(f, tb_) attn_load(f, (const unsigned char*)kf, (const unsigned char*)vt, fbase + (unsigned)(tb_) * 128u, ssq, kqbase + (unsigned)(tb_) * 4u)
    ATT_LOAD(ka, q0 + 32);
    ATT_LOAD(kb, q0);
    attn_fin(ka, ik, wl, lane, hh);
    attn_half<true>(ka, ik, qU, c, hh, cU, oU0, oU1);
    ATT_LOAD(ka, q0 >= 32 ? q0 - 32 : 0);
    attn_fin(kb, ik, wl, lane, hh);
    attn_half<false>(kb, ik, qU, c, hh, cU, oU0, oU1);
    attn_half<true>(kb, ik, qL, c, hh, cL, oL0, oL1);
    for (int tb = q0 - 32; tb >= 0; tb -= 64) {
      ATT_LOAD(kb, tb >= 32 ? tb - 32 : 0);
      attn_fin(ka, ik, wl, lane, hh);
      { const bool uz = __all(cU == 0.f);
        if (!uz) attn_half<false>(ka, ik, qU, c, hh, cU, oU0, oU1);
        attn_half<false>(ka, ik, qL, c, hh, cL, oL0, oL1);
        if (uz && __all(cL == 0.f)) break; }
      if (tb < 32) break;
      ATT_LOAD(ka, tb >= 64 ? tb - 64 : 0);
      attn_fin(kb, ik, wl, lane, hh);
      { const bool uz = __all(cU == 0.f);
        if (!uz) attn_half<false>(kb, ik, qU, c, hh, cU, oU0, oU1);
        attn_half<false>(kb, ik, qL, c, hh, cL, oL0, oL1);
        if (uz && __all(cL == 0.f)) break; }
    }
#undef ATT_LOAD
    float sL = 0.f, sU = 0.f;
#pragma unroll
    for (int r = 0; r < 16; ++r) { sL += oL0[r] * oL0[r] + oL1[r] * oL1[r]; sU += oU0[r] * oU0[r] + oU1[r] * oU1[r]; }
    sL += __shfl_xor(sL, 32); sU += __shfl_xor(sU, 32);
    __syncthreads();
    if (hh == 0) { red[head * 64 + c] = sL; red[head * 64 + 32 + c] = sU; }
    __syncthreads();
    float tL = 0.f, tU = 0.f;
#pragma unroll
    for (int h8 = 0; h8 < 8; ++h8) { tL += red[h8 * 64 + c]; tU += red[h8 * 64 + 32 + c]; }
    const float* g = p.sb_out_g + head * 64 + 4 * hh;
#pragma unroll
    for (int up = 0; up < 2; ++up) {
      const float inv = rsqrtf((up ? tU : tL) * (1.f / DSB) + EPS);
      u16* orow = mixed + (tq + 32 * up) * D + head * 64 + 4 * hh;
#pragma unroll
      for (int rg = 0; rg < 4; ++rg) {
        const float4 g0 = *(const float4*)(g + 8 * rg), g1 = *(const float4*)(g + 32 + 8 * rg);
        const float a0 = up ? oU0[4 * rg] : oL0[4 * rg], a1 = up ? oU0[4 * rg + 1] : oL0[4 * rg + 1], a2 = up ? oU0[4 * rg + 2] : oL0[4 * rg + 2], a3 = up ? oU0[4 * rg + 3] : oL0[4 * rg + 3];
        const float b0 = up ? oU1[4 * rg] : oL1[4 * rg], b1 = up ? oU1[4 * rg + 1] : oL1[4 * rg + 1], b2 = up ? oU1[4 * rg + 2] : oL1[4 * rg + 2], b3 = up ? oU1[4 * rg + 3] : oL1[4 * rg + 3];
        uint2 w0, w1;
        w0.x = pack2(a0 * inv * g0.x, a1 * inv * g0.y); w0.y = pack2(a2 * inv * g0.z, a3 * inv * g0.w);
        w1.x = pack2(b0 * inv * g1.x, b1 * inv * g1.y); w1.y = pack2(b2 * inv * g1.z, b3 * inv * g1.w);
        *(uint2*)(orow + 8 * rg) = w0; *(uint2*)(orow + 32 + 8 * rg) = w1;
      }
    }
  }
}
#define SEL_DI DI
#define SEL_F2U(x) __float_as_uint(x)
#define SEL_U2F(x) __uint_as_float(x)

#define CE(a, b) do { const unsigned _h = (a) > (b) ? (a) : (b), _l = (a) > (b) ? (b) : (a); (a) = _h; (b) = _l; } while (0)
SEL_DI void sort16(unsigned (&v)[16]) {
  CE(v[0], v[1]); CE(v[2], v[3]); CE(v[0], v[2]); CE(v[1], v[3]); CE(v[1], v[2]); CE(v[4], v[5]); CE(v[6], v[7]); CE(v[4], v[6]);
  CE(v[5], v[7]); CE(v[5], v[6]); CE(v[0], v[4]); CE(v[2], v[6]); CE(v[2], v[4]); CE(v[1], v[5]); CE(v[3], v[7]); CE(v[3], v[5]);
  CE(v[1], v[2]); CE(v[3], v[4]); CE(v[5], v[6]); CE(v[8], v[9]); CE(v[10], v[11]); CE(v[8], v[10]); CE(v[9], v[11]); CE(v[9], v[10]);
  CE(v[12], v[13]); CE(v[14], v[15]); CE(v[12], v[14]); CE(v[13], v[15]); CE(v[13], v[14]); CE(v[8], v[12]); CE(v[10], v[14]); CE(v[10], v[12]);
  CE(v[9], v[13]); CE(v[11], v[15]); CE(v[11], v[13]); CE(v[9], v[10]); CE(v[11], v[12]); CE(v[13], v[14]); CE(v[0], v[8]); CE(v[4], v[12]);
  CE(v[4], v[8]); CE(v[2], v[10]); CE(v[6], v[14]); CE(v[6], v[10]); CE(v[2], v[4]); CE(v[6], v[8]); CE(v[10], v[12]); CE(v[1], v[9]);
  CE(v[5], v[13]); CE(v[5], v[9]); CE(v[3], v[11]); CE(v[7], v[15]); CE(v[7], v[11]); CE(v[3], v[5]); CE(v[7], v[9]); CE(v[11], v[13]);
  CE(v[1], v[2]); CE(v[3], v[4]); CE(v[5], v[6]); CE(v[7], v[8]); CE(v[9], v[10]); CE(v[11], v[12]); CE(v[13], v[14]);
}
SEL_DI void bitonic_merge16(unsigned (&v)[16]) {
#pragma unroll
  for (int d = 8; d >= 1; d >>= 1)
#pragma unroll
    for (int i = 0; i < 16; ++i) if ((i & d) == 0) CE(v[i], v[i + d]);
}
SEL_DI void merge_top16(unsigned (&a)[16], const unsigned (&b)[16]) {
#pragma unroll
  for (int i = 0; i < 16; ++i) a[i] = a[i] > b[15 - i] ? a[i] : b[15 - i];
  bitonic_merge16(a);
}
SEL_DI void top16_of_64(unsigned (&g0)[16], unsigned (&g1)[16], unsigned (&g2)[16], unsigned (&g3)[16]) {
  sort16(g0); sort16(g1); sort16(g2); sort16(g3);
  merge_top16(g0, g1); merge_top16(g2, g3); merge_top16(g0, g2);
}
SEL_DI unsigned cand_key(float a, float b, unsigned payload) {
  float s = a + b; s = s < 32.0f ? 32.0f : (s > 127.99f ? 127.99f : s);
  return ((SEL_F2U(s) << 8) & 0xFFFFC000u) | payload;
}
SEL_DI void stage2(const unsigned (&L1)[16], const unsigned (&L2)[16], unsigned (&R)[16]) {
  float f1[16], f2m[16]; unsigned P1[16], P2[16];
#pragma unroll
  for (int i = 0; i < 16; ++i) { f1[i] = SEL_U2F(L1[i] & ~127u); f2m[i] = SEL_U2F(L2[i] & ~127u) - 64.0f; P1[i] = (L1[i] & 127u) << 7; P2[i] = L2[i] & 127u; }
  unsigned K[64];
  K[0] = cand_key(f1[0], f2m[0], P1[0] | P2[0]);
  K[1] = cand_key(f1[0], f2m[1], P1[0] | P2[1]);
  K[2] = cand_key(f1[0], f2m[2], P1[0] | P2[2]);
  K[3] = cand_key(f1[0], f2m[3], P1[0] | P2[3]);
  K[4] = cand_key(f1[0], f2m[4], P1[0] | P2[4]);
  K[5] = cand_key(f1[0], f2m[5], P1[0] | P2[5]);
  K[6] = cand_key(f1[0], f2m[6], P1[0] | P2[6]);
  K[7] = cand_key(f1[0], f2m[7], P1[0] | P2[7]);
  K[8] = cand_key(f1[0], f2m[8], P1[0] | P2[8]);
  K[9] = cand_key(f1[0], f2m[9], P1[0] | P2[9]);
  K[10] = cand_key(f1[0], f2m[10], P1[0] | P2[10]);
  K[11] = cand_key(f1[0], f2m[11], P1[0] | P2[11]);
  K[12] = cand_key(f1[0], f2m[12], P1[0] | P2[12]);
  K[13] = cand_key(f1[0], f2m[13], P1[0] | P2[13]);
  K[14] = cand_key(f1[0], f2m[14], P1[0] | P2[14]);
  K[15] = cand_key(f1[0], f2m[15], P1[0] | P2[15]);
  K[16] = cand_key(f1[1], f2m[0], P1[1] | P2[0]);
  K[17] = cand_key(f1[1], f2m[1], P1[1] | P2[1]);
  K[18] = cand_key(f1[1], f2m[2], P1[1] | P2[2]);
  K[19] = cand_key(f1[1], f2m[3], P1[1] | P2[3]);
  K[20] = cand_key(f1[1], f2m[4], P1[1] | P2[4]);
  K[21] = cand_key(f1[1], f2m[5], P1[1] | P2[5]);
  K[22] = cand_key(f1[1], f2m[6], P1[1] | P2[6]);
  K[23] = cand_key(f1[1], f2m[7], P1[1] | P2[7]);
  K[24] = cand_key(f1[2], f2m[0], P1[2] | P2[0]);
  K[25] = cand_key(f1[2], f2m[1], P1[2] | P2[1]);
  K[26] = cand_key(f1[2], f2m[2], P1[2] | P2[2]);
  K[27] = cand_key(f1[2], f2m[3], P1[2] | P2[3]);
  K[28] = cand_key(f1[2], f2m[4], P1[2] | P2[4]);
  K[29] = cand_key(f1[3], f2m[0], P1[3] | P2[0]);
  K[30] = cand_key(f1[3], f2m[1], P1[3] | P2[1]);
  K[31] = cand_key(f1[3], f2m[2], P1[3] | P2[2]);
  K[32] = cand_key(f1[3], f2m[3], P1[3] | P2[3]);
  K[33] = cand_key(f1[4], f2m[0], P1[4] | P2[0]);
  K[34] = cand_key(f1[4], f2m[1], P1[4] | P2[1]);
  K[35] = cand_key(f1[4], f2m[2], P1[4] | P2[2]);
  K[36] = cand_key(f1[5], f2m[0], P1[5] | P2[0]);
  K[37] = cand_key(f1[5], f2m[1], P1[5] | P2[1]);
  K[38] = cand_key(f1[6], f2m[0], P1[6] | P2[0]);
  K[39] = cand_key(f1[6], f2m[1], P1[6] | P2[1]);
  K[40] = cand_key(f1[7], f2m[0], P1[7] | P2[0]);
  K[41] = cand_key(f1[7], f2m[1], P1[7] | P2[1]);
  K[42] = cand_key(f1[8], f2m[0], P1[8] | P2[0]);
  K[43] = cand_key(f1[9], f2m[0], P1[9] | P2[0]);
  K[44] = cand_key(f1[10], f2m[0], P1[10] | P2[0]);
  K[45] = cand_key(f1[11], f2m[0], P1[11] | P2[0]);
  K[46] = cand_key(f1[12], f2m[0], P1[12] | P2[0]);
  K[47] = cand_key(f1[13], f2m[0], P1[13] | P2[0]);
  K[48] = cand_key(f1[14], f2m[0], P1[14] | P2[0]);
  K[49] = cand_key(f1[15], f2m[0], P1[15] | P2[0]);
#pragma unroll
  for (int c = 50; c < 64; ++c) K[c] = 0u;
  unsigned g1[16], g2[16], g3[16];
#pragma unroll
  for (int i = 0; i < 16; ++i) { R[i] = K[i]; g1[i] = K[16 + i]; g2[i] = K[32 + i]; g3[i] = K[48 + i]; }
  sort16(R); sort16(g1); sort16(g2); CE(g3[0], g3[1]);
  merge_top16(R, g1);
  g2[15] = g2[15] > g3[0] ? g2[15] : g3[0]; g2[14] = g2[14] > g3[1] ? g2[14] : g3[1];
  bitonic_merge16(g2);
  merge_top16(R, g2);
}

constexpr int SKP = 272;
struct QFrag { bf16x8_t f[8]; };
DI QFrag stage1_load(const u16* __restrict__ qrow, int hh) { QFrag q;
#pragma unroll
  for (int ks = 0; ks < 8; ++ks) q.f[ks] = *(const bf16x8_t*)(qrow + 16 * ks + 8 * hh);
  return q; }
DI void stage1(const QFrag& qfr, const LAS unsigned char* sk, int tok, int hh, unsigned (&out)[16]) {
  f32x16_t acc[4];
#pragma unroll
  for (int kt = 0; kt < 4; ++kt)
#pragma unroll
    for (int r = 0; r < 16; ++r) acc[kt][r] = 64.0f;
#pragma unroll
  for (int ks = 0; ks < 8; ++ks) {
#pragma unroll
    for (int kt = 0; kt < 4; ++kt) {
      const bf16x8_t ak = *(const LAS bf16x8_t*)(sk + (32 * kt + tok) * SKP + (16 * ks + 8 * hh) * 2);
      acc[kt] = __builtin_amdgcn_mfma_f32_32x32x16_bf16(ak, qfr.f[ks], acc[kt], 0, 0, 0);
    }
    __builtin_amdgcn_sched_barrier(0);
  }
  unsigned g1[16], g2[16], g3[16];
#pragma unroll
  for (int r = 0; r < 16; ++r) {
    const unsigned ix = (unsigned)((r & 3) + 8 * (r >> 2));
    out[r] = (__float_as_uint(acc[0][r]) & ~127u) | ix; g1[r] = (__float_as_uint(acc[1][r]) & ~127u) | (32u + ix);
    g2[r] = (__float_as_uint(acc[2][r]) & ~127u) | (64u + ix); g3[r] = (__float_as_uint(acc[3][r]) & ~127u) | (96u + ix);
  }
  top16_of_64(out, g1, g2, g3);
  unsigned oth[16];
#pragma unroll
  for (int i = 0; i < 16; ++i) { out[i] |= (unsigned)(hh << 2); }
#pragma unroll
  for (int i = 0; i < 16; ++i) oth[i] = (unsigned)__shfl_xor((int)out[i], 32);
  merge_top16(out, oth);
}
DI void topk_phase(const Params& p, const u16* __restrict__ qp, const float* __restrict__ uinv, int* __restrict__ idx_out, float2* __restrict__ gu_out, unsigned char* smem) {
  const int tid = threadIdx.x;
  LAS unsigned char* sk = (LAS unsigned char*)smem;
  __syncthreads();
#pragma unroll
  for (int i = tid; i < 2 * 128 * 16; i += NTHREADS) {
    const int c = i & 15, row = i >> 4;
    const float4* s = (const float4*)(p.sub_keys + (size_t)row * 128 + c * 8);
    const float4 a = s[0], b = s[1];
    pg8::u32x4 o; o.x = pack2(a.x, a.y); o.y = pack2(a.z, a.w); o.z = pack2(b.x, b.y); o.w = pack2(b.z, b.w);
    *(LAS pg8::u32x4*)(sk + row * SKP + c * 16) = o;
  }
  __syncthreads();
  const int lane = tid & 63, tok = lane & 31, hh = lane >> 5, gw = blockIdx.x * NWAVES + (tid >> 6), nw = gridDim.x * NWAVES;
  for (int item = gw; item < (T / 32) * 4; item += nw) {
    const int t = (item >> 2) * 32 + tok, hp = item & 3;
    const u16* qt = qp + (size_t)t * 2048 + hp * 512;
    unsigned LA1[16], LA2[16], LB1[16], LB2[16];
    { QFrag fa = stage1_load(qt, hh), fb = stage1_load(qt + 128, hh);
      stage1(fa, sk, tok, hh, LA1); fa = stage1_load(qt + 256, hh);
      stage1(fb, sk + 128 * SKP, tok, hh, LA2); fb = stage1_load(qt + 384, hh);
      stage1(fa, sk, tok, hh, LB1);
      stage1(fb, sk + 128 * SKP, tok, hh, LB2); }
    unsigned L1[16], L2[16], R[16];
#pragma unroll
    for (int i = 0; i < 16; ++i) { L1[i] = hh ? LB1[i] : LA1[i]; L2[i] = hh ? LB2[i] : LA2[i]; }
    stage2(L1, L2, R);
    const int head = hp * 2 + hh;
    float ev[16], sum = 0.f;
    const float mx = __uint_as_float(0x42000000u | ((R[0] >> 14) << 6));
#pragma unroll
    for (int k = 0; k < 16; ++k) { ev[k] = __expf(__uint_as_float(0x42000000u | ((R[k] >> 14) << 6)) - mx); sum += ev[k]; }
    const float rs = 1.f / sum;
    int* io = idx_out + (size_t)t * 128 + head * 16; float2* go = gu_out + (size_t)t * 128 + head * 16;
#pragma unroll
    for (int k4 = 0; k4 < 4; ++k4) {
      int4 ex; ex.x = (int)(R[4 * k4] & 0x3FFFu); ex.y = (int)(R[4 * k4 + 1] & 0x3FFFu); ex.z = (int)(R[4 * k4 + 2] & 0x3FFFu); ex.w = (int)(R[4 * k4 + 3] & 0x3FFFu);
      ((int4*)io)[k4] = ex;
      float4 ga, gb; ga.x = ev[4 * k4] * rs; ga.y = uinv[ex.x]; ga.z = ev[4 * k4 + 1] * rs; ga.w = uinv[ex.y];
      gb.x = ev[4 * k4 + 2] * rs; gb.y = uinv[ex.z]; gb.z = ev[4 * k4 + 3] * rs; gb.w = uinv[ex.w];
      ((float4*)go)[2 * k4] = ga; ((float4*)go)[2 * k4 + 1] = gb;
    }
  }
}

typedef float f32x4_t __attribute__((ext_vector_type(4)));
typedef float f32x2_t __attribute__((ext_vector_type(2)));
typedef int i32x8_t __attribute__((ext_vector_type(8)));
constexpr int UIP = 132;
constexpr int UGP = 1032;
struct UBuf { uint4 r0, r1, r2, r3; unsigned e; float vi; };
#define U_LOAD(buf, g) do { const unsigned _e = myi[(g)]; const LAS unsigned* _il = idl + (lane >> 5) * UIP + (g); const unsigned _lo = 16u * (lane & 31); \
    buf.r0 = *(const uint4*)(U4 + (size_t)_il[0] * 512 + _lo); buf.r1 = *(const uint4*)(U4 + (size_t)_il[2 * UIP] * 512 + _lo); \
    buf.r2 = *(const uint4*)(U4 + (size_t)_il[4 * UIP] * 512 + _lo); buf.r3 = *(const uint4*)(U4 + (size_t)_il[6 * UIP] * 512 + _lo); \
    buf.e = _e; buf.vi = vinv[_e]; } while (0)
#define U_ST(i, r) do { pg8::u32x4 _o; _o.x = (r).x; _o.y = (r).y; _o.z = (r).z; _o.w = (r).w; *(LAS pg8::u32x4*)(gst + (2 * (i) + (lane >> 5)) * 528 + 16 * (lane & 31)) = _o; } while (0)
#define U_LD(j) (*(const LAS pg8::u32x4*)(gld + 128 * (j)))
#define U_MMA(c, r, b) c = __builtin_amdgcn_mfma_scale_f32_16x16x128_f8f6f4((i32x8_t){(int)(r).x, (int)(r).y, (int)(r).z, (int)(r).w, 0, 0, 0, 0}, b, c, 4, 0, 0, 0x7F7F7F7F, 0, 0x7F7F7F7F)
#define U_COMP(buf, g) do { f32x4_t c = {0.f, 0.f, 0.f, 0.f}; \
    U_ST(0, buf.r0); U_ST(1, buf.r1); U_ST(2, buf.r2); U_ST(3, buf.r3); asm volatile("" ::: "memory"); \
    { const pg8::u32x4 a0 = U_LD(0), a1 = U_LD(1), a2 = U_LD(2), a3 = U_LD(3); asm volatile("" ::: "memory"); \
      U_MMA(c, a0, B0); U_MMA(c, a1, B1); U_MMA(c, a2, B2); U_MMA(c, a3, B3); } \
    const int rsel = pp & 3; const float v = rsel == 0 ? c[0] : rsel == 1 ? c[1] : rsel == 2 ? c[2] : c[3]; \
    const float vo = __shfl(v, (lane + 40) & 63); \
    if (pp < 8 && q == (pp >> 2)) { const f32x2_t gu2 = *(const LAS f32x2_t*)(myg + (g) * 8); \
      const float d = (v + vo) * gu2[1]; const float act = 0.5f * d * (1.f + erff(d * 0.70710678118654752f)); \
      uint2 o; o.x = buf.e; o.y = __float_as_uint(gu2[0] * act * buf.vi); pw[(size_t)tok * 128 + (g)] = o; } } while (0)
DI void peer_u_phase(const u16* __restrict__ xb, const float* __restrict__ rowss, const int* __restrict__ idx, const float2* __restrict__ gu,
                     const unsigned char* __restrict__ U4, const float* __restrict__ vinv, uint2* __restrict__ pw, unsigned char* smem) {
  const int lane = threadIdx.x & 63, wave = threadIdx.x >> 6, pp = lane & 15, q = lane >> 4, gw = blockIdx.x * NWAVES + wave, nw = gridDim.x * NWAVES;
  const int pi = pp & 7, x = q + 4 * (pp >> 3);
  const unsigned xoff = 16u * x;
  LAS unsigned* idl = (LAS unsigned*)(smem + wave * (8 * UIP * 4 + 8 * UGP + 8 * 528));
  LAS unsigned char* gul = (LAS unsigned char*)(idl + 8 * UIP);
  LAS unsigned char* gst = gul + 8 * UGP;
  const LAS unsigned char* gld = gst + pi * 528 + 16 * x;
  const LAS unsigned* myi = idl + pi * UIP;
  const LAS unsigned char* myg = gul + pi * UGP;
  for (int unit = gw; unit < T / 8; unit += nw) {
    const int tok = unit * 8 + pi;
    __builtin_amdgcn_wave_barrier();
#pragma unroll
    for (int r8 = 0; r8 < 8; ++r8) {
      const int* ir = idx + (size_t)(unit * 8 + r8) * 128;
      idl[r8 * UIP + lane] = (unsigned)ir[lane]; idl[r8 * UIP + 64 + lane] = (unsigned)ir[64 + lane];
      const uint4 gv = ((const uint4*)(gu + (size_t)(unit * 8 + r8) * 128))[lane];
      pg8::u32x4 o; o.x = gv.x; o.y = gv.y; o.z = gv.z; o.w = gv.w; *(LAS pg8::u32x4*)(gul + r8 * UGP + lane * 16) = o;
    }
    __builtin_amdgcn_fence(__ATOMIC_RELEASE, "wavefront");
    __builtin_amdgcn_wave_barrier();
    const float inv = rsqrtf(rowss[tok] * (1.f / D) + EPS);
    i32x8_t B0, B1, B2, B3;
#define U_BUILD(Bv, i) do { const u16* sb = xb + (size_t)tok * D + 256 * (i) + 128 * (pp >> 3) + 16 * q; \
      _Pragma("unroll") for (int h = 0; h < 4; ++h) { float f[8]; unpack8(*(const uint4*)(sb + 64 * (h >> 1) + 8 * (h & 1)), f); int w; \
        w = __builtin_amdgcn_cvt_pk_fp8_f32(f[0] * inv, f[1] * inv, 0, false); w = __builtin_amdgcn_cvt_pk_fp8_f32(f[2] * inv, f[3] * inv, w, true); Bv[2 * h] = w; \
        w = __builtin_amdgcn_cvt_pk_fp8_f32(f[4] * inv, f[5] * inv, 0, false); w = __builtin_amdgcn_cvt_pk_fp8_f32(f[6] * inv, f[7] * inv, w, true); Bv[2 * h + 1] = w; } } while (0)
    U_BUILD(B0, 0); U_BUILD(B1, 1); U_BUILD(B2, 2); U_BUILD(B3, 3);
    UBuf b0, b1, b2, b3;
#define SB() __builtin_amdgcn_sched_barrier(0)
    U_LOAD(b0, 0); U_LOAD(b1, 1); U_LOAD(b2, 2); SB();
#pragma unroll 1
    for (int g = 0; g < 128; g += 4) {
      U_LOAD(b3, g + 3); SB(); U_COMP(b0, g); SB();
      U_LOAD(b0, (g + 4) & 127); SB(); U_COMP(b1, g + 1); SB();
      U_LOAD(b1, (g + 5) & 127); SB(); U_COMP(b2, g + 2); SB();
      U_LOAD(b2, (g + 6) & 127); SB(); U_COMP(b3, g + 3); SB();
    }
  }
}

typedef int i32x2_t __attribute__((ext_vector_type(2)));
template <bool LOCAL>
DI void peer_v_phase(const uint2* __restrict__ pw, const unsigned char* __restrict__ V4, const u16* __restrict__ xb, float* __restrict__ out, unsigned char* smem) {
  const int lane = threadIdx.x & 63, wave = threadIdx.x >> 6, r = lane >> 3, c = lane & 7, n16 = lane & 15, kg = lane >> 4;
  LAS unsigned char* img = (LAS unsigned char*)smem + wave * VWAVE;
  LAS unsigned char* pbuf = img + 128 * VIMP;
  const int nunit = 4 * (T / 64);
  const int cnt = LOCAL ? 4 : (((int)blockIdx.x < nunit) ? (nunit - 1 - (int)blockIdx.x) / (int)gridDim.x + 1 : 0), N = cnt * 8;
  if (N == 0) return;
#define V_TOK(n, jj, tt) do { if (LOCAL) { jj = (n) >> 3; tt = (int)blockIdx.x * 64 + wave * 8 + ((n) & 7); } else { const int _u = (int)blockIdx.x + ((n) >> 3) * (int)gridDim.x; jj = _u & 3; tt = (_u >> 2) * 64 + wave * 8 + ((n) & 7); } } while (0)
#define V_LDPW(n) ({ int _j, _t; V_TOK(n, _j, _t); ((const uint4*)(pw + (size_t)_t * 128))[lane]; })
#define V_STAGE(n, pq, scv) do { LAS unsigned char* _b = pbuf + ((n) & 1) * 1024; \
    *(LAS i32x2_t*)(_b + 8 * lane) = (i32x2_t){(int)(pq).x, (int)(pq).z}; *(LAS i32x2_t*)(_b + 512 + 8 * lane) = (i32x2_t){(int)(pq).y, (int)(pq).w}; \
    const float _m = wave_max(fmaxf(fabsf(__uint_as_float((pq).y)), fabsf(__uint_as_float((pq).w)))); scv = _m > 0.f ? 224.f / _m : 1.f; } while (0)
#define V_GATHER(n) do { int _j, _t; V_TOK(n, _j, _t); const unsigned char* _vb = V4 + (size_t)_j * ((size_t)NEXP * 128) + 16 * c; const LAS unsigned* _e = (const LAS unsigned*)(pbuf + ((n) & 1) * 1024); \
    _Pragma("unroll") for (int i = 0; i < 16; ++i) G[i] = *(const uint4*)(_vb + (_e[8 * i + r] * 128u)); } while (0)
#define V_WRITEIMG() do { _Pragma("unroll") for (int i = 0; i < 16; ++i) { LAS unsigned char* _d = img + (8 * i + r) * VIMP + 16 * c; \
      *(LAS i32x2_t*)(_d) = (i32x2_t){(int)G[i].x, (int)G[i].y}; *(LAS i32x2_t*)(_d + 8) = (i32x2_t){(int)G[i].z, (int)G[i].w}; } } while (0)
  uint4 G[16];
  uint4 pq = V_LDPW(0);
  float sc_cur, sc_nxt;
  V_STAGE(0, pq, sc_cur); asm volatile("" ::: "memory");
  if (N > 1) pq = V_LDPW(1);
  V_GATHER(0);
  V_WRITEIMG(); asm volatile("" ::: "memory");
  for (int n = 0; n < N; ++n) {
    int j, t; V_TOK(n, j, t);
    const uint2 xr = *(const uint2*)(xb + (size_t)t * D + 256 * j + 4 * lane);
    if (n + 1 < N) { V_STAGE(n + 1, pq, sc_nxt); asm volatile("" ::: "memory"); if (n + 2 < N) pq = V_LDPW(n + 2); V_GATHER(n + 1); }
    __builtin_amdgcn_sched_barrier(0);
    i32x8_t A;
    { const LAS float* wl = (const LAS float*)(pbuf + (n & 1) * 1024 + 512);
#pragma unroll
      for (int h = 0; h < 2; ++h)
#pragma unroll
        for (int d = 0; d < 4; ++d) { const f32x4_t w4 = *(const LAS f32x4_t*)(wl + 64 * h + 16 * kg + 4 * d);
          int w = __builtin_amdgcn_cvt_pk_fp8_f32(w4[0] * sc_cur, w4[1] * sc_cur, 0, false); w = __builtin_amdgcn_cvt_pk_fp8_f32(w4[2] * sc_cur, w4[3] * sc_cur, w, true);
          A[4 * h + d] = n16 == 0 ? w : 0; } }
    float val[16];
    const LAS unsigned char* ib = img + (32 * kg + n16) * VIMP;
    i32x2_t tb0[16], tb1[16];
#pragma unroll
    for (int ct = 0; ct < 16; ++ct) { tb0[ct] = __builtin_amdgcn_ds_read_tr4_b64_v2i32((LAS i32x2_t*)(ib + 8 * ct)); tb1[ct] = __builtin_amdgcn_ds_read_tr4_b64_v2i32((LAS i32x2_t*)(ib + 16 * VIMP + 8 * ct)); }
#pragma unroll
    for (int ct = 0; ct < 16; ++ct) {
      const f32x4_t z = {0.f, 0.f, 0.f, 0.f};
      const f32x4_t cc = __builtin_amdgcn_mfma_scale_f32_16x16x128_f8f6f4(A, (i32x8_t){tb0[ct][0], tb0[ct][1], tb1[ct][0], tb1[ct][1], 0, 0, 0, 0}, z, 0, 4, 0, 0x7F7F7F7F, 0, 0x7F7F7F7F);
      val[ct] = cc[0];
    }
    asm volatile("" : "+v"(val[0]), "+v"(val[1]), "+v"(val[2]), "+v"(val[3]), "+v"(val[4]), "+v"(val[5]), "+v"(val[6]), "+v"(val[7]),
                      "+v"(val[8]), "+v"(val[9]), "+v"(val[10]), "+v"(val[11]), "+v"(val[12]), "+v"(val[13]), "+v"(val[14]), "+v"(val[15]));
    LAS float* stg = (LAS float*)(pbuf + (n & 1) * 1024);
    if (lane < 16) {
#pragma unroll
      for (int ct = 0; ct < 16; ++ct) stg[16 * ct + lane] = val[ct];
    }
    asm volatile("" ::: "memory");
    const f32x4_t s4 = *(const LAS f32x4_t*)(stg + 4 * lane);
    const float rs = 1.f / sc_cur;
    float4 o;
    o.x = bflo(xr.x) + s4[0] * rs; o.y = bfhi(xr.x) + s4[1] * rs; o.z = bflo(xr.y) + s4[2] * rs; o.w = bfhi(xr.y) + s4[3] * rs;
    { typedef float f4v __attribute__((ext_vector_type(4))); const f4v ov = {o.x, o.y, o.z, o.w}; __builtin_nontemporal_store(ov, (f4v*)(out + (size_t)t * D + 256 * j + 4 * lane)); }
    __builtin_amdgcn_sched_barrier(0);
    asm volatile("" ::: "memory");
    if (n + 1 < N) { V_WRITEIMG(); sc_cur = sc_nxt; }
    asm volatile("" ::: "memory");
  }
}

constexpr int NPHASE = 8;
__global__ void __launch_bounds__(NTHREADS, 2) fwd_kernel(Params p) {
  extern __shared__ __attribute__((aligned(16))) unsigned char smem[];
  cg::grid_group grid = cg::this_grid();
  unsigned char* ws = p.ws;
  u16* wt_in = (u16*)(ws + WS_WTIN); u16* wt_out = (u16*)(ws + WS_WTOUT); u16* wt_q = (u16*)(ws + WS_WTQ);
  u16* act = (u16*)(ws + WS_ACT); u16* proj = (u16*)(ws + WS_PROJ);
  int* idx = (int*)(ws + WS_IDX); float2* gu = (float2*)(ws + WS_SB); unsigned char* U8 = ws + WS_U8; unsigned char* V8 = ws + WS_V8;
  uint2* pw = (uint2*)(ws + WS_PW); float* uinv = (float*)(ws + WS_UINV); float* vinv = (float*)(ws + WS_VINV);
  float* rowss = (float*)(ws + WS_ROWSS);
  volatile LAS unsigned* misc = (volatile LAS unsigned*)(LAS unsigned char*)(smem + LDS_MISC);
  if (threadIdx.x < 8) misc[threadIdx.x] = 0u;
  __syncthreads();
  XcdBarrier bar = xcd_barrier_post((unsigned*)(ws + WS_CTL), misc);
  PG8_LAS unsigned char* lds = (PG8_LAS unsigned char*)smem;
  const int lo = p.ph_lo, hi = p.ph_hi;
#define IN(k) (lo <= (k) && (k) < hi)
#define SEAM(k) do { if (IN(k) && IN((k) + 1)) xcd_barrier(bar); } while (0)
  if (IN(0)) {
    transpose_convert(p.w_in, wt_in, D, DIN, nullptr, (float*)smem);
    transpose_convert(p.w_out, wt_out, D, D, nullptr, (float*)smem);
    transpose_convert(p.w_q, wt_q, D, 2048, p.norm2_g, (float*)smem);
    convert_fp4_rows<false>(p.peer_u, p.norm2_g, U8, uinv);
    convert_fp4_rows<true>(p.peer_v, nullptr, V8, vinv);
    rmsnorm1024(p.x, p.norm1_g, act);
    for (int i = blockIdx.x * NTHREADS + threadIdx.x; i < T; i += gridDim.x * NTHREADS) rowss[i] = 0.f;
    for (int i = blockIdx.x * NTHREADS + threadIdx.x; i < 2 * 32 * SEQ; i += gridDim.x * NTHREADS) ((float*)(ws + WS_SB + 16 * MBy))[i] = 0.f;
  }
  if (lo < 0) grid.sync();
  SEAM(0);
  u16* vt = (u16*)(ws + WS_SB);
  u16* kfr = (u16*)(ws + WS_IDX);
  float* ssq = (float*)(ws + WS_SB + 16 * MBy);
  if (IN(1)) { pg8::Gemm g{act, wt_in, T, DIN, D}; pg8::StaticOrder S; S.init(T, DIN, gridDim.x, blockIdx.x);
    pg8::EpiInProj E{proj, vt, kfr, ssq, lds + pg8::STAGE_BYTES + (threadIdx.x >> 6) * 2560}; pg8::gemm_phase<pg8::EpiInProj, pg8::StaticOrder>(lds, g, S, E, nullptr); }
  SEAM(1);
  if (IN(2)) { attn_phase(p, proj, kfr, vt, ssq, act, smem); conv_tokens(p, proj, act); }
  SEAM(2);
  if (IN(3)) { pg8::Gemm g{act, wt_out, T, D, D}; pg8::StaticOrder S; S.init(T, D, gridDim.x, blockIdx.x);
    pg8::EpiResid E{p.x, p.out, proj, rowss, D}; pg8::gemm_phase<pg8::EpiResid, pg8::StaticOrder>(lds, g, S, E, nullptr); }
  SEAM(3);
  u16* xb = proj;
  u16* qp = proj + (size_t)T * D;
  if (IN(4)) { pg8::Gemm g{xb, wt_q, T, 2048, D}; pg8::StaticOrder S; S.init(T, 2048, gridDim.x, blockIdx.x);
    pg8::EpiBf16S E{qp, 2048, rowss}; pg8::gemm_phase<pg8::EpiBf16S, pg8::StaticOrder>(lds, g, S, E, nullptr); }
  SEAM(4);
  const bool local = (gridDim.x == T / 64) && IN(5) && IN(6) && IN(7);
#define LSEAM() do { asm volatile("s_waitcnt vmcnt(0)" ::: "memory"); __builtin_amdgcn_fence(__ATOMIC_RELEASE, "workgroup"); __syncthreads(); __builtin_amdgcn_fence(__ATOMIC_ACQUIRE, "workgroup"); } while (0)
  if (IN(5)) topk_phase(p, qp, uinv, idx, gu, smem);
  if (local) LSEAM(); else SEAM(5);
  if (IN(6)) peer_u_phase(xb, rowss, idx, gu, U8, vinv, pw, smem);
  if (local) LSEAM(); else SEAM(6);
  if (IN(7)) { if (local) peer_v_phase<true>(pw, V8, xb, p.out, smem); else peer_v_phase<false>(pw, V8, xb, p.out, smem); }
}

extern "C" void kernel_launch(void* const* d_in, const int* in_sizes, int n_in, void* d_out, int out_size, void* d_ws, size_t ws_size,
                              hipStream_t stream) {
  static int grid_blocks = 0;
  if (!grid_blocks) {
    int dev = 0, cus = 0, per_cu = 0;
    (void)hipGetDevice(&dev);
    (void)hipDeviceGetAttribute(&cus, hipDeviceAttributeMultiprocessorCount, dev);
    (void)hipFuncSetAttribute((const void*)fwd_kernel, hipFuncAttributeMaxDynamicSharedMemorySize, LDS_BYTES);
    (void)hipOccupancyMaxActiveBlocksPerMultiprocessor(&per_cu, fwd_kernel, NTHREADS, LDS_BYTES);
    if (per_cu < 1) per_cu = 1;
    if (per_cu > 1) per_cu = 1;
    grid_blocks = cus * per_cu;
  }
  Params p{};
  p.x = (const float*)d_in[0]; p.norm1_g = (const float*)d_in[1]; p.w_in = (const float*)d_in[2]; p.q_norm_g = (const float*)d_in[3];
  p.k_norm_g = (const float*)d_in[4]; p.conv_w = (const float*)d_in[5]; p.sb_out_g = (const float*)d_in[6]; p.conv_out_g = (const float*)d_in[7];
  p.w_out = (const float*)d_in[8]; p.norm2_g = (const float*)d_in[9]; p.w_q = (const float*)d_in[10]; p.sub_keys = (const float*)d_in[11];
  p.peer_u = (const float*)d_in[12]; p.peer_v = (const float*)d_in[13];
  p.out = (float*)d_out; p.ws = (unsigned char*)d_ws;
  p.ph_lo = 0; p.ph_hi = NPHASE;
  (void)hipMemsetAsync((unsigned char*)d_ws + WS_CTL, 0, 4096 * 4 + 8 * 64 * 4, stream);
  void* args[] = {&p};
  hipError_t e = hipLaunchCooperativeKernel((void*)fwd_kernel, dim3(grid_blocks), dim3(NTHREADS), args, LDS_BYTES, stream);
  if (e != hipSuccess) fprintf(stderr, "cooperative launch failed: %s (grid %d)\n", hipGetErrorString(e), grid_blocks);
}
```

```cpp
#include <hip/hip_runtime.h>
#include <hip/hip_cooperative_groups.h>
#include <cstdio>
#include <cstdint>
namespace cg = cooperative_groups;

typedef unsigned short u16;
#define DI __device__ __forceinline__
#define LAS __attribute__((address_space(3)))

constexpr int T = 16384, D = 1024, SEQ = 4096;
constexpr int DIN = 3072, DSB = 512;
constexpr int NEXP = 16384;
constexpr float EPS = 1e-6f;
constexpr bool F8_QK = true, F8_OUT = false, F8_Q = true;
constexpr float W8S = 64.f;
constexpr int NWAVES = 8, NTHREADS = NWAVES * 64;
constexpr int BWR = 3, BW_U0 = 1792 * BWR, BW_U1 = 2 * BW_U0, BW_V0 = BW_U0;

namespace pg8 {
#define PG8_LAS __attribute__((address_space(3)))
typedef unsigned short bf16_t;
typedef short bf16x8 __attribute__((ext_vector_type(8)));
typedef float f32x4 __attribute__((ext_vector_type(4)));
typedef unsigned u32x4 __attribute__((ext_vector_type(4)));
constexpr int BM = 256, BK = 64, HALF = 128, HTB = HALF * BK * 2  , STAGE_BYTES = 8 * HTB, NXCD = 8, WGM = 8;

__host__ __device__ __forceinline__ int lds_byte(int r, int c) { const int st = (r >> 4) * 2 + (c >> 5), rr = r & 15, cc = c & 31, ob = rr * 64 + cc * 2; return st * 1024 + (ob ^ (((ob >> 9) & 1) << 5)); }
__host__ __device__ __forceinline__ void stage_rc(int b, int& R, int& C) { const int st = b / 1024, sb = b % 1024, swz = sb ^ (((sb >> 9) & 1) << 5); R = (st >> 1) * 16 + swz / 64; C = (st & 1) * 32 + (swz % 64) / 2; }
__host__ __device__ __forceinline__ int perm32(int rho) { const int n = rho >> 4, i = rho & 15; return 8 * (i >> 2) + 4 * n + (i & 3); }

struct Unit { int pm, pn; };
struct Gemm { const bf16_t* A; const bf16_t* Bt; int M, N, K; };
struct StaticOrder {
    int nM, nN, nwg, G, c;
    __host__ __device__ void init(int M, int N, int G_, int c_) { nM = M / BM; nN = N / BM; nwg = nM * nN; G = G_; c = c_; }
    __host__ __device__ bool next(int i, Unit& u) const {
        const long L = (long)i * G + c; if (L >= nwg) return false;
        int wgid = (int)L; { const int q = nwg / NXCD, r = nwg % NXCD, xcd = wgid % NXCD, off = wgid / NXCD; wgid = (xcd < r ? xcd * (q + 1) : r * (q + 1) + (xcd - r) * q) + off; }
        const int nig = WGM * nN, gid = wgid / nig, fm = gid * WGM, gsz = (nM - fm) < WGM ? (nM - fm) : WGM;
        u.pm = fm + ((wgid % nig) % gsz); u.pn = (wgid % nig) / gsz; return true;
    }
    __device__ __forceinline__ void a_ready(const Unit&) const {}
    __device__ __forceinline__ void done(const Unit&) const {}
};
__device__ __forceinline__ unsigned cvt_pk_bf16(float lo, float hi) { unsigned r; asm volatile("v_cvt_pk_bf16_f32 %0, %1, %2" : "=v"(r) : "v"(lo), "v"(hi)); return r; }

struct EpiBf16S {
    static constexpr bool PERM = true, AFTER_DRAIN = false;
    bf16_t* O; int ldc; const float* rowss; float cs;
    __device__ __forceinline__ void operator()(const f32x4 (&acc)[2][2][4][2], const Unit& u, int wr, int wc, int fr, int fq) const {
        const int row0 = u.pm * BM + wr * 64 + fr, col0 = u.pn * BM + wc * 32 + 8 * fq;
#pragma unroll
        for (int ai = 0; ai < 2; ++ai)
#pragma unroll
            for (int m = 0; m < 4; ++m) { const int row = row0 + ai * HALF + m * 16;
                const float sc = (rowss ? rsqrtf(rowss[row] * (1.f / 1024.f) + 1e-6f) : 1.f) * cs;
#pragma unroll
                for (int bj = 0; bj < 2; ++bj) { const f32x4 v0 = acc[ai][bj][m][0] * sc, v1 = acc[ai][bj][m][1] * sc;
                    u32x4 w; w.x = cvt_pk_bf16(v0[0], v0[1]); w.y = cvt_pk_bf16(v0[2], v0[3]); w.z = cvt_pk_bf16(v1[0], v1[1]); w.w = cvt_pk_bf16(v1[2], v1[3]);
                    const int col = col0 + bj * HALF;
                    *(u32x4*)(O + ((((size_t)(row >> 5) * 16 + (col >> 7)) * 8 + ((col >> 4) & 7)) * 64 + (row & 31) + 32 * ((col >> 3) & 1)) * 8) = w; } }
    }
};
struct EpiInProj {
    static constexpr bool PERM = true, AFTER_DRAIN = false;
    bf16_t* O; bf16_t* vt; bf16_t* kf; bf16_t* qf; float* ssq; PG8_LAS unsigned char* xl; int pn0; float cs;
    __device__ __forceinline__ void operator()(const f32x4 (&acc)[2][2][4][2], const Unit& u, int wr, int wc, int fr, int fq) const {
        const int lpn = u.pn + pn0;
        const int row0 = u.pm * BM + wr * 64 + fr, kind = lpn < 6 ? (lpn >> 1) : (lpn < 10 ? 3 : 4);
        if (kind < 2) {
#pragma unroll
            for (int ai = 0; ai < 2; ++ai)
#pragma unroll
                for (int m = 0; m < 4; ++m) { const int row = row0 + ai * HALF + m * 16; const int bb = row >> 12, ss = row & 4095;
#pragma unroll
                    for (int bj = 0; bj < 2; ++bj) { const f32x4 v0 = acc[ai][bj][m][0] * cs, v1 = acc[ai][bj][m][1] * cs;
                        u32x4 w; w.x = cvt_pk_bf16(v0[0], v0[1]); w.y = cvt_pk_bf16(v0[2], v0[3]); w.z = cvt_pk_bf16(v1[0], v1[1]); w.w = cvt_pk_bf16(v1[2], v1[3]);
                        const int kp = ss & 31, rho = kind ? (kp & 3) + 4 * (kp >> 4) + 8 * ((kp >> 2) & 3) : kp;
                        *(u32x4*)((kind ? kf : qf) + (((((size_t)(bb * 8 + (lpn & 1) * 4 + bj * 2 + (wc >> 1))) * 128 + (ss >> 5)) * 4 + (wc & 1) * 2 + (fq >> 1)) * 64 + rho + 32 * (fq & 1)) * 8) = w;
                        float sq = v0[0] * v0[0] + v0[1] * v0[1] + v0[2] * v0[2] + v0[3] * v0[3] + v1[0] * v1[0] + v1[1] * v1[1] + v1[2] * v1[2] + v1[3] * v1[3];
                        sq += __shfl_xor(sq, 16); sq += __shfl_xor(sq, 32);
                        const int head = (lpn & 1) * 4 + bj * 2 + (wc >> 1);
                        if (fq == 0) unsafeAtomicAdd(ssq + ((size_t)(kind * 32 + bb * 8 + head)) * 4096 + ss, sq);
                    } }
        } else if (kind == 3) {
            const int ch0 = (lpn - 6) * HALF + wc * 32 + 8 * fq;
#pragma unroll
            for (int ai = 0; ai < 2; ++ai)
#pragma unroll
                for (int m = 0; m < 4; ++m) { const int row = row0 + ai * HALF + m * 16;
                    const f32x4 a0 = acc[ai][0][m][0] * cs, a1 = acc[ai][0][m][1] * cs, c0 = acc[ai][1][m][0] * cs, c1 = acc[ai][1][m][1] * cs;
                    u32x4 w; w.x = cvt_pk_bf16(a0[0] * c0[0], a0[1] * c0[1]); w.y = cvt_pk_bf16(a0[2] * c0[2], a0[3] * c0[3]); w.z = cvt_pk_bf16(a1[0] * c1[0], a1[1] * c1[1]); w.w = cvt_pk_bf16(a1[2] * c1[2], a1[3] * c1[3]);
                    *(u32x4*)(O + (size_t)row * 512 + ch0) = w; }
        } else if (kind == 4) {
            const int ch0 = (lpn - 10) * BM + wc * 32 + 8 * fq;
#pragma unroll
            for (int ai = 0; ai < 2; ++ai)
#pragma unroll
                for (int m = 0; m < 4; ++m) { const int row = row0 + ai * HALF + m * 16;
#pragma unroll
                    for (int bj = 0; bj < 2; ++bj) { const f32x4 v0 = acc[ai][bj][m][0] * cs, v1 = acc[ai][bj][m][1] * cs;
                        u32x4 w; w.x = cvt_pk_bf16(v0[0], v0[1]); w.y = cvt_pk_bf16(v0[2], v0[3]); w.z = cvt_pk_bf16(v1[0], v1[1]); w.w = cvt_pk_bf16(v1[2], v1[3]);
                        *(u32x4*)(O + (size_t)16384 * 512 + (size_t)row * 512 + ch0 + bj * HALF) = w; } }
        } else {
            const int lane = fr + 16 * fq;
#pragma unroll
            for (int ai = 0; ai < 2; ++ai)
#pragma unroll
                for (int bj = 0; bj < 2; ++bj) {
                    const int d0w = (lpn & 1) * 256 + bj * HALF + wc * 32;
#pragma unroll
                    for (int mh = 0; mh < 2; ++mh) {
#pragma unroll
                        for (int mm = 0; mm < 2; ++mm) { const f32x4 v0 = acc[ai][bj][2 * mh + mm][0] * cs, v1 = acc[ai][bj][2 * mh + mm][1] * cs;
                            const unsigned w0 = cvt_pk_bf16(v0[0], v0[1]), w1 = cvt_pk_bf16(v0[2], v0[3]), w2 = cvt_pk_bf16(v1[0], v1[1]), w3 = cvt_pk_bf16(v1[2], v1[3]);
                            PG8_LAS unsigned char* wp = xl + (8 * fq) * 80 + 2 * (16 * mm + fr);
                            *(PG8_LAS bf16_t*)(wp) = (bf16_t)w0; *(PG8_LAS bf16_t*)(wp + 80) = (bf16_t)(w0 >> 16); *(PG8_LAS bf16_t*)(wp + 160) = (bf16_t)w1; *(PG8_LAS bf16_t*)(wp + 240) = (bf16_t)(w1 >> 16);
                            *(PG8_LAS bf16_t*)(wp + 320) = (bf16_t)w2; *(PG8_LAS bf16_t*)(wp + 400) = (bf16_t)(w2 >> 16); *(PG8_LAS bf16_t*)(wp + 480) = (bf16_t)w3; *(PG8_LAS bf16_t*)(wp + 560) = (bf16_t)(w3 >> 16); }
                        asm volatile("" ::: "memory");
                        const int rowb = u.pm * BM + wr * 64 + ai * HALF + 32 * mh, bb = rowb >> 12, ssb = rowb & 4095;
#pragma unroll
                        for (int k = 0; k < 2; ++k) { const int id = lane + 64 * k, dd = id >> 2, tc = id & 3;
                            const u32x4 w = *(const PG8_LAS u32x4*)(xl + dd * 80 + 16 * tc);
                            const int dg = d0w + dd;
                            *(u32x4*)(vt + (((((size_t)(bb * 8 + (dg >> 6))) * 128 + (ssb >> 5)) * 4 + 2 * ((dg >> 5) & 1) + (tc & 1)) * 64 + (dg & 31) + 32 * (tc >> 1)) * 8) = w; }
                        asm volatile("" ::: "memory");
                    } }
        }
    }
};
struct EpiQK {
    static constexpr bool PERM = true, AFTER_DRAIN = false;
    bf16_t* kf; bf16_t* qf; float* ssq; float cs;
    __device__ __forceinline__ void operator()(const f32x4 (&acc)[2][2][4][2], const Unit& u, int wr, int wc, int fr, int fq) const {
        const int row0 = u.pm * BM + wr * 64 + fr, kind = u.pn >> 1;
#pragma unroll
        for (int ai = 0; ai < 2; ++ai)
#pragma unroll
            for (int m = 0; m < 4; ++m) { const int row = row0 + ai * HALF + m * 16; const int bb = row >> 12, ss = row & 4095;
#pragma unroll
                for (int bj = 0; bj < 2; ++bj) { const f32x4 v0 = acc[ai][bj][m][0] * cs, v1 = acc[ai][bj][m][1] * cs;
                    u32x4 w; w.x = cvt_pk_bf16(v0[0], v0[1]); w.y = cvt_pk_bf16(v0[2], v0[3]); w.z = cvt_pk_bf16(v1[0], v1[1]); w.w = cvt_pk_bf16(v1[2], v1[3]);
                    const int kp = ss & 31, rho = kind ? (kp & 3) + 4 * (kp >> 4) + 8 * ((kp >> 2) & 3) : kp;
                    *(u32x4*)((kind ? kf : qf) + (((((size_t)(bb * 8 + (u.pn & 1) * 4 + bj * 2 + (wc >> 1))) * 128 + (ss >> 5)) * 4 + (wc & 1) * 2 + (fq >> 1)) * 64 + rho + 32 * (fq & 1)) * 8) = w;
                    float sq = v0[0] * v0[0] + v0[1] * v0[1] + v0[2] * v0[2] + v0[3] * v0[3] + v1[0] * v1[0] + v1[1] * v1[1] + v1[2] * v1[2] + v1[3] * v1[3];
                    sq += __shfl_xor(sq, 16); sq += __shfl_xor(sq, 32);
                    const int head = (u.pn & 1) * 4 + bj * 2 + (wc >> 1);
                    if (fq == 0) unsafeAtomicAdd(ssq + ((size_t)(kind * 32 + bb * 8 + head)) * 4096 + ss, sq);
                } }
    }
};
struct EpiResid {
    static constexpr bool PERM = true, AFTER_DRAIN = false;
    const float* resid; float* out32; bf16_t* xb; float* rowss; int ldc; float cs; unsigned char* xb8;
    __device__ __forceinline__ void operator()(const f32x4 (&acc)[2][2][4][2], const Unit& u, int wr, int wc, int fr, int fq) const {
        const int row0 = u.pm * BM + wr * 64 + fr, col0 = u.pn * BM + wc * 32 + 8 * fq;
#pragma unroll
        for (int ai = 0; ai < 2; ++ai)
#pragma unroll
            for (int m = 0; m < 4; ++m) { const int row = row0 + ai * HALF + m * 16; const size_t off = (size_t)row * ldc + col0; float ss = 0.f;
#pragma unroll
                for (int bj = 0; bj < 2; ++bj) {
                    const f32x4 r0 = __builtin_nontemporal_load((const f32x4*)(resid + off + bj * HALF)), r1 = __builtin_nontemporal_load((const f32x4*)(resid + off + bj * HALF + 4));
                    const f32x4 o0 = r0 + acc[ai][bj][m][0] * cs, o1 = r1 + acc[ai][bj][m][1] * cs;
                    ss += o0[0] * o0[0] + o0[1] * o0[1] + o0[2] * o0[2] + o0[3] * o0[3] + o1[0] * o1[0] + o1[1] * o1[1] + o1[2] * o1[2] + o1[3] * o1[3];
                    u32x4 w; w.x = cvt_pk_bf16(o0[0], o0[1]); w.y = cvt_pk_bf16(o0[2], o0[3]); w.z = cvt_pk_bf16(o1[0], o1[1]); w.w = cvt_pk_bf16(o1[2], o1[3]);
                    *(u32x4*)(xb + off + bj * HALF) = w;
                    if (xb8) { int a = __builtin_amdgcn_cvt_pk_fp8_f32(__builtin_amdgcn_fmed3f(o0[0], -448.f, 448.f), __builtin_amdgcn_fmed3f(o0[1], -448.f, 448.f), 0, false);
                        a = __builtin_amdgcn_cvt_pk_fp8_f32(__builtin_amdgcn_fmed3f(o0[2], -448.f, 448.f), __builtin_amdgcn_fmed3f(o0[3], -448.f, 448.f), a, true);
                        int b = __builtin_amdgcn_cvt_pk_fp8_f32(__builtin_amdgcn_fmed3f(o1[0], -448.f, 448.f), __builtin_amdgcn_fmed3f(o1[1], -448.f, 448.f), 0, false);
                        b = __builtin_amdgcn_cvt_pk_fp8_f32(__builtin_amdgcn_fmed3f(o1[2], -448.f, 448.f), __builtin_amdgcn_fmed3f(o1[3], -448.f, 448.f), b, true);
                        typedef int i32x2v __attribute__((ext_vector_type(2))); *(i32x2v*)(xb8 + off + bj * HALF) = (i32x2v){a, b}; } }
                ss += __shfl_xor(ss, 16); ss += __shfl_xor(ss, 32);
                if (fq == 0) unsafeAtomicAdd(rowss + row, ss); }
    }
};
typedef int pg_i32x8 __attribute__((ext_vector_type(8)));
typedef int pg_i32x4 __attribute__((ext_vector_type(4)));
template <class Epi, class Sched, bool STAMP = false, bool F8 = false>
__device__ __forceinline__ void gemm_phase(PG8_LAS unsigned char* lds, const Gemm g, const Sched& S, const Epi& E, unsigned long long* stamps) {
    const int tid = threadIdx.x, wid = __builtin_amdgcn_readfirstlane(tid >> 6), lane = tid & 63, wr = wid >> 2, wc = wid & 3, fr = lane & 15, fq = lane >> 4;
    const int K = g.K, nt = K / BK;
    int ts_lo = 0, ts_hi = 0, nts = 0; const unsigned long long rt_entry = STAMP ? (unsigned long long)wall_clock64() : 0ull;
#define PG8_STAMP() do { if (STAMP && wid == 0 && nts < 64) { const unsigned long long _c = (unsigned long long)clock64(); \
        ts_lo = (lane == nts) ? (int)(unsigned)_c : ts_lo; ts_hi = (lane == nts) ? (int)(unsigned)(_c >> 32) : ts_hi; ++nts; } } while (0)
    PG8_STAMP();
    unsigned voffA[2], voffB[2];
#pragma unroll
    for (int i = 0; i < 2; ++i) { int R, C; stage_rc(tid * 16 + i * 8192, R, C); const int Rb = Epi::PERM ? ((R & ~31) + perm32(R & 31)) : R;
        voffA[i] = (unsigned)(R * K + C) * 2u; voffB[i] = (unsigned)(Rb * K + C) * 2u; }
    const size_t kstep = (size_t)(BK * 2);
    const size_t hstep = (size_t)HALF * K * 2;
    const size_t tstep = 2 * hstep;
    const unsigned ldsw = (unsigned)wid * 1024u;
    const int aoff = lds_byte(wr * 64 + fr, fq * 8), boff = lds_byte(wc * 32 + fr, fq * 8);
#define PG8_SA(b, h) (((b) * 2 + (h)) * HTB)
#define PG8_SB(b, h) ((4 + (b) * 2 + (h)) * HTB)
#define PG8_STAGE(bufoff, gbase, voff) do { _Pragma("unroll") for (int _i = 0; _i < 2; ++_i) \
        __builtin_amdgcn_global_load_lds((const unsigned*)((const char*)(gbase) + (voff)[_i]), (PG8_LAS unsigned*)(lds + (bufoff) + ldsw + _i * 8192), 16, 0, 0); } while (0)
#define PG8_LDA(dst, b, h) do { _Pragma("unroll") for (int m = 0; m < 4; ++m) { const pg_i32x4 _l = *(const PG8_LAS pg_i32x4*)(lds + PG8_SA(b, h) + aoff + m * 2048), _h = *(const PG8_LAS pg_i32x4*)(lds + PG8_SA(b, h) + aoff + m * 2048 + 1024); \
        if (F8) { dst##8[m].lo = _l; dst##8[m].hi = _h; } else { dst[m][0] = __builtin_bit_cast(bf16x8, _l); dst[m][1] = __builtin_bit_cast(bf16x8, _h); } } } while (0)
#define PG8_LDB(dst, b, h) do { _Pragma("unroll") for (int n = 0; n < 2; ++n) { const pg_i32x4 _l = *(const PG8_LAS pg_i32x4*)(lds + PG8_SB(b, h) + boff + n * 2048), _h = *(const PG8_LAS pg_i32x4*)(lds + PG8_SB(b, h) + boff + n * 2048 + 1024); \
        if (F8) { dst##8[n].lo = _l; dst##8[n].hi = _h; } else { dst[n][0] = __builtin_bit_cast(bf16x8, _l); dst[n][1] = __builtin_bit_cast(bf16x8, _h); } } } while (0)
#define PG8_MMA(ai, bj, At, Bt) do { __builtin_amdgcn_s_setprio(1); _Pragma("unroll") for (int m = 0; m < 4; ++m) _Pragma("unroll") for (int n = 0; n < 2; ++n) { \
        if (F8) asm volatile("v_mfma_scale_f32_16x16x128_f8f6f4 %0, %1, %2, %0, %3, %3 op_sel_hi:[0,0,0]" : "+v"(acc[ai][bj][m][n]) : "v"(Bt##8[n]), "v"(At##8[m]), "v"(f8one)); \
        else { acc[ai][bj][m][n] = __builtin_amdgcn_mfma_f32_16x16x32_bf16(Bt[n][0], At[m][0], acc[ai][bj][m][n], 0, 0, 0); acc[ai][bj][m][n] = __builtin_amdgcn_mfma_f32_16x16x32_bf16(Bt[n][1], At[m][1], acc[ai][bj][m][n], 0, 0, 0); } } \
        __builtin_amdgcn_s_setprio(0); } while (0)
#define PG8_WAIT_V(n) asm volatile("s_waitcnt vmcnt(" #n ")" ::: "memory")
#define PG8_WAIT_L(n) asm volatile("s_waitcnt lgkmcnt(" #n ")" ::: "memory")
#define PG8_BAR __builtin_amdgcn_s_barrier()
#define PG8_SCHED __builtin_amdgcn_sched_barrier(0)
    Unit cur, nxt; int ui = 0;
    if (!S.next(0, cur)) return;
    f32x4 acc[2][2][4][2];
#pragma unroll
    for (int a = 0; a < 2; ++a)
#pragma unroll
        for (int b = 0; b < 2; ++b)
#pragma unroll
            for (int m = 0; m < 4; ++m)
#pragma unroll
                for (int n = 0; n < 2; ++n) acc[a][b][m][n] = (f32x4){0.f, 0.f, 0.f, 0.f};
    bf16x8 At[4][2], B0[2][2], B1[2][2]; pg_i32x8 At8[4], B08[2], B18[2];
    const int f8one = 0x7F7F7F7F;
    const char* cA = (const char*)g.A + (size_t)cur.pm * tstep; const char* cB = (const char*)g.Bt + (size_t)cur.pn * tstep;
    S.a_ready(cur);
    PG8_STAGE(PG8_SB(0, 0), cB, voffB); PG8_STAGE(PG8_SA(0, 0), cA, voffA); PG8_STAGE(PG8_SB(0, 1), cB + hstep, voffB); PG8_STAGE(PG8_SA(0, 1), cA + hstep, voffA);
    if (wr == 1) PG8_BAR;
    PG8_WAIT_V(4); PG8_BAR;
    PG8_STAGE(PG8_SB(1, 0), cB + kstep, voffB); PG8_STAGE(PG8_SA(1, 0), cA + kstep, voffA); PG8_STAGE(PG8_SB(1, 1), cB + hstep + kstep, voffB);
    PG8_WAIT_V(6); PG8_BAR;
    PG8_STAMP();
    for (;;) {
        const bool has_next = S.next(ui + 1, nxt);
        const char* nA = has_next ? (const char*)g.A + (size_t)nxt.pm * tstep : cA; const char* nB = has_next ? (const char*)g.Bt + (size_t)nxt.pn * tstep : cB;
        for (int t = 0; t < nt; t += 2) {
            const bool last = (t == nt - 2);
            const char* a1 = cA + (size_t)(t + 1) * kstep;
            const char* a2 = last ? nA : cA + (size_t)(t + 2) * kstep; const char* b2 = last ? nB : cB + (size_t)(t + 2) * kstep;
            const char* a3 = a2 + kstep; const char* b3 = b2 + kstep;
            if (last && has_next) S.a_ready(nxt);
            PG8_LDB(B0, 0, 0); PG8_SCHED; PG8_LDA(At, 0, 0); PG8_STAGE(PG8_SA(1, 1), a1 + hstep, voffA);
            PG8_WAIT_L(8); PG8_BAR; PG8_WAIT_L(0); PG8_MMA(0, 0, At, B0); PG8_BAR; PG8_SCHED;
            PG8_LDB(B1, 0, 1); PG8_STAGE(PG8_SB(0, 0), b2, voffB);
            PG8_BAR; PG8_WAIT_L(0); PG8_MMA(0, 1, At, B1); PG8_BAR;
            PG8_LDA(At, 0, 1); PG8_STAGE(PG8_SA(0, 0), a2, voffA);
            PG8_BAR; PG8_WAIT_L(0); PG8_MMA(1, 0, At, B0); PG8_BAR; PG8_SCHED;
            PG8_STAGE(PG8_SB(0, 1), b2 + hstep, voffB);
            PG8_WAIT_V(6); PG8_BAR; PG8_MMA(1, 1, At, B1); PG8_BAR;
            PG8_LDB(B0, 1, 0); PG8_SCHED; PG8_LDA(At, 1, 0); PG8_STAGE(PG8_SA(0, 1), a2 + hstep, voffA);
            PG8_WAIT_L(8); PG8_BAR; PG8_WAIT_L(0); PG8_MMA(0, 0, At, B0); PG8_BAR; PG8_SCHED;
            PG8_LDB(B1, 1, 1); PG8_STAGE(PG8_SB(1, 0), b3, voffB);
            PG8_BAR; PG8_WAIT_L(0); PG8_MMA(0, 1, At, B1); PG8_BAR;
            PG8_LDA(At, 1, 1); PG8_STAGE(PG8_SA(1, 0), a3, voffA);
            PG8_BAR; PG8_WAIT_L(0); PG8_MMA(1, 0, At, B0); PG8_BAR; PG8_SCHED;
            PG8_STAGE(PG8_SB(1, 1), b3 + hstep, voffB);
            PG8_WAIT_V(6); PG8_BAR; PG8_MMA(1, 1, At, B1); PG8_BAR;
        }
        PG8_STAMP();
        if (F8) asm volatile("s_nop 15\n\ts_nop 15" ::: "memory");
        if constexpr (!Epi::AFTER_DRAIN) { E(acc, cur, wr, wc, fr, fq); S.done(cur); }
        PG8_STAMP();
        if (!has_next) break;
#pragma unroll
        for (int a = 0; a < 2; ++a)
#pragma unroll
            for (int b = 0; b < 2; ++b)
#pragma unroll
                for (int m = 0; m < 4; ++m)
#pragma unroll
                    for (int n = 0; n < 2; ++n) acc[a][b][m][n] = (f32x4){0.f, 0.f, 0.f, 0.f};
        cur = nxt; cA = nA; cB = nB; ++ui;
    }
    PG8_WAIT_V(0);
    if (wr == 0) PG8_BAR;
    PG8_BAR;
    if constexpr (Epi::AFTER_DRAIN) { E.fused(acc, cur, wr, wc, fr, fq, lds, wid, lane); S.done(cur); }
    PG8_STAMP();
    if (STAMP && wid == 0) { stamps[lane] = lane < nts ? (((unsigned long long)(unsigned)ts_hi << 32) | (unsigned)ts_lo) : 0ull;
        if (lane == 62) stamps[62] = rt_entry; if (lane == 63) stamps[63] = (unsigned long long)wall_clock64(); }
#undef PG8_STAMP
#undef PG8_SA
#undef PG8_SB
#undef PG8_STAGE
#undef PG8_LDA
#undef PG8_LDB
#undef PG8_MMA
#undef PG8_WAIT_V
#undef PG8_WAIT_L
#undef PG8_BAR
#undef PG8_SCHED
}
}


constexpr size_t MBy = 1u << 20;
constexpr size_t WS_WTIN = 0, WS_WTOUT = 6 * MBy, WS_WTQ = 8 * MBy, WS_CTL = 12 * MBy, WS_ROWSS = 12 * MBy + 65536, WS_ACT = 13 * MBy, WS_PROJ = 45 * MBy,
                 WS_SB = 141 * MBy, WS_IDX = 173 * MBy, WS_GATE = 181 * MBy, WS_U8 = 189 * MBy, WS_V8 = 205 * MBy, WS_PW = 221 * MBy,
                 WS_UINV = 12 * MBy + 262144, WS_VINV = 12 * MBy + 393216;
constexpr int VIMP = 136, VWAVE = 128 * VIMP + 2048;
constexpr int LDS_MISC = 8 * VWAVE, LDS_BYTES = 8 * VWAVE + 256;
static_assert(LDS_MISC >= pg8::STAGE_BYTES && LDS_BYTES <= 163840, "LDS budget");

struct Params {
  const float *x, *norm1_g, *w_in, *q_norm_g, *k_norm_g, *conv_w, *sb_out_g, *conv_out_g, *w_out, *norm2_g, *w_q, *sub_keys, *peer_u, *peer_v;
  float* out; unsigned char* ws; int ph_lo, ph_hi;
};

#define XB_TMO      128
#define XB_XCNT(j)  (256  + 64 * (j))
#define XB_XSUB(j)  (1280 + 64 * (j))
#define XB_XGEN(j)  (2304 + 64 * (j))
#define XB_TOP      3328
#define XB_TOPGEN   3392
#define XCD_BAR_WORDS 3456
#define XB_SPIN_CAP (1u << 18)
DI unsigned xb_ld(unsigned* p) { return __hip_atomic_load(p, __ATOMIC_RELAXED, __HIP_MEMORY_SCOPE_AGENT); }
DI unsigned xb_add(unsigned* p, unsigned v) { return __hip_atomic_fetch_add(p, v, __ATOMIC_RELAXED, __HIP_MEMORY_SCOPE_AGENT); }
DI unsigned xb_xcc_id() { return (unsigned)__builtin_amdgcn_s_getreg((3 << 11) | 20) & 0xFu; }
#define XB_SPIN(cond, bar) do { unsigned _sp = 0; while (cond) { __builtin_amdgcn_s_sleep(1); \
    if ((++_sp & 255u) == 0u) { if (xb_ld(&(bar)[XB_TMO])) break; if (_sp > XB_SPIN_CAP) { atomicAdd(&(bar)[XB_TMO], 1u); break; } } } } while (0)
struct XcdBarrier { unsigned* bar; unsigned x; volatile LAS unsigned* st; };
DI XcdBarrier xcd_barrier_post(unsigned* bar, volatile LAS unsigned* st) {
  XcdBarrier b; b.bar = bar; b.x = xb_xcc_id(); b.st = st;
  if (threadIdx.x == 0) (void)xb_add(&bar[XB_XCNT(b.x)], 1u);
  return b;
}
DI void xcd_barrier_complete(unsigned* bar, unsigned x, unsigned& nloc, unsigned& nx) {
  const unsigned G = gridDim.x * gridDim.y * gridDim.z;
  unsigned sum, cnt, mine, sp = 0u;
  for (;;) {
    sum = 0u; cnt = 0u; mine = 0u;
#pragma unroll
    for (unsigned j = 0; j < 16; ++j) { const unsigned c = xb_ld(&bar[XB_XCNT(j)]); sum += c; cnt += (c > 0u) ? 1u : 0u; mine = (j == x) ? c : mine; }
    if (sum == G) break;
    __builtin_amdgcn_s_sleep(1);
    if ((++sp & 255u) == 0u) { if (xb_ld(&bar[XB_TMO])) break; if (sp > XB_SPIN_CAP) { atomicAdd(&bar[XB_TMO], 1u); break; } }
  }
  nloc = mine > 0u ? mine : 1u; nx = cnt > 0u ? cnt : 1u;
}
DI void xcd_barrier_t0(const XcdBarrier& b) {
  if (threadIdx.x == 0) {
    unsigned* bar = b.bar;
    __builtin_amdgcn_s_waitcnt(0);
    unsigned nloc = b.st[0], nx = b.st[1];
    if (nloc == 0u) { xcd_barrier_complete(bar, b.x, nloc, nx); b.st[0] = nloc; b.st[1] = nx; }
    const unsigned old = xb_add(&bar[XB_XSUB(b.x)], 1u);
    const unsigned gen = old / nloc;
    if (old + 1u == (gen + 1u) * nloc) {
      __builtin_amdgcn_fence(__ATOMIC_RELEASE, "agent");
      asm volatile("s_waitcnt vmcnt(0)" ::: "memory");
      const unsigned og = xb_add(&bar[XB_TOP], 1u);
      const unsigned tg = og / nx;
      if (og + 1u == (tg + 1u) * nx) xb_add(&bar[XB_TOPGEN], 1u);
      else XB_SPIN(xb_ld(&bar[XB_TOPGEN]) == tg, bar);
      __builtin_amdgcn_fence(__ATOMIC_ACQUIRE, "agent");
      asm volatile("s_waitcnt vmcnt(0)" ::: "memory");
      xb_add(&bar[XB_XGEN(b.x)], 1u);
      asm volatile("s_waitcnt vmcnt(0)" ::: "memory");
    } else {
      XB_SPIN(xb_ld(&bar[XB_XGEN(b.x)]) == gen, bar);
      asm volatile("buffer_inv sc0\n\ts_waitcnt vmcnt(0)" ::: "memory");
    }
  }
}
DI void xcd_barrier(const XcdBarrier& b) {
  asm volatile("s_waitcnt vmcnt(0)" ::: "memory");
  __syncthreads();
  xcd_barrier_t0(b);
  __syncthreads();
}

DI u16 f2bf(float x) { unsigned u = __float_as_uint(x); u += 0x7fffu + ((u >> 16) & 1u); return (u16)(u >> 16); }
DI float bflo(unsigned w) { return __uint_as_float(w << 16); }
DI float bfhi(unsigned w) { return __uint_as_float(w & 0xffff0000u); }
DI unsigned pack2(float a, float b) { return (unsigned)f2bf(a) | ((unsigned)f2bf(b) << 16); }
DI float wave_sum(float v) {
#pragma unroll
  for (int o = 32; o >= 1; o >>= 1) v += __shfl_xor(v, o);
  return v;
}
DI float wave_max(float v) {
#pragma unroll
  for (int o = 32; o >= 1; o >>= 1) v = fmaxf(v, __shfl_xor(v, o));
  return v;
}
DI void unpack8(const uint4 w, float* f) {
  f[0] = bflo(w.x); f[1] = bfhi(w.x); f[2] = bflo(w.y); f[3] = bfhi(w.y); f[4] = bflo(w.z); f[5] = bfhi(w.z); f[6] = bflo(w.w); f[7] = bfhi(w.w);
}
DI unsigned pack4_fp8(float a, float b, float c, float d) {
  a = __builtin_amdgcn_fmed3f(a, -448.f, 448.f); b = __builtin_amdgcn_fmed3f(b, -448.f, 448.f); c = __builtin_amdgcn_fmed3f(c, -448.f, 448.f); d = __builtin_amdgcn_fmed3f(d, -448.f, 448.f);
  int w = __builtin_amdgcn_cvt_pk_fp8_f32(a, b, 0, false); w = __builtin_amdgcn_cvt_pk_fp8_f32(c, d, w, true); return (unsigned)w; }
DI uint2 pack8_fp8(const float* f, float sc) { uint2 o; o.x = pack4_fp8(f[0] * sc, f[1] * sc, f[2] * sc, f[3] * sc); o.y = pack4_fp8(f[4] * sc, f[5] * sc, f[6] * sc, f[7] * sc); return o; }
DI uint4 pack8(const float* f) { uint4 o; o.x = pack2(f[0], f[1]); o.y = pack2(f[2], f[3]); o.z = pack2(f[4], f[5]); o.w = pack2(f[6], f[7]); return o; }


DI float4 ld_nt_f4(const float4* p) { typedef float f4v __attribute__((ext_vector_type(4))); const f4v v = __builtin_nontemporal_load((const f4v*)p); return make_float4(v.x, v.y, v.z, v.w); }

DI int inproj_row(int n0) {
  if (n0 < 1536) return n0;
  if (n0 < 2048) { const int ch = n0 - 1536; return 1536 + (ch >> 7) * 256 + (ch & 127); }
  if (n0 < 2560) return 2560 + (n0 - 2048);
  const int ch = n0 - 2560; return 1536 + (ch >> 7) * 256 + 128 + (ch & 127);
}
template <bool REMAP = false>
DI void transpose_convert(const float* __restrict__ W, u16* __restrict__ Wt, int K, int N, const float* __restrict__ rg, float* sm) {
  const int tid = threadIdx.x, tn_cnt = N / 64, ntile = (K / 64) * tn_cnt;
  for (int tile = blockIdx.x; tile < ntile; tile += gridDim.x) {
    const int tk = tile / tn_cnt, tn = tile % tn_cnt;
    __syncthreads();
#pragma unroll
    for (int r = 0; r < 2; ++r) { const int row = r * 32 + (tid >> 4), c4 = (tid & 15) * 4;
      const float g = rg ? rg[tk * 64 + row] : 1.f;
      const float4 v = ld_nt_f4((const float4*)(W + (size_t)(tk * 64 + row) * N + tn * 64 + c4));
      sm[row * 65 + c4] = v.x * g; sm[row * 65 + c4 + 1] = v.y * g; sm[row * 65 + c4 + 2] = v.z * g; sm[row * 65 + c4 + 3] = v.w * g; }
    __syncthreads();
    { const int n = tid & 63, k0 = (tid >> 6) * 8;
      float f[8];
#pragma unroll
      for (int j = 0; j < 8; ++j) f[j] = sm[(k0 + j) * 65 + n];
      *(uint4*)(Wt + (size_t)((REMAP ? inproj_row(tn * 64) : tn * 64) + n) * K + tk * 64 + k0) = pack8(f); }
  }
}
DI void transpose_all(const Params& p, u16* __restrict__ wt_in, u16* __restrict__ wt_out, u16* __restrict__ wt_q, unsigned char* smem) {
  const int lane = threadIdx.x & 63, wave = threadIdx.x >> 6, gw = blockIdx.x * NWAVES + wave, nw = gridDim.x * NWAVES;
  LAS float* sm = (LAS float*)(smem + wave * (64 * 65 * 4));
  for (int tile = gw; tile < 1536; tile += nw) {
    const float* W; u16* Wt; const float* rg = nullptr; int N, tl, remap = 0, f8 = 0;
    if (tile < 768) { W = p.w_in; Wt = wt_in; N = DIN; tl = tile; remap = 1; f8 = F8_QK && (tile % 48) < 16; }
    else if (tile < 1024) { W = p.w_out; Wt = wt_out; N = D; tl = tile - 768; f8 = F8_OUT; }
    else { W = p.w_q; Wt = wt_q; N = 2048; tl = tile - 1024; rg = p.norm2_g; f8 = F8_Q; }
    const int tn_cnt = N / 64, tk = tl / tn_cnt, tn = tl % tn_cnt;
    float4 v[16];
#pragma unroll
    for (int i = 0; i < 16; ++i) v[i] = ld_nt_f4((const float4*)(W + (size_t)(tk * 64 + 4 * i + (lane >> 4)) * N + tn * 64 + (lane & 15) * 4));
    __builtin_amdgcn_wave_barrier();
#pragma unroll
    for (int i = 0; i < 16; ++i) { const int row = 4 * i + (lane >> 4), c4 = (lane & 15) * 4; const float g = rg ? rg[tk * 64 + row] : 1.f;
      sm[row * 65 + c4] = v[i].x * g; sm[row * 65 + c4 + 1] = v[i].y * g; sm[row * 65 + c4 + 2] = v[i].z * g; sm[row * 65 + c4 + 3] = v[i].w * g; }
    __builtin_amdgcn_fence(__ATOMIC_RELEASE, "wavefront");
    __builtin_amdgcn_wave_barrier();
    const int dn = remap ? inproj_row(tn * 64) : tn * 64;
#pragma unroll
    for (int i = 0; i < 8; ++i) { const int n = 8 * i + (lane >> 3), k0 = (lane & 7) * 8;
      float f[8];
#pragma unroll
      for (int j = 0; j < 8; ++j) f[j] = sm[(k0 + j) * 65 + n];
      if (f8) *(uint2*)((unsigned char*)Wt + (size_t)(dn + n) * D + tk * 64 + k0) = pack8_fp8(f, W8S);
      else *(uint4*)(Wt + (size_t)(dn + n) * D + tk * 64 + k0) = pack8(f); }
    __builtin_amdgcn_wave_barrier();
  }
}
template <bool SLICED, int RB = 4>
DI void convert_fp4_rows(const float* __restrict__ src, const float* __restrict__ cg, unsigned char* __restrict__ dst, float* __restrict__ inv_out, int gw, int nw, int r0, int r1) {
  const int lane = threadIdx.x & 63;
  float4 g[4];
#pragma unroll
  for (int k = 0; k < 4; ++k) g[k] = cg ? ((const float4*)cg)[lane + 64 * k] : make_float4(1.f, 1.f, 1.f, 1.f);
  for (int row0 = r0 + gw * RB; row0 < r1; row0 += nw * RB) {
    float4 a[RB][4];
#pragma unroll
    for (int rr = 0; rr < RB; ++rr)
#pragma unroll
      for (int k = 0; k < 4; ++k) a[rr][k] = ld_nt_f4((const float4*)(src + (size_t)(row0 + rr) * D) + lane + 64 * k);
#pragma unroll
    for (int rr = 0; rr < RB; ++rr) {
      float am = 0.f;
#pragma unroll
      for (int k = 0; k < 4; ++k) { a[rr][k].x *= g[k].x; a[rr][k].y *= g[k].y; a[rr][k].z *= g[k].z; a[rr][k].w *= g[k].w;
        am = fmaxf(fmaxf(am, fmaxf(fabsf(a[rr][k].x), fabsf(a[rr][k].y))), fmaxf(fabsf(a[rr][k].z), fabsf(a[rr][k].w))); }
      am = wave_max(am);
      const float sc = am > 0.f ? 6.f / am : 1.f;
      const int row = row0 + rr;
#pragma unroll
      for (int k = 0; k < 4; ++k) {
        unsigned w = 0u;
        w = __builtin_amdgcn_cvt_scalef32_pk_fp4_f32(w, a[rr][k].x * sc, a[rr][k].y * sc, 1.0f, 0); w = __builtin_amdgcn_cvt_scalef32_pk_fp4_f32(w, a[rr][k].z * sc, a[rr][k].w * sc, 1.0f, 1);
        if (SLICED) *(u16*)(dst + (size_t)k * ((size_t)NEXP * 128) + (size_t)row * 128 + 2 * lane) = (u16)w;
        else *(u16*)(dst + (size_t)row * 512 + 128 * k + 2 * lane) = (u16)w;
      }
      if (lane == 0) inv_out[row] = am > 0.f ? am * (1.f / 6.f) : 1.f;
    }
  }
}
DI void rmsnorm1024(const float* __restrict__ src, const float* __restrict__ g, u16* __restrict__ dst, unsigned char* __restrict__ dst8) {
  const int lane = threadIdx.x & 63, gw = blockIdx.x * NWAVES + (threadIdx.x >> 6), nw = gridDim.x * NWAVES;
  float4 gg[4];
#pragma unroll
  for (int j = 0; j < 4; ++j) gg[j] = ((const float4*)g)[lane + 64 * j];
  for (int row0 = gw * 4; row0 < T; row0 += nw * 4) {
    float4 v[4][4];
#pragma unroll
    for (int rr = 0; rr < 4; ++rr)
#pragma unroll
      for (int j = 0; j < 4; ++j) v[rr][j] = ld_nt_f4((const float4*)(src + (size_t)(row0 + rr) * D) + lane + 64 * j);
#pragma unroll
    for (int rr = 0; rr < 4; ++rr) {
      float ss = 0.f;
#pragma unroll
      for (int j = 0; j < 4; ++j) ss += v[rr][j].x * v[rr][j].x + v[rr][j].y * v[rr][j].y + v[rr][j].z * v[rr][j].z + v[rr][j].w * v[rr][j].w;
      ss = wave_sum(ss);
      const float inv = rsqrtf(ss * (1.f / D) + EPS);
#pragma unroll
      for (int j = 0; j < 4; ++j) {
        uint2 o; o.x = pack2(v[rr][j].x * inv * gg[j].x, v[rr][j].y * inv * gg[j].y); o.y = pack2(v[rr][j].z * inv * gg[j].z, v[rr][j].w * inv * gg[j].w);
        *(uint2*)(dst + (size_t)(row0 + rr) * D + 4 * (lane + 64 * j)) = o;
        if (dst8) *(unsigned*)(dst8 + (size_t)(row0 + rr) * D + 4 * (lane + 64 * j)) = pack4_fp8(v[rr][j].x * inv * gg[j].x, v[rr][j].y * inv * gg[j].y, v[rr][j].z * inv * gg[j].z, v[rr][j].w * inv * gg[j].w);
      }
    }
  }
}

DI void conv_tokens(const Params& p, const u16* __restrict__ proj, u16* __restrict__ mixed) {
  const int lane = threadIdx.x & 63, gw = blockIdx.x * NWAVES + (threadIdx.x >> 6), nw = gridDim.x * NWAVES;
  const int c0 = 8 * lane;
  float w0[8], w1[8], w2[8], go[8];
#pragma unroll
  for (int j = 0; j < 8; ++j) { w0[j] = p.conv_w[c0 + j]; w1[j] = p.conv_w[DSB + c0 + j]; w2[j] = p.conv_w[2 * DSB + c0 + j]; go[j] = p.conv_out_g[c0 + j]; }
  const u16* pcb = proj; const u16* gbb = proj + (size_t)T * DSB;
  for (int t0 = gw * 8; t0 < T; t0 += nw * 8) {
    const u16* prow = pcb + (size_t)t0 * DSB + c0; const u16* brow = gbb + (size_t)t0 * DSB + c0;
    const bool first = (t0 & (SEQ - 1)) == 0;
    uint4 X[10], B[8];
#pragma unroll
    for (int i = 0; i < 10; ++i) X[i] = *(const uint4*)(prow + (ptrdiff_t)(i - 2) * DSB);
#pragma unroll
    for (int i = 0; i < 8; ++i) B[i] = *(const uint4*)(brow + (size_t)i * DSB);
    float pa[8], pb[8], pc[8];
    unpack8(X[0], pa); unpack8(X[1], pb);
#pragma unroll
    for (int j = 0; j < 8; ++j) { pa[j] = first ? 0.f : pa[j]; pb[j] = first ? 0.f : pb[j]; }
#pragma unroll
    for (int i = 0; i < 8; ++i) {
      float bg[8], y[8]; unpack8(X[i + 2], pc); unpack8(B[i], bg);
      float ss = 0.f;
#pragma unroll
      for (int j = 0; j < 8; ++j) { y[j] = (w2[j] * pc[j] + w1[j] * pb[j] + w0[j] * pa[j]) * bg[j]; ss += y[j] * y[j]; pa[j] = pb[j]; pb[j] = pc[j]; }
      ss = wave_sum(ss);
      const float inv = rsqrtf(ss * (1.f / DSB) + EPS);
#pragma unroll
      for (int j = 0; j < 8; ++j) y[j] = y[j] * inv * go[j];
      if (F8_OUT) *(uint2*)((unsigned char*)mixed + (size_t)(t0 + i) * D + DSB + c0) = pack8_fp8(y, 1.f);
    else *(uint4*)(mixed + (size_t)(t0 + i) * D + DSB + c0) = pack8(y);
    }
  }
}

typedef float f32x16_t __attribute__((ext_vector_type(16)));
typedef short bf16x8_t __attribute__((ext_vector_type(8)));
DI bf16x8_t pack_bf16x8(float a0, float a1, float a2, float a3, float a4, float a5, float a6, float a7) {
  pg8::u32x4 r;
  asm volatile("v_cvt_pk_bf16_f32 %0, %4, %5\n\tv_cvt_pk_bf16_f32 %1, %6, %7\n\tv_cvt_pk_bf16_f32 %2, %8, %9\n\tv_cvt_pk_bf16_f32 %3, %10, %11\n\ts_nop 1"
               : "=&v"(r[0]), "=&v"(r[1]), "=&v"(r[2]), "=&v"(r[3]) : "v"(a0), "v"(a1), "v"(a2), "v"(a3), "v"(a4), "v"(a5), "v"(a6), "v"(a7));
  return __builtin_bit_cast(bf16x8_t, r);
}
struct AttnKV { bf16x8_t k0, k1, k2, k3, v00, v01, v10, v11; float kq; };
DI void attn_load(AttnKV& f, const unsigned char* __restrict__ kf, const unsigned char* __restrict__ vf, unsigned off, const float* __restrict__ ksq, unsigned koff) {
  const bf16x8_t* kr = (const bf16x8_t*)(kf + off); const bf16x8_t* vr = (const bf16x8_t*)(vf + off);
  f.k0 = kr[0]; f.k1 = kr[64]; f.k2 = kr[128]; f.k3 = kr[192];
  f.v00 = vr[0]; f.v01 = vr[64]; f.v10 = vr[128]; f.v11 = vr[192];
  f.kq = *(const float*)((const unsigned char*)ksq + koff);
}
DI void attn_fin(const AttnKV& f, float (&ik)[16], LAS float* wl, int lane, int hh) {
  const float v = rsqrtf(f.kq * (1.f / 64.f) + EPS) * 0.18033688011112042f;
  asm volatile("" ::: "memory");
  if (lane < 32) wl[lane] = v;
  asm volatile("" ::: "memory");
#pragma unroll
  for (int r4 = 0; r4 < 4; ++r4) { const pg8::f32x4 q4 = ((const LAS pg8::f32x4*)(wl + 16 * hh))[r4]; ik[4 * r4] = q4[0]; ik[4 * r4 + 1] = q4[1]; ik[4 * r4 + 2] = q4[2]; ik[4 * r4 + 3] = q4[3]; }
  asm volatile("" ::: "memory");
}
DI float other_half(float v, int hh) {
  const auto r = __builtin_amdgcn_permlane32_swap(__float_as_uint(v), __float_as_uint(v), false, false);
  return __uint_as_float(hh ? r[0] : r[1]);
}
DI f32x16_t attn_s(const AttnKV& f, const LAS bf16x8_t* q) {
  const bf16x8_t q0 = q[0], q1 = q[64], q2 = q[128], q3 = q[192];
  f32x16_t s;
#pragma unroll
  for (int r = 0; r < 16; ++r) s[r] = 0.f;
  s = __builtin_amdgcn_mfma_f32_32x32x16_bf16(f.k0, q0, s, 0, 0, 0); s = __builtin_amdgcn_mfma_f32_32x32x16_bf16(f.k1, q1, s, 0, 0, 0);
  s = __builtin_amdgcn_mfma_f32_32x32x16_bf16(f.k2, q2, s, 0, 0, 0); s = __builtin_amdgcn_mfma_f32_32x32x16_bf16(f.k3, q3, s, 0, 0, 0);
  return s;
}
template <bool DIAG>
DI void attn_post(const AttnKV& f, const float (&ik)[16], const f32x16_t s, int c, int hh, float& carry, f32x16_t& o0, f32x16_t& o1) {
  float rr[16];
#pragma unroll
  for (int r = 0; r < 16; ++r) {
    const float e = __builtin_amdgcn_exp2f(s[r] * ik[r]);
    float x = __builtin_amdgcn_rcpf(1.f + e);
    if (DIAG) x = (16 * hh + r) < c ? x : 1.f;
    rr[r] = x;
  }
  float tot = ((rr[0] * rr[1]) * (rr[2] * rr[3])) * ((rr[4] * rr[5]) * (rr[6] * rr[7]));
  tot *= ((rr[8] * rr[9]) * (rr[10] * rr[11])) * ((rr[12] * rr[13]) * (rr[14] * rr[15]));
  const float oth = other_half(tot, hh);
  float P = hh ? carry : carry * oth;
  float a[16];
#pragma unroll
  for (int r = 15; r >= 0; --r) { const float Pn = P * rr[r]; a[r] = P - Pn; P = Pn; }
  carry = carry * tot * oth;
  const bf16x8_t af0 = pack_bf16x8(a[0], a[1], a[2], a[3], a[4], a[5], a[6], a[7]), af1 = pack_bf16x8(a[8], a[9], a[10], a[11], a[12], a[13], a[14], a[15]);
  o0 = __builtin_amdgcn_mfma_f32_32x32x16_bf16(f.v00, af0, o0, 0, 0, 0); o0 = __builtin_amdgcn_mfma_f32_32x32x16_bf16(f.v01, af1, o0, 0, 0, 0);
  o1 = __builtin_amdgcn_mfma_f32_32x32x16_bf16(f.v10, af0, o1, 0, 0, 0); o1 = __builtin_amdgcn_mfma_f32_32x32x16_bf16(f.v11, af1, o1, 0, 0, 0);
}
DI void attn_phase(const Params& p, const u16* __restrict__ qf, const u16* __restrict__ kf, const u16* __restrict__ vt, const float* __restrict__ ssq, u16* __restrict__ mixed, unsigned char* smem) {
  const int lane = threadIdx.x & 63, head = threadIdx.x >> 6, c = lane & 31, hh = lane >> 5;
  LAS float* red = (LAS float*)smem;
  LAS float* wl = (LAS float*)(smem + 2048 + head * 128);
  LAS bf16x8_t* qst = (LAS bf16x8_t*)(smem + 8192 + head * 8192) + lane;
  for (int item = blockIdx.x; item < 4 * 64; item += gridDim.x) {
    int b, qb;
    if (gridDim.x == 256) { const int xcd = item & 7; b = xcd >> 1; qb = (xcd & 1) * 32 + (item >> 3); } else { b = item & 3; qb = 63 - (item >> 2); }
    const int q0 = qb * 64;
    const size_t tq = (size_t)b * SEQ + q0 + c;
    const float* qsq = ssq + ((size_t)(b * 8 + head)) * SEQ;
    const unsigned fbase = ((unsigned)(b * 8 + head) * 128u * 256u + (unsigned)lane) * 16u;
    const unsigned kqbase = ((unsigned)(32 + b * 8 + head) * SEQ + (unsigned)c) * 4u;
    AttnKV ka, kb;
#define ATT_LOAD(f, tb_) attn_load(f, (const unsigned char*)kf, (const unsigned char*)vt, fbase + (unsigned)(tb_) * 128u, ssq, kqbase + (unsigned)(tb_) * 4u)
    ATT_LOAD(ka, q0 + 32);
    ATT_LOAD(kb, q0);
#pragma unroll
    for (int up = 0; up < 2; ++up) {
      const float iq = rsqrtf(qsq[q0 + 32 * up + c] * (1.f / 64.f) + EPS);
#pragma unroll
      for (int ks = 0; ks < 4; ++ks) { float f[8]; unpack8(*(const uint4*)((const unsigned char*)qf + fbase + (unsigned)(q0 + 32 * up) * 128u + (unsigned)ks * 1024u), f);
        float gq[8];
        { const float4 qa = *(const float4*)(p.q_norm_g + 16 * ks + 8 * hh), qb = *(const float4*)(p.q_norm_g + 16 * ks + 8 * hh + 4), ka4 = *(const float4*)(p.k_norm_g + 16 * ks + 8 * hh), kb4 = *(const float4*)(p.k_norm_g + 16 * ks + 8 * hh + 4);
          gq[0] = qa.x * ka4.x * iq; gq[1] = qa.y * ka4.y * iq; gq[2] = qa.z * ka4.z * iq; gq[3] = qa.w * ka4.w * iq; gq[4] = qb.x * kb4.x * iq; gq[5] = qb.y * kb4.y * iq; gq[6] = qb.z * kb4.z * iq; gq[7] = qb.w * kb4.w * iq; }
        qst[(up * 4 + ks) * 64] = pack_bf16x8(f[0] * gq[0], f[1] * gq[1], f[2] * gq[2], f[3] * gq[3], f[4] * gq[4], f[5] * gq[5], f[6] * gq[6], f[7] * gq[7]); }
    }
    asm volatile("" ::: "memory");
    const LAS bf16x8_t* qL = qst; const LAS bf16x8_t* qU = qst + 256;
    f32x16_t oL0, oL1, oU0, oU1;
#pragma unroll
    for (int r = 0; r < 16; ++r) { oL0[r] = 0.f; oL1[r] = 0.f; oU0[r] = 0.f; oU1[r] = 0.f; }
    float cL = 1.f, cU = 1.f;
    float ik[16];
    attn_fin(ka, ik, wl, lane, hh);
    attn_post<true>(ka, ik, attn_s(ka, qU), c, hh, cU, oU0, oU1);
    ATT_LOAD(ka, q0 >= 32 ? q0 - 32 : 0);
    attn_fin(kb, ik, wl, lane, hh);
    { const f32x16_t s2 = attn_s(kb, qL), s1 = attn_s(kb, qU); attn_post<false>(kb, ik, s1, c, hh, cU, oU0, oU1); attn_post<true>(kb, ik, s2, c, hh, cL, oL0, oL1); }
    for (int tb = q0 - 32; tb >= 0; tb -= 64) {
      ATT_LOAD(kb, tb >= 32 ? tb - 32 : 0);
      attn_fin(ka, ik, wl, lane, hh);
      { const bool uz = __all(cU == 0.f);
        const f32x16_t s2 = attn_s(ka, qL);
        if (!uz) attn_post<false>(ka, ik, attn_s(ka, qU), c, hh, cU, oU0, oU1);
        attn_post<false>(ka, ik, s2, c, hh, cL, oL0, oL1);
        if (uz && __all(cL == 0.f)) break; }
      if (tb < 32) break;
      ATT_LOAD(ka, tb >= 64 ? tb - 64 : 0);
      attn_fin(kb, ik, wl, lane, hh);
      { const bool uz = __all(cU == 0.f);
        const f32x16_t s2 = attn_s(kb, qL);
        if (!uz) attn_post<false>(kb, ik, attn_s(kb, qU), c, hh, cU, oU0, oU1);
        attn_post<false>(kb, ik, s2, c, hh, cL, oL0, oL1);
        if (uz && __all(cL == 0.f)) break; }
    }
#undef ATT_LOAD
    float sL = 0.f, sU = 0.f;
#pragma unroll
    for (int r = 0; r < 16; ++r) { sL += oL0[r] * oL0[r] + oL1[r] * oL1[r]; sU += oU0[r] * oU0[r] + oU1[r] * oU1[r]; }
    sL += __shfl_xor(sL, 32); sU += __shfl_xor(sU, 32);
    __syncthreads();
    if (hh == 0) { red[head * 64 + c] = sL; red[head * 64 + 32 + c] = sU; }
    __syncthreads();
    float tL = 0.f, tU = 0.f;
#pragma unroll
    for (int h8 = 0; h8 < 8; ++h8) { tL += red[h8 * 64 + c]; tU += red[h8 * 64 + 32 + c]; }
    const float* g = p.sb_out_g + head * 64 + 4 * hh;
    if (F8_OUT) {
#pragma unroll
    for (int up = 0; up < 2; ++up) {
      const float inv = rsqrtf((up ? tU : tL) * (1.f / DSB) + EPS);
      unsigned char* orow = (unsigned char*)mixed + (tq + 32 * up) * D + head * 64 + 8 * hh;
#pragma unroll
      for (int half = 0; half < 2; ++half)
#pragma unroll
        for (int pr = 0; pr < 2; ++pr) {
          unsigned w[2];
#pragma unroll
          for (int e = 0; e < 2; ++e) { const int rg = 2 * pr + e; const float4 gg = *(const float4*)(g + 32 * half + 8 * rg);
            const f32x16_t& o = up ? (half ? oU1 : oU0) : (half ? oL1 : oL0);
            w[e] = pack4_fp8(o[4 * rg] * inv * gg.x, o[4 * rg + 1] * inv * gg.y, o[4 * rg + 2] * inv * gg.z, o[4 * rg + 3] * inv * gg.w); }
          const auto s0 = __builtin_amdgcn_permlane32_swap(w[0], w[1], false, false);
          uint2 st; st.x = s0[0]; st.y = s0[1];
          *(uint2*)(orow + 32 * half + 16 * pr) = st;
        }
    }
    } else {
#pragma unroll
    for (int up = 0; up < 2; ++up) {
      const float inv = rsqrtf((up ? tU : tL) * (1.f / DSB) + EPS);
      u16* orow = mixed + (tq + 32 * up) * D + head * 64 + 8 * hh;
#pragma unroll
      for (int half = 0; half < 2; ++half)
#pragma unroll
        for (int pr = 0; pr < 2; ++pr) {
          unsigned w[2][2];
#pragma unroll
          for (int e = 0; e < 2; ++e) { const int rg = 2 * pr + e; const float4 gg = *(const float4*)(g + 32 * half + 8 * rg);
            const f32x16_t& o = up ? (half ? oU1 : oU0) : (half ? oL1 : oL0);
            w[e][0] = pack2(o[4 * rg] * inv * gg.x, o[4 * rg + 1] * inv * gg.y); w[e][1] = pack2(o[4 * rg + 2] * inv * gg.z, o[4 * rg + 3] * inv * gg.w); }
          const auto s0 = __builtin_amdgcn_permlane32_swap(w[0][0], w[1][0], false, false), s1 = __builtin_amdgcn_permlane32_swap(w[0][1], w[1][1], false, false);
          uint4 st; st.x = s0[0]; st.y = s1[0]; st.z = s0[1]; st.w = s1[1];
          *(uint4*)(orow + 32 * half + 16 * pr) = st;
        }
    }
    }
  }
}
#define SEL_DI DI
#define SEL_F2U(x) __float_as_uint(x)
#define SEL_U2F(x) __uint_as_float(x)

#define CE(a, b) do { const unsigned _h = (a) > (b) ? (a) : (b), _l = (a) > (b) ? (b) : (a); (a) = _h; (b) = _l; } while (0)
SEL_DI void sort16(unsigned (&v)[16]) {
  CE(v[0], v[1]); CE(v[2], v[3]); CE(v[0], v[2]); CE(v[1], v[3]); CE(v[1], v[2]); CE(v[4], v[5]); CE(v[6], v[7]); CE(v[4], v[6]);
  CE(v[5], v[7]); CE(v[5], v[6]); CE(v[0], v[4]); CE(v[2], v[6]); CE(v[2], v[4]); CE(v[1], v[5]); CE(v[3], v[7]); CE(v[3], v[5]);
  CE(v[1], v[2]); CE(v[3], v[4]); CE(v[5], v[6]); CE(v[8], v[9]); CE(v[10], v[11]); CE(v[8], v[10]); CE(v[9], v[11]); CE(v[9], v[10]);
  CE(v[12], v[13]); CE(v[14], v[15]); CE(v[12], v[14]); CE(v[13], v[15]); CE(v[13], v[14]); CE(v[8], v[12]); CE(v[10], v[14]); CE(v[10], v[12]);
  CE(v[9], v[13]); CE(v[11], v[15]); CE(v[11], v[13]); CE(v[9], v[10]); CE(v[11], v[12]); CE(v[13], v[14]); CE(v[0], v[8]); CE(v[4], v[12]);
  CE(v[4], v[8]); CE(v[2], v[10]); CE(v[6], v[14]); CE(v[6], v[10]); CE(v[2], v[4]); CE(v[6], v[8]); CE(v[10], v[12]); CE(v[1], v[9]);
  CE(v[5], v[13]); CE(v[5], v[9]); CE(v[3], v[11]); CE(v[7], v[15]); CE(v[7], v[11]); CE(v[3], v[5]); CE(v[7], v[9]); CE(v[11], v[13]);
  CE(v[1], v[2]); CE(v[3], v[4]); CE(v[5], v[6]); CE(v[7], v[8]); CE(v[9], v[10]); CE(v[11], v[12]); CE(v[13], v[14]);
}
SEL_DI void bitonic_merge16(unsigned (&v)[16]) {
#pragma unroll
  for (int d = 8; d >= 1; d >>= 1)
#pragma unroll
    for (int i = 0; i < 16; ++i) if ((i & d) == 0) CE(v[i], v[i + d]);
}
SEL_DI void merge_top16(unsigned (&a)[16], const unsigned (&b)[16]) {
#pragma unroll
  for (int i = 0; i < 16; ++i) a[i] = a[i] > b[15 - i] ? a[i] : b[15 - i];
  bitonic_merge16(a);
}
SEL_DI void top16_of_64(unsigned (&g0)[16], unsigned (&g1)[16], unsigned (&g2)[16], unsigned (&g3)[16]) {
  sort16(g0); sort16(g1); sort16(g2); sort16(g3);
  merge_top16(g0, g1); merge_top16(g2, g3); merge_top16(g0, g2);
}
SEL_DI unsigned cand_key(float a, float b, unsigned payload) {
  float s = a + b; s = s < 32.0f ? 32.0f : (s > 127.99f ? 127.99f : s);
  return ((SEL_F2U(s) << 8) & 0xFFFFC000u) | payload;
}
SEL_DI void stage2(const unsigned (&L1)[16], const unsigned (&L2)[16], unsigned (&R)[16]) {
  float f1[16], f2m[16]; unsigned P1[16], P2[16];
#pragma unroll
  for (int i = 0; i < 16; ++i) { f1[i] = SEL_U2F(L1[i] & ~127u); f2m[i] = SEL_U2F(L2[i] & ~127u) - 64.0f; P1[i] = (L1[i] & 127u) << 7; P2[i] = L2[i] & 127u; }
  unsigned K[64];
  K[0] = cand_key(f1[0], f2m[0], P1[0] | P2[0]);
  K[1] = cand_key(f1[0], f2m[1], P1[0] | P2[1]);
  K[2] = cand_key(f1[0], f2m[2], P1[0] | P2[2]);
  K[3] = cand_key(f1[0], f2m[3], P1[0] | P2[3]);
  K[4] = cand_key(f1[0], f2m[4], P1[0] | P2[4]);
  K[5] = cand_key(f1[0], f2m[5], P1[0] | P2[5]);
  K[6] = cand_key(f1[0], f2m[6], P1[0] | P2[6]);
  K[7] = cand_key(f1[0], f2m[7], P1[0] | P2[7]);
  K[8] = cand_key(f1[0], f2m[8], P1[0] | P2[8]);
  K[9] = cand_key(f1[0], f2m[9], P1[0] | P2[9]);
  K[10] = cand_key(f1[0], f2m[10], P1[0] | P2[10]);
  K[11] = cand_key(f1[0], f2m[11], P1[0] | P2[11]);
  K[12] = cand_key(f1[0], f2m[12], P1[0] | P2[12]);
  K[13] = cand_key(f1[0], f2m[13], P1[0] | P2[13]);
  K[14] = cand_key(f1[0], f2m[14], P1[0] | P2[14]);
  K[15] = cand_key(f1[0], f2m[15], P1[0] | P2[15]);
  K[16] = cand_key(f1[1], f2m[0], P1[1] | P2[0]);
  K[17] = cand_key(f1[1], f2m[1], P1[1] | P2[1]);
  K[18] = cand_key(f1[1], f2m[2], P1[1] | P2[2]);
  K[19] = cand_key(f1[1], f2m[3], P1[1] | P2[3]);
  K[20] = cand_key(f1[1], f2m[4], P1[1] | P2[4]);
  K[21] = cand_key(f1[1], f2m[5], P1[1] | P2[5]);
  K[22] = cand_key(f1[1], f2m[6], P1[1] | P2[6]);
  K[23] = cand_key(f1[1], f2m[7], P1[1] | P2[7]);
  K[24] = cand_key(f1[2], f2m[0], P1[2] | P2[0]);
  K[25] = cand_key(f1[2], f2m[1], P1[2] | P2[1]);
  K[26] = cand_key(f1[2], f2m[2], P1[2] | P2[2]);
  K[27] = cand_key(f1[2], f2m[3], P1[2] | P2[3]);
  K[28] = cand_key(f1[2], f2m[4], P1[2] | P2[4]);
  K[29] = cand_key(f1[3], f2m[0], P1[3] | P2[0]);
  K[30] = cand_key(f1[3], f2m[1], P1[3] | P2[1]);
  K[31] = cand_key(f1[3], f2m[2], P1[3] | P2[2]);
  K[32] = cand_key(f1[3], f2m[3], P1[3] | P2[3]);
  K[33] = cand_key(f1[4], f2m[0], P1[4] | P2[0]);
  K[34] = cand_key(f1[4], f2m[1], P1[4] | P2[1]);
  K[35] = cand_key(f1[4], f2m[2], P1[4] | P2[2]);
  K[36] = cand_key(f1[5], f2m[0], P1[5] | P2[0]);
  K[37] = cand_key(f1[5], f2m[1], P1[5] | P2[1]);
  K[38] = cand_key(f1[6], f2m[0], P1[6] | P2[0]);
  K[39] = cand_key(f1[6], f2m[1], P1[6] | P2[1]);
  K[40] = cand_key(f1[7], f2m[0], P1[7] | P2[0]);
  K[41] = cand_key(f1[7], f2m[1], P1[7] | P2[1]);
  K[42] = cand_key(f1[8], f2m[0], P1[8] | P2[0]);
  K[43] = cand_key(f1[9], f2m[0], P1[9] | P2[0]);
  K[44] = cand_key(f1[10], f2m[0], P1[10] | P2[0]);
  K[45] = cand_key(f1[11], f2m[0], P1[11] | P2[0]);
  K[46] = cand_key(f1[12], f2m[0], P1[12] | P2[0]);
  K[47] = cand_key(f1[13], f2m[0], P1[13] | P2[0]);
  K[48] = cand_key(f1[14], f2m[0], P1[14] | P2[0]);
  K[49] = cand_key(f1[15], f2m[0], P1[15] | P2[0]);
#pragma unroll
  for (int c = 50; c < 64; ++c) K[c] = 0u;
  unsigned g1[16], g2[16], g3[16];
#pragma unroll
  for (int i = 0; i < 16; ++i) { R[i] = K[i]; g1[i] = K[16 + i]; g2[i] = K[32 + i]; g3[i] = K[48 + i]; }
  sort16(R); sort16(g1); sort16(g2); CE(g3[0], g3[1]);
  merge_top16(R, g1);
  g2[15] = g2[15] > g3[0] ? g2[15] : g3[0]; g2[14] = g2[14] > g3[1] ? g2[14] : g3[1];
  bitonic_merge16(g2);
  merge_top16(R, g2);
}

constexpr int SKP = 272;
struct QFrag { bf16x8_t f[8]; };
DI QFrag stage1_load(const u16* __restrict__ qfrag) { QFrag q;
#pragma unroll
  for (int ks = 0; ks < 8; ++ks) q.f[ks] = *(const bf16x8_t*)(qfrag + 512 * ks);
  return q; }
DI void stage1(const QFrag& qfr, const LAS unsigned char* sk, int tok, int hh, unsigned (&out)[16]) {
  f32x16_t acc[4];
#pragma unroll
  for (int kt = 0; kt < 4; ++kt)
#pragma unroll
    for (int r = 0; r < 16; ++r) acc[kt][r] = 64.0f;
  bf16x8_t ak[2][4];
#pragma unroll
  for (int kt = 0; kt < 4; ++kt) ak[0][kt] = *(const LAS bf16x8_t*)(sk + (32 * kt + tok) * SKP + (8 * hh) * 2);
  __builtin_amdgcn_sched_barrier(0);
#pragma unroll
  for (int ks = 0; ks < 8; ++ks) {
    if (ks < 7) {
#pragma unroll
      for (int kt = 0; kt < 4; ++kt) ak[(ks + 1) & 1][kt] = *(const LAS bf16x8_t*)(sk + (32 * kt + tok) * SKP + (16 * (ks + 1) + 8 * hh) * 2);
    }
#pragma unroll
    for (int kt = 0; kt < 4; ++kt) acc[kt] = __builtin_amdgcn_mfma_f32_32x32x16_bf16(ak[ks & 1][kt], qfr.f[ks], acc[kt], 0, 0, 0);
    __builtin_amdgcn_sched_barrier(0);
  }
  unsigned g1[16], g2[16], g3[16];
#pragma unroll
  for (int r = 0; r < 16; ++r) {
    const unsigned ix = (unsigned)((r & 3) + 8 * (r >> 2));
    out[r] = (__float_as_uint(acc[0][r]) & ~127u) | ix; g1[r] = (__float_as_uint(acc[1][r]) & ~127u) | (32u + ix);
    g2[r] = (__float_as_uint(acc[2][r]) & ~127u) | (64u + ix); g3[r] = (__float_as_uint(acc[3][r]) & ~127u) | (96u + ix);
  }
  top16_of_64(out, g1, g2, g3);
  unsigned oth[16];
#pragma unroll
  for (int i = 0; i < 16; ++i) { out[i] |= (unsigned)(hh << 2); }
#pragma unroll
  for (int i = 0; i < 16; ++i) oth[i] = (unsigned)__shfl_xor((int)out[i], 32);
  merge_top16(out, oth);
}
template <bool SYNC>
DI void topk_fill(const Params& p, unsigned char* smem, int t0 = 0, int nt = NTHREADS) {
  const int tid = (int)threadIdx.x - t0;
  LAS unsigned char* sk = (LAS unsigned char*)smem;
  if (SYNC) __syncthreads();
#pragma unroll 1
  for (int i = tid; i < 2 * 128 * 16; i += nt) {
    const int c = i & 15, row = i >> 4;
    const float4* s = (const float4*)(p.sub_keys + (size_t)row * 128 + c * 8);
    const float4 a = s[0], b = s[1];
    pg8::u32x4 o; o.x = pack2(a.x, a.y); o.y = pack2(a.z, a.w); o.z = pack2(b.x, b.y); o.w = pack2(b.z, b.w);
    *(LAS pg8::u32x4*)(sk + row * SKP + c * 16) = o;
  }
  if (SYNC) __syncthreads();
}
DI void topk_phase(const Params& p, const u16* __restrict__ qp, const float* __restrict__ uinv, int* __restrict__ idx_out, float2* __restrict__ gu_out, unsigned char* smem, bool filled) {
  const int tid = threadIdx.x;
  LAS unsigned char* sk = (LAS unsigned char*)smem;
  if (!filled) topk_fill<true>(p, smem);
  const int lane = tid & 63, tok = lane & 31, hh = lane >> 5, gw = blockIdx.x * NWAVES + (tid >> 6), nw = gridDim.x * NWAVES;
  for (int item = gw; item < (T / 32) * 4; item += nw) {
    const int t = (item >> 2) * 32 + tok, hp = item & 3;
    const u16* qt = qp + (((size_t)(item >> 2) * 16 + hp * 4) * 8 * 64 + lane) * 8;
    unsigned LA1[16], LA2[16], LB1[16], LB2[16];
    { QFrag fa = stage1_load(qt), fb = stage1_load(qt + 4096);
      stage1(fa, sk, tok, hh, LA1); fa = stage1_load(qt + 2 * 4096);
      stage1(fb, sk + 128 * SKP, tok, hh, LA2); fb = stage1_load(qt + 3 * 4096);
      stage1(fa, sk, tok, hh, LB1);
      stage1(fb, sk + 128 * SKP, tok, hh, LB2); }
    unsigned L1[16], L2[16], R[16];
#pragma unroll
    for (int i = 0; i < 16; ++i) { L1[i] = hh ? LB1[i] : LA1[i]; L2[i] = hh ? LB2[i] : LA2[i]; }
    stage2(L1, L2, R);
    const int head = hp * 2 + hh;
    float ev[16], sum = 0.f;
    const float mx = __uint_as_float(0x42000000u | ((R[0] >> 14) << 6));
#pragma unroll
    for (int k = 0; k < 16; ++k) { ev[k] = __expf(__uint_as_float(0x42000000u | ((R[k] >> 14) << 6)) - mx); sum += ev[k]; }
    const float rs = 1.f / sum;
    uint4* go = (uint4*)(gu_out + (size_t)t * 128 + head * 16);
#pragma unroll
    for (int k2 = 0; k2 < 8; ++k2) {
      const unsigned e0 = R[2 * k2] & 0x3FFFu, e1 = R[2 * k2 + 1] & 0x3FFFu;
      uint4 rec; rec.x = e0 | (pack2(0.f, ev[2 * k2] * rs) & 0xFFFF0000u); rec.y = __float_as_uint(uinv[e0]); rec.z = e1 | (pack2(0.f, ev[2 * k2 + 1] * rs) & 0xFFFF0000u); rec.w = __float_as_uint(uinv[e1]);
      go[k2] = rec;
    }
  }
}

typedef float f32x4_t __attribute__((ext_vector_type(4)));
typedef float f32x2_t __attribute__((ext_vector_type(2)));
typedef int i32x8_t __attribute__((ext_vector_type(8)));
typedef int i32x2_t __attribute__((ext_vector_type(2)));
constexpr int UIP = 132;
constexpr int UGP = 1032;
struct UBuf { uint4 r0, r1, r2, r3; unsigned e; float vi; };
#define U_IDS(g) do { const LAS unsigned* _il = idl + (lane >> 5) * UIP + (g); nid0 = _il[0]; nid1 = _il[2 * UIP]; nid2 = _il[4 * UIP]; nid3 = _il[6 * UIP]; nide = myi[(g)]; } while (0)
#define U_LOAD(buf, g) do { const unsigned _e = nide; const unsigned _lo = 16u * (lane & 31); \
    buf.r0 = *(const uint4*)(U4 + (size_t)nid0 * 512 + _lo); buf.r1 = *(const uint4*)(U4 + (size_t)nid1 * 512 + _lo); \
    buf.r2 = *(const uint4*)(U4 + (size_t)nid2 * 512 + _lo); buf.r3 = *(const uint4*)(U4 + (size_t)nid3 * 512 + _lo); \
    buf.e = _e; buf.vi = vinv[_e]; U_IDS(((g) + 1) & 127); } while (0)
#define U_ST(i, r) do { pg8::u32x4 _o; _o.x = (r).x; _o.y = (r).y; _o.z = (r).z; _o.w = (r).w; *(LAS pg8::u32x4*)(gst + (2 * (i) + (lane >> 5)) * 528 + 16 * (lane & 31)) = _o; } while (0)
#define U_LD(j) (*(const LAS pg8::u32x4*)(gld + 128 * (j)))
#define U_MMA(c, r, b) c = __builtin_amdgcn_mfma_scale_f32_16x16x128_f8f6f4((i32x8_t){(int)(r).x, (int)(r).y, (int)(r).z, (int)(r).w, 0, 0, 0, 0}, b, c, 4, 0, 0, 0x7F7F7F7F, 0, 0x7F7F7F7F)
#define U_COMP(buf, g) do { f32x4_t c = {0.f, 0.f, 0.f, 0.f}; \
    U_ST(0, buf.r0); U_ST(1, buf.r1); U_ST(2, buf.r2); U_ST(3, buf.r3); asm volatile("" ::: "memory"); \
    { const pg8::u32x4 a0 = U_LD(0), a1 = U_LD(1), a2 = U_LD(2), a3 = U_LD(3); asm volatile("" ::: "memory"); \
      U_MMA(c, a0, B0); U_MMA(c, a1, B1); U_MMA(c, a2, B2); U_MMA(c, a3, B3); } \
    const int rsel = pp & 3; const float v = rsel == 0 ? c[0] : rsel == 1 ? c[1] : rsel == 2 ? c[2] : c[3]; \
    const float vo = __shfl(v, (lane + 40) & 63); \
    if (pp < 8 && q == (pp >> 2)) { const f32x2_t gu2 = *(const LAS f32x2_t*)(myg + (g) * 8); \
      const float d = (v + vo) * gu2[1]; const float act = 0.5f * d * (1.f + erff(d * 0.70710678118654752f)); \
      uint2 o; o.x = buf.e; o.y = __float_as_uint(gu2[0] * act * buf.vi); pw[(size_t)tok * 128 + (g)] = o; } } while (0)
DI void peer_u_phase(const unsigned char* __restrict__ x8, const float* __restrict__ rowss, const int* __restrict__ idx, const float2* __restrict__ gu,
                     const unsigned char* __restrict__ U4, const float* __restrict__ vinv, uint2* __restrict__ pw, unsigned char* smem) {
  const int lane = threadIdx.x & 63, wave = threadIdx.x >> 6, pp = lane & 15, q = lane >> 4, gw = blockIdx.x * NWAVES + wave, nw = gridDim.x * NWAVES;
  const int pi = pp & 7, x = q + 4 * (pp >> 3);
  const unsigned xoff = 16u * x;
  LAS unsigned* idl = (LAS unsigned*)(smem + wave * (8 * UIP * 4 + 8 * UGP + 8 * 528 + 1024));
  LAS unsigned char* gul = (LAS unsigned char*)(idl + 8 * UIP);
  LAS unsigned char* gst = gul + 8 * UGP;
  const LAS unsigned char* gld = gst + pi * 528 + 16 * x;
  LAS unsigned* cnt = (LAS unsigned*)(gst + 8 * 528);
  const LAS unsigned* myi = idl + pi * UIP;
  const LAS unsigned char* myg = gul + pi * UGP;
  for (int unit = gw; unit < T / 8; unit += nw) {
    const int tok = unit * 8 + pi;
    __builtin_amdgcn_wave_barrier();
    uint4 gv[8];
#pragma unroll
    for (int r8 = 0; r8 < 8; ++r8) gv[r8] = ((const uint4*)(gu + (size_t)(unit * 8 + r8) * 128))[lane];
    ((LAS pg8::u32x4*)cnt)[lane] = (pg8::u32x4){0u, 0u, 0u, 0u};
    __builtin_amdgcn_fence(__ATOMIC_RELEASE, "wavefront");
    __builtin_amdgcn_wave_barrier();
    unsigned rk0[8], rk1[8];
#pragma unroll
    for (int r8 = 0; r8 < 8; ++r8) {
      rk0[r8] = __hip_atomic_fetch_add(cnt + r8 * 32 + ((gv[r8].x & 0x3FFFu) >> 9), 1u, __ATOMIC_RELAXED, __HIP_MEMORY_SCOPE_WAVEFRONT);
      rk1[r8] = __hip_atomic_fetch_add(cnt + r8 * 32 + ((gv[r8].z & 0x3FFFu) >> 9), 1u, __ATOMIC_RELAXED, __HIP_MEMORY_SCOPE_WAVEFRONT);
    }
    __builtin_amdgcn_fence(__ATOMIC_RELEASE, "wavefront");
    __builtin_amdgcn_wave_barrier();
#pragma unroll
    for (int k = 0; k < 4; ++k) {
      LAS unsigned* cp = cnt + (2 * k + (lane >> 5)) * 32 + (lane & 31);
      const unsigned c = *cp; unsigned inc = c;
#pragma unroll
      for (int d = 1; d < 32; d <<= 1) { const unsigned o = (unsigned)__shfl_up((int)inc, d, 32); inc += ((lane & 31) >= d) ? o : 0u; }
      *cp = inc - c;
    }
    __builtin_amdgcn_fence(__ATOMIC_RELEASE, "wavefront");
    __builtin_amdgcn_wave_barrier();
#pragma unroll
    for (int r8 = 0; r8 < 8; ++r8) {
      const unsigned e0 = gv[r8].x & 0x3FFFu, e1 = gv[r8].z & 0x3FFFu;
      const unsigned s0 = cnt[r8 * 32 + (e0 >> 9)] + rk0[r8], s1 = cnt[r8 * 32 + (e1 >> 9)] + rk1[r8];
      idl[r8 * UIP + s0] = e0; idl[r8 * UIP + s1] = e1;
      *(LAS i32x2_t*)(gul + r8 * UGP + s0 * 8) = (i32x2_t){(int)(gv[r8].x & 0xFFFF0000u), (int)gv[r8].y};
      *(LAS i32x2_t*)(gul + r8 * UGP + s1 * 8) = (i32x2_t){(int)(gv[r8].z & 0xFFFF0000u), (int)gv[r8].w};
    }
    __builtin_amdgcn_fence(__ATOMIC_RELEASE, "wavefront");
    __builtin_amdgcn_wave_barrier();
    const float inv = rsqrtf(rowss[tok] * (1.f / D) + EPS);
    i32x8_t B0, B1, B2, B3;
#define U_CV4(wd) ({ const int _w = (int)(wd); int _o = __builtin_amdgcn_cvt_pk_fp8_f32(__builtin_amdgcn_cvt_f32_fp8(_w, 0) * inv, __builtin_amdgcn_cvt_f32_fp8(_w, 1) * inv, 0, false); \
      __builtin_amdgcn_cvt_pk_fp8_f32(__builtin_amdgcn_cvt_f32_fp8(_w, 2) * inv, __builtin_amdgcn_cvt_f32_fp8(_w, 3) * inv, _o, true); })
#define U_BUILD(Bv, i) do { const unsigned char* sb = x8 + (size_t)tok * D + 256 * (i) + 128 * (pp >> 3) + 16 * q; \
      _Pragma("unroll") for (int h2 = 0; h2 < 2; ++h2) { const uint4 r = *(const uint4*)(sb + 64 * h2); \
        Bv[4 * h2] = U_CV4(r.x); Bv[4 * h2 + 1] = U_CV4(r.y); Bv[4 * h2 + 2] = U_CV4(r.z); Bv[4 * h2 + 3] = U_CV4(r.w); } } while (0)
    U_BUILD(B0, 0); U_BUILD(B1, 1); U_BUILD(B2, 2); U_BUILD(B3, 3);
    UBuf b0, b1, b2, b3;
#define SB() __builtin_amdgcn_sched_barrier(0)
    unsigned nid0, nid1, nid2, nid3, nide; U_IDS(0);
    U_LOAD(b0, 0); U_LOAD(b1, 1); U_LOAD(b2, 2); SB();
#pragma unroll 1
    for (int g = 0; g < 128; g += 4) {
      U_LOAD(b3, g + 3); SB(); U_COMP(b0, g); SB();
      U_LOAD(b0, (g + 4) & 127); SB(); U_COMP(b1, g + 1); SB();
      U_LOAD(b1, (g + 5) & 127); SB(); U_COMP(b2, g + 2); SB();
      U_LOAD(b2, (g + 6) & 127); SB(); U_COMP(b3, g + 3); SB();
    }
  }
}

template <bool LOCAL>
DI void peer_v_phase(const uint2* __restrict__ pw, const unsigned char* __restrict__ V4, const u16* __restrict__ xb, float* __restrict__ out, unsigned char* smem) {
  const int lane = threadIdx.x & 63, wave = threadIdx.x >> 6, r = lane >> 3, c = lane & 7, n16 = lane & 15, kg = lane >> 4;
  LAS unsigned char* img = (LAS unsigned char*)smem + wave * VWAVE;
  LAS unsigned char* pbuf = img + 128 * VIMP;
  const int nunit = 4 * (T / 64);
  const int cnt = LOCAL ? 4 : (((int)blockIdx.x < nunit) ? (nunit - 1 - (int)blockIdx.x) / (int)gridDim.x + 1 : 0), N = cnt * 8;
  if (N == 0) return;
#define V_TOK(n, jj, tt) do { if (LOCAL) { jj = (n) >> 3; tt = (int)blockIdx.x * 64 + wave * 8 + ((n) & 7); } else { const int _u = (int)blockIdx.x + ((n) >> 3) * (int)gridDim.x; jj = _u & 3; tt = (_u >> 2) * 64 + wave * 8 + ((n) & 7); } } while (0)
#define V_LDPW(n) ({ int _j, _t; V_TOK(n, _j, _t); ((const uint4*)(pw + (size_t)_t * 128))[lane]; })
#define V_STAGE(n, pq, scv) do { LAS unsigned char* _b = pbuf + ((n) & 1) * 1024; \
    *(LAS i32x2_t*)(_b + 8 * lane) = (i32x2_t){(int)(pq).x, (int)(pq).z}; *(LAS i32x2_t*)(_b + 512 + 8 * lane) = (i32x2_t){(int)(pq).y, (int)(pq).w}; \
    const float _m = wave_max(fmaxf(fabsf(__uint_as_float((pq).y)), fabsf(__uint_as_float((pq).w)))); scv = _m > 0.f ? 224.f / _m : 1.f; } while (0)
#define V_GATHER(n) do { int _j, _t; V_TOK(n, _j, _t); const unsigned char* _vb = V4 + (size_t)_j * ((size_t)NEXP * 128) + 16 * c; const LAS unsigned* _e = (const LAS unsigned*)(pbuf + ((n) & 1) * 1024); \
    _Pragma("unroll") for (int i = 0; i < 16; ++i) G[i] = *(const uint4*)(_vb + (_e[8 * i + r] * 128u)); } while (0)
#define V_WRITEIMG() do { _Pragma("unroll") for (int i = 0; i < 16; ++i) { LAS unsigned char* _d = img + (8 * i + r) * VIMP + 16 * c; \
      *(LAS i32x2_t*)(_d) = (i32x2_t){(int)G[i].x, (int)G[i].y}; *(LAS i32x2_t*)(_d + 8) = (i32x2_t){(int)G[i].z, (int)G[i].w}; } } while (0)
  uint4 G[16];
  uint4 pq = V_LDPW(0);
  float sc_cur, sc_nxt;
  V_STAGE(0, pq, sc_cur); asm volatile("" ::: "memory");
  if (N > 1) pq = V_LDPW(1);
  V_GATHER(0);
  V_WRITEIMG(); asm volatile("" ::: "memory");
  for (int n = 0; n < N; ++n) {
    int j, t; V_TOK(n, j, t);
    const uint2 xr = *(const uint2*)(xb + (size_t)t * D + 256 * j + 4 * lane);
    if (n + 1 < N) { V_STAGE(n + 1, pq, sc_nxt); asm volatile("" ::: "memory"); if (n + 2 < N) pq = V_LDPW(n + 2); V_GATHER(n + 1); }
    __builtin_amdgcn_sched_barrier(0);
    i32x8_t A;
    { const LAS float* wl = (const LAS float*)(pbuf + (n & 1) * 1024 + 512);
#pragma unroll
      for (int h = 0; h < 2; ++h)
#pragma unroll
        for (int d = 0; d < 4; ++d) { const f32x4_t w4 = *(const LAS f32x4_t*)(wl + 64 * h + 16 * kg + 4 * d);
          int w = __builtin_amdgcn_cvt_pk_fp8_f32(w4[0] * sc_cur, w4[1] * sc_cur, 0, false); w = __builtin_amdgcn_cvt_pk_fp8_f32(w4[2] * sc_cur, w4[3] * sc_cur, w, true);
          A[4 * h + d] = n16 == 0 ? w : 0; } }
    float val[16];
    const LAS unsigned char* ib = img + (32 * kg + n16) * VIMP;
    i32x2_t tb0[16], tb1[16];
#pragma unroll
    for (int ct = 0; ct < 16; ++ct) { tb0[ct] = __builtin_amdgcn_ds_read_tr4_b64_v2i32((LAS i32x2_t*)(ib + 8 * ct)); tb1[ct] = __builtin_amdgcn_ds_read_tr4_b64_v2i32((LAS i32x2_t*)(ib + 16 * VIMP + 8 * ct)); }
#pragma unroll
    for (int ct = 0; ct < 16; ++ct) {
      const f32x4_t z = {0.f, 0.f, 0.f, 0.f};
      const f32x4_t cc = __builtin_amdgcn_mfma_scale_f32_16x16x128_f8f6f4(A, (i32x8_t){tb0[ct][0], tb0[ct][1], tb1[ct][0], tb1[ct][1], 0, 0, 0, 0}, z, 0, 4, 0, 0x7F7F7F7F, 0, 0x7F7F7F7F);
      val[ct] = cc[0];
    }
    asm volatile("" : "+v"(val[0]), "+v"(val[1]), "+v"(val[2]), "+v"(val[3]), "+v"(val[4]), "+v"(val[5]), "+v"(val[6]), "+v"(val[7]),
                      "+v"(val[8]), "+v"(val[9]), "+v"(val[10]), "+v"(val[11]), "+v"(val[12]), "+v"(val[13]), "+v"(val[14]), "+v"(val[15]));
    LAS float* stg = (LAS float*)(pbuf + (n & 1) * 1024);
    if (lane < 16) {
#pragma unroll
      for (int ct = 0; ct < 16; ++ct) stg[16 * ct + lane] = val[ct];
    }
    asm volatile("" ::: "memory");
    const f32x4_t s4 = *(const LAS f32x4_t*)(stg + 4 * lane);
    const float rs = 1.f / sc_cur;
    float4 o;
    o.x = bflo(xr.x) + s4[0] * rs; o.y = bfhi(xr.x) + s4[1] * rs; o.z = bflo(xr.y) + s4[2] * rs; o.w = bfhi(xr.y) + s4[3] * rs;
    { typedef float f4v __attribute__((ext_vector_type(4))); const f4v ov = {o.x, o.y, o.z, o.w}; __builtin_nontemporal_store(ov, (f4v*)(out + (size_t)t * D + 256 * j + 4 * lane)); }
    __builtin_amdgcn_sched_barrier(0);
    asm volatile("" ::: "memory");
    if (n + 1 < N) { V_WRITEIMG(); sc_cur = sc_nxt; }
    asm volatile("" ::: "memory");
  }
}

constexpr int NPHASE = 8;
__global__ void __launch_bounds__(NTHREADS, 2) fwd_kernel(Params p) {
  extern __shared__ __attribute__((aligned(16))) unsigned char smem[];
  cg::grid_group grid = cg::this_grid();
  unsigned char* ws = p.ws;
  u16* wt_in = (u16*)(ws + WS_WTIN); u16* wt_out = (u16*)(ws + WS_WTOUT); u16* wt_q = (u16*)(ws + WS_WTQ);
  u16* act = (u16*)(ws + WS_ACT); u16* proj = (u16*)(ws + WS_PROJ);
  unsigned char* act8 = ws + WS_PROJ + 32 * MBy;
  int* idx = (int*)(ws + WS_IDX); float2* gu = (float2*)(ws + WS_SB); unsigned char* U8 = ws + WS_U8; unsigned char* V8 = ws + WS_V8;
  uint2* pw = (uint2*)(ws + WS_PW); float* uinv = (float*)(ws + WS_UINV); float* vinv = (float*)(ws + WS_VINV);
  float* rowss = (float*)(ws + WS_ROWSS);
  volatile LAS unsigned* misc = (volatile LAS unsigned*)(LAS unsigned char*)(smem + LDS_MISC);
  if (threadIdx.x < 8) misc[threadIdx.x] = 0u;
  __syncthreads();
  XcdBarrier bar = xcd_barrier_post((unsigned*)(ws + WS_CTL), misc);
  PG8_LAS unsigned char* lds = (PG8_LAS unsigned char*)smem;
  const int lo = p.ph_lo, hi = p.ph_hi;
#define IN(k) (lo <= (k) && (k) < hi)
#define SEAM(k) do { if (IN(k) && IN((k) + 1)) xcd_barrier(bar); } while (0)
  const int bwi = blockIdx.x * (NWAVES - 1) + (int)(threadIdx.x >> 6) - 1, bwn = gridDim.x * (NWAVES - 1);
#define SEAMW(k, WORK) do { if (IN(k) && IN((k) + 1)) { asm volatile("s_waitcnt vmcnt(0)" ::: "memory"); __syncthreads(); if (threadIdx.x >= 64) { WORK; } xcd_barrier_t0(bar); __syncthreads(); } } while (0)
  if (IN(0)) {
    transpose_all(p, wt_in, wt_out, wt_q, smem);
    { const int gwa = blockIdx.x * NWAVES + (threadIdx.x >> 6), nwa = gridDim.x * NWAVES;
      convert_fp4_rows<false>(p.peer_u, p.norm2_g, U8, uinv, gwa, nwa, BW_U1, NEXP);
      convert_fp4_rows<true>(p.peer_v, nullptr, V8, vinv, gwa, nwa, BW_V0, NEXP); }
    rmsnorm1024(p.x, p.norm1_g, act, F8_QK ? act8 : nullptr);
    for (int i = blockIdx.x * NTHREADS + threadIdx.x; i < T; i += gridDim.x * NTHREADS) rowss[i] = 0.f;
    for (int i = blockIdx.x * NTHREADS + threadIdx.x; i < 2 * 32 * SEQ; i += gridDim.x * NTHREADS) ((float*)(ws + WS_SB + 16 * MBy))[i] = 0.f;
  }
  if (lo < 0) grid.sync();
  SEAM(0);
  u16* vt = (u16*)(ws + WS_SB);
  u16* qfr = (u16*)(ws + WS_PW);
  u16* kfr = (u16*)(ws + WS_IDX);
  float* ssq = (float*)(ws + WS_SB + 16 * MBy);
  int k2 = D / 2; asm volatile("" : "+s"(k2));
  if (IN(1)) {
    PG8_LAS unsigned char* xl = lds + pg8::STAGE_BYTES + __builtin_amdgcn_readfirstlane(threadIdx.x >> 6) * 2560;
    if (F8_QK) {
      { pg8::StaticOrder S; S.init(T, 1024, gridDim.x, blockIdx.x); pg8::EpiQK E{kfr, qfr, ssq, 1.f / W8S};
        pg8::Gemm g{(const u16*)act8, wt_in, T, 1024, k2}; pg8::gemm_phase<pg8::EpiQK, pg8::StaticOrder, false, true>(lds, g, S, E, nullptr); }
      { pg8::StaticOrder S; S.init(T, 2048, gridDim.x, blockIdx.x); pg8::EpiInProj E{proj, vt, kfr, qfr, ssq, xl, 4, 1.f};
        pg8::Gemm g{act, wt_in + (size_t)1024 * D, T, 2048, D}; pg8::gemm_phase<pg8::EpiInProj, pg8::StaticOrder>(lds, g, S, E, nullptr); }
    } else { pg8::StaticOrder S; S.init(T, DIN, gridDim.x, blockIdx.x); pg8::EpiInProj E{proj, vt, kfr, qfr, ssq, xl, 0, 1.f};
      pg8::Gemm g{act, wt_in, T, DIN, D}; pg8::gemm_phase<pg8::EpiInProj, pg8::StaticOrder>(lds, g, S, E, nullptr); } }
  SEAMW(1, (convert_fp4_rows<false, BWR>)(p.peer_u, p.norm2_g, U8, uinv, bwi, bwn, 0, BW_U0));
  if (IN(2)) { attn_phase(p, qfr, kfr, vt, ssq, act, smem); conv_tokens(p, proj, act); }
  SEAMW(2, (convert_fp4_rows<false, BWR>)(p.peer_u, p.norm2_g, U8, uinv, bwi, bwn, BW_U0, BW_U1));
  unsigned char* xb8 = ws + WS_IDX;
  if (IN(3)) { pg8::StaticOrder S; S.init(T, D, gridDim.x, blockIdx.x);
    pg8::EpiResid E{p.x, p.out, proj, rowss, D, F8_OUT ? 1.f / W8S : 1.f, F8_Q ? xb8 : nullptr};
    if (F8_OUT) { pg8::Gemm g{act, wt_out, T, D, k2}; pg8::gemm_phase<pg8::EpiResid, pg8::StaticOrder, false, true>(lds, g, S, E, nullptr); }
    else { pg8::Gemm g{act, wt_out, T, D, D}; pg8::gemm_phase<pg8::EpiResid, pg8::StaticOrder>(lds, g, S, E, nullptr); } }
  SEAMW(3, (convert_fp4_rows<true, BWR>)(p.peer_v, nullptr, V8, vinv, bwi, bwn, 0, BW_V0));
  u16* xb = proj;
  u16* qp = proj + (size_t)T * D;
  if (IN(4)) { pg8::StaticOrder S; S.init(T, 2048, gridDim.x, blockIdx.x);
    pg8::EpiBf16S E{qp, 2048, rowss, F8_Q ? 1.f / W8S : 1.f};
    if (F8_Q) { pg8::Gemm g{(const u16*)xb8, wt_q, T, 2048, k2}; pg8::gemm_phase<pg8::EpiBf16S, pg8::StaticOrder, false, true>(lds, g, S, E, nullptr); }
    else { pg8::Gemm g{xb, wt_q, T, 2048, D}; pg8::gemm_phase<pg8::EpiBf16S, pg8::StaticOrder>(lds, g, S, E, nullptr); } }
  const bool prefill = IN(4) && IN(5);
  if (prefill) SEAMW(4, (topk_fill<false>)(p, smem, 64, NTHREADS - 64)); else SEAM(4);
  const bool local = (gridDim.x == T / 64) && IN(5) && IN(6) && IN(7);
#define LSEAM() do { asm volatile("s_waitcnt vmcnt(0)" ::: "memory"); __builtin_amdgcn_fence(__ATOMIC_RELEASE, "workgroup"); __syncthreads(); __builtin_amdgcn_fence(__ATOMIC_ACQUIRE, "workgroup"); } while (0)
  if (IN(5)) topk_phase(p, qp, uinv, idx, gu, smem, prefill);
  if (local) LSEAM(); else SEAM(5);
  if (IN(6)) peer_u_phase(xb8, rowss, idx, gu, U8, vinv, pw, smem);
  if (local) LSEAM(); else SEAM(6);
  if (IN(7)) { if (local) peer_v_phase<true>(pw, V8, xb, p.out, smem); else peer_v_phase<false>(pw, V8, xb, p.out, smem); }
}

extern "C" void kernel_launch(void* const* d_in, const int* in_sizes, int n_in, void* d_out, int out_size, void* d_ws, size_t ws_size,
                              hipStream_t stream) {
  static int grid_blocks = 0;
  if (!grid_blocks) {
    int dev = 0, cus = 0, per_cu = 0;
    (void)hipGetDevice(&dev);
    (void)hipDeviceGetAttribute(&cus, hipDeviceAttributeMultiprocessorCount, dev);
    (void)hipFuncSetAttribute((const void*)fwd_kernel, hipFuncAttributeMaxDynamicSharedMemorySize, LDS_BYTES);
    (void)hipOccupancyMaxActiveBlocksPerMultiprocessor(&per_cu, fwd_kernel, NTHREADS, LDS_BYTES);
    if (per_cu < 1) per_cu = 1;
    if (per_cu > 1) per_cu = 1;
    grid_blocks = cus * per_cu;
  }
  Params p{};
  p.x = (const float*)d_in[0]; p.norm1_g = (const float*)d_in[1]; p.w_in = (const float*)d_in[2]; p.q_norm_g = (const float*)d_in[3];
  p.k_norm_g = (const float*)d_in[4]; p.conv_w = (const float*)d_in[5]; p.sb_out_g = (const float*)d_in[6]; p.conv_out_g = (const float*)d_in[7];
  p.w_out = (const float*)d_in[8]; p.norm2_g = (const float*)d_in[9]; p.w_q = (const float*)d_in[10]; p.sub_keys = (const float*)d_in[11];
  p.peer_u = (const float*)d_in[12]; p.peer_v = (const float*)d_in[13];
  p.out = (float*)d_out; p.ws = (unsigned char*)d_ws;
  p.ph_lo = 0; p.ph_hi = NPHASE;
  (void)hipMemsetAsync((unsigned char*)d_ws + WS_CTL, 0, 4096 * 4 + 8 * 64 * 4, stream);
  void* args[] = {&p};
  hipError_t e = hipLaunchCooperativeKernel((void*)fwd_kernel, dim3(grid_blocks), dim3(NTHREADS), args, LDS_BYTES, stream);
  if (e != hipSuccess) fprintf(stderr, "cooperative launch failed: %s (grid %d)\n", hipGetErrorString(e), grid_blocks);
}
```
